# Optimizing an MI355X kernel written in HIP

```python
import math
import jax, jax.numpy as jnp
from jax import lax
import numpy as np

D_MODEL = 1024
BATCH = 8
SEQ = 2048
DEPTH = 2
DEC_BATCH = 128
DEC_SEQ = 4
PAST_LEN = 16384
PAGE_SIZE = 128

N_META = 16
H_A = 4
DK_A = 128
DV_A = 128
QK_A = H_A * DK_A
W_A = H_A * DV_A
H_B = 4
DK_B = 128
DV_B = 128
W_B = H_B * DV_B
CONV_B = 4
D_FF = 2816
CONV_F = 3
CHUNK = 64
ALPHA = (2 * DEPTH) ** 0.25
BETA_INIT = (8 * DEPTH) ** -0.25
LN_EPS = 1e-5
NORM_EPS = 1e-6

A_Q = 0
A_K = A_Q + QK_A
A_V = A_K + QK_A
A_O = A_V + W_A
A_I = A_O + W_A
B_QKV = A_I + 2 * H_A
B_Z = B_QKV + 3 * W_B
B_BETA = B_Z + W_B
B_A = B_BETA + H_B
G_MERGE = B_A + H_B
N_IN = G_MERGE + 2 * D_MODEL

kernel_name = 'hybrid_mlstm_gdn_convffn_step'


def layer_norm(x, g, b):
    xf = x.astype(jnp.float32)
    mu = xf.mean(-1, keepdims=True)
    var = jnp.square(xf - mu).mean(-1, keepdims=True)
    return ((xf - mu) * lax.rsqrt(var + LN_EPS) * g + b).astype(x.dtype)


def head_layer_norm(h):
    mu = h.mean(-1, keepdims=True)
    var = jnp.square(h - mu).mean(-1, keepdims=True)
    return (h - mu) * lax.rsqrt(var + NORM_EPS)


def rms_norm(h):
    return h * lax.rsqrt(jnp.square(h).mean(-1, keepdims=True) + NORM_EPS)


def l2norm(h):
    return h * lax.rsqrt(jnp.square(h).sum(-1, keepdims=True) + NORM_EPS)


def causal_dwconv(u, buf, w):
    width = w.shape[0]
    L = u.shape[1]
    ext = jnp.concatenate([buf.astype(u.dtype), u], axis=1)
    out = ext[:, 0:L] * w[0]
    for j in range(1, width):
        out = out + ext[:, j:j + L] * w[j]
    return out, ext[:, L:]


def _to_chunks(a, c):
    B, H, L = a.shape[:3]
    a = a.reshape((B, H, L // c, c) + a.shape[3:])
    return jnp.moveaxis(a, 2, 0)


def _from_chunks(a):
    a = jnp.moveaxis(a, 0, 2)
    return a.reshape(a.shape[:2] + (a.shape[2] * a.shape[3],) + a.shape[4:])


def run_segments(step, carry, xs, seg_lens):
    outs = []
    start = 0
    for L in seg_lens:
        c = math.gcd(L, CHUNK)
        seg = tuple(_to_chunks(a[:, :, start:start + L], c) for a in xs)
        carry, o = lax.scan(step, carry, seg)
        outs.append(_from_chunks(o))
        start += L
    return jnp.concatenate(outs, axis=2), carry


def _mlstm_step(carry, xs):
    C, n, m = carry
    q, k, v, ig, lf = xs
    c = q.shape[2]
    incl = jnp.tril(jnp.ones((c, c), dtype=bool))
    b = jnp.cumsum(lf, axis=-1)
    D = jnp.where(incl, b[..., :, None] - b[..., None, :] + ig[..., None, :], -jnp.inf)
    inter = b + m[..., None]
    m_t = jnp.maximum(inter, D.max(-1))
    w_intra = jnp.exp(D - m_t[..., None])
    w_inter = jnp.exp(inter - m_t)
    s = jnp.einsum('bhtd,bhsd->bhts', q, k) * w_intra
    num = jnp.einsum('bhts,bhsv->bhtv', s, v) + w_inter[..., None] * jnp.einsum('bhtd,bhdv->bhtv', q, C)
    den = s.sum(-1) + w_inter * jnp.einsum('bhtd,bhd->bht', q, n)
    h = num / jnp.maximum(jnp.abs(den), jnp.exp(-m_t))[..., None]
    m_new = m_t[..., -1]
    w_src = jnp.exp(b[..., -1:] - b + ig - m_new[..., None])
    w_old = jnp.exp(b[..., -1] + m - m_new)
    kw = k * w_src[..., None]
    C_new = w_old[..., None, None] * C + jnp.einsum('bhsd,bhsv->bhdv', kw, v)
    n_new = w_old[..., None] * n + kw.sum(2)
    return (C_new, n_new, m_new), h


def _gdn_step(S, xs):
    q, k, v, beta, g = xs
    c = q.shape[2]
    incl = jnp.tril(jnp.ones((c, c), dtype=bool))
    strict = jnp.tril(jnp.ones((c, c), dtype=bool), -1)
    G = jnp.cumsum(g, axis=-1)
    decay = jnp.exp(jnp.where(incl, G[..., :, None] - G[..., None, :], -jnp.inf))
    A = jnp.where(strict, beta[..., None] * jnp.einsum('bhtd,bhsd->bhts', k, k) * decay, 0.0)
    rhs = jnp.concatenate([beta[..., None] * v, (beta * jnp.exp(G))[..., None] * k], axis=-1)
    sol = lax.linalg.triangular_solve(jnp.eye(c, dtype=A.dtype) + A, rhs, left_side=True, lower=True,
                                      unit_diagonal=True)
    dv = v.shape[-1]
    U = sol[..., :dv] - jnp.einsum('bhtd,bhdv->bhtv', sol[..., dv:], S)
    o = (jnp.exp(G)[..., None] * jnp.einsum('bhtd,bhdv->bhtv', q, S)
         + jnp.einsum('bhts,bhsv->bhtv', jnp.einsum('bhtd,bhsd->bhts', q, k) * decay, U))
    G_end = G[..., -1]
    S_new = (jnp.exp(G_end)[..., None, None] * S
             + jnp.einsum('bhsd,bhsv->bhdv', k * jnp.exp(G_end[..., None] - G)[..., None], U))
    return S_new, o


def token_mixers(x, state, w_in, gate_bias, a_norm_w, conv_w, A_log, dt_bias, b_norm_w,
                 w_pa, w_pb, w_out, seg_lens):
    C0, n0, m0, S0, conv_buf = state
    B, L, _ = x.shape
    f32 = jnp.float32
    p = x @ w_in

    def heads(a, h):
        return a.reshape(B, L, h, -1).transpose(0, 2, 1, 3).astype(f32)

    qa = heads(p[..., A_Q:A_K], H_A) * DK_A ** -0.5
    ka = heads(p[..., A_K:A_V], H_A)
    va = heads(p[..., A_V:A_O], H_A)
    gif = (p[..., A_I:B_QKV] + gate_bias).astype(f32).transpose(0, 2, 1)
    ig = gif[:, :H_A]
    lf = jax.nn.log_sigmoid(gif[:, H_A:])
    hA, (C, n, m) = run_segments(_mlstm_step, (C0.astype(f32), n0.astype(f32), m0.astype(f32)),
                                 (qa, ka, va, ig, lf), seg_lens)
    hA = head_layer_norm(hA.transpose(0, 2, 1, 3)).reshape(B, L, W_A) * a_norm_w
    hA = (jax.nn.sigmoid(p[..., A_O:A_I].astype(f32)) * hA).astype(x.dtype)

    qkv, conv_new = causal_dwconv(p[..., B_QKV:B_Z], conv_buf, conv_w)
    qkv = jax.nn.silu(qkv)
    qb = l2norm(heads(qkv[..., :W_B], H_B)) * DK_B ** -0.5
    kb = l2norm(heads(qkv[..., W_B:2 * W_B], H_B))
    vb = heads(qkv[..., 2 * W_B:], H_B)
    beta = jax.nn.sigmoid(p[..., B_BETA:B_A].astype(f32)).transpose(0, 2, 1)
    g = (-jnp.exp(A_log.astype(f32))
         * jax.nn.softplus(p[..., B_A:G_MERGE].astype(f32) + dt_bias)).transpose(0, 2, 1)
    hB, S = run_segments(_gdn_step, S0.astype(f32), (qb, kb, vb, beta, g), seg_lens)
    hB = rms_norm(hB.transpose(0, 2, 1, 3)) * b_norm_w
    hB = (hB.reshape(B, L, W_B) * jax.nn.silu(p[..., B_Z:B_BETA].astype(f32))).astype(x.dtype)

    mg = jax.nn.sigmoid(p[..., G_MERGE:])
    y = mg[..., :D_MODEL] * (hA @ w_pa) + mg[..., D_MODEL:] * (hB @ w_pb)
    return y @ w_out, (C, n, m, S, conv_new)


def conv_ffn(x, w_up, conv_w, w_down, buf):
    u = x @ w_up
    u, new_buf = causal_dwconv(u, buf, conv_w)
    h = jax.nn.silu(u[..., :D_FF]) * u[..., D_FF:]
    return h @ w_down, new_buf


def decoder_layer(x, st, lp, seg_lens):
    (w_in, gate_bias, a_norm_w, conv_w, A_log, dt_bias, b_norm_w, w_pa, w_pb, w_out,
     ln1_g, ln1_b, w_up, f_conv_w, w_down, ln2_g, ln2_b) = lp
    C0, n0, m0, S0, gbuf, fbuf = st
    mix, (C, n, m, S, gbuf_new) = token_mixers(x, (C0, n0, m0, S0, gbuf), w_in, gate_bias, a_norm_w,
                                               conv_w, A_log, dt_bias, b_norm_w, w_pa, w_pb, w_out,
                                               seg_lens)
    x = layer_norm(ALPHA * x + mix, ln1_g, ln1_b)
    ff, fbuf_new = conv_ffn(x, w_up, f_conv_w, w_down, fbuf)
    x = layer_norm(ALPHA * x + ff, ln2_g, ln2_b)
    return x, (C, n, m, S, gbuf_new, fbuf_new)


def setup_inputs(seed: int = 0) -> dict:
    key = jax.random.key(seed)
    ks = jax.random.split(key, 32)
    f32 = jnp.float32

    def nrm(k, shape, s):
        return jax.random.normal(k, shape, f32) * s

    dt = jax.random.uniform(ks[14], (DEPTH, H_B), f32, 0.001, 0.1)
    return {
        'x_prompt': nrm(ks[0], (BATCH, SEQ, D_MODEL), 1.0),
        'x_sample': nrm(ks[1], (DEC_BATCH, DEC_SEQ, D_MODEL), 1.0),
        'state_mlstm_C': nrm(ks[2], (DEPTH, DEC_BATCH, H_A, DK_A, DV_A), 0.1),
        'state_mlstm_n': nrm(ks[3], (DEPTH, DEC_BATCH, H_A, DK_A), 0.1),
        'state_mlstm_m': jax.random.uniform(ks[4], (DEPTH, DEC_BATCH, H_A), f32, 0.0, 3.0),
        'state_gdn_S': nrm(ks[5], (DEPTH, DEC_BATCH, H_B, DK_B, DV_B), DK_B ** -0.5),
        'state_gdn_conv': nrm(ks[6], (DEPTH, DEC_BATCH, CONV_B - 1, 3 * W_B), 1.0),
        'state_ffn_conv': nrm(ks[7], (DEPTH, DEC_BATCH, CONV_F - 1, 2 * D_FF), 1.0),
        'meta_tokens': nrm(ks[8], (N_META, D_MODEL), 1.0),
        'ln_emb_g': 1.0 + nrm(ks[9], (D_MODEL,), 0.01),
        'ln_emb_b': nrm(ks[10], (D_MODEL,), 0.01),
        'w_in': nrm(ks[11], (DEPTH, D_MODEL, N_IN), D_MODEL ** -0.5),
        'mlstm_gate_bias': jnp.concatenate([nrm(ks[12], (DEPTH, H_A), 0.1),
                                            3.0 + nrm(ks[13], (DEPTH, H_A), 0.1)], axis=-1),
        'mlstm_norm_w': 1.0 + nrm(ks[15], (DEPTH, W_A), 0.01),
        'gdn_conv_w': nrm(ks[16], (DEPTH, CONV_B, 3 * W_B), CONV_B ** -0.5),
        'gdn_A_log': jnp.log(jax.random.uniform(ks[17], (DEPTH, H_B), f32, 1.0, 16.0)),
        'gdn_dt_bias': jnp.log(jnp.expm1(dt)),
        'gdn_norm_w': 1.0 + nrm(ks[18], (DEPTH, DV_B), 0.01),
        'w_branch_a': nrm(ks[19], (DEPTH, W_A, D_MODEL), W_A ** -0.5),
        'w_branch_b': nrm(ks[20], (DEPTH, W_B, D_MODEL), W_B ** -0.5),
        'w_out': nrm(ks[21], (DEPTH, D_MODEL, D_MODEL), BETA_INIT * D_MODEL ** -0.5),
        'ln1_g': 1.0 + nrm(ks[22], (DEPTH, D_MODEL), 0.01),
        'ln1_b': nrm(ks[23], (DEPTH, D_MODEL), 0.01),
        'w_up': nrm(ks[24], (DEPTH, D_MODEL, 2 * D_FF), D_MODEL ** -0.5),
        'ffn_conv_w': nrm(ks[25], (DEPTH, CONV_F, 2 * D_FF), CONV_F ** -0.5),
        'w_down': nrm(ks[26], (DEPTH, D_FF, D_MODEL), BETA_INIT * D_FF ** -0.5),
        'ln2_g': 1.0 + nrm(ks[27], (DEPTH, D_MODEL), 0.01),
        'ln2_b': nrm(ks[28], (DEPTH, D_MODEL), 0.01),
    }


def reference(x_prompt, x_sample, state_mlstm_C, state_mlstm_n, state_mlstm_m, state_gdn_S,
              state_gdn_conv, state_ffn_conv, meta_tokens, ln_emb_g, ln_emb_b, w_in, mlstm_gate_bias,
              mlstm_norm_w, gdn_conv_w, gdn_A_log, gdn_dt_bias, gdn_norm_w, w_branch_a, w_branch_b,
              w_out, ln1_g, ln1_b, w_up, ffn_conv_w, w_down, ln2_g, ln2_b):
    f32 = jnp.float32
    B = x_prompt.shape[0]
    dt = x_prompt.dtype
    meta = jnp.broadcast_to(meta_tokens.astype(dt), (B, N_META, D_MODEL))
    xp = layer_norm(jnp.concatenate([meta, x_prompt], axis=1), ln_emb_g, ln_emb_b)
    xs = layer_norm(x_sample, ln_emb_g, ln_emb_b)
    prompt_segs = (N_META, x_prompt.shape[1])
    sample_segs = (x_sample.shape[1],)
    p_states = []
    s_states = []
    for l in range(DEPTH):
        lp = (w_in[l], mlstm_gate_bias[l], mlstm_norm_w[l], gdn_conv_w[l], gdn_A_log[l], gdn_dt_bias[l],
              gdn_norm_w[l], w_branch_a[l], w_branch_b[l], w_out[l], ln1_g[l], ln1_b[l], w_up[l],
              ffn_conv_w[l], w_down[l], ln2_g[l], ln2_b[l])
        zero_st = (jnp.zeros((B, H_A, DK_A, DV_A), f32), jnp.zeros((B, H_A, DK_A), f32),
                   jnp.zeros((B, H_A), f32), jnp.zeros((B, H_B, DK_B, DV_B), f32),
                   jnp.zeros((B, CONV_B - 1, 3 * W_B), dt), jnp.zeros((B, CONV_F - 1, 2 * D_FF), dt))
        samp_st = (state_mlstm_C[l], state_mlstm_n[l], state_mlstm_m[l], state_gdn_S[l],
                   state_gdn_conv[l], state_ffn_conv[l])
        xp, st_p = decoder_layer(xp, zero_st, lp, prompt_segs)
        xs, st_s = decoder_layer(xs, samp_st, lp, sample_segs)
        p_states.append(st_p)
        s_states.append(st_s)
    dtypes = (state_mlstm_C.dtype, state_mlstm_n.dtype, state_mlstm_m.dtype, state_gdn_S.dtype,
              state_gdn_conv.dtype, state_ffn_conv.dtype)

    def stack(states, i):
        return jnp.stack([s[i] for s in states], axis=0).astype(dtypes[i])

    y_prompt = xp[:, N_META:]
    y_sample = xs
    return (y_prompt, y_sample,
            stack(p_states, 0), stack(p_states, 1), stack(p_states, 2), stack(p_states, 3),
            stack(p_states, 4), stack(p_states, 5),
            stack(s_states, 0), stack(s_states, 1), stack(s_states, 2), stack(s_states, 3),
            stack(s_states, 4), stack(s_states, 5))
```

```cpp
#include <hip/hip_runtime.h>
#include <hip/hip_cooperative_groups.h>
#include <cstdio>
namespace cg = cooperative_groups;

#ifndef MULTI
#define MULTI 0
#endif

typedef unsigned short bf16_t;
typedef short bf16x8 __attribute__((ext_vector_type(8)));
typedef float f32x4 __attribute__((ext_vector_type(4)));
typedef float f32x2 __attribute__((ext_vector_type(2)));
typedef unsigned u32x2 __attribute__((ext_vector_type(2)));
typedef unsigned u32x4 __attribute__((ext_vector_type(4)));

constexpr int D = 1024, NB = 8, LP = 2064, LPAD = 2080, NS = 128, LS = 4, DEPTH = 2, NMETA = 16, SEQ = 2048;
constexpr int MROWS = NB * LPAD + NS * LS;
constexpr int SROW0 = NB * LPAD;
constexpr int NIN = 6160, NP = 6144, DFF = 2816, NU = 5632;
constexpr int cQ = 0, cK = 512, cV = 1024, cO = 1536, cBQ = 2048, cBK = 2560, cBV = 3072, cZ = 3584, cMG = 4096;
constexpr float ALPHA = 1.4142135623730951f;
constexpr int SPLIT_ROW0 = 64 * 256;
constexpr int NTHREADS = 512;
constexpr int LDS_GEMM = 131072;
constexpr int LDS_BYTES = LDS_GEMM + 256;

constexpr size_t W_IN = (size_t)NP * 1024, W_AB = 2048 * 512, W_OUT = 1024 * 2048, W_UP = (size_t)NU * 1024, W_DN = (size_t)1024 * DFF;
constexpr size_t W_LAYER = W_IN + W_AB + W_OUT + W_UP + W_DN;
constexpr size_t OFF_W = 0;
constexpr size_t OFF_WG = OFF_W + DEPTH * W_LAYER * 2;
constexpr size_t OFF_X = OFF_WG + DEPTH * 16 * 1024 * 4;
constexpr size_t OFF_G = OFF_X + (size_t)MROWS * D * 2;
constexpr size_t OFF_HB = OFF_G + (size_t)MROWS * 16 * 4;
constexpr size_t OFF_P = OFF_HB + (size_t)(MROWS / 32) * 2 * NU * 2;
constexpr size_t OFF_GH = OFF_P + (size_t)MROWS * NP * 2;
constexpr size_t OFF_REC = OFF_GH + (size_t)(MROWS / 32) * 3 * 1536 * 2;
constexpr size_t OFF_BAR = OFF_REC + (size_t)MROWS * 4 * 16 * 4;
constexpr size_t OFF_TB = OFF_BAR + 16384;
constexpr size_t WS_END = OFF_TB + (size_t)(MROWS / 32) * 4 * 3 * 1024 * 2;

constexpr size_t o_yp = 0;
constexpr size_t o_ys = o_yp + (size_t)NB * SEQ * D;
constexpr size_t o_pC = o_ys + (size_t)NS * LS * D;
constexpr size_t o_pn = o_pC + (size_t)DEPTH * NB * 4 * 128 * 128;
constexpr size_t o_pm = o_pn + (size_t)DEPTH * NB * 4 * 128;
constexpr size_t o_pS = o_pm + (size_t)DEPTH * NB * 4;
constexpr size_t o_pgc = o_pS + (size_t)DEPTH * NB * 4 * 128 * 128;
constexpr size_t o_pfc = o_pgc + (size_t)DEPTH * NB * 3 * 1536;
constexpr size_t o_sC = o_pfc + (size_t)DEPTH * NB * 2 * NU;
constexpr size_t o_sn = o_sC + (size_t)DEPTH * NS * 4 * 128 * 128;
constexpr size_t o_sm = o_sn + (size_t)DEPTH * NS * 4 * 128;
constexpr size_t o_sS = o_sm + (size_t)DEPTH * NS * 4;
constexpr size_t o_sgc = o_sS + (size_t)DEPTH * NS * 4 * 128 * 128;
constexpr size_t o_sfc = o_sgc + (size_t)DEPTH * NS * 3 * 1536;
constexpr size_t o_end = o_sfc + (size_t)DEPTH * NS * 2 * NU;

struct Params {
    const float* x_prompt; const float* x_sample; const float* st_C; const float* st_n; const float* st_m; const float* st_S;
    const float* st_gconv; const float* st_fconv; const float* meta; const float* ln_emb_g; const float* ln_emb_b; const float* w_in;
    const float* gate_bias; const float* a_norm_w; const float* gconv_w; const float* A_log; const float* dt_bias; const float* b_norm_w;
    const float* w_pa; const float* w_pb; const float* w_out; const float* ln1_g; const float* ln1_b; const float* w_up;
    const float* fconv_w; const float* w_down; const float* ln2_g; const float* ln2_b;
    float* out; unsigned char* ws;
    int ph_lo, ph_hi;
    int wv, pad_;
};

__device__ __forceinline__ int opaque_tid(int wv) { int lane; asm volatile("v_mbcnt_lo_u32_b32 %0, -1, 0\n\tv_mbcnt_hi_u32_b32 %0, -1, %0" : "=v"(lane)); return wv * 64 + lane; }
__device__ __forceinline__ float bflo(unsigned u) { return __uint_as_float(u << 16); }
__device__ __forceinline__ float bfhi(unsigned u) { return __uint_as_float(u & 0xffff0000u); }
__device__ __forceinline__ unsigned pk2(float lo, float hi) { unsigned r; asm("v_cvt_pk_bf16_f32 %0, %1, %2" : "=v"(r) : "v"(lo), "v"(hi)); return r; }
template <int CTRL> __device__ __forceinline__ float dppf(float v) { return __int_as_float(__builtin_amdgcn_update_dpp(0, __float_as_int(v), CTRL, 0xf, 0xf, true)); }
__device__ __forceinline__ float red8(float v) { v += dppf<0xB1>(v); v += dppf<0x4E>(v); v += dppf<0x141>(v); return v; }
__device__ __forceinline__ float red16(float v) { v = red8(v); v += dppf<0x140>(v); return v; }
__device__ __forceinline__ float rdl(float v, int l) { return __int_as_float(__builtin_amdgcn_readlane(__float_as_int(v), l)); }
__device__ __forceinline__ float rdl_pin(float v, int l) { float r_; asm volatile("v_readlane_b32 %0, %1, %2" : "=s"(r_) : "v"(v), "s"(l)); return r_; }
__device__ __forceinline__ float red64(float v) { v = red16(v); return (rdl(v, 0) + rdl(v, 16)) + (rdl(v, 32) + rdl(v, 48)); }
__device__ __forceinline__ float sigmoidf_(float x) { return __builtin_amdgcn_rcpf(1.f + __expf(-x)); }
__device__ __forceinline__ u32x4 pack8(const float* y) { u32x4 o; o.x = pk2(y[0], y[1]); o.y = pk2(y[2], y[3]); o.z = pk2(y[4], y[5]); o.w = pk2(y[6], y[7]); return o; }
__device__ __forceinline__ void unpack8(u32x4 a, float* x) { x[0] = bflo(a.x); x[1] = bfhi(a.x); x[2] = bflo(a.y); x[3] = bfhi(a.y); x[4] = bflo(a.z); x[5] = bfhi(a.z); x[6] = bflo(a.w); x[7] = bfhi(a.w); }


#define XB_TMO      128
#define XB_XCNT(j)  (256  + 64 * (j))
#define XB_XSUB(j)  (1280 + 64 * (j))
#define XB_XGEN(j)  (2304 + 64 * (j))
#define XB_TOP      3328
#define XB_TOPGEN   3392
#define XCD_BAR_WORDS 3456
#define XB_SPIN_CAP (1u << 18)
#define LAS __attribute__((address_space(3)))
__device__ __forceinline__ unsigned xb_ld(unsigned* p)              { return __hip_atomic_load(p, __ATOMIC_RELAXED, __HIP_MEMORY_SCOPE_AGENT); }
__device__ __forceinline__ unsigned xb_add(unsigned* p, unsigned v) { return __hip_atomic_fetch_add(p, v, __ATOMIC_RELAXED, __HIP_MEMORY_SCOPE_AGENT); }
__device__ __forceinline__ unsigned xb_xcc_id() { return (unsigned)__builtin_amdgcn_s_getreg((3 << 11) | 20) & 0xFu; }
#define XB_SPIN(cond, bar) do { unsigned _sp = 0; while (cond) { __builtin_amdgcn_s_sleep(1); \
    if ((++_sp & 255u) == 0u) { if (xb_ld(&(bar)[XB_TMO])) break; if (_sp > XB_SPIN_CAP) { atomicAdd(&(bar)[XB_TMO], 1u); break; } } } } while (0)
__device__ __forceinline__ void xcd_barrier_complete(unsigned* bar, unsigned x, unsigned& nloc, unsigned& nx) {
    const unsigned G = gridDim.x;
    unsigned sum, cnt, mine, sp = 0u;
    for (;;) {
        sum = 0u; cnt = 0u; mine = 0u;
#pragma unroll
        for (unsigned j = 0; j < 16; ++j) { const unsigned c = xb_ld(&bar[XB_XCNT(j)]); sum += c; cnt += (c > 0u) ? 1u : 0u; mine = (j == x) ? c : mine; }
        if (sum == G) break;
        __builtin_amdgcn_s_sleep(1);
        if ((++sp & 255u) == 0u) { if (xb_ld(&bar[XB_TMO])) break; if (sp > XB_SPIN_CAP) { atomicAdd(&bar[XB_TMO], 1u); break; } }
    }
    nloc = mine > 0u ? mine : 1u; nx = cnt > 0u ? cnt : 1u;
}
__device__ __forceinline__ void xcd_barrier(unsigned* bar, unsigned x, volatile LAS unsigned* st, int wv) {
    asm volatile("s_waitcnt vmcnt(0)" ::: "memory");
    __syncthreads();
    if (opaque_tid(wv) == 0) {
        __builtin_amdgcn_s_waitcnt(0);
        unsigned nloc = st[0], nx = st[1];
        if (nloc == 0u) { xcd_barrier_complete(bar, x, nloc, nx); st[0] = nloc; st[1] = nx; }
        const unsigned old = xb_add(&bar[XB_XSUB(x)], 1u);
        const unsigned gen = old / nloc;
        if (old + 1u == (gen + 1u) * nloc) {
            __builtin_amdgcn_fence(__ATOMIC_RELEASE, "agent");
            asm volatile("s_waitcnt vmcnt(0)" ::: "memory");
            const unsigned og = xb_add(&bar[XB_TOP], 1u);
            const unsigned tg = og / nx;
            if (og + 1u == (tg + 1u) * nx) xb_add(&bar[XB_TOPGEN], 1u);
            else XB_SPIN(xb_ld(&bar[XB_TOPGEN]) == tg, bar);
            __builtin_amdgcn_fence(__ATOMIC_ACQUIRE, "agent");
            xb_add(&bar[XB_XGEN(x)], 1u);
            asm volatile("s_waitcnt vmcnt(0)" ::: "memory");
        } else {
            XB_SPIN(xb_ld(&bar[XB_XGEN(x)]) == gen, bar);
            __builtin_amdgcn_fence(__ATOMIC_ACQUIRE, "agent");
            asm volatile("s_waitcnt vmcnt(0)" ::: "memory");
        }
    }
    __syncthreads();
}

struct TJob { const float* src; int ldw; int K; int N; bf16_t* dst; int ldt; };
__device__ __forceinline__ void transpose_item(const TJob& jb, int item, float* scr, int lane) {
    const int nblk = jb.N / 32, kb = item / nblk, nb = item % nblk, k0 = 64 * kb, n0 = 32 * nb;
#pragma unroll 8
    for (int i = 0; i < 32; ++i) { const int kk = 2 * i + (lane >> 5); scr[kk * 33 + (lane & 31)] = jb.src[(size_t)(k0 + kk) * jb.ldw + n0 + (lane & 31)]; }
    __builtin_amdgcn_s_waitcnt(0xc07f); asm volatile("" ::: "memory");
    const int c = lane & 7;
#pragma unroll
    for (int j = 0; j < 4; ++j) { const int n = (lane >> 3) + 8 * j; const float* s = scr + (8 * c) * 33 + n;
        u32x4 o; o.x = pk2(s[0 * 33], s[1 * 33]); o.y = pk2(s[2 * 33], s[3 * 33]); o.z = pk2(s[4 * 33], s[5 * 33]); o.w = pk2(s[6 * 33], s[7 * 33]);
        *(u32x4*)(jb.dst + (size_t)(n0 + n) * jb.ldt + k0 + 8 * c) = o; }
    __builtin_amdgcn_s_waitcnt(0xc07f); asm volatile("" ::: "memory");
}
__device__ __forceinline__ bf16_t* wl(const Params& p, int l) { return (bf16_t*)(p.ws + OFF_W) + (size_t)l * W_LAYER; }
__device__ __forceinline__ bf16_t* w_inT(const Params& p, int l) { return wl(p, l); }
__device__ __forceinline__ bf16_t* w_abT(const Params& p, int l) { return wl(p, l) + W_IN; }
__device__ __forceinline__ bf16_t* w_outT(const Params& p, int l) { return wl(p, l) + W_IN + W_AB; }
__device__ __forceinline__ bf16_t* w_upT(const Params& p, int l) { return wl(p, l) + W_IN + W_AB + W_OUT; }
__device__ __forceinline__ bf16_t* w_dnT(const Params& p, int l) { return wl(p, l) + W_IN + W_AB + W_OUT + W_UP; }

__device__ __forceinline__ void phase_weights(const Params& p, float* lds) {
    const int tid = opaque_tid(p.wv); const int wave = tid >> 6, lane = tid & 63;
    float* scr = lds + wave * (64 * 33);
    const int gw = blockIdx.x * 8 + wave, NGW = gridDim.x * 8;
    constexpr int I0 = 16 * 64, I1 = 16 * 64, I2 = 16 * 64, I3 = 8 * 32, I4 = 8 * 32, I5 = 16 * 32, I6 = 16 * 32, I7 = 16 * (NU / 32), I8 = (DFF / 64) * 32;
    constexpr int IL = I0 + I1 + I2 + I3 + I4 + I5 + I6 + I7 + I8;
    for (int it = gw; it < DEPTH * IL; it += NGW) {
        const int l = it / IL; int r = it % IL;
        TJob jb;
        const float* win = p.w_in + (size_t)l * 1024 * NIN;
        if (r < I0) { jb = {win, NIN, 1024, 2048, w_inT(p, l), 1024}; }
        else if ((r -= I0) < I1) { jb = {win + 2056, NIN, 1024, 2048, w_inT(p, l) + (size_t)2048 * 1024, 1024}; }
        else if ((r -= I1) < I2) { jb = {win + 4112, NIN, 1024, 2048, w_inT(p, l) + (size_t)4096 * 1024, 1024}; }
        else if ((r -= I2) < I3) { jb = {p.w_pa + (size_t)l * 512 * 1024, 1024, 512, 1024, w_abT(p, l), 512}; }
        else if ((r -= I3) < I4) { jb = {p.w_pb + (size_t)l * 512 * 1024, 1024, 512, 1024, w_abT(p, l) + (size_t)1024 * 512, 512}; }
        else if ((r -= I4) < I5) { jb = {p.w_out + (size_t)l * 1024 * 1024, 1024, 1024, 1024, w_outT(p, l), 2048}; }
        else if ((r -= I5) < I6) { jb = {p.w_out + (size_t)l * 1024 * 1024, 1024, 1024, 1024, w_outT(p, l) + 1024, 2048}; }
        else if ((r -= I6) < I7) { jb = {p.w_up + (size_t)l * 1024 * NU, NU, 1024, NU, w_upT(p, l), 1024}; }
        else { r -= I7; jb = {p.w_down + (size_t)l * DFF * 1024, 1024, DFF, 1024, w_dnT(p, l), DFF}; }
        transpose_item(jb, r, scr, lane);
    }
    float* wg = (float*)(p.ws + OFF_WG);
    for (int i = blockIdx.x * NTHREADS + tid; i < DEPTH * 16 * 1024; i += gridDim.x * NTHREADS) {
        const int l = i >> 14, g = (i >> 10) & 15, k = i & 1023;
        const int col = g < 8 ? 2048 + g : 4104 + (g - 8);
        wg[i] = p.w_in[((size_t)l * 1024 + k) * NIN + col];
    }
}

__device__ __forceinline__ void phase_ln(const Params& p, int mode, const bf16_t* src, int ldsrc, const float* gam, const float* bet,
                                         int gate_layer  , bool final_out) {
    const int tid = opaque_tid(p.wv); const int wave = tid >> 6, lane = tid & 63;
    bf16_t* X = (bf16_t*)(p.ws + OFF_X);
    float* G = (float*)(p.ws + OFF_G);
    const float* wg = (const float*)(p.ws + OFF_WG) + (size_t)(gate_layer < 0 ? 0 : gate_layer) * 16 * 1024;
    for (int row = blockIdx.x * 8 + wave; row < MROWS; row += gridDim.x * 8) {
        int b = 0, t = 0; bool samp = row >= SROW0;
        if (!samp) { b = row / LPAD; t = row - b * LPAD; } else { b = (row - SROW0) >> 2; t = row & 3; }
        const bool valid = samp || t < LP;
        bf16_t* xo = X + (size_t)row * D;
        if (!valid) { if (mode == 0) {
#pragma unroll
                for (int j = 0; j < 4; ++j) *(u32x2*)(xo + 256 * j + lane * 4) = (u32x2){0u, 0u}; }
            continue; }
        f32x4 v[4];
        if (mode == 0) {
            const float* s = samp ? p.x_sample + ((size_t)b * LS + t) * D : (t < NMETA ? p.meta + (size_t)t * D : p.x_prompt + ((size_t)b * SEQ + (t - NMETA)) * D);
#pragma unroll
            for (int j = 0; j < 4; ++j) v[j] = *(const f32x4*)(s + 256 * j + lane * 4);
        } else {
            const bf16_t* s = src + (size_t)row * ldsrc;
#pragma unroll
            for (int j = 0; j < 4; ++j) { u32x2 u = *(const u32x2*)(s + 256 * j + lane * 4); v[j] = (f32x4){bflo(u.x), bfhi(u.x), bflo(u.y), bfhi(u.y)}; }
            if (row >= SPLIT_ROW0) { const bf16_t* sp = (const bf16_t*)(p.ws + OFF_GH) + (size_t)(row - SPLIT_ROW0) * D;
#pragma unroll
                for (int q = 0; q < 3; ++q)
#pragma unroll
                    for (int j = 0; j < 4; ++j) { const u32x2 u = *(const u32x2*)(sp + (size_t)q * (MROWS - SPLIT_ROW0) * D + 256 * j + lane * 4); v[j] += (f32x4){bflo(u.x), bfhi(u.x), bflo(u.y), bfhi(u.y)}; } }
        }
        float sum = 0.f;
#pragma unroll
        for (int j = 0; j < 4; ++j) sum += (v[j][0] + v[j][1]) + (v[j][2] + v[j][3]);
        const float mean = red64(sum) * (1.f / D);
        float s2 = 0.f;
#pragma unroll
        for (int j = 0; j < 4; ++j) { v[j] = v[j] - mean; s2 += (v[j][0] * v[j][0] + v[j][1] * v[j][1]) + (v[j][2] * v[j][2] + v[j][3] * v[j][3]); }
        const float rstd = rsqrtf(red64(s2) * (1.f / D) + 1e-5f);
#pragma unroll
        for (int j = 0; j < 4; ++j) { const f32x4 g4 = *(const f32x4*)(gam + 256 * j + lane * 4), b4 = *(const f32x4*)(bet + 256 * j + lane * 4);
            v[j] = v[j] * rstd * g4 + b4;
            *(u32x2*)(xo + 256 * j + lane * 4) = (u32x2){pk2(v[j][0], v[j][1]), pk2(v[j][2], v[j][3])}; }
        if (final_out) {
            float* o = nullptr;
            if (samp) o = p.out + o_ys + ((size_t)b * LS + t) * D; else if (t >= NMETA) o = p.out + o_yp + ((size_t)b * SEQ + (t - NMETA)) * D;
            if (o) {
#pragma unroll
                for (int j = 0; j < 4; ++j) *(f32x4*)(o + 256 * j + lane * 4) = v[j]; }
        }
        if (gate_layer >= 0) {
            float mine = 0.f;
#pragma unroll 2
            for (int g = 0; g < 16; ++g) {
                float a = 0.f;
#pragma unroll
                for (int j = 0; j < 4; ++j) { const f32x4 w4 = *(const f32x4*)(wg + g * 1024 + 256 * j + lane * 4); a += (v[j][0] * w4[0] + v[j][1] * w4[1]) + (v[j][2] * w4[2] + v[j][3] * w4[3]); }
                a = red64(a);
                if (lane == g) mine = a;
            }
            if (lane < 16) G[(size_t)row * 16 + lane] = mine;
        }
    }
}

constexpr int BM = 256, BK = 64, HALF = 128, HT = HALF * BK, NXCD = 8, WGM = 8;
__device__ __forceinline__ int lds_byte(int r, int c) { int st = (r >> 4) * 2 + (c >> 5), rr = r & 15, cc = c & 31, ob = rr * 64 + cc * 2; return st * 1024 + (ob ^ (((ob >> 9) & 1) << 5)); }
__device__ __forceinline__ void stage_rc(int b, int& R, int& C) { int st = b / 1024, sb = b % 1024, swz = sb ^ (((sb >> 9) & 1) << 5); R = (st >> 1) * 16 + swz / 64; C = (st & 1) * 32 + (swz % 64) / 2; }

struct GemmArgs { const bf16_t* A; const bf16_t* A2; int a2_from_pn; int lda; const bf16_t* Bt; int M, N, K; int splitk; };

template <class Epi>
__device__ __forceinline__ void gemm_phase(const GemmArgs g, const Epi& epi, int wv) {
    extern __shared__ __attribute__((aligned(16))) unsigned char smem_raw[];
    bf16_t* shm = (bf16_t*)smem_raw;
#define SA(b, h) (shm + ((b) * 2 + (h)) * HT)
#define SB(b, h) (shm + (4 + (b) * 2 + (h)) * HT)
#define STAGE_A(P_, br, kt) do { const char* _gb = (const char*)(A + (size_t)(br) * lda + (size_t)((kt) + kofs) * BK); \
    unsigned _o0 = offA0, _o1 = offA1; asm volatile("" : "+v"(_o0), "+v"(_o1)); \
    __builtin_amdgcn_global_load_lds((const unsigned*)(_gb + _o0), (unsigned*)((char*)(P_) + tid * 16), 16, 0, 0); \
    __builtin_amdgcn_global_load_lds((const unsigned*)(_gb + _o1), (unsigned*)((char*)(P_) + tid * 16 + 8192), 16, 0, 0); } while (0)
#define STAGE_B(P_, bc, kt) do { const char* _gb = (const char*)(Bt + (size_t)(bc) * K + (size_t)((kt) + kofs) * BK); \
    unsigned _o0 = offB0, _o1 = offB1; asm volatile("" : "+v"(_o0), "+v"(_o1)); \
    __builtin_amdgcn_global_load_lds((const unsigned*)(_gb + _o0), (unsigned*)((char*)(P_) + tid * 16), 16, 0, 0); \
    __builtin_amdgcn_global_load_lds((const unsigned*)(_gb + _o1), (unsigned*)((char*)(P_) + tid * 16 + 8192), 16, 0, 0); } while (0)
#define LDA(dst, b, h) for (int m = 0; m < 4; ++m) for (int k = 0; k < 2; ++k) \
    dst[m][k] = *reinterpret_cast<const bf16x8*>((char*)SA(b, h) + lds_byte(wr * 64 + m * 16 + fr, k * 32 + fq * 8))
#define LDB(dst, b, h) for (int n = 0; n < 2; ++n) for (int k = 0; k < 2; ++k) \
    dst[n][k] = *reinterpret_cast<const bf16x8*>((char*)SB(b, h) + lds_byte(wc * 32 + n * 16 + fr, k * 32 + fq * 8))
#define MMA(ai, bj, At_, Bt_) do { __builtin_amdgcn_s_setprio(1); \
    for (int m = 0; m < 4; ++m) for (int n = 0; n < 2; ++n) for (int k = 0; k < 2; ++k) \
      acc[ai][bj][m][n] = __builtin_amdgcn_mfma_f32_16x16x32_bf16(Bt_[n][k], At_[m][k], acc[ai][bj][m][n], 0, 0, 0); \
    __builtin_amdgcn_s_setprio(0); } while (0)
#define WAIT_V(n) asm volatile("s_waitcnt vmcnt(" #n ")" ::: "memory")
#define WAIT_L(n) asm volatile("s_waitcnt lgkmcnt(" #n ")" ::: "memory")
#define BAR __builtin_amdgcn_s_barrier()
#define SCHED __builtin_amdgcn_sched_barrier(0)
    const int lda = g.lda, K = g.K; const bf16_t* Bt = g.Bt;
    const int nMall = g.M / BM, nN = g.N / BM, nM = g.splitk ? 64 : nMall, nwg = nM * nN, nunits = nwg + (nMall - nM) * nN * 4;
    const int tid = opaque_tid(wv);
    const int wid = tid >> 6, lane = tid & 63, wr = wid >> 2, wc = wid & 3, fr = lane & 15, fq = lane >> 4;
    const int ntK = K / BK;
    unsigned offA0, offA1, offB0, offB1;
    { int r0, c0, r1, c1; stage_rc(tid * 16, r0, c0); stage_rc(tid * 16 + 8192, r1, c1);
      offA0 = (unsigned)(r0 * lda + c0) * 2u; offA1 = (unsigned)(r1 * lda + c1) * 2u; offB0 = (unsigned)(r0 * K + c0) * 2u; offB1 = (unsigned)(r1 * K + c1) * 2u; }
    for (int Lt = blockIdx.x; Lt < nunits; Lt += gridDim.x) {
        int pm, pn, kofs = 0, nt = ntK, split = 0;
        if (Lt < nwg) {
            int wgid = Lt;
            { int q = nwg / NXCD, r = nwg % NXCD, xcd = wgid % NXCD, off = wgid / NXCD; wgid = (xcd < r ? xcd * (q + 1) : r * (q + 1) + (xcd - r) * q) + off; }
            const int nig = WGM * nN, gid = wgid / nig, fm = gid * WGM, gsz = min(nM - fm, WGM);
            pm = fm + ((wgid % nig) % gsz); pn = (wgid % nig) / gsz;
        } else {
            const int u = Lt - nwg, tl = u >> 2; split = u & 3; pm = nM + tl / nN; pn = tl % nN;
            const int q4 = ntK >> 2;
            if (q4 & 1) { nt = split < 2 ? q4 + 1 : q4 - 1; kofs = split < 2 ? split * (q4 + 1) : 2 * (q4 + 1) + (split - 2) * (q4 - 1); } else { nt = q4; kofs = split * q4; }
        }
        const int brow = pm * BM, bcol = pn * BM;
        const bf16_t* A = (pn >= g.a2_from_pn) ? g.A2 : g.A;
        f32x4 acc[2][2][4][2] = {};
        bf16x8 At[4][2], B0[2][2], B1[2][2];
        STAGE_B(SB(0, 0), bcol, 0); STAGE_A(SA(0, 0), brow, 0);
        STAGE_B(SB(0, 1), bcol + HALF, 0); STAGE_A(SA(0, 1), brow + HALF, 0);
        if (wr == 1) BAR;
        WAIT_V(4); BAR;
        STAGE_B(SB(1, 0), bcol, 1); STAGE_A(SA(1, 0), brow, 1); STAGE_B(SB(1, 1), bcol + HALF, 1);
        WAIT_V(6); BAR;
        for (int t = 0; t < nt - 2; t += 2) {
            LDB(B0, 0, 0); SCHED; LDA(At, 0, 0); STAGE_A(SA(1, 1), brow + HALF, t + 1);
            WAIT_L(8); BAR; WAIT_L(0); MMA(0, 0, At, B0); BAR; SCHED;
            LDB(B1, 0, 1); STAGE_B(SB(0, 0), bcol, t + 2);
            BAR; WAIT_L(0); MMA(0, 1, At, B1); BAR;
            LDA(At, 0, 1); STAGE_A(SA(0, 0), brow, t + 2);
            BAR; WAIT_L(0); MMA(1, 0, At, B0); BAR; SCHED;
            STAGE_B(SB(0, 1), bcol + HALF, t + 2);
            WAIT_V(6); BAR; MMA(1, 1, At, B1); BAR;
            LDB(B0, 1, 0); SCHED; LDA(At, 1, 0); STAGE_A(SA(0, 1), brow + HALF, t + 2);
            WAIT_L(8); BAR; WAIT_L(0); MMA(0, 0, At, B0); BAR; SCHED;
            LDB(B1, 1, 1); STAGE_B(SB(1, 0), bcol, t + 3);
            BAR; WAIT_L(0); MMA(0, 1, At, B1); BAR;
            LDA(At, 1, 1); STAGE_A(SA(1, 0), brow, t + 3);
            BAR; WAIT_L(0); MMA(1, 0, At, B0); BAR; SCHED;
            STAGE_B(SB(1, 1), bcol + HALF, t + 3);
            WAIT_V(6); BAR; MMA(1, 1, At, B1); BAR;
        }
        { LDB(B0, 0, 0); LDA(At, 0, 0); STAGE_A(SA(1, 1), brow + HALF, nt - 1);
          BAR; WAIT_L(0); MMA(0, 0, At, B0); BAR;
          LDB(B1, 0, 1); BAR; WAIT_L(0); MMA(0, 1, At, B1); BAR;
          LDA(At, 0, 1); WAIT_V(4); BAR; WAIT_L(0); MMA(1, 0, At, B0); MMA(1, 1, At, B1); BAR; }
        { LDB(B0, 1, 0); LDA(At, 1, 0); WAIT_V(2); BAR; WAIT_L(0); MMA(0, 0, At, B0); BAR;
          LDB(B1, 1, 1); WAIT_V(0); BAR; WAIT_L(0); MMA(0, 1, At, B1); BAR;
          LDA(At, 1, 1); BAR; WAIT_L(0); MMA(1, 0, At, B0); MMA(1, 1, At, B1); BAR; }
        if (wr == 0) BAR;
        int erow = brow + wr * 64 + fr, ecol = bcol + wc * 32 + fq * 4;
        asm volatile("" : "+v"(erow), "+v"(ecol));
#pragma unroll
        for (int ai = 0; ai < 2; ++ai)
#pragma unroll
            for (int m = 0; m < 4; ++m) {
                const int row = erow + ai * HALF + m * 16;
#pragma unroll
                for (int bj = 0; bj < 2; ++bj)
#pragma unroll
                    for (int n = 0; n < 2; ++n) epi(row, ecol + bj * HALF + n * 16, acc[ai][bj][m][n], split);
                if (m & 1) SCHED;
            }
        __syncthreads();
    }
#undef SA
#undef SB
}

struct EpiP {
    bf16_t* P; bf16_t* GH; float* out; int l;
    __device__ __forceinline__ void operator()(int row, int col, f32x4 v, int split) const {
        *(u32x2*)(P + (size_t)row * NP + col) = (u32x2){pk2(v[0], v[1]), pk2(v[2], v[3])};
        if (col >= cBQ && col < cZ) {
            const int c = col - cBQ;
            if ((row & 31) >= 29) *(u32x2*)(GH + ((size_t)(row >> 5) * 3 + ((row & 31) - 29)) * 1536 + c) = (u32x2){pk2(v[0], v[1]), pk2(v[2], v[3])};
            if (row < SROW0) { const int b = row / LPAD, t = row - b * LPAD; if (t >= LP - 3 && t < LP) *(f32x4*)(out + o_pgc + ((size_t)(l * NB + b) * 3 + (t - (LP - 3))) * 1536 + c) = v; }
            else { const int s = (row - SROW0) >> 2, t = row & 3; if (t >= 1) *(f32x4*)(out + o_sgc + ((size_t)(l * NS + s) * 3 + (t - 1)) * 1536 + c) = v; }
        }
    }
};
struct EpiMerge {
    bf16_t* P;
    __device__ __forceinline__ void operator()(int row, int col, f32x4 v, int split) const {
        u32x2* ptr = (u32x2*)(P + (size_t)row * NP + cMG + col); const u32x2 gm = *ptr;
        v[0] *= sigmoidf_(bflo(gm.x)); v[1] *= sigmoidf_(bfhi(gm.x)); v[2] *= sigmoidf_(bflo(gm.y)); v[3] *= sigmoidf_(bfhi(gm.y));
        *ptr = (u32x2){pk2(v[0], v[1]), pk2(v[2], v[3])};
    }
};
struct EpiRes {
    const bf16_t* X; bf16_t* O; int ldo; int ocol0; bf16_t* SCR;
    __device__ __forceinline__ void operator()(int row, int col, f32x4 v, int split) const {
        if (split == 0) {
            const u32x2 x = *(const u32x2*)(X + (size_t)row * D + col);
            v[0] += ALPHA * bflo(x.x); v[1] += ALPHA * bfhi(x.x); v[2] += ALPHA * bflo(x.y); v[3] += ALPHA * bfhi(x.y);
            *(u32x2*)(O + (size_t)row * ldo + ocol0 + col) = (u32x2){pk2(v[0], v[1]), pk2(v[2], v[3])};
        } else *(u32x2*)(SCR + ((size_t)(split - 1) * (MROWS - SPLIT_ROW0) + (row - SPLIT_ROW0)) * D + col) = (u32x2){pk2(v[0], v[1]), pk2(v[2], v[3])};
    }
};
struct EpiUp {
    bf16_t* U; bf16_t* HB; float* out; int l;
    __device__ __forceinline__ void operator()(int row, int col, f32x4 v, int split) const {
        const u32x2 o = (u32x2){pk2(v[0], v[1]), pk2(v[2], v[3])};
        *(u32x2*)(U + (size_t)row * NU + col) = o;
        if ((row & 31) >= 30) *(u32x2*)(HB + ((size_t)(row >> 5) * 2 + (row & 1)) * NU + col) = o;
        if (row < SROW0) { const int b = row / LPAD, t = row - b * LPAD; if (t >= LP - 2 && t < LP) *(f32x4*)(out + o_pfc + ((size_t)(l * NB + b) * 2 + (t - (LP - 2))) * NU + col) = v; }
        else { const int s = (row - SROW0) >> 2, t = row & 3; if (t >= 2) *(f32x4*)(out + o_sfc + ((size_t)(l * NS + s) * 2 + (t - 2)) * NU + col) = v; }
    }
};

constexpr int SBUF = 32 * 128 * 2 + 32 * 32 + 32 * 16;
__device__ __forceinline__ float* QB(float* lds, int b) { return lds + b * SBUF; }
__device__ __forceinline__ float* KB(float* lds, int b) { return lds + b * SBUF + 4096; }
__device__ __forceinline__ float* VB(float* lds, int b) { return lds + b * SBUF + 8192; }
__device__ __forceinline__ float* SCB(float* lds, int b) { return lds + b * SBUF + 9216; }
__device__ __forceinline__ float* OB(float* lds, int b) { return lds + 2 * SBUF + b * 1024; }

__device__ __forceinline__ void store_out_blk(bf16_t* P, int row0, int jb, int L, int pcol, const float* ob, int ptid) {
    const int tt = ptid >> 3, g = ptid & 7, t0 = jb * 32;
    if (t0 + tt < L) { const f32x4 v = *(const f32x4*)(ob + tt * 32 + g * 4);
        *(u32x2*)(P + (size_t)(row0 + t0 + tt) * NP + pcol + g * 4) = (u32x2){pk2(v[0], v[1]), pk2(v[2], v[3])}; }
}
__device__ __forceinline__ f32x2 lo2(f32x4 v) { return __builtin_shufflevector(v, v, 0, 1); }
__device__ __forceinline__ f32x2 hi2(f32x4 v) { return __builtin_shufflevector(v, v, 2, 3); }
__device__ __forceinline__ f32x2 bc2(float x) { return (f32x2){x, x}; }
__device__ __forceinline__ float dot16(const f32x4* a, const float* kp) {
    float s = 0.f;
#pragma unroll
    for (int i = 0; i < 4; ++i) { const f32x4 b = *(const f32x4*)(kp + 4 * i); s += (a[i][0] * b[0] + a[i][1] * b[1]) + (a[i][2] * b[2] + a[i][3] * b[3]); }
    return s;
}

struct StageRegs { f32x4 &q0, &q1, &k0, &k1, &v, &r0, &x0, &x1; };
__device__ __forceinline__ f32x4 asf(u32x4 u) { return __builtin_bit_cast(f32x4, u); }
__device__ __forceinline__ u32x4 asu(f32x4 f) { return __builtin_bit_cast(u32x4, f); }
#define BARRIER_LDS() asm volatile("s_waitcnt lgkmcnt(0)\n\ts_barrier" ::: "memory")
__device__ __forceinline__ void issue_mlstm(const Params& p, int h, int qtr, int row0, int L, int jb, int ptid, StageRegs& r) {
    const bf16_t* P = (const bf16_t*)(p.ws + OFF_P); const float* G = (const float*)(p.ws + OFF_G);
    const int tt = ptid >> 3, g = ptid & 7, t0 = jb * 32;
    if (t0 + tt >= L) return;
    const int row = row0 + t0 + tt;
    const bf16_t* prow = P + (size_t)row * NP;
    r.q0 = asf(*(const u32x4*)(prow + cQ + h * 128 + g * 16)); r.q1 = asf(*(const u32x4*)(prow + cQ + h * 128 + g * 16 + 8));
    r.k0 = asf(*(const u32x4*)(prow + cK + h * 128 + g * 16)); r.k1 = asf(*(const u32x4*)(prow + cK + h * 128 + g * 16 + 8));
    { const u32x2 vv_ = *(const u32x2*)(prow + cV + h * 128 + qtr * 32 + g * 4); r.v = asf((u32x4){vv_.x, vv_.y, 0u, 0u}); }
    if (g == 0) { const float* gr = G + (size_t)row * 16; r.r0 = (f32x4){gr[h], gr[4 + h], 0.f, 0.f}; }
}
__device__ __forceinline__ void commit_mlstm(const Params& p, int l, int h, int L, int jb, float* lds, int ptid, const StageRegs& r) {
    const int tt = ptid >> 3, g = ptid & 7, t0 = jb * 32, b = jb & 1;
    if (t0 + tt >= L) return;
    float x[16]; f32x4 qs[4];
    unpack8(asu(r.q0), x); unpack8(asu(r.q1), x + 8);
    float* qd = QB(lds, b) + tt * 128 + g * 16;
#pragma unroll
    for (int i = 0; i < 4; ++i) { qs[i] = (f32x4){x[4 * i], x[4 * i + 1], x[4 * i + 2], x[4 * i + 3]} * 0.08838834764831845f; *(f32x4*)(qd + 4 * i) = qs[i]; }
    unpack8(asu(r.k0), x); unpack8(asu(r.k1), x + 8);
    float* kd = KB(lds, b) + tt * 128 + g * 16;
#pragma unroll
    for (int i = 0; i < 4; ++i) *(f32x4*)(kd + 4 * i) = (f32x4){x[4 * i], x[4 * i + 1], x[4 * i + 2], x[4 * i + 3]};
    *(f32x4*)(VB(lds, b) + tt * 32 + g * 4) = (f32x4){bflo(asu(r.v).x), bfhi(asu(r.v).x), bflo(asu(r.v).y), bfhi(asu(r.v).y)};
    const float* kmb = KB(lds, b) + (tt & ~3) * 128 + g * 16;
    f32x4 qk;
#pragma unroll
    for (int j = 0; j < 4; ++j) qk[j] = red8(dot16(qs, kmb + j * 128));
    if (g == 0) {
        const float ig = r.r0[0] + p.gate_bias[l * 8 + h], f = r.r0[1] + p.gate_bias[l * 8 + 4 + h];
        const float lf = fminf(f, 0.f) - log1pf(__expf(-fabsf(f)));
        float* sc = SCB(lds, b) + tt * 16; *(f32x2*)sc = (f32x2){ig, lf}; *(f32x4*)(sc + 4) = qk; }
}

__device__ __forceinline__ void scan_mlstm(const Params& p, int l, bool samp, int bs, int h, int qtr, int row0, int L, float* lds) {
    const int tid = opaque_tid(p.wv); const bool cons = tid < 256; const int ptid = tid - 256;
    const int lane = tid & 63, w = (tid >> 6) & 3, s = lane & 7, cl = w * 8 + (lane >> 3), col = qtr * 32 + cl;
    const int e2 = 2 * (lane >> 3), nd = (e2 >> 2) * 32 + s * 4 + (e2 & 3);
    bf16_t* P = (bf16_t*)(p.ws + OFF_P);
    f32x2 C[8]; float n0v = 0.f, n1v = 0.f, m = 0.f;
#pragma unroll
    for (int e = 0; e < 8; ++e) C[e] = bc2(0.f);
    if (cons && samp) {
        const size_t sh = (size_t)(l * NS + bs) * 4 + h;
        const float* C0 = p.st_C + sh * 16384;
#pragma unroll
        for (int e = 0; e < 16; ++e) { const int d = (e >> 2) * 32 + s * 4 + (e & 3); C[e >> 1][e & 1] = C0[d * 128 + col]; }
        n0v = p.st_n[sh * 128 + nd]; n1v = p.st_n[sh * 128 + nd + 1]; m = p.st_m[sh];
    }
    const int nblk = (L + 31) >> 5;
    f32x4 k4[4][4];
    StageRegs sr{k4[0][0], k4[0][1], k4[0][2], k4[0][3], k4[1][0], k4[1][1], k4[1][2], k4[1][3]};
    if (!cons) { issue_mlstm(p, h, qtr, row0, L, 0, ptid, sr); commit_mlstm(p, l, h, L, 0, lds, ptid, sr); if (1 < nblk) issue_mlstm(p, h, qtr, row0, L, 1, ptid, sr); }
    BARRIER_LDS();
    for (int jb = 0; jb < nblk; ++jb) {
        if (!cons) {
            if (jb + 1 < nblk) commit_mlstm(p, l, h, L, jb + 1, lds, ptid, sr);
            if (jb + 2 < nblk) issue_mlstm(p, h, qtr, row0, L, jb + 2, ptid, sr);
            if (jb > 0) store_out_blk(P, row0, jb - 1, L, cV + h * 128 + qtr * 32, OB(lds, (jb - 1) & 1), ptid);
        } else {
            const float* qb = QB(lds, jb & 1); const float* kb = KB(lds, jb & 1); const float* vb = VB(lds, jb & 1); const float* sc = SCB(lds, jb & 1);
            float* ob = OB(lds, jb & 1);
            const int nt = min(32, L - jb * 32);
            f32x4 q4[4][4]; f32x2 kn[4], qn[4]; float vv[4], ig[4], lf[4]; f32x4 qk[4];
#define MLOAD_Q(T0) do { _Pragma("unroll") for (int i = 0; i < 4; ++i) { const int t = (T0) + i; \
        _Pragma("unroll") for (int j = 0; j < 4; ++j) q4[i][j] = *(const f32x4*)(qb + t * 128 + j * 32 + s * 4); \
        qn[i] = *(const f32x2*)(qb + t * 128 + nd); } } while (0)
#define MLOAD_K(T0) do { _Pragma("unroll") for (int i = 0; i < 4; ++i) { const int t = (T0) + i; \
        const f32x2 gg = *(const f32x2*)(sc + t * 16); ig[i] = gg[0]; lf[i] = gg[1]; \
        qk[i] = *(const f32x4*)(sc + t * 16 + 4); vv[i] = vb[t * 32 + cl]; } \
      _Pragma("unroll") for (int i = 0; i < 4; ++i) { const int t = (T0) + i; \
        _Pragma("unroll") for (int j = 0; j < 4; ++j) k4[i][j] = *(const f32x4*)(kb + t * 128 + j * 32 + s * 4); \
        kn[i] = *(const f32x2*)(kb + t * 128 + nd); } } while (0)
            MLOAD_Q(0); MLOAD_K(0);
#pragma unroll 1
            for (int t0 = 0; t0 < nt; t0 += 4) {
                float d[4], dn[4];
                const int tn = min(t0 + 4, 28);
                __builtin_amdgcn_sched_barrier(0);
#pragma unroll
                for (int i = 0; i < 4; ++i) {
                    f32x2 a = bc2(0.f), a2 = bc2(0.f);
#pragma unroll
                    for (int j = 0; j < 4; ++j) { a = lo2(q4[i][j]) * C[2 * j] + a; a2 = hi2(q4[i][j]) * C[2 * j + 1] + a2; }
                    a = a + a2;
                    d[i] = a[0] + a[1]; dn[i] = qn[i][0] * n0v + qn[i][1] * n1v;
                }
                __builtin_amdgcn_sched_barrier(0);
                MLOAD_Q(tn);
                __builtin_amdgcn_sched_barrier(0);
#pragma unroll
                for (int i = 0; i < 4; ++i) { d[i] = red8(d[i]); dn[i] = red64(dn[i]); }
                float fp[4], ip[4], em[4];
#pragma unroll
                for (int i = 0; i < 4; ++i) { const float mn = fmaxf(lf[i] + m, ig[i]); fp[i] = __expf(lf[i] + m - mn); ip[i] = __expf(ig[i] - mn); em[i] = __expf(-mn); m = mn; }
                const float F0 = fp[0], F1 = F0 * fp[1], F2 = F1 * fp[2], F3 = F2 * fp[3];
                const float g00 = ip[0], g10 = g00 * fp[1], g11 = ip[1], g20 = g10 * fp[2], g21 = g11 * fp[2], g22 = ip[2];
                const float g30 = g20 * fp[3], g31 = g21 * fp[3], g32 = g22 * fp[3], g33 = ip[3];
                const float s00 = g00 * qk[0][0];
                const float s10 = g10 * qk[1][0], s11 = g11 * qk[1][1];
                const float s20 = g20 * qk[2][0], s21 = g21 * qk[2][1], s22 = g22 * qk[2][2];
                const float s30 = g30 * qk[3][0], s31 = g31 * qk[3][1], s32 = g32 * qk[3][2], s33 = g33 * qk[3][3];
                const float num0 = F0 * d[0] + s00 * vv[0], den0 = F0 * dn[0] + s00;
                const float num1 = F1 * d[1] + s10 * vv[0] + s11 * vv[1], den1 = F1 * dn[1] + s10 + s11;
                const float num2 = F2 * d[2] + s20 * vv[0] + s21 * vv[1] + s22 * vv[2], den2 = F2 * dn[2] + s20 + s21 + s22;
                const float num3 = F3 * d[3] + s30 * vv[0] + s31 * vv[1] + s32 * vv[2] + s33 * vv[3], den3 = F3 * dn[3] + s30 + s31 + s32 + s33;
                if (s == 0) {
                    ob[(t0 + 0) * 32 + cl] = num0 / fmaxf(fabsf(den0), em[0]); ob[(t0 + 1) * 32 + cl] = num1 / fmaxf(fabsf(den1), em[1]);
                    ob[(t0 + 2) * 32 + cl] = num2 / fmaxf(fabsf(den2), em[2]); ob[(t0 + 3) * 32 + cl] = num3 / fmaxf(fabsf(den3), em[3]);
                }
                const float c0 = g30 * vv[0], c1 = g31 * vv[1], c2 = g32 * vv[2], c3 = g33 * vv[3];
#pragma unroll
                for (int j = 0; j < 4; ++j) {
                    C[2 * j] = lo2(k4[3][j]) * bc2(c3) + (lo2(k4[2][j]) * bc2(c2) + (lo2(k4[1][j]) * bc2(c1) + (lo2(k4[0][j]) * bc2(c0) + C[2 * j] * bc2(F3))));
                    C[2 * j + 1] = hi2(k4[3][j]) * bc2(c3) + (hi2(k4[2][j]) * bc2(c2) + (hi2(k4[1][j]) * bc2(c1) + (hi2(k4[0][j]) * bc2(c0) + C[2 * j + 1] * bc2(F3)))); }
                n0v = n0v * F3 + (kn[0][0] * g30 + kn[1][0] * g31) + (kn[2][0] * g32 + kn[3][0] * g33);
                n1v = n1v * F3 + (kn[0][1] * g30 + kn[1][1] * g31) + (kn[2][1] * g32 + kn[3][1] * g33);
                __builtin_amdgcn_sched_barrier(0);
                MLOAD_K(tn);
            }
#undef MLOAD_Q
#undef MLOAD_K
        }
        BARRIER_LDS();
    }
    if (!cons) store_out_blk(P, row0, nblk - 1, L, cV + h * 128 + qtr * 32, OB(lds, (nblk - 1) & 1), ptid);
    else {
        const size_t sh = samp ? (size_t)(l * NS + bs) * 4 + h : (size_t)(l * NB + bs) * 4 + h;
        float* Co = p.out + (samp ? o_sC : o_pC) + sh * 16384;
#pragma unroll
        for (int e = 0; e < 16; ++e) { const int d = (e >> 2) * 32 + s * 4 + (e & 3); Co[d * 128 + col] = C[e >> 1][e & 1]; }
        if (qtr == 0 && w == 0) { float* no = p.out + (samp ? o_sn : o_pn) + sh * 128; no[nd] = n0v; no[nd + 1] = n1v;
            if (lane == 0) p.out[(samp ? o_sm : o_pm) + sh] = m; }
    }
    BARRIER_LDS();
}

typedef float f32x16 __attribute__((ext_vector_type(16)));
#define MFMA32(a, b, c) __builtin_amdgcn_mfma_f32_32x32x16_bf16((a), (b), (c), 0, 0, 0)
__device__ __forceinline__ int crow(int reg, int hf) { return (reg & 3) + 8 * (reg >> 2) + 4 * hf; }
__device__ __forceinline__ bf16x8 pack_step(const f32x16& x, int s) {
    u32x4 pk;
    asm volatile("s_nop 7\n\ts_nop 3\n\tv_cvt_pk_bf16_f32 %0, %4, %5\n\tv_cvt_pk_bf16_f32 %1, %6, %7\n\tv_cvt_pk_bf16_f32 %2, %8, %9\n\tv_cvt_pk_bf16_f32 %3, %10, %11\n\ts_nop 1"
                 : "=&v"(pk[0]), "=&v"(pk[1]), "=&v"(pk[2]), "=&v"(pk[3])
                 : "v"(x[8 * s]), "v"(x[8 * s + 1]), "v"(x[8 * s + 2]), "v"(x[8 * s + 3]), "v"(x[8 * s + 4]), "v"(x[8 * s + 5]), "v"(x[8 * s + 6]), "v"(x[8 * s + 7]));
    return __builtin_bit_cast(bf16x8, pk);
}
__device__ __forceinline__ bf16x8 frag_n(const bf16_t* base, int ld, int r, int hf, int kb) { return *(const bf16x8*)(base + r * ld + kb * 16 + hf * 8); }
__device__ __forceinline__ bf16x8 frag_p(const bf16_t* base, int ld, int r, int hf, int k0) {
    const u32x2 a = *(const u32x2*)(base + r * ld + k0 + 4 * hf), b = *(const u32x2*)(base + r * ld + k0 + 8 + 4 * hf);
    return __builtin_bit_cast(bf16x8, (u32x4){a.x, a.y, b.x, b.y});
}
__device__ __forceinline__ int kto(int d) { return d * 40 + (d >> 4) * 8; }
__device__ __forceinline__ bf16_t f2bf(float x) { return (bf16_t)(pk2(x, 0.f) & 0xffffu); }

constexpr int CH_LDQ = 136, CH_LDS = 40;
constexpr int CH_QB = 0, CH_KB = 8704, CH_KWT = 17408, CH_VT = 27904, CH_SW = 33024, CH_SC = 35584, CH_QW = 36608, CH_SLOT = 45312, CH_OB = 2 * CH_SLOT;
constexpr int SC_U = 0, SC_B = 32, SC_PM = 64;

__device__ __forceinline__ void store_out_norm(bf16_t* P, int row0, int jb, int L, int pcol, const float* ob, const float* rd, int ptid) {
    const int tt = ptid >> 3, g = ptid & 7, t0 = jb * 32;
    if (t0 + tt < L) { const f32x4 v = *(const f32x4*)(ob + tt * 32 + g * 4) * rd[tt];
        *(u32x2*)(P + (size_t)(row0 + t0 + tt) * NP + pcol + g * 4) = (u32x2){pk2(v[0], v[1]), pk2(v[2], v[3])}; }
}
__device__ __forceinline__ void issue_mlstm_chunk(const Params& p, int h, int qtr, int row0, int L, int nch, int jb, int ptid, StageRegs& r) {
    if (jb >= nch) return;
    const bf16_t* P = (const bf16_t*)(p.ws + OFF_P); const float* REC = (const float*)(p.ws + OFF_REC);
    const int tt = ptid >> 3, g = ptid & 7, t0 = jb * 32;
    const int row = row0 + t0 + tt;
    if (g == 0) r.r0 = *(const f32x4*)(REC + ((size_t)row * 4 + h) * 16 + 4);
    if (t0 + tt >= L) return;
    const bf16_t* prow = P + (size_t)row * NP;
    r.q0 = asf(*(const u32x4*)(prow + cQ + h * 128 + g * 16)); r.q1 = asf(*(const u32x4*)(prow + cQ + h * 128 + g * 16 + 8));
    r.k0 = asf(*(const u32x4*)(prow + cK + h * 128 + g * 16)); r.k1 = asf(*(const u32x4*)(prow + cK + h * 128 + g * 16 + 8));
    { const u32x2 vv_ = *(const u32x2*)(prow + cV + h * 128 + qtr * 32 + g * 4); r.v = asf((u32x4){vv_.x, vv_.y, 0u, 0u}); }
}

__device__ __forceinline__ void scan_mlstm_chunk(const Params& p, int l, int bs, int h, int qtr, int row0, int L, unsigned char* lb) {
    const int tid = opaque_tid(p.wv); const int wave = tid >> 6, lane = tid & 63, r = lane & 31, hf = lane >> 5, ptid = tid - 256;
    bf16_t* P = (bf16_t*)(p.ws + OFF_P);
    const int nch = (L + 31) >> 5;
    f32x16 C[4];
    const int ct = wave == 3 ? 1 : 0;
#pragma unroll
    for (int dt = 0; dt < 4; ++dt)
#pragma unroll
        for (int i = 0; i < 16; ++i) C[dt][i] = 0.f;
    float m0 = 0.f;
    f32x4 s0, s1, s2, s3, s4, s5, s6, s7; StageRegs sr{s0, s1, s2, s3, s4, s5, s6, s7};
    if (wave >= 4) { for (int i = ptid; i < 2 * 32 * CH_LDS; i += 256) { const int sl = i / (32 * CH_LDS), e = i % (32 * CH_LDS);
            ((bf16_t*)(lb + sl * CH_SLOT + CH_VT))[32 * CH_LDS + e] = (e < CH_LDS) ? (bf16_t)0x3f80 : (bf16_t)0; } }
#define CH_P1(JN) do { const int jn_ = (JN); unsigned char* sl_ = lb + (jn_ & 1) * CH_SLOT; const int tt = ptid >> 3, g = ptid & 7; const bool val_ = jn_ * 32 + tt < L; \
        u32x4 q0_ = asu(sr.q0), q1_ = asu(sr.q1), k0_ = asu(sr.k0), k1_ = asu(sr.k1); u32x4 v_ = asu(sr.v); \
        if (!val_) { q0_ = q1_ = k0_ = k1_ = v_ = (u32x4){0u, 0u, 0u, 0u}; } \
        *(u32x4*)(sl_ + CH_QB + (tt * CH_LDQ + g * 16) * 2) = q0_; *(u32x4*)(sl_ + CH_QB + (tt * CH_LDQ + g * 16 + 8) * 2) = q1_; \
        *(u32x4*)(sl_ + CH_KB + (tt * CH_LDQ + g * 16) * 2) = k0_; *(u32x4*)(sl_ + CH_KB + (tt * CH_LDQ + g * 16 + 8) * 2) = k1_; \
        bf16_t* vt_ = (bf16_t*)(sl_ + CH_VT); \
        vt_[(g * 4 + 0) * CH_LDS + tt] = (bf16_t)(v_.x & 0xffffu); vt_[(g * 4 + 1) * CH_LDS + tt] = (bf16_t)(v_.x >> 16); \
        vt_[(g * 4 + 2) * CH_LDS + tt] = (bf16_t)(v_.y & 0xffffu); vt_[(g * 4 + 3) * CH_LDS + tt] = (bf16_t)(v_.y >> 16); \
        if (g == 0) { float* sc_ = (float*)(sl_ + CH_SC); sc_[SC_U + tt] = sr.r0[0]; sc_[SC_B + tt] = sr.r0[1]; sc_[SC_PM + tt] = sr.r0[2]; } \
        issue_mlstm_chunk(p, h, qtr, row0, L, nch, jn_ + 1, ptid, sr); } while (0)
#define CH_P2(JN) do { unsigned char* sl_ = lb + ((JN) & 1) * CH_SLOT; const float* sc_ = (const float*)(sl_ + CH_SC); \
        const float bT_ = sc_[SC_B + 31], mT_ = bT_ + fmaxf(m0, sc_[SC_PM + 31]); \
        if (wave == 1) { f32x16 a_; _Pragma("unroll") for (int i = 0; i < 16; ++i) a_[i] = 0.f; \
            _Pragma("unroll") for (int kb = 0; kb < 8; ++kb) a_ = MFMA32(frag_n((const bf16_t*)(sl_ + CH_QB), CH_LDQ, r, hf, kb), frag_n((const bf16_t*)(sl_ + CH_KB), CH_LDQ, r, hf, kb), a_); \
            bf16_t* sw_ = (bf16_t*)(sl_ + CH_SW); const float us_ = sc_[SC_U + r]; \
            _Pragma("unroll") for (int i4 = 0; i4 < 4; ++i4) { const f32x4 pm4 = *(const f32x4*)(sc_ + SC_PM + 8 * i4 + 4 * hf); \
                _Pragma("unroll") for (int ii = 0; ii < 4; ++ii) { const int t = 8 * i4 + 4 * hf + ii; const float w_ = (r <= t) ? __expf(us_ - fmaxf(m0, pm4[ii])) * 0.08838834764831845f : 0.f; \
                    sw_[t * CH_LDS + r] = f2bf(a_[4 * i4 + ii] * w_); } } } \
        else if (wave >= 4) { const int tt = ptid >> 3, g = ptid & 7; \
            const float wi_ = __expf(m0 - fmaxf(m0, sc_[SC_PM + tt])) * 0.08838834764831845f, ws_ = __expf(sc_[SC_U + tt] + bT_ - mT_); float x_[16]; \
            u32x4* qp_ = (u32x4*)(sl_ + CH_QB + (tt * CH_LDQ + g * 16) * 2); unpack8(qp_[0], x_); unpack8(qp_[1], x_ + 8); \
            _Pragma("unroll") for (int i = 0; i < 16; ++i) x_[i] *= wi_; \
            u32x4* qo_ = (u32x4*)(sl_ + CH_QW + (tt * CH_LDQ + g * 16) * 2); qo_[0] = pack8(x_); qo_[1] = pack8(x_ + 8); \
            const u32x4* kp_ = (const u32x4*)(sl_ + CH_KB + (tt * CH_LDQ + g * 16) * 2); unpack8(kp_[0], x_); unpack8(kp_[1], x_ + 8); \
            bf16_t* kw_ = (bf16_t*)(sl_ + CH_KWT); \
            _Pragma("unroll") for (int i = 0; i < 16; ++i) kw_[kto(g * 16) + i * CH_LDS + tt] = f2bf(x_[i] * ws_); } \
        if (wave == 1 || wave >= 4) m0 = mT_; } while (0)
    if (wave >= 4) { issue_mlstm_chunk(p, h, qtr, row0, L, nch, 0, ptid, sr); CH_P1(0); }
    BARRIER_LDS();
    CH_P2(0);
    BARRIER_LDS();
#pragma unroll 1
    for (int j = 0; j < nch; ++j) {
        if (wave == 0 || wave == 3) {
            const unsigned char* sl = lb + (j & 1) * CH_SLOT; const float* sc = (const float*)(sl + CH_SC);
            const bf16_t* qw = (const bf16_t*)(sl + CH_QW); const bf16_t* sw = (const bf16_t*)(sl + CH_SW); const bf16_t* vt = (const bf16_t*)(sl + CH_VT) + ct * 32 * CH_LDS; const bf16_t* kwt = (const bf16_t*)(sl + CH_KWT);
            const float bT = sc[SC_B + 31], mT = bT + fmaxf(m0, sc[SC_PM + 31]);
            f32x16 H;
#pragma unroll
            for (int i = 0; i < 16; ++i) H[i] = 0.f;
#pragma unroll
            for (int dt = 0; dt < 4; ++dt)
#pragma unroll
                for (int u = 0; u < 2; ++u) H = MFMA32(frag_p(qw, CH_LDQ, r, hf, 32 * dt + 16 * u), pack_step(C[dt], u), H);
            bf16x8 vb[2];
#pragma unroll
            for (int kb = 0; kb < 2; ++kb) { vb[kb] = frag_n(vt, CH_LDS, r, hf, kb); H = MFMA32(frag_n(sw, CH_LDS, r, hf, kb), vb[kb], H); }
            const float wold = __expf(bT - mT + m0);
#pragma unroll
            for (int dt = 0; dt < 4; ++dt) {
#pragma unroll
                for (int i = 0; i < 16; ++i) C[dt][i] *= wold;
#pragma unroll
                for (int kb = 0; kb < 2; ++kb) C[dt] = MFMA32(frag_n(kwt + kto(dt * 32 + r), 0, 0, hf, kb), vb[kb], C[dt]);
            }
            float* ob = (float*)(lb + CH_OB) + (j & 1) * 1024; float* rd = (float*)(lb + CH_OB + 8192) + (j & 1) * 32;
            if (ct == 0) {
#pragma unroll
                for (int i = 0; i < 16; ++i) ob[crow(i, hf) * 32 + r] = H[i];
            } else if (r == 0) {
#pragma unroll
                for (int i = 0; i < 16; ++i) { const int t = crow(i, hf); rd[t] = __builtin_amdgcn_rcpf(fmaxf(fabsf(H[i]), __expf(-(sc[SC_B + t] + fmaxf(m0, sc[SC_PM + t]))))); }
            }
            m0 = mT;
        } else if (wave >= 4) {
            if (j + 1 < nch) CH_P1(j + 1);
            if (j > 0) store_out_norm(P, row0, j - 1, L, cV + h * 128 + qtr * 32, (const float*)(lb + CH_OB) + ((j - 1) & 1) * 1024, (const float*)(lb + CH_OB + 8192) + ((j - 1) & 1) * 32, ptid);
        }
        BARRIER_LDS();
        if (j + 1 < nch) CH_P2(j + 1);
        BARRIER_LDS();
    }
    if (wave >= 4) store_out_norm(P, row0, nch - 1, L, cV + h * 128 + qtr * 32, (const float*)(lb + CH_OB) + ((nch - 1) & 1) * 1024, (const float*)(lb + CH_OB + 8192) + ((nch - 1) & 1) * 32, ptid);
    const size_t sh = (size_t)(l * NB + bs) * 4 + h;
    if (wave == 0) {
        float* Co = p.out + o_pC + sh * 16384;
#pragma unroll
        for (int dt = 0; dt < 4; ++dt)
#pragma unroll
            for (int i = 0; i < 16; ++i) Co[(32 * dt + crow(i, hf)) * 128 + qtr * 32 + r] = C[dt][i];
        if (lane == 0 && qtr == 0) p.out[o_pm + sh] = m0;
    } else if (wave == 3 && r == 0 && qtr == 0) {
#pragma unroll
        for (int dt = 0; dt < 4; ++dt)
#pragma unroll
            for (int i = 0; i < 16; ++i) p.out[o_pn + sh * 128 + 32 * dt + crow(i, hf)] = C[dt][i];
    }
    __syncthreads();
#undef CH_P1
#undef CH_P2
}

__device__ __forceinline__ void gdn_raw8(const bf16_t* P, int r0, int tr, int pcol, const bf16_t* gh, const float* st, int hch, float* x) {
    if (tr >= 0) unpack8(*(const u32x4*)(P + (size_t)(r0 + tr) * NP + pcol), x);
    else if (gh) unpack8(*(const u32x4*)(gh + (3 + tr) * 1536 + hch), x);
    else if (st) { const float* hp = st + (3 + tr) * 1536 + hch; const f32x4 a = *(const f32x4*)hp, b = *(const f32x4*)(hp + 4);
        x[0] = a[0]; x[1] = a[1]; x[2] = a[2]; x[3] = a[3]; x[4] = b[0]; x[5] = b[1]; x[6] = b[2]; x[7] = b[3]; }
    else {
#pragma unroll
        for (int i = 0; i < 8; ++i) x[i] = 0.f; }
}
__device__ __forceinline__ void gdn_conv8(const bf16_t* P, int r0, int tr, int pcol, const bf16_t* gh, const float* st, int hch, const float* cw, float* y) {
#pragma unroll
    for (int i = 0; i < 8; ++i) y[i] = 0.f;
#pragma unroll
    for (int j = 0; j < 4; ++j) { float x[8]; gdn_raw8(P, r0, tr - 3 + j, pcol, gh, st, hch, x);
        const f32x4 w0 = *(const f32x4*)(cw + j * 1536 + hch), w1 = *(const f32x4*)(cw + j * 1536 + hch + 4);
        y[0] += x[0] * w0[0]; y[1] += x[1] * w0[1]; y[2] += x[2] * w0[2]; y[3] += x[3] * w0[3];
        y[4] += x[4] * w1[0]; y[5] += x[5] * w1[1]; y[6] += x[6] * w1[2]; y[7] += x[7] * w1[3]; }
#pragma unroll
    for (int i = 0; i < 8; ++i) y[i] = y[i] * sigmoidf_(y[i]);
}

__device__ __forceinline__ void phase_prep(const Params& p, int l, float* lds) {
    const int tid = opaque_tid(p.wv); const int half = tid >> 8, t = tid & 255, tt = t >> 3, g = t & 7, wq = t >> 6, lane = t & 63, r = lane & 31, hf = lane >> 5;
    bf16_t* P = (bf16_t*)(p.ws + OFF_P); const bf16_t* GH = (const bf16_t*)(p.ws + OFF_GH);
    const float* G = (const float*)(p.ws + OFF_G); float* REC = (float*)(p.ws + OFF_REC); bf16_t* TB = (bf16_t*)(p.ws + OFF_TB);
    const float* cw = p.gconv_w + (size_t)l * 4 * 1536;
    float* ksc = lds + half * 4096;
    unsigned char* pl = (unsigned char*)lds + 32768 + half * 22016;
    bf16_t* kimg = (bf16_t*)pl; bf16_t* qimg = (bf16_t*)(pl + 8704); float* am = (float*)(pl + 17408); float* sgl = (float*)(pl + 21504); float* sbe = sgl + 32; float* sG = sgl + 64;
    constexpr int NITEM = (MROWS / 32) * 4;
    for (int base = blockIdx.x * 2; base < NITEM; base += gridDim.x * 2) {
        const int item = base + half; const bool act = item < NITEM;
        const int rb = item >> 2, h = item & 3, r0 = rb * 32;
        const bool samp = rb >= SROW0 / 32;
        int tr = tt; const bf16_t* gh = nullptr; const float* st = nullptr; int rbase = r0; bool valid = act;
        if (!samp) { const int jb = rb % (LPAD / 32); if (jb * 32 + tt >= LP) valid = false; if (jb > 0) gh = GH + (size_t)(rb - 1) * 3 * 1536; }
        else { const int sq = (rb - SROW0 / 32) * 8 + (tt >> 2); tr = tt & 3; rbase = r0 + (tt & ~3); st = p.st_gconv + (size_t)(l * NS + sq) * 3 * 1536; }
        const int ch = h * 128 + g * 16;
        u32x4 oq0 = (u32x4){0u, 0u, 0u, 0u}, oq1 = oq0, ok0 = oq0, ok1 = oq0, ov0 = oq0, ov1 = oq0;
        float ga = 0.f, gb = 0.f, gg = 0.f;
        if (valid) {
            float y[16];
            gdn_conv8(P, rbase, tr, cBV + ch, gh, st, 1024 + ch, cw, y); gdn_conv8(P, rbase, tr, cBV + ch + 8, gh, st, 1024 + ch + 8, cw, y + 8);
            ov0 = pack8(y); ov1 = pack8(y + 8);
            __builtin_amdgcn_sched_barrier(0);
            gdn_conv8(P, rbase, tr, cBQ + ch, gh, st, ch, cw, y); gdn_conv8(P, rbase, tr, cBQ + ch + 8, gh, st, ch + 8, cw, y + 8);
            float ss = 0.f;
#pragma unroll
            for (int i = 0; i < 16; ++i) ss += y[i] * y[i];
            float rs = rsqrtf(red8(ss) + 1e-6f) * 0.08838834764831845f;
#pragma unroll
            for (int i = 0; i < 16; ++i) y[i] *= rs;
            oq0 = pack8(y); oq1 = pack8(y + 8);
            __builtin_amdgcn_sched_barrier(0);
            gdn_conv8(P, rbase, tr, cBK + ch, gh, st, 512 + ch, cw, y); gdn_conv8(P, rbase, tr, cBK + ch + 8, gh, st, 512 + ch + 8, cw, y + 8);
            ss = 0.f;
#pragma unroll
            for (int i = 0; i < 16; ++i) ss += y[i] * y[i];
            rs = rsqrtf(red8(ss) + 1e-6f);
#pragma unroll
            for (int i = 0; i < 16; ++i) y[i] *= rs;
            ok0 = pack8(y); ok1 = pack8(y + 8);
            unpack8(ok0, y); unpack8(ok1, y + 8);
#pragma unroll
            for (int i = 0; i < 4; ++i) *(f32x4*)(ksc + tt * 128 + g * 16 + 4 * i) = (f32x4){y[4 * i], y[4 * i + 1], y[4 * i + 2], y[4 * i + 3]};
            if (g == 0) { const float* gr = G + (size_t)(r0 + tt) * 16;
                gb = sigmoidf_(gr[8 + h]);
                const float xa = gr[12 + h] + p.dt_bias[l * 4 + h];
                const float sp = fmaxf(xa, 0.f) + log1pf(__expf(-fabsf(xa)));
                gg = -__expf(p.A_log[l * 4 + h]) * sp; ga = __expf(gg); }
        }
        if (!samp) {
            *(u32x4*)(kimg + tt * CH_LDQ + g * 16) = ok0; *(u32x4*)(kimg + tt * CH_LDQ + g * 16 + 8) = ok1;
            *(u32x4*)(qimg + tt * CH_LDQ + g * 16) = oq0; *(u32x4*)(qimg + tt * CH_LDQ + g * 16 + 8) = oq1;
            if (g == 0) { sgl[tt] = gg; sbe[tt] = gb; }
        }
        __syncthreads();
        f32x16 pacc;
#pragma unroll
        for (int i = 0; i < 16; ++i) pacc[i] = 0.f;
        float myG = 0.f, totG = 0.f;
        if (valid) {
            bf16_t* pr = P + (size_t)(r0 + tt) * NP;
            *(u32x4*)(pr + cBQ + ch) = oq0; *(u32x4*)(pr + cBQ + ch + 8) = oq1; *(u32x4*)(pr + cBK + ch) = ok0; *(u32x4*)(pr + cBK + ch + 8) = ok1;
            *(u32x4*)(pr + cBV + ch) = ov0; *(u32x4*)(pr + cBV + ch + 8) = ov1;
        }
        if (samp) {
            if (valid) {
                const float* kmb = ksc + (tt & ~3) * 128 + g * 16;
                f32x4 qk, kk, qs[4], ks[4];
                { float y[16]; unpack8(oq0, y); unpack8(oq1, y + 8);
#pragma unroll
                  for (int i = 0; i < 4; ++i) qs[i] = (f32x4){y[4 * i], y[4 * i + 1], y[4 * i + 2], y[4 * i + 3]};
                  unpack8(ok0, y); unpack8(ok1, y + 8);
#pragma unroll
                  for (int i = 0; i < 4; ++i) ks[i] = (f32x4){y[4 * i], y[4 * i + 1], y[4 * i + 2], y[4 * i + 3]}; }
#pragma unroll
                for (int j = 0; j < 4; ++j) { qk[j] = red8(dot16(qs, kmb + j * 128)); kk[j] = red8(dot16(ks, kmb + j * 128)); }
                if (g == 0) { float* rec = REC + ((size_t)(r0 + tt) * 4 + h) * 16; *(f32x4*)rec = (f32x4){ga, gb, gg, 0.f}; *(f32x4*)(rec + 4) = qk; *(f32x4*)(rec + 8) = kk; }
            }
        } else if (act) {
            if (wq < 2) {
                const bf16_t* ai = wq == 0 ? kimg : qimg;
#pragma unroll
                for (int kb = 0; kb < 8; ++kb) pacc = MFMA32(frag_n(ai, CH_LDQ, r, hf, kb), frag_n(kimg, CH_LDQ, r, hf, kb), pacc);
            } else if (wq == 2) {
                const float gm = sgl[r]; float cum = 0.f;
#pragma unroll
                for (int t2 = 0; t2 < 32; ++t2) { cum += rdl(gm, t2); if (r == t2) myG = cum; }
                totG = cum;
                if (lane < 32) sG[r] = myG;
                if (lane == 0) sG[32] = cum;
            }
        }
        __syncthreads();
        if (!samp && act) {
            bf16_t* tb = TB + (size_t)item * 3072;
            if (wq == 0) {
                const float Gs_ = sG[r]; float* ag = (float*)tb;
#pragma unroll
                for (int i4 = 0; i4 < 4; ++i4) { const f32x4 G4 = *(const f32x4*)(sG + 8 * i4 + 4 * hf), b4 = *(const f32x4*)(sbe + 8 * i4 + 4 * hf);
#pragma unroll
                    for (int ii = 0; ii < 4; ++ii) { const int t2 = 8 * i4 + 4 * hf + ii; ag[t2 * 32 + r] = (r < t2) ? b4[ii] * pacc[4 * i4 + ii] * __expf(G4[ii] - Gs_) : 0.f; } }
            } else if (wq == 1) {
                const float Gs_ = sG[r];
#pragma unroll
                for (int i4 = 0; i4 < 4; ++i4) { const f32x4 G4 = *(const f32x4*)(sG + 8 * i4 + 4 * hf);
#pragma unroll
                    for (int ii = 0; ii < 4; ++ii) { const int t2 = 8 * i4 + 4 * hf + ii; tb[2048 + t2 * 32 + r] = f2bf((r <= t2) ? pacc[4 * i4 + ii] * __expf(G4[ii] - Gs_) : 0.f); } }
            }
            if (valid && g == 0) { const float Gt = sG[tt], GT = sG[32];
                float* rec = REC + ((size_t)(r0 + tt) * 4 + h) * 16; *(f32x4*)rec = (f32x4){ga, gb, gg, Gt}; *(f32x4*)(rec + 12) = (f32x4){GT - Gt, GT, 0.f, 0.f}; }
        }
        __syncthreads();
    }
    asm volatile("s_waitcnt vmcnt(0)" ::: "memory");
    __syncthreads();
    { const int wv_ = tid >> 6; float* am = lds + wv_ * 1024;
      int nmine = 0;
      for (int base = blockIdx.x * 2; base < NITEM; base += gridDim.x * 2) nmine += 2;
      for (int idx = wv_; idx < nmine; idx += 8) {
        const int item = blockIdx.x * 2 + (idx >> 1) * gridDim.x * 2 + (idx & 1);
        const int rb = item >> 2, h = item & 3;
        if (item >= NITEM || rb >= SROW0 / 32) continue;
        bf16_t* tb = TB + (size_t)item * 3072; const float* ag = (const float*)tb;
#pragma unroll
        for (int q = 0; q < 4; ++q) *(f32x4*)(am + q * 256 + lane * 4) = *(const f32x4*)(ag + q * 256 + lane * 4);
        const float* rec = REC + ((size_t)(rb * 32 + r) * 4 + h) * 16;
        const bool rv = (rb % (LPAD / 32)) * 32 + r < LP;
        const float bs_ = rv ? rec[1] : 0.f, bg_ = rv ? bs_ * __expf(rec[3]) : 0.f;
        asm volatile("s_waitcnt vmcnt(0) lgkmcnt(0)" ::: "memory");
        float Tc[32];
#pragma unroll
        for (int t2 = 0; t2 < 32; ++t2) { float v0 = 0.f, v1 = 0.f, v2 = 0.f, v3 = 0.f;
#pragma unroll
            for (int q4 = 0; q4 < (t2 + 3) / 4; ++q4) { const f32x4 a4 = *(const f32x4*)(am + t2 * 32 + q4 * 4);
                if (q4 * 4 + 0 < t2) v0 += a4[0] * Tc[q4 * 4 + 0]; if (q4 * 4 + 1 < t2) v1 += a4[1] * Tc[q4 * 4 + 1];
                if (q4 * 4 + 2 < t2) v2 += a4[2] * Tc[q4 * 4 + 2]; if (q4 * 4 + 3 < t2) v3 += a4[3] * Tc[q4 * 4 + 3]; }
            Tc[t2] = ((r == t2) ? 1.f : 0.f) - ((v0 + v1) + (v2 + v3)); }
        if (hf == 0) {
#pragma unroll
            for (int t2 = 0; t2 < 32; ++t2) { tb[t2 * 32 + r] = f2bf(Tc[t2] * bs_); tb[1024 + t2 * 32 + r] = f2bf(Tc[t2] * bg_); } }
        asm volatile("s_waitcnt lgkmcnt(0)" ::: "memory");
      } }
    { const int wv_ = tid >> 6;
      for (int it = blockIdx.x * 8 + wv_; it < (SROW0 / 32) * 4; it += gridDim.x * 8) {
        const int rbp = it >> 2, hh = it & 3, jb = rbp % (LPAD / 32), row = rbp * 32 + r;
        float igm = -1e30f, lfm = 0.f;
        if (jb * 32 + r < LP) { const float* gr = G + (size_t)row * 16; igm = gr[hh] + p.gate_bias[l * 8 + hh]; const float f = gr[4 + hh] + p.gate_bias[l * 8 + 4 + hh]; lfm = fminf(f, 0.f) - log1pf(__expf(-fabsf(f))); }
        float bsum = 0.f, pm = -3e38f, myb = 0.f, myu = 0.f, mypm = 0.f;
#pragma unroll
        for (int t2 = 0; t2 < 32; ++t2) { bsum += rdl(lfm, t2); const float u_ = rdl(igm, t2) - bsum; pm = fmaxf(pm, u_); if (r == t2) { myb = bsum; myu = u_; mypm = pm; } }
        if (lane < 32) *(f32x4*)(REC + ((size_t)row * 4 + hh) * 16 + 4) = (f32x4){myu, myb, mypm, 0.f};
      } }
}

__device__ __forceinline__ void issue_gdn(const Params& p, int h, int qtr, int row0, int L, int jb, int ptid, StageRegs& r) {
    const bf16_t* P = (const bf16_t*)(p.ws + OFF_P); const float* REC = (const float*)(p.ws + OFF_REC);
    const int tt = ptid >> 3, g = ptid & 7, t0 = jb * 32;
    if (t0 + tt >= L) return;
    const int row = row0 + t0 + tt;
    const bf16_t* prow = P + (size_t)row * NP;
    r.q0 = asf(*(const u32x4*)(prow + cBQ + h * 128 + g * 16)); r.q1 = asf(*(const u32x4*)(prow + cBQ + h * 128 + g * 16 + 8));
    r.k0 = asf(*(const u32x4*)(prow + cBK + h * 128 + g * 16)); r.k1 = asf(*(const u32x4*)(prow + cBK + h * 128 + g * 16 + 8));
    { const u32x2 vv_ = *(const u32x2*)(prow + cBV + h * 128 + qtr * 32 + g * 4); r.v = asf((u32x4){vv_.x, vv_.y, 0u, 0u}); }
    if (g < 3) r.r0 = *(const f32x4*)(REC + ((size_t)row * 4 + h) * 16 + g * 4);
}
__device__ __forceinline__ void commit_gdn(int L, int jb, float* lds, int ptid, const StageRegs& r) {
    const int tt = ptid >> 3, g = ptid & 7, t0 = jb * 32, b = jb & 1;
    if (t0 + tt >= L) return;
    float x[16];
    unpack8(asu(r.q0), x); unpack8(asu(r.q1), x + 8);
    float* qd = QB(lds, b) + tt * 128 + g * 16;
#pragma unroll
    for (int i = 0; i < 4; ++i) *(f32x4*)(qd + 4 * i) = (f32x4){x[4 * i], x[4 * i + 1], x[4 * i + 2], x[4 * i + 3]};
    unpack8(asu(r.k0), x); unpack8(asu(r.k1), x + 8);
    float* kd = KB(lds, b) + tt * 128 + g * 16;
#pragma unroll
    for (int i = 0; i < 4; ++i) *(f32x4*)(kd + 4 * i) = (f32x4){x[4 * i], x[4 * i + 1], x[4 * i + 2], x[4 * i + 3]};
    *(f32x4*)(VB(lds, b) + tt * 32 + g * 4) = (f32x4){bflo(asu(r.v).x), bfhi(asu(r.v).x), bflo(asu(r.v).y), bfhi(asu(r.v).y)};
    if (g < 3) *(f32x4*)(SCB(lds, b) + tt * 16 + g * 4) = r.r0;
}

constexpr int GD_Q = 0, GD_K = 8704, GD_KT = 17408, GD_KDT = 27904, GD_VT = 38400, GD_QKD = 40960, GD_TV = 43520, GD_TK = 46080, GD_W = 48640, GD_SC = 57344, GD_SLOT = 58368, GD_OB = 2 * GD_SLOT;
constexpr int GS_B = 32, GS_EG = 96, GS_ETG = 128, GS_EGT = 160;

__device__ __forceinline__ void issue_gdn_chunk(const Params& p, int h, int qtr, int row0, int L, int nch, int jb, int ptid, StageRegs& r) {
    if (jb >= nch) return;
    const bf16_t* P = (const bf16_t*)(p.ws + OFF_P); const float* REC = (const float*)(p.ws + OFF_REC);
    const bf16_t* tb = (const bf16_t*)(p.ws + OFF_TB) + ((size_t)((row0 >> 5) + jb) * 4 + h) * 3072;
    r.x0 = asf(*(const u32x4*)(tb + ptid * 8));
    if (ptid < 128) r.x1 = asf(*(const u32x4*)(tb + 2048 + ptid * 8));
    const int tt = ptid >> 3, g = ptid & 7, t0 = jb * 32;
    if (t0 + tt >= L) return;
    const int row = row0 + t0 + tt;
    const bf16_t* prow = P + (size_t)row * NP;
    r.q0 = asf(*(const u32x4*)(prow + cBQ + h * 128 + g * 16)); r.q1 = asf(*(const u32x4*)(prow + cBQ + h * 128 + g * 16 + 8));
    r.k0 = asf(*(const u32x4*)(prow + cBK + h * 128 + g * 16)); r.k1 = asf(*(const u32x4*)(prow + cBK + h * 128 + g * 16 + 8));
    { const u32x2 vv_ = *(const u32x2*)(prow + cBV + h * 128 + qtr * 32 + g * 4); r.v = asf((u32x4){vv_.x, vv_.y, 0u, 0u}); }
    if (g == 0 || g == 3) r.r0 = *(const f32x4*)(REC + ((size_t)row * 4 + h) * 16 + g * 4);
}

__device__ __forceinline__ void scan_gdn_chunk(const Params& p, int l, int bs, int h, int qtr, int row0, int L, unsigned char* lb) {
    const int tid = opaque_tid(p.wv); const int wave = tid >> 6, lane = tid & 63, r = lane & 31, hf = lane >> 5, ptid = tid - 256;
    bf16_t* P = (bf16_t*)(p.ws + OFF_P);
    const int nch = (L + 31) >> 5;
    f32x16 S[4];
#pragma unroll
    for (int dt = 0; dt < 4; ++dt)
#pragma unroll
        for (int i = 0; i < 16; ++i) S[dt][i] = 0.f;
    f32x4 s0, s1, s2, s3, s4, s5, s6, s7; StageRegs sr{s0, s1, s2, s3, s4, s5, s6, s7};
#define GD_P1(JN) do { const int jn_ = (JN); unsigned char* sl_ = lb + (jn_ & 1) * GD_SLOT; const int tt = ptid >> 3, g = ptid & 7; const bool val_ = jn_ * 32 + tt < L; \
        u32x4 q0_ = asu(sr.q0), q1_ = asu(sr.q1), k0_ = asu(sr.k0), k1_ = asu(sr.k1); u32x4 v_ = asu(sr.v); \
        if (!val_) { q0_ = q1_ = k0_ = k1_ = v_ = (u32x4){0u, 0u, 0u, 0u}; } \
        *(u32x4*)(sl_ + GD_Q + (tt * CH_LDQ + g * 16) * 2) = q0_; *(u32x4*)(sl_ + GD_Q + (tt * CH_LDQ + g * 16 + 8) * 2) = q1_; \
        *(u32x4*)(sl_ + GD_K + (tt * CH_LDQ + g * 16) * 2) = k0_; *(u32x4*)(sl_ + GD_K + (tt * CH_LDQ + g * 16 + 8) * 2) = k1_; \
        bf16_t* kt_ = (bf16_t*)(sl_ + GD_KT) + kto(g * 16) + tt; \
        _Pragma("unroll") for (int i = 0; i < 4; ++i) { kt_[(2 * i) * CH_LDS] = (bf16_t)(k0_[i] & 0xffffu); kt_[(2 * i + 1) * CH_LDS] = (bf16_t)(k0_[i] >> 16); \
            kt_[(8 + 2 * i) * CH_LDS] = (bf16_t)(k1_[i] & 0xffffu); kt_[(8 + 2 * i + 1) * CH_LDS] = (bf16_t)(k1_[i] >> 16); } \
        bf16_t* vt_ = (bf16_t*)(sl_ + GD_VT); \
        vt_[(g * 4 + 0) * CH_LDS + tt] = (bf16_t)(v_.x & 0xffffu); vt_[(g * 4 + 1) * CH_LDS + tt] = (bf16_t)(v_.x >> 16); \
        vt_[(g * 4 + 2) * CH_LDS + tt] = (bf16_t)(v_.y & 0xffffu); vt_[(g * 4 + 3) * CH_LDS + tt] = (bf16_t)(v_.y >> 16); \
        { const int row_ = ptid >> 2, c4_ = ptid & 3; *(u32x4*)(sl_ + (row_ < 32 ? GD_TV : GD_TK) + ((row_ & 31) * CH_LDS + c4_ * 8) * 2) = asu(sr.x0); \
          if (ptid < 128) *(u32x4*)(sl_ + GD_QKD + (row_ * CH_LDS + c4_ * 8) * 2) = asu(sr.x1); } \
        float* sc_ = (float*)(sl_ + GD_SC); \
        if (g == 0) { sc_[GS_B + tt] = val_ ? sr.r0[1] : 0.f; sc_[GS_EG + tt] = val_ ? __expf(sr.r0[3]) : 0.f; } \
        if (g == 3) { sc_[GS_ETG + tt] = val_ ? __expf(sr.r0[0]) : 0.f; if (tt == 0) sc_[GS_EGT] = __expf(sr.r0[1]); } \
        issue_gdn_chunk(p, h, qtr, row0, L, nch, jn_ + 1, ptid, sr); } while (0)
#define GD_P2(JN) do { if (wave >= 4) { unsigned char* sl_ = lb + ((JN) & 1) * GD_SLOT; const float* sc_ = (const float*)(sl_ + GD_SC); \
        { const int tt = ptid >> 3, g = ptid & 7; const float eg_ = sc_[GS_EG + tt], et_ = sc_[GS_ETG + tt]; float x_[16]; \
            u32x4* qp_ = (u32x4*)(sl_ + GD_Q + (tt * CH_LDQ + g * 16) * 2); unpack8(qp_[0], x_); unpack8(qp_[1], x_ + 8); \
            _Pragma("unroll") for (int i = 0; i < 16; ++i) x_[i] *= eg_; \
            qp_[0] = pack8(x_); qp_[1] = pack8(x_ + 8); \
            const u32x4* kp_ = (const u32x4*)(sl_ + GD_K + (tt * CH_LDQ + g * 16) * 2); unpack8(kp_[0], x_); unpack8(kp_[1], x_ + 8); \
            bf16_t* kd_ = (bf16_t*)(sl_ + GD_KDT); \
            _Pragma("unroll") for (int i = 0; i < 16; ++i) kd_[kto(g * 16) + i * CH_LDS + tt] = f2bf(x_[i] * et_); } \
        { const int dt_ = wave - 4; f32x16 a_; \
            _Pragma("unroll") for (int i = 0; i < 16; ++i) a_[i] = 0.f; \
            _Pragma("unroll") for (int kb = 0; kb < 2; ++kb) a_ = MFMA32(frag_n((const bf16_t*)(sl_ + GD_KT) + kto(dt_ * 32 + r), 0, 0, hf, kb), frag_n((const bf16_t*)(sl_ + GD_TK), CH_LDS, r, hf, kb), a_); \
            _Pragma("unroll") for (int i4 = 0; i4 < 4; ++i4) { unsigned lo_, hi_;     \
                asm volatile("s_nop 7\n\ts_nop 7\n\tv_cvt_pk_bf16_f32 %0, %2, %3\n\tv_cvt_pk_bf16_f32 %1, %4, %5" : "=&v"(lo_), "=&v"(hi_) : "v"(a_[4 * i4]), "v"(a_[4 * i4 + 1]), "v"(a_[4 * i4 + 2]), "v"(a_[4 * i4 + 3])); \
                *(u32x2*)(sl_ + GD_W + (r * CH_LDQ + 32 * dt_ + 8 * i4 + 4 * hf) * 2) = (u32x2){lo_, hi_}; } } } } while (0)
    if (wave >= 4) { issue_gdn_chunk(p, h, qtr, row0, L, nch, 0, ptid, sr); GD_P1(0); }
    BARRIER_LDS();
    GD_P2(0);
    BARRIER_LDS();
#pragma unroll 1
    for (int j = 0; j < nch; ++j) {
        if (wave == 0) {
            const unsigned char* sl = lb + (j & 1) * GD_SLOT; const float* sc = (const float*)(sl + GD_SC);
            const bf16_t* wq = (const bf16_t*)(sl + GD_W); const bf16_t* qg = (const bf16_t*)(sl + GD_Q); const bf16_t* tv = (const bf16_t*)(sl + GD_TV); const bf16_t* vt = (const bf16_t*)(sl + GD_VT);
            const bf16_t* qkd = (const bf16_t*)(sl + GD_QKD); const bf16_t* kdt = (const bf16_t*)(sl + GD_KDT);
            f32x16 U, O;
#pragma unroll
            for (int i = 0; i < 16; ++i) { U[i] = 0.f; O[i] = 0.f; }
#pragma unroll
            for (int dt = 0; dt < 4; ++dt)
#pragma unroll
                for (int u = 0; u < 2; ++u) { const bf16x8 sb = pack_step(S[dt], u);
                    U = MFMA32(frag_p(wq, CH_LDQ, r, hf, 32 * dt + 16 * u), sb, U); O = MFMA32(frag_p(qg, CH_LDQ, r, hf, 32 * dt + 16 * u), sb, O); }
            f32x16 Uv;
#pragma unroll
            for (int i = 0; i < 16; ++i) Uv[i] = 0.f;
#pragma unroll
            for (int kb = 0; kb < 2; ++kb) Uv = MFMA32(frag_n(tv, CH_LDS, r, hf, kb), frag_n(vt, CH_LDS, r, hf, kb), Uv);
#pragma unroll
            for (int i = 0; i < 16; ++i) U[i] = Uv[i] - U[i];
            bf16x8 ub[2]; ub[0] = pack_step(U, 0); ub[1] = pack_step(U, 1);
#pragma unroll
            for (int u = 0; u < 2; ++u) O = MFMA32(frag_p(qkd, CH_LDS, r, hf, 16 * u), ub[u], O);
            const float egt = sc[GS_EGT];
#pragma unroll
            for (int dt = 0; dt < 4; ++dt) {
#pragma unroll
                for (int i = 0; i < 16; ++i) S[dt][i] *= egt;
#pragma unroll
                for (int u = 0; u < 2; ++u) S[dt] = MFMA32(frag_p(kdt + kto(dt * 32 + r), 0, 0, hf, 16 * u), ub[u], S[dt]);
            }
            float* ob = (float*)(lb + GD_OB) + (j & 1) * 1024;
#pragma unroll
            for (int i = 0; i < 16; ++i) ob[crow(i, hf) * 32 + r] = O[i];
        } else if (wave >= 4) {
            if (j + 1 < nch) GD_P1(j + 1);
            if (j > 0) store_out_blk(P, row0, j - 1, L, cBV + h * 128 + qtr * 32, (const float*)(lb + GD_OB) + ((j - 1) & 1) * 1024, ptid);
        }
        BARRIER_LDS();
        if (j + 1 < nch) GD_P2(j + 1);
        BARRIER_LDS();
    }
    if (wave >= 4) store_out_blk(P, row0, nch - 1, L, cBV + h * 128 + qtr * 32, (const float*)(lb + GD_OB) + ((nch - 1) & 1) * 1024, ptid);
    if (wave == 0) {
        float* So = p.out + o_pS + ((size_t)(l * NB + bs) * 4 + h) * 16384;
#pragma unroll
        for (int dt = 0; dt < 4; ++dt)
#pragma unroll
            for (int i = 0; i < 16; ++i) So[(32 * dt + crow(i, hf)) * 128 + qtr * 32 + r] = S[dt][i];
    }
    __syncthreads();
#undef GD_P1
#undef GD_P2
}

__device__ __forceinline__ void scan_gdn(const Params& p, int l, bool samp, int bs, int h, int qtr, int row0, int L, float* lds) {
    const int tid = opaque_tid(p.wv); const bool cons = tid < 256; const int ptid = tid - 256;
    const int lane = tid & 63, w = (tid >> 6) & 3, s = lane & 7, cl = w * 8 + (lane >> 3), col = qtr * 32 + cl;
    bf16_t* P = (bf16_t*)(p.ws + OFF_P);
    f32x2 S[8];
#pragma unroll
    for (int e = 0; e < 8; ++e) S[e] = bc2(0.f);
    if (cons && samp) {
        const float* S0 = p.st_S + ((size_t)(l * NS + bs) * 4 + h) * 16384;
#pragma unroll
        for (int e = 0; e < 16; ++e) { const int d = (e >> 2) * 32 + s * 4 + (e & 3); S[e >> 1][e & 1] = S0[d * 128 + col]; }
    }
    const int nblk = (L + 31) >> 5;
    f32x4 k4[4][4];
    StageRegs sr{k4[0][0], k4[0][1], k4[0][2], k4[0][3], k4[1][0], k4[1][1], k4[1][2], k4[1][3]};
    if (!cons) { issue_gdn(p, h, qtr, row0, L, 0, ptid, sr); commit_gdn(L, 0, lds, ptid, sr); if (1 < nblk) issue_gdn(p, h, qtr, row0, L, 1, ptid, sr); }
    BARRIER_LDS();
    for (int jb = 0; jb < nblk; ++jb) {
        if (!cons) {
            if (jb + 1 < nblk) commit_gdn(L, jb + 1, lds, ptid, sr);
            if (jb + 2 < nblk) issue_gdn(p, h, qtr, row0, L, jb + 2, ptid, sr);
            if (jb > 0) store_out_blk(P, row0, jb - 1, L, cBV + h * 128 + qtr * 32, OB(lds, (jb - 1) & 1), ptid);
        } else {
            const float* qb = QB(lds, jb & 1); const float* kb = KB(lds, jb & 1); const float* vb = VB(lds, jb & 1); const float* sc = SCB(lds, jb & 1);
            float* ob = OB(lds, jb & 1);
            const int nt = min(32, L - jb * 32);
            f32x4 q4[4][4]; float vv[4], a[4], be[4]; f32x4 qk[4], kk[4];
#define GLOAD_Q(T0) do { _Pragma("unroll") for (int i = 0; i < 4; ++i) { const int t = (T0) + i; \
        _Pragma("unroll") for (int j = 0; j < 4; ++j) q4[i][j] = *(const f32x4*)(qb + t * 128 + j * 32 + s * 4); } } while (0)
#define GLOAD_K(T0) do { _Pragma("unroll") for (int i = 0; i < 4; ++i) { const int t = (T0) + i; \
        _Pragma("unroll") for (int j = 0; j < 4; ++j) k4[i][j] = *(const f32x4*)(kb + t * 128 + j * 32 + s * 4); } \
      _Pragma("unroll") for (int i = 0; i < 4; ++i) { const int t = (T0) + i; \
        const f32x2 gg = *(const f32x2*)(sc + t * 16); a[i] = gg[0]; be[i] = gg[1]; \
        qk[i] = *(const f32x4*)(sc + t * 16 + 4); kk[i] = *(const f32x4*)(sc + t * 16 + 8); vv[i] = vb[t * 32 + cl]; } } while (0)
            GLOAD_Q(0); GLOAD_K(0);
#pragma unroll 1
            for (int t0 = 0; t0 < nt; t0 += 4) {
                float dk[4], dq[4];
                const int tn = min(t0 + 4, 28);
                __builtin_amdgcn_sched_barrier(0);
#pragma unroll
                for (int i = 0; i < 4; ++i) {
                    f32x2 x = bc2(0.f), x2 = bc2(0.f), y = bc2(0.f), y2 = bc2(0.f);
#pragma unroll
                    for (int j = 0; j < 4; ++j) {
                        x = lo2(k4[i][j]) * S[2 * j] + x; x2 = hi2(k4[i][j]) * S[2 * j + 1] + x2;
                        y = lo2(q4[i][j]) * S[2 * j] + y; y2 = hi2(q4[i][j]) * S[2 * j + 1] + y2; }
                    x = x + x2; y = y + y2;
                    dk[i] = x[0] + x[1]; dq[i] = y[0] + y[1];
                }
                __builtin_amdgcn_sched_barrier(0);
                GLOAD_Q(tn);
                __builtin_amdgcn_sched_barrier(0);
#pragma unroll
                for (int i = 0; i < 4; ++i) { dk[i] = red8(dk[i]); dq[i] = red8(dq[i]); }
                const float A0 = a[0], A1 = A0 * a[1], A2 = A1 * a[2], A3 = A2 * a[3];
                const float r10 = a[1], r21 = a[2], r32 = a[3], r20 = r10 * a[2], r31 = r21 * a[3], r30 = r20 * a[3];
                const float u0 = be[0] * (vv[0] - A0 * dk[0]);
                const float u1 = be[1] * (vv[1] - A1 * dk[1] - r10 * kk[1][0] * u0);
                const float u2 = be[2] * (vv[2] - A2 * dk[2] - r20 * kk[2][0] * u0 - r21 * kk[2][1] * u1);
                const float u3 = be[3] * (vv[3] - A3 * dk[3] - r30 * kk[3][0] * u0 - r31 * kk[3][1] * u1 - r32 * kk[3][2] * u2);
                if (s == 0) {
                    ob[(t0 + 0) * 32 + cl] = A0 * dq[0] + qk[0][0] * u0;
                    ob[(t0 + 1) * 32 + cl] = A1 * dq[1] + r10 * qk[1][0] * u0 + qk[1][1] * u1;
                    ob[(t0 + 2) * 32 + cl] = A2 * dq[2] + r20 * qk[2][0] * u0 + r21 * qk[2][1] * u1 + qk[2][2] * u2;
                    ob[(t0 + 3) * 32 + cl] = A3 * dq[3] + r30 * qk[3][0] * u0 + r31 * qk[3][1] * u1 + r32 * qk[3][2] * u2 + qk[3][3] * u3;
                }
                const float c0 = r30 * u0, c1 = r31 * u1, c2 = r32 * u2, c3 = u3;
#pragma unroll
                for (int j = 0; j < 4; ++j) {
                    S[2 * j] = lo2(k4[3][j]) * bc2(c3) + (lo2(k4[2][j]) * bc2(c2) + (lo2(k4[1][j]) * bc2(c1) + (lo2(k4[0][j]) * bc2(c0) + S[2 * j] * bc2(A3))));
                    S[2 * j + 1] = hi2(k4[3][j]) * bc2(c3) + (hi2(k4[2][j]) * bc2(c2) + (hi2(k4[1][j]) * bc2(c1) + (hi2(k4[0][j]) * bc2(c0) + S[2 * j + 1] * bc2(A3)))); }
                __builtin_amdgcn_sched_barrier(0);
                GLOAD_K(tn);
            }
#undef GLOAD_Q
#undef GLOAD_K
        }
        BARRIER_LDS();
    }
    if (!cons) store_out_blk(P, row0, nblk - 1, L, cBV + h * 128 + qtr * 32, OB(lds, (nblk - 1) & 1), ptid);
    else {
        const size_t sh = samp ? (size_t)(l * NS + bs) * 4 + h : (size_t)(l * NB + bs) * 4 + h;
        float* So = p.out + (samp ? o_sS : o_pS) + sh * 16384;
#pragma unroll
        for (int e = 0; e < 16; ++e) { const int d = (e >> 2) * 32 + s * 4 + (e & 3); So[d * 128 + col] = S[e >> 1][e & 1]; }
    }
    BARRIER_LDS();
}

__device__ __forceinline__ void phase_scan(const Params& p, int l, float* lds) {
    for (int item = blockIdx.x; item < 256 + 4096; item += gridDim.x) {
        int qtr, h, bs, branch, row0, L; bool samp;
        if (item < 256) { qtr = item & 3; h = (item >> 2) & 3; bs = (item >> 4) & 7; branch = item >> 7; samp = false; row0 = bs * LPAD; L = LP; }
        else { const int j = item - 256; qtr = j & 3; h = (j >> 2) & 3; branch = (j >> 4) & 1; bs = j >> 5; samp = true; row0 = SROW0 + bs * 4; L = LS; }
        if (branch == 0) { if (samp) scan_mlstm(p, l, samp, bs, h, qtr, row0, L, lds); else scan_mlstm_chunk(p, l, bs, h, qtr, row0, L, (unsigned char*)lds); }
        else { if (samp) scan_gdn(p, l, samp, bs, h, qtr, row0, L, lds); else scan_gdn_chunk(p, l, bs, h, qtr, row0, L, (unsigned char*)lds); }
    }
}

__device__ __forceinline__ void phase_norm(const Params& p, int l) {
    const int tid = opaque_tid(p.wv); const int wave = tid >> 6, lane = tid & 63;
    bf16_t* P = (bf16_t*)(p.ws + OFF_P);
    const int part = lane >> 5, hh = (lane >> 3) & 3, g = lane & 7, ch0 = hh * 128 + g * 16;
    const int craw = (part ? cBV : cV) + ch0, cgate = (part ? cZ : cO) + ch0;
    const float* wn = part ? p.b_norm_w + l * 128 + g * 16 : p.a_norm_w + l * 512 + ch0;
    for (int row = blockIdx.x * 8 + wave; row < MROWS; row += gridDim.x * 8) {
        if (row < SROW0 && (row % LPAD) >= LP) continue;
        bf16_t* pr = P + (size_t)row * NP;
        float x[16], z[16];
        unpack8(*(const u32x4*)(pr + craw), x); unpack8(*(const u32x4*)(pr + craw + 8), x + 8);
        unpack8(*(const u32x4*)(pr + cgate), z); unpack8(*(const u32x4*)(pr + cgate + 8), z + 8);
        float sum = 0.f;
#pragma unroll
        for (int i = 0; i < 16; ++i) sum += x[i];
        float mean = red8(sum) * (1.f / 128.f);
        if (part) mean = 0.f;
        float s2 = 0.f;
#pragma unroll
        for (int i = 0; i < 16; ++i) { x[i] -= mean; s2 += x[i] * x[i]; }
        const float rstd = rsqrtf(red8(s2) * (1.f / 128.f) + 1e-6f);
        float y[16];
#pragma unroll
        for (int i = 0; i < 16; ++i) { const float sg = sigmoidf_(z[i]); y[i] = x[i] * rstd * wn[i] * (part ? z[i] * sg : sg); }
        u32x4 o0, o1;
        o0.x = pk2(y[0], y[1]); o0.y = pk2(y[2], y[3]); o0.z = pk2(y[4], y[5]); o0.w = pk2(y[6], y[7]);
        o1.x = pk2(y[8], y[9]); o1.y = pk2(y[10], y[11]); o1.z = pk2(y[12], y[13]); o1.w = pk2(y[14], y[15]);
        *(u32x4*)(pr + cgate) = o0; *(u32x4*)(pr + cgate + 8) = o1;
    }
}

__device__ __forceinline__ void phase_convact(const Params& p, int l) {
    bf16_t* U = (bf16_t*)(p.ws + OFF_P); const bf16_t* HB = (const bf16_t*)(p.ws + OFF_HB);
    const float* cw = p.fconv_w + (size_t)l * 3 * NU;
    constexpr int NCG = DFF / 8, NRG = MROWS / 32;
    const int tid = opaque_tid(p.wv);
    for (int it = blockIdx.x * NTHREADS + tid; it < NRG * NCG; it += gridDim.x * NTHREADS) {
        const int rg = it / NCG, cg_ = it - rg * NCG, c0 = cg_ * 8;
        float wa[3][8], wb[3][8];
#pragma unroll
        for (int j = 0; j < 3; ++j) {
            const f32x4 a0 = *(const f32x4*)(cw + j * NU + c0), a1 = *(const f32x4*)(cw + j * NU + c0 + 4);
            const f32x4 b0 = *(const f32x4*)(cw + j * NU + DFF + c0), b1 = *(const f32x4*)(cw + j * NU + DFF + c0 + 4);
#pragma unroll
            for (int i = 0; i < 4; ++i) { wa[j][i] = a0[i]; wa[j][4 + i] = a1[i]; wb[j][i] = b0[i]; wb[j][4 + i] = b1[i]; }
        }
        float a2[8], a1[8], b2[8], b1[8];
        const bool samp = rg >= SROW0 / 32;
#pragma unroll
        for (int i = 0; i < 8; ++i) { a2[i] = a1[i] = b2[i] = b1[i] = 0.f; }
        if (!samp && (rg % (LPAD / 32)) != 0) {
            const bf16_t* h0 = HB + (size_t)(rg - 1) * 2 * NU;
            unpack8(*(const u32x4*)(h0 + c0), a2); unpack8(*(const u32x4*)(h0 + NU + c0), a1);
            unpack8(*(const u32x4*)(h0 + DFF + c0), b2); unpack8(*(const u32x4*)(h0 + NU + DFF + c0), b1);
        }
#pragma unroll 4
        for (int i = 0; i < 32; ++i) {
            const int row = rg * 32 + i;
            if (samp && (i & 3) == 0) {
                const float* st = p.st_fconv + ((size_t)(l * NS + ((row - SROW0) >> 2)) * 2) * NU;
                const f32x4 x0 = *(const f32x4*)(st + c0), x1 = *(const f32x4*)(st + c0 + 4), y0 = *(const f32x4*)(st + NU + c0), y1 = *(const f32x4*)(st + NU + c0 + 4);
                const f32x4 u0 = *(const f32x4*)(st + DFF + c0), u1 = *(const f32x4*)(st + DFF + c0 + 4), v0 = *(const f32x4*)(st + NU + DFF + c0), v1 = *(const f32x4*)(st + NU + DFF + c0 + 4);
#pragma unroll
                for (int e = 0; e < 4; ++e) { a2[e] = x0[e]; a2[4 + e] = x1[e]; a1[e] = y0[e]; a1[4 + e] = y1[e]; b2[e] = u0[e]; b2[4 + e] = u1[e]; b1[e] = v0[e]; b1[4 + e] = v1[e]; }
            }
            bf16_t* ur = U + (size_t)row * NU;
            float a[8], b[8], hh[8];
            unpack8(*(const u32x4*)(ur + c0), a); unpack8(*(const u32x4*)(ur + DFF + c0), b);
#pragma unroll
            for (int e = 0; e < 8; ++e) {
                const float ca = wa[0][e] * a2[e] + wa[1][e] * a1[e] + wa[2][e] * a[e];
                const float cb = wb[0][e] * b2[e] + wb[1][e] * b1[e] + wb[2][e] * b[e];
                hh[e] = ca * sigmoidf_(ca) * cb;
                a2[e] = a1[e]; a1[e] = a[e]; b2[e] = b1[e]; b1[e] = b[e];
            }
            u32x4 o; o.x = pk2(hh[0], hh[1]); o.y = pk2(hh[2], hh[3]); o.z = pk2(hh[4], hh[5]); o.w = pk2(hh[6], hh[7]);
            *(u32x4*)(ur + c0) = o;
        }
    }
}

#ifndef PROBE
#define PROBE 0
#endif
constexpr int NPHASE = 2 + DEPTH * 11;
__global__ void __launch_bounds__(NTHREADS) fwd_kernel(Params pin) {
    extern __shared__ __attribute__((aligned(16))) unsigned char smem_raw[];
    Params p = pin; p.wv = __builtin_amdgcn_readfirstlane((int)(threadIdx.x >> 6));
    unsigned* bar = (unsigned*)(p.ws + OFF_BAR); const unsigned xcc = xb_xcc_id();
    volatile LAS unsigned* xst = (volatile LAS unsigned*)(LAS unsigned char*)(smem_raw + LDS_GEMM);
    if (threadIdx.x == 0) { xst[0] = 0u; xst[1] = 0u; (void)xb_add(&bar[XB_XCNT(xcc)], 1u); }
    __syncthreads();
    float* lds = (float*)smem_raw;
    bf16_t* X = (bf16_t*)(p.ws + OFF_X); bf16_t* P = (bf16_t*)(p.ws + OFF_P); bf16_t* HB = (bf16_t*)(p.ws + OFF_HB);
    for (int ph = p.ph_lo; ph < p.ph_hi; ++ph) {
#if PROBE == 3
      for (int rep = 0; rep < 2; ++rep) { const int sx = ph < 2 ? -1 : (ph - 2) % 11; if (rep == 1 && !(ph < 2 || sx == 6 || sx == 10)) break;
#endif
        if (ph == 0) phase_weights(p, lds);
        else if (ph == 1) phase_ln(p, 0, nullptr, 0, p.ln_emb_g, p.ln_emb_b, 0, false);
        else {
            const int l = (ph - 2) / 11, s = (ph - 2) % 11;
            if (s == 0) { GemmArgs g{X, X, 1 << 30, D, w_inT(p, l), MROWS, NP, 1024}; gemm_phase(g, EpiP{P, (bf16_t*)(p.ws + OFF_GH), p.out, l}, p.wv); }
            else if (s == 1) phase_prep(p, l, lds);
            else if (s == 2) phase_scan(p, l, lds);
            else if (s == 3) phase_norm(p, l);
            else if (s == 4) { GemmArgs g{P + cO, P + cZ, 4, NP, w_abT(p, l), MROWS, 2048, 512}; gemm_phase(g, EpiMerge{P}, p.wv); }
            else if (s == 5) { GemmArgs g{P + cMG, P + cMG, 1 << 30, NP, w_outT(p, l), MROWS, 1024, 2048, 1}; gemm_phase(g, EpiRes{X, P, NP, 0, (bf16_t*)(p.ws + OFF_GH)}, p.wv); }
            else if (s == 6) phase_ln(p, 1, P, NP, p.ln1_g + l * D, p.ln1_b + l * D, -1, false);
            else if (s == 7) { GemmArgs g{X, X, 1 << 30, D, w_upT(p, l), MROWS, NU, 1024}; gemm_phase(g, EpiUp{P, HB, p.out, l}, p.wv); }
            else if (s == 8) phase_convact(p, l);
            else if (s == 9) { GemmArgs g{P, P, 1 << 30, NU, w_dnT(p, l), MROWS, 1024, DFF, 1}; gemm_phase(g, EpiRes{X, P, NU, DFF, (bf16_t*)(p.ws + OFF_GH)}, p.wv); }
            else phase_ln(p, 1, P + DFF, NU, p.ln2_g + l * D, p.ln2_b + l * D, l + 1 < DEPTH ? l + 1 : -1, l + 1 == DEPTH);
        }
#if PROBE == 3
      }
#endif
        if (ph + 1 < p.ph_hi) { if (ph == 0) cg::this_grid().sync(); else xcd_barrier(bar, xcc, xst, p.wv); }
    }
#if PROBE == 4
    for (int i = 0; i < 20; ++i) xcd_barrier(bar, xcc, xst, p.wv);
#endif
}

extern "C" void kernel_launch(void* const* d_in, const int* in_sizes, int n_in, void* d_out, int out_size, void* d_ws, size_t ws_size, hipStream_t stream) {
    static int grid = 0;
    if (grid == 0) {
        if (n_in != 28 || (size_t)out_size != o_end || ws_size < WS_END) { fprintf(stderr, "kernel_launch: unexpected sizes n_in %d out %d ws %zu (need %zu)\n", n_in, out_size, ws_size, (size_t)WS_END); grid = -1; return; }
        int dev = 0, cus = 0, per_cu = 0;
        hipGetDevice(&dev); hipDeviceGetAttribute(&cus, hipDeviceAttributeMultiprocessorCount, dev);
        if (hipFuncSetAttribute((const void*)fwd_kernel, hipFuncAttributeMaxDynamicSharedMemorySize, LDS_BYTES) != hipSuccess) { fprintf(stderr, "hipFuncSetAttribute failed\n"); grid = -1; return; }
        if (hipOccupancyMaxActiveBlocksPerMultiprocessor(&per_cu, (const void*)fwd_kernel, NTHREADS, LDS_BYTES) != hipSuccess || per_cu < 1) { fprintf(stderr, "occupancy query failed (%d)\n", per_cu); (void)hipGetLastError(); per_cu = 1; }
        grid = cus * per_cu;
        if (grid > 256) grid = 256;
    }
    if (grid < 0) return;
    if (hipMemsetAsync((unsigned char*)d_ws + OFF_BAR, 0, 16384, stream) != hipSuccess) { fprintf(stderr, "memset of barrier words failed\n"); return; }
    Params p{};
    const float** pp = (const float**)&p;
    for (int i = 0; i < 28; ++i) pp[i] = (const float*)d_in[i];
    p.out = (float*)d_out; p.ws = (unsigned char*)d_ws;
#if MULTI
    for (int ph = 0; ph < NPHASE; ++ph) { p.ph_lo = ph; p.ph_hi = ph + 1; hipLaunchKernelGGL(fwd_kernel, dim3(grid), dim3(NTHREADS), LDS_BYTES, stream, p); }
#else
    p.ph_lo = 0; p.ph_hi = NPHASE;
    void* args[] = {&p};
    hipError_t e = hipLaunchCooperativeKernel((const void*)fwd_kernel, dim3(grid), dim3(NTHREADS), args, LDS_BYTES, stream);
    if (e != hipSuccess) fprintf(stderr, "cooperative launch failed: %s (grid %d)\n", hipGetErrorString(e), grid);
#endif
}
```

```cpp
#include <hip/hip_runtime.h>
#include <hip/hip_cooperative_groups.h>
#include <cstdio>
namespace cg = cooperative_groups;

#ifndef MULTI
#define MULTI 0
#endif

typedef unsigned short bf16_t;
typedef short bf16x8 __attribute__((ext_vector_type(8)));
typedef float f32x4 __attribute__((ext_vector_type(4)));
typedef float f32x2 __attribute__((ext_vector_type(2)));
typedef unsigned u32x2 __attribute__((ext_vector_type(2)));
typedef unsigned u32x4 __attribute__((ext_vector_type(4)));

constexpr int D = 1024, NB = 8, LP = 2064, LPAD = 2080, NS = 128, LS = 4, DEPTH = 2, NMETA = 16, SEQ = 2048;
constexpr int MROWS = NB * LPAD + NS * LS;
constexpr int SROW0 = NB * LPAD;
constexpr int NIN = 6160, NP = 6144, DFF = 2816, NU = 5632;
constexpr int cQ = 0, cK = 512, cV = 1024, cO = 1536, cBQ = 2048, cBK = 2560, cBV = 3072, cZ = 3584, cMG = 4096;
constexpr float ALPHA = 1.4142135623730951f;
constexpr int SPLIT_ROW0 = 64 * 256;
constexpr int NTHREADS = 512;
constexpr int LDS_GEMM = 131072;
constexpr int LDS_BYTES = LDS_GEMM + 256;

constexpr size_t W_IN = (size_t)NP * 1024, W_AB = 2048 * 512, W_OUT = 1024 * 2048, W_UP = (size_t)NU * 1024, W_DN = (size_t)1024 * DFF;
constexpr size_t W_LAYER = W_IN + W_AB + W_OUT + W_UP + W_DN;
constexpr size_t OFF_W = 0;
constexpr size_t OFF_WG = OFF_W + DEPTH * W_LAYER * 2;
constexpr size_t OFF_X = OFF_WG + DEPTH * 16 * 1024 * 4;
constexpr size_t OFF_G = OFF_X + (size_t)MROWS * D * 2;
constexpr size_t OFF_HB = OFF_G + (size_t)MROWS * 16 * 4;
constexpr size_t OFF_P = OFF_HB + (size_t)(MROWS / 32) * 2 * NU * 2;
constexpr size_t OFF_GH = OFF_P + (size_t)MROWS * NP * 2;
constexpr size_t OFF_REC = OFF_GH + (size_t)(MROWS / 32) * 3 * 1536 * 2;
constexpr size_t OFF_BAR = OFF_REC + (size_t)MROWS * 4 * 16 * 4;
constexpr size_t OFF_TB = OFF_BAR + 16384;
constexpr size_t WS_END = OFF_TB + (size_t)(MROWS / 32) * 4 * 3 * 1024 * 2;

constexpr size_t o_yp = 0;
constexpr size_t o_ys = o_yp + (size_t)NB * SEQ * D;
constexpr size_t o_pC = o_ys + (size_t)NS * LS * D;
constexpr size_t o_pn = o_pC + (size_t)DEPTH * NB * 4 * 128 * 128;
constexpr size_t o_pm = o_pn + (size_t)DEPTH * NB * 4 * 128;
constexpr size_t o_pS = o_pm + (size_t)DEPTH * NB * 4;
constexpr size_t o_pgc = o_pS + (size_t)DEPTH * NB * 4 * 128 * 128;
constexpr size_t o_pfc = o_pgc + (size_t)DEPTH * NB * 3 * 1536;
constexpr size_t o_sC = o_pfc + (size_t)DEPTH * NB * 2 * NU;
constexpr size_t o_sn = o_sC + (size_t)DEPTH * NS * 4 * 128 * 128;
constexpr size_t o_sm = o_sn + (size_t)DEPTH * NS * 4 * 128;
constexpr size_t o_sS = o_sm + (size_t)DEPTH * NS * 4;
constexpr size_t o_sgc = o_sS + (size_t)DEPTH * NS * 4 * 128 * 128;
constexpr size_t o_sfc = o_sgc + (size_t)DEPTH * NS * 3 * 1536;
constexpr size_t o_end = o_sfc + (size_t)DEPTH * NS * 2 * NU;

struct Params {
    const float* x_prompt; const float* x_sample; const float* st_C; const float* st_n; const float* st_m; const float* st_S;
    const float* st_gconv; const float* st_fconv; const float* meta; const float* ln_emb_g; const float* ln_emb_b; const float* w_in;
    const float* gate_bias; const float* a_norm_w; const float* gconv_w; const float* A_log; const float* dt_bias; const float* b_norm_w;
    const float* w_pa; const float* w_pb; const float* w_out; const float* ln1_g; const float* ln1_b; const float* w_up;
    const float* fconv_w; const float* w_down; const float* ln2_g; const float* ln2_b;
    float* out; unsigned char* ws;
    int ph_lo, ph_hi;
    int wv, pad_;
};

__device__ __forceinline__ int opaque_tid(int wv) { int lane; asm volatile("v_mbcnt_lo_u32_b32 %0, -1, 0\n\tv_mbcnt_hi_u32_b32 %0, -1, %0" : "=v"(lane)); return wv * 64 + lane; }
__device__ __forceinline__ float bflo(unsigned u) { return __uint_as_float(u << 16); }
__device__ __forceinline__ float bfhi(unsigned u) { return __uint_as_float(u & 0xffff0000u); }
__device__ __forceinline__ unsigned pk2(float lo, float hi) { unsigned r; asm("v_cvt_pk_bf16_f32 %0, %1, %2" : "=v"(r) : "v"(lo), "v"(hi)); return r; }
template <int CTRL> __device__ __forceinline__ float dppf(float v) { return __int_as_float(__builtin_amdgcn_update_dpp(0, __float_as_int(v), CTRL, 0xf, 0xf, true)); }
__device__ __forceinline__ float red8(float v) { v += dppf<0xB1>(v); v += dppf<0x4E>(v); v += dppf<0x141>(v); return v; }
__device__ __forceinline__ float red16(float v) { v = red8(v); v += dppf<0x140>(v); return v; }
__device__ __forceinline__ float rdl(float v, int l) { return __int_as_float(__builtin_amdgcn_readlane(__float_as_int(v), l)); }
__device__ __forceinline__ float rdl_pin(float v, int l) { float r_; asm volatile("v_readlane_b32 %0, %1, %2" : "=s"(r_) : "v"(v), "s"(l)); return r_; }
__device__ __forceinline__ float red64(float v) { v = red16(v); return (rdl(v, 0) + rdl(v, 16)) + (rdl(v, 32) + rdl(v, 48)); }
__device__ __forceinline__ float sigmoidf_(float x) { return __builtin_amdgcn_rcpf(1.f + __expf(-x)); }
__device__ __forceinline__ u32x4 pack8(const float* y) { u32x4 o; o.x = pk2(y[0], y[1]); o.y = pk2(y[2], y[3]); o.z = pk2(y[4], y[5]); o.w = pk2(y[6], y[7]); return o; }
__device__ __forceinline__ void unpack8(u32x4 a, float* x) { x[0] = bflo(a.x); x[1] = bfhi(a.x); x[2] = bflo(a.y); x[3] = bfhi(a.y); x[4] = bflo(a.z); x[5] = bfhi(a.z); x[6] = bflo(a.w); x[7] = bfhi(a.w); }


#define XB_TMO      128
#define XB_XCNT(j)  (256  + 64 * (j))
#define XB_XSUB(j)  (1280 + 64 * (j))
#define XB_XGEN(j)  (2304 + 64 * (j))
#define XB_TOP      3328
#define XB_TOPGEN   3392
#define XCD_BAR_WORDS 3456
#define XB_SPIN_CAP (1u << 18)
#define LAS __attribute__((address_space(3)))
__device__ __forceinline__ unsigned xb_ld(unsigned* p)              { return __hip_atomic_load(p, __ATOMIC_RELAXED, __HIP_MEMORY_SCOPE_AGENT); }
__device__ __forceinline__ unsigned xb_add(unsigned* p, unsigned v) { return __hip_atomic_fetch_add(p, v, __ATOMIC_RELAXED, __HIP_MEMORY_SCOPE_AGENT); }
__device__ __forceinline__ unsigned xb_xcc_id() { return (unsigned)__builtin_amdgcn_s_getreg((3 << 11) | 20) & 0xFu; }
#define XB_SPIN(cond, bar) do { unsigned _sp = 0; while (cond) { __builtin_amdgcn_s_sleep(1); \
    if ((++_sp & 255u) == 0u) { if (xb_ld(&(bar)[XB_TMO])) break; if (_sp > XB_SPIN_CAP) { atomicAdd(&(bar)[XB_TMO], 1u); break; } } } } while (0)
__device__ __forceinline__ void xcd_barrier_complete(unsigned* bar, unsigned x, unsigned& nloc, unsigned& nx) {
    const unsigned G = gridDim.x;
    unsigned sum, cnt, mine, sp = 0u;
    for (;;) {
        sum = 0u; cnt = 0u; mine = 0u;
#pragma unroll
        for (unsigned j = 0; j < 16; ++j) { const unsigned c = xb_ld(&bar[XB_XCNT(j)]); sum += c; cnt += (c > 0u) ? 1u : 0u; mine = (j == x) ? c : mine; }
        if (sum == G) break;
        __builtin_amdgcn_s_sleep(1);
        if ((++sp & 255u) == 0u) { if (xb_ld(&bar[XB_TMO])) break; if (sp > XB_SPIN_CAP) { atomicAdd(&bar[XB_TMO], 1u); break; } }
    }
    nloc = mine > 0u ? mine : 1u; nx = cnt > 0u ? cnt : 1u;
}
__device__ __forceinline__ void xcd_barrier(unsigned* bar, unsigned x, volatile LAS unsigned* st, int wv) {
    asm volatile("s_waitcnt vmcnt(0)" ::: "memory");
    __syncthreads();
    if (opaque_tid(wv) == 0) {
        __builtin_amdgcn_s_waitcnt(0);
        unsigned nloc = st[0], nx = st[1];
        if (nloc == 0u) { xcd_barrier_complete(bar, x, nloc, nx); st[0] = nloc; st[1] = nx; }
        const unsigned old = xb_add(&bar[XB_XSUB(x)], 1u);
        const unsigned gen = old / nloc;
        if (old + 1u == (gen + 1u) * nloc) {
            __builtin_amdgcn_fence(__ATOMIC_RELEASE, "agent");
            asm volatile("s_waitcnt vmcnt(0)" ::: "memory");
            const unsigned og = xb_add(&bar[XB_TOP], 1u);
            const unsigned tg = og / nx;
            if (og + 1u == (tg + 1u) * nx) xb_add(&bar[XB_TOPGEN], 1u);
            else XB_SPIN(xb_ld(&bar[XB_TOPGEN]) == tg, bar);
            __builtin_amdgcn_fence(__ATOMIC_ACQUIRE, "agent");
            xb_add(&bar[XB_XGEN(x)], 1u);
            asm volatile("s_waitcnt vmcnt(0)" ::: "memory");
        } else {
            XB_SPIN(xb_ld(&bar[XB_XGEN(x)]) == gen, bar);
            __builtin_amdgcn_fence(__ATOMIC_ACQUIRE, "agent");
            asm volatile("s_waitcnt vmcnt(0)" ::: "memory");
        }
    }
    __syncthreads();
}

struct TJob { const float* src; int ldw; int K; int N; bf16_t* dst; int ldt; };
__device__ __forceinline__ void transpose_item(const TJob& jb, int item, float* scr, int lane) {
    const int nblk = jb.N / 32, kb = item / nblk, nb = item % nblk, k0 = 64 * kb, n0 = 32 * nb;
#pragma unroll 8
    for (int i = 0; i < 32; ++i) { const int kk = 2 * i + (lane >> 5); scr[kk * 33 + (lane & 31)] = jb.src[(size_t)(k0 + kk) * jb.ldw + n0 + (lane & 31)]; }
    __builtin_amdgcn_s_waitcnt(0xc07f); asm volatile("" ::: "memory");
    const int c = lane & 7;
#pragma unroll
    for (int j = 0; j < 4; ++j) { const int n = (lane >> 3) + 8 * j; const float* s = scr + (8 * c) * 33 + n;
        u32x4 o; o.x = pk2(s[0 * 33], s[1 * 33]); o.y = pk2(s[2 * 33], s[3 * 33]); o.z = pk2(s[4 * 33], s[5 * 33]); o.w = pk2(s[6 * 33], s[7 * 33]);
        *(u32x4*)(jb.dst + (size_t)(n0 + n) * jb.ldt + k0 + 8 * c) = o; }
    __builtin_amdgcn_s_waitcnt(0xc07f); asm volatile("" ::: "memory");
}
__device__ __forceinline__ bf16_t* wl(const Params& p, int l) { return (bf16_t*)(p.ws + OFF_W) + (size_t)l * W_LAYER; }
__device__ __forceinline__ bf16_t* w_inT(const Params& p, int l) { return wl(p, l); }
__device__ __forceinline__ bf16_t* w_abT(const Params& p, int l) { return wl(p, l) + W_IN; }
__device__ __forceinline__ bf16_t* w_outT(const Params& p, int l) { return wl(p, l) + W_IN + W_AB; }
__device__ __forceinline__ bf16_t* w_upT(const Params& p, int l) { return wl(p, l) + W_IN + W_AB + W_OUT; }
__device__ __forceinline__ bf16_t* w_dnT(const Params& p, int l) { return wl(p, l) + W_IN + W_AB + W_OUT + W_UP; }

__device__ __forceinline__ void phase_weights(const Params& p, float* lds) {
    const int tid = opaque_tid(p.wv); const int wave = tid >> 6, lane = tid & 63;
    float* scr = lds + wave * (64 * 33);
    const int gw = blockIdx.x * 8 + wave, NGW = gridDim.x * 8;
    constexpr int I0 = 16 * 64, I1 = 16 * 64, I2 = 16 * 64, I3 = 8 * 32, I4 = 8 * 32, I5 = 16 * 32, I6 = 16 * 32, I7 = 16 * (NU / 32), I8 = (DFF / 64) * 32;
    constexpr int IL = I0 + I1 + I2 + I3 + I4 + I5 + I6 + I7 + I8;
    for (int it = gw; it < DEPTH * IL; it += NGW) {
        const int l = it / IL; int r = it % IL;
        TJob jb;
        const float* win = p.w_in + (size_t)l * 1024 * NIN;
        if (r < I0) { jb = {win, NIN, 1024, 2048, w_inT(p, l), 1024}; }
        else if ((r -= I0) < I1) { jb = {win + 2056, NIN, 1024, 2048, w_inT(p, l) + (size_t)2048 * 1024, 1024}; }
        else if ((r -= I1) < I2) { jb = {win + 4112, NIN, 1024, 2048, w_inT(p, l) + (size_t)4096 * 1024, 1024}; }
        else if ((r -= I2) < I3) { jb = {p.w_pa + (size_t)l * 512 * 1024, 1024, 512, 1024, w_abT(p, l), 512}; }
        else if ((r -= I3) < I4) { jb = {p.w_pb + (size_t)l * 512 * 1024, 1024, 512, 1024, w_abT(p, l) + (size_t)1024 * 512, 512}; }
        else if ((r -= I4) < I5) { jb = {p.w_out + (size_t)l * 1024 * 1024, 1024, 1024, 1024, w_outT(p, l), 2048}; }
        else if ((r -= I5) < I6) { jb = {p.w_out + (size_t)l * 1024 * 1024, 1024, 1024, 1024, w_outT(p, l) + 1024, 2048}; }
        else if ((r -= I6) < I7) { jb = {p.w_up + (size_t)l * 1024 * NU, NU, 1024, NU, w_upT(p, l), 1024}; }
        else { r -= I7; jb = {p.w_down + (size_t)l * DFF * 1024, 1024, DFF, 1024, w_dnT(p, l), DFF}; }
        transpose_item(jb, r, scr, lane);
    }
    float* wg = (float*)(p.ws + OFF_WG);
    for (int i = blockIdx.x * NTHREADS + tid; i < DEPTH * 16 * 1024; i += gridDim.x * NTHREADS) {
        const int l = i >> 14, g = (i >> 10) & 15, k = i & 1023;
        const int col = g < 8 ? 2048 + g : 4104 + (g - 8);
        wg[i] = p.w_in[((size_t)l * 1024 + k) * NIN + col];
    }
}

__device__ __forceinline__ void phase_ln(const Params& p, int mode, const bf16_t* src, int ldsrc, const float* gam, const float* bet,
                                         int gate_layer  , bool final_out) {
    const int tid = opaque_tid(p.wv); const int wave = tid >> 6, lane = tid & 63;
    bf16_t* X = (bf16_t*)(p.ws + OFF_X);
    float* G = (float*)(p.ws + OFF_G);
    const float* wg = (const float*)(p.ws + OFF_WG) + (size_t)(gate_layer < 0 ? 0 : gate_layer) * 16 * 1024;
    for (int row = blockIdx.x * 8 + wave; row < MROWS; row += gridDim.x * 8) {
        int b = 0, t = 0; bool samp = row >= SROW0;
        if (!samp) { b = row / LPAD; t = row - b * LPAD; } else { b = (row - SROW0) >> 2; t = row & 3; }
        const bool valid = samp || t < LP;
        bf16_t* xo = X + (size_t)row * D;
        if (!valid) { if (mode == 0) {
#pragma unroll
                for (int j = 0; j < 4; ++j) *(u32x2*)(xo + 256 * j + lane * 4) = (u32x2){0u, 0u}; }
            continue; }
        f32x4 v[4];
        if (mode == 0) {
            const float* s = samp ? p.x_sample + ((size_t)b * LS + t) * D : (t < NMETA ? p.meta + (size_t)t * D : p.x_prompt + ((size_t)b * SEQ + (t - NMETA)) * D);
#pragma unroll
            for (int j = 0; j < 4; ++j) v[j] = *(const f32x4*)(s + 256 * j + lane * 4);
        } else {
            const bf16_t* s = src + (size_t)row * ldsrc;
#pragma unroll
            for (int j = 0; j < 4; ++j) { u32x2 u = *(const u32x2*)(s + 256 * j + lane * 4); v[j] = (f32x4){bflo(u.x), bfhi(u.x), bflo(u.y), bfhi(u.y)}; }
            if (row >= SPLIT_ROW0) { const bf16_t* sp = (const bf16_t*)(p.ws + OFF_GH) + (size_t)(row - SPLIT_ROW0) * D;
#pragma unroll
                for (int q = 0; q < 3; ++q)
#pragma unroll
                    for (int j = 0; j < 4; ++j) { const u32x2 u = *(const u32x2*)(sp + (size_t)q * (MROWS - SPLIT_ROW0) * D + 256 * j + lane * 4); v[j] += (f32x4){bflo(u.x), bfhi(u.x), bflo(u.y), bfhi(u.y)}; } }
        }
        float sum = 0.f;
#pragma unroll
        for (int j = 0; j < 4; ++j) sum += (v[j][0] + v[j][1]) + (v[j][2] + v[j][3]);
        const float mean = red64(sum) * (1.f / D);
        float s2 = 0.f;
#pragma unroll
        for (int j = 0; j < 4; ++j) { v[j] = v[j] - mean; s2 += (v[j][0] * v[j][0] + v[j][1] * v[j][1]) + (v[j][2] * v[j][2] + v[j][3] * v[j][3]); }
        const float rstd = rsqrtf(red64(s2) * (1.f / D) + 1e-5f);
#pragma unroll
        for (int j = 0; j < 4; ++j) { const f32x4 g4 = *(const f32x4*)(gam + 256 * j + lane * 4), b4 = *(const f32x4*)(bet + 256 * j + lane * 4);
            v[j] = v[j] * rstd * g4 + b4;
            *(u32x2*)(xo + 256 * j + lane * 4) = (u32x2){pk2(v[j][0], v[j][1]), pk2(v[j][2], v[j][3])}; }
        if (final_out) {
            float* o = nullptr;
            if (samp) o = p.out + o_ys + ((size_t)b * LS + t) * D; else if (t >= NMETA) o = p.out + o_yp + ((size_t)b * SEQ + (t - NMETA)) * D;
            if (o) {
#pragma unroll
                for (int j = 0; j < 4; ++j) *(f32x4*)(o + 256 * j + lane * 4) = v[j]; }
        }
        if (gate_layer >= 0) {
            float mine = 0.f;
#pragma unroll 2
            for (int g = 0; g < 16; ++g) {
                float a = 0.f;
#pragma unroll
                for (int j = 0; j < 4; ++j) { const f32x4 w4 = *(const f32x4*)(wg + g * 1024 + 256 * j + lane * 4); a += (v[j][0] * w4[0] + v[j][1] * w4[1]) + (v[j][2] * w4[2] + v[j][3] * w4[3]); }
                a = red64(a);
                if (lane == g) mine = a;
            }
            if (lane < 16) G[(size_t)row * 16 + lane] = mine;
        }
    }
}

constexpr int BM = 256, BK = 64, HALF = 128, HT = HALF * BK, NXCD = 8, WGM = 8;
__device__ __forceinline__ int lds_byte(int r, int c) { int st = (r >> 4) * 2 + (c >> 5), rr = r & 15, cc = c & 31, ob = rr * 64 + cc * 2; return st * 1024 + (ob ^ (((ob >> 9) & 1) << 5)); }
__device__ __forceinline__ void stage_rc(int b, int& R, int& C) { int st = b / 1024, sb = b % 1024, swz = sb ^ (((sb >> 9) & 1) << 5); R = (st >> 1) * 16 + swz / 64; C = (st & 1) * 32 + (swz % 64) / 2; }

struct GemmArgs { const bf16_t* A; const bf16_t* A2; int a2_from_pn; int lda; const bf16_t* Bt; int M, N, K; int splitk; };

template <class Epi>
__device__ __forceinline__ void gemm_phase(const GemmArgs g, const Epi& epi, int wv) {
    extern __shared__ __attribute__((aligned(16))) unsigned char smem_raw[];
    bf16_t* shm = (bf16_t*)smem_raw;
#define SA(b, h) (shm + ((b) * 2 + (h)) * HT)
#define SB(b, h) (shm + (4 + (b) * 2 + (h)) * HT)
#define STAGE_A(P_, br, kt) do { const char* _gb = (const char*)(A + (size_t)(br) * lda + (size_t)((kt) + kofs) * BK); \
    unsigned _o0 = offA0, _o1 = offA1; asm volatile("" : "+v"(_o0), "+v"(_o1)); \
    __builtin_amdgcn_global_load_lds((const unsigned*)(_gb + _o0), (unsigned*)((char*)(P_) + tid * 16), 16, 0, 0); \
    __builtin_amdgcn_global_load_lds((const unsigned*)(_gb + _o1), (unsigned*)((char*)(P_) + tid * 16 + 8192), 16, 0, 0); } while (0)
#define STAGE_B(P_, bc, kt) do { const char* _gb = (const char*)(Bt + (size_t)(bc) * K + (size_t)((kt) + kofs) * BK); \
    unsigned _o0 = offB0, _o1 = offB1; asm volatile("" : "+v"(_o0), "+v"(_o1)); \
    __builtin_amdgcn_global_load_lds((const unsigned*)(_gb + _o0), (unsigned*)((char*)(P_) + tid * 16), 16, 0, 0); \
    __builtin_amdgcn_global_load_lds((const unsigned*)(_gb + _o1), (unsigned*)((char*)(P_) + tid * 16 + 8192), 16, 0, 0); } while (0)
#define LDA(dst, b, h) for (int m = 0; m < 4; ++m) for (int k = 0; k < 2; ++k) \
    dst[m][k] = *reinterpret_cast<const bf16x8*>((char*)SA(b, h) + lds_byte(wr * 64 + m * 16 + fr, k * 32 + fq * 8))
#define LDB(dst, b, h) for (int n = 0; n < 2; ++n) for (int k = 0; k < 2; ++k) \
    dst[n][k] = *reinterpret_cast<const bf16x8*>((char*)SB(b, h) + lds_byte(wc * 32 + n * 16 + fr, k * 32 + fq * 8))
#define MMA(ai, bj, At_, Bt_) do { __builtin_amdgcn_s_setprio(1); \
    for (int m = 0; m < 4; ++m) for (int n = 0; n < 2; ++n) for (int k = 0; k < 2; ++k) \
      acc[ai][bj][m][n] = __builtin_amdgcn_mfma_f32_16x16x32_bf16(Bt_[n][k], At_[m][k], acc[ai][bj][m][n], 0, 0, 0); \
    __builtin_amdgcn_s_setprio(0); } while (0)
#define WAIT_V(n) asm volatile("s_waitcnt vmcnt(" #n ")" ::: "memory")
#define WAIT_L(n) asm volatile("s_waitcnt lgkmcnt(" #n ")" ::: "memory")
#define BAR __builtin_amdgcn_s_barrier()
#define SCHED __builtin_amdgcn_sched_barrier(0)
    const int lda = g.lda, K = g.K; const bf16_t* Bt = g.Bt;
    const int nMall = g.M / BM, nN = g.N / BM, nM = g.splitk ? 64 : nMall, nwg = nM * nN, nunits = nwg + (nMall - nM) * nN * 4;
    const int tid = opaque_tid(wv);
    const int wid = tid >> 6, lane = tid & 63, wr = wid >> 2, wc = wid & 3, fr = lane & 15, fq = lane >> 4;
    const int ntK = K / BK;
    unsigned offA0, offA1, offB0, offB1;
    { int r0, c0, r1, c1; stage_rc(tid * 16, r0, c0); stage_rc(tid * 16 + 8192, r1, c1);
      offA0 = (unsigned)(r0 * lda + c0) * 2u; offA1 = (unsigned)(r1 * lda + c1) * 2u; offB0 = (unsigned)(r0 * K + c0) * 2u; offB1 = (unsigned)(r1 * K + c1) * 2u; }
    for (int Lt = blockIdx.x; Lt < nunits; Lt += gridDim.x) {
        int pm, pn, kofs = 0, nt = ntK, split = 0;
        if (Lt < nwg) {
            int wgid = Lt;
            { int q = nwg / NXCD, r = nwg % NXCD, xcd = wgid % NXCD, off = wgid / NXCD; wgid = (xcd < r ? xcd * (q + 1) : r * (q + 1) + (xcd - r) * q) + off; }
            const int nig = WGM * nN, gid = wgid / nig, fm = gid * WGM, gsz = min(nM - fm, WGM);
            pm = fm + ((wgid % nig) % gsz); pn = (wgid % nig) / gsz;
        } else {
            const int u = Lt - nwg, tl = u >> 2; split = u & 3; pm = nM + tl / nN; pn = tl % nN;
            const int q4 = ntK >> 2;
            if (q4 & 1) { nt = split < 2 ? q4 + 1 : q4 - 1; kofs = split < 2 ? split * (q4 + 1) : 2 * (q4 + 1) + (split - 2) * (q4 - 1); } else { nt = q4; kofs = split * q4; }
        }
        const int brow = pm * BM, bcol = pn * BM;
        const bf16_t* A = (pn >= g.a2_from_pn) ? g.A2 : g.A;
        f32x4 acc[2][2][4][2] = {};
        bf16x8 At[4][2], B0[2][2], B1[2][2];
        STAGE_B(SB(0, 0), bcol, 0); STAGE_A(SA(0, 0), brow, 0);
        STAGE_B(SB(0, 1), bcol + HALF, 0); STAGE_A(SA(0, 1), brow + HALF, 0);
        if (wr == 1) BAR;
        WAIT_V(4); BAR;
        STAGE_B(SB(1, 0), bcol, 1); STAGE_A(SA(1, 0), brow, 1); STAGE_B(SB(1, 1), bcol + HALF, 1);
        WAIT_V(6); BAR;
        for (int t = 0; t < nt - 2; t += 2) {
            LDB(B0, 0, 0); SCHED; LDA(At, 0, 0); STAGE_A(SA(1, 1), brow + HALF, t + 1);
            WAIT_L(8); BAR; WAIT_L(0); MMA(0, 0, At, B0); BAR; SCHED;
            LDB(B1, 0, 1); STAGE_B(SB(0, 0), bcol, t + 2);
            BAR; WAIT_L(0); MMA(0, 1, At, B1); BAR;
            LDA(At, 0, 1); STAGE_A(SA(0, 0), brow, t + 2);
            BAR; WAIT_L(0); MMA(1, 0, At, B0); BAR; SCHED;
            STAGE_B(SB(0, 1), bcol + HALF, t + 2);
            WAIT_V(6); BAR; MMA(1, 1, At, B1); BAR;
            LDB(B0, 1, 0); SCHED; LDA(At, 1, 0); STAGE_A(SA(0, 1), brow + HALF, t + 2);
            WAIT_L(8); BAR; WAIT_L(0); MMA(0, 0, At, B0); BAR; SCHED;
            LDB(B1, 1, 1); STAGE_B(SB(1, 0), bcol, t + 3);
            BAR; WAIT_L(0); MMA(0, 1, At, B1); BAR;
            LDA(At, 1, 1); STAGE_A(SA(1, 0), brow, t + 3);
            BAR; WAIT_L(0); MMA(1, 0, At, B0); BAR; SCHED;
            STAGE_B(SB(1, 1), bcol + HALF, t + 3);
            WAIT_V(6); BAR; MMA(1, 1, At, B1); BAR;
        }
        { LDB(B0, 0, 0); LDA(At, 0, 0); STAGE_A(SA(1, 1), brow + HALF, nt - 1);
          BAR; WAIT_L(0); MMA(0, 0, At, B0); BAR;
          LDB(B1, 0, 1); BAR; WAIT_L(0); MMA(0, 1, At, B1); BAR;
          LDA(At, 0, 1); WAIT_V(4); BAR; WAIT_L(0); MMA(1, 0, At, B0); MMA(1, 1, At, B1); BAR; }
        { LDB(B0, 1, 0); LDA(At, 1, 0); WAIT_V(2); BAR; WAIT_L(0); MMA(0, 0, At, B0); BAR;
          LDB(B1, 1, 1); WAIT_V(0); BAR; WAIT_L(0); MMA(0, 1, At, B1); BAR;
          LDA(At, 1, 1); BAR; WAIT_L(0); MMA(1, 0, At, B0); MMA(1, 1, At, B1); BAR; }
        if (wr == 0) BAR;
        int erow = brow + wr * 64 + fr, ecol = bcol + wc * 32 + fq * 4;
        asm volatile("" : "+v"(erow), "+v"(ecol));
#pragma unroll
        for (int ai = 0; ai < 2; ++ai)
#pragma unroll
            for (int m = 0; m < 4; ++m) {
                const int row = erow + ai * HALF + m * 16;
#pragma unroll
                for (int bj = 0; bj < 2; ++bj)
#pragma unroll
                    for (int n = 0; n < 2; ++n) epi(row, ecol + bj * HALF + n * 16, acc[ai][bj][m][n], split);
                if (m & 1) SCHED;
            }
        __syncthreads();
    }
#undef SA
#undef SB
}

struct EpiP {
    bf16_t* P; bf16_t* GH; float* out; int l;
    __device__ __forceinline__ void operator()(int row, int col, f32x4 v, int split) const {
        *(u32x2*)(P + (size_t)row * NP + col) = (u32x2){pk2(v[0], v[1]), pk2(v[2], v[3])};
        if (col >= cBQ && col < cZ) {
            const int c = col - cBQ;
            if ((row & 31) >= 29) *(u32x2*)(GH + ((size_t)(row >> 5) * 3 + ((row & 31) - 29)) * 1536 + c) = (u32x2){pk2(v[0], v[1]), pk2(v[2], v[3])};
            if (row < SROW0) { const int b = row / LPAD, t = row - b * LPAD; if (t >= LP - 3 && t < LP) *(f32x4*)(out + o_pgc + ((size_t)(l * NB + b) * 3 + (t - (LP - 3))) * 1536 + c) = v; }
            else { const int s = (row - SROW0) >> 2, t = row & 3; if (t >= 1) *(f32x4*)(out + o_sgc + ((size_t)(l * NS + s) * 3 + (t - 1)) * 1536 + c) = v; }
        }
    }
};
struct EpiMerge {
    bf16_t* P;
    __device__ __forceinline__ void operator()(int row, int col, f32x4 v, int split) const {
        u32x2* ptr = (u32x2*)(P + (size_t)row * NP + cMG + col); const u32x2 gm = *ptr;
        v[0] *= sigmoidf_(bflo(gm.x)); v[1] *= sigmoidf_(bfhi(gm.x)); v[2] *= sigmoidf_(bflo(gm.y)); v[3] *= sigmoidf_(bfhi(gm.y));
        *ptr = (u32x2){pk2(v[0], v[1]), pk2(v[2], v[3])};
    }
};
struct EpiRes {
    const bf16_t* X; bf16_t* O; int ldo; int ocol0; bf16_t* SCR;
    __device__ __forceinline__ void operator()(int row, int col, f32x4 v, int split) const {
        if (split == 0) {
            const u32x2 x = *(const u32x2*)(X + (size_t)row * D + col);
            v[0] += ALPHA * bflo(x.x); v[1] += ALPHA * bfhi(x.x); v[2] += ALPHA * bflo(x.y); v[3] += ALPHA * bfhi(x.y);
            *(u32x2*)(O + (size_t)row * ldo + ocol0 + col) = (u32x2){pk2(v[0], v[1]), pk2(v[2], v[3])};
        } else *(u32x2*)(SCR + ((size_t)(split - 1) * (MROWS - SPLIT_ROW0) + (row - SPLIT_ROW0)) * D + col) = (u32x2){pk2(v[0], v[1]), pk2(v[2], v[3])};
    }
};
struct EpiUp {
    bf16_t* U; bf16_t* HB; float* out; int l;
    __device__ __forceinline__ void operator()(int row, int col, f32x4 v, int split) const {
        const u32x2 o = (u32x2){pk2(v[0], v[1]), pk2(v[2], v[3])};
        *(u32x2*)(U + (size_t)row * NU + col) = o;
        if ((row & 31) >= 30) *(u32x2*)(HB + ((size_t)(row >> 5) * 2 + (row & 1)) * NU + col) = o;
        if (row < SROW0) { const int b = row / LPAD, t = row - b * LPAD; if (t >= LP - 2 && t < LP) *(f32x4*)(out + o_pfc + ((size_t)(l * NB + b) * 2 + (t - (LP - 2))) * NU + col) = v; }
        else { const int s = (row - SROW0) >> 2, t = row & 3; if (t >= 2) *(f32x4*)(out + o_sfc + ((size_t)(l * NS + s) * 2 + (t - 2)) * NU + col) = v; }
    }
};

constexpr int SBUF = 32 * 128 * 2 + 32 * 32 + 32 * 16;
__device__ __forceinline__ float* QB(float* lds, int b) { return lds + b * SBUF; }
__device__ __forceinline__ float* KB(float* lds, int b) { return lds + b * SBUF + 4096; }
__device__ __forceinline__ float* VB(float* lds, int b) { return lds + b * SBUF + 8192; }
__device__ __forceinline__ float* SCB(float* lds, int b) { return lds + b * SBUF + 9216; }
__device__ __forceinline__ float* OB(float* lds, int b) { return lds + 2 * SBUF + b * 1024; }

__device__ __forceinline__ void store_out_blk(bf16_t* P, int row0, int jb, int L, int pcol, const float* ob, int ptid) {
    const int tt = ptid >> 3, g = ptid & 7, t0 = jb * 32;
    if (t0 + tt < L) { const f32x4 v = *(const f32x4*)(ob + tt * 32 + g * 4);
        *(u32x2*)(P + (size_t)(row0 + t0 + tt) * NP + pcol + g * 4) = (u32x2){pk2(v[0], v[1]), pk2(v[2], v[3])}; }
}
__device__ __forceinline__ f32x2 lo2(f32x4 v) { return __builtin_shufflevector(v, v, 0, 1); }
__device__ __forceinline__ f32x2 hi2(f32x4 v) { return __builtin_shufflevector(v, v, 2, 3); }
__device__ __forceinline__ f32x2 bc2(float x) { return (f32x2){x, x}; }
__device__ __forceinline__ float dot16(const f32x4* a, const float* kp) {
    float s = 0.f;
#pragma unroll
    for (int i = 0; i < 4; ++i) { const f32x4 b = *(const f32x4*)(kp + 4 * i); s += (a[i][0] * b[0] + a[i][1] * b[1]) + (a[i][2] * b[2] + a[i][3] * b[3]); }
    return s;
}

struct StageRegs { f32x4 &q0, &q1, &k0, &k1, &v, &r0, &x0, &x1; };
__device__ __forceinline__ f32x4 asf(u32x4 u) { return __builtin_bit_cast(f32x4, u); }
__device__ __forceinline__ u32x4 asu(f32x4 f) { return __builtin_bit_cast(u32x4, f); }
#define BARRIER_LDS() asm volatile("s_waitcnt lgkmcnt(0)\n\ts_barrier" ::: "memory")
__device__ __forceinline__ void issue_mlstm(const Params& p, int h, int qtr, int row0, int L, int jb, int ptid, StageRegs& r) {
    const bf16_t* P = (const bf16_t*)(p.ws + OFF_P); const float* G = (const float*)(p.ws + OFF_G);
    const int tt = ptid >> 3, g = ptid & 7, t0 = jb * 32;
    if (t0 + tt >= L) return;
    const int row = row0 + t0 + tt;
    const bf16_t* prow = P + (size_t)row * NP;
    r.q0 = asf(*(const u32x4*)(prow + cQ + h * 128 + g * 16)); r.q1 = asf(*(const u32x4*)(prow + cQ + h * 128 + g * 16 + 8));
    r.k0 = asf(*(const u32x4*)(prow + cK + h * 128 + g * 16)); r.k1 = asf(*(const u32x4*)(prow + cK + h * 128 + g * 16 + 8));
    { const u32x2 vv_ = *(const u32x2*)(prow + cV + h * 128 + qtr * 32 + g * 4); r.v = asf((u32x4){vv_.x, vv_.y, 0u, 0u}); }
    if (g == 0) { const float* gr = G + (size_t)row * 16; r.r0 = (f32x4){gr[h], gr[4 + h], 0.f, 0.f}; }
}
__device__ __forceinline__ void commit_mlstm(const Params& p, int l, int h, int L, int jb, float* lds, int ptid, const StageRegs& r, int bsel = -1) {
    const int tt = ptid >> 3, g = ptid & 7, t0 = jb * 32, b = bsel >= 0 ? bsel : (jb & 1);
    if (t0 + tt >= L) return;
    float x[16]; f32x4 qs[4];
    unpack8(asu(r.q0), x); unpack8(asu(r.q1), x + 8);
    float* qd = QB(lds, b) + tt * 128 + g * 16;
#pragma unroll
    for (int i = 0; i < 4; ++i) { qs[i] = (f32x4){x[4 * i], x[4 * i + 1], x[4 * i + 2], x[4 * i + 3]} * 0.08838834764831845f; *(f32x4*)(qd + 4 * i) = qs[i]; }
    unpack8(asu(r.k0), x); unpack8(asu(r.k1), x + 8);
    float* kd = KB(lds, b) + tt * 128 + g * 16;
#pragma unroll
    for (int i = 0; i < 4; ++i) *(f32x4*)(kd + 4 * i) = (f32x4){x[4 * i], x[4 * i + 1], x[4 * i + 2], x[4 * i + 3]};
    *(f32x4*)(VB(lds, b) + tt * 32 + g * 4) = (f32x4){bflo(asu(r.v).x), bfhi(asu(r.v).x), bflo(asu(r.v).y), bfhi(asu(r.v).y)};
    const float* kmb = KB(lds, b) + (tt & ~3) * 128 + g * 16;
    f32x4 qk;
#pragma unroll
    for (int j = 0; j < 4; ++j) qk[j] = red8(dot16(qs, kmb + j * 128));
    if (g == 0) {
        const float ig = r.r0[0] + p.gate_bias[l * 8 + h], f = r.r0[1] + p.gate_bias[l * 8 + 4 + h];
        const float lf = fminf(f, 0.f) - log1pf(__expf(-fabsf(f)));
        float* sc = SCB(lds, b) + tt * 16; *(f32x2*)sc = (f32x2){ig, lf}; *(f32x4*)(sc + 4) = qk; }
}

__device__ __forceinline__ void scan_mlstm(const Params& p, int l, bool samp, int bs, int h, int qtr, int row0, int L, float* lds) {
    const int tid = opaque_tid(p.wv); const bool cons = tid < 256; const int ptid = tid - 256;
    const int lane = tid & 63, w = (tid >> 6) & 3, s = lane & 7, cl = w * 8 + (lane >> 3), col = qtr * 32 + cl;
    const int e2 = 2 * (lane >> 3), nd = (e2 >> 2) * 32 + s * 4 + (e2 & 3);
    bf16_t* P = (bf16_t*)(p.ws + OFF_P);
    f32x2 C[8]; float n0v = 0.f, n1v = 0.f, m = 0.f;
#pragma unroll
    for (int e = 0; e < 8; ++e) C[e] = bc2(0.f);
    if (cons && samp) {
        const size_t sh = (size_t)(l * NS + bs) * 4 + h;
        const float* C0 = p.st_C + sh * 16384;
#pragma unroll
        for (int e = 0; e < 16; ++e) { const int d = (e >> 2) * 32 + s * 4 + (e & 3); C[e >> 1][e & 1] = C0[d * 128 + col]; }
        n0v = p.st_n[sh * 128 + nd]; n1v = p.st_n[sh * 128 + nd + 1]; m = p.st_m[sh];
    }
    const int nblk = (L + 31) >> 5;
    f32x4 k4[4][4];
    StageRegs sr{k4[0][0], k4[0][1], k4[0][2], k4[0][3], k4[1][0], k4[1][1], k4[1][2], k4[1][3]};
    if (!cons) { issue_mlstm(p, h, qtr, row0, L, 0, ptid, sr); commit_mlstm(p, l, h, L, 0, lds, ptid, sr); if (1 < nblk) issue_mlstm(p, h, qtr, row0, L, 1, ptid, sr); }
    BARRIER_LDS();
    for (int jb = 0; jb < nblk; ++jb) {
        if (!cons) {
            if (jb + 1 < nblk) commit_mlstm(p, l, h, L, jb + 1, lds, ptid, sr);
            if (jb + 2 < nblk) issue_mlstm(p, h, qtr, row0, L, jb + 2, ptid, sr);
            if (jb > 0) store_out_blk(P, row0, jb - 1, L, cV + h * 128 + qtr * 32, OB(lds, (jb - 1) & 1), ptid);
        } else {
            const float* qb = QB(lds, jb & 1); const float* kb = KB(lds, jb & 1); const float* vb = VB(lds, jb & 1); const float* sc = SCB(lds, jb & 1);
            float* ob = OB(lds, jb & 1);
            const int nt = min(32, L - jb * 32);
            f32x4 q4[4][4]; f32x2 kn[4], qn[4]; float vv[4], ig[4], lf[4]; f32x4 qk[4];
#define MLOAD_Q(T0) do { _Pragma("unroll") for (int i = 0; i < 4; ++i) { const int t = (T0) + i; \
        _Pragma("unroll") for (int j = 0; j < 4; ++j) q4[i][j] = *(const f32x4*)(qb + t * 128 + j * 32 + s * 4); \
        qn[i] = *(const f32x2*)(qb + t * 128 + nd); } } while (0)
#define MLOAD_K(T0) do { _Pragma("unroll") for (int i = 0; i < 4; ++i) { const int t = (T0) + i; \
        const f32x2 gg = *(const f32x2*)(sc + t * 16); ig[i] = gg[0]; lf[i] = gg[1]; \
        qk[i] = *(const f32x4*)(sc + t * 16 + 4); vv[i] = vb[t * 32 + cl]; } \
      _Pragma("unroll") for (int i = 0; i < 4; ++i) { const int t = (T0) + i; \
        _Pragma("unroll") for (int j = 0; j < 4; ++j) k4[i][j] = *(const f32x4*)(kb + t * 128 + j * 32 + s * 4); \
        kn[i] = *(const f32x2*)(kb + t * 128 + nd); } } while (0)
            MLOAD_Q(0); MLOAD_K(0);
#pragma unroll 1
            for (int t0 = 0; t0 < nt; t0 += 4) {
                float d[4], dn[4];
                const int tn = min(t0 + 4, 28);
                __builtin_amdgcn_sched_barrier(0);
#pragma unroll
                for (int i = 0; i < 4; ++i) {
                    f32x2 a = bc2(0.f), a2 = bc2(0.f);
#pragma unroll
                    for (int j = 0; j < 4; ++j) { a = lo2(q4[i][j]) * C[2 * j] + a; a2 = hi2(q4[i][j]) * C[2 * j + 1] + a2; }
                    a = a + a2;
                    d[i] = a[0] + a[1]; dn[i] = qn[i][0] * n0v + qn[i][1] * n1v;
                }
                __builtin_amdgcn_sched_barrier(0);
                MLOAD_Q(tn);
                __builtin_amdgcn_sched_barrier(0);
#pragma unroll
                for (int i = 0; i < 4; ++i) { d[i] = red8(d[i]); dn[i] = red64(dn[i]); }
                float fp[4], ip[4], em[4];
#pragma unroll
                for (int i = 0; i < 4; ++i) { const float mn = fmaxf(lf[i] + m, ig[i]); fp[i] = __expf(lf[i] + m - mn); ip[i] = __expf(ig[i] - mn); em[i] = __expf(-mn); m = mn; }
                const float F0 = fp[0], F1 = F0 * fp[1], F2 = F1 * fp[2], F3 = F2 * fp[3];
                const float g00 = ip[0], g10 = g00 * fp[1], g11 = ip[1], g20 = g10 * fp[2], g21 = g11 * fp[2], g22 = ip[2];
                const float g30 = g20 * fp[3], g31 = g21 * fp[3], g32 = g22 * fp[3], g33 = ip[3];
                const float s00 = g00 * qk[0][0];
                const float s10 = g10 * qk[1][0], s11 = g11 * qk[1][1];
                const float s20 = g20 * qk[2][0], s21 = g21 * qk[2][1], s22 = g22 * qk[2][2];
                const float s30 = g30 * qk[3][0], s31 = g31 * qk[3][1], s32 = g32 * qk[3][2], s33 = g33 * qk[3][3];
                const float num0 = F0 * d[0] + s00 * vv[0], den0 = F0 * dn[0] + s00;
                const float num1 = F1 * d[1] + s10 * vv[0] + s11 * vv[1], den1 = F1 * dn[1] + s10 + s11;
                const float num2 = F2 * d[2] + s20 * vv[0] + s21 * vv[1] + s22 * vv[2], den2 = F2 * dn[2] + s20 + s21 + s22;
                const float num3 = F3 * d[3] + s30 * vv[0] + s31 * vv[1] + s32 * vv[2] + s33 * vv[3], den3 = F3 * dn[3] + s30 + s31 + s32 + s33;
                if (s == 0) {
                    ob[(t0 + 0) * 32 + cl] = num0 / fmaxf(fabsf(den0), em[0]); ob[(t0 + 1) * 32 + cl] = num1 / fmaxf(fabsf(den1), em[1]);
                    ob[(t0 + 2) * 32 + cl] = num2 / fmaxf(fabsf(den2), em[2]); ob[(t0 + 3) * 32 + cl] = num3 / fmaxf(fabsf(den3), em[3]);
                }
                const float c0 = g30 * vv[0], c1 = g31 * vv[1], c2 = g32 * vv[2], c3 = g33 * vv[3];
#pragma unroll
                for (int j = 0; j < 4; ++j) {
                    C[2 * j] = lo2(k4[3][j]) * bc2(c3) + (lo2(k4[2][j]) * bc2(c2) + (lo2(k4[1][j]) * bc2(c1) + (lo2(k4[0][j]) * bc2(c0) + C[2 * j] * bc2(F3))));
                    C[2 * j + 1] = hi2(k4[3][j]) * bc2(c3) + (hi2(k4[2][j]) * bc2(c2) + (hi2(k4[1][j]) * bc2(c1) + (hi2(k4[0][j]) * bc2(c0) + C[2 * j + 1] * bc2(F3)))); }
                n0v = n0v * F3 + (kn[0][0] * g30 + kn[1][0] * g31) + (kn[2][0] * g32 + kn[3][0] * g33);
                n1v = n1v * F3 + (kn[0][1] * g30 + kn[1][1] * g31) + (kn[2][1] * g32 + kn[3][1] * g33);
                __builtin_amdgcn_sched_barrier(0);
                MLOAD_K(tn);
            }
#undef MLOAD_Q
#undef MLOAD_K
        }
        BARRIER_LDS();
    }
    if (!cons) store_out_blk(P, row0, nblk - 1, L, cV + h * 128 + qtr * 32, OB(lds, (nblk - 1) & 1), ptid);
    else {
        const size_t sh = samp ? (size_t)(l * NS + bs) * 4 + h : (size_t)(l * NB + bs) * 4 + h;
        float* Co = p.out + (samp ? o_sC : o_pC) + sh * 16384;
#pragma unroll
        for (int e = 0; e < 16; ++e) { const int d = (e >> 2) * 32 + s * 4 + (e & 3); Co[d * 128 + col] = C[e >> 1][e & 1]; }
        if (qtr == 0 && w == 0) { float* no = p.out + (samp ? o_sn : o_pn) + sh * 128; no[nd] = n0v; no[nd + 1] = n1v;
            if (lane == 0) p.out[(samp ? o_sm : o_pm) + sh] = m; }
    }
    BARRIER_LDS();
}


constexpr int ST_LD = 33;
__device__ __forceinline__ float* STB(float* lds, int b) { return lds + 2 * SBUF + 2048 + b * (128 * ST_LD); }
__device__ __forceinline__ void st_issue(const float* S0, int qtr, int ptid, f32x4& a0, f32x4& a1, f32x4& a2, f32x4& a3) {
    const int d = ptid >> 3, c = (ptid & 7) * 4; const float* b = S0 + d * 128 + qtr * 32 + c;
    a0 = *(const f32x4*)b; a1 = *(const f32x4*)(b + 32 * 128); a2 = *(const f32x4*)(b + 64 * 128); a3 = *(const f32x4*)(b + 96 * 128);
}
__device__ __forceinline__ void st_commit(float* st, int ptid, const f32x4& a0, const f32x4& a1, const f32x4& a2, const f32x4& a3) {
    const int d = ptid >> 3, c = (ptid & 7) * 4; float* b = st + d * ST_LD + c;
#pragma unroll
    for (int i = 0; i < 4; ++i) { b[i] = a0[i]; b[32 * ST_LD + i] = a1[i]; b[64 * ST_LD + i] = a2[i]; b[96 * ST_LD + i] = a3[i]; }
}
__device__ __forceinline__ void st_store(float* So, int qtr, const float* st, int ptid) {
    const int d = ptid >> 3, c = (ptid & 7) * 4; const float* b = st + d * ST_LD + c; float* o = So + d * 128 + qtr * 32 + c;
#pragma unroll
    for (int q = 0; q < 4; ++q) *(f32x4*)(o + q * 32 * 128) = (f32x4){b[q * 32 * ST_LD], b[q * 32 * ST_LD + 1], b[q * 32 * ST_LD + 2], b[q * 32 * ST_LD + 3]};
}
__device__ __forceinline__ void scan_mlstm_stream(const Params& p, int l, int h, int qtr, int bs0, int nseq, float* lds) {
    const int tid = opaque_tid(p.wv); const bool cons = tid < 256; const int ptid = tid - 256;
    const int lane = tid & 63, w = (tid >> 6) & 3, s = lane & 7, cl = w * 8 + (lane >> 3), col = qtr * 32 + cl;
    const int e2 = 2 * (lane >> 3), nd = (e2 >> 2) * 32 + s * 4 + (e2 & 3);
    bf16_t* P = (bf16_t*)(p.ws + OFF_P);
    f32x2 C[8]; float n0v = 0.f, n1v = 0.f, m = 0.f, n0n = 0.f, n1n = 0.f, mnx = 0.f;
#pragma unroll
    for (int e = 0; e < 8; ++e) C[e] = bc2(0.f);
    f32x4 k4[4][4];
    StageRegs sr{k4[0][0], k4[0][1], k4[0][2], k4[0][3], k4[1][0], k4[1][1], k4[1][2], k4[1][3]};
#define LOADSTATE(BS) do { const size_t sh_ = (size_t)(l * NS + (BS)) * 4 + h; n0n = p.st_n[sh_ * 128 + nd]; n1n = p.st_n[sh_ * 128 + nd + 1]; mnx = p.st_m[sh_]; } while (0)
#define STISSUE(BS) st_issue(p.st_C + ((size_t)(l * NS + (BS)) * 4 + h) * 16384, qtr, ptid, k4[2][0], k4[2][1], k4[2][2], k4[2][3])
    if (!cons) { issue_mlstm(p, h, qtr, SROW0 + bs0 * 4, LS, 0, ptid, sr); STISSUE(bs0); } else LOADSTATE(bs0);
#pragma unroll 1
    for (int k = 0; k < nseq; ++k) {
        const int bs = bs0 + 8 * k, row0 = SROW0 + bs * 4;
        if (!cons) { commit_mlstm(p, l, h, LS, 0, lds, ptid, sr, k & 1); st_commit(STB(lds, k & 1), ptid, k4[2][0], k4[2][1], k4[2][2], k4[2][3]);
            if (k + 1 < nseq) { issue_mlstm(p, h, qtr, row0 + 32, LS, 0, ptid, sr); STISSUE(bs + 8); } }
        else {
            n0v = n0n; n1v = n1n; m = mnx;
            if (k + 1 < nseq) LOADSTATE(bs + 8);
        }
        BARRIER_LDS();
        if (!cons) { if (k > 0) { store_out_blk(P, row0 - 32, 0, LS, cV + h * 128 + qtr * 32, OB(lds, (k - 1) & 1), ptid); st_store(p.out + o_sC + ((size_t)(l * NS + bs - 8) * 4 + h) * 16384, qtr, STB(lds, (k - 1) & 1), ptid); } }
        else {
            const float* qb = QB(lds, k & 1); const float* kb = KB(lds, k & 1); const float* vb = VB(lds, k & 1); const float* sc = SCB(lds, k & 1);
            float* ob = OB(lds, k & 1); float* stb = STB(lds, k & 1);
#pragma unroll
            for (int e = 0; e < 16; ++e) { const int d = (e >> 2) * 32 + s * 4 + (e & 3); C[e >> 1][e & 1] = stb[d * ST_LD + cl]; }
            f32x4 q4[4][4]; f32x2 kn[4], qn[4]; float vv[4], ig[4], lf[4]; f32x4 qk[4];
#define MLOAD_Q(T0) do { _Pragma("unroll") for (int i = 0; i < 4; ++i) { const int t = (T0) + i; \
        _Pragma("unroll") for (int j = 0; j < 4; ++j) q4[i][j] = *(const f32x4*)(qb + t * 128 + j * 32 + s * 4); \
        qn[i] = *(const f32x2*)(qb + t * 128 + nd); } } while (0)
#define MLOAD_K(T0) do { _Pragma("unroll") for (int i = 0; i < 4; ++i) { const int t = (T0) + i; \
        const f32x2 gg = *(const f32x2*)(sc + t * 16); ig[i] = gg[0]; lf[i] = gg[1]; \
        qk[i] = *(const f32x4*)(sc + t * 16 + 4); vv[i] = vb[t * 32 + cl]; } \
      _Pragma("unroll") for (int i = 0; i < 4; ++i) { const int t = (T0) + i; \
        _Pragma("unroll") for (int j = 0; j < 4; ++j) k4[i][j] = *(const f32x4*)(kb + t * 128 + j * 32 + s * 4); \
        kn[i] = *(const f32x2*)(kb + t * 128 + nd); } } while (0)
            MLOAD_Q(0); MLOAD_K(0);
            {
                float d[4], dn[4];
                __builtin_amdgcn_sched_barrier(0);
#pragma unroll
                for (int i = 0; i < 4; ++i) {
                    f32x2 a = bc2(0.f), a2 = bc2(0.f);
#pragma unroll
                    for (int j = 0; j < 4; ++j) { a = lo2(q4[i][j]) * C[2 * j] + a; a2 = hi2(q4[i][j]) * C[2 * j + 1] + a2; }
                    a = a + a2;
                    d[i] = a[0] + a[1]; dn[i] = qn[i][0] * n0v + qn[i][1] * n1v;
                }
                __builtin_amdgcn_sched_barrier(0);
#pragma unroll
                for (int i = 0; i < 4; ++i) { d[i] = red8(d[i]); dn[i] = red64(dn[i]); }
                float fp[4], ip[4], em[4];
#pragma unroll
                for (int i = 0; i < 4; ++i) { const float mn = fmaxf(lf[i] + m, ig[i]); fp[i] = __expf(lf[i] + m - mn); ip[i] = __expf(ig[i] - mn); em[i] = __expf(-mn); m = mn; }
                const float F0 = fp[0], F1 = F0 * fp[1], F2 = F1 * fp[2], F3 = F2 * fp[3];
                const float g00 = ip[0], g10 = g00 * fp[1], g11 = ip[1], g20 = g10 * fp[2], g21 = g11 * fp[2], g22 = ip[2];
                const float g30 = g20 * fp[3], g31 = g21 * fp[3], g32 = g22 * fp[3], g33 = ip[3];
                const float s00 = g00 * qk[0][0];
                const float s10 = g10 * qk[1][0], s11 = g11 * qk[1][1];
                const float s20 = g20 * qk[2][0], s21 = g21 * qk[2][1], s22 = g22 * qk[2][2];
                const float s30 = g30 * qk[3][0], s31 = g31 * qk[3][1], s32 = g32 * qk[3][2], s33 = g33 * qk[3][3];
                const float num0 = F0 * d[0] + s00 * vv[0], den0 = F0 * dn[0] + s00;
                const float num1 = F1 * d[1] + s10 * vv[0] + s11 * vv[1], den1 = F1 * dn[1] + s10 + s11;
                const float num2 = F2 * d[2] + s20 * vv[0] + s21 * vv[1] + s22 * vv[2], den2 = F2 * dn[2] + s20 + s21 + s22;
                const float num3 = F3 * d[3] + s30 * vv[0] + s31 * vv[1] + s32 * vv[2] + s33 * vv[3], den3 = F3 * dn[3] + s30 + s31 + s32 + s33;
                if (s == 0) {
                    ob[0 * 32 + cl] = num0 / fmaxf(fabsf(den0), em[0]); ob[1 * 32 + cl] = num1 / fmaxf(fabsf(den1), em[1]);
                    ob[2 * 32 + cl] = num2 / fmaxf(fabsf(den2), em[2]); ob[3 * 32 + cl] = num3 / fmaxf(fabsf(den3), em[3]);
                }
                const float c0 = g30 * vv[0], c1 = g31 * vv[1], c2 = g32 * vv[2], c3 = g33 * vv[3];
#pragma unroll
                for (int j = 0; j < 4; ++j) {
                    C[2 * j] = lo2(k4[3][j]) * bc2(c3) + (lo2(k4[2][j]) * bc2(c2) + (lo2(k4[1][j]) * bc2(c1) + (lo2(k4[0][j]) * bc2(c0) + C[2 * j] * bc2(F3))));
                    C[2 * j + 1] = hi2(k4[3][j]) * bc2(c3) + (hi2(k4[2][j]) * bc2(c2) + (hi2(k4[1][j]) * bc2(c1) + (hi2(k4[0][j]) * bc2(c0) + C[2 * j + 1] * bc2(F3)))); }
                n0v = n0v * F3 + (kn[0][0] * g30 + kn[1][0] * g31) + (kn[2][0] * g32 + kn[3][0] * g33);
                n1v = n1v * F3 + (kn[0][1] * g30 + kn[1][1] * g31) + (kn[2][1] * g32 + kn[3][1] * g33);
            }
#undef MLOAD_Q
#undef MLOAD_K
            const size_t sh = (size_t)(l * NS + bs) * 4 + h;
#pragma unroll
            for (int e = 0; e < 16; ++e) { const int d = (e >> 2) * 32 + s * 4 + (e & 3); stb[d * ST_LD + cl] = C[e >> 1][e & 1]; }
            if (qtr == 0 && w == 0) { float* no = p.out + o_sn + sh * 128; no[nd] = n0v; no[nd + 1] = n1v; if (lane == 0) p.out[o_sm + sh] = m; }
        }
    }
    BARRIER_LDS();
    if (!cons) { store_out_blk(P, SROW0 + (bs0 + 8 * (nseq - 1)) * 4, 0, LS, cV + h * 128 + qtr * 32, OB(lds, (nseq - 1) & 1), ptid); st_store(p.out + o_sC + ((size_t)(l * NS + bs0 + 8 * (nseq - 1)) * 4 + h) * 16384, qtr, STB(lds, (nseq - 1) & 1), ptid); }
    BARRIER_LDS();
#undef LOADSTATE
#undef STISSUE
}


typedef float f32x16 __attribute__((ext_vector_type(16)));
#define MFMA32(a, b, c) __builtin_amdgcn_mfma_f32_32x32x16_bf16((a), (b), (c), 0, 0, 0)
__device__ __forceinline__ int crow(int reg, int hf) { return (reg & 3) + 8 * (reg >> 2) + 4 * hf; }
__device__ __forceinline__ bf16x8 pack_step(const f32x16& x, int s) {
    u32x4 pk;
    asm volatile("s_nop 7\n\ts_nop 3\n\tv_cvt_pk_bf16_f32 %0, %4, %5\n\tv_cvt_pk_bf16_f32 %1, %6, %7\n\tv_cvt_pk_bf16_f32 %2, %8, %9\n\tv_cvt_pk_bf16_f32 %3, %10, %11\n\ts_nop 1"
                 : "=&v"(pk[0]), "=&v"(pk[1]), "=&v"(pk[2]), "=&v"(pk[3])
                 : "v"(x[8 * s]), "v"(x[8 * s + 1]), "v"(x[8 * s + 2]), "v"(x[8 * s + 3]), "v"(x[8 * s + 4]), "v"(x[8 * s + 5]), "v"(x[8 * s + 6]), "v"(x[8 * s + 7]));
    return __builtin_bit_cast(bf16x8, pk);
}
__device__ __forceinline__ bf16x8 frag_n(const bf16_t* base, int ld, int r, int hf, int kb) { return *(const bf16x8*)(base + r * ld + kb * 16 + hf * 8); }
__device__ __forceinline__ bf16x8 frag_p(const bf16_t* base, int ld, int r, int hf, int k0) {
    const u32x2 a = *(const u32x2*)(base + r * ld + k0 + 4 * hf), b = *(const u32x2*)(base + r * ld + k0 + 8 + 4 * hf);
    return __builtin_bit_cast(bf16x8, (u32x4){a.x, a.y, b.x, b.y});
}
__device__ __forceinline__ int kto(int d) { return d * 40 + (d >> 4) * 8; }
__device__ __forceinline__ bf16_t f2bf(float x) { return (bf16_t)(pk2(x, 0.f) & 0xffffu); }

constexpr int CH_LDQ = 136, CH_LDS = 40;
constexpr int CH_QB = 0, CH_KB = 8704, CH_KWT = 17408, CH_VT = 27904, CH_SW = 33024, CH_SC = 35584, CH_QW = 36608, CH_SLOT = 45312, CH_OB = 2 * CH_SLOT;
constexpr int SC_U = 0, SC_B = 32, SC_PM = 64;

__device__ __forceinline__ void store_out_norm(bf16_t* P, int row0, int jb, int L, int pcol, const float* ob, const float* rd, int ptid) {
    const int tt = ptid >> 3, g = ptid & 7, t0 = jb * 32;
    if (t0 + tt < L) { const f32x4 v = *(const f32x4*)(ob + tt * 32 + g * 4) * rd[tt];
        *(u32x2*)(P + (size_t)(row0 + t0 + tt) * NP + pcol + g * 4) = (u32x2){pk2(v[0], v[1]), pk2(v[2], v[3])}; }
}
__device__ __forceinline__ void issue_mlstm_chunk(const Params& p, int h, int qtr, int row0, int L, int nch, int jb, int ptid, StageRegs& r) {
    if (jb >= nch) return;
    const bf16_t* P = (const bf16_t*)(p.ws + OFF_P); const float* REC = (const float*)(p.ws + OFF_REC);
    const int tt = ptid >> 3, g = ptid & 7, t0 = jb * 32;
    const int row = row0 + t0 + tt;
    if (g == 0) r.r0 = *(const f32x4*)(REC + ((size_t)row * 4 + h) * 16 + 4);
    if (t0 + tt >= L) return;
    const bf16_t* prow = P + (size_t)row * NP;
    r.q0 = asf(*(const u32x4*)(prow + cQ + h * 128 + g * 16)); r.q1 = asf(*(const u32x4*)(prow + cQ + h * 128 + g * 16 + 8));
    r.k0 = asf(*(const u32x4*)(prow + cK + h * 128 + g * 16)); r.k1 = asf(*(const u32x4*)(prow + cK + h * 128 + g * 16 + 8));
    { const u32x2 vv_ = *(const u32x2*)(prow + cV + h * 128 + qtr * 32 + g * 4); r.v = asf((u32x4){vv_.x, vv_.y, 0u, 0u}); }
}

__device__ __forceinline__ void scan_mlstm_chunk(const Params& p, int l, int bs, int h, int qtr, int row0, int L, unsigned char* lb) {
    const int tid = opaque_tid(p.wv); const int wave = tid >> 6, lane = tid & 63, r = lane & 31, hf = lane >> 5, ptid = tid - 256;
    bf16_t* P = (bf16_t*)(p.ws + OFF_P);
    const int nch = (L + 31) >> 5;
    f32x16 C[4];
    const int ct = wave == 3 ? 1 : 0;
#pragma unroll
    for (int dt = 0; dt < 4; ++dt)
#pragma unroll
        for (int i = 0; i < 16; ++i) C[dt][i] = 0.f;
    float m0 = 0.f;
    f32x4 s0, s1, s2, s3, s4, s5, s6, s7; StageRegs sr{s0, s1, s2, s3, s4, s5, s6, s7};
    if (wave >= 4) { for (int i = ptid; i < 2 * 32 * CH_LDS; i += 256) { const int sl = i / (32 * CH_LDS), e = i % (32 * CH_LDS);
            ((bf16_t*)(lb + sl * CH_SLOT + CH_VT))[32 * CH_LDS + e] = (e < CH_LDS) ? (bf16_t)0x3f80 : (bf16_t)0; } }
#define CH_P1(JN) do { const int jn_ = (JN); unsigned char* sl_ = lb + (jn_ & 1) * CH_SLOT; const int tt = ptid >> 3, g = ptid & 7; const bool val_ = jn_ * 32 + tt < L; \
        u32x4 q0_ = asu(sr.q0), q1_ = asu(sr.q1), k0_ = asu(sr.k0), k1_ = asu(sr.k1); u32x4 v_ = asu(sr.v); \
        if (!val_) { q0_ = q1_ = k0_ = k1_ = v_ = (u32x4){0u, 0u, 0u, 0u}; } \
        *(u32x4*)(sl_ + CH_QB + (tt * CH_LDQ + g * 16) * 2) = q0_; *(u32x4*)(sl_ + CH_QB + (tt * CH_LDQ + g * 16 + 8) * 2) = q1_; \
        *(u32x4*)(sl_ + CH_KB + (tt * CH_LDQ + g * 16) * 2) = k0_; *(u32x4*)(sl_ + CH_KB + (tt * CH_LDQ + g * 16 + 8) * 2) = k1_; \
        bf16_t* vt_ = (bf16_t*)(sl_ + CH_VT); \
        vt_[(g * 4 + 0) * CH_LDS + tt] = (bf16_t)(v_.x & 0xffffu); vt_[(g * 4 + 1) * CH_LDS + tt] = (bf16_t)(v_.x >> 16); \
        vt_[(g * 4 + 2) * CH_LDS + tt] = (bf16_t)(v_.y & 0xffffu); vt_[(g * 4 + 3) * CH_LDS + tt] = (bf16_t)(v_.y >> 16); \
        if (g == 0) { float* sc_ = (float*)(sl_ + CH_SC); sc_[SC_U + tt] = sr.r0[0]; sc_[SC_B + tt] = sr.r0[1]; sc_[SC_PM + tt] = sr.r0[2]; } \
        issue_mlstm_chunk(p, h, qtr, row0, L, nch, jn_ + 1, ptid, sr); } while (0)
#define CH_P2(JN) do { unsigned char* sl_ = lb + ((JN) & 1) * CH_SLOT; const float* sc_ = (const float*)(sl_ + CH_SC); \
        const float bT_ = sc_[SC_B + 31], mT_ = bT_ + fmaxf(m0, sc_[SC_PM + 31]); \
        if (wave == 1) { f32x16 a_; _Pragma("unroll") for (int i = 0; i < 16; ++i) a_[i] = 0.f; \
            _Pragma("unroll") for (int kb = 0; kb < 8; ++kb) a_ = MFMA32(frag_n((const bf16_t*)(sl_ + CH_QB), CH_LDQ, r, hf, kb), frag_n((const bf16_t*)(sl_ + CH_KB), CH_LDQ, r, hf, kb), a_); \
            bf16_t* sw_ = (bf16_t*)(sl_ + CH_SW); const float us_ = sc_[SC_U + r]; \
            _Pragma("unroll") for (int i4 = 0; i4 < 4; ++i4) { const f32x4 pm4 = *(const f32x4*)(sc_ + SC_PM + 8 * i4 + 4 * hf); \
                _Pragma("unroll") for (int ii = 0; ii < 4; ++ii) { const int t = 8 * i4 + 4 * hf + ii; const float w_ = (r <= t) ? __expf(us_ - fmaxf(m0, pm4[ii])) * 0.08838834764831845f : 0.f; \
                    sw_[t * CH_LDS + r] = f2bf(a_[4 * i4 + ii] * w_); } } } \
        else if (wave >= 4) { const int tt = ptid >> 3, g = ptid & 7; \
            const float wi_ = __expf(m0 - fmaxf(m0, sc_[SC_PM + tt])) * 0.08838834764831845f, ws_ = __expf(sc_[SC_U + tt] + bT_ - mT_); float x_[16]; \
            u32x4* qp_ = (u32x4*)(sl_ + CH_QB + (tt * CH_LDQ + g * 16) * 2); unpack8(qp_[0], x_); unpack8(qp_[1], x_ + 8); \
            _Pragma("unroll") for (int i = 0; i < 16; ++i) x_[i] *= wi_; \
            u32x4* qo_ = (u32x4*)(sl_ + CH_QW + (tt * CH_LDQ + g * 16) * 2); qo_[0] = pack8(x_); qo_[1] = pack8(x_ + 8); \
            const u32x4* kp_ = (const u32x4*)(sl_ + CH_KB + (tt * CH_LDQ + g * 16) * 2); unpack8(kp_[0], x_); unpack8(kp_[1], x_ + 8); \
            bf16_t* kw_ = (bf16_t*)(sl_ + CH_KWT); \
            _Pragma("unroll") for (int i = 0; i < 16; ++i) kw_[kto(g * 16) + i * CH_LDS + tt] = f2bf(x_[i] * ws_); } \
        if (wave == 1 || wave >= 4) m0 = mT_; } while (0)
    if (wave >= 4) { issue_mlstm_chunk(p, h, qtr, row0, L, nch, 0, ptid, sr); CH_P1(0); }
    BARRIER_LDS();
    CH_P2(0);
    BARRIER_LDS();
#pragma unroll 1
    for (int j = 0; j < nch; ++j) {
        if (wave == 0 || wave == 3) {
            const unsigned char* sl = lb + (j & 1) * CH_SLOT; const float* sc = (const float*)(sl + CH_SC);
            const bf16_t* qw = (const bf16_t*)(sl + CH_QW); const bf16_t* sw = (const bf16_t*)(sl + CH_SW); const bf16_t* vt = (const bf16_t*)(sl + CH_VT) + ct * 32 * CH_LDS; const bf16_t* kwt = (const bf16_t*)(sl + CH_KWT);
            const float bT = sc[SC_B + 31], mT = bT + fmaxf(m0, sc[SC_PM + 31]);
            f32x16 H;
#pragma unroll
            for (int i = 0; i < 16; ++i) H[i] = 0.f;
#pragma unroll
            for (int dt = 0; dt < 4; ++dt)
#pragma unroll
                for (int u = 0; u < 2; ++u) H = MFMA32(frag_p(qw, CH_LDQ, r, hf, 32 * dt + 16 * u), pack_step(C[dt], u), H);
            bf16x8 vb[2];
#pragma unroll
            for (int kb = 0; kb < 2; ++kb) { vb[kb] = frag_n(vt, CH_LDS, r, hf, kb); H = MFMA32(frag_n(sw, CH_LDS, r, hf, kb), vb[kb], H); }
            const float wold = __expf(bT - mT + m0);
#pragma unroll
            for (int dt = 0; dt < 4; ++dt) {
#pragma unroll
                for (int i = 0; i < 16; ++i) C[dt][i] *= wold;
#pragma unroll
                for (int kb = 0; kb < 2; ++kb) C[dt] = MFMA32(frag_n(kwt + kto(dt * 32 + r), 0, 0, hf, kb), vb[kb], C[dt]);
            }
            float* ob = (float*)(lb + CH_OB) + (j & 1) * 1024; float* rd = (float*)(lb + CH_OB + 8192) + (j & 1) * 32;
            if (ct == 0) {
#pragma unroll
                for (int i = 0; i < 16; ++i) ob[crow(i, hf) * 32 + r] = H[i];
            } else if (r == 0) {
#pragma unroll
                for (int i = 0; i < 16; ++i) { const int t = crow(i, hf); rd[t] = __builtin_amdgcn_rcpf(fmaxf(fabsf(H[i]), __expf(-(sc[SC_B + t] + fmaxf(m0, sc[SC_PM + t]))))); }
            }
            m0 = mT;
        } else if (wave >= 4) {
            if (j + 1 < nch) CH_P1(j + 1);
            if (j > 0) store_out_norm(P, row0, j - 1, L, cV + h * 128 + qtr * 32, (const float*)(lb + CH_OB) + ((j - 1) & 1) * 1024, (const float*)(lb + CH_OB + 8192) + ((j - 1) & 1) * 32, ptid);
        }
        BARRIER_LDS();
        if (j + 1 < nch) CH_P2(j + 1);
        BARRIER_LDS();
    }
    if (wave >= 4) store_out_norm(P, row0, nch - 1, L, cV + h * 128 + qtr * 32, (const float*)(lb + CH_OB) + ((nch - 1) & 1) * 1024, (const float*)(lb + CH_OB + 8192) + ((nch - 1) & 1) * 32, ptid);
    const size_t sh = (size_t)(l * NB + bs) * 4 + h;
    if (wave == 0) {
        float* Co = p.out + o_pC + sh * 16384;
#pragma unroll
        for (int dt = 0; dt < 4; ++dt)
#pragma unroll
            for (int i = 0; i < 16; ++i) Co[(32 * dt + crow(i, hf)) * 128 + qtr * 32 + r] = C[dt][i];
        if (lane == 0 && qtr == 0) p.out[o_pm + sh] = m0;
    } else if (wave == 3 && r == 0 && qtr == 0) {
#pragma unroll
        for (int dt = 0; dt < 4; ++dt)
#pragma unroll
            for (int i = 0; i < 16; ++i) p.out[o_pn + sh * 128 + 32 * dt + crow(i, hf)] = C[dt][i];
    }
    __syncthreads();
#undef CH_P1
#undef CH_P2
}

__device__ __forceinline__ void gdn_raw8(const bf16_t* P, int r0, int tr, int pcol, const bf16_t* gh, const float* st, int hch, float* x) {
    if (tr >= 0) unpack8(*(const u32x4*)(P + (size_t)(r0 + tr) * NP + pcol), x);
    else if (gh) unpack8(*(const u32x4*)(gh + (3 + tr) * 1536 + hch), x);
    else if (st) { const float* hp = st + (3 + tr) * 1536 + hch; const f32x4 a = *(const f32x4*)hp, b = *(const f32x4*)(hp + 4);
        x[0] = a[0]; x[1] = a[1]; x[2] = a[2]; x[3] = a[3]; x[4] = b[0]; x[5] = b[1]; x[6] = b[2]; x[7] = b[3]; }
    else {
#pragma unroll
        for (int i = 0; i < 8; ++i) x[i] = 0.f; }
}
__device__ __forceinline__ void gdn_conv8(const bf16_t* P, int r0, int tr, int pcol, const bf16_t* gh, const float* st, int hch, const float* cw, float* y) {
#pragma unroll
    for (int i = 0; i < 8; ++i) y[i] = 0.f;
#pragma unroll
    for (int j = 0; j < 4; ++j) { float x[8]; gdn_raw8(P, r0, tr - 3 + j, pcol, gh, st, hch, x);
        const f32x4 w0 = *(const f32x4*)(cw + j * 1536 + hch), w1 = *(const f32x4*)(cw + j * 1536 + hch + 4);
        y[0] += x[0] * w0[0]; y[1] += x[1] * w0[1]; y[2] += x[2] * w0[2]; y[3] += x[3] * w0[3];
        y[4] += x[4] * w1[0]; y[5] += x[5] * w1[1]; y[6] += x[6] * w1[2]; y[7] += x[7] * w1[3]; }
#pragma unroll
    for (int i = 0; i < 8; ++i) y[i] = y[i] * sigmoidf_(y[i]);
}

__device__ __forceinline__ void phase_prep(const Params& p, int l, float* lds) {
    const int tid = opaque_tid(p.wv); const int half = tid >> 8, t = tid & 255, tt = t >> 3, g = t & 7, wq = t >> 6, lane = t & 63, r = lane & 31, hf = lane >> 5;
    bf16_t* P = (bf16_t*)(p.ws + OFF_P); const bf16_t* GH = (const bf16_t*)(p.ws + OFF_GH);
    const float* G = (const float*)(p.ws + OFF_G); float* REC = (float*)(p.ws + OFF_REC); bf16_t* TB = (bf16_t*)(p.ws + OFF_TB);
    const float* cw = p.gconv_w + (size_t)l * 4 * 1536;
    float* ksc = lds + half * 4096;
    unsigned char* pl = (unsigned char*)lds + 32768 + half * 22016;
    bf16_t* kimg = (bf16_t*)pl; bf16_t* qimg = (bf16_t*)(pl + 8704); float* am = (float*)(pl + 17408); float* sgl = (float*)(pl + 21504); float* sbe = sgl + 32; float* sG = sgl + 64;
    constexpr int NITEM = (MROWS / 32) * 4;
    for (int base = blockIdx.x * 2; base < NITEM; base += gridDim.x * 2) {
        const int item = base + half; const bool act = item < NITEM;
        const int rb = item >> 2, h = item & 3, r0 = rb * 32;
        const bool samp = rb >= SROW0 / 32;
        int tr = tt; const bf16_t* gh = nullptr; const float* st = nullptr; int rbase = r0; bool valid = act;
        if (!samp) { const int jb = rb % (LPAD / 32); if (jb * 32 + tt >= LP) valid = false; if (jb > 0) gh = GH + (size_t)(rb - 1) * 3 * 1536; }
        else { const int sq = (rb - SROW0 / 32) * 8 + (tt >> 2); tr = tt & 3; rbase = r0 + (tt & ~3); st = p.st_gconv + (size_t)(l * NS + sq) * 3 * 1536; }
        const int ch = h * 128 + g * 16;
        u32x4 oq0 = (u32x4){0u, 0u, 0u, 0u}, oq1 = oq0, ok0 = oq0, ok1 = oq0, ov0 = oq0, ov1 = oq0;
        float ga = 0.f, gb = 0.f, gg = 0.f;
        if (valid) {
            float y[16];
            gdn_conv8(P, rbase, tr, cBV + ch, gh, st, 1024 + ch, cw, y); gdn_conv8(P, rbase, tr, cBV + ch + 8, gh, st, 1024 + ch + 8, cw, y + 8);
            ov0 = pack8(y); ov1 = pack8(y + 8);
            __builtin_amdgcn_sched_barrier(0);
            gdn_conv8(P, rbase, tr, cBQ + ch, gh, st, ch, cw, y); gdn_conv8(P, rbase, tr, cBQ + ch + 8, gh, st, ch + 8, cw, y + 8);
            float ss = 0.f;
#pragma unroll
            for (int i = 0; i < 16; ++i) ss += y[i] * y[i];
            float rs = rsqrtf(red8(ss) + 1e-6f) * 0.08838834764831845f;
#pragma unroll
            for (int i = 0; i < 16; ++i) y[i] *= rs;
            oq0 = pack8(y); oq1 = pack8(y + 8);
            __builtin_amdgcn_sched_barrier(0);
            gdn_conv8(P, rbase, tr, cBK + ch, gh, st, 512 + ch, cw, y); gdn_conv8(P, rbase, tr, cBK + ch + 8, gh, st, 512 + ch + 8, cw, y + 8);
            ss = 0.f;
#pragma unroll
            for (int i = 0; i < 16; ++i) ss += y[i] * y[i];
            rs = rsqrtf(red8(ss) + 1e-6f);
#pragma unroll
            for (int i = 0; i < 16; ++i) y[i] *= rs;
            ok0 = pack8(y); ok1 = pack8(y + 8);
            unpack8(ok0, y); unpack8(ok1, y + 8);
#pragma unroll
            for (int i = 0; i < 4; ++i) *(f32x4*)(ksc + tt * 128 + g * 16 + 4 * i) = (f32x4){y[4 * i], y[4 * i + 1], y[4 * i + 2], y[4 * i + 3]};
            if (g == 0) { const float* gr = G + (size_t)(r0 + tt) * 16;
                gb = sigmoidf_(gr[8 + h]);
                const float xa = gr[12 + h] + p.dt_bias[l * 4 + h];
                const float sp = fmaxf(xa, 0.f) + log1pf(__expf(-fabsf(xa)));
                gg = -__expf(p.A_log[l * 4 + h]) * sp; ga = __expf(gg); }
        }
        if (!samp) {
            *(u32x4*)(kimg + tt * CH_LDQ + g * 16) = ok0; *(u32x4*)(kimg + tt * CH_LDQ + g * 16 + 8) = ok1;
            *(u32x4*)(qimg + tt * CH_LDQ + g * 16) = oq0; *(u32x4*)(qimg + tt * CH_LDQ + g * 16 + 8) = oq1;
            if (g == 0) { sgl[tt] = gg; sbe[tt] = gb; }
        }
        __syncthreads();
        f32x16 pacc;
#pragma unroll
        for (int i = 0; i < 16; ++i) pacc[i] = 0.f;
        float myG = 0.f, totG = 0.f;
        if (valid) {
            bf16_t* pr = P + (size_t)(r0 + tt) * NP;
            *(u32x4*)(pr + cBQ + ch) = oq0; *(u32x4*)(pr + cBQ + ch + 8) = oq1; *(u32x4*)(pr + cBK + ch) = ok0; *(u32x4*)(pr + cBK + ch + 8) = ok1;
            *(u32x4*)(pr + cBV + ch) = ov0; *(u32x4*)(pr + cBV + ch + 8) = ov1;
        }
        if (samp) {
            if (valid) {
                const float* kmb = ksc + (tt & ~3) * 128 + g * 16;
                f32x4 qk, kk, qs[4], ks[4];
                { float y[16]; unpack8(oq0, y); unpack8(oq1, y + 8);
#pragma unroll
                  for (int i = 0; i < 4; ++i) qs[i] = (f32x4){y[4 * i], y[4 * i + 1], y[4 * i + 2], y[4 * i + 3]};
                  unpack8(ok0, y); unpack8(ok1, y + 8);
#pragma unroll
                  for (int i = 0; i < 4; ++i) ks[i] = (f32x4){y[4 * i], y[4 * i + 1], y[4 * i + 2], y[4 * i + 3]}; }
#pragma unroll
                for (int j = 0; j < 4; ++j) { qk[j] = red8(dot16(qs, kmb + j * 128)); kk[j] = red8(dot16(ks, kmb + j * 128)); }
                if (g == 0) { float* rec = REC + ((size_t)(r0 + tt) * 4 + h) * 16; *(f32x4*)rec = (f32x4){ga, gb, gg, 0.f}; *(f32x4*)(rec + 4) = qk; *(f32x4*)(rec + 8) = kk; }
            }
        } else if (act) {
            if (wq < 2) {
                const bf16_t* ai = wq == 0 ? kimg : qimg;
#pragma unroll
                for (int kb = 0; kb < 8; ++kb) pacc = MFMA32(frag_n(ai, CH_LDQ, r, hf, kb), frag_n(kimg, CH_LDQ, r, hf, kb), pacc);
            } else if (wq == 2) {
                const float gm = sgl[r]; float cum = 0.f;
#pragma unroll
                for (int t2 = 0; t2 < 32; ++t2) { cum += rdl(gm, t2); if (r == t2) myG = cum; }
                totG = cum;
                if (lane < 32) sG[r] = myG;
                if (lane == 0) sG[32] = cum;
            }
        }
        __syncthreads();
        if (!samp && act) {
            bf16_t* tb = TB + (size_t)item * 3072;
            if (wq == 0) {
                const float Gs_ = sG[r]; float* ag = (float*)tb;
#pragma unroll
                for (int i4 = 0; i4 < 4; ++i4) { const f32x4 G4 = *(const f32x4*)(sG + 8 * i4 + 4 * hf), b4 = *(const f32x4*)(sbe + 8 * i4 + 4 * hf);
#pragma unroll
                    for (int ii = 0; ii < 4; ++ii) { const int t2 = 8 * i4 + 4 * hf + ii; ag[t2 * 32 + r] = (r < t2) ? b4[ii] * pacc[4 * i4 + ii] * __expf(G4[ii] - Gs_) : 0.f; } }
            } else if (wq == 1) {
                const float Gs_ = sG[r];
#pragma unroll
                for (int i4 = 0; i4 < 4; ++i4) { const f32x4 G4 = *(const f32x4*)(sG + 8 * i4 + 4 * hf);
#pragma unroll
                    for (int ii = 0; ii < 4; ++ii) { const int t2 = 8 * i4 + 4 * hf + ii; tb[2048 + t2 * 32 + r] = f2bf((r <= t2) ? pacc[4 * i4 + ii] * __expf(G4[ii] - Gs_) : 0.f); } }
            }
            if (valid && g == 0) { const float Gt = sG[tt], GT = sG[32];
                float* rec = REC + ((size_t)(r0 + tt) * 4 + h) * 16; *(f32x4*)rec = (f32x4){ga, gb, gg, Gt}; *(f32x4*)(rec + 12) = (f32x4){GT - Gt, GT, 0.f, 0.f}; }
        }
        __syncthreads();
    }
    asm volatile("s_waitcnt vmcnt(0)" ::: "memory");
    __syncthreads();
    { const int wv_ = tid >> 6; float* am = lds + wv_ * 1024;
      int nmine = 0;
      for (int base = blockIdx.x * 2; base < NITEM; base += gridDim.x * 2) nmine += 2;
      for (int idx = wv_; idx < nmine; idx += 8) {
        const int item = blockIdx.x * 2 + (idx >> 1) * gridDim.x * 2 + (idx & 1);
        const int rb = item >> 2, h = item & 3;
        if (item >= NITEM || rb >= SROW0 / 32) continue;
        bf16_t* tb = TB + (size_t)item * 3072; const float* ag = (const float*)tb;
#pragma unroll
        for (int q = 0; q < 4; ++q) *(f32x4*)(am + q * 256 + lane * 4) = *(const f32x4*)(ag + q * 256 + lane * 4);
        const float* rec = REC + ((size_t)(rb * 32 + r) * 4 + h) * 16;
        const bool rv = (rb % (LPAD / 32)) * 32 + r < LP;
        const float bs_ = rv ? rec[1] : 0.f, bg_ = rv ? bs_ * __expf(rec[3]) : 0.f;
        asm volatile("s_waitcnt vmcnt(0) lgkmcnt(0)" ::: "memory");
        float Tc[32];
#pragma unroll
        for (int t2 = 0; t2 < 32; ++t2) { float v0 = 0.f, v1 = 0.f, v2 = 0.f, v3 = 0.f;
#pragma unroll
            for (int q4 = 0; q4 < (t2 + 3) / 4; ++q4) { const f32x4 a4 = *(const f32x4*)(am + t2 * 32 + q4 * 4);
                if (q4 * 4 + 0 < t2) v0 += a4[0] * Tc[q4 * 4 + 0]; if (q4 * 4 + 1 < t2) v1 += a4[1] * Tc[q4 * 4 + 1];
                if (q4 * 4 + 2 < t2) v2 += a4[2] * Tc[q4 * 4 + 2]; if (q4 * 4 + 3 < t2) v3 += a4[3] * Tc[q4 * 4 + 3]; }
            Tc[t2] = ((r == t2) ? 1.f : 0.f) - ((v0 + v1) + (v2 + v3)); }
        if (hf == 0) {
#pragma unroll
            for (int t2 = 0; t2 < 32; ++t2) { tb[t2 * 32 + r] = f2bf(Tc[t2] * bs_); tb[1024 + t2 * 32 + r] = f2bf(Tc[t2] * bg_); } }
        asm volatile("s_waitcnt lgkmcnt(0)" ::: "memory");
      } }
    { const int wv_ = tid >> 6;
      for (int it = blockIdx.x * 8 + wv_; it < (SROW0 / 32) * 4; it += gridDim.x * 8) {
        const int rbp = it >> 2, hh = it & 3, jb = rbp % (LPAD / 32), row = rbp * 32 + r;
        float igm = -1e30f, lfm = 0.f;
        if (jb * 32 + r < LP) { const float* gr = G + (size_t)row * 16; igm = gr[hh] + p.gate_bias[l * 8 + hh]; const float f = gr[4 + hh] + p.gate_bias[l * 8 + 4 + hh]; lfm = fminf(f, 0.f) - log1pf(__expf(-fabsf(f))); }
        float bsum = 0.f, pm = -3e38f, myb = 0.f, myu = 0.f, mypm = 0.f;
#pragma unroll
        for (int t2 = 0; t2 < 32; ++t2) { bsum += rdl(lfm, t2); const float u_ = rdl(igm, t2) - bsum; pm = fmaxf(pm, u_); if (r == t2) { myb = bsum; myu = u_; mypm = pm; } }
        if (lane < 32) *(f32x4*)(REC + ((size_t)row * 4 + hh) * 16 + 4) = (f32x4){myu, myb, mypm, 0.f};
      } }
}

__device__ __forceinline__ void issue_gdn(const Params& p, int h, int qtr, int row0, int L, int jb, int ptid, StageRegs& r) {
    const bf16_t* P = (const bf16_t*)(p.ws + OFF_P); const float* REC = (const float*)(p.ws + OFF_REC);
    const int tt = ptid >> 3, g = ptid & 7, t0 = jb * 32;
    if (t0 + tt >= L) return;
    const int row = row0 + t0 + tt;
    const bf16_t* prow = P + (size_t)row * NP;
    r.q0 = asf(*(const u32x4*)(prow + cBQ + h * 128 + g * 16)); r.q1 = asf(*(const u32x4*)(prow + cBQ + h * 128 + g * 16 + 8));
    r.k0 = asf(*(const u32x4*)(prow + cBK + h * 128 + g * 16)); r.k1 = asf(*(const u32x4*)(prow + cBK + h * 128 + g * 16 + 8));
    { const u32x2 vv_ = *(const u32x2*)(prow + cBV + h * 128 + qtr * 32 + g * 4); r.v = asf((u32x4){vv_.x, vv_.y, 0u, 0u}); }
    if (g < 3) r.r0 = *(const f32x4*)(REC + ((size_t)row * 4 + h) * 16 + g * 4);
}
__device__ __forceinline__ void commit_gdn(int L, int jb, float* lds, int ptid, const StageRegs& r, int bsel = -1) {
    const int tt = ptid >> 3, g = ptid & 7, t0 = jb * 32, b = bsel >= 0 ? bsel : (jb & 1);
    if (t0 + tt >= L) return;
    float x[16];
    unpack8(asu(r.q0), x); unpack8(asu(r.q1), x + 8);
    float* qd = QB(lds, b) + tt * 128 + g * 16;
#pragma unroll
    for (int i = 0; i < 4; ++i) *(f32x4*)(qd + 4 * i) = (f32x4){x[4 * i], x[4 * i + 1], x[4 * i + 2], x[4 * i + 3]};
    unpack8(asu(r.k0), x); unpack8(asu(r.k1), x + 8);
    float* kd = KB(lds, b) + tt * 128 + g * 16;
#pragma unroll
    for (int i = 0; i < 4; ++i) *(f32x4*)(kd + 4 * i) = (f32x4){x[4 * i], x[4 * i + 1], x[4 * i + 2], x[4 * i + 3]};
    *(f32x4*)(VB(lds, b) + tt * 32 + g * 4) = (f32x4){bflo(asu(r.v).x), bfhi(asu(r.v).x), bflo(asu(r.v).y), bfhi(asu(r.v).y)};
    if (g < 3) *(f32x4*)(SCB(lds, b) + tt * 16 + g * 4) = r.r0;
}

constexpr int GD_Q = 0, GD_K = 8704, GD_KT = 17408, GD_KDT = 27904, GD_VT = 38400, GD_QKD = 40960, GD_TV = 43520, GD_TK = 46080, GD_W = 48640, GD_SC = 57344, GD_SLOT = 58368, GD_OB = 2 * GD_SLOT;
constexpr int GS_B = 32, GS_EG = 96, GS_ETG = 128, GS_EGT = 160;

__device__ __forceinline__ void issue_gdn_chunk(const Params& p, int h, int qtr, int row0, int L, int nch, int jb, int ptid, StageRegs& r) {
    if (jb >= nch) return;
    const bf16_t* P = (const bf16_t*)(p.ws + OFF_P); const float* REC = (const float*)(p.ws + OFF_REC);
    const bf16_t* tb = (const bf16_t*)(p.ws + OFF_TB) + ((size_t)((row0 >> 5) + jb) * 4 + h) * 3072;
    r.x0 = asf(*(const u32x4*)(tb + ptid * 8));
    if (ptid < 128) r.x1 = asf(*(const u32x4*)(tb + 2048 + ptid * 8));
    const int tt = ptid >> 3, g = ptid & 7, t0 = jb * 32;
    if (t0 + tt >= L) return;
    const int row = row0 + t0 + tt;
    const bf16_t* prow = P + (size_t)row * NP;
    r.q0 = asf(*(const u32x4*)(prow + cBQ + h * 128 + g * 16)); r.q1 = asf(*(const u32x4*)(prow + cBQ + h * 128 + g * 16 + 8));
    r.k0 = asf(*(const u32x4*)(prow + cBK + h * 128 + g * 16)); r.k1 = asf(*(const u32x4*)(prow + cBK + h * 128 + g * 16 + 8));
    { const u32x2 vv_ = *(const u32x2*)(prow + cBV + h * 128 + qtr * 32 + g * 4); r.v = asf((u32x4){vv_.x, vv_.y, 0u, 0u}); }
    if (g == 0 || g == 3) r.r0 = *(const f32x4*)(REC + ((size_t)row * 4 + h) * 16 + g * 4);
}

__device__ __forceinline__ void scan_gdn_chunk(const Params& p, int l, int bs, int h, int qtr, int row0, int L, unsigned char* lb) {
    const int tid = opaque_tid(p.wv); const int wave = tid >> 6, lane = tid & 63, r = lane & 31, hf = lane >> 5, ptid = tid - 256;
    bf16_t* P = (bf16_t*)(p.ws + OFF_P);
    const int nch = (L + 31) >> 5;
    f32x16 S[4];
#pragma unroll
    for (int dt = 0; dt < 4; ++dt)
#pragma unroll
        for (int i = 0; i < 16; ++i) S[dt][i] = 0.f;
    f32x4 s0, s1, s2, s3, s4, s5, s6, s7; StageRegs sr{s0, s1, s2, s3, s4, s5, s6, s7};
#define GD_P1(JN) do { const int jn_ = (JN); unsigned char* sl_ = lb + (jn_ & 1) * GD_SLOT; const int tt = ptid >> 3, g = ptid & 7; const bool val_ = jn_ * 32 + tt < L; \
        u32x4 q0_ = asu(sr.q0), q1_ = asu(sr.q1), k0_ = asu(sr.k0), k1_ = asu(sr.k1); u32x4 v_ = asu(sr.v); \
        if (!val_) { q0_ = q1_ = k0_ = k1_ = v_ = (u32x4){0u, 0u, 0u, 0u}; } \
        *(u32x4*)(sl_ + GD_Q + (tt * CH_LDQ + g * 16) * 2) = q0_; *(u32x4*)(sl_ + GD_Q + (tt * CH_LDQ + g * 16 + 8) * 2) = q1_; \
        *(u32x4*)(sl_ + GD_K + (tt * CH_LDQ + g * 16) * 2) = k0_; *(u32x4*)(sl_ + GD_K + (tt * CH_LDQ + g * 16 + 8) * 2) = k1_; \
        bf16_t* kt_ = (bf16_t*)(sl_ + GD_KT) + kto(g * 16) + tt; \
        _Pragma("unroll") for (int i = 0; i < 4; ++i) { kt_[(2 * i) * CH_LDS] = (bf16_t)(k0_[i] & 0xffffu); kt_[(2 * i + 1) * CH_LDS] = (bf16_t)(k0_[i] >> 16); \
            kt_[(8 + 2 * i) * CH_LDS] = (bf16_t)(k1_[i] & 0xffffu); kt_[(8 + 2 * i + 1) * CH_LDS] = (bf16_t)(k1_[i] >> 16); } \
        bf16_t* vt_ = (bf16_t*)(sl_ + GD_VT); \
        vt_[(g * 4 + 0) * CH_LDS + tt] = (bf16_t)(v_.x & 0xffffu); vt_[(g * 4 + 1) * CH_LDS + tt] = (bf16_t)(v_.x >> 16); \
        vt_[(g * 4 + 2) * CH_LDS + tt] = (bf16_t)(v_.y & 0xffffu); vt_[(g * 4 + 3) * CH_LDS + tt] = (bf16_t)(v_.y >> 16); \
        { const int row_ = ptid >> 2, c4_ = ptid & 3; *(u32x4*)(sl_ + (row_ < 32 ? GD_TV : GD_TK) + ((row_ & 31) * CH_LDS + c4_ * 8) * 2) = asu(sr.x0); \
          if (ptid < 128) *(u32x4*)(sl_ + GD_QKD + (row_ * CH_LDS + c4_ * 8) * 2) = asu(sr.x1); } \
        float* sc_ = (float*)(sl_ + GD_SC); \
        if (g == 0) { sc_[GS_B + tt] = val_ ? sr.r0[1] : 0.f; sc_[GS_EG + tt] = val_ ? __expf(sr.r0[3]) : 0.f; } \
        if (g == 3) { sc_[GS_ETG + tt] = val_ ? __expf(sr.r0[0]) : 0.f; if (tt == 0) sc_[GS_EGT] = __expf(sr.r0[1]); } \
        issue_gdn_chunk(p, h, qtr, row0, L, nch, jn_ + 1, ptid, sr); } while (0)
#define GD_P2(JN) do { if (wave >= 4) { unsigned char* sl_ = lb + ((JN) & 1) * GD_SLOT; const float* sc_ = (const float*)(sl_ + GD_SC); \
        { const int tt = ptid >> 3, g = ptid & 7; const float eg_ = sc_[GS_EG + tt], et_ = sc_[GS_ETG + tt]; float x_[16]; \
            u32x4* qp_ = (u32x4*)(sl_ + GD_Q + (tt * CH_LDQ + g * 16) * 2); unpack8(qp_[0], x_); unpack8(qp_[1], x_ + 8); \
            _Pragma("unroll") for (int i = 0; i < 16; ++i) x_[i] *= eg_; \
            qp_[0] = pack8(x_); qp_[1] = pack8(x_ + 8); \
            const u32x4* kp_ = (const u32x4*)(sl_ + GD_K + (tt * CH_LDQ + g * 16) * 2); unpack8(kp_[0], x_); unpack8(kp_[1], x_ + 8); \
            bf16_t* kd_ = (bf16_t*)(sl_ + GD_KDT); \
            _Pragma("unroll") for (int i = 0; i < 16; ++i) kd_[kto(g * 16) + i * CH_LDS + tt] = f2bf(x_[i] * et_); } \
        { const int dt_ = wave - 4; f32x16 a_; \
            _Pragma("unroll") for (int i = 0; i < 16; ++i) a_[i] = 0.f; \
            _Pragma("unroll") for (int kb = 0; kb < 2; ++kb) a_ = MFMA32(frag_n((const bf16_t*)(sl_ + GD_KT) + kto(dt_ * 32 + r), 0, 0, hf, kb), frag_n((const bf16_t*)(sl_ + GD_TK), CH_LDS, r, hf, kb), a_); \
            _Pragma("unroll") for (int i4 = 0; i4 < 4; ++i4) { unsigned lo_, hi_;     \
                asm volatile("s_nop 7\n\ts_nop 7\n\tv_cvt_pk_bf16_f32 %0, %2, %3\n\tv_cvt_pk_bf16_f32 %1, %4, %5" : "=&v"(lo_), "=&v"(hi_) : "v"(a_[4 * i4]), "v"(a_[4 * i4 + 1]), "v"(a_[4 * i4 + 2]), "v"(a_[4 * i4 + 3])); \
                *(u32x2*)(sl_ + GD_W + (r * CH_LDQ + 32 * dt_ + 8 * i4 + 4 * hf) * 2) = (u32x2){lo_, hi_}; } } } } while (0)
    if (wave >= 4) { issue_gdn_chunk(p, h, qtr, row0, L, nch, 0, ptid, sr); GD_P1(0); }
    BARRIER_LDS();
    GD_P2(0);
    BARRIER_LDS();
#pragma unroll 1
    for (int j = 0; j < nch; ++j) {
        if (wave == 0) {
            const unsigned char* sl = lb + (j & 1) * GD_SLOT; const float* sc = (const float*)(sl + GD_SC);
            const bf16_t* wq = (const bf16_t*)(sl + GD_W); const bf16_t* qg = (const bf16_t*)(sl + GD_Q); const bf16_t* tv = (const bf16_t*)(sl + GD_TV); const bf16_t* vt = (const bf16_t*)(sl + GD_VT);
            const bf16_t* qkd = (const bf16_t*)(sl + GD_QKD); const bf16_t* kdt = (const bf16_t*)(sl + GD_KDT);
            f32x16 U, O;
#pragma unroll
            for (int i = 0; i < 16; ++i) { U[i] = 0.f; O[i] = 0.f; }
#pragma unroll
            for (int dt = 0; dt < 4; ++dt)
#pragma unroll
                for (int u = 0; u < 2; ++u) { const bf16x8 sb = pack_step(S[dt], u);
                    U = MFMA32(frag_p(wq, CH_LDQ, r, hf, 32 * dt + 16 * u), sb, U); O = MFMA32(frag_p(qg, CH_LDQ, r, hf, 32 * dt + 16 * u), sb, O); }
            f32x16 Uv;
#pragma unroll
            for (int i = 0; i < 16; ++i) Uv[i] = 0.f;
#pragma unroll
            for (int kb = 0; kb < 2; ++kb) Uv = MFMA32(frag_n(tv, CH_LDS, r, hf, kb), frag_n(vt, CH_LDS, r, hf, kb), Uv);
#pragma unroll
            for (int i = 0; i < 16; ++i) U[i] = Uv[i] - U[i];
            bf16x8 ub[2]; ub[0] = pack_step(U, 0); ub[1] = pack_step(U, 1);
#pragma unroll
            for (int u = 0; u < 2; ++u) O = MFMA32(frag_p(qkd, CH_LDS, r, hf, 16 * u), ub[u], O);
            const float egt = sc[GS_EGT];
#pragma unroll
            for (int dt = 0; dt < 4; ++dt) {
#pragma unroll
                for (int i = 0; i < 16; ++i) S[dt][i] *= egt;
#pragma unroll
                for (int u = 0; u < 2; ++u) S[dt] = MFMA32(frag_p(kdt + kto(dt * 32 + r), 0, 0, hf, 16 * u), ub[u], S[dt]);
            }
            float* ob = (float*)(lb + GD_OB) + (j & 1) * 1024;
#pragma unroll
            for (int i = 0; i < 16; ++i) ob[crow(i, hf) * 32 + r] = O[i];
        } else if (wave >= 4) {
            if (j + 1 < nch) GD_P1(j + 1);
            if (j > 0) store_out_blk(P, row0, j - 1, L, cBV + h * 128 + qtr * 32, (const float*)(lb + GD_OB) + ((j - 1) & 1) * 1024, ptid);
        }
        BARRIER_LDS();
        if (j + 1 < nch) GD_P2(j + 1);
        BARRIER_LDS();
    }
    if (wave >= 4) store_out_blk(P, row0, nch - 1, L, cBV + h * 128 + qtr * 32, (const float*)(lb + GD_OB) + ((nch - 1) & 1) * 1024, ptid);
    if (wave == 0) {
        float* So = p.out + o_pS + ((size_t)(l * NB + bs) * 4 + h) * 16384;
#pragma unroll
        for (int dt = 0; dt < 4; ++dt)
#pragma unroll
            for (int i = 0; i < 16; ++i) So[(32 * dt + crow(i, hf)) * 128 + qtr * 32 + r] = S[dt][i];
    }
    __syncthreads();
#undef GD_P1
#undef GD_P2
}

__device__ __forceinline__ void scan_gdn(const Params& p, int l, bool samp, int bs, int h, int qtr, int row0, int L, float* lds) {
    const int tid = opaque_tid(p.wv); const bool cons = tid < 256; const int ptid = tid - 256;
    const int lane = tid & 63, w = (tid >> 6) & 3, s = lane & 7, cl = w * 8 + (lane >> 3), col = qtr * 32 + cl;
    bf16_t* P = (bf16_t*)(p.ws + OFF_P);
    f32x2 S[8];
#pragma unroll
    for (int e = 0; e < 8; ++e) S[e] = bc2(0.f);
    if (cons && samp) {
        const float* S0 = p.st_S + ((size_t)(l * NS + bs) * 4 + h) * 16384;
#pragma unroll
        for (int e = 0; e < 16; ++e) { const int d = (e >> 2) * 32 + s * 4 + (e & 3); S[e >> 1][e & 1] = S0[d * 128 + col]; }
    }
    const int nblk = (L + 31) >> 5;
    f32x4 k4[4][4];
    StageRegs sr{k4[0][0], k4[0][1], k4[0][2], k4[0][3], k4[1][0], k4[1][1], k4[1][2], k4[1][3]};
    if (!cons) { issue_gdn(p, h, qtr, row0, L, 0, ptid, sr); commit_gdn(L, 0, lds, ptid, sr); if (1 < nblk) issue_gdn(p, h, qtr, row0, L, 1, ptid, sr); }
    BARRIER_LDS();
    for (int jb = 0; jb < nblk; ++jb) {
        if (!cons) {
            if (jb + 1 < nblk) commit_gdn(L, jb + 1, lds, ptid, sr);
            if (jb + 2 < nblk) issue_gdn(p, h, qtr, row0, L, jb + 2, ptid, sr);
            if (jb > 0) store_out_blk(P, row0, jb - 1, L, cBV + h * 128 + qtr * 32, OB(lds, (jb - 1) & 1), ptid);
        } else {
            const float* qb = QB(lds, jb & 1); const float* kb = KB(lds, jb & 1); const float* vb = VB(lds, jb & 1); const float* sc = SCB(lds, jb & 1);
            float* ob = OB(lds, jb & 1);
            const int nt = min(32, L - jb * 32);
            f32x4 q4[4][4]; float vv[4], a[4], be[4]; f32x4 qk[4], kk[4];
#define GLOAD_Q(T0) do { _Pragma("unroll") for (int i = 0; i < 4; ++i) { const int t = (T0) + i; \
        _Pragma("unroll") for (int j = 0; j < 4; ++j) q4[i][j] = *(const f32x4*)(qb + t * 128 + j * 32 + s * 4); } } while (0)
#define GLOAD_K(T0) do { _Pragma("unroll") for (int i = 0; i < 4; ++i) { const int t = (T0) + i; \
        _Pragma("unroll") for (int j = 0; j < 4; ++j) k4[i][j] = *(const f32x4*)(kb + t * 128 + j * 32 + s * 4); } \
      _Pragma("unroll") for (int i = 0; i < 4; ++i) { const int t = (T0) + i; \
        const f32x2 gg = *(const f32x2*)(sc + t * 16); a[i] = gg[0]; be[i] = gg[1]; \
        qk[i] = *(const f32x4*)(sc + t * 16 + 4); kk[i] = *(const f32x4*)(sc + t * 16 + 8); vv[i] = vb[t * 32 + cl]; } } while (0)
            GLOAD_Q(0); GLOAD_K(0);
#pragma unroll 1
            for (int t0 = 0; t0 < nt; t0 += 4) {
                float dk[4], dq[4];
                const int tn = min(t0 + 4, 28);
                __builtin_amdgcn_sched_barrier(0);
#pragma unroll
                for (int i = 0; i < 4; ++i) {
                    f32x2 x = bc2(0.f), x2 = bc2(0.f), y = bc2(0.f), y2 = bc2(0.f);
#pragma unroll
                    for (int j = 0; j < 4; ++j) {
                        x = lo2(k4[i][j]) * S[2 * j] + x; x2 = hi2(k4[i][j]) * S[2 * j + 1] + x2;
                        y = lo2(q4[i][j]) * S[2 * j] + y; y2 = hi2(q4[i][j]) * S[2 * j + 1] + y2; }
                    x = x + x2; y = y + y2;
                    dk[i] = x[0] + x[1]; dq[i] = y[0] + y[1];
                }
                __builtin_amdgcn_sched_barrier(0);
                GLOAD_Q(tn);
                __builtin_amdgcn_sched_barrier(0);
#pragma unroll
                for (int i = 0; i < 4; ++i) { dk[i] = red8(dk[i]); dq[i] = red8(dq[i]); }
                const float A0 = a[0], A1 = A0 * a[1], A2 = A1 * a[2], A3 = A2 * a[3];
                const float r10 = a[1], r21 = a[2], r32 = a[3], r20 = r10 * a[2], r31 = r21 * a[3], r30 = r20 * a[3];
                const float u0 = be[0] * (vv[0] - A0 * dk[0]);
                const float u1 = be[1] * (vv[1] - A1 * dk[1] - r10 * kk[1][0] * u0);
                const float u2 = be[2] * (vv[2] - A2 * dk[2] - r20 * kk[2][0] * u0 - r21 * kk[2][1] * u1);
                const float u3 = be[3] * (vv[3] - A3 * dk[3] - r30 * kk[3][0] * u0 - r31 * kk[3][1] * u1 - r32 * kk[3][2] * u2);
                if (s == 0) {
                    ob[(t0 + 0) * 32 + cl] = A0 * dq[0] + qk[0][0] * u0;
                    ob[(t0 + 1) * 32 + cl] = A1 * dq[1] + r10 * qk[1][0] * u0 + qk[1][1] * u1;
                    ob[(t0 + 2) * 32 + cl] = A2 * dq[2] + r20 * qk[2][0] * u0 + r21 * qk[2][1] * u1 + qk[2][2] * u2;
                    ob[(t0 + 3) * 32 + cl] = A3 * dq[3] + r30 * qk[3][0] * u0 + r31 * qk[3][1] * u1 + r32 * qk[3][2] * u2 + qk[3][3] * u3;
                }
                const float c0 = r30 * u0, c1 = r31 * u1, c2 = r32 * u2, c3 = u3;
#pragma unroll
                for (int j = 0; j < 4; ++j) {
                    S[2 * j] = lo2(k4[3][j]) * bc2(c3) + (lo2(k4[2][j]) * bc2(c2) + (lo2(k4[1][j]) * bc2(c1) + (lo2(k4[0][j]) * bc2(c0) + S[2 * j] * bc2(A3))));
                    S[2 * j + 1] = hi2(k4[3][j]) * bc2(c3) + (hi2(k4[2][j]) * bc2(c2) + (hi2(k4[1][j]) * bc2(c1) + (hi2(k4[0][j]) * bc2(c0) + S[2 * j + 1] * bc2(A3)))); }
                __builtin_amdgcn_sched_barrier(0);
                GLOAD_K(tn);
            }
#undef GLOAD_Q
#undef GLOAD_K
        }
        BARRIER_LDS();
    }
    if (!cons) store_out_blk(P, row0, nblk - 1, L, cBV + h * 128 + qtr * 32, OB(lds, (nblk - 1) & 1), ptid);
    else {
        const size_t sh = samp ? (size_t)(l * NS + bs) * 4 + h : (size_t)(l * NB + bs) * 4 + h;
        float* So = p.out + (samp ? o_sS : o_pS) + sh * 16384;
#pragma unroll
        for (int e = 0; e < 16; ++e) { const int d = (e >> 2) * 32 + s * 4 + (e & 3); So[d * 128 + col] = S[e >> 1][e & 1]; }
    }
    BARRIER_LDS();
}

__device__ __forceinline__ void scan_gdn_stream(const Params& p, int l, int h, int qtr, int bs0, int nseq, float* lds) {
    const int tid = opaque_tid(p.wv); const bool cons = tid < 256; const int ptid = tid - 256;
    const int lane = tid & 63, w = (tid >> 6) & 3, s = lane & 7, cl = w * 8 + (lane >> 3), col = qtr * 32 + cl;
    bf16_t* P = (bf16_t*)(p.ws + OFF_P);
    f32x2 S[8];
#pragma unroll
    for (int e = 0; e < 8; ++e) S[e] = bc2(0.f);
    f32x4 k4[4][4];
    StageRegs sr{k4[0][0], k4[0][1], k4[0][2], k4[0][3], k4[1][0], k4[1][1], k4[1][2], k4[1][3]};
#define LOADSTATE(BS) do { } while (0)
#define STISSUE(BS) st_issue(p.st_S + ((size_t)(l * NS + (BS)) * 4 + h) * 16384, qtr, ptid, k4[2][0], k4[2][1], k4[2][2], k4[2][3])
    if (!cons) { issue_gdn(p, h, qtr, SROW0 + bs0 * 4, LS, 0, ptid, sr); STISSUE(bs0); }
#pragma unroll 1
    for (int k = 0; k < nseq; ++k) {
        const int bs = bs0 + 8 * k, row0 = SROW0 + bs * 4;
        if (!cons) { commit_gdn(LS, 0, lds, ptid, sr, k & 1); st_commit(STB(lds, k & 1), ptid, k4[2][0], k4[2][1], k4[2][2], k4[2][3]);
            if (k + 1 < nseq) { issue_gdn(p, h, qtr, row0 + 32, LS, 0, ptid, sr); STISSUE(bs + 8); } }
        BARRIER_LDS();
        if (!cons) { if (k > 0) { store_out_blk(P, row0 - 32, 0, LS, cBV + h * 128 + qtr * 32, OB(lds, (k - 1) & 1), ptid); st_store(p.out + o_sS + ((size_t)(l * NS + bs - 8) * 4 + h) * 16384, qtr, STB(lds, (k - 1) & 1), ptid); } }
        else {
            const float* qb = QB(lds, k & 1); const float* kb = KB(lds, k & 1); const float* vb = VB(lds, k & 1); const float* sc = SCB(lds, k & 1);
            float* ob = OB(lds, k & 1); float* stb = STB(lds, k & 1);
#pragma unroll
            for (int e = 0; e < 16; ++e) { const int d = (e >> 2) * 32 + s * 4 + (e & 3); S[e >> 1][e & 1] = stb[d * ST_LD + cl]; }
            f32x4 q4[4][4]; float vv[4], a[4], be[4]; f32x4 qk[4], kk[4];
#define GLOAD_Q(T0) do { _Pragma("unroll") for (int i = 0; i < 4; ++i) { const int t = (T0) + i; \
        _Pragma("unroll") for (int j = 0; j < 4; ++j) q4[i][j] = *(const f32x4*)(qb + t * 128 + j * 32 + s * 4); } } while (0)
#define GLOAD_K(T0) do { _Pragma("unroll") for (int i = 0; i < 4; ++i) { const int t = (T0) + i; \
        _Pragma("unroll") for (int j = 0; j < 4; ++j) k4[i][j] = *(const f32x4*)(kb + t * 128 + j * 32 + s * 4); } \
      _Pragma("unroll") for (int i = 0; i < 4; ++i) { const int t = (T0) + i; \
        const f32x2 gg = *(const f32x2*)(sc + t * 16); a[i] = gg[0]; be[i] = gg[1]; \
        qk[i] = *(const f32x4*)(sc + t * 16 + 4); kk[i] = *(const f32x4*)(sc + t * 16 + 8); vv[i] = vb[t * 32 + cl]; } } while (0)
            GLOAD_Q(0); GLOAD_K(0);
            {
                float dk[4], dq[4];
                __builtin_amdgcn_sched_barrier(0);
#pragma unroll
                for (int i = 0; i < 4; ++i) {
                    f32x2 x = bc2(0.f), x2 = bc2(0.f), y = bc2(0.f), y2 = bc2(0.f);
#pragma unroll
                    for (int j = 0; j < 4; ++j) {
                        x = lo2(k4[i][j]) * S[2 * j] + x; x2 = hi2(k4[i][j]) * S[2 * j + 1] + x2;
                        y = lo2(q4[i][j]) * S[2 * j] + y; y2 = hi2(q4[i][j]) * S[2 * j + 1] + y2; }
                    x = x + x2; y = y + y2;
                    dk[i] = x[0] + x[1]; dq[i] = y[0] + y[1];
                }
                __builtin_amdgcn_sched_barrier(0);
#pragma unroll
                for (int i = 0; i < 4; ++i) { dk[i] = red8(dk[i]); dq[i] = red8(dq[i]); }
                const float A0 = a[0], A1 = A0 * a[1], A2 = A1 * a[2], A3 = A2 * a[3];
                const float r10 = a[1], r21 = a[2], r32 = a[3], r20 = r10 * a[2], r31 = r21 * a[3], r30 = r20 * a[3];
                const float u0 = be[0] * (vv[0] - A0 * dk[0]);
                const float u1 = be[1] * (vv[1] - A1 * dk[1] - r10 * kk[1][0] * u0);
                const float u2 = be[2] * (vv[2] - A2 * dk[2] - r20 * kk[2][0] * u0 - r21 * kk[2][1] * u1);
                const float u3 = be[3] * (vv[3] - A3 * dk[3] - r30 * kk[3][0] * u0 - r31 * kk[3][1] * u1 - r32 * kk[3][2] * u2);
                if (s == 0) {
                    ob[0 * 32 + cl] = A0 * dq[0] + qk[0][0] * u0;
                    ob[1 * 32 + cl] = A1 * dq[1] + r10 * qk[1][0] * u0 + qk[1][1] * u1;
                    ob[2 * 32 + cl] = A2 * dq[2] + r20 * qk[2][0] * u0 + r21 * qk[2][1] * u1 + qk[2][2] * u2;
                    ob[3 * 32 + cl] = A3 * dq[3] + r30 * qk[3][0] * u0 + r31 * qk[3][1] * u1 + r32 * qk[3][2] * u2 + qk[3][3] * u3;
                }
                const float c0 = r30 * u0, c1 = r31 * u1, c2 = r32 * u2, c3 = u3;
#pragma unroll
                for (int j = 0; j < 4; ++j) {
                    S[2 * j] = lo2(k4[3][j]) * bc2(c3) + (lo2(k4[2][j]) * bc2(c2) + (lo2(k4[1][j]) * bc2(c1) + (lo2(k4[0][j]) * bc2(c0) + S[2 * j] * bc2(A3))));
                    S[2 * j + 1] = hi2(k4[3][j]) * bc2(c3) + (hi2(k4[2][j]) * bc2(c2) + (hi2(k4[1][j]) * bc2(c1) + (hi2(k4[0][j]) * bc2(c0) + S[2 * j + 1] * bc2(A3)))); }
            }
#undef GLOAD_Q
#undef GLOAD_K
#pragma unroll
            for (int e = 0; e < 16; ++e) { const int d = (e >> 2) * 32 + s * 4 + (e & 3); stb[d * ST_LD + cl] = S[e >> 1][e & 1]; }
        }
    }
    BARRIER_LDS();
    if (!cons) { store_out_blk(P, SROW0 + (bs0 + 8 * (nseq - 1)) * 4, 0, LS, cBV + h * 128 + qtr * 32, OB(lds, (nseq - 1) & 1), ptid); st_store(p.out + o_sS + ((size_t)(l * NS + bs0 + 8 * (nseq - 1)) * 4 + h) * 16384, qtr, STB(lds, (nseq - 1) & 1), ptid); }
    BARRIER_LDS();
#undef LOADSTATE
#undef STISSUE
}


__device__ __forceinline__ void phase_scan(const Params& p, int l, float* lds) {
    for (int item = blockIdx.x; item < 256; item += gridDim.x) {
        const int qtr = item & 3, h = (item >> 2) & 3, bs = (item >> 4) & 7, branch = item >> 7;
        if (branch == 0) scan_mlstm_chunk(p, l, bs, h, qtr, bs * LPAD, LP, (unsigned char*)lds); else scan_gdn_chunk(p, l, bs, h, qtr, bs * LPAD, LP, (unsigned char*)lds);
    }
    for (int c = blockIdx.x; c < 256; c += gridDim.x) {
        const int qtr = c & 3, h = (c >> 2) & 3, branch = (c >> 4) & 1, bs0 = c >> 5;
        if (branch == 0) scan_mlstm_stream(p, l, h, qtr, bs0, NS / 8, lds); else scan_gdn_stream(p, l, h, qtr, bs0, NS / 8, lds);
    }
}

__device__ __forceinline__ void phase_norm(const Params& p, int l) {
    const int tid = opaque_tid(p.wv); const int wave = tid >> 6, lane = tid & 63;
    bf16_t* P = (bf16_t*)(p.ws + OFF_P);
    const int part = lane >> 5, hh = (lane >> 3) & 3, g = lane & 7, ch0 = hh * 128 + g * 16;
    const int craw = (part ? cBV : cV) + ch0, cgate = (part ? cZ : cO) + ch0;
    const float* wn = part ? p.b_norm_w + l * 128 + g * 16 : p.a_norm_w + l * 512 + ch0;
    for (int row = blockIdx.x * 8 + wave; row < MROWS; row += gridDim.x * 8) {
        if (row < SROW0 && (row % LPAD) >= LP) continue;
        bf16_t* pr = P + (size_t)row * NP;
        float x[16], z[16];
        unpack8(*(const u32x4*)(pr + craw), x); unpack8(*(const u32x4*)(pr + craw + 8), x + 8);
        unpack8(*(const u32x4*)(pr + cgate), z); unpack8(*(const u32x4*)(pr + cgate + 8), z + 8);
        float sum = 0.f;
#pragma unroll
        for (int i = 0; i < 16; ++i) sum += x[i];
        float mean = red8(sum) * (1.f / 128.f);
        if (part) mean = 0.f;
        float s2 = 0.f;
#pragma unroll
        for (int i = 0; i < 16; ++i) { x[i] -= mean; s2 += x[i] * x[i]; }
        const float rstd = rsqrtf(red8(s2) * (1.f / 128.f) + 1e-6f);
        float y[16];
#pragma unroll
        for (int i = 0; i < 16; ++i) { const float sg = sigmoidf_(z[i]); y[i] = x[i] * rstd * wn[i] * (part ? z[i] * sg : sg); }
        u32x4 o0, o1;
        o0.x = pk2(y[0], y[1]); o0.y = pk2(y[2], y[3]); o0.z = pk2(y[4], y[5]); o0.w = pk2(y[6], y[7]);
        o1.x = pk2(y[8], y[9]); o1.y = pk2(y[10], y[11]); o1.z = pk2(y[12], y[13]); o1.w = pk2(y[14], y[15]);
        *(u32x4*)(pr + cgate) = o0; *(u32x4*)(pr + cgate + 8) = o1;
    }
}

__device__ __forceinline__ void phase_convact(const Params& p, int l) {
    bf16_t* U = (bf16_t*)(p.ws + OFF_P); const bf16_t* HB = (const bf16_t*)(p.ws + OFF_HB);
    const float* cw = p.fconv_w + (size_t)l * 3 * NU;
    constexpr int NCG = DFF / 8, NRG = MROWS / 32;
    const int tid = opaque_tid(p.wv);
    for (int it = blockIdx.x * NTHREADS + tid; it < NRG * NCG; it += gridDim.x * NTHREADS) {
        const int rg = it / NCG, cg_ = it - rg * NCG, c0 = cg_ * 8;
        float wa[3][8], wb[3][8];
#pragma unroll
        for (int j = 0; j < 3; ++j) {
            const f32x4 a0 = *(const f32x4*)(cw + j * NU + c0), a1 = *(const f32x4*)(cw + j * NU + c0 + 4);
            const f32x4 b0 = *(const f32x4*)(cw + j * NU + DFF + c0), b1 = *(const f32x4*)(cw + j * NU + DFF + c0 + 4);
#pragma unroll
            for (int i = 0; i < 4; ++i) { wa[j][i] = a0[i]; wa[j][4 + i] = a1[i]; wb[j][i] = b0[i]; wb[j][4 + i] = b1[i]; }
        }
        float a2[8], a1[8], b2[8], b1[8];
        const bool samp = rg >= SROW0 / 32;
#pragma unroll
        for (int i = 0; i < 8; ++i) { a2[i] = a1[i] = b2[i] = b1[i] = 0.f; }
        if (!samp && (rg % (LPAD / 32)) != 0) {
            const bf16_t* h0 = HB + (size_t)(rg - 1) * 2 * NU;
            unpack8(*(const u32x4*)(h0 + c0), a2); unpack8(*(const u32x4*)(h0 + NU + c0), a1);
            unpack8(*(const u32x4*)(h0 + DFF + c0), b2); unpack8(*(const u32x4*)(h0 + NU + DFF + c0), b1);
        }
#pragma unroll 4
        for (int i = 0; i < 32; ++i) {
            const int row = rg * 32 + i;
            if (samp && (i & 3) == 0) {
                const float* st = p.st_fconv + ((size_t)(l * NS + ((row - SROW0) >> 2)) * 2) * NU;
                const f32x4 x0 = *(const f32x4*)(st + c0), x1 = *(const f32x4*)(st + c0 + 4), y0 = *(const f32x4*)(st + NU + c0), y1 = *(const f32x4*)(st + NU + c0 + 4);
                const f32x4 u0 = *(const f32x4*)(st + DFF + c0), u1 = *(const f32x4*)(st + DFF + c0 + 4), v0 = *(const f32x4*)(st + NU + DFF + c0), v1 = *(const f32x4*)(st + NU + DFF + c0 + 4);
#pragma unroll
                for (int e = 0; e < 4; ++e) { a2[e] = x0[e]; a2[4 + e] = x1[e]; a1[e] = y0[e]; a1[4 + e] = y1[e]; b2[e] = u0[e]; b2[4 + e] = u1[e]; b1[e] = v0[e]; b1[4 + e] = v1[e]; }
            }
            bf16_t* ur = U + (size_t)row * NU;
            float a[8], b[8], hh[8];
            unpack8(*(const u32x4*)(ur + c0), a); unpack8(*(const u32x4*)(ur + DFF + c0), b);
#pragma unroll
            for (int e = 0; e < 8; ++e) {
                const float ca = wa[0][e] * a2[e] + wa[1][e] * a1[e] + wa[2][e] * a[e];
                const float cb = wb[0][e] * b2[e] + wb[1][e] * b1[e] + wb[2][e] * b[e];
                hh[e] = ca * sigmoidf_(ca) * cb;
                a2[e] = a1[e]; a1[e] = a[e]; b2[e] = b1[e]; b1[e] = b[e];
            }
            u32x4 o; o.x = pk2(hh[0], hh[1]); o.y = pk2(hh[2], hh[3]); o.z = pk2(hh[4], hh[5]); o.w = pk2(hh[6], hh[7]);
            *(u32x4*)(ur + c0) = o;
        }
    }
}

#ifndef PROBE
#define PROBE 0
#endif
constexpr int NPHASE = 2 + DEPTH * 11;
__global__ void __launch_bounds__(NTHREADS) fwd_kernel(Params pin) {
    extern __shared__ __attribute__((aligned(16))) unsigned char smem_raw[];
    Params p = pin; p.wv = __builtin_amdgcn_readfirstlane((int)(threadIdx.x >> 6));
    unsigned* bar = (unsigned*)(p.ws + OFF_BAR); const unsigned xcc = xb_xcc_id();
    volatile LAS unsigned* xst = (volatile LAS unsigned*)(LAS unsigned char*)(smem_raw + LDS_GEMM);
    if (threadIdx.x == 0) { xst[0] = 0u; xst[1] = 0u; (void)xb_add(&bar[XB_XCNT(xcc)], 1u); }
    __syncthreads();
    float* lds = (float*)smem_raw;
    bf16_t* X = (bf16_t*)(p.ws + OFF_X); bf16_t* P = (bf16_t*)(p.ws + OFF_P); bf16_t* HB = (bf16_t*)(p.ws + OFF_HB);
    for (int ph = p.ph_lo; ph < p.ph_hi; ++ph) {
#if PROBE == 3
      for (int rep = 0; rep < 2; ++rep) { const int sx = ph < 2 ? -1 : (ph - 2) % 11; if (rep == 1 && !(ph < 2 || sx == 6 || sx == 10)) break;
#endif
        if (ph == 0) phase_weights(p, lds);
        else if (ph == 1) phase_ln(p, 0, nullptr, 0, p.ln_emb_g, p.ln_emb_b, 0, false);
        else {
            const int l = (ph - 2) / 11, s = (ph - 2) % 11;
            if (s == 0) { GemmArgs g{X, X, 1 << 30, D, w_inT(p, l), MROWS, NP, 1024}; gemm_phase(g, EpiP{P, (bf16_t*)(p.ws + OFF_GH), p.out, l}, p.wv); }
            else if (s == 1) phase_prep(p, l, lds);
            else if (s == 2) phase_scan(p, l, lds);
            else if (s == 3) phase_norm(p, l);
            else if (s == 4) { GemmArgs g{P + cO, P + cZ, 4, NP, w_abT(p, l), MROWS, 2048, 512}; gemm_phase(g, EpiMerge{P}, p.wv); }
            else if (s == 5) { GemmArgs g{P + cMG, P + cMG, 1 << 30, NP, w_outT(p, l), MROWS, 1024, 2048, 1}; gemm_phase(g, EpiRes{X, P, NP, 0, (bf16_t*)(p.ws + OFF_GH)}, p.wv); }
            else if (s == 6) phase_ln(p, 1, P, NP, p.ln1_g + l * D, p.ln1_b + l * D, -1, false);
            else if (s == 7) { GemmArgs g{X, X, 1 << 30, D, w_upT(p, l), MROWS, NU, 1024}; gemm_phase(g, EpiUp{P, HB, p.out, l}, p.wv); }
            else if (s == 8) phase_convact(p, l);
            else if (s == 9) { GemmArgs g{P, P, 1 << 30, NU, w_dnT(p, l), MROWS, 1024, DFF, 1}; gemm_phase(g, EpiRes{X, P, NU, DFF, (bf16_t*)(p.ws + OFF_GH)}, p.wv); }
            else phase_ln(p, 1, P + DFF, NU, p.ln2_g + l * D, p.ln2_b + l * D, l + 1 < DEPTH ? l + 1 : -1, l + 1 == DEPTH);
        }
#if PROBE == 3
      }
#endif
        if (ph + 1 < p.ph_hi) { if (ph == 0) cg::this_grid().sync(); else xcd_barrier(bar, xcc, xst, p.wv); }
    }
#if PROBE == 4
    for (int i = 0; i < 20; ++i) xcd_barrier(bar, xcc, xst, p.wv);
#endif
}

extern "C" void kernel_launch(void* const* d_in, const int* in_sizes, int n_in, void* d_out, int out_size, void* d_ws, size_t ws_size, hipStream_t stream) {
    static int grid = 0;
    if (grid == 0) {
        if (n_in != 28 || (size_t)out_size != o_end || ws_size < WS_END) { fprintf(stderr, "kernel_launch: unexpected sizes n_in %d out %d ws %zu (need %zu)\n", n_in, out_size, ws_size, (size_t)WS_END); grid = -1; return; }
        int dev = 0, cus = 0, per_cu = 0;
        hipGetDevice(&dev); hipDeviceGetAttribute(&cus, hipDeviceAttributeMultiprocessorCount, dev);
        if (hipFuncSetAttribute((const void*)fwd_kernel, hipFuncAttributeMaxDynamicSharedMemorySize, LDS_BYTES) != hipSuccess) { fprintf(stderr, "hipFuncSetAttribute failed\n"); grid = -1; return; }
        if (hipOccupancyMaxActiveBlocksPerMultiprocessor(&per_cu, (const void*)fwd_kernel, NTHREADS, LDS_BYTES) != hipSuccess || per_cu < 1) { fprintf(stderr, "occupancy query failed (%d)\n", per_cu); (void)hipGetLastError(); per_cu = 1; }
        grid = cus * per_cu;
        if (grid > 256) grid = 256;
    }
    if (grid < 0) return;
    if (hipMemsetAsync((unsigned char*)d_ws + OFF_BAR, 0, 16384, stream) != hipSuccess) { fprintf(stderr, "memset of barrier words failed\n"); return; }
    Params p{};
    const float** pp = (const float**)&p;
    for (int i = 0; i < 28; ++i) pp[i] = (const float*)d_in[i];
    p.out = (float*)d_out; p.ws = (unsigned char*)d_ws;
#if MULTI
    for (int ph = 0; ph < NPHASE; ++ph) { p.ph_lo = ph; p.ph_hi = ph + 1; hipLaunchKernelGGL(fwd_kernel, dim3(grid), dim3(NTHREADS), LDS_BYTES, stream, p); }
#else
    p.ph_lo = 0; p.ph_hi = NPHASE;
    void* args[] = {&p};
    hipError_t e = hipLaunchCooperativeKernel((const void*)fwd_kernel, dim3(grid), dim3(NTHREADS), args, LDS_BYTES, stream);
    if (e != hipSuccess) fprintf(stderr, "cooperative launch failed: %s (grid %d)\n", hipGetErrorString(e), grid);
#endif
}
```

```cpp
#include <hip/hip_runtime.h>
#include <hip/hip_cooperative_groups.h>
#include <cstdio>
namespace cg = cooperative_groups;

#ifndef MULTI
#define MULTI 0
#endif

typedef unsigned short bf16_t;
typedef short bf16x8 __attribute__((ext_vector_type(8)));
typedef float f32x4 __attribute__((ext_vector_type(4)));
typedef float f32x2 __attribute__((ext_vector_type(2)));
typedef unsigned u32x2 __attribute__((ext_vector_type(2)));
typedef unsigned u32x4 __attribute__((ext_vector_type(4)));

constexpr int D = 1024, NB = 8, LP = 2064, LPAD = 2080, NS = 128, LS = 4, DEPTH = 2, NMETA = 16, SEQ = 2048;
constexpr int MROWS = NB * LPAD + NS * LS;
constexpr int SROW0 = NB * LPAD;
constexpr int NIN = 6160, NP = 6144, DFF = 2816, NU = 5632;
constexpr int cQ = 0, cK = 512, cV = 1024, cO = 1536, cBQ = 2048, cBK = 2560, cBV = 3072, cZ = 3584, cMG = 4096;
constexpr float ALPHA = 1.4142135623730951f;
constexpr int SPLIT_ROW0 = 64 * 256;
constexpr int NTHREADS = 512;
constexpr int LDS_GEMM = 131072;
constexpr int LDS_BYTES = LDS_GEMM + 256;

constexpr size_t W_IN = (size_t)NP * 1024, W_AB = 2048 * 512, W_OUT = 1024 * 2048, W_UP = (size_t)NU * 1024, W_DN = (size_t)1024 * DFF;
constexpr size_t W_LAYER = W_IN + W_AB + W_OUT + W_UP + W_DN;
constexpr size_t OFF_W = 0;
constexpr size_t OFF_WG = OFF_W + DEPTH * W_LAYER * 2;
constexpr size_t OFF_X = OFF_WG + DEPTH * 16 * 1024 * 4;
constexpr size_t OFF_G = OFF_X + (size_t)MROWS * D * 2;
constexpr size_t OFF_HB = OFF_G + (size_t)MROWS * 16 * 4;
constexpr size_t OFF_P = OFF_HB + (size_t)(MROWS / 32) * 2 * NU * 2;
constexpr size_t OFF_GH = OFF_P + (size_t)MROWS * NP * 2;
constexpr size_t OFF_REC = OFF_GH + (size_t)(MROWS / 32) * 3 * 1536 * 2;
constexpr size_t OFF_BAR = OFF_REC + (size_t)MROWS * 4 * 16 * 4;
constexpr size_t OFF_TB = OFF_BAR + 16384;
constexpr size_t WS_END = OFF_TB + (size_t)(MROWS / 32) * 4 * 3 * 1024 * 2;

constexpr size_t o_yp = 0;
constexpr size_t o_ys = o_yp + (size_t)NB * SEQ * D;
constexpr size_t o_pC = o_ys + (size_t)NS * LS * D;
constexpr size_t o_pn = o_pC + (size_t)DEPTH * NB * 4 * 128 * 128;
constexpr size_t o_pm = o_pn + (size_t)DEPTH * NB * 4 * 128;
constexpr size_t o_pS = o_pm + (size_t)DEPTH * NB * 4;
constexpr size_t o_pgc = o_pS + (size_t)DEPTH * NB * 4 * 128 * 128;
constexpr size_t o_pfc = o_pgc + (size_t)DEPTH * NB * 3 * 1536;
constexpr size_t o_sC = o_pfc + (size_t)DEPTH * NB * 2 * NU;
constexpr size_t o_sn = o_sC + (size_t)DEPTH * NS * 4 * 128 * 128;
constexpr size_t o_sm = o_sn + (size_t)DEPTH * NS * 4 * 128;
constexpr size_t o_sS = o_sm + (size_t)DEPTH * NS * 4;
constexpr size_t o_sgc = o_sS + (size_t)DEPTH * NS * 4 * 128 * 128;
constexpr size_t o_sfc = o_sgc + (size_t)DEPTH * NS * 3 * 1536;
constexpr size_t o_end = o_sfc + (size_t)DEPTH * NS * 2 * NU;

struct Params {
    const float* x_prompt; const float* x_sample; const float* st_C; const float* st_n; const float* st_m; const float* st_S;
    const float* st_gconv; const float* st_fconv; const float* meta; const float* ln_emb_g; const float* ln_emb_b; const float* w_in;
    const float* gate_bias; const float* a_norm_w; const float* gconv_w; const float* A_log; const float* dt_bias; const float* b_norm_w;
    const float* w_pa; const float* w_pb; const float* w_out; const float* ln1_g; const float* ln1_b; const float* w_up;
    const float* fconv_w; const float* w_down; const float* ln2_g; const float* ln2_b;
    float* out; unsigned char* ws;
    int ph_lo, ph_hi;
    int wv, pad_;
};

__device__ __forceinline__ int opaque_tid(int wv) { int lane; asm volatile("v_mbcnt_lo_u32_b32 %0, -1, 0\n\tv_mbcnt_hi_u32_b32 %0, -1, %0" : "=v"(lane)); return wv * 64 + lane; }
__device__ __forceinline__ float bflo(unsigned u) { return __uint_as_float(u << 16); }
__device__ __forceinline__ float bfhi(unsigned u) { return __uint_as_float(u & 0xffff0000u); }
__device__ __forceinline__ unsigned pk2(float lo, float hi) { unsigned r; asm("v_cvt_pk_bf16_f32 %0, %1, %2" : "=v"(r) : "v"(lo), "v"(hi)); return r; }
template <int CTRL> __device__ __forceinline__ float dppf(float v) { return __int_as_float(__builtin_amdgcn_update_dpp(0, __float_as_int(v), CTRL, 0xf, 0xf, true)); }
__device__ __forceinline__ float red8(float v) { v += dppf<0xB1>(v); v += dppf<0x4E>(v); v += dppf<0x141>(v); return v; }
__device__ __forceinline__ float red16(float v) { v = red8(v); v += dppf<0x140>(v); return v; }
__device__ __forceinline__ float rdl(float v, int l) { return __int_as_float(__builtin_amdgcn_readlane(__float_as_int(v), l)); }
__device__ __forceinline__ float rdl_pin(float v, int l) { float r_; asm volatile("v_readlane_b32 %0, %1, %2" : "=s"(r_) : "v"(v), "s"(l)); return r_; }
__device__ __forceinline__ float red64(float v) { v = red16(v); return (rdl(v, 0) + rdl(v, 16)) + (rdl(v, 32) + rdl(v, 48)); }
__device__ __forceinline__ float sigmoidf_(float x) { return __builtin_amdgcn_rcpf(1.f + __expf(-x)); }
__device__ __forceinline__ u32x4 pack8(const float* y) { u32x4 o; o.x = pk2(y[0], y[1]); o.y = pk2(y[2], y[3]); o.z = pk2(y[4], y[5]); o.w = pk2(y[6], y[7]); return o; }
__device__ __forceinline__ void unpack8(u32x4 a, float* x) { x[0] = bflo(a.x); x[1] = bfhi(a.x); x[2] = bflo(a.y); x[3] = bfhi(a.y); x[4] = bflo(a.z); x[5] = bfhi(a.z); x[6] = bflo(a.w); x[7] = bfhi(a.w); }


#define XB_TMO      128
#define XB_XCNT(j)  (256  + 64 * (j))
#define XB_XSUB(j)  (1280 + 64 * (j))
#define XB_XGEN(j)  (2304 + 64 * (j))
#define XB_TOP      3328
#define XB_TOPGEN   3392
#define XCD_BAR_WORDS 3456
#define XB_SPIN_CAP (1u << 18)
#define LAS __attribute__((address_space(3)))
__device__ __forceinline__ unsigned xb_ld(unsigned* p)              { return __hip_atomic_load(p, __ATOMIC_RELAXED, __HIP_MEMORY_SCOPE_AGENT); }
__device__ __forceinline__ unsigned xb_add(unsigned* p, unsigned v) { return __hip_atomic_fetch_add(p, v, __ATOMIC_RELAXED, __HIP_MEMORY_SCOPE_AGENT); }
__device__ __forceinline__ unsigned xb_xcc_id() { return (unsigned)__builtin_amdgcn_s_getreg((3 << 11) | 20) & 0xFu; }
#define XB_SPIN(cond, bar) do { unsigned _sp = 0; while (cond) { __builtin_amdgcn_s_sleep(1); \
    if ((++_sp & 255u) == 0u) { if (xb_ld(&(bar)[XB_TMO])) break; if (_sp > XB_SPIN_CAP) { atomicAdd(&(bar)[XB_TMO], 1u); break; } } } } while (0)
__device__ __forceinline__ void xcd_barrier_complete(unsigned* bar, unsigned x, unsigned& nloc, unsigned& nx) {
    const unsigned G = gridDim.x;
    unsigned sum, cnt, mine, sp = 0u;
    for (;;) {
        sum = 0u; cnt = 0u; mine = 0u;
#pragma unroll
        for (unsigned j = 0; j < 16; ++j) { const unsigned c = xb_ld(&bar[XB_XCNT(j)]); sum += c; cnt += (c > 0u) ? 1u : 0u; mine = (j == x) ? c : mine; }
        if (sum == G) break;
        __builtin_amdgcn_s_sleep(1);
        if ((++sp & 255u) == 0u) { if (xb_ld(&bar[XB_TMO])) break; if (sp > XB_SPIN_CAP) { atomicAdd(&bar[XB_TMO], 1u); break; } }
    }
    nloc = mine > 0u ? mine : 1u; nx = cnt > 0u ? cnt : 1u;
}
__device__ __forceinline__ void xcd_barrier(unsigned* bar, unsigned x, volatile LAS unsigned* st, int wv) {
    asm volatile("s_waitcnt vmcnt(0)" ::: "memory");
    __syncthreads();
    if (opaque_tid(wv) == 0) {
        __builtin_amdgcn_s_waitcnt(0);
        unsigned nloc = st[0], nx = st[1];
        if (nloc == 0u) { xcd_barrier_complete(bar, x, nloc, nx); st[0] = nloc; st[1] = nx; }
        const unsigned old = xb_add(&bar[XB_XSUB(x)], 1u);
        const unsigned gen = old / nloc;
        if (old + 1u == (gen + 1u) * nloc) {
            __builtin_amdgcn_fence(__ATOMIC_RELEASE, "agent");
            asm volatile("s_waitcnt vmcnt(0)" ::: "memory");
            const unsigned og = xb_add(&bar[XB_TOP], 1u);
            const unsigned tg = og / nx;
            if (og + 1u == (tg + 1u) * nx) xb_add(&bar[XB_TOPGEN], 1u);
            else XB_SPIN(xb_ld(&bar[XB_TOPGEN]) == tg, bar);
            __builtin_amdgcn_fence(__ATOMIC_ACQUIRE, "agent");
            xb_add(&bar[XB_XGEN(x)], 1u);
            asm volatile("s_waitcnt vmcnt(0)" ::: "memory");
        } else {
            XB_SPIN(xb_ld(&bar[XB_XGEN(x)]) == gen, bar);
            __builtin_amdgcn_fence(__ATOMIC_ACQUIRE, "agent");
            asm volatile("s_waitcnt vmcnt(0)" ::: "memory");
        }
    }
    __syncthreads();
}

struct TJob { const float* src; int ldw; int K; int N; bf16_t* dst; int ldt; };
__device__ __forceinline__ void transpose_item(const TJob& jb, int item, float* scr, int lane) {
    const int nblk = jb.N / 32, kb = item / nblk, nb = item % nblk, k0 = 64 * kb, n0 = 32 * nb;
#pragma unroll 8
    for (int i = 0; i < 32; ++i) { const int kk = 2 * i + (lane >> 5); scr[kk * 33 + (lane & 31)] = jb.src[(size_t)(k0 + kk) * jb.ldw + n0 + (lane & 31)]; }
    __builtin_amdgcn_s_waitcnt(0xc07f); asm volatile("" ::: "memory");
    const int c = lane & 7;
#pragma unroll
    for (int j = 0; j < 4; ++j) { const int n = (lane >> 3) + 8 * j; const float* s = scr + (8 * c) * 33 + n;
        u32x4 o; o.x = pk2(s[0 * 33], s[1 * 33]); o.y = pk2(s[2 * 33], s[3 * 33]); o.z = pk2(s[4 * 33], s[5 * 33]); o.w = pk2(s[6 * 33], s[7 * 33]);
        *(u32x4*)(jb.dst + (size_t)(n0 + n) * jb.ldt + k0 + 8 * c) = o; }
    __builtin_amdgcn_s_waitcnt(0xc07f); asm volatile("" ::: "memory");
}
__device__ __forceinline__ bf16_t* wl(const Params& p, int l) { return (bf16_t*)(p.ws + OFF_W) + (size_t)l * W_LAYER; }
__device__ __forceinline__ bf16_t* w_inT(const Params& p, int l) { return wl(p, l); }
__device__ __forceinline__ bf16_t* w_abT(const Params& p, int l) { return wl(p, l) + W_IN; }
__device__ __forceinline__ bf16_t* w_outT(const Params& p, int l) { return wl(p, l) + W_IN + W_AB; }
__device__ __forceinline__ bf16_t* w_upT(const Params& p, int l) { return wl(p, l) + W_IN + W_AB + W_OUT; }
__device__ __forceinline__ bf16_t* w_dnT(const Params& p, int l) { return wl(p, l) + W_IN + W_AB + W_OUT + W_UP; }

__device__ __forceinline__ void phase_weights(const Params& p, float* lds) {
    const int tid = opaque_tid(p.wv); const int wave = tid >> 6, lane = tid & 63;
    float* scr = lds + wave * (64 * 33);
    const int gw = blockIdx.x * 8 + wave, NGW = gridDim.x * 8;
    constexpr int I0 = 16 * 64, I1 = 16 * 64, I2 = 16 * 64, I3 = 8 * 32, I4 = 8 * 32, I5 = 16 * 32, I6 = 16 * 32, I7 = 16 * (NU / 32), I8 = (DFF / 64) * 32;
    constexpr int IL = I0 + I1 + I2 + I3 + I4 + I5 + I6 + I7 + I8;
    for (int it = gw; it < DEPTH * IL; it += NGW) {
        const int l = it / IL; int r = it % IL;
        TJob jb;
        const float* win = p.w_in + (size_t)l * 1024 * NIN;
        if (r < I0) { jb = {win, NIN, 1024, 2048, w_inT(p, l), 1024}; }
        else if ((r -= I0) < I1) { jb = {win + 2056, NIN, 1024, 2048, w_inT(p, l) + (size_t)2048 * 1024, 1024}; }
        else if ((r -= I1) < I2) { jb = {win + 4112, NIN, 1024, 2048, w_inT(p, l) + (size_t)4096 * 1024, 1024}; }
        else if ((r -= I2) < I3) { jb = {p.w_pa + (size_t)l * 512 * 1024, 1024, 512, 1024, w_abT(p, l), 512}; }
        else if ((r -= I3) < I4) { jb = {p.w_pb + (size_t)l * 512 * 1024, 1024, 512, 1024, w_abT(p, l) + (size_t)1024 * 512, 512}; }
        else if ((r -= I4) < I5) { jb = {p.w_out + (size_t)l * 1024 * 1024, 1024, 1024, 1024, w_outT(p, l), 2048}; }
        else if ((r -= I5) < I6) { jb = {p.w_out + (size_t)l * 1024 * 1024, 1024, 1024, 1024, w_outT(p, l) + 1024, 2048}; }
        else if ((r -= I6) < I7) { jb = {p.w_up + (size_t)l * 1024 * NU, NU, 1024, NU, w_upT(p, l), 1024}; }
        else { r -= I7; jb = {p.w_down + (size_t)l * DFF * 1024, 1024, DFF, 1024, w_dnT(p, l), DFF}; }
        transpose_item(jb, r, scr, lane);
    }
    float* wg = (float*)(p.ws + OFF_WG);
    for (int i = blockIdx.x * NTHREADS + tid; i < DEPTH * 16 * 1024; i += gridDim.x * NTHREADS) {
        const int l = i >> 14, g = (i >> 10) & 15, k = i & 1023;
        const int col = g < 8 ? 2048 + g : 4104 + (g - 8);
        wg[i] = p.w_in[((size_t)l * 1024 + k) * NIN + col];
    }
}

__device__ __forceinline__ void phase_ln(const Params& p, int mode, const bf16_t* src, int ldsrc, const float* gam, const float* bet,
                                         int gate_layer  , bool final_out) {
    const int tid = opaque_tid(p.wv); const int wave = tid >> 6, lane = tid & 63;
    bf16_t* X = (bf16_t*)(p.ws + OFF_X);
    float* G = (float*)(p.ws + OFF_G);
    const float* wg = (const float*)(p.ws + OFF_WG) + (size_t)(gate_layer < 0 ? 0 : gate_layer) * 16 * 1024;
    for (int row = blockIdx.x * 8 + wave; row < MROWS; row += gridDim.x * 8) {
        int b = 0, t = 0; bool samp = row >= SROW0;
        if (!samp) { b = row / LPAD; t = row - b * LPAD; } else { b = (row - SROW0) >> 2; t = row & 3; }
        const bool valid = samp || t < LP;
        bf16_t* xo = X + (size_t)row * D;
        if (!valid) { if (mode == 0) {
#pragma unroll
                for (int j = 0; j < 4; ++j) *(u32x2*)(xo + 256 * j + lane * 4) = (u32x2){0u, 0u}; }
            continue; }
        f32x4 v[4];
        if (mode == 0) {
            const float* s = samp ? p.x_sample + ((size_t)b * LS + t) * D : (t < NMETA ? p.meta + (size_t)t * D : p.x_prompt + ((size_t)b * SEQ + (t - NMETA)) * D);
#pragma unroll
            for (int j = 0; j < 4; ++j) v[j] = *(const f32x4*)(s + 256 * j + lane * 4);
        } else {
            const bf16_t* s = src + (size_t)row * ldsrc;
#pragma unroll
            for (int j = 0; j < 4; ++j) { u32x2 u = *(const u32x2*)(s + 256 * j + lane * 4); v[j] = (f32x4){bflo(u.x), bfhi(u.x), bflo(u.y), bfhi(u.y)}; }
            if (row >= SPLIT_ROW0) { const bf16_t* sp = (const bf16_t*)(p.ws + OFF_GH) + (size_t)(row - SPLIT_ROW0) * D;
#pragma unroll
                for (int q = 0; q < 3; ++q)
#pragma unroll
                    for (int j = 0; j < 4; ++j) { const u32x2 u = *(const u32x2*)(sp + (size_t)q * (MROWS - SPLIT_ROW0) * D + 256 * j + lane * 4); v[j] += (f32x4){bflo(u.x), bfhi(u.x), bflo(u.y), bfhi(u.y)}; } }
        }
        float sum = 0.f;
#pragma unroll
        for (int j = 0; j < 4; ++j) sum += (v[j][0] + v[j][1]) + (v[j][2] + v[j][3]);
        const float mean = red64(sum) * (1.f / D);
        float s2 = 0.f;
#pragma unroll
        for (int j = 0; j < 4; ++j) { v[j] = v[j] - mean; s2 += (v[j][0] * v[j][0] + v[j][1] * v[j][1]) + (v[j][2] * v[j][2] + v[j][3] * v[j][3]); }
        const float rstd = rsqrtf(red64(s2) * (1.f / D) + 1e-5f);
#pragma unroll
        for (int j = 0; j < 4; ++j) { const f32x4 g4 = *(const f32x4*)(gam + 256 * j + lane * 4), b4 = *(const f32x4*)(bet + 256 * j + lane * 4);
            v[j] = v[j] * rstd * g4 + b4;
            *(u32x2*)(xo + 256 * j + lane * 4) = (u32x2){pk2(v[j][0], v[j][1]), pk2(v[j][2], v[j][3])}; }
        if (final_out) {
            float* o = nullptr;
            if (samp) o = p.out + o_ys + ((size_t)b * LS + t) * D; else if (t >= NMETA) o = p.out + o_yp + ((size_t)b * SEQ + (t - NMETA)) * D;
            if (o) {
#pragma unroll
                for (int j = 0; j < 4; ++j) *(f32x4*)(o + 256 * j + lane * 4) = v[j]; }
        }
        if (gate_layer >= 0) {
            float mine = 0.f;
#pragma unroll 2
            for (int g = 0; g < 16; ++g) {
                float a = 0.f;
#pragma unroll
                for (int j = 0; j < 4; ++j) { const f32x4 w4 = *(const f32x4*)(wg + g * 1024 + 256 * j + lane * 4); a += (v[j][0] * w4[0] + v[j][1] * w4[1]) + (v[j][2] * w4[2] + v[j][3] * w4[3]); }
                a = red64(a);
                if (lane == g) mine = a;
            }
            if (lane < 16) G[(size_t)row * 16 + lane] = mine;
        }
    }
}

constexpr int BM = 256, BK = 64, HALF = 128, HT = HALF * BK, NXCD = 8, WGM = 8;
__device__ __forceinline__ int lds_byte(int r, int c) { int st = (r >> 4) * 2 + (c >> 5), rr = r & 15, cc = c & 31, ob = rr * 64 + cc * 2; return st * 1024 + (ob ^ (((ob >> 9) & 1) << 5)); }
__device__ __forceinline__ void stage_rc(int b, int& R, int& C) { int st = b / 1024, sb = b % 1024, swz = sb ^ (((sb >> 9) & 1) << 5); R = (st >> 1) * 16 + swz / 64; C = (st & 1) * 32 + (swz % 64) / 2; }

struct GemmArgs { const bf16_t* A; const bf16_t* A2; int a2_from_pn; int lda; const bf16_t* Bt; int M, N, K; int splitk; };

template <class Epi>
__device__ __forceinline__ void gemm_phase(const GemmArgs g, const Epi& epi, int wv) {
    extern __shared__ __attribute__((aligned(16))) unsigned char smem_raw[];
    bf16_t* shm = (bf16_t*)smem_raw;
#define SA(b, h) (shm + ((b) * 2 + (h)) * HT)
#define SB(b, h) (shm + (4 + (b) * 2 + (h)) * HT)
#define STAGE_A(P_, br, kt) do { const char* _gb = (const char*)(A + (size_t)(br) * lda + (size_t)((kt) + kofs) * BK); \
    unsigned _o0 = offA0, _o1 = offA1; asm volatile("" : "+v"(_o0), "+v"(_o1)); \
    __builtin_amdgcn_global_load_lds((const unsigned*)(_gb + _o0), (unsigned*)((char*)(P_) + tid * 16), 16, 0, 0); \
    __builtin_amdgcn_global_load_lds((const unsigned*)(_gb + _o1), (unsigned*)((char*)(P_) + tid * 16 + 8192), 16, 0, 0); } while (0)
#define STAGE_B(P_, bc, kt) do { const char* _gb = (const char*)(Bt + (size_t)(bc) * K + (size_t)((kt) + kofs) * BK); \
    unsigned _o0 = offB0, _o1 = offB1; asm volatile("" : "+v"(_o0), "+v"(_o1)); \
    __builtin_amdgcn_global_load_lds((const unsigned*)(_gb + _o0), (unsigned*)((char*)(P_) + tid * 16), 16, 0, 0); \
    __builtin_amdgcn_global_load_lds((const unsigned*)(_gb + _o1), (unsigned*)((char*)(P_) + tid * 16 + 8192), 16, 0, 0); } while (0)
#define LDA(dst, b, h) for (int m = 0; m < 4; ++m) for (int k = 0; k < 2; ++k) \
    dst[m][k] = *reinterpret_cast<const bf16x8*>((char*)SA(b, h) + lds_byte(wr * 64 + m * 16 + fr, k * 32 + fq * 8))
#define LDB(dst, b, h) for (int n = 0; n < 2; ++n) for (int k = 0; k < 2; ++k) \
    dst[n][k] = *reinterpret_cast<const bf16x8*>((char*)SB(b, h) + lds_byte(wc * 32 + n * 16 + fr, k * 32 + fq * 8))
#define MMA(ai, bj, At_, Bt_) do { __builtin_amdgcn_s_setprio(1); \
    for (int m = 0; m < 4; ++m) for (int n = 0; n < 2; ++n) for (int k = 0; k < 2; ++k) \
      acc[ai][bj][m][n] = __builtin_amdgcn_mfma_f32_16x16x32_bf16(Bt_[n][k], At_[m][k], acc[ai][bj][m][n], 0, 0, 0); \
    __builtin_amdgcn_s_setprio(0); } while (0)
#define WAIT_V(n) asm volatile("s_waitcnt vmcnt(" #n ")" ::: "memory")
#define WAIT_L(n) asm volatile("s_waitcnt lgkmcnt(" #n ")" ::: "memory")
#define BAR __builtin_amdgcn_s_barrier()
#define SCHED __builtin_amdgcn_sched_barrier(0)
    const int lda = g.lda, K = g.K; const bf16_t* Bt = g.Bt;
    const int nMall = g.M / BM, nN = g.N / BM, nM = g.splitk ? 64 : nMall, nwg = nM * nN, nunits = nwg + (nMall - nM) * nN * 4;
    const int tid = opaque_tid(wv);
    const int wid = tid >> 6, lane = tid & 63, wr = wid >> 2, wc = wid & 3, fr = lane & 15, fq = lane >> 4;
    const int ntK = K / BK;
    unsigned offA0, offA1, offB0, offB1;
    { int r0, c0, r1, c1; stage_rc(tid * 16, r0, c0); stage_rc(tid * 16 + 8192, r1, c1);
      offA0 = (unsigned)(r0 * lda + c0) * 2u; offA1 = (unsigned)(r1 * lda + c1) * 2u;
      const int p0 = (r0 & ~31) + 8 * ((r0 & 15) >> 2) + 4 * ((r0 >> 4) & 1) + (r0 & 3), p1 = (r1 & ~31) + 8 * ((r1 & 15) >> 2) + 4 * ((r1 >> 4) & 1) + (r1 & 3);
      offB0 = (unsigned)(p0 * K + c0) * 2u; offB1 = (unsigned)(p1 * K + c1) * 2u; }
    for (int Lt = blockIdx.x; Lt < nunits; Lt += gridDim.x) {
        int pm, pn, kofs = 0, nt = ntK, split = 0;
        if (Lt < nwg) {
            int wgid = Lt;
            { int q = nwg / NXCD, r = nwg % NXCD, xcd = wgid % NXCD, off = wgid / NXCD; wgid = (xcd < r ? xcd * (q + 1) : r * (q + 1) + (xcd - r) * q) + off; }
            const int nig = WGM * nN, gid = wgid / nig, fm = gid * WGM, gsz = min(nM - fm, WGM);
            pm = fm + ((wgid % nig) % gsz); pn = (wgid % nig) / gsz;
        } else {
            const int u = Lt - nwg, tl = u >> 2; split = u & 3; pm = nM + tl / nN; pn = tl % nN;
            const int q4 = ntK >> 2;
            if (q4 & 1) { nt = split < 2 ? q4 + 1 : q4 - 1; kofs = split < 2 ? split * (q4 + 1) : 2 * (q4 + 1) + (split - 2) * (q4 - 1); } else { nt = q4; kofs = split * q4; }
        }
        const int brow = pm * BM, bcol = pn * BM;
        const bf16_t* A = (pn >= g.a2_from_pn) ? g.A2 : g.A;
        f32x4 acc[2][2][4][2] = {};
        bf16x8 At[4][2], B0[2][2], B1[2][2];
        STAGE_B(SB(0, 0), bcol, 0); STAGE_A(SA(0, 0), brow, 0);
        STAGE_B(SB(0, 1), bcol + HALF, 0); STAGE_A(SA(0, 1), brow + HALF, 0);
        if (wr == 1) BAR;
        WAIT_V(4); BAR;
        STAGE_B(SB(1, 0), bcol, 1); STAGE_A(SA(1, 0), brow, 1); STAGE_B(SB(1, 1), bcol + HALF, 1);
        WAIT_V(6); BAR;
        for (int t = 0; t < nt - 2; t += 2) {
            LDB(B0, 0, 0); SCHED; LDA(At, 0, 0); STAGE_A(SA(1, 1), brow + HALF, t + 1);
            WAIT_L(8); BAR; WAIT_L(0); MMA(0, 0, At, B0); BAR; SCHED;
            LDB(B1, 0, 1); STAGE_B(SB(0, 0), bcol, t + 2);
            BAR; WAIT_L(0); MMA(0, 1, At, B1); BAR;
            LDA(At, 0, 1); STAGE_A(SA(0, 0), brow, t + 2);
            BAR; WAIT_L(0); MMA(1, 0, At, B0); BAR; SCHED;
            STAGE_B(SB(0, 1), bcol + HALF, t + 2);
            WAIT_V(6); BAR; MMA(1, 1, At, B1); BAR;
            LDB(B0, 1, 0); SCHED; LDA(At, 1, 0); STAGE_A(SA(0, 1), brow + HALF, t + 2);
            WAIT_L(8); BAR; WAIT_L(0); MMA(0, 0, At, B0); BAR; SCHED;
            LDB(B1, 1, 1); STAGE_B(SB(1, 0), bcol, t + 3);
            BAR; WAIT_L(0); MMA(0, 1, At, B1); BAR;
            LDA(At, 1, 1); STAGE_A(SA(1, 0), brow, t + 3);
            BAR; WAIT_L(0); MMA(1, 0, At, B0); BAR; SCHED;
            STAGE_B(SB(1, 1), bcol + HALF, t + 3);
            WAIT_V(6); BAR; MMA(1, 1, At, B1); BAR;
        }
        { LDB(B0, 0, 0); LDA(At, 0, 0); STAGE_A(SA(1, 1), brow + HALF, nt - 1);
          BAR; WAIT_L(0); MMA(0, 0, At, B0); BAR;
          LDB(B1, 0, 1); BAR; WAIT_L(0); MMA(0, 1, At, B1); BAR;
          LDA(At, 0, 1); WAIT_V(4); BAR; WAIT_L(0); MMA(1, 0, At, B0); MMA(1, 1, At, B1); BAR; }
        { LDB(B0, 1, 0); LDA(At, 1, 0); WAIT_V(2); BAR; WAIT_L(0); MMA(0, 0, At, B0); BAR;
          LDB(B1, 1, 1); WAIT_V(0); BAR; WAIT_L(0); MMA(0, 1, At, B1); BAR;
          LDA(At, 1, 1); BAR; WAIT_L(0); MMA(1, 0, At, B0); MMA(1, 1, At, B1); BAR; }
        if (wr == 0) BAR;
        int erow = brow + wr * 64 + fr, ecol = bcol + wc * 32 + fq * 8;
        asm volatile("" : "+v"(erow), "+v"(ecol));
#pragma unroll
        for (int ai = 0; ai < 2; ++ai)
#pragma unroll
            for (int m = 0; m < 4; ++m) {
                const int row = erow + ai * HALF + m * 16;
#pragma unroll
                for (int bj = 0; bj < 2; ++bj) epi(row, ecol + bj * HALF, acc[ai][bj][m][0], acc[ai][bj][m][1], split);
                if (m & 1) SCHED;
            }
        __syncthreads();
    }
#undef SA
#undef SB
}

struct EpiP {
    bf16_t* P; bf16_t* GH; float* out; int l;
    __device__ __forceinline__ void operator()(int row, int col, f32x4 v, f32x4 w, int split) const {
        const u32x4 o = (u32x4){pk2(v[0], v[1]), pk2(v[2], v[3]), pk2(w[0], w[1]), pk2(w[2], w[3])};
        *(u32x4*)(P + (size_t)row * NP + col) = o;
        if (col >= cBQ && col < cZ) {
            const int c = col - cBQ;
            if ((row & 31) >= 29) *(u32x4*)(GH + ((size_t)(row >> 5) * 3 + ((row & 31) - 29)) * 1536 + c) = o;
            if (row < SROW0) { const int b = row / LPAD, t = row - b * LPAD; if (t >= LP - 3 && t < LP) { float* d = out + o_pgc + ((size_t)(l * NB + b) * 3 + (t - (LP - 3))) * 1536 + c; *(f32x4*)d = v; *(f32x4*)(d + 4) = w; } }
            else { const int s = (row - SROW0) >> 2, t = row & 3; if (t >= 1) { float* d = out + o_sgc + ((size_t)(l * NS + s) * 3 + (t - 1)) * 1536 + c; *(f32x4*)d = v; *(f32x4*)(d + 4) = w; } }
        }
    }
};
struct EpiMerge {
    bf16_t* P;
    __device__ __forceinline__ void operator()(int row, int col, f32x4 v, f32x4 w, int split) const {
        u32x4* ptr = (u32x4*)(P + (size_t)row * NP + cMG + col); const u32x4 gm = *ptr;
        v[0] *= sigmoidf_(bflo(gm.x)); v[1] *= sigmoidf_(bfhi(gm.x)); v[2] *= sigmoidf_(bflo(gm.y)); v[3] *= sigmoidf_(bfhi(gm.y));
        w[0] *= sigmoidf_(bflo(gm.z)); w[1] *= sigmoidf_(bfhi(gm.z)); w[2] *= sigmoidf_(bflo(gm.w)); w[3] *= sigmoidf_(bfhi(gm.w));
        *ptr = (u32x4){pk2(v[0], v[1]), pk2(v[2], v[3]), pk2(w[0], w[1]), pk2(w[2], w[3])};
    }
};
struct EpiRes {
    const bf16_t* X; bf16_t* O; int ldo; int ocol0; bf16_t* SCR;
    __device__ __forceinline__ void operator()(int row, int col, f32x4 v, f32x4 w, int split) const {
        if (split == 0) {
            const u32x4 x = *(const u32x4*)(X + (size_t)row * D + col);
            v[0] += ALPHA * bflo(x.x); v[1] += ALPHA * bfhi(x.x); v[2] += ALPHA * bflo(x.y); v[3] += ALPHA * bfhi(x.y);
            w[0] += ALPHA * bflo(x.z); w[1] += ALPHA * bfhi(x.z); w[2] += ALPHA * bflo(x.w); w[3] += ALPHA * bfhi(x.w);
            *(u32x4*)(O + (size_t)row * ldo + ocol0 + col) = (u32x4){pk2(v[0], v[1]), pk2(v[2], v[3]), pk2(w[0], w[1]), pk2(w[2], w[3])};
        } else *(u32x4*)(SCR + ((size_t)(split - 1) * (MROWS - SPLIT_ROW0) + (row - SPLIT_ROW0)) * D + col) = (u32x4){pk2(v[0], v[1]), pk2(v[2], v[3]), pk2(w[0], w[1]), pk2(w[2], w[3])};
    }
};
struct EpiUp {
    bf16_t* U; bf16_t* HB; float* out; int l;
    __device__ __forceinline__ void operator()(int row, int col, f32x4 v, f32x4 w, int split) const {
        const u32x4 o = (u32x4){pk2(v[0], v[1]), pk2(v[2], v[3]), pk2(w[0], w[1]), pk2(w[2], w[3])};
        *(u32x4*)(U + (size_t)row * NU + col) = o;
        if ((row & 31) >= 30) *(u32x4*)(HB + ((size_t)(row >> 5) * 2 + (row & 1)) * NU + col) = o;
        if (row < SROW0) { const int b = row / LPAD, t = row - b * LPAD; if (t >= LP - 2 && t < LP) { float* d = out + o_pfc + ((size_t)(l * NB + b) * 2 + (t - (LP - 2))) * NU + col; *(f32x4*)d = v; *(f32x4*)(d + 4) = w; } }
        else { const int s = (row - SROW0) >> 2, t = row & 3; if (t >= 2) { float* d = out + o_sfc + ((size_t)(l * NS + s) * 2 + (t - 2)) * NU + col; *(f32x4*)d = v; *(f32x4*)(d + 4) = w; } }
    }
};

constexpr int SBUF = 32 * 128 * 2 + 32 * 32 + 32 * 16;
__device__ __forceinline__ float* QB(float* lds, int b) { return lds + b * SBUF; }
__device__ __forceinline__ float* KB(float* lds, int b) { return lds + b * SBUF + 4096; }
__device__ __forceinline__ float* VB(float* lds, int b) { return lds + b * SBUF + 8192; }
__device__ __forceinline__ float* SCB(float* lds, int b) { return lds + b * SBUF + 9216; }
__device__ __forceinline__ float* OB(float* lds, int b) { return lds + 2 * SBUF + b * 1024; }

__device__ __forceinline__ void store_out_blk(bf16_t* P, int row0, int jb, int L, int pcol, const float* ob, int ptid) {
    const int tt = ptid >> 3, g = ptid & 7, t0 = jb * 32;
    if (t0 + tt < L) { const f32x4 v = *(const f32x4*)(ob + tt * 32 + g * 4);
        *(u32x2*)(P + (size_t)(row0 + t0 + tt) * NP + pcol + g * 4) = (u32x2){pk2(v[0], v[1]), pk2(v[2], v[3])}; }
}
__device__ __forceinline__ f32x2 lo2(f32x4 v) { return __builtin_shufflevector(v, v, 0, 1); }
__device__ __forceinline__ f32x2 hi2(f32x4 v) { return __builtin_shufflevector(v, v, 2, 3); }
__device__ __forceinline__ f32x2 bc2(float x) { return (f32x2){x, x}; }
__device__ __forceinline__ float dot16(const f32x4* a, const float* kp) {
    float s = 0.f;
#pragma unroll
    for (int i = 0; i < 4; ++i) { const f32x4 b = *(const f32x4*)(kp + 4 * i); s += (a[i][0] * b[0] + a[i][1] * b[1]) + (a[i][2] * b[2] + a[i][3] * b[3]); }
    return s;
}

struct StageRegs { f32x4 &q0, &q1, &k0, &k1, &v, &r0, &x0, &x1; };
__device__ __forceinline__ f32x4 asf(u32x4 u) { return __builtin_bit_cast(f32x4, u); }
__device__ __forceinline__ u32x4 asu(f32x4 f) { return __builtin_bit_cast(u32x4, f); }
#define BARRIER_LDS() asm volatile("s_waitcnt lgkmcnt(0)\n\ts_barrier" ::: "memory")
__device__ __forceinline__ void issue_mlstm(const Params& p, int h, int qtr, int row0, int L, int jb, int ptid, StageRegs& r) {
    const bf16_t* P = (const bf16_t*)(p.ws + OFF_P); const float* G = (const float*)(p.ws + OFF_G);
    const int tt = ptid >> 3, g = ptid & 7, t0 = jb * 32;
    if (t0 + tt >= L) return;
    const int row = row0 + t0 + tt;
    const bf16_t* prow = P + (size_t)row * NP;
    r.q0 = asf(*(const u32x4*)(prow + cQ + h * 128 + g * 16)); r.q1 = asf(*(const u32x4*)(prow + cQ + h * 128 + g * 16 + 8));
    r.k0 = asf(*(const u32x4*)(prow + cK + h * 128 + g * 16)); r.k1 = asf(*(const u32x4*)(prow + cK + h * 128 + g * 16 + 8));
    { const u32x2 vv_ = *(const u32x2*)(prow + cV + h * 128 + qtr * 32 + g * 4); r.v = asf((u32x4){vv_.x, vv_.y, 0u, 0u}); }
    if (g == 0) { const float* gr = G + (size_t)row * 16; r.r0 = (f32x4){gr[h], gr[4 + h], 0.f, 0.f}; }
}
__device__ __forceinline__ void commit_mlstm(const Params& p, int l, int h, int L, int jb, float* lds, int ptid, const StageRegs& r, int bsel = -1) {
    const int tt = ptid >> 3, g = ptid & 7, t0 = jb * 32, b = bsel >= 0 ? bsel : (jb & 1);
    if (t0 + tt >= L) return;
    float x[16]; f32x4 qs[4];
    unpack8(asu(r.q0), x); unpack8(asu(r.q1), x + 8);
    float* qd = QB(lds, b) + tt * 128 + g * 16;
#pragma unroll
    for (int i = 0; i < 4; ++i) { qs[i] = (f32x4){x[4 * i], x[4 * i + 1], x[4 * i + 2], x[4 * i + 3]} * 0.08838834764831845f; *(f32x4*)(qd + 4 * i) = qs[i]; }
    unpack8(asu(r.k0), x); unpack8(asu(r.k1), x + 8);
    float* kd = KB(lds, b) + tt * 128 + g * 16;
#pragma unroll
    for (int i = 0; i < 4; ++i) *(f32x4*)(kd + 4 * i) = (f32x4){x[4 * i], x[4 * i + 1], x[4 * i + 2], x[4 * i + 3]};
    *(f32x4*)(VB(lds, b) + tt * 32 + g * 4) = (f32x4){bflo(asu(r.v).x), bfhi(asu(r.v).x), bflo(asu(r.v).y), bfhi(asu(r.v).y)};
    const float* kmb = KB(lds, b) + (tt & ~3) * 128 + g * 16;
    f32x4 qk;
#pragma unroll
    for (int j = 0; j < 4; ++j) qk[j] = red8(dot16(qs, kmb + j * 128));
    if (g == 0) {
        const float ig = r.r0[0] + p.gate_bias[l * 8 + h], f = r.r0[1] + p.gate_bias[l * 8 + 4 + h];
        const float lf = fminf(f, 0.f) - log1pf(__expf(-fabsf(f)));
        float* sc = SCB(lds, b) + tt * 16; *(f32x2*)sc = (f32x2){ig, lf}; *(f32x4*)(sc + 4) = qk; }
}

__device__ __forceinline__ void scan_mlstm(const Params& p, int l, bool samp, int bs, int h, int qtr, int row0, int L, float* lds) {
    const int tid = opaque_tid(p.wv); const bool cons = tid < 256; const int ptid = tid - 256;
    const int lane = tid & 63, w = (tid >> 6) & 3, s = lane & 7, cl = w * 8 + (lane >> 3), col = qtr * 32 + cl;
    const int e2 = 2 * (lane >> 3), nd = (e2 >> 2) * 32 + s * 4 + (e2 & 3);
    bf16_t* P = (bf16_t*)(p.ws + OFF_P);
    f32x2 C[8]; float n0v = 0.f, n1v = 0.f, m = 0.f;
#pragma unroll
    for (int e = 0; e < 8; ++e) C[e] = bc2(0.f);
    if (cons && samp) {
        const size_t sh = (size_t)(l * NS + bs) * 4 + h;
        const float* C0 = p.st_C + sh * 16384;
#pragma unroll
        for (int e = 0; e < 16; ++e) { const int d = (e >> 2) * 32 + s * 4 + (e & 3); C[e >> 1][e & 1] = C0[d * 128 + col]; }
        n0v = p.st_n[sh * 128 + nd]; n1v = p.st_n[sh * 128 + nd + 1]; m = p.st_m[sh];
    }
    const int nblk = (L + 31) >> 5;
    f32x4 k4[4][4];
    StageRegs sr{k4[0][0], k4[0][1], k4[0][2], k4[0][3], k4[1][0], k4[1][1], k4[1][2], k4[1][3]};
    if (!cons) { issue_mlstm(p, h, qtr, row0, L, 0, ptid, sr); commit_mlstm(p, l, h, L, 0, lds, ptid, sr); if (1 < nblk) issue_mlstm(p, h, qtr, row0, L, 1, ptid, sr); }
    BARRIER_LDS();
    for (int jb = 0; jb < nblk; ++jb) {
        if (!cons) {
            if (jb + 1 < nblk) commit_mlstm(p, l, h, L, jb + 1, lds, ptid, sr);
            if (jb + 2 < nblk) issue_mlstm(p, h, qtr, row0, L, jb + 2, ptid, sr);
            if (jb > 0) store_out_blk(P, row0, jb - 1, L, cV + h * 128 + qtr * 32, OB(lds, (jb - 1) & 1), ptid);
        } else {
            const float* qb = QB(lds, jb & 1); const float* kb = KB(lds, jb & 1); const float* vb = VB(lds, jb & 1); const float* sc = SCB(lds, jb & 1);
            float* ob = OB(lds, jb & 1);
            const int nt = min(32, L - jb * 32);
            f32x4 q4[4][4]; f32x2 kn[4], qn[4]; float vv[4], ig[4], lf[4]; f32x4 qk[4];
#define MLOAD_Q(T0) do { _Pragma("unroll") for (int i = 0; i < 4; ++i) { const int t = (T0) + i; \
        _Pragma("unroll") for (int j = 0; j < 4; ++j) q4[i][j] = *(const f32x4*)(qb + t * 128 + j * 32 + s * 4); \
        qn[i] = *(const f32x2*)(qb + t * 128 + nd); } } while (0)
#define MLOAD_K(T0) do { _Pragma("unroll") for (int i = 0; i < 4; ++i) { const int t = (T0) + i; \
        const f32x2 gg = *(const f32x2*)(sc + t * 16); ig[i] = gg[0]; lf[i] = gg[1]; \
        qk[i] = *(const f32x4*)(sc + t * 16 + 4); vv[i] = vb[t * 32 + cl]; } \
      _Pragma("unroll") for (int i = 0; i < 4; ++i) { const int t = (T0) + i; \
        _Pragma("unroll") for (int j = 0; j < 4; ++j) k4[i][j] = *(const f32x4*)(kb + t * 128 + j * 32 + s * 4); \
        kn[i] = *(const f32x2*)(kb + t * 128 + nd); } } while (0)
            MLOAD_Q(0); MLOAD_K(0);
#pragma unroll 1
            for (int t0 = 0; t0 < nt; t0 += 4) {
                float d[4], dn[4];
                const int tn = min(t0 + 4, 28);
                __builtin_amdgcn_sched_barrier(0);
#pragma unroll
                for (int i = 0; i < 4; ++i) {
                    f32x2 a = bc2(0.f), a2 = bc2(0.f);
#pragma unroll
                    for (int j = 0; j < 4; ++j) { a = lo2(q4[i][j]) * C[2 * j] + a; a2 = hi2(q4[i][j]) * C[2 * j + 1] + a2; }
                    a = a + a2;
                    d[i] = a[0] + a[1]; dn[i] = qn[i][0] * n0v + qn[i][1] * n1v;
                }
                __builtin_amdgcn_sched_barrier(0);
                MLOAD_Q(tn);
                __builtin_amdgcn_sched_barrier(0);
#pragma unroll
                for (int i = 0; i < 4; ++i) { d[i] = red8(d[i]); dn[i] = red64(dn[i]); }
                float fp[4], ip[4], em[4];
#pragma unroll
                for (int i = 0; i < 4; ++i) { const float mn = fmaxf(lf[i] + m, ig[i]); fp[i] = __expf(lf[i] + m - mn); ip[i] = __expf(ig[i] - mn); em[i] = __expf(-mn); m = mn; }
                const float F0 = fp[0], F1 = F0 * fp[1], F2 = F1 * fp[2], F3 = F2 * fp[3];
                const float g00 = ip[0], g10 = g00 * fp[1], g11 = ip[1], g20 = g10 * fp[2], g21 = g11 * fp[2], g22 = ip[2];
                const float g30 = g20 * fp[3], g31 = g21 * fp[3], g32 = g22 * fp[3], g33 = ip[3];
                const float s00 = g00 * qk[0][0];
                const float s10 = g10 * qk[1][0], s11 = g11 * qk[1][1];
                const float s20 = g20 * qk[2][0], s21 = g21 * qk[2][1], s22 = g22 * qk[2][2];
                const float s30 = g30 * qk[3][0], s31 = g31 * qk[3][1], s32 = g32 * qk[3][2], s33 = g33 * qk[3][3];
                const float num0 = F0 * d[0] + s00 * vv[0], den0 = F0 * dn[0] + s00;
                const float num1 = F1 * d[1] + s10 * vv[0] + s11 * vv[1], den1 = F1 * dn[1] + s10 + s11;
                const float num2 = F2 * d[2] + s20 * vv[0] + s21 * vv[1] + s22 * vv[2], den2 = F2 * dn[2] + s20 + s21 + s22;
                const float num3 = F3 * d[3] + s30 * vv[0] + s31 * vv[1] + s32 * vv[2] + s33 * vv[3], den3 = F3 * dn[3] + s30 + s31 + s32 + s33;
                if (s == 0) {
                    ob[(t0 + 0) * 32 + cl] = num0 / fmaxf(fabsf(den0), em[0]); ob[(t0 + 1) * 32 + cl] = num1 / fmaxf(fabsf(den1), em[1]);
                    ob[(t0 + 2) * 32 + cl] = num2 / fmaxf(fabsf(den2), em[2]); ob[(t0 + 3) * 32 + cl] = num3 / fmaxf(fabsf(den3), em[3]);
                }
                const float c0 = g30 * vv[0], c1 = g31 * vv[1], c2 = g32 * vv[2], c3 = g33 * vv[3];
#pragma unroll
                for (int j = 0; j < 4; ++j) {
                    C[2 * j] = lo2(k4[3][j]) * bc2(c3) + (lo2(k4[2][j]) * bc2(c2) + (lo2(k4[1][j]) * bc2(c1) + (lo2(k4[0][j]) * bc2(c0) + C[2 * j] * bc2(F3))));
                    C[2 * j + 1] = hi2(k4[3][j]) * bc2(c3) + (hi2(k4[2][j]) * bc2(c2) + (hi2(k4[1][j]) * bc2(c1) + (hi2(k4[0][j]) * bc2(c0) + C[2 * j + 1] * bc2(F3)))); }
                n0v = n0v * F3 + (kn[0][0] * g30 + kn[1][0] * g31) + (kn[2][0] * g32 + kn[3][0] * g33);
                n1v = n1v * F3 + (kn[0][1] * g30 + kn[1][1] * g31) + (kn[2][1] * g32 + kn[3][1] * g33);
                __builtin_amdgcn_sched_barrier(0);
                MLOAD_K(tn);
            }
#undef MLOAD_Q
#undef MLOAD_K
        }
        BARRIER_LDS();
    }
    if (!cons) store_out_blk(P, row0, nblk - 1, L, cV + h * 128 + qtr * 32, OB(lds, (nblk - 1) & 1), ptid);
    else {
        const size_t sh = samp ? (size_t)(l * NS + bs) * 4 + h : (size_t)(l * NB + bs) * 4 + h;
        float* Co = p.out + (samp ? o_sC : o_pC) + sh * 16384;
#pragma unroll
        for (int e = 0; e < 16; ++e) { const int d = (e >> 2) * 32 + s * 4 + (e & 3); Co[d * 128 + col] = C[e >> 1][e & 1]; }
        if (qtr == 0 && w == 0) { float* no = p.out + (samp ? o_sn : o_pn) + sh * 128; no[nd] = n0v; no[nd + 1] = n1v;
            if (lane == 0) p.out[(samp ? o_sm : o_pm) + sh] = m; }
    }
    BARRIER_LDS();
}


constexpr int ST_LD = 33;
__device__ __forceinline__ float* STB(float* lds, int b) { return lds + 2 * SBUF + 2048 + b * (128 * ST_LD); }
__device__ __forceinline__ void st_issue(const float* S0, int qtr, int ptid, f32x4& a0, f32x4& a1, f32x4& a2, f32x4& a3) {
    const int d = ptid >> 3, c = (ptid & 7) * 4; const float* b = S0 + d * 128 + qtr * 32 + c;
    a0 = *(const f32x4*)b; a1 = *(const f32x4*)(b + 32 * 128); a2 = *(const f32x4*)(b + 64 * 128); a3 = *(const f32x4*)(b + 96 * 128);
}
__device__ __forceinline__ void st_commit(float* st, int ptid, const f32x4& a0, const f32x4& a1, const f32x4& a2, const f32x4& a3) {
    const int d = ptid >> 3, c = (ptid & 7) * 4; float* b = st + d * ST_LD + c;
#pragma unroll
    for (int i = 0; i < 4; ++i) { b[i] = a0[i]; b[32 * ST_LD + i] = a1[i]; b[64 * ST_LD + i] = a2[i]; b[96 * ST_LD + i] = a3[i]; }
}
__device__ __forceinline__ void st_store(float* So, int qtr, const float* st, int ptid) {
    const int d = ptid >> 3, c = (ptid & 7) * 4; const float* b = st + d * ST_LD + c; float* o = So + d * 128 + qtr * 32 + c;
#pragma unroll
    for (int q = 0; q < 4; ++q) *(f32x4*)(o + q * 32 * 128) = (f32x4){b[q * 32 * ST_LD], b[q * 32 * ST_LD + 1], b[q * 32 * ST_LD + 2], b[q * 32 * ST_LD + 3]};
}
__device__ __forceinline__ void scan_mlstm_stream(const Params& p, int l, int h, int qtr, int bs0, int nseq, float* lds) {
    const int tid = opaque_tid(p.wv); const bool cons = tid < 256; const int ptid = tid - 256;
    const int lane = tid & 63, w = (tid >> 6) & 3, s = lane & 7, cl = w * 8 + (lane >> 3), col = qtr * 32 + cl;
    const int e2 = 2 * (lane >> 3), nd = (e2 >> 2) * 32 + s * 4 + (e2 & 3);
    bf16_t* P = (bf16_t*)(p.ws + OFF_P);
    f32x2 C[8]; float n0v = 0.f, n1v = 0.f, m = 0.f, n0n = 0.f, n1n = 0.f, mnx = 0.f;
#pragma unroll
    for (int e = 0; e < 8; ++e) C[e] = bc2(0.f);
    f32x4 k4[4][4];
    StageRegs sr{k4[0][0], k4[0][1], k4[0][2], k4[0][3], k4[1][0], k4[1][1], k4[1][2], k4[1][3]};
#define LOADSTATE(BS) do { const size_t sh_ = (size_t)(l * NS + (BS)) * 4 + h; n0n = p.st_n[sh_ * 128 + nd]; n1n = p.st_n[sh_ * 128 + nd + 1]; mnx = p.st_m[sh_]; } while (0)
#define STISSUE(BS) st_issue(p.st_C + ((size_t)(l * NS + (BS)) * 4 + h) * 16384, qtr, ptid, k4[2][0], k4[2][1], k4[2][2], k4[2][3])
    if (!cons) { issue_mlstm(p, h, qtr, SROW0 + bs0 * 4, LS, 0, ptid, sr); STISSUE(bs0); } else LOADSTATE(bs0);
#pragma unroll 1
    for (int k = 0; k < nseq; ++k) {
        const int bs = bs0 + 8 * k, row0 = SROW0 + bs * 4;
        if (!cons) { commit_mlstm(p, l, h, LS, 0, lds, ptid, sr, k & 1); st_commit(STB(lds, k & 1), ptid, k4[2][0], k4[2][1], k4[2][2], k4[2][3]);
            if (k + 1 < nseq) { issue_mlstm(p, h, qtr, row0 + 32, LS, 0, ptid, sr); STISSUE(bs + 8); } }
        else {
            n0v = n0n; n1v = n1n; m = mnx;
            if (k + 1 < nseq) LOADSTATE(bs + 8);
        }
        BARRIER_LDS();
        if (!cons) { if (k > 0) { store_out_blk(P, row0 - 32, 0, LS, cV + h * 128 + qtr * 32, OB(lds, (k - 1) & 1), ptid); st_store(p.out + o_sC + ((size_t)(l * NS + bs - 8) * 4 + h) * 16384, qtr, STB(lds, (k - 1) & 1), ptid); } }
        else {
            const float* qb = QB(lds, k & 1); const float* kb = KB(lds, k & 1); const float* vb = VB(lds, k & 1); const float* sc = SCB(lds, k & 1);
            float* ob = OB(lds, k & 1); float* stb = STB(lds, k & 1);
#pragma unroll
            for (int e = 0; e < 16; ++e) { const int d = (e >> 2) * 32 + s * 4 + (e & 3); C[e >> 1][e & 1] = stb[d * ST_LD + cl]; }
            f32x4 q4[4][4]; f32x2 kn[4], qn[4]; float vv[4], ig[4], lf[4]; f32x4 qk[4];
#define MLOAD_Q(T0) do { _Pragma("unroll") for (int i = 0; i < 4; ++i) { const int t = (T0) + i; \
        _Pragma("unroll") for (int j = 0; j < 4; ++j) q4[i][j] = *(const f32x4*)(qb + t * 128 + j * 32 + s * 4); \
        qn[i] = *(const f32x2*)(qb + t * 128 + nd); } } while (0)
#define MLOAD_K(T0) do { _Pragma("unroll") for (int i = 0; i < 4; ++i) { const int t = (T0) + i; \
        const f32x2 gg = *(const f32x2*)(sc + t * 16); ig[i] = gg[0]; lf[i] = gg[1]; \
        qk[i] = *(const f32x4*)(sc + t * 16 + 4); vv[i] = vb[t * 32 + cl]; } \
      _Pragma("unroll") for (int i = 0; i < 4; ++i) { const int t = (T0) + i; \
        _Pragma("unroll") for (int j = 0; j < 4; ++j) k4[i][j] = *(const f32x4*)(kb + t * 128 + j * 32 + s * 4); \
        kn[i] = *(const f32x2*)(kb + t * 128 + nd); } } while (0)
            MLOAD_Q(0); MLOAD_K(0);
            {
                float d[4], dn[4];
                __builtin_amdgcn_sched_barrier(0);
#pragma unroll
                for (int i = 0; i < 4; ++i) {
                    f32x2 a = bc2(0.f), a2 = bc2(0.f);
#pragma unroll
                    for (int j = 0; j < 4; ++j) { a = lo2(q4[i][j]) * C[2 * j] + a; a2 = hi2(q4[i][j]) * C[2 * j + 1] + a2; }
                    a = a + a2;
                    d[i] = a[0] + a[1]; dn[i] = qn[i][0] * n0v + qn[i][1] * n1v;
                }
                __builtin_amdgcn_sched_barrier(0);
#pragma unroll
                for (int i = 0; i < 4; ++i) { d[i] = red8(d[i]); dn[i] = red64(dn[i]); }
                float fp[4], ip[4], em[4];
#pragma unroll
                for (int i = 0; i < 4; ++i) { const float mn = fmaxf(lf[i] + m, ig[i]); fp[i] = __expf(lf[i] + m - mn); ip[i] = __expf(ig[i] - mn); em[i] = __expf(-mn); m = mn; }
                const float F0 = fp[0], F1 = F0 * fp[1], F2 = F1 * fp[2], F3 = F2 * fp[3];
                const float g00 = ip[0], g10 = g00 * fp[1], g11 = ip[1], g20 = g10 * fp[2], g21 = g11 * fp[2], g22 = ip[2];
                const float g30 = g20 * fp[3], g31 = g21 * fp[3], g32 = g22 * fp[3], g33 = ip[3];
                const float s00 = g00 * qk[0][0];
                const float s10 = g10 * qk[1][0], s11 = g11 * qk[1][1];
                const float s20 = g20 * qk[2][0], s21 = g21 * qk[2][1], s22 = g22 * qk[2][2];
                const float s30 = g30 * qk[3][0], s31 = g31 * qk[3][1], s32 = g32 * qk[3][2], s33 = g33 * qk[3][3];
                const float num0 = F0 * d[0] + s00 * vv[0], den0 = F0 * dn[0] + s00;
                const float num1 = F1 * d[1] + s10 * vv[0] + s11 * vv[1], den1 = F1 * dn[1] + s10 + s11;
                const float num2 = F2 * d[2] + s20 * vv[0] + s21 * vv[1] + s22 * vv[2], den2 = F2 * dn[2] + s20 + s21 + s22;
                const float num3 = F3 * d[3] + s30 * vv[0] + s31 * vv[1] + s32 * vv[2] + s33 * vv[3], den3 = F3 * dn[3] + s30 + s31 + s32 + s33;
                if (s == 0) {
                    ob[0 * 32 + cl] = num0 / fmaxf(fabsf(den0), em[0]); ob[1 * 32 + cl] = num1 / fmaxf(fabsf(den1), em[1]);
                    ob[2 * 32 + cl] = num2 / fmaxf(fabsf(den2), em[2]); ob[3 * 32 + cl] = num3 / fmaxf(fabsf(den3), em[3]);
                }
                const float c0 = g30 * vv[0], c1 = g31 * vv[1], c2 = g32 * vv[2], c3 = g33 * vv[3];
#pragma unroll
                for (int j = 0; j < 4; ++j) {
                    C[2 * j] = lo2(k4[3][j]) * bc2(c3) + (lo2(k4[2][j]) * bc2(c2) + (lo2(k4[1][j]) * bc2(c1) + (lo2(k4[0][j]) * bc2(c0) + C[2 * j] * bc2(F3))));
                    C[2 * j + 1] = hi2(k4[3][j]) * bc2(c3) + (hi2(k4[2][j]) * bc2(c2) + (hi2(k4[1][j]) * bc2(c1) + (hi2(k4[0][j]) * bc2(c0) + C[2 * j + 1] * bc2(F3)))); }
                n0v = n0v * F3 + (kn[0][0] * g30 + kn[1][0] * g31) + (kn[2][0] * g32 + kn[3][0] * g33);
                n1v = n1v * F3 + (kn[0][1] * g30 + kn[1][1] * g31) + (kn[2][1] * g32 + kn[3][1] * g33);
            }
#undef MLOAD_Q
#undef MLOAD_K
            const size_t sh = (size_t)(l * NS + bs) * 4 + h;
#pragma unroll
            for (int e = 0; e < 16; ++e) { const int d = (e >> 2) * 32 + s * 4 + (e & 3); stb[d * ST_LD + cl] = C[e >> 1][e & 1]; }
            if (qtr == 0 && w == 0) { float* no = p.out + o_sn + sh * 128; no[nd] = n0v; no[nd + 1] = n1v; if (lane == 0) p.out[o_sm + sh] = m; }
        }
    }
    BARRIER_LDS();
    if (!cons) { store_out_blk(P, SROW0 + (bs0 + 8 * (nseq - 1)) * 4, 0, LS, cV + h * 128 + qtr * 32, OB(lds, (nseq - 1) & 1), ptid); st_store(p.out + o_sC + ((size_t)(l * NS + bs0 + 8 * (nseq - 1)) * 4 + h) * 16384, qtr, STB(lds, (nseq - 1) & 1), ptid); }
    BARRIER_LDS();
#undef LOADSTATE
#undef STISSUE
}


typedef float f32x16 __attribute__((ext_vector_type(16)));
#define MFMA32(a, b, c) __builtin_amdgcn_mfma_f32_32x32x16_bf16((a), (b), (c), 0, 0, 0)
__device__ __forceinline__ int crow(int reg, int hf) { return (reg & 3) + 8 * (reg >> 2) + 4 * hf; }
__device__ __forceinline__ bf16x8 pack_step(const f32x16& x, int s) {
    u32x4 pk;
    asm volatile("s_nop 7\n\ts_nop 3\n\tv_cvt_pk_bf16_f32 %0, %4, %5\n\tv_cvt_pk_bf16_f32 %1, %6, %7\n\tv_cvt_pk_bf16_f32 %2, %8, %9\n\tv_cvt_pk_bf16_f32 %3, %10, %11\n\ts_nop 1"
                 : "=&v"(pk[0]), "=&v"(pk[1]), "=&v"(pk[2]), "=&v"(pk[3])
                 : "v"(x[8 * s]), "v"(x[8 * s + 1]), "v"(x[8 * s + 2]), "v"(x[8 * s + 3]), "v"(x[8 * s + 4]), "v"(x[8 * s + 5]), "v"(x[8 * s + 6]), "v"(x[8 * s + 7]));
    return __builtin_bit_cast(bf16x8, pk);
}
__device__ __forceinline__ bf16x8 frag_n(const bf16_t* base, int ld, int r, int hf, int kb) { return *(const bf16x8*)(base + r * ld + kb * 16 + hf * 8); }
__device__ __forceinline__ bf16x8 frag_p(const bf16_t* base, int ld, int r, int hf, int k0) {
    const u32x2 a = *(const u32x2*)(base + r * ld + k0 + 4 * hf), b = *(const u32x2*)(base + r * ld + k0 + 8 + 4 * hf);
    return __builtin_bit_cast(bf16x8, (u32x4){a.x, a.y, b.x, b.y});
}
__device__ __forceinline__ int kto(int d) { return d * 40 + (d >> 4) * 8; }
__device__ __forceinline__ bf16_t f2bf(float x) { return (bf16_t)(pk2(x, 0.f) & 0xffffu); }

constexpr int CH_LDQ = 136, CH_LDS = 40;
constexpr int CH_QB = 0, CH_KB = 8704, CH_KWT = 17408, CH_VT = 27904, CH_SW = 33024, CH_SC = 35584, CH_QW = 36608, CH_SLOT = 45312, CH_OB = 2 * CH_SLOT;
constexpr int SC_U = 0, SC_B = 32, SC_PM = 64;

__device__ __forceinline__ void store_out_norm(bf16_t* P, int row0, int jb, int L, int pcol, const float* ob, const float* rd, int ptid) {
    const int tt = ptid >> 3, g = ptid & 7, t0 = jb * 32;
    if (t0 + tt < L) { const f32x4 v = *(const f32x4*)(ob + tt * 32 + g * 4) * rd[tt];
        *(u32x2*)(P + (size_t)(row0 + t0 + tt) * NP + pcol + g * 4) = (u32x2){pk2(v[0], v[1]), pk2(v[2], v[3])}; }
}
__device__ __forceinline__ void issue_mlstm_chunk(const Params& p, int h, int qtr, int row0, int L, int nch, int jb, int ptid, StageRegs& r) {
    if (jb >= nch) return;
    const bf16_t* P = (const bf16_t*)(p.ws + OFF_P); const float* REC = (const float*)(p.ws + OFF_REC);
    const int tt = ptid >> 3, g = ptid & 7, t0 = jb * 32;
    const int row = row0 + t0 + tt;
    if (g == 0) r.r0 = *(const f32x4*)(REC + ((size_t)row * 4 + h) * 16 + 4);
    if (t0 + tt >= L) return;
    const bf16_t* prow = P + (size_t)row * NP;
    r.q0 = asf(*(const u32x4*)(prow + cQ + h * 128 + g * 16)); r.q1 = asf(*(const u32x4*)(prow + cQ + h * 128 + g * 16 + 8));
    r.k0 = asf(*(const u32x4*)(prow + cK + h * 128 + g * 16)); r.k1 = asf(*(const u32x4*)(prow + cK + h * 128 + g * 16 + 8));
    { const u32x2 vv_ = *(const u32x2*)(prow + cV + h * 128 + qtr * 32 + g * 4); r.v = asf((u32x4){vv_.x, vv_.y, 0u, 0u}); }
}

__device__ __forceinline__ void scan_mlstm_chunk(const Params& p, int l, int bs, int h, int qtr, int row0, int L, unsigned char* lb) {
    const int tid = opaque_tid(p.wv); const int wave = tid >> 6, lane = tid & 63, r = lane & 31, hf = lane >> 5, ptid = tid - 256;
    bf16_t* P = (bf16_t*)(p.ws + OFF_P);
    const int nch = (L + 31) >> 5;
    f32x16 C[4];
    const int ct = wave == 3 ? 1 : 0;
#pragma unroll
    for (int dt = 0; dt < 4; ++dt)
#pragma unroll
        for (int i = 0; i < 16; ++i) C[dt][i] = 0.f;
    float m0 = 0.f;
    f32x4 s0, s1, s2, s3, s4, s5, s6, s7; StageRegs sr{s0, s1, s2, s3, s4, s5, s6, s7};
    if (wave >= 4) { for (int i = ptid; i < 2 * 32 * CH_LDS; i += 256) { const int sl = i / (32 * CH_LDS), e = i % (32 * CH_LDS);
            ((bf16_t*)(lb + sl * CH_SLOT + CH_VT))[32 * CH_LDS + e] = (e < CH_LDS) ? (bf16_t)0x3f80 : (bf16_t)0; } }
#define CH_P1(JN) do { const int jn_ = (JN); unsigned char* sl_ = lb + (jn_ & 1) * CH_SLOT; const int tt = ptid >> 3, g = ptid & 7; const bool val_ = jn_ * 32 + tt < L; \
        u32x4 q0_ = asu(sr.q0), q1_ = asu(sr.q1), k0_ = asu(sr.k0), k1_ = asu(sr.k1); u32x4 v_ = asu(sr.v); \
        if (!val_) { q0_ = q1_ = k0_ = k1_ = v_ = (u32x4){0u, 0u, 0u, 0u}; } \
        *(u32x4*)(sl_ + CH_QB + (tt * CH_LDQ + g * 16) * 2) = q0_; *(u32x4*)(sl_ + CH_QB + (tt * CH_LDQ + g * 16 + 8) * 2) = q1_; \
        *(u32x4*)(sl_ + CH_KB + (tt * CH_LDQ + g * 16) * 2) = k0_; *(u32x4*)(sl_ + CH_KB + (tt * CH_LDQ + g * 16 + 8) * 2) = k1_; \
        bf16_t* vt_ = (bf16_t*)(sl_ + CH_VT); \
        vt_[(g * 4 + 0) * CH_LDS + tt] = (bf16_t)(v_.x & 0xffffu); vt_[(g * 4 + 1) * CH_LDS + tt] = (bf16_t)(v_.x >> 16); \
        vt_[(g * 4 + 2) * CH_LDS + tt] = (bf16_t)(v_.y & 0xffffu); vt_[(g * 4 + 3) * CH_LDS + tt] = (bf16_t)(v_.y >> 16); \
        if (g == 0) { float* sc_ = (float*)(sl_ + CH_SC); sc_[SC_U + tt] = sr.r0[0]; sc_[SC_B + tt] = sr.r0[1]; sc_[SC_PM + tt] = sr.r0[2]; } \
        issue_mlstm_chunk(p, h, qtr, row0, L, nch, jn_ + 1, ptid, sr); } while (0)
#define CH_P2(JN) do { unsigned char* sl_ = lb + ((JN) & 1) * CH_SLOT; const float* sc_ = (const float*)(sl_ + CH_SC); \
        const float bT_ = sc_[SC_B + 31], mT_ = bT_ + fmaxf(m0, sc_[SC_PM + 31]); \
        if (wave == 1) { f32x16 a_; _Pragma("unroll") for (int i = 0; i < 16; ++i) a_[i] = 0.f; \
            _Pragma("unroll") for (int kb = 0; kb < 8; ++kb) a_ = MFMA32(frag_n((const bf16_t*)(sl_ + CH_QB), CH_LDQ, r, hf, kb), frag_n((const bf16_t*)(sl_ + CH_KB), CH_LDQ, r, hf, kb), a_); \
            bf16_t* sw_ = (bf16_t*)(sl_ + CH_SW); const float us_ = sc_[SC_U + r]; \
            _Pragma("unroll") for (int i4 = 0; i4 < 4; ++i4) { const f32x4 pm4 = *(const f32x4*)(sc_ + SC_PM + 8 * i4 + 4 * hf); \
                _Pragma("unroll") for (int ii = 0; ii < 4; ++ii) { const int t = 8 * i4 + 4 * hf + ii; const float w_ = (r <= t) ? __expf(us_ - fmaxf(m0, pm4[ii])) * 0.08838834764831845f : 0.f; \
                    sw_[t * CH_LDS + r] = f2bf(a_[4 * i4 + ii] * w_); } } } \
        else if (wave >= 4) { const int tt = ptid >> 3, g = ptid & 7; \
            const float wi_ = __expf(m0 - fmaxf(m0, sc_[SC_PM + tt])) * 0.08838834764831845f, ws_ = __expf(sc_[SC_U + tt] + bT_ - mT_); float x_[16]; \
            u32x4* qp_ = (u32x4*)(sl_ + CH_QB + (tt * CH_LDQ + g * 16) * 2); unpack8(qp_[0], x_); unpack8(qp_[1], x_ + 8); \
            _Pragma("unroll") for (int i = 0; i < 16; ++i) x_[i] *= wi_; \
            u32x4* qo_ = (u32x4*)(sl_ + CH_QW + (tt * CH_LDQ + g * 16) * 2); qo_[0] = pack8(x_); qo_[1] = pack8(x_ + 8); \
            const u32x4* kp_ = (const u32x4*)(sl_ + CH_KB + (tt * CH_LDQ + g * 16) * 2); unpack8(kp_[0], x_); unpack8(kp_[1], x_ + 8); \
            bf16_t* kw_ = (bf16_t*)(sl_ + CH_KWT); \
            _Pragma("unroll") for (int i = 0; i < 16; ++i) kw_[kto(g * 16) + i * CH_LDS + tt] = f2bf(x_[i] * ws_); } \
        if (wave == 1 || wave >= 4) m0 = mT_; } while (0)
    if (wave >= 4) { issue_mlstm_chunk(p, h, qtr, row0, L, nch, 0, ptid, sr); CH_P1(0); }
    BARRIER_LDS();
    CH_P2(0);
    BARRIER_LDS();
#pragma unroll 1
    for (int j = 0; j < nch; ++j) {
        if (wave == 0 || wave == 3) {
            const unsigned char* sl = lb + (j & 1) * CH_SLOT; const float* sc = (const float*)(sl + CH_SC);
            const bf16_t* qw = (const bf16_t*)(sl + CH_QW); const bf16_t* sw = (const bf16_t*)(sl + CH_SW); const bf16_t* vt = (const bf16_t*)(sl + CH_VT) + ct * 32 * CH_LDS; const bf16_t* kwt = (const bf16_t*)(sl + CH_KWT);
            const float bT = sc[SC_B + 31], mT = bT + fmaxf(m0, sc[SC_PM + 31]);
            f32x16 H;
#pragma unroll
            for (int i = 0; i < 16; ++i) H[i] = 0.f;
#pragma unroll
            for (int dt = 0; dt < 4; ++dt)
#pragma unroll
                for (int u = 0; u < 2; ++u) H = MFMA32(frag_p(qw, CH_LDQ, r, hf, 32 * dt + 16 * u), pack_step(C[dt], u), H);
            bf16x8 vb[2];
#pragma unroll
            for (int kb = 0; kb < 2; ++kb) { vb[kb] = frag_n(vt, CH_LDS, r, hf, kb); H = MFMA32(frag_n(sw, CH_LDS, r, hf, kb), vb[kb], H); }
            const float wold = __expf(bT - mT + m0);
#pragma unroll
            for (int dt = 0; dt < 4; ++dt) {
#pragma unroll
                for (int i = 0; i < 16; ++i) C[dt][i] *= wold;
#pragma unroll
                for (int kb = 0; kb < 2; ++kb) C[dt] = MFMA32(frag_n(kwt + kto(dt * 32 + r), 0, 0, hf, kb), vb[kb], C[dt]);
            }
            float* ob = (float*)(lb + CH_OB) + (j & 1) * 1024; float* rd = (float*)(lb + CH_OB + 8192) + (j & 1) * 32;
            if (ct == 0) {
#pragma unroll
                for (int i = 0; i < 16; ++i) ob[crow(i, hf) * 32 + r] = H[i];
            } else if (r == 0) {
#pragma unroll
                for (int i = 0; i < 16; ++i) { const int t = crow(i, hf); rd[t] = __builtin_amdgcn_rcpf(fmaxf(fabsf(H[i]), __expf(-(sc[SC_B + t] + fmaxf(m0, sc[SC_PM + t]))))); }
            }
            m0 = mT;
        } else if (wave >= 4) {
            if (j + 1 < nch) CH_P1(j + 1);
            if (j > 0) store_out_norm(P, row0, j - 1, L, cV + h * 128 + qtr * 32, (const float*)(lb + CH_OB) + ((j - 1) & 1) * 1024, (const float*)(lb + CH_OB + 8192) + ((j - 1) & 1) * 32, ptid);
        }
        BARRIER_LDS();
        if (j + 1 < nch) CH_P2(j + 1);
        BARRIER_LDS();
    }
    if (wave >= 4) store_out_norm(P, row0, nch - 1, L, cV + h * 128 + qtr * 32, (const float*)(lb + CH_OB) + ((nch - 1) & 1) * 1024, (const float*)(lb + CH_OB + 8192) + ((nch - 1) & 1) * 32, ptid);
    const size_t sh = (size_t)(l * NB + bs) * 4 + h;
    if (wave == 0) {
        float* Co = p.out + o_pC + sh * 16384;
#pragma unroll
        for (int dt = 0; dt < 4; ++dt)
#pragma unroll
            for (int i = 0; i < 16; ++i) Co[(32 * dt + crow(i, hf)) * 128 + qtr * 32 + r] = C[dt][i];
        if (lane == 0 && qtr == 0) p.out[o_pm + sh] = m0;
    } else if (wave == 3 && r == 0 && qtr == 0) {
#pragma unroll
        for (int dt = 0; dt < 4; ++dt)
#pragma unroll
            for (int i = 0; i < 16; ++i) p.out[o_pn + sh * 128 + 32 * dt + crow(i, hf)] = C[dt][i];
    }
    __syncthreads();
#undef CH_P1
#undef CH_P2
}

__device__ __forceinline__ void gdn_raw8(const bf16_t* P, int r0, int tr, int pcol, const bf16_t* gh, const float* st, int hch, float* x) {
    if (tr >= 0) unpack8(*(const u32x4*)(P + (size_t)(r0 + tr) * NP + pcol), x);
    else if (gh) unpack8(*(const u32x4*)(gh + (3 + tr) * 1536 + hch), x);
    else if (st) { const float* hp = st + (3 + tr) * 1536 + hch; const f32x4 a = *(const f32x4*)hp, b = *(const f32x4*)(hp + 4);
        x[0] = a[0]; x[1] = a[1]; x[2] = a[2]; x[3] = a[3]; x[4] = b[0]; x[5] = b[1]; x[6] = b[2]; x[7] = b[3]; }
    else {
#pragma unroll
        for (int i = 0; i < 8; ++i) x[i] = 0.f; }
}
__device__ __forceinline__ void gdn_conv8(const bf16_t* P, int r0, int tr, int pcol, const bf16_t* gh, const float* st, int hch, const float* cw, float* y) {
#pragma unroll
    for (int i = 0; i < 8; ++i) y[i] = 0.f;
#pragma unroll
    for (int j = 0; j < 4; ++j) { float x[8]; gdn_raw8(P, r0, tr - 3 + j, pcol, gh, st, hch, x);
        const f32x4 w0 = *(const f32x4*)(cw + j * 1536 + hch), w1 = *(const f32x4*)(cw + j * 1536 + hch + 4);
        y[0] += x[0] * w0[0]; y[1] += x[1] * w0[1]; y[2] += x[2] * w0[2]; y[3] += x[3] * w0[3];
        y[4] += x[4] * w1[0]; y[5] += x[5] * w1[1]; y[6] += x[6] * w1[2]; y[7] += x[7] * w1[3]; }
#pragma unroll
    for (int i = 0; i < 8; ++i) y[i] = y[i] * sigmoidf_(y[i]);
}

__device__ __forceinline__ void phase_prep(const Params& p, int l, float* lds) {
    const int tid = opaque_tid(p.wv); const int half = tid >> 8, t = tid & 255, tt = t >> 3, g = t & 7, wq = t >> 6, lane = t & 63, r = lane & 31, hf = lane >> 5;
    bf16_t* P = (bf16_t*)(p.ws + OFF_P); const bf16_t* GH = (const bf16_t*)(p.ws + OFF_GH);
    const float* G = (const float*)(p.ws + OFF_G); float* REC = (float*)(p.ws + OFF_REC); bf16_t* TB = (bf16_t*)(p.ws + OFF_TB);
    const float* cw = p.gconv_w + (size_t)l * 4 * 1536;
    float* ksc = lds + half * 4096;
    unsigned char* pl = (unsigned char*)lds + 32768 + half * 22016;
    bf16_t* kimg = (bf16_t*)pl; bf16_t* qimg = (bf16_t*)(pl + 8704); float* am = (float*)(pl + 17408); float* sgl = (float*)(pl + 21504); float* sbe = sgl + 32; float* sG = sgl + 64;
    constexpr int NITEM = (MROWS / 32) * 4;
    for (int base = blockIdx.x * 2; base < NITEM; base += gridDim.x * 2) {
        const int item = base + half; const bool act = item < NITEM;
        const int rb = item >> 2, h = item & 3, r0 = rb * 32;
        const bool samp = rb >= SROW0 / 32;
        int tr = tt; const bf16_t* gh = nullptr; const float* st = nullptr; int rbase = r0; bool valid = act;
        if (!samp) { const int jb = rb % (LPAD / 32); if (jb * 32 + tt >= LP) valid = false; if (jb > 0) gh = GH + (size_t)(rb - 1) * 3 * 1536; }
        else { const int sq = (rb - SROW0 / 32) * 8 + (tt >> 2); tr = tt & 3; rbase = r0 + (tt & ~3); st = p.st_gconv + (size_t)(l * NS + sq) * 3 * 1536; }
        const int ch = h * 128 + g * 16;
        u32x4 oq0 = (u32x4){0u, 0u, 0u, 0u}, oq1 = oq0, ok0 = oq0, ok1 = oq0, ov0 = oq0, ov1 = oq0;
        float ga = 0.f, gb = 0.f, gg = 0.f;
        if (valid) {
            float y[16];
            gdn_conv8(P, rbase, tr, cBV + ch, gh, st, 1024 + ch, cw, y); gdn_conv8(P, rbase, tr, cBV + ch + 8, gh, st, 1024 + ch + 8, cw, y + 8);
            ov0 = pack8(y); ov1 = pack8(y + 8);
            __builtin_amdgcn_sched_barrier(0);
            gdn_conv8(P, rbase, tr, cBQ + ch, gh, st, ch, cw, y); gdn_conv8(P, rbase, tr, cBQ + ch + 8, gh, st, ch + 8, cw, y + 8);
            float ss = 0.f;
#pragma unroll
            for (int i = 0; i < 16; ++i) ss += y[i] * y[i];
            float rs = rsqrtf(red8(ss) + 1e-6f) * 0.08838834764831845f;
#pragma unroll
            for (int i = 0; i < 16; ++i) y[i] *= rs;
            oq0 = pack8(y); oq1 = pack8(y + 8);
            __builtin_amdgcn_sched_barrier(0);
            gdn_conv8(P, rbase, tr, cBK + ch, gh, st, 512 + ch, cw, y); gdn_conv8(P, rbase, tr, cBK + ch + 8, gh, st, 512 + ch + 8, cw, y + 8);
            ss = 0.f;
#pragma unroll
            for (int i = 0; i < 16; ++i) ss += y[i] * y[i];
            rs = rsqrtf(red8(ss) + 1e-6f);
#pragma unroll
            for (int i = 0; i < 16; ++i) y[i] *= rs;
            ok0 = pack8(y); ok1 = pack8(y + 8);
            unpack8(ok0, y); unpack8(ok1, y + 8);
#pragma unroll
            for (int i = 0; i < 4; ++i) *(f32x4*)(ksc + tt * 128 + g * 16 + 4 * i) = (f32x4){y[4 * i], y[4 * i + 1], y[4 * i + 2], y[4 * i + 3]};
            if (g == 0) { const float* gr = G + (size_t)(r0 + tt) * 16;
                gb = sigmoidf_(gr[8 + h]);
                const float xa = gr[12 + h] + p.dt_bias[l * 4 + h];
                const float sp = fmaxf(xa, 0.f) + log1pf(__expf(-fabsf(xa)));
                gg = -__expf(p.A_log[l * 4 + h]) * sp; ga = __expf(gg); }
        }
        if (!samp) {
            *(u32x4*)(kimg + tt * CH_LDQ + g * 16) = ok0; *(u32x4*)(kimg + tt * CH_LDQ + g * 16 + 8) = ok1;
            *(u32x4*)(qimg + tt * CH_LDQ + g * 16) = oq0; *(u32x4*)(qimg + tt * CH_LDQ + g * 16 + 8) = oq1;
            if (g == 0) { sgl[tt] = gg; sbe[tt] = gb; }
        }
        __syncthreads();
        f32x16 pacc;
#pragma unroll
        for (int i = 0; i < 16; ++i) pacc[i] = 0.f;
        float myG = 0.f, totG = 0.f;
        if (valid) {
            bf16_t* pr = P + (size_t)(r0 + tt) * NP;
            *(u32x4*)(pr + cBQ + ch) = oq0; *(u32x4*)(pr + cBQ + ch + 8) = oq1; *(u32x4*)(pr + cBK + ch) = ok0; *(u32x4*)(pr + cBK + ch + 8) = ok1;
            *(u32x4*)(pr + cBV + ch) = ov0; *(u32x4*)(pr + cBV + ch + 8) = ov1;
        }
        if (samp) {
            if (valid) {
                const float* kmb = ksc + (tt & ~3) * 128 + g * 16;
                f32x4 qk, kk, qs[4], ks[4];
                { float y[16]; unpack8(oq0, y); unpack8(oq1, y + 8);
#pragma unroll
                  for (int i = 0; i < 4; ++i) qs[i] = (f32x4){y[4 * i], y[4 * i + 1], y[4 * i + 2], y[4 * i + 3]};
                  unpack8(ok0, y); unpack8(ok1, y + 8);
#pragma unroll
                  for (int i = 0; i < 4; ++i) ks[i] = (f32x4){y[4 * i], y[4 * i + 1], y[4 * i + 2], y[4 * i + 3]}; }
#pragma unroll
                for (int j = 0; j < 4; ++j) { qk[j] = red8(dot16(qs, kmb + j * 128)); kk[j] = red8(dot16(ks, kmb + j * 128)); }
                if (g == 0) { float* rec = REC + ((size_t)(r0 + tt) * 4 + h) * 16; *(f32x4*)rec = (f32x4){ga, gb, gg, 0.f}; *(f32x4*)(rec + 4) = qk; *(f32x4*)(rec + 8) = kk; }
            }
        } else if (act) {
            if (wq < 2) {
                const bf16_t* ai = wq == 0 ? kimg : qimg;
#pragma unroll
                for (int kb = 0; kb < 8; ++kb) pacc = MFMA32(frag_n(ai, CH_LDQ, r, hf, kb), frag_n(kimg, CH_LDQ, r, hf, kb), pacc);
            } else if (wq == 2) {
                const float gm = sgl[r]; float cum = 0.f;
#pragma unroll
                for (int t2 = 0; t2 < 32; ++t2) { cum += rdl(gm, t2); if (r == t2) myG = cum; }
                totG = cum;
                if (lane < 32) sG[r] = myG;
                if (lane == 0) sG[32] = cum;
            }
        }
        __syncthreads();
        if (!samp && act) {
            bf16_t* tb = TB + (size_t)item * 3072;
            if (wq == 0) {
                const float Gs_ = sG[r]; float* ag = (float*)tb;
#pragma unroll
                for (int i4 = 0; i4 < 4; ++i4) { const f32x4 G4 = *(const f32x4*)(sG + 8 * i4 + 4 * hf), b4 = *(const f32x4*)(sbe + 8 * i4 + 4 * hf);
#pragma unroll
                    for (int ii = 0; ii < 4; ++ii) { const int t2 = 8 * i4 + 4 * hf + ii; ag[t2 * 32 + r] = (r < t2) ? b4[ii] * pacc[4 * i4 + ii] * __expf(G4[ii] - Gs_) : 0.f; } }
            } else if (wq == 1) {
                const float Gs_ = sG[r];
#pragma unroll
                for (int i4 = 0; i4 < 4; ++i4) { const f32x4 G4 = *(const f32x4*)(sG + 8 * i4 + 4 * hf);
#pragma unroll
                    for (int ii = 0; ii < 4; ++ii) { const int t2 = 8 * i4 + 4 * hf + ii; tb[2048 + t2 * 32 + r] = f2bf((r <= t2) ? pacc[4 * i4 + ii] * __expf(G4[ii] - Gs_) : 0.f); } }
            }
            if (valid && g == 0) { const float Gt = sG[tt], GT = sG[32];
                float* rec = REC + ((size_t)(r0 + tt) * 4 + h) * 16; *(f32x4*)rec = (f32x4){ga, gb, gg, Gt}; *(f32x4*)(rec + 12) = (f32x4){GT - Gt, GT, 0.f, 0.f}; }
        }
        __syncthreads();
    }
    asm volatile("s_waitcnt vmcnt(0)" ::: "memory");
    __syncthreads();
    { const int wv_ = tid >> 6; float* am = lds + wv_ * 1024;
      int nmine = 0;
      for (int base = blockIdx.x * 2; base < NITEM; base += gridDim.x * 2) nmine += 2;
      for (int idx = wv_; idx < nmine; idx += 8) {
        const int item = blockIdx.x * 2 + (idx >> 1) * gridDim.x * 2 + (idx & 1);
        const int rb = item >> 2, h = item & 3;
        if (item >= NITEM || rb >= SROW0 / 32) continue;
        bf16_t* tb = TB + (size_t)item * 3072; const float* ag = (const float*)tb;
#pragma unroll
        for (int q = 0; q < 4; ++q) *(f32x4*)(am + q * 256 + lane * 4) = *(const f32x4*)(ag + q * 256 + lane * 4);
        const float* rec = REC + ((size_t)(rb * 32 + r) * 4 + h) * 16;
        const bool rv = (rb % (LPAD / 32)) * 32 + r < LP;
        const float bs_ = rv ? rec[1] : 0.f, bg_ = rv ? bs_ * __expf(rec[3]) : 0.f;
        asm volatile("s_waitcnt vmcnt(0) lgkmcnt(0)" ::: "memory");
        float Tc[32];
#pragma unroll
        for (int t2 = 0; t2 < 32; ++t2) { float v0 = 0.f, v1 = 0.f, v2 = 0.f, v3 = 0.f;
#pragma unroll
            for (int q4 = 0; q4 < (t2 + 3) / 4; ++q4) { const f32x4 a4 = *(const f32x4*)(am + t2 * 32 + q4 * 4);
                if (q4 * 4 + 0 < t2) v0 += a4[0] * Tc[q4 * 4 + 0]; if (q4 * 4 + 1 < t2) v1 += a4[1] * Tc[q4 * 4 + 1];
                if (q4 * 4 + 2 < t2) v2 += a4[2] * Tc[q4 * 4 + 2]; if (q4 * 4 + 3 < t2) v3 += a4[3] * Tc[q4 * 4 + 3]; }
            Tc[t2] = ((r == t2) ? 1.f : 0.f) - ((v0 + v1) + (v2 + v3)); }
        if (hf == 0) {
#pragma unroll
            for (int t2 = 0; t2 < 32; ++t2) { tb[t2 * 32 + r] = f2bf(Tc[t2] * bs_); tb[1024 + t2 * 32 + r] = f2bf(Tc[t2] * bg_); } }
        asm volatile("s_waitcnt lgkmcnt(0)" ::: "memory");
      } }
    { const int wv_ = tid >> 6;
      for (int it = blockIdx.x * 8 + wv_; it < (SROW0 / 32) * 4; it += gridDim.x * 8) {
        const int rbp = it >> 2, hh = it & 3, jb = rbp % (LPAD / 32), row = rbp * 32 + r;
        float igm = -1e30f, lfm = 0.f;
        if (jb * 32 + r < LP) { const float* gr = G + (size_t)row * 16; igm = gr[hh] + p.gate_bias[l * 8 + hh]; const float f = gr[4 + hh] + p.gate_bias[l * 8 + 4 + hh]; lfm = fminf(f, 0.f) - log1pf(__expf(-fabsf(f))); }
        float bsum = 0.f, pm = -3e38f, myb = 0.f, myu = 0.f, mypm = 0.f;
#pragma unroll
        for (int t2 = 0; t2 < 32; ++t2) { bsum += rdl(lfm, t2); const float u_ = rdl(igm, t2) - bsum; pm = fmaxf(pm, u_); if (r == t2) { myb = bsum; myu = u_; mypm = pm; } }
        if (lane < 32) *(f32x4*)(REC + ((size_t)row * 4 + hh) * 16 + 4) = (f32x4){myu, myb, mypm, 0.f};
      } }
}

__device__ __forceinline__ void issue_gdn(const Params& p, int h, int qtr, int row0, int L, int jb, int ptid, StageRegs& r) {
    const bf16_t* P = (const bf16_t*)(p.ws + OFF_P); const float* REC = (const float*)(p.ws + OFF_REC);
    const int tt = ptid >> 3, g = ptid & 7, t0 = jb * 32;
    if (t0 + tt >= L) return;
    const int row = row0 + t0 + tt;
    const bf16_t* prow = P + (size_t)row * NP;
    r.q0 = asf(*(const u32x4*)(prow + cBQ + h * 128 + g * 16)); r.q1 = asf(*(const u32x4*)(prow + cBQ + h * 128 + g * 16 + 8));
    r.k0 = asf(*(const u32x4*)(prow + cBK + h * 128 + g * 16)); r.k1 = asf(*(const u32x4*)(prow + cBK + h * 128 + g * 16 + 8));
    { const u32x2 vv_ = *(const u32x2*)(prow + cBV + h * 128 + qtr * 32 + g * 4); r.v = asf((u32x4){vv_.x, vv_.y, 0u, 0u}); }
    if (g < 3) r.r0 = *(const f32x4*)(REC + ((size_t)row * 4 + h) * 16 + g * 4);
}
__device__ __forceinline__ void commit_gdn(int L, int jb, float* lds, int ptid, const StageRegs& r, int bsel = -1) {
    const int tt = ptid >> 3, g = ptid & 7, t0 = jb * 32, b = bsel >= 0 ? bsel : (jb & 1);
    if (t0 + tt >= L) return;
    float x[16];
    unpack8(asu(r.q0), x); unpack8(asu(r.q1), x + 8);
    float* qd = QB(lds, b) + tt * 128 + g * 16;
#pragma unroll
    for (int i = 0; i < 4; ++i) *(f32x4*)(qd + 4 * i) = (f32x4){x[4 * i], x[4 * i + 1], x[4 * i + 2], x[4 * i + 3]};
    unpack8(asu(r.k0), x); unpack8(asu(r.k1), x + 8);
    float* kd = KB(lds, b) + tt * 128 + g * 16;
#pragma unroll
    for (int i = 0; i < 4; ++i) *(f32x4*)(kd + 4 * i) = (f32x4){x[4 * i], x[4 * i + 1], x[4 * i + 2], x[4 * i + 3]};
    *(f32x4*)(VB(lds, b) + tt * 32 + g * 4) = (f32x4){bflo(asu(r.v).x), bfhi(asu(r.v).x), bflo(asu(r.v).y), bfhi(asu(r.v).y)};
    if (g < 3) *(f32x4*)(SCB(lds, b) + tt * 16 + g * 4) = r.r0;
}

constexpr int GD_Q = 0, GD_K = 8704, GD_KT = 17408, GD_KDT = 27904, GD_VT = 38400, GD_QKD = 40960, GD_TV = 43520, GD_TK = 46080, GD_W = 48640, GD_SC = 57344, GD_SLOT = 58368, GD_OB = 2 * GD_SLOT;
constexpr int GS_B = 32, GS_EG = 96, GS_ETG = 128, GS_EGT = 160;

__device__ __forceinline__ void issue_gdn_chunk(const Params& p, int h, int qtr, int row0, int L, int nch, int jb, int ptid, StageRegs& r) {
    if (jb >= nch) return;
    const bf16_t* P = (const bf16_t*)(p.ws + OFF_P); const float* REC = (const float*)(p.ws + OFF_REC);
    const bf16_t* tb = (const bf16_t*)(p.ws + OFF_TB) + ((size_t)((row0 >> 5) + jb) * 4 + h) * 3072;
    r.x0 = asf(*(const u32x4*)(tb + ptid * 8));
    if (ptid < 128) r.x1 = asf(*(const u32x4*)(tb + 2048 + ptid * 8));
    const int tt = ptid >> 3, g = ptid & 7, t0 = jb * 32;
    if (t0 + tt >= L) return;
    const int row = row0 + t0 + tt;
    const bf16_t* prow = P + (size_t)row * NP;
    r.q0 = asf(*(const u32x4*)(prow + cBQ + h * 128 + g * 16)); r.q1 = asf(*(const u32x4*)(prow + cBQ + h * 128 + g * 16 + 8));
    r.k0 = asf(*(const u32x4*)(prow + cBK + h * 128 + g * 16)); r.k1 = asf(*(const u32x4*)(prow + cBK + h * 128 + g * 16 + 8));
    { const u32x2 vv_ = *(const u32x2*)(prow + cBV + h * 128 + qtr * 32 + g * 4); r.v = asf((u32x4){vv_.x, vv_.y, 0u, 0u}); }
    if (g == 0 || g == 3) r.r0 = *(const f32x4*)(REC + ((size_t)row * 4 + h) * 16 + g * 4);
}

__device__ __forceinline__ void scan_gdn_chunk(const Params& p, int l, int bs, int h, int qtr, int row0, int L, unsigned char* lb) {
    const int tid = opaque_tid(p.wv); const int wave = tid >> 6, lane = tid & 63, r = lane & 31, hf = lane >> 5, ptid = tid - 256;
    bf16_t* P = (bf16_t*)(p.ws + OFF_P);
    const int nch = (L + 31) >> 5;
    f32x16 S[4];
#pragma unroll
    for (int dt = 0; dt < 4; ++dt)
#pragma unroll
        for (int i = 0; i < 16; ++i) S[dt][i] = 0.f;
    f32x4 s0, s1, s2, s3, s4, s5, s6, s7; StageRegs sr{s0, s1, s2, s3, s4, s5, s6, s7};
#define GD_P1(JN) do { const int jn_ = (JN); unsigned char* sl_ = lb + (jn_ & 1) * GD_SLOT; const int tt = ptid >> 3, g = ptid & 7; const bool val_ = jn_ * 32 + tt < L; \
        u32x4 q0_ = asu(sr.q0), q1_ = asu(sr.q1), k0_ = asu(sr.k0), k1_ = asu(sr.k1); u32x4 v_ = asu(sr.v); \
        if (!val_) { q0_ = q1_ = k0_ = k1_ = v_ = (u32x4){0u, 0u, 0u, 0u}; } \
        *(u32x4*)(sl_ + GD_Q + (tt * CH_LDQ + g * 16) * 2) = q0_; *(u32x4*)(sl_ + GD_Q + (tt * CH_LDQ + g * 16 + 8) * 2) = q1_; \
        *(u32x4*)(sl_ + GD_K + (tt * CH_LDQ + g * 16) * 2) = k0_; *(u32x4*)(sl_ + GD_K + (tt * CH_LDQ + g * 16 + 8) * 2) = k1_; \
        bf16_t* kt_ = (bf16_t*)(sl_ + GD_KT) + kto(g * 16) + tt; \
        _Pragma("unroll") for (int i = 0; i < 4; ++i) { kt_[(2 * i) * CH_LDS] = (bf16_t)(k0_[i] & 0xffffu); kt_[(2 * i + 1) * CH_LDS] = (bf16_t)(k0_[i] >> 16); \
            kt_[(8 + 2 * i) * CH_LDS] = (bf16_t)(k1_[i] & 0xffffu); kt_[(8 + 2 * i + 1) * CH_LDS] = (bf16_t)(k1_[i] >> 16); } \
        bf16_t* vt_ = (bf16_t*)(sl_ + GD_VT); \
        vt_[(g * 4 + 0) * CH_LDS + tt] = (bf16_t)(v_.x & 0xffffu); vt_[(g * 4 + 1) * CH_LDS + tt] = (bf16_t)(v_.x >> 16); \
        vt_[(g * 4 + 2) * CH_LDS + tt] = (bf16_t)(v_.y & 0xffffu); vt_[(g * 4 + 3) * CH_LDS + tt] = (bf16_t)(v_.y >> 16); \
        { const int row_ = ptid >> 2, c4_ = ptid & 3; *(u32x4*)(sl_ + (row_ < 32 ? GD_TV : GD_TK) + ((row_ & 31) * CH_LDS + c4_ * 8) * 2) = asu(sr.x0); \
          if (ptid < 128) *(u32x4*)(sl_ + GD_QKD + (row_ * CH_LDS + c4_ * 8) * 2) = asu(sr.x1); } \
        float* sc_ = (float*)(sl_ + GD_SC); \
        if (g == 0) { sc_[GS_B + tt] = val_ ? sr.r0[1] : 0.f; sc_[GS_EG + tt] = val_ ? __expf(sr.r0[3]) : 0.f; } \
        if (g == 3) { sc_[GS_ETG + tt] = val_ ? __expf(sr.r0[0]) : 0.f; if (tt == 0) sc_[GS_EGT] = __expf(sr.r0[1]); } \
        issue_gdn_chunk(p, h, qtr, row0, L, nch, jn_ + 1, ptid, sr); } while (0)
#define GD_P2(JN) do { if (wave >= 4) { unsigned char* sl_ = lb + ((JN) & 1) * GD_SLOT; const float* sc_ = (const float*)(sl_ + GD_SC); \
        { const int tt = ptid >> 3, g = ptid & 7; const float eg_ = sc_[GS_EG + tt], et_ = sc_[GS_ETG + tt]; float x_[16]; \
            u32x4* qp_ = (u32x4*)(sl_ + GD_Q + (tt * CH_LDQ + g * 16) * 2); unpack8(qp_[0], x_); unpack8(qp_[1], x_ + 8); \
            _Pragma("unroll") for (int i = 0; i < 16; ++i) x_[i] *= eg_; \
            qp_[0] = pack8(x_); qp_[1] = pack8(x_ + 8); \
            const u32x4* kp_ = (const u32x4*)(sl_ + GD_K + (tt * CH_LDQ + g * 16) * 2); unpack8(kp_[0], x_); unpack8(kp_[1], x_ + 8); \
            bf16_t* kd_ = (bf16_t*)(sl_ + GD_KDT); \
            _Pragma("unroll") for (int i = 0; i < 16; ++i) kd_[kto(g * 16) + i * CH_LDS + tt] = f2bf(x_[i] * et_); } \
        { const int dt_ = wave - 4; f32x16 a_; \
            _Pragma("unroll") for (int i = 0; i < 16; ++i) a_[i] = 0.f; \
            _Pragma("unroll") for (int kb = 0; kb < 2; ++kb) a_ = MFMA32(frag_n((const bf16_t*)(sl_ + GD_KT) + kto(dt_ * 32 + r), 0, 0, hf, kb), frag_n((const bf16_t*)(sl_ + GD_TK), CH_LDS, r, hf, kb), a_); \
            _Pragma("unroll") for (int i4 = 0; i4 < 4; ++i4) { unsigned lo_, hi_;     \
                asm volatile("s_nop 7\n\ts_nop 7\n\tv_cvt_pk_bf16_f32 %0, %2, %3\n\tv_cvt_pk_bf16_f32 %1, %4, %5" : "=&v"(lo_), "=&v"(hi_) : "v"(a_[4 * i4]), "v"(a_[4 * i4 + 1]), "v"(a_[4 * i4 + 2]), "v"(a_[4 * i4 + 3])); \
                *(u32x2*)(sl_ + GD_W + (r * CH_LDQ + 32 * dt_ + 8 * i4 + 4 * hf) * 2) = (u32x2){lo_, hi_}; } } } } while (0)
    if (wave >= 4) { issue_gdn_chunk(p, h, qtr, row0, L, nch, 0, ptid, sr); GD_P1(0); }
    BARRIER_LDS();
    GD_P2(0);
    BARRIER_LDS();
#pragma unroll 1
    for (int j = 0; j < nch; ++j) {
        if (wave == 0) {
            const unsigned char* sl = lb + (j & 1) * GD_SLOT; const float* sc = (const float*)(sl + GD_SC);
            const bf16_t* wq = (const bf16_t*)(sl + GD_W); const bf16_t* qg = (const bf16_t*)(sl + GD_Q); const bf16_t* tv = (const bf16_t*)(sl + GD_TV); const bf16_t* vt = (const bf16_t*)(sl + GD_VT);
            const bf16_t* qkd = (const bf16_t*)(sl + GD_QKD); const bf16_t* kdt = (const bf16_t*)(sl + GD_KDT);
            f32x16 U, O;
#pragma unroll
            for (int i = 0; i < 16; ++i) { U[i] = 0.f; O[i] = 0.f; }
#pragma unroll
            for (int dt = 0; dt < 4; ++dt)
#pragma unroll
                for (int u = 0; u < 2; ++u) { const bf16x8 sb = pack_step(S[dt], u);
                    U = MFMA32(frag_p(wq, CH_LDQ, r, hf, 32 * dt + 16 * u), sb, U); O = MFMA32(frag_p(qg, CH_LDQ, r, hf, 32 * dt + 16 * u), sb, O); }
            f32x16 Uv;
#pragma unroll
            for (int i = 0; i < 16; ++i) Uv[i] = 0.f;
#pragma unroll
            for (int kb = 0; kb < 2; ++kb) Uv = MFMA32(frag_n(tv, CH_LDS, r, hf, kb), frag_n(vt, CH_LDS, r, hf, kb), Uv);
#pragma unroll
            for (int i = 0; i < 16; ++i) U[i] = Uv[i] - U[i];
            bf16x8 ub[2]; ub[0] = pack_step(U, 0); ub[1] = pack_step(U, 1);
#pragma unroll
            for (int u = 0; u < 2; ++u) O = MFMA32(frag_p(qkd, CH_LDS, r, hf, 16 * u), ub[u], O);
            const float egt = sc[GS_EGT];
#pragma unroll
            for (int dt = 0; dt < 4; ++dt) {
#pragma unroll
                for (int i = 0; i < 16; ++i) S[dt][i] *= egt;
#pragma unroll
                for (int u = 0; u < 2; ++u) S[dt] = MFMA32(frag_p(kdt + kto(dt * 32 + r), 0, 0, hf, 16 * u), ub[u], S[dt]);
            }
            float* ob = (float*)(lb + GD_OB) + (j & 1) * 1024;
#pragma unroll
            for (int i = 0; i < 16; ++i) ob[crow(i, hf) * 32 + r] = O[i];
        } else if (wave >= 4) {
            if (j + 1 < nch) GD_P1(j + 1);
            if (j > 0) store_out_blk(P, row0, j - 1, L, cBV + h * 128 + qtr * 32, (const float*)(lb + GD_OB) + ((j - 1) & 1) * 1024, ptid);
        }
        BARRIER_LDS();
        if (j + 1 < nch) GD_P2(j + 1);
        BARRIER_LDS();
    }
    if (wave >= 4) store_out_blk(P, row0, nch - 1, L, cBV + h * 128 + qtr * 32, (const float*)(lb + GD_OB) + ((nch - 1) & 1) * 1024, ptid);
    if (wave == 0) {
        float* So = p.out + o_pS + ((size_t)(l * NB + bs) * 4 + h) * 16384;
#pragma unroll
        for (int dt = 0; dt < 4; ++dt)
#pragma unroll
            for (int i = 0; i < 16; ++i) So[(32 * dt + crow(i, hf)) * 128 + qtr * 32 + r] = S[dt][i];
    }
    __syncthreads();
#undef GD_P1
#undef GD_P2
}

__device__ __forceinline__ void scan_gdn(const Params& p, int l, bool samp, int bs, int h, int qtr, int row0, int L, float* lds) {
    const int tid = opaque_tid(p.wv); const bool cons = tid < 256; const int ptid = tid - 256;
    const int lane = tid & 63, w = (tid >> 6) & 3, s = lane & 7, cl = w * 8 + (lane >> 3), col = qtr * 32 + cl;
    bf16_t* P = (bf16_t*)(p.ws + OFF_P);
    f32x2 S[8];
#pragma unroll
    for (int e = 0; e < 8; ++e) S[e] = bc2(0.f);
    if (cons && samp) {
        const float* S0 = p.st_S + ((size_t)(l * NS + bs) * 4 + h) * 16384;
#pragma unroll
        for (int e = 0; e < 16; ++e) { const int d = (e >> 2) * 32 + s * 4 + (e & 3); S[e >> 1][e & 1] = S0[d * 128 + col]; }
    }
    const int nblk = (L + 31) >> 5;
    f32x4 k4[4][4];
    StageRegs sr{k4[0][0], k4[0][1], k4[0][2], k4[0][3], k4[1][0], k4[1][1], k4[1][2], k4[1][3]};
    if (!cons) { issue_gdn(p, h, qtr, row0, L, 0, ptid, sr); commit_gdn(L, 0, lds, ptid, sr); if (1 < nblk) issue_gdn(p, h, qtr, row0, L, 1, ptid, sr); }
    BARRIER_LDS();
    for (int jb = 0; jb < nblk; ++jb) {
        if (!cons) {
            if (jb + 1 < nblk) commit_gdn(L, jb + 1, lds, ptid, sr);
            if (jb + 2 < nblk) issue_gdn(p, h, qtr, row0, L, jb + 2, ptid, sr);
            if (jb > 0) store_out_blk(P, row0, jb - 1, L, cBV + h * 128 + qtr * 32, OB(lds, (jb - 1) & 1), ptid);
        } else {
            const float* qb = QB(lds, jb & 1); const float* kb = KB(lds, jb & 1); const float* vb = VB(lds, jb & 1); const float* sc = SCB(lds, jb & 1);
            float* ob = OB(lds, jb & 1);
            const int nt = min(32, L - jb * 32);
            f32x4 q4[4][4]; float vv[4], a[4], be[4]; f32x4 qk[4], kk[4];
#define GLOAD_Q(T0) do { _Pragma("unroll") for (int i = 0; i < 4; ++i) { const int t = (T0) + i; \
        _Pragma("unroll") for (int j = 0; j < 4; ++j) q4[i][j] = *(const f32x4*)(qb + t * 128 + j * 32 + s * 4); } } while (0)
#define GLOAD_K(T0) do { _Pragma("unroll") for (int i = 0; i < 4; ++i) { const int t = (T0) + i; \
        _Pragma("unroll") for (int j = 0; j < 4; ++j) k4[i][j] = *(const f32x4*)(kb + t * 128 + j * 32 + s * 4); } \
      _Pragma("unroll") for (int i = 0; i < 4; ++i) { const int t = (T0) + i; \
        const f32x2 gg = *(const f32x2*)(sc + t * 16); a[i] = gg[0]; be[i] = gg[1]; \
        qk[i] = *(const f32x4*)(sc + t * 16 + 4); kk[i] = *(const f32x4*)(sc + t * 16 + 8); vv[i] = vb[t * 32 + cl]; } } while (0)
            GLOAD_Q(0); GLOAD_K(0);
#pragma unroll 1
            for (int t0 = 0; t0 < nt; t0 += 4) {
                float dk[4], dq[4];
                const int tn = min(t0 + 4, 28);
                __builtin_amdgcn_sched_barrier(0);
#pragma unroll
                for (int i = 0; i < 4; ++i) {
                    f32x2 x = bc2(0.f), x2 = bc2(0.f), y = bc2(0.f), y2 = bc2(0.f);
#pragma unroll
                    for (int j = 0; j < 4; ++j) {
                        x = lo2(k4[i][j]) * S[2 * j] + x; x2 = hi2(k4[i][j]) * S[2 * j + 1] + x2;
                        y = lo2(q4[i][j]) * S[2 * j] + y; y2 = hi2(q4[i][j]) * S[2 * j + 1] + y2; }
                    x = x + x2; y = y + y2;
                    dk[i] = x[0] + x[1]; dq[i] = y[0] + y[1];
                }
                __builtin_amdgcn_sched_barrier(0);
                GLOAD_Q(tn);
                __builtin_amdgcn_sched_barrier(0);
#pragma unroll
                for (int i = 0; i < 4; ++i) { dk[i] = red8(dk[i]); dq[i] = red8(dq[i]); }
                const float A0 = a[0], A1 = A0 * a[1], A2 = A1 * a[2], A3 = A2 * a[3];
                const float r10 = a[1], r21 = a[2], r32 = a[3], r20 = r10 * a[2], r31 = r21 * a[3], r30 = r20 * a[3];
                const float u0 = be[0] * (vv[0] - A0 * dk[0]);
                const float u1 = be[1] * (vv[1] - A1 * dk[1] - r10 * kk[1][0] * u0);
                const float u2 = be[2] * (vv[2] - A2 * dk[2] - r20 * kk[2][0] * u0 - r21 * kk[2][1] * u1);
                const float u3 = be[3] * (vv[3] - A3 * dk[3] - r30 * kk[3][0] * u0 - r31 * kk[3][1] * u1 - r32 * kk[3][2] * u2);
                if (s == 0) {
                    ob[(t0 + 0) * 32 + cl] = A0 * dq[0] + qk[0][0] * u0;
                    ob[(t0 + 1) * 32 + cl] = A1 * dq[1] + r10 * qk[1][0] * u0 + qk[1][1] * u1;
                    ob[(t0 + 2) * 32 + cl] = A2 * dq[2] + r20 * qk[2][0] * u0 + r21 * qk[2][1] * u1 + qk[2][2] * u2;
                    ob[(t0 + 3) * 32 + cl] = A3 * dq[3] + r30 * qk[3][0] * u0 + r31 * qk[3][1] * u1 + r32 * qk[3][2] * u2 + qk[3][3] * u3;
                }
                const float c0 = r30 * u0, c1 = r31 * u1, c2 = r32 * u2, c3 = u3;
#pragma unroll
                for (int j = 0; j < 4; ++j) {
                    S[2 * j] = lo2(k4[3][j]) * bc2(c3) + (lo2(k4[2][j]) * bc2(c2) + (lo2(k4[1][j]) * bc2(c1) + (lo2(k4[0][j]) * bc2(c0) + S[2 * j] * bc2(A3))));
                    S[2 * j + 1] = hi2(k4[3][j]) * bc2(c3) + (hi2(k4[2][j]) * bc2(c2) + (hi2(k4[1][j]) * bc2(c1) + (hi2(k4[0][j]) * bc2(c0) + S[2 * j + 1] * bc2(A3)))); }
                __builtin_amdgcn_sched_barrier(0);
                GLOAD_K(tn);
            }
#undef GLOAD_Q
#undef GLOAD_K
        }
        BARRIER_LDS();
    }
    if (!cons) store_out_blk(P, row0, nblk - 1, L, cBV + h * 128 + qtr * 32, OB(lds, (nblk - 1) & 1), ptid);
    else {
        const size_t sh = samp ? (size_t)(l * NS + bs) * 4 + h : (size_t)(l * NB + bs) * 4 + h;
        float* So = p.out + (samp ? o_sS : o_pS) + sh * 16384;
#pragma unroll
        for (int e = 0; e < 16; ++e) { const int d = (e >> 2) * 32 + s * 4 + (e & 3); So[d * 128 + col] = S[e >> 1][e & 1]; }
    }
    BARRIER_LDS();
}

__device__ __forceinline__ void scan_gdn_stream(const Params& p, int l, int h, int qtr, int bs0, int nseq, float* lds) {
    const int tid = opaque_tid(p.wv); const bool cons = tid < 256; const int ptid = tid - 256;
    const int lane = tid & 63, w = (tid >> 6) & 3, s = lane & 7, cl = w * 8 + (lane >> 3), col = qtr * 32 + cl;
    bf16_t* P = (bf16_t*)(p.ws + OFF_P);
    f32x2 S[8];
#pragma unroll
    for (int e = 0; e < 8; ++e) S[e] = bc2(0.f);
    f32x4 k4[4][4];
    StageRegs sr{k4[0][0], k4[0][1], k4[0][2], k4[0][3], k4[1][0], k4[1][1], k4[1][2], k4[1][3]};
#define LOADSTATE(BS) do { } while (0)
#define STISSUE(BS) st_issue(p.st_S + ((size_t)(l * NS + (BS)) * 4 + h) * 16384, qtr, ptid, k4[2][0], k4[2][1], k4[2][2], k4[2][3])
    if (!cons) { issue_gdn(p, h, qtr, SROW0 + bs0 * 4, LS, 0, ptid, sr); STISSUE(bs0); }
#pragma unroll 1
    for (int k = 0; k < nseq; ++k) {
        const int bs = bs0 + 8 * k, row0 = SROW0 + bs * 4;
        if (!cons) { commit_gdn(LS, 0, lds, ptid, sr, k & 1); st_commit(STB(lds, k & 1), ptid, k4[2][0], k4[2][1], k4[2][2], k4[2][3]);
            if (k + 1 < nseq) { issue_gdn(p, h, qtr, row0 + 32, LS, 0, ptid, sr); STISSUE(bs + 8); } }
        BARRIER_LDS();
        if (!cons) { if (k > 0) { store_out_blk(P, row0 - 32, 0, LS, cBV + h * 128 + qtr * 32, OB(lds, (k - 1) & 1), ptid); st_store(p.out + o_sS + ((size_t)(l * NS + bs - 8) * 4 + h) * 16384, qtr, STB(lds, (k - 1) & 1), ptid); } }
        else {
            const float* qb = QB(lds, k & 1); const float* kb = KB(lds, k & 1); const float* vb = VB(lds, k & 1); const float* sc = SCB(lds, k & 1);
            float* ob = OB(lds, k & 1); float* stb = STB(lds, k & 1);
#pragma unroll
            for (int e = 0; e < 16; ++e) { const int d = (e >> 2) * 32 + s * 4 + (e & 3); S[e >> 1][e & 1] = stb[d * ST_LD + cl]; }
            f32x4 q4[4][4]; float vv[4], a[4], be[4]; f32x4 qk[4], kk[4];
#define GLOAD_Q(T0) do { _Pragma("unroll") for (int i = 0; i < 4; ++i) { const int t = (T0) + i; \
        _Pragma("unroll") for (int j = 0; j < 4; ++j) q4[i][j] = *(const f32x4*)(qb + t * 128 + j * 32 + s * 4); } } while (0)
#define GLOAD_K(T0) do { _Pragma("unroll") for (int i = 0; i < 4; ++i) { const int t = (T0) + i; \
        _Pragma("unroll") for (int j = 0; j < 4; ++j) k4[i][j] = *(const f32x4*)(kb + t * 128 + j * 32 + s * 4); } \
      _Pragma("unroll") for (int i = 0; i < 4; ++i) { const int t = (T0) + i; \
        const f32x2 gg = *(const f32x2*)(sc + t * 16); a[i] = gg[0]; be[i] = gg[1]; \
        qk[i] = *(const f32x4*)(sc + t * 16 + 4); kk[i] = *(const f32x4*)(sc + t * 16 + 8); vv[i] = vb[t * 32 + cl]; } } while (0)
            GLOAD_Q(0); GLOAD_K(0);
            {
                float dk[4], dq[4];
                __builtin_amdgcn_sched_barrier(0);
#pragma unroll
                for (int i = 0; i < 4; ++i) {
                    f32x2 x = bc2(0.f), x2 = bc2(0.f), y = bc2(0.f), y2 = bc2(0.f);
#pragma unroll
                    for (int j = 0; j < 4; ++j) {
                        x = lo2(k4[i][j]) * S[2 * j] + x; x2 = hi2(k4[i][j]) * S[2 * j + 1] + x2;
                        y = lo2(q4[i][j]) * S[2 * j] + y; y2 = hi2(q4[i][j]) * S[2 * j + 1] + y2; }
                    x = x + x2; y = y + y2;
                    dk[i] = x[0] + x[1]; dq[i] = y[0] + y[1];
                }
                __builtin_amdgcn_sched_barrier(0);
#pragma unroll
                for (int i = 0; i < 4; ++i) { dk[i] = red8(dk[i]); dq[i] = red8(dq[i]); }
                const float A0 = a[0], A1 = A0 * a[1], A2 = A1 * a[2], A3 = A2 * a[3];
                const float r10 = a[1], r21 = a[2], r32 = a[3], r20 = r10 * a[2], r31 = r21 * a[3], r30 = r20 * a[3];
                const float u0 = be[0] * (vv[0] - A0 * dk[0]);
                const float u1 = be[1] * (vv[1] - A1 * dk[1] - r10 * kk[1][0] * u0);
                const float u2 = be[2] * (vv[2] - A2 * dk[2] - r20 * kk[2][0] * u0 - r21 * kk[2][1] * u1);
                const float u3 = be[3] * (vv[3] - A3 * dk[3] - r30 * kk[3][0] * u0 - r31 * kk[3][1] * u1 - r32 * kk[3][2] * u2);
                if (s == 0) {
                    ob[0 * 32 + cl] = A0 * dq[0] + qk[0][0] * u0;
                    ob[1 * 32 + cl] = A1 * dq[1] + r10 * qk[1][0] * u0 + qk[1][1] * u1;
                    ob[2 * 32 + cl] = A2 * dq[2] + r20 * qk[2][0] * u0 + r21 * qk[2][1] * u1 + qk[2][2] * u2;
                    ob[3 * 32 + cl] = A3 * dq[3] + r30 * qk[3][0] * u0 + r31 * qk[3][1] * u1 + r32 * qk[3][2] * u2 + qk[3][3] * u3;
                }
                const float c0 = r30 * u0, c1 = r31 * u1, c2 = r32 * u2, c3 = u3;
#pragma unroll
                for (int j = 0; j < 4; ++j) {
                    S[2 * j] = lo2(k4[3][j]) * bc2(c3) + (lo2(k4[2][j]) * bc2(c2) + (lo2(k4[1][j]) * bc2(c1) + (lo2(k4[0][j]) * bc2(c0) + S[2 * j] * bc2(A3))));
                    S[2 * j + 1] = hi2(k4[3][j]) * bc2(c3) + (hi2(k4[2][j]) * bc2(c2) + (hi2(k4[1][j]) * bc2(c1) + (hi2(k4[0][j]) * bc2(c0) + S[2 * j + 1] * bc2(A3)))); }
            }
#undef GLOAD_Q
#undef GLOAD_K
#pragma unroll
            for (int e = 0; e < 16; ++e) { const int d = (e >> 2) * 32 + s * 4 + (e & 3); stb[d * ST_LD + cl] = S[e >> 1][e & 1]; }
        }
    }
    BARRIER_LDS();
    if (!cons) { store_out_blk(P, SROW0 + (bs0 + 8 * (nseq - 1)) * 4, 0, LS, cBV + h * 128 + qtr * 32, OB(lds, (nseq - 1) & 1), ptid); st_store(p.out + o_sS + ((size_t)(l * NS + bs0 + 8 * (nseq - 1)) * 4 + h) * 16384, qtr, STB(lds, (nseq - 1) & 1), ptid); }
    BARRIER_LDS();
#undef LOADSTATE
#undef STISSUE
}


__device__ __forceinline__ void phase_scan(const Params& p, int l, float* lds) {
    for (int item = blockIdx.x; item < 256; item += gridDim.x) {
        const int qtr = item & 3, h = (item >> 2) & 3, bs = (item >> 4) & 7, branch = item >> 7;
        if (branch == 0) scan_mlstm_chunk(p, l, bs, h, qtr, bs * LPAD, LP, (unsigned char*)lds); else scan_gdn_chunk(p, l, bs, h, qtr, bs * LPAD, LP, (unsigned char*)lds);
    }
    for (int c = blockIdx.x; c < 256; c += gridDim.x) {
        const int qtr = c & 3, h = (c >> 2) & 3, branch = (c >> 4) & 1, bs0 = c >> 5;
        if (branch == 0) scan_mlstm_stream(p, l, h, qtr, bs0, NS / 8, lds); else scan_gdn_stream(p, l, h, qtr, bs0, NS / 8, lds);
    }
}

__device__ __forceinline__ void phase_norm(const Params& p, int l) {
    const int tid = opaque_tid(p.wv); const int wave = tid >> 6, lane = tid & 63;
    bf16_t* P = (bf16_t*)(p.ws + OFF_P);
    const int part = lane >> 5, hh = (lane >> 3) & 3, g = lane & 7, ch0 = hh * 128 + g * 16;
    const int craw = (part ? cBV : cV) + ch0, cgate = (part ? cZ : cO) + ch0;
    const float* wn = part ? p.b_norm_w + l * 128 + g * 16 : p.a_norm_w + l * 512 + ch0;
    for (int row = blockIdx.x * 8 + wave; row < MROWS; row += gridDim.x * 8) {
        if (row < SROW0 && (row % LPAD) >= LP) continue;
        bf16_t* pr = P + (size_t)row * NP;
        float x[16], z[16];
        unpack8(*(const u32x4*)(pr + craw), x); unpack8(*(const u32x4*)(pr + craw + 8), x + 8);
        unpack8(*(const u32x4*)(pr + cgate), z); unpack8(*(const u32x4*)(pr + cgate + 8), z + 8);
        float sum = 0.f;
#pragma unroll
        for (int i = 0; i < 16; ++i) sum += x[i];
        float mean = red8(sum) * (1.f / 128.f);
        if (part) mean = 0.f;
        float s2 = 0.f;
#pragma unroll
        for (int i = 0; i < 16; ++i) { x[i] -= mean; s2 += x[i] * x[i]; }
        const float rstd = rsqrtf(red8(s2) * (1.f / 128.f) + 1e-6f);
        float y[16];
#pragma unroll
        for (int i = 0; i < 16; ++i) { const float sg = sigmoidf_(z[i]); y[i] = x[i] * rstd * wn[i] * (part ? z[i] * sg : sg); }
        u32x4 o0, o1;
        o0.x = pk2(y[0], y[1]); o0.y = pk2(y[2], y[3]); o0.z = pk2(y[4], y[5]); o0.w = pk2(y[6], y[7]);
        o1.x = pk2(y[8], y[9]); o1.y = pk2(y[10], y[11]); o1.z = pk2(y[12], y[13]); o1.w = pk2(y[14], y[15]);
        *(u32x4*)(pr + cgate) = o0; *(u32x4*)(pr + cgate + 8) = o1;
    }
}

__device__ __forceinline__ void phase_convact(const Params& p, int l) {
    bf16_t* U = (bf16_t*)(p.ws + OFF_P); const bf16_t* HB = (const bf16_t*)(p.ws + OFF_HB);
    const float* cw = p.fconv_w + (size_t)l * 3 * NU;
    constexpr int NCG = DFF / 8, NRG = MROWS / 32;
    const int tid = opaque_tid(p.wv);
    for (int it = blockIdx.x * NTHREADS + tid; it < NRG * NCG; it += gridDim.x * NTHREADS) {
        const int rg = it / NCG, cg_ = it - rg * NCG, c0 = cg_ * 8;
        float wa[3][8], wb[3][8];
#pragma unroll
        for (int j = 0; j < 3; ++j) {
            const f32x4 a0 = *(const f32x4*)(cw + j * NU + c0), a1 = *(const f32x4*)(cw + j * NU + c0 + 4);
            const f32x4 b0 = *(const f32x4*)(cw + j * NU + DFF + c0), b1 = *(const f32x4*)(cw + j * NU + DFF + c0 + 4);
#pragma unroll
            for (int i = 0; i < 4; ++i) { wa[j][i] = a0[i]; wa[j][4 + i] = a1[i]; wb[j][i] = b0[i]; wb[j][4 + i] = b1[i]; }
        }
        float a2[8], a1[8], b2[8], b1[8];
        const bool samp = rg >= SROW0 / 32;
#pragma unroll
        for (int i = 0; i < 8; ++i) { a2[i] = a1[i] = b2[i] = b1[i] = 0.f; }
        if (!samp && (rg % (LPAD / 32)) != 0) {
            const bf16_t* h0 = HB + (size_t)(rg - 1) * 2 * NU;
            unpack8(*(const u32x4*)(h0 + c0), a2); unpack8(*(const u32x4*)(h0 + NU + c0), a1);
            unpack8(*(const u32x4*)(h0 + DFF + c0), b2); unpack8(*(const u32x4*)(h0 + NU + DFF + c0), b1);
        }
#pragma unroll 4
        for (int i = 0; i < 32; ++i) {
            const int row = rg * 32 + i;
            if (samp && (i & 3) == 0) {
                const float* st = p.st_fconv + ((size_t)(l * NS + ((row - SROW0) >> 2)) * 2) * NU;
                const f32x4 x0 = *(const f32x4*)(st + c0), x1 = *(const f32x4*)(st + c0 + 4), y0 = *(const f32x4*)(st + NU + c0), y1 = *(const f32x4*)(st + NU + c0 + 4);
                const f32x4 u0 = *(const f32x4*)(st + DFF + c0), u1 = *(const f32x4*)(st + DFF + c0 + 4), v0 = *(const f32x4*)(st + NU + DFF + c0), v1 = *(const f32x4*)(st + NU + DFF + c0 + 4);
#pragma unroll
                for (int e = 0; e < 4; ++e) { a2[e] = x0[e]; a2[4 + e] = x1[e]; a1[e] = y0[e]; a1[4 + e] = y1[e]; b2[e] = u0[e]; b2[4 + e] = u1[e]; b1[e] = v0[e]; b1[4 + e] = v1[e]; }
            }
            bf16_t* ur = U + (size_t)row * NU;
            float a[8], b[8], hh[8];
            unpack8(*(const u32x4*)(ur + c0), a); unpack8(*(const u32x4*)(ur + DFF + c0), b);
#pragma unroll
            for (int e = 0; e < 8; ++e) {
                const float ca = wa[0][e] * a2[e] + wa[1][e] * a1[e] + wa[2][e] * a[e];
                const float cb = wb[0][e] * b2[e] + wb[1][e] * b1[e] + wb[2][e] * b[e];
                hh[e] = ca * sigmoidf_(ca) * cb;
                a2[e] = a1[e]; a1[e] = a[e]; b2[e] = b1[e]; b1[e] = b[e];
            }
            u32x4 o; o.x = pk2(hh[0], hh[1]); o.y = pk2(hh[2], hh[3]); o.z = pk2(hh[4], hh[5]); o.w = pk2(hh[6], hh[7]);
            *(u32x4*)(ur + c0) = o;
        }
    }
}

#ifndef PROBE
#define PROBE 0
#endif
constexpr int NPHASE = 2 + DEPTH * 11;
__global__ void __launch_bounds__(NTHREADS) fwd_kernel(Params pin) {
    extern __shared__ __attribute__((aligned(16))) unsigned char smem_raw[];
    Params p = pin; p.wv = __builtin_amdgcn_readfirstlane((int)(threadIdx.x >> 6));
    unsigned* bar = (unsigned*)(p.ws + OFF_BAR); const unsigned xcc = xb_xcc_id();
    volatile LAS unsigned* xst = (volatile LAS unsigned*)(LAS unsigned char*)(smem_raw + LDS_GEMM);
    if (threadIdx.x == 0) { xst[0] = 0u; xst[1] = 0u; (void)xb_add(&bar[XB_XCNT(xcc)], 1u); }
    __syncthreads();
    float* lds = (float*)smem_raw;
    bf16_t* X = (bf16_t*)(p.ws + OFF_X); bf16_t* P = (bf16_t*)(p.ws + OFF_P); bf16_t* HB = (bf16_t*)(p.ws + OFF_HB);
    for (int ph = p.ph_lo; ph < p.ph_hi; ++ph) {
#if PROBE == 3
      for (int rep = 0; rep < 2; ++rep) { const int sx = ph < 2 ? -1 : (ph - 2) % 11; if (rep == 1 && !(ph < 2 || sx == 6 || sx == 10)) break;
#endif
        if (ph == 0) phase_weights(p, lds);
        else if (ph == 1) phase_ln(p, 0, nullptr, 0, p.ln_emb_g, p.ln_emb_b, 0, false);
        else {
            const int l = (ph - 2) / 11, s = (ph - 2) % 11;
            if (s == 0) { GemmArgs g{X, X, 1 << 30, D, w_inT(p, l), MROWS, NP, 1024}; gemm_phase(g, EpiP{P, (bf16_t*)(p.ws + OFF_GH), p.out, l}, p.wv); }
            else if (s == 1) phase_prep(p, l, lds);
            else if (s == 2) phase_scan(p, l, lds);
            else if (s == 3) phase_norm(p, l);
            else if (s == 4) { GemmArgs g{P + cO, P + cZ, 4, NP, w_abT(p, l), MROWS, 2048, 512}; gemm_phase(g, EpiMerge{P}, p.wv); }
            else if (s == 5) { GemmArgs g{P + cMG, P + cMG, 1 << 30, NP, w_outT(p, l), MROWS, 1024, 2048, 1}; gemm_phase(g, EpiRes{X, P, NP, 0, (bf16_t*)(p.ws + OFF_GH)}, p.wv); }
            else if (s == 6) phase_ln(p, 1, P, NP, p.ln1_g + l * D, p.ln1_b + l * D, -1, false);
            else if (s == 7) { GemmArgs g{X, X, 1 << 30, D, w_upT(p, l), MROWS, NU, 1024}; gemm_phase(g, EpiUp{P, HB, p.out, l}, p.wv); }
            else if (s == 8) phase_convact(p, l);
            else if (s == 9) { GemmArgs g{P, P, 1 << 30, NU, w_dnT(p, l), MROWS, 1024, DFF, 1}; gemm_phase(g, EpiRes{X, P, NU, DFF, (bf16_t*)(p.ws + OFF_GH)}, p.wv); }
            else phase_ln(p, 1, P + DFF, NU, p.ln2_g + l * D, p.ln2_b + l * D, l + 1 < DEPTH ? l + 1 : -1, l + 1 == DEPTH);
        }
#if PROBE == 3
      }
#endif
        if (ph + 1 < p.ph_hi) { if (ph == 0) cg::this_grid().sync(); else xcd_barrier(bar, xcc, xst, p.wv); }
    }
#if PROBE == 4
    for (int i = 0; i < 20; ++i) xcd_barrier(bar, xcc, xst, p.wv);
#endif
}

extern "C" void kernel_launch(void* const* d_in, const int* in_sizes, int n_in, void* d_out, int out_size, void* d_ws, size_t ws_size, hipStream_t stream) {
    static int grid = 0;
    if (grid == 0) {
        if (n_in != 28 || (size_t)out_size != o_end || ws_size < WS_END) { fprintf(stderr, "kernel_launch: unexpected sizes n_in %d out %d ws %zu (need %zu)\n", n_in, out_size, ws_size, (size_t)WS_END); grid = -1; return; }
        int dev = 0, cus = 0, per_cu = 0;
        hipGetDevice(&dev); hipDeviceGetAttribute(&cus, hipDeviceAttributeMultiprocessorCount, dev);
        if (hipFuncSetAttribute((const void*)fwd_kernel, hipFuncAttributeMaxDynamicSharedMemorySize, LDS_BYTES) != hipSuccess) { fprintf(stderr, "hipFuncSetAttribute failed\n"); grid = -1; return; }
        if (hipOccupancyMaxActiveBlocksPerMultiprocessor(&per_cu, (const void*)fwd_kernel, NTHREADS, LDS_BYTES) != hipSuccess || per_cu < 1) { fprintf(stderr, "occupancy query failed (%d)\n", per_cu); (void)hipGetLastError(); per_cu = 1; }
        grid = cus * per_cu;
        if (grid > 256) grid = 256;
    }
    if (grid < 0) return;
    if (hipMemsetAsync((unsigned char*)d_ws + OFF_BAR, 0, 16384, stream) != hipSuccess) { fprintf(stderr, "memset of barrier words failed\n"); return; }
    Params p{};
    const float** pp = (const float**)&p;
    for (int i = 0; i < 28; ++i) pp[i] = (const float*)d_in[i];
    p.out = (float*)d_out; p.ws = (unsigned char*)d_ws;
#if MULTI
    for (int ph = 0; ph < NPHASE; ++ph) { p.ph_lo = ph; p.ph_hi = ph + 1; hipLaunchKernelGGL(fwd_kernel, dim3(grid), dim3(NTHREADS), LDS_BYTES, stream, p); }
#else
    p.ph_lo = 0; p.ph_hi = NPHASE;
    void* args[] = {&p};
    hipError_t e = hipLaunchCooperativeKernel((const void*)fwd_kernel, dim3(grid), dim3(NTHREADS), args, LDS_BYTES, stream);
    if (e != hipSuccess) fprintf(stderr, "cooperative launch failed: %s (grid %d)\n", hipGetErrorString(e), grid);
#endif
}
```

```cpp
#include <hip/hip_runtime.h>
#include <hip/hip_cooperative_groups.h>
#include <cstdio>
namespace cg = cooperative_groups;

#ifndef MULTI
#define MULTI 0
#endif

typedef unsigned short bf16_t;
typedef short bf16x8 __attribute__((ext_vector_type(8)));
typedef float f32x4 __attribute__((ext_vector_type(4)));
typedef float f32x2 __attribute__((ext_vector_type(2)));
typedef unsigned u32x2 __attribute__((ext_vector_type(2)));
typedef unsigned u32x4 __attribute__((ext_vector_type(4)));

constexpr int D = 1024, NB = 8, LP = 2064, LPAD = 2080, NS = 128, LS = 4, DEPTH = 2, NMETA = 16, SEQ = 2048;
constexpr int MROWS = NB * LPAD + NS * LS;
constexpr int SROW0 = NB * LPAD;
constexpr int NIN = 6160, NP = 6144, DFF = 2816, NU = 5632;
constexpr int cQ = 0, cK = 512, cV = 1024, cO = 1536, cBQ = 2048, cBK = 2560, cBV = 3072, cZ = 3584, cMG = 4096;
constexpr float ALPHA = 1.4142135623730951f;
constexpr int SPLIT_ROW0 = 64 * 256;
constexpr int NTHREADS = 512;
constexpr int LDS_GEMM = 131072;
constexpr int LDS_BYTES = LDS_GEMM + 256;

constexpr size_t W_IN = (size_t)NP * 1024, W_AB = 2048 * 512, W_OUT = 1024 * 2048, W_UP = (size_t)NU * 1024, W_DN = (size_t)1024 * DFF;
constexpr size_t W_LAYER = W_IN + W_AB + W_OUT + W_UP + W_DN;
constexpr size_t OFF_W = 0;
constexpr size_t OFF_WG = OFF_W + DEPTH * W_LAYER * 2;
constexpr size_t OFF_X = OFF_WG + DEPTH * 16 * 1024 * 4;
constexpr size_t OFF_G = OFF_X + (size_t)MROWS * D * 2;
constexpr size_t OFF_HB = OFF_G + (size_t)MROWS * 16 * 4;
constexpr size_t OFF_P = OFF_HB + (size_t)(MROWS / 32) * 2 * NU * 2;
constexpr size_t OFF_GH = OFF_P + (size_t)MROWS * NP * 2;
constexpr size_t OFF_REC = OFF_GH + (size_t)(MROWS / 32) * 3 * 1536 * 2;
constexpr size_t OFF_BAR = OFF_REC + (size_t)MROWS * 4 * 16 * 4;
constexpr size_t OFF_TB = OFF_BAR + 16384;
constexpr size_t WS_END = OFF_TB + (size_t)(MROWS / 32) * 4 * 3 * 1024 * 2;

constexpr size_t o_yp = 0;
constexpr size_t o_ys = o_yp + (size_t)NB * SEQ * D;
constexpr size_t o_pC = o_ys + (size_t)NS * LS * D;
constexpr size_t o_pn = o_pC + (size_t)DEPTH * NB * 4 * 128 * 128;
constexpr size_t o_pm = o_pn + (size_t)DEPTH * NB * 4 * 128;
constexpr size_t o_pS = o_pm + (size_t)DEPTH * NB * 4;
constexpr size_t o_pgc = o_pS + (size_t)DEPTH * NB * 4 * 128 * 128;
constexpr size_t o_pfc = o_pgc + (size_t)DEPTH * NB * 3 * 1536;
constexpr size_t o_sC = o_pfc + (size_t)DEPTH * NB * 2 * NU;
constexpr size_t o_sn = o_sC + (size_t)DEPTH * NS * 4 * 128 * 128;
constexpr size_t o_sm = o_sn + (size_t)DEPTH * NS * 4 * 128;
constexpr size_t o_sS = o_sm + (size_t)DEPTH * NS * 4;
constexpr size_t o_sgc = o_sS + (size_t)DEPTH * NS * 4 * 128 * 128;
constexpr size_t o_sfc = o_sgc + (size_t)DEPTH * NS * 3 * 1536;
constexpr size_t o_end = o_sfc + (size_t)DEPTH * NS * 2 * NU;

struct Params {
    const float* x_prompt; const float* x_sample; const float* st_C; const float* st_n; const float* st_m; const float* st_S;
    const float* st_gconv; const float* st_fconv; const float* meta; const float* ln_emb_g; const float* ln_emb_b; const float* w_in;
    const float* gate_bias; const float* a_norm_w; const float* gconv_w; const float* A_log; const float* dt_bias; const float* b_norm_w;
    const float* w_pa; const float* w_pb; const float* w_out; const float* ln1_g; const float* ln1_b; const float* w_up;
    const float* fconv_w; const float* w_down; const float* ln2_g; const float* ln2_b;
    float* out; unsigned char* ws;
    int ph_lo, ph_hi;
    int wv, pad_;
};

__device__ __forceinline__ int opaque_tid(int wv) { int lane; asm volatile("v_mbcnt_lo_u32_b32 %0, -1, 0\n\tv_mbcnt_hi_u32_b32 %0, -1, %0" : "=v"(lane)); return wv * 64 + lane; }
__device__ __forceinline__ float bflo(unsigned u) { return __uint_as_float(u << 16); }
__device__ __forceinline__ float bfhi(unsigned u) { return __uint_as_float(u & 0xffff0000u); }
__device__ __forceinline__ unsigned pk2(float lo, float hi) { unsigned r; asm("v_cvt_pk_bf16_f32 %0, %1, %2" : "=v"(r) : "v"(lo), "v"(hi)); return r; }
template <int CTRL> __device__ __forceinline__ float dppf(float v) { return __int_as_float(__builtin_amdgcn_update_dpp(0, __float_as_int(v), CTRL, 0xf, 0xf, true)); }
__device__ __forceinline__ float red8(float v) { v += dppf<0xB1>(v); v += dppf<0x4E>(v); v += dppf<0x141>(v); return v; }
__device__ __forceinline__ float red16(float v) { v = red8(v); v += dppf<0x140>(v); return v; }
__device__ __forceinline__ float rdl(float v, int l) { return __int_as_float(__builtin_amdgcn_readlane(__float_as_int(v), l)); }
__device__ __forceinline__ float rdl_pin(float v, int l) { float r_; asm volatile("v_readlane_b32 %0, %1, %2" : "=s"(r_) : "v"(v), "s"(l)); return r_; }
__device__ __forceinline__ float red64(float v) { v = red16(v); return (rdl(v, 0) + rdl(v, 16)) + (rdl(v, 32) + rdl(v, 48)); }
__device__ __forceinline__ float sigmoidf_(float x) { return __builtin_amdgcn_rcpf(1.f + __expf(-x)); }
__device__ __forceinline__ u32x4 pack8(const float* y) { u32x4 o; o.x = pk2(y[0], y[1]); o.y = pk2(y[2], y[3]); o.z = pk2(y[4], y[5]); o.w = pk2(y[6], y[7]); return o; }
__device__ __forceinline__ void unpack8(u32x4 a, float* x) { x[0] = bflo(a.x); x[1] = bfhi(a.x); x[2] = bflo(a.y); x[3] = bfhi(a.y); x[4] = bflo(a.z); x[5] = bfhi(a.z); x[6] = bflo(a.w); x[7] = bfhi(a.w); }


#define XB_TMO      128
#define XB_XCNT(j)  (256  + 64 * (j))
#define XB_XSUB(j)  (1280 + 64 * (j))
#define XB_XGEN(j)  (2304 + 64 * (j))
#define XB_TOP      3328
#define XB_TOPGEN   3392
#define XCD_BAR_WORDS 3456
#define XB_SPIN_CAP (1u << 18)
#define LAS __attribute__((address_space(3)))
__device__ __forceinline__ unsigned xb_ld(unsigned* p)              { return __hip_atomic_load(p, __ATOMIC_RELAXED, __HIP_MEMORY_SCOPE_AGENT); }
__device__ __forceinline__ unsigned xb_add(unsigned* p, unsigned v) { return __hip_atomic_fetch_add(p, v, __ATOMIC_RELAXED, __HIP_MEMORY_SCOPE_AGENT); }
__device__ __forceinline__ unsigned xb_xcc_id() { return (unsigned)__builtin_amdgcn_s_getreg((3 << 11) | 20) & 0xFu; }
#define XB_SPIN(cond, bar) do { unsigned _sp = 0; while (cond) { __builtin_amdgcn_s_sleep(1); \
    if ((++_sp & 255u) == 0u) { if (xb_ld(&(bar)[XB_TMO])) break; if (_sp > XB_SPIN_CAP) { atomicAdd(&(bar)[XB_TMO], 1u); break; } } } } while (0)
__device__ __forceinline__ void xcd_barrier_complete(unsigned* bar, unsigned x, unsigned& nloc, unsigned& nx) {
    const unsigned G = gridDim.x;
    unsigned sum, cnt, mine, sp = 0u;
    for (;;) {
        sum = 0u; cnt = 0u; mine = 0u;
#pragma unroll
        for (unsigned j = 0; j < 16; ++j) { const unsigned c = xb_ld(&bar[XB_XCNT(j)]); sum += c; cnt += (c > 0u) ? 1u : 0u; mine = (j == x) ? c : mine; }
        if (sum == G) break;
        __builtin_amdgcn_s_sleep(1);
        if ((++sp & 255u) == 0u) { if (xb_ld(&bar[XB_TMO])) break; if (sp > XB_SPIN_CAP) { atomicAdd(&bar[XB_TMO], 1u); break; } }
    }
    nloc = mine > 0u ? mine : 1u; nx = cnt > 0u ? cnt : 1u;
}
__device__ __forceinline__ void xcd_barrier(unsigned* bar, unsigned x, volatile LAS unsigned* st, int wv) {
    asm volatile("s_waitcnt vmcnt(0)" ::: "memory");
    __syncthreads();
    if (opaque_tid(wv) == 0) {
        __builtin_amdgcn_s_waitcnt(0);
        unsigned nloc = st[0], nx = st[1];
        if (nloc == 0u) { xcd_barrier_complete(bar, x, nloc, nx); st[0] = nloc; st[1] = nx; }
        const unsigned old = xb_add(&bar[XB_XSUB(x)], 1u);
        const unsigned gen = old / nloc;
        if (old + 1u == (gen + 1u) * nloc) {
            __builtin_amdgcn_fence(__ATOMIC_RELEASE, "agent");
            asm volatile("s_waitcnt vmcnt(0)" ::: "memory");
            const unsigned og = xb_add(&bar[XB_TOP], 1u);
            const unsigned tg = og / nx;
            if (og + 1u == (tg + 1u) * nx) xb_add(&bar[XB_TOPGEN], 1u);
            else XB_SPIN(xb_ld(&bar[XB_TOPGEN]) == tg, bar);
            __builtin_amdgcn_fence(__ATOMIC_ACQUIRE, "agent");
            xb_add(&bar[XB_XGEN(x)], 1u);
            asm volatile("s_waitcnt vmcnt(0)" ::: "memory");
        } else {
            XB_SPIN(xb_ld(&bar[XB_XGEN(x)]) == gen, bar);
            __builtin_amdgcn_fence(__ATOMIC_ACQUIRE, "agent");
            asm volatile("s_waitcnt vmcnt(0)" ::: "memory");
        }
    }
    __syncthreads();
}

struct TJob { const float* src; int ldw; int K; int N; bf16_t* dst; int ldt; };
__device__ __forceinline__ void transpose_item(const TJob& jb, int item, float* scr, int lane) {
    const int nblk = jb.N / 32, kb = item / nblk, nb = item % nblk, k0 = 64 * kb, n0 = 32 * nb;
#pragma unroll 8
    for (int i = 0; i < 32; ++i) { const int kk = 2 * i + (lane >> 5); scr[kk * 33 + (lane & 31)] = jb.src[(size_t)(k0 + kk) * jb.ldw + n0 + (lane & 31)]; }
    __builtin_amdgcn_s_waitcnt(0xc07f); asm volatile("" ::: "memory");
    const int c = lane & 7;
#pragma unroll
    for (int j = 0; j < 4; ++j) { const int n = (lane >> 3) + 8 * j; const float* s = scr + (8 * c) * 33 + n;
        u32x4 o; o.x = pk2(s[0 * 33], s[1 * 33]); o.y = pk2(s[2 * 33], s[3 * 33]); o.z = pk2(s[4 * 33], s[5 * 33]); o.w = pk2(s[6 * 33], s[7 * 33]);
        *(u32x4*)(jb.dst + (size_t)(n0 + n) * jb.ldt + k0 + 8 * c) = o; }
    __builtin_amdgcn_s_waitcnt(0xc07f); asm volatile("" ::: "memory");
}
__device__ __forceinline__ bf16_t* wl(const Params& p, int l) { return (bf16_t*)(p.ws + OFF_W) + (size_t)l * W_LAYER; }
__device__ __forceinline__ bf16_t* w_inT(const Params& p, int l) { return wl(p, l); }
__device__ __forceinline__ bf16_t* w_abT(const Params& p, int l) { return wl(p, l) + W_IN; }
__device__ __forceinline__ bf16_t* w_outT(const Params& p, int l) { return wl(p, l) + W_IN + W_AB; }
__device__ __forceinline__ bf16_t* w_upT(const Params& p, int l) { return wl(p, l) + W_IN + W_AB + W_OUT; }
__device__ __forceinline__ bf16_t* w_dnT(const Params& p, int l) { return wl(p, l) + W_IN + W_AB + W_OUT + W_UP; }

__device__ __forceinline__ void phase_weights(const Params& p, float* lds) {
    const int tid = opaque_tid(p.wv); const int wave = tid >> 6, lane = tid & 63;
    float* scr = lds + wave * (64 * 33);
    const int gw = blockIdx.x * 8 + wave, NGW = gridDim.x * 8;
    constexpr int I0 = 16 * 64, I1 = 16 * 64, I2 = 16 * 64, I3 = 8 * 32, I4 = 8 * 32, I5 = 16 * 32, I6 = 16 * 32, I7 = 16 * (NU / 32), I8 = (DFF / 64) * 32;
    constexpr int IL = I0 + I1 + I2 + I3 + I4 + I5 + I6 + I7 + I8;
    for (int it = gw; it < DEPTH * IL; it += NGW) {
        const int l = it / IL; int r = it % IL;
        TJob jb;
        const float* win = p.w_in + (size_t)l * 1024 * NIN;
        if (r < I0) { jb = {win, NIN, 1024, 2048, w_inT(p, l), 1024}; }
        else if ((r -= I0) < I1) { jb = {win + 2056, NIN, 1024, 2048, w_inT(p, l) + (size_t)2048 * 1024, 1024}; }
        else if ((r -= I1) < I2) { jb = {win + 4112, NIN, 1024, 2048, w_inT(p, l) + (size_t)4096 * 1024, 1024}; }
        else if ((r -= I2) < I3) { jb = {p.w_pa + (size_t)l * 512 * 1024, 1024, 512, 1024, w_abT(p, l), 512}; }
        else if ((r -= I3) < I4) { jb = {p.w_pb + (size_t)l * 512 * 1024, 1024, 512, 1024, w_abT(p, l) + (size_t)1024 * 512, 512}; }
        else if ((r -= I4) < I5) { jb = {p.w_out + (size_t)l * 1024 * 1024, 1024, 1024, 1024, w_outT(p, l), 2048}; }
        else if ((r -= I5) < I6) { jb = {p.w_out + (size_t)l * 1024 * 1024, 1024, 1024, 1024, w_outT(p, l) + 1024, 2048}; }
        else if ((r -= I6) < I7) { jb = {p.w_up + (size_t)l * 1024 * NU, NU, 1024, NU, w_upT(p, l), 1024}; }
        else { r -= I7; jb = {p.w_down + (size_t)l * DFF * 1024, 1024, DFF, 1024, w_dnT(p, l), DFF}; }
        transpose_item(jb, r, scr, lane);
    }
    float* wg = (float*)(p.ws + OFF_WG);
    for (int i = blockIdx.x * NTHREADS + tid; i < DEPTH * 16 * 1024; i += gridDim.x * NTHREADS) {
        const int l = i >> 14, g = (i >> 10) & 15, k = i & 1023;
        const int col = g < 8 ? 2048 + g : 4104 + (g - 8);
        wg[i] = p.w_in[((size_t)l * 1024 + k) * NIN + col];
    }
}

__device__ __forceinline__ void phase_ln(const Params& p, int mode, const bf16_t* src, int ldsrc, const float* gam, const float* bet,
                                         int gate_layer  , bool final_out) {
    const int tid = opaque_tid(p.wv); const int wave = tid >> 6, lane = tid & 63;
    bf16_t* X = (bf16_t*)(p.ws + OFF_X);
    float* G = (float*)(p.ws + OFF_G);
    const float* wg = (const float*)(p.ws + OFF_WG) + (size_t)(gate_layer < 0 ? 0 : gate_layer) * 16 * 1024;
    for (int row = blockIdx.x * 8 + wave; row < MROWS; row += gridDim.x * 8) {
        int b = 0, t = 0; bool samp = row >= SROW0;
        if (!samp) { b = row / LPAD; t = row - b * LPAD; } else { b = (row - SROW0) >> 2; t = row & 3; }
        const bool valid = samp || t < LP;
        bf16_t* xo = X + (size_t)row * D;
        if (!valid) { if (mode == 0) {
#pragma unroll
                for (int j = 0; j < 4; ++j) *(u32x2*)(xo + 256 * j + lane * 4) = (u32x2){0u, 0u}; }
            continue; }
        f32x4 v[4];
        if (mode == 0) {
            const float* s = samp ? p.x_sample + ((size_t)b * LS + t) * D : (t < NMETA ? p.meta + (size_t)t * D : p.x_prompt + ((size_t)b * SEQ + (t - NMETA)) * D);
#pragma unroll
            for (int j = 0; j < 4; ++j) v[j] = *(const f32x4*)(s + 256 * j + lane * 4);
        } else {
            const bf16_t* s = src + (size_t)row * ldsrc;
#pragma unroll
            for (int j = 0; j < 4; ++j) { u32x2 u = *(const u32x2*)(s + 256 * j + lane * 4); v[j] = (f32x4){bflo(u.x), bfhi(u.x), bflo(u.y), bfhi(u.y)}; }
            if (row >= SPLIT_ROW0) { const bf16_t* sp = (const bf16_t*)(p.ws + OFF_GH) + (size_t)(row - SPLIT_ROW0) * D;
#pragma unroll
                for (int q = 0; q < 3; ++q)
#pragma unroll
                    for (int j = 0; j < 4; ++j) { const u32x2 u = *(const u32x2*)(sp + (size_t)q * (MROWS - SPLIT_ROW0) * D + 256 * j + lane * 4); v[j] += (f32x4){bflo(u.x), bfhi(u.x), bflo(u.y), bfhi(u.y)}; } }
        }
        float sum = 0.f;
#pragma unroll
        for (int j = 0; j < 4; ++j) sum += (v[j][0] + v[j][1]) + (v[j][2] + v[j][3]);
        const float mean = red64(sum) * (1.f / D);
        float s2 = 0.f;
#pragma unroll
        for (int j = 0; j < 4; ++j) { v[j] = v[j] - mean; s2 += (v[j][0] * v[j][0] + v[j][1] * v[j][1]) + (v[j][2] * v[j][2] + v[j][3] * v[j][3]); }
        const float rstd = rsqrtf(red64(s2) * (1.f / D) + 1e-5f);
#pragma unroll
        for (int j = 0; j < 4; ++j) { const f32x4 g4 = *(const f32x4*)(gam + 256 * j + lane * 4), b4 = *(const f32x4*)(bet + 256 * j + lane * 4);
            v[j] = v[j] * rstd * g4 + b4;
            *(u32x2*)(xo + 256 * j + lane * 4) = (u32x2){pk2(v[j][0], v[j][1]), pk2(v[j][2], v[j][3])}; }
        if (final_out) {
            float* o = nullptr;
            if (samp) o = p.out + o_ys + ((size_t)b * LS + t) * D; else if (t >= NMETA) o = p.out + o_yp + ((size_t)b * SEQ + (t - NMETA)) * D;
            if (o) {
#pragma unroll
                for (int j = 0; j < 4; ++j) *(f32x4*)(o + 256 * j + lane * 4) = v[j]; }
        }
        if (gate_layer >= 0) {
            float mine = 0.f;
#pragma unroll 2
            for (int g = 0; g < 16; ++g) {
                float a = 0.f;
#pragma unroll
                for (int j = 0; j < 4; ++j) { const f32x4 w4 = *(const f32x4*)(wg + g * 1024 + 256 * j + lane * 4); a += (v[j][0] * w4[0] + v[j][1] * w4[1]) + (v[j][2] * w4[2] + v[j][3] * w4[3]); }
                a = red64(a);
                if (lane == g) mine = a;
            }
            if (lane < 16) G[(size_t)row * 16 + lane] = mine;
        }
    }
}

constexpr int BM = 256, BK = 64, HALF = 128, HT = HALF * BK, NXCD = 8, WGM = 8;
__device__ __forceinline__ int lds_byte(int r, int c) { int st = (r >> 4) * 2 + (c >> 5), rr = r & 15, cc = c & 31, ob = rr * 64 + cc * 2; return st * 1024 + (ob ^ (((ob >> 9) & 1) << 5)); }
__device__ __forceinline__ void stage_rc(int b, int& R, int& C) { int st = b / 1024, sb = b % 1024, swz = sb ^ (((sb >> 9) & 1) << 5); R = (st >> 1) * 16 + swz / 64; C = (st & 1) * 32 + (swz % 64) / 2; }

struct GemmArgs { const bf16_t* A; const bf16_t* A2; int a2_from_pn; int lda; const bf16_t* Bt; int M, N, K; int splitk; };

template <class Epi>
__device__ __forceinline__ void gemm_phase(const GemmArgs g, const Epi& epi, int wv) {
    extern __shared__ __attribute__((aligned(16))) unsigned char smem_raw[];
    bf16_t* shm = (bf16_t*)smem_raw;
#define SA(b, h) (shm + ((b) * 2 + (h)) * HT)
#define SB(b, h) (shm + (4 + (b) * 2 + (h)) * HT)
#define STAGE_A(P_, br, kt) do { const char* _gb = (const char*)(A + (size_t)(br) * lda + (size_t)((kt) + kofs) * BK); \
    unsigned _o0 = offA0, _o1 = offA1; asm volatile("" : "+v"(_o0), "+v"(_o1)); \
    __builtin_amdgcn_global_load_lds((const unsigned*)(_gb + _o0), (unsigned*)((char*)(P_) + tid * 16), 16, 0, 0); \
    __builtin_amdgcn_global_load_lds((const unsigned*)(_gb + _o1), (unsigned*)((char*)(P_) + tid * 16 + 8192), 16, 0, 0); } while (0)
#define STAGE_B(P_, bc, kt) do { const char* _gb = (const char*)(Bt + (size_t)(bc) * K + (size_t)((kt) + kofs) * BK); \
    unsigned _o0 = offB0, _o1 = offB1; asm volatile("" : "+v"(_o0), "+v"(_o1)); \
    __builtin_amdgcn_global_load_lds((const unsigned*)(_gb + _o0), (unsigned*)((char*)(P_) + tid * 16), 16, 0, 0); \
    __builtin_amdgcn_global_load_lds((const unsigned*)(_gb + _o1), (unsigned*)((char*)(P_) + tid * 16 + 8192), 16, 0, 0); } while (0)
#define LDA(dst, b, h) for (int m = 0; m < 4; ++m) for (int k = 0; k < 2; ++k) \
    dst[m][k] = *reinterpret_cast<const bf16x8*>((char*)SA(b, h) + lds_byte(wr * 64 + m * 16 + fr, k * 32 + fq * 8))
#define LDB(dst, b, h) for (int n = 0; n < 2; ++n) for (int k = 0; k < 2; ++k) \
    dst[n][k] = *reinterpret_cast<const bf16x8*>((char*)SB(b, h) + lds_byte(wc * 32 + n * 16 + fr, k * 32 + fq * 8))
#define MMA(ai, bj, At_, Bt_) do { __builtin_amdgcn_s_setprio(1); \
    for (int m = 0; m < 4; ++m) for (int n = 0; n < 2; ++n) for (int k = 0; k < 2; ++k) \
      acc[ai][bj][m][n] = __builtin_amdgcn_mfma_f32_16x16x32_bf16(Bt_[n][k], At_[m][k], acc[ai][bj][m][n], 0, 0, 0); \
    __builtin_amdgcn_s_setprio(0); } while (0)
#define WAIT_V(n) asm volatile("s_waitcnt vmcnt(" #n ")" ::: "memory")
#define WAIT_L(n) asm volatile("s_waitcnt lgkmcnt(" #n ")" ::: "memory")
#define BAR __builtin_amdgcn_s_barrier()
#define SCHED __builtin_amdgcn_sched_barrier(0)
    const int lda = g.lda, K = g.K; const bf16_t* Bt = g.Bt;
    const int nMall = g.M / BM, nN = g.N / BM, nM = g.splitk ? 64 : nMall, nwg = nM * nN, nunits = nwg + (nMall - nM) * nN * 4;
    const int tid = opaque_tid(wv);
    const int wid = tid >> 6, lane = tid & 63, wr = wid >> 2, wc = wid & 3, fr = lane & 15, fq = lane >> 4;
    const int ntK = K / BK;
    unsigned offA0, offA1, offB0, offB1;
    { int r0, c0, r1, c1; stage_rc(tid * 16, r0, c0); stage_rc(tid * 16 + 8192, r1, c1);
      offA0 = (unsigned)(r0 * lda + c0) * 2u; offA1 = (unsigned)(r1 * lda + c1) * 2u;
      const int p0 = (r0 & ~31) + 8 * ((r0 & 15) >> 2) + 4 * ((r0 >> 4) & 1) + (r0 & 3), p1 = (r1 & ~31) + 8 * ((r1 & 15) >> 2) + 4 * ((r1 >> 4) & 1) + (r1 & 3);
      offB0 = (unsigned)(p0 * K + c0) * 2u; offB1 = (unsigned)(p1 * K + c1) * 2u; }
    for (int Lt = blockIdx.x; Lt < nunits; Lt += gridDim.x) {
        int pm, pn, kofs = 0, nt = ntK, split = 0;
        if (Lt < nwg) {
            int wgid = Lt;
            { int q = nwg / NXCD, r = nwg % NXCD, xcd = wgid % NXCD, off = wgid / NXCD; wgid = (xcd < r ? xcd * (q + 1) : r * (q + 1) + (xcd - r) * q) + off; }
            const int nig = WGM * nN, gid = wgid / nig, fm = gid * WGM, gsz = min(nM - fm, WGM);
            pm = fm + ((wgid % nig) % gsz); pn = (wgid % nig) / gsz;
        } else {
            const int u = Lt - nwg, tl = u >> 2; split = u & 3; pm = nM + tl / nN; pn = tl % nN;
            const int q4 = ntK >> 2;
            if (q4 & 1) { nt = split < 2 ? q4 + 1 : q4 - 1; kofs = split < 2 ? split * (q4 + 1) : 2 * (q4 + 1) + (split - 2) * (q4 - 1); } else { nt = q4; kofs = split * q4; }
        }
        const int brow = pm * BM, bcol = pn * BM;
        const bf16_t* A = (pn >= g.a2_from_pn) ? g.A2 : g.A;
        f32x4 acc[2][2][4][2] = {};
        bf16x8 At[4][2], B0[2][2], B1[2][2];
        STAGE_B(SB(0, 0), bcol, 0); STAGE_A(SA(0, 0), brow, 0);
        STAGE_B(SB(0, 1), bcol + HALF, 0); STAGE_A(SA(0, 1), brow + HALF, 0);
        if (wr == 1) BAR;
        WAIT_V(4); BAR;
        STAGE_B(SB(1, 0), bcol, 1); STAGE_A(SA(1, 0), brow, 1); STAGE_B(SB(1, 1), bcol + HALF, 1);
        WAIT_V(6); BAR;
        for (int t = 0; t < nt - 2; t += 2) {
            LDB(B0, 0, 0); SCHED; LDA(At, 0, 0); STAGE_A(SA(1, 1), brow + HALF, t + 1);
            WAIT_L(8); BAR; WAIT_L(0); MMA(0, 0, At, B0); BAR; SCHED;
            LDB(B1, 0, 1); STAGE_B(SB(0, 0), bcol, t + 2);
            BAR; WAIT_L(0); MMA(0, 1, At, B1); BAR;
            LDA(At, 0, 1); STAGE_A(SA(0, 0), brow, t + 2);
            BAR; WAIT_L(0); MMA(1, 0, At, B0); BAR; SCHED;
            STAGE_B(SB(0, 1), bcol + HALF, t + 2);
            WAIT_V(6); BAR; MMA(1, 1, At, B1); BAR;
            LDB(B0, 1, 0); SCHED; LDA(At, 1, 0); STAGE_A(SA(0, 1), brow + HALF, t + 2);
            WAIT_L(8); BAR; WAIT_L(0); MMA(0, 0, At, B0); BAR; SCHED;
            LDB(B1, 1, 1); STAGE_B(SB(1, 0), bcol, t + 3);
            BAR; WAIT_L(0); MMA(0, 1, At, B1); BAR;
            LDA(At, 1, 1); STAGE_A(SA(1, 0), brow, t + 3);
            BAR; WAIT_L(0); MMA(1, 0, At, B0); BAR; SCHED;
            STAGE_B(SB(1, 1), bcol + HALF, t + 3);
            WAIT_V(6); BAR; MMA(1, 1, At, B1); BAR;
        }
        { LDB(B0, 0, 0); LDA(At, 0, 0); STAGE_A(SA(1, 1), brow + HALF, nt - 1);
          BAR; WAIT_L(0); MMA(0, 0, At, B0); BAR;
          LDB(B1, 0, 1); BAR; WAIT_L(0); MMA(0, 1, At, B1); BAR;
          LDA(At, 0, 1); WAIT_V(4); BAR; WAIT_L(0); MMA(1, 0, At, B0); MMA(1, 1, At, B1); BAR; }
        { LDB(B0, 1, 0); LDA(At, 1, 0); WAIT_V(2); BAR; WAIT_L(0); MMA(0, 0, At, B0); BAR;
          LDB(B1, 1, 1); WAIT_V(0); BAR; WAIT_L(0); MMA(0, 1, At, B1); BAR;
          LDA(At, 1, 1); BAR; WAIT_L(0); MMA(1, 0, At, B0); MMA(1, 1, At, B1); BAR; }
        if (wr == 0) BAR;
        int erow = brow + wr * 64 + fr, ecol = bcol + wc * 32 + fq * 8;
        asm volatile("" : "+v"(erow), "+v"(ecol));
#pragma unroll
        for (int ai = 0; ai < 2; ++ai)
#pragma unroll
            for (int m = 0; m < 4; ++m) {
                const int row = erow + ai * HALF + m * 16;
#pragma unroll
                for (int bj = 0; bj < 2; ++bj) epi(row, ecol + bj * HALF, acc[ai][bj][m][0], acc[ai][bj][m][1], split);
                if (m & 1) SCHED;
            }
    }
#undef SA
#undef SB
}

struct EpiP {
    bf16_t* P; bf16_t* GH; float* out; int l;
    __device__ __forceinline__ void operator()(int row, int col, f32x4 v, f32x4 w, int split) const {
        const u32x4 o = (u32x4){pk2(v[0], v[1]), pk2(v[2], v[3]), pk2(w[0], w[1]), pk2(w[2], w[3])};
        *(u32x4*)(P + (size_t)row * NP + col) = o;
        if (col >= cBQ && col < cZ) {
            const int c = col - cBQ;
            if ((row & 31) >= 29) *(u32x4*)(GH + ((size_t)(row >> 5) * 3 + ((row & 31) - 29)) * 1536 + c) = o;
            if (row < SROW0) { const int b = row / LPAD, t = row - b * LPAD; if (t >= LP - 3 && t < LP) { float* d = out + o_pgc + ((size_t)(l * NB + b) * 3 + (t - (LP - 3))) * 1536 + c; *(f32x4*)d = v; *(f32x4*)(d + 4) = w; } }
            else { const int s = (row - SROW0) >> 2, t = row & 3; if (t >= 1) { float* d = out + o_sgc + ((size_t)(l * NS + s) * 3 + (t - 1)) * 1536 + c; *(f32x4*)d = v; *(f32x4*)(d + 4) = w; } }
        }
    }
};
struct EpiMerge {
    bf16_t* P;
    __device__ __forceinline__ void operator()(int row, int col, f32x4 v, f32x4 w, int split) const {
        u32x4* ptr = (u32x4*)(P + (size_t)row * NP + cMG + col); const u32x4 gm = *ptr;
        v[0] *= sigmoidf_(bflo(gm.x)); v[1] *= sigmoidf_(bfhi(gm.x)); v[2] *= sigmoidf_(bflo(gm.y)); v[3] *= sigmoidf_(bfhi(gm.y));
        w[0] *= sigmoidf_(bflo(gm.z)); w[1] *= sigmoidf_(bfhi(gm.z)); w[2] *= sigmoidf_(bflo(gm.w)); w[3] *= sigmoidf_(bfhi(gm.w));
        *ptr = (u32x4){pk2(v[0], v[1]), pk2(v[2], v[3]), pk2(w[0], w[1]), pk2(w[2], w[3])};
    }
};
struct EpiRes {
    const bf16_t* X; bf16_t* O; int ldo; int ocol0; bf16_t* SCR;
    __device__ __forceinline__ void operator()(int row, int col, f32x4 v, f32x4 w, int split) const {
        if (split == 0) {
            const u32x4 x = *(const u32x4*)(X + (size_t)row * D + col);
            v[0] += ALPHA * bflo(x.x); v[1] += ALPHA * bfhi(x.x); v[2] += ALPHA * bflo(x.y); v[3] += ALPHA * bfhi(x.y);
            w[0] += ALPHA * bflo(x.z); w[1] += ALPHA * bfhi(x.z); w[2] += ALPHA * bflo(x.w); w[3] += ALPHA * bfhi(x.w);
            *(u32x4*)(O + (size_t)row * ldo + ocol0 + col) = (u32x4){pk2(v[0], v[1]), pk2(v[2], v[3]), pk2(w[0], w[1]), pk2(w[2], w[3])};
        } else *(u32x4*)(SCR + ((size_t)(split - 1) * (MROWS - SPLIT_ROW0) + (row - SPLIT_ROW0)) * D + col) = (u32x4){pk2(v[0], v[1]), pk2(v[2], v[3]), pk2(w[0], w[1]), pk2(w[2], w[3])};
    }
};
struct EpiUp {
    bf16_t* U; bf16_t* HB; float* out; int l;
    __device__ __forceinline__ void operator()(int row, int col, f32x4 v, f32x4 w, int split) const {
        const u32x4 o = (u32x4){pk2(v[0], v[1]), pk2(v[2], v[3]), pk2(w[0], w[1]), pk2(w[2], w[3])};
        *(u32x4*)(U + (size_t)row * NU + col) = o;
        if ((row & 31) >= 30) *(u32x4*)(HB + ((size_t)(row >> 5) * 2 + (row & 1)) * NU + col) = o;
        if (row < SROW0) { const int b = row / LPAD, t = row - b * LPAD; if (t >= LP - 2 && t < LP) { float* d = out + o_pfc + ((size_t)(l * NB + b) * 2 + (t - (LP - 2))) * NU + col; *(f32x4*)d = v; *(f32x4*)(d + 4) = w; } }
        else { const int s = (row - SROW0) >> 2, t = row & 3; if (t >= 2) { float* d = out + o_sfc + ((size_t)(l * NS + s) * 2 + (t - 2)) * NU + col; *(f32x4*)d = v; *(f32x4*)(d + 4) = w; } }
    }
};

constexpr int SBUF = 32 * 128 * 2 + 32 * 32 + 32 * 16;
__device__ __forceinline__ float* QB(float* lds, int b) { return lds + b * SBUF; }
__device__ __forceinline__ float* KB(float* lds, int b) { return lds + b * SBUF + 4096; }
__device__ __forceinline__ float* VB(float* lds, int b) { return lds + b * SBUF + 8192; }
__device__ __forceinline__ float* SCB(float* lds, int b) { return lds + b * SBUF + 9216; }
__device__ __forceinline__ float* OB(float* lds, int b) { return lds + 2 * SBUF + b * 1024; }

__device__ __forceinline__ void store_out_blk(bf16_t* P, int row0, int jb, int L, int pcol, const float* ob, int ptid) {
    const int tt = ptid >> 3, g = ptid & 7, t0 = jb * 32;
    if (t0 + tt < L) { const f32x4 v = *(const f32x4*)(ob + tt * 32 + g * 4);
        *(u32x2*)(P + (size_t)(row0 + t0 + tt) * NP + pcol + g * 4) = (u32x2){pk2(v[0], v[1]), pk2(v[2], v[3])}; }
}
__device__ __forceinline__ f32x2 lo2(f32x4 v) { return __builtin_shufflevector(v, v, 0, 1); }
__device__ __forceinline__ f32x2 hi2(f32x4 v) { return __builtin_shufflevector(v, v, 2, 3); }
__device__ __forceinline__ f32x2 bc2(float x) { return (f32x2){x, x}; }
__device__ __forceinline__ float dot16(const f32x4* a, const float* kp) {
    float s = 0.f;
#pragma unroll
    for (int i = 0; i < 4; ++i) { const f32x4 b = *(const f32x4*)(kp + 4 * i); s += (a[i][0] * b[0] + a[i][1] * b[1]) + (a[i][2] * b[2] + a[i][3] * b[3]); }
    return s;
}

struct StageRegs { f32x4 &q0, &q1, &k0, &k1, &v, &r0, &x0, &x1; };
__device__ __forceinline__ f32x4 asf(u32x4 u) { return __builtin_bit_cast(f32x4, u); }
__device__ __forceinline__ u32x4 asu(f32x4 f) { return __builtin_bit_cast(u32x4, f); }
#define BARRIER_LDS() asm volatile("s_waitcnt lgkmcnt(0)\n\ts_barrier" ::: "memory")
__device__ __forceinline__ void issue_mlstm(const Params& p, int h, int qtr, int row0, int L, int jb, int ptid, StageRegs& r) {
    const bf16_t* P = (const bf16_t*)(p.ws + OFF_P); const float* G = (const float*)(p.ws + OFF_G);
    const int tt = ptid >> 3, g = ptid & 7, t0 = jb * 32;
    if (t0 + tt >= L) return;
    const int row = row0 + t0 + tt;
    const bf16_t* prow = P + (size_t)row * NP;
    r.q0 = asf(*(const u32x4*)(prow + cQ + h * 128 + g * 16)); r.q1 = asf(*(const u32x4*)(prow + cQ + h * 128 + g * 16 + 8));
    r.k0 = asf(*(const u32x4*)(prow + cK + h * 128 + g * 16)); r.k1 = asf(*(const u32x4*)(prow + cK + h * 128 + g * 16 + 8));
    { const u32x2 vv_ = *(const u32x2*)(prow + cV + h * 128 + qtr * 32 + g * 4); r.v = asf((u32x4){vv_.x, vv_.y, 0u, 0u}); }
    if (g == 0) { const float* gr = G + (size_t)row * 16; r.r0 = (f32x4){gr[h], gr[4 + h], 0.f, 0.f}; }
}
__device__ __forceinline__ void commit_mlstm(const Params& p, int l, int h, int L, int jb, float* lds, int ptid, const StageRegs& r, int bsel = -1) {
    const int tt = ptid >> 3, g = ptid & 7, t0 = jb * 32, b = bsel >= 0 ? bsel : (jb & 1);
    if (t0 + tt >= L) return;
    float x[16]; f32x4 qs[4];
    unpack8(asu(r.q0), x); unpack8(asu(r.q1), x + 8);
    float* qd = QB(lds, b) + tt * 128 + g * 16;
#pragma unroll
    for (int i = 0; i < 4; ++i) { qs[i] = (f32x4){x[4 * i], x[4 * i + 1], x[4 * i + 2], x[4 * i + 3]} * 0.08838834764831845f; *(f32x4*)(qd + 4 * i) = qs[i]; }
    unpack8(asu(r.k0), x); unpack8(asu(r.k1), x + 8);
    float* kd = KB(lds, b) + tt * 128 + g * 16;
#pragma unroll
    for (int i = 0; i < 4; ++i) *(f32x4*)(kd + 4 * i) = (f32x4){x[4 * i], x[4 * i + 1], x[4 * i + 2], x[4 * i + 3]};
    *(f32x4*)(VB(lds, b) + tt * 32 + g * 4) = (f32x4){bflo(asu(r.v).x), bfhi(asu(r.v).x), bflo(asu(r.v).y), bfhi(asu(r.v).y)};
    const float* kmb = KB(lds, b) + (tt & ~3) * 128 + g * 16;
    f32x4 qk;
#pragma unroll
    for (int j = 0; j < 4; ++j) qk[j] = red8(dot16(qs, kmb + j * 128));
    if (g == 0) {
        const float ig = r.r0[0] + p.gate_bias[l * 8 + h], f = r.r0[1] + p.gate_bias[l * 8 + 4 + h];
        const float lf = fminf(f, 0.f) - log1pf(__expf(-fabsf(f)));
        float* sc = SCB(lds, b) + tt * 16; *(f32x2*)sc = (f32x2){ig, lf}; *(f32x4*)(sc + 4) = qk; }
}

__device__ __forceinline__ void scan_mlstm(const Params& p, int l, bool samp, int bs, int h, int qtr, int row0, int L, float* lds) {
    const int tid = opaque_tid(p.wv); const bool cons = tid < 256; const int ptid = tid - 256;
    const int lane = tid & 63, w = (tid >> 6) & 3, s = lane & 7, cl = w * 8 + (lane >> 3), col = qtr * 32 + cl;
    const int e2 = 2 * (lane >> 3), nd = (e2 >> 2) * 32 + s * 4 + (e2 & 3);
    bf16_t* P = (bf16_t*)(p.ws + OFF_P);
    f32x2 C[8]; float n0v = 0.f, n1v = 0.f, m = 0.f;
#pragma unroll
    for (int e = 0; e < 8; ++e) C[e] = bc2(0.f);
    if (cons && samp) {
        const size_t sh = (size_t)(l * NS + bs) * 4 + h;
        const float* C0 = p.st_C + sh * 16384;
#pragma unroll
        for (int e = 0; e < 16; ++e) { const int d = (e >> 2) * 32 + s * 4 + (e & 3); C[e >> 1][e & 1] = C0[d * 128 + col]; }
        n0v = p.st_n[sh * 128 + nd]; n1v = p.st_n[sh * 128 + nd + 1]; m = p.st_m[sh];
    }
    const int nblk = (L + 31) >> 5;
    f32x4 k4[4][4];
    StageRegs sr{k4[0][0], k4[0][1], k4[0][2], k4[0][3], k4[1][0], k4[1][1], k4[1][2], k4[1][3]};
    if (!cons) { issue_mlstm(p, h, qtr, row0, L, 0, ptid, sr); commit_mlstm(p, l, h, L, 0, lds, ptid, sr); if (1 < nblk) issue_mlstm(p, h, qtr, row0, L, 1, ptid, sr); }
    BARRIER_LDS();
    for (int jb = 0; jb < nblk; ++jb) {
        if (!cons) {
            if (jb + 1 < nblk) commit_mlstm(p, l, h, L, jb + 1, lds, ptid, sr);
            if (jb + 2 < nblk) issue_mlstm(p, h, qtr, row0, L, jb + 2, ptid, sr);
            if (jb > 0) store_out_blk(P, row0, jb - 1, L, cV + h * 128 + qtr * 32, OB(lds, (jb - 1) & 1), ptid);
        } else {
            const float* qb = QB(lds, jb & 1); const float* kb = KB(lds, jb & 1); const float* vb = VB(lds, jb & 1); const float* sc = SCB(lds, jb & 1);
            float* ob = OB(lds, jb & 1);
            const int nt = min(32, L - jb * 32);
            f32x4 q4[4][4]; f32x2 kn[4], qn[4]; float vv[4], ig[4], lf[4]; f32x4 qk[4];
#define MLOAD_Q(T0) do { _Pragma("unroll") for (int i = 0; i < 4; ++i) { const int t = (T0) + i; \
        _Pragma("unroll") for (int j = 0; j < 4; ++j) q4[i][j] = *(const f32x4*)(qb + t * 128 + j * 32 + s * 4); \
        qn[i] = *(const f32x2*)(qb + t * 128 + nd); } } while (0)
#define MLOAD_K(T0) do { _Pragma("unroll") for (int i = 0; i < 4; ++i) { const int t = (T0) + i; \
        const f32x2 gg = *(const f32x2*)(sc + t * 16); ig[i] = gg[0]; lf[i] = gg[1]; \
        qk[i] = *(const f32x4*)(sc + t * 16 + 4); vv[i] = vb[t * 32 + cl]; } \
      _Pragma("unroll") for (int i = 0; i < 4; ++i) { const int t = (T0) + i; \
        _Pragma("unroll") for (int j = 0; j < 4; ++j) k4[i][j] = *(const f32x4*)(kb + t * 128 + j * 32 + s * 4); \
        kn[i] = *(const f32x2*)(kb + t * 128 + nd); } } while (0)
            MLOAD_Q(0); MLOAD_K(0);
#pragma unroll 1
            for (int t0 = 0; t0 < nt; t0 += 4) {
                float d[4], dn[4];
                const int tn = min(t0 + 4, 28);
                __builtin_amdgcn_sched_barrier(0);
#pragma unroll
                for (int i = 0; i < 4; ++i) {
                    f32x2 a = bc2(0.f), a2 = bc2(0.f);
#pragma unroll
                    for (int j = 0; j < 4; ++j) { a = lo2(q4[i][j]) * C[2 * j] + a; a2 = hi2(q4[i][j]) * C[2 * j + 1] + a2; }
                    a = a + a2;
                    d[i] = a[0] + a[1]; dn[i] = qn[i][0] * n0v + qn[i][1] * n1v;
                }
                __builtin_amdgcn_sched_barrier(0);
                MLOAD_Q(tn);
                __builtin_amdgcn_sched_barrier(0);
#pragma unroll
                for (int i = 0; i < 4; ++i) { d[i] = red8(d[i]); dn[i] = red64(dn[i]); }
                float fp[4], ip[4], em[4];
#pragma unroll
                for (int i = 0; i < 4; ++i) { const float mn = fmaxf(lf[i] + m, ig[i]); fp[i] = __expf(lf[i] + m - mn); ip[i] = __expf(ig[i] - mn); em[i] = __expf(-mn); m = mn; }
                const float F0 = fp[0], F1 = F0 * fp[1], F2 = F1 * fp[2], F3 = F2 * fp[3];
                const float g00 = ip[0], g10 = g00 * fp[1], g11 = ip[1], g20 = g10 * fp[2], g21 = g11 * fp[2], g22 = ip[2];
                const float g30 = g20 * fp[3], g31 = g21 * fp[3], g32 = g22 * fp[3], g33 = ip[3];
                const float s00 = g00 * qk[0][0];
                const float s10 = g10 * qk[1][0], s11 = g11 * qk[1][1];
                const float s20 = g20 * qk[2][0], s21 = g21 * qk[2][1], s22 = g22 * qk[2][2];
                const float s30 = g30 * qk[3][0], s31 = g31 * qk[3][1], s32 = g32 * qk[3][2], s33 = g33 * qk[3][3];
                const float num0 = F0 * d[0] + s00 * vv[0], den0 = F0 * dn[0] + s00;
                const float num1 = F1 * d[1] + s10 * vv[0] + s11 * vv[1], den1 = F1 * dn[1] + s10 + s11;
                const float num2 = F2 * d[2] + s20 * vv[0] + s21 * vv[1] + s22 * vv[2], den2 = F2 * dn[2] + s20 + s21 + s22;
                const float num3 = F3 * d[3] + s30 * vv[0] + s31 * vv[1] + s32 * vv[2] + s33 * vv[3], den3 = F3 * dn[3] + s30 + s31 + s32 + s33;
                if (s == 0) {
                    ob[(t0 + 0) * 32 + cl] = num0 / fmaxf(fabsf(den0), em[0]); ob[(t0 + 1) * 32 + cl] = num1 / fmaxf(fabsf(den1), em[1]);
                    ob[(t0 + 2) * 32 + cl] = num2 / fmaxf(fabsf(den2), em[2]); ob[(t0 + 3) * 32 + cl] = num3 / fmaxf(fabsf(den3), em[3]);
                }
                const float c0 = g30 * vv[0], c1 = g31 * vv[1], c2 = g32 * vv[2], c3 = g33 * vv[3];
#pragma unroll
                for (int j = 0; j < 4; ++j) {
                    C[2 * j] = lo2(k4[3][j]) * bc2(c3) + (lo2(k4[2][j]) * bc2(c2) + (lo2(k4[1][j]) * bc2(c1) + (lo2(k4[0][j]) * bc2(c0) + C[2 * j] * bc2(F3))));
                    C[2 * j + 1] = hi2(k4[3][j]) * bc2(c3) + (hi2(k4[2][j]) * bc2(c2) + (hi2(k4[1][j]) * bc2(c1) + (hi2(k4[0][j]) * bc2(c0) + C[2 * j + 1] * bc2(F3)))); }
                n0v = n0v * F3 + (kn[0][0] * g30 + kn[1][0] * g31) + (kn[2][0] * g32 + kn[3][0] * g33);
                n1v = n1v * F3 + (kn[0][1] * g30 + kn[1][1] * g31) + (kn[2][1] * g32 + kn[3][1] * g33);
                __builtin_amdgcn_sched_barrier(0);
                MLOAD_K(tn);
            }
#undef MLOAD_Q
#undef MLOAD_K
        }
        BARRIER_LDS();
    }
    if (!cons) store_out_blk(P, row0, nblk - 1, L, cV + h * 128 + qtr * 32, OB(lds, (nblk - 1) & 1), ptid);
    else {
        const size_t sh = samp ? (size_t)(l * NS + bs) * 4 + h : (size_t)(l * NB + bs) * 4 + h;
        float* Co = p.out + (samp ? o_sC : o_pC) + sh * 16384;
#pragma unroll
        for (int e = 0; e < 16; ++e) { const int d = (e >> 2) * 32 + s * 4 + (e & 3); Co[d * 128 + col] = C[e >> 1][e & 1]; }
        if (qtr == 0 && w == 0) { float* no = p.out + (samp ? o_sn : o_pn) + sh * 128; no[nd] = n0v; no[nd + 1] = n1v;
            if (lane == 0) p.out[(samp ? o_sm : o_pm) + sh] = m; }
    }
    BARRIER_LDS();
}


constexpr int ST_LD = 33;
__device__ __forceinline__ float* STB(float* lds, int b) { return lds + 2 * SBUF + 2048 + b * (128 * ST_LD); }
__device__ __forceinline__ void st_issue(const float* S0, int qtr, int ptid, f32x4& a0, f32x4& a1, f32x4& a2, f32x4& a3) {
    const int d = ptid >> 3, c = (ptid & 7) * 4; const float* b = S0 + d * 128 + qtr * 32 + c;
    a0 = *(const f32x4*)b; a1 = *(const f32x4*)(b + 32 * 128); a2 = *(const f32x4*)(b + 64 * 128); a3 = *(const f32x4*)(b + 96 * 128);
}
__device__ __forceinline__ void st_commit(float* st, int ptid, const f32x4& a0, const f32x4& a1, const f32x4& a2, const f32x4& a3) {
    const int d = ptid >> 3, c = (ptid & 7) * 4; float* b = st + d * ST_LD + c;
#pragma unroll
    for (int i = 0; i < 4; ++i) { b[i] = a0[i]; b[32 * ST_LD + i] = a1[i]; b[64 * ST_LD + i] = a2[i]; b[96 * ST_LD + i] = a3[i]; }
}
__device__ __forceinline__ void st_store(float* So, int qtr, const float* st, int ptid) {
    const int d = ptid >> 3, c = (ptid & 7) * 4; const float* b = st + d * ST_LD + c; float* o = So + d * 128 + qtr * 32 + c;
#pragma unroll
    for (int q = 0; q < 4; ++q) *(f32x4*)(o + q * 32 * 128) = (f32x4){b[q * 32 * ST_LD], b[q * 32 * ST_LD + 1], b[q * 32 * ST_LD + 2], b[q * 32 * ST_LD + 3]};
}
__device__ __forceinline__ void scan_mlstm_stream(const Params& p, int l, int h, int qtr, int bs0, int nseq, float* lds) {
    const int tid = opaque_tid(p.wv); const bool cons = tid < 256; const int ptid = tid - 256;
    const int lane = tid & 63, w = (tid >> 6) & 3, s = lane & 7, cl = w * 8 + (lane >> 3), col = qtr * 32 + cl;
    const int e2 = 2 * (lane >> 3), nd = (e2 >> 2) * 32 + s * 4 + (e2 & 3);
    bf16_t* P = (bf16_t*)(p.ws + OFF_P);
    f32x2 C[8]; float n0v = 0.f, n1v = 0.f, m = 0.f, n0n = 0.f, n1n = 0.f, mnx = 0.f;
#pragma unroll
    for (int e = 0; e < 8; ++e) C[e] = bc2(0.f);
    f32x4 k4[4][4];
    StageRegs sr{k4[0][0], k4[0][1], k4[0][2], k4[0][3], k4[1][0], k4[1][1], k4[1][2], k4[1][3]};
#define LOADSTATE(BS) do { const size_t sh_ = (size_t)(l * NS + (BS)) * 4 + h; n0n = p.st_n[sh_ * 128 + nd]; n1n = p.st_n[sh_ * 128 + nd + 1]; mnx = p.st_m[sh_]; } while (0)
#define STISSUE(BS) st_issue(p.st_C + ((size_t)(l * NS + (BS)) * 4 + h) * 16384, qtr, ptid, k4[2][0], k4[2][1], k4[2][2], k4[2][3])
    if (!cons) { issue_mlstm(p, h, qtr, SROW0 + bs0 * 4, LS, 0, ptid, sr); STISSUE(bs0); } else LOADSTATE(bs0);
#pragma unroll 1
    for (int k = 0; k < nseq; ++k) {
        const int bs = bs0 + 8 * k, row0 = SROW0 + bs * 4;
        if (!cons) { commit_mlstm(p, l, h, LS, 0, lds, ptid, sr, k & 1); st_commit(STB(lds, k & 1), ptid, k4[2][0], k4[2][1], k4[2][2], k4[2][3]);
            if (k + 1 < nseq) { issue_mlstm(p, h, qtr, row0 + 32, LS, 0, ptid, sr); STISSUE(bs + 8); } }
        else {
            n0v = n0n; n1v = n1n; m = mnx;
            if (k + 1 < nseq) LOADSTATE(bs + 8);
        }
        BARRIER_LDS();
        if (!cons) { if (k > 0) { store_out_blk(P, row0 - 32, 0, LS, cV + h * 128 + qtr * 32, OB(lds, (k - 1) & 1), ptid); st_store(p.out + o_sC + ((size_t)(l * NS + bs - 8) * 4 + h) * 16384, qtr, STB(lds, (k - 1) & 1), ptid); } }
        else {
            const float* qb = QB(lds, k & 1); const float* kb = KB(lds, k & 1); const float* vb = VB(lds, k & 1); const float* sc = SCB(lds, k & 1);
            float* ob = OB(lds, k & 1); float* stb = STB(lds, k & 1);
#pragma unroll
            for (int e = 0; e < 16; ++e) { const int d = (e >> 2) * 32 + s * 4 + (e & 3); C[e >> 1][e & 1] = stb[d * ST_LD + cl]; }
            f32x4 q4[4][4]; f32x2 kn[4], qn[4]; float vv[4], ig[4], lf[4]; f32x4 qk[4];
#define MLOAD_Q(T0) do { _Pragma("unroll") for (int i = 0; i < 4; ++i) { const int t = (T0) + i; \
        _Pragma("unroll") for (int j = 0; j < 4; ++j) q4[i][j] = *(const f32x4*)(qb + t * 128 + j * 32 + s * 4); \
        qn[i] = *(const f32x2*)(qb + t * 128 + nd); } } while (0)
#define MLOAD_K(T0) do { _Pragma("unroll") for (int i = 0; i < 4; ++i) { const int t = (T0) + i; \
        const f32x2 gg = *(const f32x2*)(sc + t * 16); ig[i] = gg[0]; lf[i] = gg[1]; \
        qk[i] = *(const f32x4*)(sc + t * 16 + 4); vv[i] = vb[t * 32 + cl]; } \
      _Pragma("unroll") for (int i = 0; i < 4; ++i) { const int t = (T0) + i; \
        _Pragma("unroll") for (int j = 0; j < 4; ++j) k4[i][j] = *(const f32x4*)(kb + t * 128 + j * 32 + s * 4); \
        kn[i] = *(const f32x2*)(kb + t * 128 + nd); } } while (0)
            MLOAD_Q(0); MLOAD_K(0);
            {
                float d[4], dn[4];
                __builtin_amdgcn_sched_barrier(0);
#pragma unroll
                for (int i = 0; i < 4; ++i) {
                    f32x2 a = bc2(0.f), a2 = bc2(0.f);
#pragma unroll
                    for (int j = 0; j < 4; ++j) { a = lo2(q4[i][j]) * C[2 * j] + a; a2 = hi2(q4[i][j]) * C[2 * j + 1] + a2; }
                    a = a + a2;
                    d[i] = a[0] + a[1]; dn[i] = qn[i][0] * n0v + qn[i][1] * n1v;
                }
                __builtin_amdgcn_sched_barrier(0);
#pragma unroll
                for (int i = 0; i < 4; ++i) { d[i] = red8(d[i]); dn[i] = red64(dn[i]); }
                float fp[4], ip[4], em[4];
#pragma unroll
                for (int i = 0; i < 4; ++i) { const float mn = fmaxf(lf[i] + m, ig[i]); fp[i] = __expf(lf[i] + m - mn); ip[i] = __expf(ig[i] - mn); em[i] = __expf(-mn); m = mn; }
                const float F0 = fp[0], F1 = F0 * fp[1], F2 = F1 * fp[2], F3 = F2 * fp[3];
                const float g00 = ip[0], g10 = g00 * fp[1], g11 = ip[1], g20 = g10 * fp[2], g21 = g11 * fp[2], g22 = ip[2];
                const float g30 = g20 * fp[3], g31 = g21 * fp[3], g32 = g22 * fp[3], g33 = ip[3];
                const float s00 = g00 * qk[0][0];
                const float s10 = g10 * qk[1][0], s11 = g11 * qk[1][1];
                const float s20 = g20 * qk[2][0], s21 = g21 * qk[2][1], s22 = g22 * qk[2][2];
                const float s30 = g30 * qk[3][0], s31 = g31 * qk[3][1], s32 = g32 * qk[3][2], s33 = g33 * qk[3][3];
                const float num0 = F0 * d[0] + s00 * vv[0], den0 = F0 * dn[0] + s00;
                const float num1 = F1 * d[1] + s10 * vv[0] + s11 * vv[1], den1 = F1 * dn[1] + s10 + s11;
                const float num2 = F2 * d[2] + s20 * vv[0] + s21 * vv[1] + s22 * vv[2], den2 = F2 * dn[2] + s20 + s21 + s22;
                const float num3 = F3 * d[3] + s30 * vv[0] + s31 * vv[1] + s32 * vv[2] + s33 * vv[3], den3 = F3 * dn[3] + s30 + s31 + s32 + s33;
                if (s == 0) {
                    ob[0 * 32 + cl] = num0 / fmaxf(fabsf(den0), em[0]); ob[1 * 32 + cl] = num1 / fmaxf(fabsf(den1), em[1]);
                    ob[2 * 32 + cl] = num2 / fmaxf(fabsf(den2), em[2]); ob[3 * 32 + cl] = num3 / fmaxf(fabsf(den3), em[3]);
                }
                const float c0 = g30 * vv[0], c1 = g31 * vv[1], c2 = g32 * vv[2], c3 = g33 * vv[3];
#pragma unroll
                for (int j = 0; j < 4; ++j) {
                    C[2 * j] = lo2(k4[3][j]) * bc2(c3) + (lo2(k4[2][j]) * bc2(c2) + (lo2(k4[1][j]) * bc2(c1) + (lo2(k4[0][j]) * bc2(c0) + C[2 * j] * bc2(F3))));
                    C[2 * j + 1] = hi2(k4[3][j]) * bc2(c3) + (hi2(k4[2][j]) * bc2(c2) + (hi2(k4[1][j]) * bc2(c1) + (hi2(k4[0][j]) * bc2(c0) + C[2 * j + 1] * bc2(F3)))); }
                n0v = n0v * F3 + (kn[0][0] * g30 + kn[1][0] * g31) + (kn[2][0] * g32 + kn[3][0] * g33);
                n1v = n1v * F3 + (kn[0][1] * g30 + kn[1][1] * g31) + (kn[2][1] * g32 + kn[3][1] * g33);
            }
#undef MLOAD_Q
#undef MLOAD_K
            const size_t sh = (size_t)(l * NS + bs) * 4 + h;
#pragma unroll
            for (int e = 0; e < 16; ++e) { const int d = (e >> 2) * 32 + s * 4 + (e & 3); stb[d * ST_LD + cl] = C[e >> 1][e & 1]; }
            if (qtr == 0 && w == 0) { float* no = p.out + o_sn + sh * 128; no[nd] = n0v; no[nd + 1] = n1v; if (lane == 0) p.out[o_sm + sh] = m; }
        }
    }
    BARRIER_LDS();
    if (!cons) { store_out_blk(P, SROW0 + (bs0 + 8 * (nseq - 1)) * 4, 0, LS, cV + h * 128 + qtr * 32, OB(lds, (nseq - 1) & 1), ptid); st_store(p.out + o_sC + ((size_t)(l * NS + bs0 + 8 * (nseq - 1)) * 4 + h) * 16384, qtr, STB(lds, (nseq - 1) & 1), ptid); }
    BARRIER_LDS();
#undef LOADSTATE
#undef STISSUE
}


typedef float f32x16 __attribute__((ext_vector_type(16)));
#define MFMA32(a, b, c) __builtin_amdgcn_mfma_f32_32x32x16_bf16((a), (b), (c), 0, 0, 0)
__device__ __forceinline__ int crow(int reg, int hf) { return (reg & 3) + 8 * (reg >> 2) + 4 * hf; }
__device__ __forceinline__ bf16x8 pack_step(const f32x16& x, int s) {
    u32x4 pk;
    asm volatile("s_nop 7\n\ts_nop 3\n\tv_cvt_pk_bf16_f32 %0, %4, %5\n\tv_cvt_pk_bf16_f32 %1, %6, %7\n\tv_cvt_pk_bf16_f32 %2, %8, %9\n\tv_cvt_pk_bf16_f32 %3, %10, %11\n\ts_nop 1"
                 : "=&v"(pk[0]), "=&v"(pk[1]), "=&v"(pk[2]), "=&v"(pk[3])
                 : "v"(x[8 * s]), "v"(x[8 * s + 1]), "v"(x[8 * s + 2]), "v"(x[8 * s + 3]), "v"(x[8 * s + 4]), "v"(x[8 * s + 5]), "v"(x[8 * s + 6]), "v"(x[8 * s + 7]));
    return __builtin_bit_cast(bf16x8, pk);
}
__device__ __forceinline__ bf16x8 frag_n(const bf16_t* base, int ld, int r, int hf, int kb) { return *(const bf16x8*)(base + r * ld + kb * 16 + hf * 8); }
__device__ __forceinline__ bf16x8 frag_p(const bf16_t* base, int ld, int r, int hf, int k0) {
    const u32x2 a = *(const u32x2*)(base + r * ld + k0 + 4 * hf), b = *(const u32x2*)(base + r * ld + k0 + 8 + 4 * hf);
    return __builtin_bit_cast(bf16x8, (u32x4){a.x, a.y, b.x, b.y});
}
__device__ __forceinline__ int kto(int d) { return d * 40 + (d >> 4) * 8; }
__device__ __forceinline__ bf16_t f2bf(float x) { return (bf16_t)(pk2(x, 0.f) & 0xffffu); }

constexpr int CH_LDQ = 136, CH_LDS = 40;
constexpr int CH_QB = 0, CH_KB = 8704, CH_KWT = 17408, CH_VT = 27904, CH_SW = 33024, CH_SC = 35584, CH_QW = 36608, CH_SLOT = 45312, CH_OB = 2 * CH_SLOT;
constexpr int SC_U = 0, SC_B = 32, SC_PM = 64;

__device__ __forceinline__ void store_out_norm(bf16_t* P, int row0, int jb, int L, int pcol, const float* ob, const float* rd, int ptid) {
    const int tt = ptid >> 3, g = ptid & 7, t0 = jb * 32;
    if (t0 + tt < L) { const f32x4 v = *(const f32x4*)(ob + tt * 32 + g * 4) * rd[tt];
        *(u32x2*)(P + (size_t)(row0 + t0 + tt) * NP + pcol + g * 4) = (u32x2){pk2(v[0], v[1]), pk2(v[2], v[3])}; }
}
__device__ __forceinline__ void issue_mlstm_chunk(const Params& p, int h, int qtr, int row0, int L, int nch, int jb, int ptid, StageRegs& r) {
    if (jb >= nch) return;
    const bf16_t* P = (const bf16_t*)(p.ws + OFF_P); const float* REC = (const float*)(p.ws + OFF_REC);
    const int tt = ptid >> 3, g = ptid & 7, t0 = jb * 32;
    const int row = row0 + t0 + tt;
    if (g == 0) r.r0 = *(const f32x4*)(REC + ((size_t)row * 4 + h) * 16 + 4);
    if (t0 + tt >= L) return;
    const bf16_t* prow = P + (size_t)row * NP;
    r.q0 = asf(*(const u32x4*)(prow + cQ + h * 128 + g * 16)); r.q1 = asf(*(const u32x4*)(prow + cQ + h * 128 + g * 16 + 8));
    r.k0 = asf(*(const u32x4*)(prow + cK + h * 128 + g * 16)); r.k1 = asf(*(const u32x4*)(prow + cK + h * 128 + g * 16 + 8));
    { const u32x2 vv_ = *(const u32x2*)(prow + cV + h * 128 + qtr * 32 + g * 4); r.v = asf((u32x4){vv_.x, vv_.y, 0u, 0u}); }
}

__device__ __forceinline__ void scan_mlstm_chunk(const Params& p, int l, int bs, int h, int qtr, int row0, int L, unsigned char* lb) {
    const int tid = opaque_tid(p.wv); const int wave = tid >> 6, lane = tid & 63, r = lane & 31, hf = lane >> 5, ptid = tid - 256;
    bf16_t* P = (bf16_t*)(p.ws + OFF_P);
    const int nch = (L + 31) >> 5;
    f32x16 C[4];
    const int ct = wave == 3 ? 1 : 0;
#pragma unroll
    for (int dt = 0; dt < 4; ++dt)
#pragma unroll
        for (int i = 0; i < 16; ++i) C[dt][i] = 0.f;
    float m0 = 0.f;
    f32x4 s0, s1, s2, s3, s4, s5, s6, s7; StageRegs sr{s0, s1, s2, s3, s4, s5, s6, s7};
    if (wave >= 4) { for (int i = ptid; i < 2 * 32 * CH_LDS; i += 256) { const int sl = i / (32 * CH_LDS), e = i % (32 * CH_LDS);
            ((bf16_t*)(lb + sl * CH_SLOT + CH_VT))[32 * CH_LDS + e] = (e < CH_LDS) ? (bf16_t)0x3f80 : (bf16_t)0; } }
#define CH_P1(JN) do { const int jn_ = (JN); unsigned char* sl_ = lb + (jn_ & 1) * CH_SLOT; const int tt = ptid >> 3, g = ptid & 7; const bool val_ = jn_ * 32 + tt < L; \
        u32x4 q0_ = asu(sr.q0), q1_ = asu(sr.q1), k0_ = asu(sr.k0), k1_ = asu(sr.k1); u32x4 v_ = asu(sr.v); \
        if (!val_) { q0_ = q1_ = k0_ = k1_ = v_ = (u32x4){0u, 0u, 0u, 0u}; } \
        *(u32x4*)(sl_ + CH_QB + (tt * CH_LDQ + g * 16) * 2) = q0_; *(u32x4*)(sl_ + CH_QB + (tt * CH_LDQ + g * 16 + 8) * 2) = q1_; \
        *(u32x4*)(sl_ + CH_KB + (tt * CH_LDQ + g * 16) * 2) = k0_; *(u32x4*)(sl_ + CH_KB + (tt * CH_LDQ + g * 16 + 8) * 2) = k1_; \
        bf16_t* vt_ = (bf16_t*)(sl_ + CH_VT); \
        vt_[(g * 4 + 0) * CH_LDS + tt] = (bf16_t)(v_.x & 0xffffu); vt_[(g * 4 + 1) * CH_LDS + tt] = (bf16_t)(v_.x >> 16); \
        vt_[(g * 4 + 2) * CH_LDS + tt] = (bf16_t)(v_.y & 0xffffu); vt_[(g * 4 + 3) * CH_LDS + tt] = (bf16_t)(v_.y >> 16); \
        if (g == 0) { float* sc_ = (float*)(sl_ + CH_SC); sc_[SC_U + tt] = sr.r0[0]; sc_[SC_B + tt] = sr.r0[1]; sc_[SC_PM + tt] = sr.r0[2]; } \
        issue_mlstm_chunk(p, h, qtr, row0, L, nch, jn_ + 1, ptid, sr); } while (0)
#define CH_P2(JN) do { unsigned char* sl_ = lb + ((JN) & 1) * CH_SLOT; const float* sc_ = (const float*)(sl_ + CH_SC); \
        const float bT_ = sc_[SC_B + 31], mT_ = bT_ + fmaxf(m0, sc_[SC_PM + 31]); \
        if (wave == 1) { f32x16 a_; _Pragma("unroll") for (int i = 0; i < 16; ++i) a_[i] = 0.f; \
            _Pragma("unroll") for (int kb = 0; kb < 8; ++kb) a_ = MFMA32(frag_n((const bf16_t*)(sl_ + CH_QB), CH_LDQ, r, hf, kb), frag_n((const bf16_t*)(sl_ + CH_KB), CH_LDQ, r, hf, kb), a_); \
            bf16_t* sw_ = (bf16_t*)(sl_ + CH_SW); const float us_ = sc_[SC_U + r]; \
            _Pragma("unroll") for (int i4 = 0; i4 < 4; ++i4) { const f32x4 pm4 = *(const f32x4*)(sc_ + SC_PM + 8 * i4 + 4 * hf); \
                _Pragma("unroll") for (int ii = 0; ii < 4; ++ii) { const int t = 8 * i4 + 4 * hf + ii; const float w_ = (r <= t) ? __expf(us_ - fmaxf(m0, pm4[ii])) * 0.08838834764831845f : 0.f; \
                    sw_[t * CH_LDS + r] = f2bf(a_[4 * i4 + ii] * w_); } } } \
        else if (wave >= 4) { const int tt = ptid >> 3, g = ptid & 7; \
            const float wi_ = __expf(m0 - fmaxf(m0, sc_[SC_PM + tt])) * 0.08838834764831845f, ws_ = __expf(sc_[SC_U + tt] + bT_ - mT_); float x_[16]; \
            u32x4* qp_ = (u32x4*)(sl_ + CH_QB + (tt * CH_LDQ + g * 16) * 2); unpack8(qp_[0], x_); unpack8(qp_[1], x_ + 8); \
            _Pragma("unroll") for (int i = 0; i < 16; ++i) x_[i] *= wi_; \
            u32x4* qo_ = (u32x4*)(sl_ + CH_QW + (tt * CH_LDQ + g * 16) * 2); qo_[0] = pack8(x_); qo_[1] = pack8(x_ + 8); \
            const u32x4* kp_ = (const u32x4*)(sl_ + CH_KB + (tt * CH_LDQ + g * 16) * 2); unpack8(kp_[0], x_); unpack8(kp_[1], x_ + 8); \
            bf16_t* kw_ = (bf16_t*)(sl_ + CH_KWT); \
            _Pragma("unroll") for (int i = 0; i < 16; ++i) kw_[kto(g * 16) + i * CH_LDS + tt] = f2bf(x_[i] * ws_); } \
        if (wave == 1 || wave >= 4) m0 = mT_; } while (0)
    if (wave >= 4) { issue_mlstm_chunk(p, h, qtr, row0, L, nch, 0, ptid, sr); CH_P1(0); }
    BARRIER_LDS();
    CH_P2(0);
    BARRIER_LDS();
#pragma unroll 1
    for (int j = 0; j < nch; ++j) {
        if (wave == 0 || wave == 3) {
            const unsigned char* sl = lb + (j & 1) * CH_SLOT; const float* sc = (const float*)(sl + CH_SC);
            const bf16_t* qw = (const bf16_t*)(sl + CH_QW); const bf16_t* sw = (const bf16_t*)(sl + CH_SW); const bf16_t* vt = (const bf16_t*)(sl + CH_VT) + ct * 32 * CH_LDS; const bf16_t* kwt = (const bf16_t*)(sl + CH_KWT);
            const float bT = sc[SC_B + 31], mT = bT + fmaxf(m0, sc[SC_PM + 31]);
            f32x16 H;
#pragma unroll
            for (int i = 0; i < 16; ++i) H[i] = 0.f;
#pragma unroll
            for (int dt = 0; dt < 4; ++dt)
#pragma unroll
                for (int u = 0; u < 2; ++u) H = MFMA32(frag_p(qw, CH_LDQ, r, hf, 32 * dt + 16 * u), pack_step(C[dt], u), H);
            bf16x8 vb[2];
#pragma unroll
            for (int kb = 0; kb < 2; ++kb) { vb[kb] = frag_n(vt, CH_LDS, r, hf, kb); H = MFMA32(frag_n(sw, CH_LDS, r, hf, kb), vb[kb], H); }
            const float wold = __expf(bT - mT + m0);
#pragma unroll
            for (int dt = 0; dt < 4; ++dt) {
#pragma unroll
                for (int i = 0; i < 16; ++i) C[dt][i] *= wold;
#pragma unroll
                for (int kb = 0; kb < 2; ++kb) C[dt] = MFMA32(frag_n(kwt + kto(dt * 32 + r), 0, 0, hf, kb), vb[kb], C[dt]);
            }
            float* ob = (float*)(lb + CH_OB) + (j & 1) * 1024; float* rd = (float*)(lb + CH_OB + 8192) + (j & 1) * 32;
            if (ct == 0) {
#pragma unroll
                for (int i = 0; i < 16; ++i) ob[crow(i, hf) * 32 + r] = H[i];
            } else if (r == 0) {
#pragma unroll
                for (int i = 0; i < 16; ++i) { const int t = crow(i, hf); rd[t] = __builtin_amdgcn_rcpf(fmaxf(fabsf(H[i]), __expf(-(sc[SC_B + t] + fmaxf(m0, sc[SC_PM + t]))))); }
            }
            m0 = mT;
        } else if (wave >= 4) {
            if (j + 1 < nch) CH_P1(j + 1);
            if (j > 0) store_out_norm(P, row0, j - 1, L, cV + h * 128 + qtr * 32, (const float*)(lb + CH_OB) + ((j - 1) & 1) * 1024, (const float*)(lb + CH_OB + 8192) + ((j - 1) & 1) * 32, ptid);
        }
        BARRIER_LDS();
        if (j + 1 < nch) CH_P2(j + 1);
        BARRIER_LDS();
    }
    if (wave >= 4) store_out_norm(P, row0, nch - 1, L, cV + h * 128 + qtr * 32, (const float*)(lb + CH_OB) + ((nch - 1) & 1) * 1024, (const float*)(lb + CH_OB + 8192) + ((nch - 1) & 1) * 32, ptid);
    const size_t sh = (size_t)(l * NB + bs) * 4 + h;
    if (wave == 0) {
        float* Co = p.out + o_pC + sh * 16384;
#pragma unroll
        for (int dt = 0; dt < 4; ++dt)
#pragma unroll
            for (int i = 0; i < 16; ++i) Co[(32 * dt + crow(i, hf)) * 128 + qtr * 32 + r] = C[dt][i];
        if (lane == 0 && qtr == 0) p.out[o_pm + sh] = m0;
    } else if (wave == 3 && r == 0 && qtr == 0) {
#pragma unroll
        for (int dt = 0; dt < 4; ++dt)
#pragma unroll
            for (int i = 0; i < 16; ++i) p.out[o_pn + sh * 128 + 32 * dt + crow(i, hf)] = C[dt][i];
    }
    __syncthreads();
#undef CH_P1
#undef CH_P2
}

__device__ __forceinline__ void gdn_raw8(const bf16_t* P, int r0, int tr, int pcol, const bf16_t* gh, const float* st, int hch, float* x) {
    if (tr >= 0) unpack8(*(const u32x4*)(P + (size_t)(r0 + tr) * NP + pcol), x);
    else if (gh) unpack8(*(const u32x4*)(gh + (3 + tr) * 1536 + hch), x);
    else if (st) { const float* hp = st + (3 + tr) * 1536 + hch; const f32x4 a = *(const f32x4*)hp, b = *(const f32x4*)(hp + 4);
        x[0] = a[0]; x[1] = a[1]; x[2] = a[2]; x[3] = a[3]; x[4] = b[0]; x[5] = b[1]; x[6] = b[2]; x[7] = b[3]; }
    else {
#pragma unroll
        for (int i = 0; i < 8; ++i) x[i] = 0.f; }
}
__device__ __forceinline__ void gdn_conv8(const bf16_t* P, int r0, int tr, int pcol, const bf16_t* gh, const float* st, int hch, const float* cw, float* y) {
#pragma unroll
    for (int i = 0; i < 8; ++i) y[i] = 0.f;
#pragma unroll
    for (int j = 0; j < 4; ++j) { float x[8]; gdn_raw8(P, r0, tr - 3 + j, pcol, gh, st, hch, x);
        const f32x4 w0 = *(const f32x4*)(cw + j * 1536 + hch), w1 = *(const f32x4*)(cw + j * 1536 + hch + 4);
        y[0] += x[0] * w0[0]; y[1] += x[1] * w0[1]; y[2] += x[2] * w0[2]; y[3] += x[3] * w0[3];
        y[4] += x[4] * w1[0]; y[5] += x[5] * w1[1]; y[6] += x[6] * w1[2]; y[7] += x[7] * w1[3]; }
#pragma unroll
    for (int i = 0; i < 8; ++i) y[i] = y[i] * sigmoidf_(y[i]);
}

__device__ __forceinline__ void phase_prep(const Params& p, int l, float* lds) {
    const int tid = opaque_tid(p.wv); const int half = tid >> 8, t = tid & 255, tt = t >> 3, g = t & 7, wq = t >> 6, lane = t & 63, r = lane & 31, hf = lane >> 5;
    bf16_t* P = (bf16_t*)(p.ws + OFF_P); const bf16_t* GH = (const bf16_t*)(p.ws + OFF_GH);
    const float* G = (const float*)(p.ws + OFF_G); float* REC = (float*)(p.ws + OFF_REC); bf16_t* TB = (bf16_t*)(p.ws + OFF_TB);
    const float* cw = p.gconv_w + (size_t)l * 4 * 1536;
    float* ksc = lds + half * 4096;
    unsigned char* pl = (unsigned char*)lds + 32768 + half * 22016;
    bf16_t* kimg = (bf16_t*)pl; bf16_t* qimg = (bf16_t*)(pl + 8704); float* am = (float*)(pl + 17408); float* sgl = (float*)(pl + 21504); float* sbe = sgl + 32; float* sG = sgl + 64;
    constexpr int NITEM = (MROWS / 32) * 4;
    for (int base = blockIdx.x * 2; base < NITEM; base += gridDim.x * 2) {
        const int item = base + half; const bool act = item < NITEM;
        const int rb = item >> 2, h = item & 3, r0 = rb * 32;
        const bool samp = rb >= SROW0 / 32;
        int tr = tt; const bf16_t* gh = nullptr; const float* st = nullptr; int rbase = r0; bool valid = act;
        if (!samp) { const int jb = rb % (LPAD / 32); if (jb * 32 + tt >= LP) valid = false; if (jb > 0) gh = GH + (size_t)(rb - 1) * 3 * 1536; }
        else { const int sq = (rb - SROW0 / 32) * 8 + (tt >> 2); tr = tt & 3; rbase = r0 + (tt & ~3); st = p.st_gconv + (size_t)(l * NS + sq) * 3 * 1536; }
        const int ch = h * 128 + g * 16;
        u32x4 oq0 = (u32x4){0u, 0u, 0u, 0u}, oq1 = oq0, ok0 = oq0, ok1 = oq0, ov0 = oq0, ov1 = oq0;
        float ga = 0.f, gb = 0.f, gg = 0.f;
        if (valid) {
            float y[16];
            gdn_conv8(P, rbase, tr, cBV + ch, gh, st, 1024 + ch, cw, y); gdn_conv8(P, rbase, tr, cBV + ch + 8, gh, st, 1024 + ch + 8, cw, y + 8);
            ov0 = pack8(y); ov1 = pack8(y + 8);
            __builtin_amdgcn_sched_barrier(0);
            gdn_conv8(P, rbase, tr, cBQ + ch, gh, st, ch, cw, y); gdn_conv8(P, rbase, tr, cBQ + ch + 8, gh, st, ch + 8, cw, y + 8);
            float ss = 0.f;
#pragma unroll
            for (int i = 0; i < 16; ++i) ss += y[i] * y[i];
            float rs = rsqrtf(red8(ss) + 1e-6f) * 0.08838834764831845f;
#pragma unroll
            for (int i = 0; i < 16; ++i) y[i] *= rs;
            oq0 = pack8(y); oq1 = pack8(y + 8);
            __builtin_amdgcn_sched_barrier(0);
            gdn_conv8(P, rbase, tr, cBK + ch, gh, st, 512 + ch, cw, y); gdn_conv8(P, rbase, tr, cBK + ch + 8, gh, st, 512 + ch + 8, cw, y + 8);
            ss = 0.f;
#pragma unroll
            for (int i = 0; i < 16; ++i) ss += y[i] * y[i];
            rs = rsqrtf(red8(ss) + 1e-6f);
#pragma unroll
            for (int i = 0; i < 16; ++i) y[i] *= rs;
            ok0 = pack8(y); ok1 = pack8(y + 8);
            unpack8(ok0, y); unpack8(ok1, y + 8);
#pragma unroll
            for (int i = 0; i < 4; ++i) *(f32x4*)(ksc + tt * 128 + g * 16 + 4 * i) = (f32x4){y[4 * i], y[4 * i + 1], y[4 * i + 2], y[4 * i + 3]};
            if (g == 0) { const float* gr = G + (size_t)(r0 + tt) * 16;
                gb = sigmoidf_(gr[8 + h]);
                const float xa = gr[12 + h] + p.dt_bias[l * 4 + h];
                const float sp = fmaxf(xa, 0.f) + log1pf(__expf(-fabsf(xa)));
                gg = -__expf(p.A_log[l * 4 + h]) * sp; ga = __expf(gg); }
        }
        if (!samp) {
            *(u32x4*)(kimg + tt * CH_LDQ + g * 16) = ok0; *(u32x4*)(kimg + tt * CH_LDQ + g * 16 + 8) = ok1;
            *(u32x4*)(qimg + tt * CH_LDQ + g * 16) = oq0; *(u32x4*)(qimg + tt * CH_LDQ + g * 16 + 8) = oq1;
            if (g == 0) { sgl[tt] = gg; sbe[tt] = gb; }
        }
        __syncthreads();
        f32x16 pacc;
#pragma unroll
        for (int i = 0; i < 16; ++i) pacc[i] = 0.f;
        float myG = 0.f, totG = 0.f;
        if (valid) {
            bf16_t* pr = P + (size_t)(r0 + tt) * NP;
            *(u32x4*)(pr + cBQ + ch) = oq0; *(u32x4*)(pr + cBQ + ch + 8) = oq1; *(u32x4*)(pr + cBK + ch) = ok0; *(u32x4*)(pr + cBK + ch + 8) = ok1;
            *(u32x4*)(pr + cBV + ch) = ov0; *(u32x4*)(pr + cBV + ch + 8) = ov1;
        }
        if (samp) {
            if (valid) {
                const float* kmb = ksc + (tt & ~3) * 128 + g * 16;
                f32x4 qk, kk, qs[4], ks[4];
                { float y[16]; unpack8(oq0, y); unpack8(oq1, y + 8);
#pragma unroll
                  for (int i = 0; i < 4; ++i) qs[i] = (f32x4){y[4 * i], y[4 * i + 1], y[4 * i + 2], y[4 * i + 3]};
                  unpack8(ok0, y); unpack8(ok1, y + 8);
#pragma unroll
                  for (int i = 0; i < 4; ++i) ks[i] = (f32x4){y[4 * i], y[4 * i + 1], y[4 * i + 2], y[4 * i + 3]}; }
#pragma unroll
                for (int j = 0; j < 4; ++j) { qk[j] = red8(dot16(qs, kmb + j * 128)); kk[j] = red8(dot16(ks, kmb + j * 128)); }
                if (g == 0) { float* rec = REC + ((size_t)(r0 + tt) * 4 + h) * 16; *(f32x4*)rec = (f32x4){ga, gb, gg, 0.f}; *(f32x4*)(rec + 4) = qk; *(f32x4*)(rec + 8) = kk; }
            }
        } else if (act) {
            if (wq < 2) {
                const bf16_t* ai = wq == 0 ? kimg : qimg;
#pragma unroll
                for (int kb = 0; kb < 8; ++kb) pacc = MFMA32(frag_n(ai, CH_LDQ, r, hf, kb), frag_n(kimg, CH_LDQ, r, hf, kb), pacc);
            } else if (wq == 2) {
                const float gm = sgl[r]; float cum = 0.f;
#pragma unroll
                for (int t2 = 0; t2 < 32; ++t2) { cum += rdl(gm, t2); if (r == t2) myG = cum; }
                totG = cum;
                if (lane < 32) sG[r] = myG;
                if (lane == 0) sG[32] = cum;
            }
        }
        __syncthreads();
        if (!samp && act) {
            bf16_t* tb = TB + (size_t)item * 3072;
            if (wq == 0) {
                const float Gs_ = sG[r]; float* ag = (float*)tb;
#pragma unroll
                for (int i4 = 0; i4 < 4; ++i4) { const f32x4 G4 = *(const f32x4*)(sG + 8 * i4 + 4 * hf), b4 = *(const f32x4*)(sbe + 8 * i4 + 4 * hf);
#pragma unroll
                    for (int ii = 0; ii < 4; ++ii) { const int t2 = 8 * i4 + 4 * hf + ii; ag[t2 * 32 + r] = (r < t2) ? b4[ii] * pacc[4 * i4 + ii] * __expf(G4[ii] - Gs_) : 0.f; } }
            } else if (wq == 1) {
                const float Gs_ = sG[r];
#pragma unroll
                for (int i4 = 0; i4 < 4; ++i4) { const f32x4 G4 = *(const f32x4*)(sG + 8 * i4 + 4 * hf);
#pragma unroll
                    for (int ii = 0; ii < 4; ++ii) { const int t2 = 8 * i4 + 4 * hf + ii; tb[2048 + t2 * 32 + r] = f2bf((r <= t2) ? pacc[4 * i4 + ii] * __expf(G4[ii] - Gs_) : 0.f); } }
            }
            if (valid && g == 0) { const float Gt = sG[tt], GT = sG[32];
                float* rec = REC + ((size_t)(r0 + tt) * 4 + h) * 16; *(f32x4*)rec = (f32x4){ga, gb, gg, Gt}; *(f32x4*)(rec + 12) = (f32x4){GT - Gt, GT, 0.f, 0.f}; }
        }
        __syncthreads();
    }
    asm volatile("s_waitcnt vmcnt(0)" ::: "memory");
    __syncthreads();
    { const int wv_ = tid >> 6; float* am = lds + wv_ * 1024;
      int nmine = 0;
      for (int base = blockIdx.x * 2; base < NITEM; base += gridDim.x * 2) nmine += 2;
      for (int idx = wv_; idx < nmine; idx += 8) {
        const int item = blockIdx.x * 2 + (idx >> 1) * gridDim.x * 2 + (idx & 1);
        const int rb = item >> 2, h = item & 3;
        if (item >= NITEM || rb >= SROW0 / 32) continue;
        bf16_t* tb = TB + (size_t)item * 3072; const float* ag = (const float*)tb;
#pragma unroll
        for (int q = 0; q < 4; ++q) *(f32x4*)(am + q * 256 + lane * 4) = *(const f32x4*)(ag + q * 256 + lane * 4);
        const float* rec = REC + ((size_t)(rb * 32 + r) * 4 + h) * 16;
        const bool rv = (rb % (LPAD / 32)) * 32 + r < LP;
        const float bs_ = rv ? rec[1] : 0.f, bg_ = rv ? bs_ * __expf(rec[3]) : 0.f;
        asm volatile("s_waitcnt vmcnt(0) lgkmcnt(0)" ::: "memory");
        float Tc[32];
#pragma unroll
        for (int t2 = 0; t2 < 32; ++t2) { float v0 = 0.f, v1 = 0.f, v2 = 0.f, v3 = 0.f;
#pragma unroll
            for (int q4 = 0; q4 < (t2 + 3) / 4; ++q4) { const f32x4 a4 = *(const f32x4*)(am + t2 * 32 + q4 * 4);
                if (q4 * 4 + 0 < t2) v0 += a4[0] * Tc[q4 * 4 + 0]; if (q4 * 4 + 1 < t2) v1 += a4[1] * Tc[q4 * 4 + 1];
                if (q4 * 4 + 2 < t2) v2 += a4[2] * Tc[q4 * 4 + 2]; if (q4 * 4 + 3 < t2) v3 += a4[3] * Tc[q4 * 4 + 3]; }
            Tc[t2] = ((r == t2) ? 1.f : 0.f) - ((v0 + v1) + (v2 + v3)); }
        if (hf == 0) {
#pragma unroll
            for (int t2 = 0; t2 < 32; ++t2) { tb[t2 * 32 + r] = f2bf(Tc[t2] * bs_); tb[1024 + t2 * 32 + r] = f2bf(Tc[t2] * bg_); } }
        asm volatile("s_waitcnt lgkmcnt(0)" ::: "memory");
      } }
    { const int wv_ = tid >> 6;
      for (int it = blockIdx.x * 8 + wv_; it < (SROW0 / 32) * 4; it += gridDim.x * 8) {
        const int rbp = it >> 2, hh = it & 3, jb = rbp % (LPAD / 32), row = rbp * 32 + r;
        float igm = -1e30f, lfm = 0.f;
        if (jb * 32 + r < LP) { const float* gr = G + (size_t)row * 16; igm = gr[hh] + p.gate_bias[l * 8 + hh]; const float f = gr[4 + hh] + p.gate_bias[l * 8 + 4 + hh]; lfm = fminf(f, 0.f) - log1pf(__expf(-fabsf(f))); }
        float bsum = 0.f, pm = -3e38f, myb = 0.f, myu = 0.f, mypm = 0.f;
#pragma unroll
        for (int t2 = 0; t2 < 32; ++t2) { bsum += rdl(lfm, t2); const float u_ = rdl(igm, t2) - bsum; pm = fmaxf(pm, u_); if (r == t2) { myb = bsum; myu = u_; mypm = pm; } }
        if (lane < 32) *(f32x4*)(REC + ((size_t)row * 4 + hh) * 16 + 4) = (f32x4){myu, myb, mypm, 0.f};
      } }
}

__device__ __forceinline__ void issue_gdn(const Params& p, int h, int qtr, int row0, int L, int jb, int ptid, StageRegs& r) {
    const bf16_t* P = (const bf16_t*)(p.ws + OFF_P); const float* REC = (const float*)(p.ws + OFF_REC);
    const int tt = ptid >> 3, g = ptid & 7, t0 = jb * 32;
    if (t0 + tt >= L) return;
    const int row = row0 + t0 + tt;
    const bf16_t* prow = P + (size_t)row * NP;
    r.q0 = asf(*(const u32x4*)(prow + cBQ + h * 128 + g * 16)); r.q1 = asf(*(const u32x4*)(prow + cBQ + h * 128 + g * 16 + 8));
    r.k0 = asf(*(const u32x4*)(prow + cBK + h * 128 + g * 16)); r.k1 = asf(*(const u32x4*)(prow + cBK + h * 128 + g * 16 + 8));
    { const u32x2 vv_ = *(const u32x2*)(prow + cBV + h * 128 + qtr * 32 + g * 4); r.v = asf((u32x4){vv_.x, vv_.y, 0u, 0u}); }
    if (g < 3) r.r0 = *(const f32x4*)(REC + ((size_t)row * 4 + h) * 16 + g * 4);
}
__device__ __forceinline__ void commit_gdn(int L, int jb, float* lds, int ptid, const StageRegs& r, int bsel = -1) {
    const int tt = ptid >> 3, g = ptid & 7, t0 = jb * 32, b = bsel >= 0 ? bsel : (jb & 1);
    if (t0 + tt >= L) return;
    float x[16];
    unpack8(asu(r.q0), x); unpack8(asu(r.q1), x + 8);
    float* qd = QB(lds, b) + tt * 128 + g * 16;
#pragma unroll
    for (int i = 0; i < 4; ++i) *(f32x4*)(qd + 4 * i) = (f32x4){x[4 * i], x[4 * i + 1], x[4 * i + 2], x[4 * i + 3]};
    unpack8(asu(r.k0), x); unpack8(asu(r.k1), x + 8);
    float* kd = KB(lds, b) + tt * 128 + g * 16;
#pragma unroll
    for (int i = 0; i < 4; ++i) *(f32x4*)(kd + 4 * i) = (f32x4){x[4 * i], x[4 * i + 1], x[4 * i + 2], x[4 * i + 3]};
    *(f32x4*)(VB(lds, b) + tt * 32 + g * 4) = (f32x4){bflo(asu(r.v).x), bfhi(asu(r.v).x), bflo(asu(r.v).y), bfhi(asu(r.v).y)};
    if (g < 3) *(f32x4*)(SCB(lds, b) + tt * 16 + g * 4) = r.r0;
}

constexpr int GD_Q = 0, GD_K = 8704, GD_KT = 17408, GD_KDT = 27904, GD_VT = 38400, GD_QKD = 40960, GD_TV = 43520, GD_TK = 46080, GD_W = 48640, GD_SC = 57344, GD_SLOT = 58368, GD_OB = 2 * GD_SLOT;
constexpr int GS_B = 32, GS_EG = 96, GS_ETG = 128, GS_EGT = 160;

__device__ __forceinline__ void issue_gdn_chunk(const Params& p, int h, int qtr, int row0, int L, int nch, int jb, int ptid, StageRegs& r) {
    if (jb >= nch) return;
    const bf16_t* P = (const bf16_t*)(p.ws + OFF_P); const float* REC = (const float*)(p.ws + OFF_REC);
    const bf16_t* tb = (const bf16_t*)(p.ws + OFF_TB) + ((size_t)((row0 >> 5) + jb) * 4 + h) * 3072;
    r.x0 = asf(*(const u32x4*)(tb + ptid * 8));
    if (ptid < 128) r.x1 = asf(*(const u32x4*)(tb + 2048 + ptid * 8));
    const int tt = ptid >> 3, g = ptid & 7, t0 = jb * 32;
    if (t0 + tt >= L) return;
    const int row = row0 + t0 + tt;
    const bf16_t* prow = P + (size_t)row * NP;
    r.q0 = asf(*(const u32x4*)(prow + cBQ + h * 128 + g * 16)); r.q1 = asf(*(const u32x4*)(prow + cBQ + h * 128 + g * 16 + 8));
    r.k0 = asf(*(const u32x4*)(prow + cBK + h * 128 + g * 16)); r.k1 = asf(*(const u32x4*)(prow + cBK + h * 128 + g * 16 + 8));
    { const u32x2 vv_ = *(const u32x2*)(prow + cBV + h * 128 + qtr * 32 + g * 4); r.v = asf((u32x4){vv_.x, vv_.y, 0u, 0u}); }
    if (g == 0 || g == 3) r.r0 = *(const f32x4*)(REC + ((size_t)row * 4 + h) * 16 + g * 4);
}

__device__ __forceinline__ void scan_gdn_chunk(const Params& p, int l, int bs, int h, int qtr, int row0, int L, unsigned char* lb) {
    const int tid = opaque_tid(p.wv); const int wave = tid >> 6, lane = tid & 63, r = lane & 31, hf = lane >> 5, ptid = tid - 256;
    bf16_t* P = (bf16_t*)(p.ws + OFF_P);
    const int nch = (L + 31) >> 5;
    f32x16 S[4];
#pragma unroll
    for (int dt = 0; dt < 4; ++dt)
#pragma unroll
        for (int i = 0; i < 16; ++i) S[dt][i] = 0.f;
    f32x4 s0, s1, s2, s3, s4, s5, s6, s7; StageRegs sr{s0, s1, s2, s3, s4, s5, s6, s7};
#define GD_P1(JN) do { const int jn_ = (JN); unsigned char* sl_ = lb + (jn_ & 1) * GD_SLOT; const int tt = ptid >> 3, g = ptid & 7; const bool val_ = jn_ * 32 + tt < L; \
        u32x4 q0_ = asu(sr.q0), q1_ = asu(sr.q1), k0_ = asu(sr.k0), k1_ = asu(sr.k1); u32x4 v_ = asu(sr.v); \
        if (!val_) { q0_ = q1_ = k0_ = k1_ = v_ = (u32x4){0u, 0u, 0u, 0u}; } \
        *(u32x4*)(sl_ + GD_Q + (tt * CH_LDQ + g * 16) * 2) = q0_; *(u32x4*)(sl_ + GD_Q + (tt * CH_LDQ + g * 16 + 8) * 2) = q1_; \
        *(u32x4*)(sl_ + GD_K + (tt * CH_LDQ + g * 16) * 2) = k0_; *(u32x4*)(sl_ + GD_K + (tt * CH_LDQ + g * 16 + 8) * 2) = k1_; \
        bf16_t* kt_ = (bf16_t*)(sl_ + GD_KT) + kto(g * 16) + tt; \
        _Pragma("unroll") for (int i = 0; i < 4; ++i) { kt_[(2 * i) * CH_LDS] = (bf16_t)(k0_[i] & 0xffffu); kt_[(2 * i + 1) * CH_LDS] = (bf16_t)(k0_[i] >> 16); \
            kt_[(8 + 2 * i) * CH_LDS] = (bf16_t)(k1_[i] & 0xffffu); kt_[(8 + 2 * i + 1) * CH_LDS] = (bf16_t)(k1_[i] >> 16); } \
        bf16_t* vt_ = (bf16_t*)(sl_ + GD_VT); \
        vt_[(g * 4 + 0) * CH_LDS + tt] = (bf16_t)(v_.x & 0xffffu); vt_[(g * 4 + 1) * CH_LDS + tt] = (bf16_t)(v_.x >> 16); \
        vt_[(g * 4 + 2) * CH_LDS + tt] = (bf16_t)(v_.y & 0xffffu); vt_[(g * 4 + 3) * CH_LDS + tt] = (bf16_t)(v_.y >> 16); \
        { const int row_ = ptid >> 2, c4_ = ptid & 3; *(u32x4*)(sl_ + (row_ < 32 ? GD_TV : GD_TK) + ((row_ & 31) * CH_LDS + c4_ * 8) * 2) = asu(sr.x0); \
          if (ptid < 128) *(u32x4*)(sl_ + GD_QKD + (row_ * CH_LDS + c4_ * 8) * 2) = asu(sr.x1); } \
        float* sc_ = (float*)(sl_ + GD_SC); \
        if (g == 0) { sc_[GS_B + tt] = val_ ? sr.r0[1] : 0.f; sc_[GS_EG + tt] = val_ ? __expf(sr.r0[3]) : 0.f; } \
        if (g == 3) { sc_[GS_ETG + tt] = val_ ? __expf(sr.r0[0]) : 0.f; if (tt == 0) sc_[GS_EGT] = __expf(sr.r0[1]); } \
        issue_gdn_chunk(p, h, qtr, row0, L, nch, jn_ + 1, ptid, sr); } while (0)
#define GD_P2(JN) do { if (wave >= 4) { unsigned char* sl_ = lb + ((JN) & 1) * GD_SLOT; const float* sc_ = (const float*)(sl_ + GD_SC); \
        { const int tt = ptid >> 3, g = ptid & 7; const float eg_ = sc_[GS_EG + tt], et_ = sc_[GS_ETG + tt]; float x_[16]; \
            u32x4* qp_ = (u32x4*)(sl_ + GD_Q + (tt * CH_LDQ + g * 16) * 2); unpack8(qp_[0], x_); unpack8(qp_[1], x_ + 8); \
            _Pragma("unroll") for (int i = 0; i < 16; ++i) x_[i] *= eg_; \
            qp_[0] = pack8(x_); qp_[1] = pack8(x_ + 8); \
            const u32x4* kp_ = (const u32x4*)(sl_ + GD_K + (tt * CH_LDQ + g * 16) * 2); unpack8(kp_[0], x_); unpack8(kp_[1], x_ + 8); \
            bf16_t* kd_ = (bf16_t*)(sl_ + GD_KDT); \
            _Pragma("unroll") for (int i = 0; i < 16; ++i) kd_[kto(g * 16) + i * CH_LDS + tt] = f2bf(x_[i] * et_); } \
        { const int dt_ = wave - 4; f32x16 a_; \
            _Pragma("unroll") for (int i = 0; i < 16; ++i) a_[i] = 0.f; \
            _Pragma("unroll") for (int kb = 0; kb < 2; ++kb) a_ = MFMA32(frag_n((const bf16_t*)(sl_ + GD_KT) + kto(dt_ * 32 + r), 0, 0, hf, kb), frag_n((const bf16_t*)(sl_ + GD_TK), CH_LDS, r, hf, kb), a_); \
            _Pragma("unroll") for (int i4 = 0; i4 < 4; ++i4) { unsigned lo_, hi_;     \
                asm volatile("s_nop 7\n\ts_nop 7\n\tv_cvt_pk_bf16_f32 %0, %2, %3\n\tv_cvt_pk_bf16_f32 %1, %4, %5" : "=&v"(lo_), "=&v"(hi_) : "v"(a_[4 * i4]), "v"(a_[4 * i4 + 1]), "v"(a_[4 * i4 + 2]), "v"(a_[4 * i4 + 3])); \
                *(u32x2*)(sl_ + GD_W + (r * CH_LDQ + 32 * dt_ + 8 * i4 + 4 * hf) * 2) = (u32x2){lo_, hi_}; } } } } while (0)
    if (wave >= 4) { issue_gdn_chunk(p, h, qtr, row0, L, nch, 0, ptid, sr); GD_P1(0); }
    BARRIER_LDS();
    GD_P2(0);
    BARRIER_LDS();
#pragma unroll 1
    for (int j = 0; j < nch; ++j) {
        if (wave == 0) {
            const unsigned char* sl = lb + (j & 1) * GD_SLOT; const float* sc = (const float*)(sl + GD_SC);
            const bf16_t* wq = (const bf16_t*)(sl + GD_W); const bf16_t* qg = (const bf16_t*)(sl + GD_Q); const bf16_t* tv = (const bf16_t*)(sl + GD_TV); const bf16_t* vt = (const bf16_t*)(sl + GD_VT);
            const bf16_t* qkd = (const bf16_t*)(sl + GD_QKD); const bf16_t* kdt = (const bf16_t*)(sl + GD_KDT);
            f32x16 U, O;
#pragma unroll
            for (int i = 0; i < 16; ++i) { U[i] = 0.f; O[i] = 0.f; }
#pragma unroll
            for (int dt = 0; dt < 4; ++dt)
#pragma unroll
                for (int u = 0; u < 2; ++u) { const bf16x8 sb = pack_step(S[dt], u);
                    U = MFMA32(frag_p(wq, CH_LDQ, r, hf, 32 * dt + 16 * u), sb, U); O = MFMA32(frag_p(qg, CH_LDQ, r, hf, 32 * dt + 16 * u), sb, O); }
            f32x16 Uv;
#pragma unroll
            for (int i = 0; i < 16; ++i) Uv[i] = 0.f;
#pragma unroll
            for (int kb = 0; kb < 2; ++kb) Uv = MFMA32(frag_n(tv, CH_LDS, r, hf, kb), frag_n(vt, CH_LDS, r, hf, kb), Uv);
#pragma unroll
            for (int i = 0; i < 16; ++i) U[i] = Uv[i] - U[i];
            bf16x8 ub[2]; ub[0] = pack_step(U, 0); ub[1] = pack_step(U, 1);
#pragma unroll
            for (int u = 0; u < 2; ++u) O = MFMA32(frag_p(qkd, CH_LDS, r, hf, 16 * u), ub[u], O);
            const float egt = sc[GS_EGT];
#pragma unroll
            for (int dt = 0; dt < 4; ++dt) {
#pragma unroll
                for (int i = 0; i < 16; ++i) S[dt][i] *= egt;
#pragma unroll
                for (int u = 0; u < 2; ++u) S[dt] = MFMA32(frag_p(kdt + kto(dt * 32 + r), 0, 0, hf, 16 * u), ub[u], S[dt]);
            }
            float* ob = (float*)(lb + GD_OB) + (j & 1) * 1024;
#pragma unroll
            for (int i = 0; i < 16; ++i) ob[crow(i, hf) * 32 + r] = O[i];
        } else if (wave >= 4) {
            if (j + 1 < nch) GD_P1(j + 1);
            if (j > 0) store_out_blk(P, row0, j - 1, L, cBV + h * 128 + qtr * 32, (const float*)(lb + GD_OB) + ((j - 1) & 1) * 1024, ptid);
        }
        BARRIER_LDS();
        if (j + 1 < nch) GD_P2(j + 1);
        BARRIER_LDS();
    }
    if (wave >= 4) store_out_blk(P, row0, nch - 1, L, cBV + h * 128 + qtr * 32, (const float*)(lb + GD_OB) + ((nch - 1) & 1) * 1024, ptid);
    if (wave == 0) {
        float* So = p.out + o_pS + ((size_t)(l * NB + bs) * 4 + h) * 16384;
#pragma unroll
        for (int dt = 0; dt < 4; ++dt)
#pragma unroll
            for (int i = 0; i < 16; ++i) So[(32 * dt + crow(i, hf)) * 128 + qtr * 32 + r] = S[dt][i];
    }
    __syncthreads();
#undef GD_P1
#undef GD_P2
}

__device__ __forceinline__ void scan_gdn(const Params& p, int l, bool samp, int bs, int h, int qtr, int row0, int L, float* lds) {
    const int tid = opaque_tid(p.wv); const bool cons = tid < 256; const int ptid = tid - 256;
    const int lane = tid & 63, w = (tid >> 6) & 3, s = lane & 7, cl = w * 8 + (lane >> 3), col = qtr * 32 + cl;
    bf16_t* P = (bf16_t*)(p.ws + OFF_P);
    f32x2 S[8];
#pragma unroll
    for (int e = 0; e < 8; ++e) S[e] = bc2(0.f);
    if (cons && samp) {
        const float* S0 = p.st_S + ((size_t)(l * NS + bs) * 4 + h) * 16384;
#pragma unroll
        for (int e = 0; e < 16; ++e) { const int d = (e >> 2) * 32 + s * 4 + (e & 3); S[e >> 1][e & 1] = S0[d * 128 + col]; }
    }
    const int nblk = (L + 31) >> 5;
    f32x4 k4[4][4];
    StageRegs sr{k4[0][0], k4[0][1], k4[0][2], k4[0][3], k4[1][0], k4[1][1], k4[1][2], k4[1][3]};
    if (!cons) { issue_gdn(p, h, qtr, row0, L, 0, ptid, sr); commit_gdn(L, 0, lds, ptid, sr); if (1 < nblk) issue_gdn(p, h, qtr, row0, L, 1, ptid, sr); }
    BARRIER_LDS();
    for (int jb = 0; jb < nblk; ++jb) {
        if (!cons) {
            if (jb + 1 < nblk) commit_gdn(L, jb + 1, lds, ptid, sr);
            if (jb + 2 < nblk) issue_gdn(p, h, qtr, row0, L, jb + 2, ptid, sr);
            if (jb > 0) store_out_blk(P, row0, jb - 1, L, cBV + h * 128 + qtr * 32, OB(lds, (jb - 1) & 1), ptid);
        } else {
            const float* qb = QB(lds, jb & 1); const float* kb = KB(lds, jb & 1); const float* vb = VB(lds, jb & 1); const float* sc = SCB(lds, jb & 1);
            float* ob = OB(lds, jb & 1);
            const int nt = min(32, L - jb * 32);
            f32x4 q4[4][4]; float vv[4], a[4], be[4]; f32x4 qk[4], kk[4];
#define GLOAD_Q(T0) do { _Pragma("unroll") for (int i = 0; i < 4; ++i) { const int t = (T0) + i; \
        _Pragma("unroll") for (int j = 0; j < 4; ++j) q4[i][j] = *(const f32x4*)(qb + t * 128 + j * 32 + s * 4); } } while (0)
#define GLOAD_K(T0) do { _Pragma("unroll") for (int i = 0; i < 4; ++i) { const int t = (T0) + i; \
        _Pragma("unroll") for (int j = 0; j < 4; ++j) k4[i][j] = *(const f32x4*)(kb + t * 128 + j * 32 + s * 4); } \
      _Pragma("unroll") for (int i = 0; i < 4; ++i) { const int t = (T0) + i; \
        const f32x2 gg = *(const f32x2*)(sc + t * 16); a[i] = gg[0]; be[i] = gg[1]; \
        qk[i] = *(const f32x4*)(sc + t * 16 + 4); kk[i] = *(const f32x4*)(sc + t * 16 + 8); vv[i] = vb[t * 32 + cl]; } } while (0)
            GLOAD_Q(0); GLOAD_K(0);
#pragma unroll 1
            for (int t0 = 0; t0 < nt; t0 += 4) {
                float dk[4], dq[4];
                const int tn = min(t0 + 4, 28);
                __builtin_amdgcn_sched_barrier(0);
#pragma unroll
                for (int i = 0; i < 4; ++i) {
                    f32x2 x = bc2(0.f), x2 = bc2(0.f), y = bc2(0.f), y2 = bc2(0.f);
#pragma unroll
                    for (int j = 0; j < 4; ++j) {
                        x = lo2(k4[i][j]) * S[2 * j] + x; x2 = hi2(k4[i][j]) * S[2 * j + 1] + x2;
                        y = lo2(q4[i][j]) * S[2 * j] + y; y2 = hi2(q4[i][j]) * S[2 * j + 1] + y2; }
                    x = x + x2; y = y + y2;
                    dk[i] = x[0] + x[1]; dq[i] = y[0] + y[1];
                }
                __builtin_amdgcn_sched_barrier(0);
                GLOAD_Q(tn);
                __builtin_amdgcn_sched_barrier(0);
#pragma unroll
                for (int i = 0; i < 4; ++i) { dk[i] = red8(dk[i]); dq[i] = red8(dq[i]); }
                const float A0 = a[0], A1 = A0 * a[1], A2 = A1 * a[2], A3 = A2 * a[3];
                const float r10 = a[1], r21 = a[2], r32 = a[3], r20 = r10 * a[2], r31 = r21 * a[3], r30 = r20 * a[3];
                const float u0 = be[0] * (vv[0] - A0 * dk[0]);
                const float u1 = be[1] * (vv[1] - A1 * dk[1] - r10 * kk[1][0] * u0);
                const float u2 = be[2] * (vv[2] - A2 * dk[2] - r20 * kk[2][0] * u0 - r21 * kk[2][1] * u1);
                const float u3 = be[3] * (vv[3] - A3 * dk[3] - r30 * kk[3][0] * u0 - r31 * kk[3][1] * u1 - r32 * kk[3][2] * u2);
                if (s == 0) {
                    ob[(t0 + 0) * 32 + cl] = A0 * dq[0] + qk[0][0] * u0;
                    ob[(t0 + 1) * 32 + cl] = A1 * dq[1] + r10 * qk[1][0] * u0 + qk[1][1] * u1;
                    ob[(t0 + 2) * 32 + cl] = A2 * dq[2] + r20 * qk[2][0] * u0 + r21 * qk[2][1] * u1 + qk[2][2] * u2;
                    ob[(t0 + 3) * 32 + cl] = A3 * dq[3] + r30 * qk[3][0] * u0 + r31 * qk[3][1] * u1 + r32 * qk[3][2] * u2 + qk[3][3] * u3;
                }
                const float c0 = r30 * u0, c1 = r31 * u1, c2 = r32 * u2, c3 = u3;
#pragma unroll
                for (int j = 0; j < 4; ++j) {
                    S[2 * j] = lo2(k4[3][j]) * bc2(c3) + (lo2(k4[2][j]) * bc2(c2) + (lo2(k4[1][j]) * bc2(c1) + (lo2(k4[0][j]) * bc2(c0) + S[2 * j] * bc2(A3))));
                    S[2 * j + 1] = hi2(k4[3][j]) * bc2(c3) + (hi2(k4[2][j]) * bc2(c2) + (hi2(k4[1][j]) * bc2(c1) + (hi2(k4[0][j]) * bc2(c0) + S[2 * j + 1] * bc2(A3)))); }
                __builtin_amdgcn_sched_barrier(0);
                GLOAD_K(tn);
            }
#undef GLOAD_Q
#undef GLOAD_K
        }
        BARRIER_LDS();
    }
    if (!cons) store_out_blk(P, row0, nblk - 1, L, cBV + h * 128 + qtr * 32, OB(lds, (nblk - 1) & 1), ptid);
    else {
        const size_t sh = samp ? (size_t)(l * NS + bs) * 4 + h : (size_t)(l * NB + bs) * 4 + h;
        float* So = p.out + (samp ? o_sS : o_pS) + sh * 16384;
#pragma unroll
        for (int e = 0; e < 16; ++e) { const int d = (e >> 2) * 32 + s * 4 + (e & 3); So[d * 128 + col] = S[e >> 1][e & 1]; }
    }
    BARRIER_LDS();
}

__device__ __forceinline__ void scan_gdn_stream(const Params& p, int l, int h, int qtr, int bs0, int nseq, float* lds) {
    const int tid = opaque_tid(p.wv); const bool cons = tid < 256; const int ptid = tid - 256;
    const int lane = tid & 63, w = (tid >> 6) & 3, s = lane & 7, cl = w * 8 + (lane >> 3), col = qtr * 32 + cl;
    bf16_t* P = (bf16_t*)(p.ws + OFF_P);
    f32x2 S[8];
#pragma unroll
    for (int e = 0; e < 8; ++e) S[e] = bc2(0.f);
    f32x4 k4[4][4];
    StageRegs sr{k4[0][0], k4[0][1], k4[0][2], k4[0][3], k4[1][0], k4[1][1], k4[1][2], k4[1][3]};
#define LOADSTATE(BS) do { } while (0)
#define STISSUE(BS) st_issue(p.st_S + ((size_t)(l * NS + (BS)) * 4 + h) * 16384, qtr, ptid, k4[2][0], k4[2][1], k4[2][2], k4[2][3])
    if (!cons) { issue_gdn(p, h, qtr, SROW0 + bs0 * 4, LS, 0, ptid, sr); STISSUE(bs0); }
#pragma unroll 1
    for (int k = 0; k < nseq; ++k) {
        const int bs = bs0 + 8 * k, row0 = SROW0 + bs * 4;
        if (!cons) { commit_gdn(LS, 0, lds, ptid, sr, k & 1); st_commit(STB(lds, k & 1), ptid, k4[2][0], k4[2][1], k4[2][2], k4[2][3]);
            if (k + 1 < nseq) { issue_gdn(p, h, qtr, row0 + 32, LS, 0, ptid, sr); STISSUE(bs + 8); } }
        BARRIER_LDS();
        if (!cons) { if (k > 0) { store_out_blk(P, row0 - 32, 0, LS, cBV + h * 128 + qtr * 32, OB(lds, (k - 1) & 1), ptid); st_store(p.out + o_sS + ((size_t)(l * NS + bs - 8) * 4 + h) * 16384, qtr, STB(lds, (k - 1) & 1), ptid); } }
        else {
            const float* qb = QB(lds, k & 1); const float* kb = KB(lds, k & 1); const float* vb = VB(lds, k & 1); const float* sc = SCB(lds, k & 1);
            float* ob = OB(lds, k & 1); float* stb = STB(lds, k & 1);
#pragma unroll
            for (int e = 0; e < 16; ++e) { const int d = (e >> 2) * 32 + s * 4 + (e & 3); S[e >> 1][e & 1] = stb[d * ST_LD + cl]; }
            f32x4 q4[4][4]; float vv[4], a[4], be[4]; f32x4 qk[4], kk[4];
#define GLOAD_Q(T0) do { _Pragma("unroll") for (int i = 0; i < 4; ++i) { const int t = (T0) + i; \
        _Pragma("unroll") for (int j = 0; j < 4; ++j) q4[i][j] = *(const f32x4*)(qb + t * 128 + j * 32 + s * 4); } } while (0)
#define GLOAD_K(T0) do { _Pragma("unroll") for (int i = 0; i < 4; ++i) { const int t = (T0) + i; \
        _Pragma("unroll") for (int j = 0; j < 4; ++j) k4[i][j] = *(const f32x4*)(kb + t * 128 + j * 32 + s * 4); } \
      _Pragma("unroll") for (int i = 0; i < 4; ++i) { const int t = (T0) + i; \
        const f32x2 gg = *(const f32x2*)(sc + t * 16); a[i] = gg[0]; be[i] = gg[1]; \
        qk[i] = *(const f32x4*)(sc + t * 16 + 4); kk[i] = *(const f32x4*)(sc + t * 16 + 8); vv[i] = vb[t * 32 + cl]; } } while (0)
            GLOAD_Q(0); GLOAD_K(0);
            {
                float dk[4], dq[4];
                __builtin_amdgcn_sched_barrier(0);
#pragma unroll
                for (int i = 0; i < 4; ++i) {
                    f32x2 x = bc2(0.f), x2 = bc2(0.f), y = bc2(0.f), y2 = bc2(0.f);
#pragma unroll
                    for (int j = 0; j < 4; ++j) {
                        x = lo2(k4[i][j]) * S[2 * j] + x; x2 = hi2(k4[i][j]) * S[2 * j + 1] + x2;
                        y = lo2(q4[i][j]) * S[2 * j] + y; y2 = hi2(q4[i][j]) * S[2 * j + 1] + y2; }
                    x = x + x2; y = y + y2;
                    dk[i] = x[0] + x[1]; dq[i] = y[0] + y[1];
                }
                __builtin_amdgcn_sched_barrier(0);
#pragma unroll
                for (int i = 0; i < 4; ++i) { dk[i] = red8(dk[i]); dq[i] = red8(dq[i]); }
                const float A0 = a[0], A1 = A0 * a[1], A2 = A1 * a[2], A3 = A2 * a[3];
                const float r10 = a[1], r21 = a[2], r32 = a[3], r20 = r10 * a[2], r31 = r21 * a[3], r30 = r20 * a[3];
                const float u0 = be[0] * (vv[0] - A0 * dk[0]);
                const float u1 = be[1] * (vv[1] - A1 * dk[1] - r10 * kk[1][0] * u0);
                const float u2 = be[2] * (vv[2] - A2 * dk[2] - r20 * kk[2][0] * u0 - r21 * kk[2][1] * u1);
                const float u3 = be[3] * (vv[3] - A3 * dk[3] - r30 * kk[3][0] * u0 - r31 * kk[3][1] * u1 - r32 * kk[3][2] * u2);
                if (s == 0) {
                    ob[0 * 32 + cl] = A0 * dq[0] + qk[0][0] * u0;
                    ob[1 * 32 + cl] = A1 * dq[1] + r10 * qk[1][0] * u0 + qk[1][1] * u1;
                    ob[2 * 32 + cl] = A2 * dq[2] + r20 * qk[2][0] * u0 + r21 * qk[2][1] * u1 + qk[2][2] * u2;
                    ob[3 * 32 + cl] = A3 * dq[3] + r30 * qk[3][0] * u0 + r31 * qk[3][1] * u1 + r32 * qk[3][2] * u2 + qk[3][3] * u3;
                }
                const float c0 = r30 * u0, c1 = r31 * u1, c2 = r32 * u2, c3 = u3;
#pragma unroll
                for (int j = 0; j < 4; ++j) {
                    S[2 * j] = lo2(k4[3][j]) * bc2(c3) + (lo2(k4[2][j]) * bc2(c2) + (lo2(k4[1][j]) * bc2(c1) + (lo2(k4[0][j]) * bc2(c0) + S[2 * j] * bc2(A3))));
                    S[2 * j + 1] = hi2(k4[3][j]) * bc2(c3) + (hi2(k4[2][j]) * bc2(c2) + (hi2(k4[1][j]) * bc2(c1) + (hi2(k4[0][j]) * bc2(c0) + S[2 * j + 1] * bc2(A3)))); }
            }
#undef GLOAD_Q
#undef GLOAD_K
#pragma unroll
            for (int e = 0; e < 16; ++e) { const int d = (e >> 2) * 32 + s * 4 + (e & 3); stb[d * ST_LD + cl] = S[e >> 1][e & 1]; }
        }
    }
    BARRIER_LDS();
    if (!cons) { store_out_blk(P, SROW0 + (bs0 + 8 * (nseq - 1)) * 4, 0, LS, cBV + h * 128 + qtr * 32, OB(lds, (nseq - 1) & 1), ptid); st_store(p.out + o_sS + ((size_t)(l * NS + bs0 + 8 * (nseq - 1)) * 4 + h) * 16384, qtr, STB(lds, (nseq - 1) & 1), ptid); }
    BARRIER_LDS();
#undef LOADSTATE
#undef STISSUE
}


__device__ __forceinline__ void phase_scan(const Params& p, int l, float* lds) {
    for (int item = blockIdx.x; item < 256; item += gridDim.x) {
        const int qtr = item & 3, h = (item >> 2) & 3, bs = (item >> 4) & 7, branch = item >> 7;
        if (branch == 0) scan_mlstm_chunk(p, l, bs, h, qtr, bs * LPAD, LP, (unsigned char*)lds); else scan_gdn_chunk(p, l, bs, h, qtr, bs * LPAD, LP, (unsigned char*)lds);
    }
    for (int c = blockIdx.x; c < 256; c += gridDim.x) {
        const int qtr = c & 3, h = (c >> 2) & 3, branch = (c >> 4) & 1, bs0 = c >> 5;
        if (branch == 0) scan_mlstm_stream(p, l, h, qtr, bs0, NS / 8, lds); else scan_gdn_stream(p, l, h, qtr, bs0, NS / 8, lds);
    }
}

__device__ __forceinline__ void phase_norm(const Params& p, int l) {
    const int tid = opaque_tid(p.wv); const int wave = tid >> 6, lane = tid & 63;
    bf16_t* P = (bf16_t*)(p.ws + OFF_P);
    const int part = lane >> 5, hh = (lane >> 3) & 3, g = lane & 7, ch0 = hh * 128 + g * 16;
    const int craw = (part ? cBV : cV) + ch0, cgate = (part ? cZ : cO) + ch0;
    const float* wn = part ? p.b_norm_w + l * 128 + g * 16 : p.a_norm_w + l * 512 + ch0;
    for (int row = blockIdx.x * 8 + wave; row < MROWS; row += gridDim.x * 8) {
        if (row < SROW0 && (row % LPAD) >= LP) continue;
        bf16_t* pr = P + (size_t)row * NP;
        float x[16], z[16];
        unpack8(*(const u32x4*)(pr + craw), x); unpack8(*(const u32x4*)(pr + craw + 8), x + 8);
        unpack8(*(const u32x4*)(pr + cgate), z); unpack8(*(const u32x4*)(pr + cgate + 8), z + 8);
        float sum = 0.f;
#pragma unroll
        for (int i = 0; i < 16; ++i) sum += x[i];
        float mean = red8(sum) * (1.f / 128.f);
        if (part) mean = 0.f;
        float s2 = 0.f;
#pragma unroll
        for (int i = 0; i < 16; ++i) { x[i] -= mean; s2 += x[i] * x[i]; }
        const float rstd = rsqrtf(red8(s2) * (1.f / 128.f) + 1e-6f);
        float y[16];
#pragma unroll
        for (int i = 0; i < 16; ++i) { const float sg = sigmoidf_(z[i]); y[i] = x[i] * rstd * wn[i] * (part ? z[i] * sg : sg); }
        u32x4 o0, o1;
        o0.x = pk2(y[0], y[1]); o0.y = pk2(y[2], y[3]); o0.z = pk2(y[4], y[5]); o0.w = pk2(y[6], y[7]);
        o1.x = pk2(y[8], y[9]); o1.y = pk2(y[10], y[11]); o1.z = pk2(y[12], y[13]); o1.w = pk2(y[14], y[15]);
        *(u32x4*)(pr + cgate) = o0; *(u32x4*)(pr + cgate + 8) = o1;
    }
}

__device__ __forceinline__ void phase_convact(const Params& p, int l) {
    bf16_t* U = (bf16_t*)(p.ws + OFF_P); const bf16_t* HB = (const bf16_t*)(p.ws + OFF_HB);
    const float* cw = p.fconv_w + (size_t)l * 3 * NU;
    constexpr int NCG = DFF / 8, NRG = MROWS / 32;
    const int tid = opaque_tid(p.wv);
    for (int it = blockIdx.x * NTHREADS + tid; it < NRG * NCG; it += gridDim.x * NTHREADS) {
        const int rg = it / NCG, cg_ = it - rg * NCG, c0 = cg_ * 8;
        float wa[3][8], wb[3][8];
#pragma unroll
        for (int j = 0; j < 3; ++j) {
            const f32x4 a0 = *(const f32x4*)(cw + j * NU + c0), a1 = *(const f32x4*)(cw + j * NU + c0 + 4);
            const f32x4 b0 = *(const f32x4*)(cw + j * NU + DFF + c0), b1 = *(const f32x4*)(cw + j * NU + DFF + c0 + 4);
#pragma unroll
            for (int i = 0; i < 4; ++i) { wa[j][i] = a0[i]; wa[j][4 + i] = a1[i]; wb[j][i] = b0[i]; wb[j][4 + i] = b1[i]; }
        }
        float a2[8], a1[8], b2[8], b1[8];
        const bool samp = rg >= SROW0 / 32;
#pragma unroll
        for (int i = 0; i < 8; ++i) { a2[i] = a1[i] = b2[i] = b1[i] = 0.f; }
        if (!samp && (rg % (LPAD / 32)) != 0) {
            const bf16_t* h0 = HB + (size_t)(rg - 1) * 2 * NU;
            unpack8(*(const u32x4*)(h0 + c0), a2); unpack8(*(const u32x4*)(h0 + NU + c0), a1);
            unpack8(*(const u32x4*)(h0 + DFF + c0), b2); unpack8(*(const u32x4*)(h0 + NU + DFF + c0), b1);
        }
#pragma unroll 4
        for (int i = 0; i < 32; ++i) {
            const int row = rg * 32 + i;
            if (samp && (i & 3) == 0) {
                const float* st = p.st_fconv + ((size_t)(l * NS + ((row - SROW0) >> 2)) * 2) * NU;
                const f32x4 x0 = *(const f32x4*)(st + c0), x1 = *(const f32x4*)(st + c0 + 4), y0 = *(const f32x4*)(st + NU + c0), y1 = *(const f32x4*)(st + NU + c0 + 4);
                const f32x4 u0 = *(const f32x4*)(st + DFF + c0), u1 = *(const f32x4*)(st + DFF + c0 + 4), v0 = *(const f32x4*)(st + NU + DFF + c0), v1 = *(const f32x4*)(st + NU + DFF + c0 + 4);
#pragma unroll
                for (int e = 0; e < 4; ++e) { a2[e] = x0[e]; a2[4 + e] = x1[e]; a1[e] = y0[e]; a1[4 + e] = y1[e]; b2[e] = u0[e]; b2[4 + e] = u1[e]; b1[e] = v0[e]; b1[4 + e] = v1[e]; }
            }
            bf16_t* ur = U + (size_t)row * NU;
            float a[8], b[8], hh[8];
            unpack8(*(const u32x4*)(ur + c0), a); unpack8(*(const u32x4*)(ur + DFF + c0), b);
#pragma unroll
            for (int e = 0; e < 8; ++e) {
                const float ca = wa[0][e] * a2[e] + wa[1][e] * a1[e] + wa[2][e] * a[e];
                const float cb = wb[0][e] * b2[e] + wb[1][e] * b1[e] + wb[2][e] * b[e];
                hh[e] = ca * sigmoidf_(ca) * cb;
                a2[e] = a1[e]; a1[e] = a[e]; b2[e] = b1[e]; b1[e] = b[e];
            }
            u32x4 o; o.x = pk2(hh[0], hh[1]); o.y = pk2(hh[2], hh[3]); o.z = pk2(hh[4], hh[5]); o.w = pk2(hh[6], hh[7]);
            *(u32x4*)(ur + c0) = o;
        }
    }
}

#ifndef PROBE
#define PROBE 0
#endif
constexpr int NPHASE = 2 + DEPTH * 11;
__global__ void __launch_bounds__(NTHREADS) fwd_kernel(Params pin) {
    extern __shared__ __attribute__((aligned(16))) unsigned char smem_raw[];
    Params p = pin; p.wv = __builtin_amdgcn_readfirstlane((int)(threadIdx.x >> 6));
    unsigned* bar = (unsigned*)(p.ws + OFF_BAR); const unsigned xcc = xb_xcc_id();
    volatile LAS unsigned* xst = (volatile LAS unsigned*)(LAS unsigned char*)(smem_raw + LDS_GEMM);
    if (threadIdx.x == 0) { xst[0] = 0u; xst[1] = 0u; (void)xb_add(&bar[XB_XCNT(xcc)], 1u); }
    __syncthreads();
    float* lds = (float*)smem_raw;
    bf16_t* X = (bf16_t*)(p.ws + OFF_X); bf16_t* P = (bf16_t*)(p.ws + OFF_P); bf16_t* HB = (bf16_t*)(p.ws + OFF_HB);
    for (int ph = p.ph_lo; ph < p.ph_hi; ++ph) {
#if PROBE == 3
      for (int rep = 0; rep < 2; ++rep) { const int sx = ph < 2 ? -1 : (ph - 2) % 11; if (rep == 1 && !(ph < 2 || sx == 6 || sx == 10)) break;
#endif
        if (ph == 0) phase_weights(p, lds);
        else if (ph == 1) phase_ln(p, 0, nullptr, 0, p.ln_emb_g, p.ln_emb_b, 0, false);
        else {
            const int l = (ph - 2) / 11, s = (ph - 2) % 11;
            if (s == 0) { GemmArgs g{X, X, 1 << 30, D, w_inT(p, l), MROWS, NP, 1024}; gemm_phase(g, EpiP{P, (bf16_t*)(p.ws + OFF_GH), p.out, l}, p.wv); }
            else if (s == 1) phase_prep(p, l, lds);
            else if (s == 2) phase_scan(p, l, lds);
            else if (s == 3) phase_norm(p, l);
            else if (s == 4) { GemmArgs g{P + cO, P + cZ, 4, NP, w_abT(p, l), MROWS, 2048, 512}; gemm_phase(g, EpiMerge{P}, p.wv); }
            else if (s == 5) { GemmArgs g{P + cMG, P + cMG, 1 << 30, NP, w_outT(p, l), MROWS, 1024, 2048, 1}; gemm_phase(g, EpiRes{X, P, NP, 0, (bf16_t*)(p.ws + OFF_GH)}, p.wv); }
            else if (s == 6) phase_ln(p, 1, P, NP, p.ln1_g + l * D, p.ln1_b + l * D, -1, false);
            else if (s == 7) { GemmArgs g{X, X, 1 << 30, D, w_upT(p, l), MROWS, NU, 1024}; gemm_phase(g, EpiUp{P, HB, p.out, l}, p.wv); }
            else if (s == 8) phase_convact(p, l);
            else if (s == 9) { GemmArgs g{P, P, 1 << 30, NU, w_dnT(p, l), MROWS, 1024, DFF, 1}; gemm_phase(g, EpiRes{X, P, NU, DFF, (bf16_t*)(p.ws + OFF_GH)}, p.wv); }
            else phase_ln(p, 1, P + DFF, NU, p.ln2_g + l * D, p.ln2_b + l * D, l + 1 < DEPTH ? l + 1 : -1, l + 1 == DEPTH);
        }
#if PROBE == 3
      }
#endif
        if (ph + 1 < p.ph_hi) { if (ph == 0) cg::this_grid().sync(); else xcd_barrier(bar, xcc, xst, p.wv); }
    }
#if PROBE == 4
    for (int i = 0; i < 20; ++i) xcd_barrier(bar, xcc, xst, p.wv);
#endif
}

extern "C" void kernel_launch(void* const* d_in, const int* in_sizes, int n_in, void* d_out, int out_size, void* d_ws, size_t ws_size, hipStream_t stream) {
    static int grid = 0;
    if (grid == 0) {
        if (n_in != 28 || (size_t)out_size != o_end || ws_size < WS_END) { fprintf(stderr, "kernel_launch: unexpected sizes n_in %d out %d ws %zu (need %zu)\n", n_in, out_size, ws_size, (size_t)WS_END); grid = -1; return; }
        int dev = 0, cus = 0, per_cu = 0;
        hipGetDevice(&dev); hipDeviceGetAttribute(&cus, hipDeviceAttributeMultiprocessorCount, dev);
        if (hipFuncSetAttribute((const void*)fwd_kernel, hipFuncAttributeMaxDynamicSharedMemorySize, LDS_BYTES) != hipSuccess) { fprintf(stderr, "hipFuncSetAttribute failed\n"); grid = -1; return; }
        if (hipOccupancyMaxActiveBlocksPerMultiprocessor(&per_cu, (const void*)fwd_kernel, NTHREADS, LDS_BYTES) != hipSuccess || per_cu < 1) { fprintf(stderr, "occupancy query failed (%d)\n", per_cu); (void)hipGetLastError(); per_cu = 1; }
        grid = cus * per_cu;
        if (grid > 256) grid = 256;
    }
    if (grid < 0) return;
    if (hipMemsetAsync((unsigned char*)d_ws + OFF_BAR, 0, 16384, stream) != hipSuccess) { fprintf(stderr, "memset of barrier words failed\n"); return; }
    Params p{};
    const float** pp = (const float**)&p;
    for (int i = 0; i < 28; ++i) pp[i] = (const float*)d_in[i];
    p.out = (float*)d_out; p.ws = (unsigned char*)d_ws;
#if MULTI
    for (int ph = 0; ph < NPHASE; ++ph) { p.ph_lo = ph; p.ph_hi = ph + 1; hipLaunchKernelGGL(fwd_kernel, dim3(grid), dim3(NTHREADS), LDS_BYTES, stream, p); }
#else
    p.ph_lo = 0; p.ph_hi = NPHASE;
    void* args[] = {&p};
    hipError_t e = hipLaunchCooperativeKernel((const void*)fwd_kernel, dim3(grid), dim3(NTHREADS), args, LDS_BYTES, stream);
    if (e != hipSuccess) fprintf(stderr, "cooperative launch failed: %s (grid %d)\n", hipGetErrorString(e), grid);
#endif
}
```

```cpp
#include <hip/hip_runtime.h>
#include <hip/hip_cooperative_groups.h>
#include <cstdio>
namespace cg = cooperative_groups;

#ifndef MULTI
#define MULTI 0
#endif

typedef unsigned short bf16_t;
typedef short bf16x8 __attribute__((ext_vector_type(8)));
typedef float f32x4 __attribute__((ext_vector_type(4)));
typedef float f32x2 __attribute__((ext_vector_type(2)));
typedef unsigned u32x2 __attribute__((ext_vector_type(2)));
typedef unsigned u32x4 __attribute__((ext_vector_type(4)));

constexpr int D = 1024, NB = 8, LP = 2064, LPAD = 2080, NS = 128, LS = 4, DEPTH = 2, NMETA = 16, SEQ = 2048;
constexpr int MROWS = NB * LPAD + NS * LS;
constexpr int SROW0 = NB * LPAD;
constexpr int NIN = 6160, NP = 6144, DFF = 2816, NU = 5632;
constexpr int cQ = 0, cK = 512, cV = 1024, cO = 1536, cBQ = 2048, cBK = 2560, cBV = 3072, cZ = 3584, cMG = 4096;
constexpr float ALPHA = 1.4142135623730951f;
constexpr int SPLIT_ROW0 = 64 * 256;
constexpr int NTHREADS = 512;
constexpr int LDS_GEMM = 131072;
constexpr int LDS_BYTES = LDS_GEMM + 256;

constexpr size_t W_IN = (size_t)NP * 1024, W_AB = 2048 * 512, W_OUT = 1024 * 2048, W_UP = (size_t)NU * 1024, W_DN = (size_t)1024 * DFF;
constexpr size_t W_LAYER = W_IN + W_AB + W_OUT + W_UP + W_DN;
constexpr size_t OFF_W = 0;
constexpr size_t OFF_WG = OFF_W + DEPTH * W_LAYER * 2;
constexpr size_t OFF_X = OFF_WG + DEPTH * 16 * 1024 * 4;
constexpr size_t OFF_G = OFF_X + (size_t)MROWS * D * 2;
constexpr size_t OFF_HB = OFF_G + (size_t)MROWS * 16 * 4;
constexpr size_t OFF_P = OFF_HB + (size_t)(MROWS / 32) * 2 * NU * 2;
constexpr size_t OFF_GH = OFF_P + (size_t)MROWS * NP * 2;
constexpr size_t OFF_REC = OFF_GH + (size_t)(MROWS / 32) * 3 * 1536 * 2;
constexpr size_t OFF_BAR = OFF_REC + (size_t)MROWS * 4 * 16 * 4;
constexpr size_t OFF_TB = OFF_BAR + 16384;
constexpr size_t WS_END = OFF_TB + (size_t)(MROWS / 32) * 4 * 3 * 1024 * 2;

constexpr size_t o_yp = 0;
constexpr size_t o_ys = o_yp + (size_t)NB * SEQ * D;
constexpr size_t o_pC = o_ys + (size_t)NS * LS * D;
constexpr size_t o_pn = o_pC + (size_t)DEPTH * NB * 4 * 128 * 128;
constexpr size_t o_pm = o_pn + (size_t)DEPTH * NB * 4 * 128;
constexpr size_t o_pS = o_pm + (size_t)DEPTH * NB * 4;
constexpr size_t o_pgc = o_pS + (size_t)DEPTH * NB * 4 * 128 * 128;
constexpr size_t o_pfc = o_pgc + (size_t)DEPTH * NB * 3 * 1536;
constexpr size_t o_sC = o_pfc + (size_t)DEPTH * NB * 2 * NU;
constexpr size_t o_sn = o_sC + (size_t)DEPTH * NS * 4 * 128 * 128;
constexpr size_t o_sm = o_sn + (size_t)DEPTH * NS * 4 * 128;
constexpr size_t o_sS = o_sm + (size_t)DEPTH * NS * 4;
constexpr size_t o_sgc = o_sS + (size_t)DEPTH * NS * 4 * 128 * 128;
constexpr size_t o_sfc = o_sgc + (size_t)DEPTH * NS * 3 * 1536;
constexpr size_t o_end = o_sfc + (size_t)DEPTH * NS * 2 * NU;

struct Params {
    const float* x_prompt; const float* x_sample; const float* st_C; const float* st_n; const float* st_m; const float* st_S;
    const float* st_gconv; const float* st_fconv; const float* meta; const float* ln_emb_g; const float* ln_emb_b; const float* w_in;
    const float* gate_bias; const float* a_norm_w; const float* gconv_w; const float* A_log; const float* dt_bias; const float* b_norm_w;
    const float* w_pa; const float* w_pb; const float* w_out; const float* ln1_g; const float* ln1_b; const float* w_up;
    const float* fconv_w; const float* w_down; const float* ln2_g; const float* ln2_b;
    float* out; unsigned char* ws;
    int ph_lo, ph_hi;
    int wv, pad_;
};

__device__ __forceinline__ int opaque_tid(int wv) { int lane; asm volatile("v_mbcnt_lo_u32_b32 %0, -1, 0\n\tv_mbcnt_hi_u32_b32 %0, -1, %0" : "=v"(lane)); return wv * 64 + lane; }
__device__ __forceinline__ float bflo(unsigned u) { return __uint_as_float(u << 16); }
__device__ __forceinline__ float bfhi(unsigned u) { return __uint_as_float(u & 0xffff0000u); }
__device__ __forceinline__ unsigned pk2(float lo, float hi) { unsigned r; asm("v_cvt_pk_bf16_f32 %0, %1, %2" : "=v"(r) : "v"(lo), "v"(hi)); return r; }
template <int CTRL> __device__ __forceinline__ float dppf(float v) { return __int_as_float(__builtin_amdgcn_update_dpp(0, __float_as_int(v), CTRL, 0xf, 0xf, true)); }
__device__ __forceinline__ float red8(float v) { v += dppf<0xB1>(v); v += dppf<0x4E>(v); v += dppf<0x141>(v); return v; }
__device__ __forceinline__ float red16(float v) { v = red8(v); v += dppf<0x140>(v); return v; }
__device__ __forceinline__ float rdl(float v, int l) { return __int_as_float(__builtin_amdgcn_readlane(__float_as_int(v), l)); }
__device__ __forceinline__ float rdl_pin(float v, int l) { float r_; asm volatile("v_readlane_b32 %0, %1, %2" : "=s"(r_) : "v"(v), "s"(l)); return r_; }
__device__ __forceinline__ float red64(float v) { v = red16(v); return (rdl(v, 0) + rdl(v, 16)) + (rdl(v, 32) + rdl(v, 48)); }
__device__ __forceinline__ float sigmoidf_(float x) { return __builtin_amdgcn_rcpf(1.f + __expf(-x)); }
__device__ __forceinline__ u32x4 pack8(const float* y) { u32x4 o; o.x = pk2(y[0], y[1]); o.y = pk2(y[2], y[3]); o.z = pk2(y[4], y[5]); o.w = pk2(y[6], y[7]); return o; }
__device__ __forceinline__ void unpack8(u32x4 a, float* x) { x[0] = bflo(a.x); x[1] = bfhi(a.x); x[2] = bflo(a.y); x[3] = bfhi(a.y); x[4] = bflo(a.z); x[5] = bfhi(a.z); x[6] = bflo(a.w); x[7] = bfhi(a.w); }


#define XB_TMO      128
#define XB_XCNT(j)  (256  + 64 * (j))
#define XB_XSUB(j)  (1280 + 64 * (j))
#define XB_XGEN(j)  (2304 + 64 * (j))
#define XB_TOP      3328
#define XB_TOPGEN   3392
#define XCD_BAR_WORDS 3456
#define XB_SPIN_CAP (1u << 18)
#define LAS __attribute__((address_space(3)))
__device__ __forceinline__ unsigned xb_ld(unsigned* p)              { return __hip_atomic_load(p, __ATOMIC_RELAXED, __HIP_MEMORY_SCOPE_AGENT); }
__device__ __forceinline__ unsigned xb_add(unsigned* p, unsigned v) { return __hip_atomic_fetch_add(p, v, __ATOMIC_RELAXED, __HIP_MEMORY_SCOPE_AGENT); }
__device__ __forceinline__ unsigned xb_xcc_id() { return (unsigned)__builtin_amdgcn_s_getreg((3 << 11) | 20) & 0xFu; }
#define XB_SPIN(cond, bar) do { unsigned _sp = 0; while (cond) { __builtin_amdgcn_s_sleep(1); \
    if ((++_sp & 255u) == 0u) { if (xb_ld(&(bar)[XB_TMO])) break; if (_sp > XB_SPIN_CAP) { atomicAdd(&(bar)[XB_TMO], 1u); break; } } } } while (0)
__device__ __forceinline__ void xcd_barrier_complete(unsigned* bar, unsigned x, unsigned& nloc, unsigned& nx) {
    const unsigned G = gridDim.x;
    unsigned sum, cnt, mine, sp = 0u;
    for (;;) {
        sum = 0u; cnt = 0u; mine = 0u;
#pragma unroll
        for (unsigned j = 0; j < 16; ++j) { const unsigned c = xb_ld(&bar[XB_XCNT(j)]); sum += c; cnt += (c > 0u) ? 1u : 0u; mine = (j == x) ? c : mine; }
        if (sum == G) break;
        __builtin_amdgcn_s_sleep(1);
        if ((++sp & 255u) == 0u) { if (xb_ld(&bar[XB_TMO])) break; if (sp > XB_SPIN_CAP) { atomicAdd(&bar[XB_TMO], 1u); break; } }
    }
    nloc = mine > 0u ? mine : 1u; nx = cnt > 0u ? cnt : 1u;
}
__device__ __forceinline__ void xcd_barrier(unsigned* bar, unsigned x, volatile LAS unsigned* st, int wv) {
    asm volatile("s_waitcnt vmcnt(0)" ::: "memory");
    __syncthreads();
    if (opaque_tid(wv) == 0) {
        __builtin_amdgcn_s_waitcnt(0);
        unsigned nloc = st[0], nx = st[1];
        if (nloc == 0u) { xcd_barrier_complete(bar, x, nloc, nx); st[0] = nloc; st[1] = nx; }
        const unsigned old = xb_add(&bar[XB_XSUB(x)], 1u);
        const unsigned gen = old / nloc;
        if (old + 1u == (gen + 1u) * nloc) {
            __builtin_amdgcn_fence(__ATOMIC_RELEASE, "agent");
            asm volatile("s_waitcnt vmcnt(0)" ::: "memory");
            const unsigned og = xb_add(&bar[XB_TOP], 1u);
            const unsigned tg = og / nx;
            if (og + 1u == (tg + 1u) * nx) xb_add(&bar[XB_TOPGEN], 1u);
            else XB_SPIN(xb_ld(&bar[XB_TOPGEN]) == tg, bar);
            __builtin_amdgcn_fence(__ATOMIC_ACQUIRE, "agent");
            xb_add(&bar[XB_XGEN(x)], 1u);
            asm volatile("s_waitcnt vmcnt(0)" ::: "memory");
        } else {
            XB_SPIN(xb_ld(&bar[XB_XGEN(x)]) == gen, bar);
            __builtin_amdgcn_fence(__ATOMIC_ACQUIRE, "agent");
            asm volatile("s_waitcnt vmcnt(0)" ::: "memory");
        }
    }
    __syncthreads();
}

struct TJob { const float* src; int ldw; int K; int N; bf16_t* dst; int ldt; };
__device__ __forceinline__ void transpose_item(const TJob& jb, int item, float* scr, int lane) {
    const int nblk = jb.N / 32, kb = item / nblk, nb = item % nblk, k0 = 64 * kb, n0 = 32 * nb;
#pragma unroll 8
    for (int i = 0; i < 32; ++i) { const int kk = 2 * i + (lane >> 5); scr[kk * 33 + (lane & 31)] = jb.src[(size_t)(k0 + kk) * jb.ldw + n0 + (lane & 31)]; }
    __builtin_amdgcn_s_waitcnt(0xc07f); asm volatile("" ::: "memory");
    const int c = lane & 7;
#pragma unroll
    for (int j = 0; j < 4; ++j) { const int n = (lane >> 3) + 8 * j; const float* s = scr + (8 * c) * 33 + n;
        u32x4 o; o.x = pk2(s[0 * 33], s[1 * 33]); o.y = pk2(s[2 * 33], s[3 * 33]); o.z = pk2(s[4 * 33], s[5 * 33]); o.w = pk2(s[6 * 33], s[7 * 33]);
        *(u32x4*)(jb.dst + (size_t)(n0 + n) * jb.ldt + k0 + 8 * c) = o; }
    __builtin_amdgcn_s_waitcnt(0xc07f); asm volatile("" ::: "memory");
}
__device__ __forceinline__ bf16_t* wl(const Params& p, int l) { return (bf16_t*)(p.ws + OFF_W) + (size_t)l * W_LAYER; }
__device__ __forceinline__ bf16_t* w_inT(const Params& p, int l) { return wl(p, l); }
__device__ __forceinline__ bf16_t* w_abT(const Params& p, int l) { return wl(p, l) + W_IN; }
__device__ __forceinline__ bf16_t* w_outT(const Params& p, int l) { return wl(p, l) + W_IN + W_AB; }
__device__ __forceinline__ bf16_t* w_upT(const Params& p, int l) { return wl(p, l) + W_IN + W_AB + W_OUT; }
__device__ __forceinline__ bf16_t* w_dnT(const Params& p, int l) { return wl(p, l) + W_IN + W_AB + W_OUT + W_UP; }

__device__ __forceinline__ void phase_weights(const Params& p, float* lds) {
    const int tid = opaque_tid(p.wv); const int wave = tid >> 6, lane = tid & 63;
    float* scr = lds + wave * (64 * 33);
    const int gw = blockIdx.x * 8 + wave, NGW = gridDim.x * 8;
    constexpr int I0 = 16 * 64, I1 = 16 * 64, I2 = 16 * 64, I3 = 8 * 32, I4 = 8 * 32, I5 = 16 * 32, I6 = 16 * 32, I7 = 16 * (NU / 32), I8 = (DFF / 64) * 32;
    constexpr int IL = I0 + I1 + I2 + I3 + I4 + I5 + I6 + I7 + I8;
    for (int it = gw; it < DEPTH * IL; it += NGW) {
        const int l = it / IL; int r = it % IL;
        TJob jb;
        const float* win = p.w_in + (size_t)l * 1024 * NIN;
        if (r < I0) { jb = {win, NIN, 1024, 2048, w_inT(p, l), 1024}; }
        else if ((r -= I0) < I1) { jb = {win + 2056, NIN, 1024, 2048, w_inT(p, l) + (size_t)2048 * 1024, 1024}; }
        else if ((r -= I1) < I2) { jb = {win + 4112, NIN, 1024, 2048, w_inT(p, l) + (size_t)4096 * 1024, 1024}; }
        else if ((r -= I2) < I3) { jb = {p.w_pa + (size_t)l * 512 * 1024, 1024, 512, 1024, w_abT(p, l), 512}; }
        else if ((r -= I3) < I4) { jb = {p.w_pb + (size_t)l * 512 * 1024, 1024, 512, 1024, w_abT(p, l) + (size_t)1024 * 512, 512}; }
        else if ((r -= I4) < I5) { jb = {p.w_out + (size_t)l * 1024 * 1024, 1024, 1024, 1024, w_outT(p, l), 2048}; }
        else if ((r -= I5) < I6) { jb = {p.w_out + (size_t)l * 1024 * 1024, 1024, 1024, 1024, w_outT(p, l) + 1024, 2048}; }
        else if ((r -= I6) < I7) { jb = {p.w_up + (size_t)l * 1024 * NU, NU, 1024, NU, w_upT(p, l), 1024}; }
        else { r -= I7; jb = {p.w_down + (size_t)l * DFF * 1024, 1024, DFF, 1024, w_dnT(p, l), DFF}; }
        transpose_item(jb, r, scr, lane);
    }
    float* wg = (float*)(p.ws + OFF_WG);
    for (int i = blockIdx.x * NTHREADS + tid; i < DEPTH * 16 * 1024; i += gridDim.x * NTHREADS) {
        const int l = i >> 14, g = (i >> 10) & 15, k = i & 1023;
        const int col = g < 8 ? 2048 + g : 4104 + (g - 8);
        wg[i] = p.w_in[((size_t)l * 1024 + k) * NIN + col];
    }
}

__device__ __forceinline__ void phase_ln(const Params& p, int mode, const bf16_t* src, int ldsrc, const float* gam, const float* bet,
                                         int gate_layer  , bool final_out) {
    const int tid = opaque_tid(p.wv); const int wave = tid >> 6, lane = tid & 63;
    bf16_t* X = (bf16_t*)(p.ws + OFF_X);
#define EOFF(j) (512 * ((j) >> 1) + lane * 8 + 4 * ((j) & 1))
    float* G = (float*)(p.ws + OFF_G);
    const float* wg = (const float*)(p.ws + OFF_WG) + (size_t)(gate_layer < 0 ? 0 : gate_layer) * 16 * 1024;
    for (int row = blockIdx.x * 8 + wave; row < MROWS; row += gridDim.x * 8) {
        int b = 0, t = 0; bool samp = row >= SROW0;
        if (!samp) { b = row / LPAD; t = row - b * LPAD; } else { b = (row - SROW0) >> 2; t = row & 3; }
        const bool valid = samp || t < LP;
        bf16_t* xo = X + (size_t)row * D;
        if (!valid) { if (mode == 0) {
#pragma unroll
                for (int jj = 0; jj < 2; ++jj) *(u32x4*)(xo + 512 * jj + lane * 8) = (u32x4){0u, 0u, 0u, 0u}; }
            continue; }
        f32x4 v[4];
        if (mode == 0) {
            const float* s = samp ? p.x_sample + ((size_t)b * LS + t) * D : (t < NMETA ? p.meta + (size_t)t * D : p.x_prompt + ((size_t)b * SEQ + (t - NMETA)) * D);
#pragma unroll
            for (int j = 0; j < 4; ++j) v[j] = *(const f32x4*)(s + EOFF(j));
        } else {
            const bf16_t* s = src + (size_t)row * ldsrc;
#pragma unroll
            for (int jj = 0; jj < 2; ++jj) { const u32x4 u = *(const u32x4*)(s + 512 * jj + lane * 8); v[2 * jj] = (f32x4){bflo(u.x), bfhi(u.x), bflo(u.y), bfhi(u.y)}; v[2 * jj + 1] = (f32x4){bflo(u.z), bfhi(u.z), bflo(u.w), bfhi(u.w)}; }
            if (row >= SPLIT_ROW0) { const bf16_t* sp = (const bf16_t*)(p.ws + OFF_GH) + (size_t)(row - SPLIT_ROW0) * D;
#pragma unroll
                for (int q = 0; q < 3; ++q)
#pragma unroll
                    for (int jj = 0; jj < 2; ++jj) { const u32x4 u = *(const u32x4*)(sp + (size_t)q * (MROWS - SPLIT_ROW0) * D + 512 * jj + lane * 8); v[2 * jj] += (f32x4){bflo(u.x), bfhi(u.x), bflo(u.y), bfhi(u.y)}; v[2 * jj + 1] += (f32x4){bflo(u.z), bfhi(u.z), bflo(u.w), bfhi(u.w)}; } }
        }
        float sum = 0.f;
#pragma unroll
        for (int j = 0; j < 4; ++j) sum += (v[j][0] + v[j][1]) + (v[j][2] + v[j][3]);
        const float mean = red64(sum) * (1.f / D);
        float s2 = 0.f;
#pragma unroll
        for (int j = 0; j < 4; ++j) { v[j] = v[j] - mean; s2 += (v[j][0] * v[j][0] + v[j][1] * v[j][1]) + (v[j][2] * v[j][2] + v[j][3] * v[j][3]); }
        const float rstd = rsqrtf(red64(s2) * (1.f / D) + 1e-5f);
#pragma unroll
        for (int j = 0; j < 4; ++j) { const f32x4 g4 = *(const f32x4*)(gam + EOFF(j)), b4 = *(const f32x4*)(bet + EOFF(j)); v[j] = v[j] * rstd * g4 + b4; }
#pragma unroll
        for (int jj = 0; jj < 2; ++jj) *(u32x4*)(xo + 512 * jj + lane * 8) = (u32x4){pk2(v[2 * jj][0], v[2 * jj][1]), pk2(v[2 * jj][2], v[2 * jj][3]), pk2(v[2 * jj + 1][0], v[2 * jj + 1][1]), pk2(v[2 * jj + 1][2], v[2 * jj + 1][3])};
        if (final_out) {
            float* o = nullptr;
            if (samp) o = p.out + o_ys + ((size_t)b * LS + t) * D; else if (t >= NMETA) o = p.out + o_yp + ((size_t)b * SEQ + (t - NMETA)) * D;
            if (o) {
#pragma unroll
                for (int j = 0; j < 4; ++j) *(f32x4*)(o + EOFF(j)) = v[j]; }
        }
        if (gate_layer >= 0) {
            float mine = 0.f;
#pragma unroll 2
            for (int g = 0; g < 16; ++g) {
                float a = 0.f;
#pragma unroll
                for (int j = 0; j < 4; ++j) { const f32x4 w4 = *(const f32x4*)(wg + g * 1024 + EOFF(j)); a += (v[j][0] * w4[0] + v[j][1] * w4[1]) + (v[j][2] * w4[2] + v[j][3] * w4[3]); }
                a = red64(a);
                if (lane == g) mine = a;
            }
            if (lane < 16) G[(size_t)row * 16 + lane] = mine;
        }
    }
#undef EOFF
}

constexpr int BM = 256, BK = 64, HALF = 128, HT = HALF * BK, NXCD = 8, WGM = 8;
__device__ __forceinline__ int lds_byte(int r, int c) { int st = (r >> 4) * 2 + (c >> 5), rr = r & 15, cc = c & 31, ob = rr * 64 + cc * 2; return st * 1024 + (ob ^ (((ob >> 9) & 1) << 5)); }
__device__ __forceinline__ void stage_rc(int b, int& R, int& C) { int st = b / 1024, sb = b % 1024, swz = sb ^ (((sb >> 9) & 1) << 5); R = (st >> 1) * 16 + swz / 64; C = (st & 1) * 32 + (swz % 64) / 2; }

struct GemmArgs { const bf16_t* A; const bf16_t* A2; int a2_from_pn; int lda; const bf16_t* Bt; int M, N, K; int splitk; };

template <class Epi>
__device__ __forceinline__ void gemm_phase(const GemmArgs g, const Epi& epi, int wv) {
    extern __shared__ __attribute__((aligned(16))) unsigned char smem_raw[];
    bf16_t* shm = (bf16_t*)smem_raw;
#define SA(b, h) (shm + ((b) * 2 + (h)) * HT)
#define SB(b, h) (shm + (4 + (b) * 2 + (h)) * HT)
#define STAGE_A(P_, br, kt) do { const char* _gb = (const char*)(A + (size_t)(br) * lda + (size_t)((kt) + kofs) * BK); \
    unsigned _o0 = offA0, _o1 = offA1; asm volatile("" : "+v"(_o0), "+v"(_o1)); \
    __builtin_amdgcn_global_load_lds((const unsigned*)(_gb + _o0), (unsigned*)((char*)(P_) + tid * 16), 16, 0, 0); \
    __builtin_amdgcn_global_load_lds((const unsigned*)(_gb + _o1), (unsigned*)((char*)(P_) + tid * 16 + 8192), 16, 0, 0); } while (0)
#define STAGE_B(P_, bc, kt) do { const char* _gb = (const char*)(Bt + (size_t)(bc) * K + (size_t)((kt) + kofs) * BK); \
    unsigned _o0 = offB0, _o1 = offB1; asm volatile("" : "+v"(_o0), "+v"(_o1)); \
    __builtin_amdgcn_global_load_lds((const unsigned*)(_gb + _o0), (unsigned*)((char*)(P_) + tid * 16), 16, 0, 0); \
    __builtin_amdgcn_global_load_lds((const unsigned*)(_gb + _o1), (unsigned*)((char*)(P_) + tid * 16 + 8192), 16, 0, 0); } while (0)
#define LDA(dst, b, h) for (int m = 0; m < 4; ++m) for (int k = 0; k < 2; ++k) \
    dst[m][k] = *reinterpret_cast<const bf16x8*>((char*)SA(b, h) + lds_byte(wr * 64 + m * 16 + fr, k * 32 + fq * 8))
#define LDB(dst, b, h) for (int n = 0; n < 2; ++n) for (int k = 0; k < 2; ++k) \
    dst[n][k] = *reinterpret_cast<const bf16x8*>((char*)SB(b, h) + lds_byte(wc * 32 + n * 16 + fr, k * 32 + fq * 8))
#define MMA(ai, bj, At_, Bt_) do { __builtin_amdgcn_s_setprio(1); \
    for (int m = 0; m < 4; ++m) for (int n = 0; n < 2; ++n) for (int k = 0; k < 2; ++k) \
      acc[ai][bj][m][n] = __builtin_amdgcn_mfma_f32_16x16x32_bf16(Bt_[n][k], At_[m][k], acc[ai][bj][m][n], 0, 0, 0); \
    __builtin_amdgcn_s_setprio(0); } while (0)
#define WAIT_V(n) asm volatile("s_waitcnt vmcnt(" #n ")" ::: "memory")
#define WAIT_L(n) asm volatile("s_waitcnt lgkmcnt(" #n ")" ::: "memory")
#define BAR __builtin_amdgcn_s_barrier()
#define SCHED __builtin_amdgcn_sched_barrier(0)
    const int lda = g.lda, K = g.K; const bf16_t* Bt = g.Bt;
    const int nMall = g.M / BM, nN = g.N / BM, nM = g.splitk ? 64 : nMall, nwg = nM * nN, nunits = nwg + (nMall - nM) * nN * 4;
    const int tid = opaque_tid(wv);
    const int wid = tid >> 6, lane = tid & 63, wr = wid >> 2, wc = wid & 3, fr = lane & 15, fq = lane >> 4;
    const int ntK = K / BK;
    unsigned offA0, offA1, offB0, offB1;
    { int r0, c0, r1, c1; stage_rc(tid * 16, r0, c0); stage_rc(tid * 16 + 8192, r1, c1);
      offA0 = (unsigned)(r0 * lda + c0) * 2u; offA1 = (unsigned)(r1 * lda + c1) * 2u;
      const int p0 = (r0 & ~31) + 8 * ((r0 & 15) >> 2) + 4 * ((r0 >> 4) & 1) + (r0 & 3), p1 = (r1 & ~31) + 8 * ((r1 & 15) >> 2) + 4 * ((r1 >> 4) & 1) + (r1 & 3);
      offB0 = (unsigned)(p0 * K + c0) * 2u; offB1 = (unsigned)(p1 * K + c1) * 2u; }
    for (int Lt = blockIdx.x; Lt < nunits; Lt += gridDim.x) {
        int pm, pn, kofs = 0, nt = ntK, split = 0;
        if (Lt < nwg) {
            int wgid = Lt;
            { int q = nwg / NXCD, r = nwg % NXCD, xcd = wgid % NXCD, off = wgid / NXCD; wgid = (xcd < r ? xcd * (q + 1) : r * (q + 1) + (xcd - r) * q) + off; }
            const int nig = WGM * nN, gid = wgid / nig, fm = gid * WGM, gsz = min(nM - fm, WGM);
            pm = fm + ((wgid % nig) % gsz); pn = (wgid % nig) / gsz;
        } else {
            const int u = Lt - nwg, tl = u >> 2; split = u & 3; pm = nM + tl / nN; pn = tl % nN;
            const int q4 = ntK >> 2;
            if (q4 & 1) { nt = split < 2 ? q4 + 1 : q4 - 1; kofs = split < 2 ? split * (q4 + 1) : 2 * (q4 + 1) + (split - 2) * (q4 - 1); } else { nt = q4; kofs = split * q4; }
        }
        const int brow = pm * BM, bcol = pn * BM;
        const bf16_t* A = (pn >= g.a2_from_pn) ? g.A2 : g.A;
        f32x4 acc[2][2][4][2] = {};
        bf16x8 At[4][2], B0[2][2], B1[2][2];
        STAGE_B(SB(0, 0), bcol, 0); STAGE_A(SA(0, 0), brow, 0);
        STAGE_B(SB(0, 1), bcol + HALF, 0); STAGE_A(SA(0, 1), brow + HALF, 0);
        if (wr == 1) BAR;
        WAIT_V(4); BAR;
        STAGE_B(SB(1, 0), bcol, 1); STAGE_A(SA(1, 0), brow, 1); STAGE_B(SB(1, 1), bcol + HALF, 1);
        WAIT_V(6); BAR;
        for (int t = 0; t < nt - 2; t += 2) {
            LDB(B0, 0, 0); SCHED; LDA(At, 0, 0); STAGE_A(SA(1, 1), brow + HALF, t + 1);
            WAIT_L(8); BAR; WAIT_L(0); MMA(0, 0, At, B0); BAR; SCHED;
            LDB(B1, 0, 1); STAGE_B(SB(0, 0), bcol, t + 2);
            BAR; WAIT_L(0); MMA(0, 1, At, B1); BAR;
            LDA(At, 0, 1); STAGE_A(SA(0, 0), brow, t + 2);
            BAR; WAIT_L(0); MMA(1, 0, At, B0); BAR; SCHED;
            STAGE_B(SB(0, 1), bcol + HALF, t + 2);
            WAIT_V(6); BAR; MMA(1, 1, At, B1); BAR;
            LDB(B0, 1, 0); SCHED; LDA(At, 1, 0); STAGE_A(SA(0, 1), brow + HALF, t + 2);
            WAIT_L(8); BAR; WAIT_L(0); MMA(0, 0, At, B0); BAR; SCHED;
            LDB(B1, 1, 1); STAGE_B(SB(1, 0), bcol, t + 3);
            BAR; WAIT_L(0); MMA(0, 1, At, B1); BAR;
            LDA(At, 1, 1); STAGE_A(SA(1, 0), brow, t + 3);
            BAR; WAIT_L(0); MMA(1, 0, At, B0); BAR; SCHED;
            STAGE_B(SB(1, 1), bcol + HALF, t + 3);
            WAIT_V(6); BAR; MMA(1, 1, At, B1); BAR;
        }
        { LDB(B0, 0, 0); LDA(At, 0, 0); STAGE_A(SA(1, 1), brow + HALF, nt - 1);
          BAR; WAIT_L(0); MMA(0, 0, At, B0); BAR;
          LDB(B1, 0, 1); BAR; WAIT_L(0); MMA(0, 1, At, B1); BAR;
          LDA(At, 0, 1); WAIT_V(4); BAR; WAIT_L(0); MMA(1, 0, At, B0); MMA(1, 1, At, B1); BAR; }
        { LDB(B0, 1, 0); LDA(At, 1, 0); WAIT_V(2); BAR; WAIT_L(0); MMA(0, 0, At, B0); BAR;
          LDB(B1, 1, 1); WAIT_V(0); BAR; WAIT_L(0); MMA(0, 1, At, B1); BAR;
          LDA(At, 1, 1); BAR; WAIT_L(0); MMA(1, 0, At, B0); MMA(1, 1, At, B1); BAR; }
        if (wr == 0) BAR;
        int erow = brow + wr * 64 + fr, ecol = bcol + wc * 32 + fq * 8;
        asm volatile("" : "+v"(erow), "+v"(ecol));
#pragma unroll
        for (int ai = 0; ai < 2; ++ai)
#pragma unroll
            for (int m = 0; m < 4; ++m) {
                const int row = erow + ai * HALF + m * 16;
#pragma unroll
                for (int bj = 0; bj < 2; ++bj) epi(row, ecol + bj * HALF, acc[ai][bj][m][0], acc[ai][bj][m][1], split);
                if (m & 1) SCHED;
            }
    }
#undef SA
#undef SB
}

struct EpiP {
    bf16_t* P; bf16_t* GH; float* out; int l;
    __device__ __forceinline__ void operator()(int row, int col, f32x4 v, f32x4 w, int split) const {
        const u32x4 o = (u32x4){pk2(v[0], v[1]), pk2(v[2], v[3]), pk2(w[0], w[1]), pk2(w[2], w[3])};
        *(u32x4*)(P + (size_t)row * NP + col) = o;
        if (col >= cBQ && col < cZ) {
            const int c = col - cBQ;
            if ((row & 31) >= 29) *(u32x4*)(GH + ((size_t)(row >> 5) * 3 + ((row & 31) - 29)) * 1536 + c) = o;
            if (row < SROW0) { const int b = row / LPAD, t = row - b * LPAD; if (t >= LP - 3 && t < LP) { float* d = out + o_pgc + ((size_t)(l * NB + b) * 3 + (t - (LP - 3))) * 1536 + c; *(f32x4*)d = v; *(f32x4*)(d + 4) = w; } }
            else { const int s = (row - SROW0) >> 2, t = row & 3; if (t >= 1) { float* d = out + o_sgc + ((size_t)(l * NS + s) * 3 + (t - 1)) * 1536 + c; *(f32x4*)d = v; *(f32x4*)(d + 4) = w; } }
        }
    }
};
struct EpiMerge {
    bf16_t* P;
    __device__ __forceinline__ void operator()(int row, int col, f32x4 v, f32x4 w, int split) const {
        u32x4* ptr = (u32x4*)(P + (size_t)row * NP + cMG + col); const u32x4 gm = *ptr;
        v[0] *= sigmoidf_(bflo(gm.x)); v[1] *= sigmoidf_(bfhi(gm.x)); v[2] *= sigmoidf_(bflo(gm.y)); v[3] *= sigmoidf_(bfhi(gm.y));
        w[0] *= sigmoidf_(bflo(gm.z)); w[1] *= sigmoidf_(bfhi(gm.z)); w[2] *= sigmoidf_(bflo(gm.w)); w[3] *= sigmoidf_(bfhi(gm.w));
        *ptr = (u32x4){pk2(v[0], v[1]), pk2(v[2], v[3]), pk2(w[0], w[1]), pk2(w[2], w[3])};
    }
};
struct EpiRes {
    const bf16_t* X; bf16_t* O; int ldo; int ocol0; bf16_t* SCR;
    __device__ __forceinline__ void operator()(int row, int col, f32x4 v, f32x4 w, int split) const {
        if (split == 0) {
            const u32x4 x = *(const u32x4*)(X + (size_t)row * D + col);
            v[0] += ALPHA * bflo(x.x); v[1] += ALPHA * bfhi(x.x); v[2] += ALPHA * bflo(x.y); v[3] += ALPHA * bfhi(x.y);
            w[0] += ALPHA * bflo(x.z); w[1] += ALPHA * bfhi(x.z); w[2] += ALPHA * bflo(x.w); w[3] += ALPHA * bfhi(x.w);
            *(u32x4*)(O + (size_t)row * ldo + ocol0 + col) = (u32x4){pk2(v[0], v[1]), pk2(v[2], v[3]), pk2(w[0], w[1]), pk2(w[2], w[3])};
        } else *(u32x4*)(SCR + ((size_t)(split - 1) * (MROWS - SPLIT_ROW0) + (row - SPLIT_ROW0)) * D + col) = (u32x4){pk2(v[0], v[1]), pk2(v[2], v[3]), pk2(w[0], w[1]), pk2(w[2], w[3])};
    }
};
struct EpiUp {
    bf16_t* U; bf16_t* HB; float* out; int l;
    __device__ __forceinline__ void operator()(int row, int col, f32x4 v, f32x4 w, int split) const {
        const u32x4 o = (u32x4){pk2(v[0], v[1]), pk2(v[2], v[3]), pk2(w[0], w[1]), pk2(w[2], w[3])};
        *(u32x4*)(U + (size_t)row * NU + col) = o;
        if ((row & 31) >= 30) *(u32x4*)(HB + ((size_t)(row >> 5) * 2 + (row & 1)) * NU + col) = o;
        if (row < SROW0) { const int b = row / LPAD, t = row - b * LPAD; if (t >= LP - 2 && t < LP) { float* d = out + o_pfc + ((size_t)(l * NB + b) * 2 + (t - (LP - 2))) * NU + col; *(f32x4*)d = v; *(f32x4*)(d + 4) = w; } }
        else { const int s = (row - SROW0) >> 2, t = row & 3; if (t >= 2) { float* d = out + o_sfc + ((size_t)(l * NS + s) * 2 + (t - 2)) * NU + col; *(f32x4*)d = v; *(f32x4*)(d + 4) = w; } }
    }
};

constexpr int SBUF = 32 * 128 * 2 + 32 * 32 + 32 * 16;
__device__ __forceinline__ float* QB(float* lds, int b) { return lds + b * SBUF; }
__device__ __forceinline__ float* KB(float* lds, int b) { return lds + b * SBUF + 4096; }
__device__ __forceinline__ float* VB(float* lds, int b) { return lds + b * SBUF + 8192; }
__device__ __forceinline__ float* SCB(float* lds, int b) { return lds + b * SBUF + 9216; }
__device__ __forceinline__ float* OB(float* lds, int b) { return lds + 2 * SBUF + b * 1024; }

__device__ __forceinline__ void store_out_blk(bf16_t* P, int row0, int jb, int L, int pcol, const float* ob, int ptid) {
    const int tt = ptid >> 3, g = ptid & 7, t0 = jb * 32;
    if (t0 + tt < L) { const f32x4 v = *(const f32x4*)(ob + tt * 32 + g * 4);
        *(u32x2*)(P + (size_t)(row0 + t0 + tt) * NP + pcol + g * 4) = (u32x2){pk2(v[0], v[1]), pk2(v[2], v[3])}; }
}
__device__ __forceinline__ f32x2 lo2(f32x4 v) { return __builtin_shufflevector(v, v, 0, 1); }
__device__ __forceinline__ f32x2 hi2(f32x4 v) { return __builtin_shufflevector(v, v, 2, 3); }
__device__ __forceinline__ f32x2 bc2(float x) { return (f32x2){x, x}; }
__device__ __forceinline__ float dot16(const f32x4* a, const float* kp) {
    float s = 0.f;
#pragma unroll
    for (int i = 0; i < 4; ++i) { const f32x4 b = *(const f32x4*)(kp + 4 * i); s += (a[i][0] * b[0] + a[i][1] * b[1]) + (a[i][2] * b[2] + a[i][3] * b[3]); }
    return s;
}

struct StageRegs { f32x4 &q0, &q1, &k0, &k1, &v, &r0, &x0, &x1; };
__device__ __forceinline__ f32x4 asf(u32x4 u) { return __builtin_bit_cast(f32x4, u); }
__device__ __forceinline__ u32x4 asu(f32x4 f) { return __builtin_bit_cast(u32x4, f); }
#define BARRIER_LDS() asm volatile("s_waitcnt lgkmcnt(0)\n\ts_barrier" ::: "memory")
__device__ __forceinline__ void issue_mlstm(const Params& p, int h, int qtr, int row0, int L, int jb, int ptid, StageRegs& r) {
    const bf16_t* P = (const bf16_t*)(p.ws + OFF_P); const float* G = (const float*)(p.ws + OFF_G);
    const int tt = ptid >> 3, g = ptid & 7, t0 = jb * 32;
    if (t0 + tt >= L) return;
    const int row = row0 + t0 + tt;
    const bf16_t* prow = P + (size_t)row * NP;
    r.q0 = asf(*(const u32x4*)(prow + cQ + h * 128 + g * 16)); r.q1 = asf(*(const u32x4*)(prow + cQ + h * 128 + g * 16 + 8));
    r.k0 = asf(*(const u32x4*)(prow + cK + h * 128 + g * 16)); r.k1 = asf(*(const u32x4*)(prow + cK + h * 128 + g * 16 + 8));
    { const u32x2 vv_ = *(const u32x2*)(prow + cV + h * 128 + qtr * 32 + g * 4); r.v = asf((u32x4){vv_.x, vv_.y, 0u, 0u}); }
    if (g == 0) { const float* gr = G + (size_t)row * 16; r.r0 = (f32x4){gr[h], gr[4 + h], 0.f, 0.f}; }
}
__device__ __forceinline__ void commit_mlstm(const Params& p, int l, int h, int L, int jb, float* lds, int ptid, const StageRegs& r, int bsel = -1) {
    const int tt = ptid >> 3, g = ptid & 7, t0 = jb * 32, b = bsel >= 0 ? bsel : (jb & 1);
    if (t0 + tt >= L) return;
    float x[16]; f32x4 qs[4];
    unpack8(asu(r.q0), x); unpack8(asu(r.q1), x + 8);
    float* qd = QB(lds, b) + tt * 128 + g * 16;
#pragma unroll
    for (int i = 0; i < 4; ++i) { qs[i] = (f32x4){x[4 * i], x[4 * i + 1], x[4 * i + 2], x[4 * i + 3]} * 0.08838834764831845f; *(f32x4*)(qd + 4 * i) = qs[i]; }
    unpack8(asu(r.k0), x); unpack8(asu(r.k1), x + 8);
    float* kd = KB(lds, b) + tt * 128 + g * 16;
#pragma unroll
    for (int i = 0; i < 4; ++i) *(f32x4*)(kd + 4 * i) = (f32x4){x[4 * i], x[4 * i + 1], x[4 * i + 2], x[4 * i + 3]};
    *(f32x4*)(VB(lds, b) + tt * 32 + g * 4) = (f32x4){bflo(asu(r.v).x), bfhi(asu(r.v).x), bflo(asu(r.v).y), bfhi(asu(r.v).y)};
    const float* kmb = KB(lds, b) + (tt & ~3) * 128 + g * 16;
    f32x4 qk;
#pragma unroll
    for (int j = 0; j < 4; ++j) qk[j] = red8(dot16(qs, kmb + j * 128));
    if (g == 0) {
        const float ig = r.r0[0] + p.gate_bias[l * 8 + h], f = r.r0[1] + p.gate_bias[l * 8 + 4 + h];
        const float lf = fminf(f, 0.f) - log1pf(__expf(-fabsf(f)));
        float* sc = SCB(lds, b) + tt * 16; *(f32x2*)sc = (f32x2){ig, lf}; *(f32x4*)(sc + 4) = qk; }
}

__device__ __forceinline__ void scan_mlstm(const Params& p, int l, bool samp, int bs, int h, int qtr, int row0, int L, float* lds) {
    const int tid = opaque_tid(p.wv); const bool cons = tid < 256; const int ptid = tid - 256;
    const int lane = tid & 63, w = (tid >> 6) & 3, s = lane & 7, cl = w * 8 + (lane >> 3), col = qtr * 32 + cl;
    const int e2 = 2 * (lane >> 3), nd = (e2 >> 2) * 32 + s * 4 + (e2 & 3);
    bf16_t* P = (bf16_t*)(p.ws + OFF_P);
    f32x2 C[8]; float n0v = 0.f, n1v = 0.f, m = 0.f;
#pragma unroll
    for (int e = 0; e < 8; ++e) C[e] = bc2(0.f);
    if (cons && samp) {
        const size_t sh = (size_t)(l * NS + bs) * 4 + h;
        const float* C0 = p.st_C + sh * 16384;
#pragma unroll
        for (int e = 0; e < 16; ++e) { const int d = (e >> 2) * 32 + s * 4 + (e & 3); C[e >> 1][e & 1] = C0[d * 128 + col]; }
        n0v = p.st_n[sh * 128 + nd]; n1v = p.st_n[sh * 128 + nd + 1]; m = p.st_m[sh];
    }
    const int nblk = (L + 31) >> 5;
    f32x4 k4[4][4];
    StageRegs sr{k4[0][0], k4[0][1], k4[0][2], k4[0][3], k4[1][0], k4[1][1], k4[1][2], k4[1][3]};
    if (!cons) { issue_mlstm(p, h, qtr, row0, L, 0, ptid, sr); commit_mlstm(p, l, h, L, 0, lds, ptid, sr); if (1 < nblk) issue_mlstm(p, h, qtr, row0, L, 1, ptid, sr); }
    BARRIER_LDS();
    for (int jb = 0; jb < nblk; ++jb) {
        if (!cons) {
            if (jb + 1 < nblk) commit_mlstm(p, l, h, L, jb + 1, lds, ptid, sr);
            if (jb + 2 < nblk) issue_mlstm(p, h, qtr, row0, L, jb + 2, ptid, sr);
            if (jb > 0) store_out_blk(P, row0, jb - 1, L, cV + h * 128 + qtr * 32, OB(lds, (jb - 1) & 1), ptid);
        } else {
            const float* qb = QB(lds, jb & 1); const float* kb = KB(lds, jb & 1); const float* vb = VB(lds, jb & 1); const float* sc = SCB(lds, jb & 1);
            float* ob = OB(lds, jb & 1);
            const int nt = min(32, L - jb * 32);
            f32x4 q4[4][4]; f32x2 kn[4], qn[4]; float vv[4], ig[4], lf[4]; f32x4 qk[4];
#define MLOAD_Q(T0) do { _Pragma("unroll") for (int i = 0; i < 4; ++i) { const int t = (T0) + i; \
        _Pragma("unroll") for (int j = 0; j < 4; ++j) q4[i][j] = *(const f32x4*)(qb + t * 128 + j * 32 + s * 4); \
        qn[i] = *(const f32x2*)(qb + t * 128 + nd); } } while (0)
#define MLOAD_K(T0) do { _Pragma("unroll") for (int i = 0; i < 4; ++i) { const int t = (T0) + i; \
        const f32x2 gg = *(const f32x2*)(sc + t * 16); ig[i] = gg[0]; lf[i] = gg[1]; \
        qk[i] = *(const f32x4*)(sc + t * 16 + 4); vv[i] = vb[t * 32 + cl]; } \
      _Pragma("unroll") for (int i = 0; i < 4; ++i) { const int t = (T0) + i; \
        _Pragma("unroll") for (int j = 0; j < 4; ++j) k4[i][j] = *(const f32x4*)(kb + t * 128 + j * 32 + s * 4); \
        kn[i] = *(const f32x2*)(kb + t * 128 + nd); } } while (0)
            MLOAD_Q(0); MLOAD_K(0);
#pragma unroll 1
            for (int t0 = 0; t0 < nt; t0 += 4) {
                float d[4], dn[4];
                const int tn = min(t0 + 4, 28);
                __builtin_amdgcn_sched_barrier(0);
#pragma unroll
                for (int i = 0; i < 4; ++i) {
                    f32x2 a = bc2(0.f), a2 = bc2(0.f);
#pragma unroll
                    for (int j = 0; j < 4; ++j) { a = lo2(q4[i][j]) * C[2 * j] + a; a2 = hi2(q4[i][j]) * C[2 * j + 1] + a2; }
                    a = a + a2;
                    d[i] = a[0] + a[1]; dn[i] = qn[i][0] * n0v + qn[i][1] * n1v;
                }
                __builtin_amdgcn_sched_barrier(0);
                MLOAD_Q(tn);
                __builtin_amdgcn_sched_barrier(0);
#pragma unroll
                for (int i = 0; i < 4; ++i) { d[i] = red8(d[i]); dn[i] = red64(dn[i]); }
                float fp[4], ip[4], em[4];
#pragma unroll
                for (int i = 0; i < 4; ++i) { const float mn = fmaxf(lf[i] + m, ig[i]); fp[i] = __expf(lf[i] + m - mn); ip[i] = __expf(ig[i] - mn); em[i] = __expf(-mn); m = mn; }
                const float F0 = fp[0], F1 = F0 * fp[1], F2 = F1 * fp[2], F3 = F2 * fp[3];
                const float g00 = ip[0], g10 = g00 * fp[1], g11 = ip[1], g20 = g10 * fp[2], g21 = g11 * fp[2], g22 = ip[2];
                const float g30 = g20 * fp[3], g31 = g21 * fp[3], g32 = g22 * fp[3], g33 = ip[3];
                const float s00 = g00 * qk[0][0];
                const float s10 = g10 * qk[1][0], s11 = g11 * qk[1][1];
                const float s20 = g20 * qk[2][0], s21 = g21 * qk[2][1], s22 = g22 * qk[2][2];
                const float s30 = g30 * qk[3][0], s31 = g31 * qk[3][1], s32 = g32 * qk[3][2], s33 = g33 * qk[3][3];
                const float num0 = F0 * d[0] + s00 * vv[0], den0 = F0 * dn[0] + s00;
                const float num1 = F1 * d[1] + s10 * vv[0] + s11 * vv[1], den1 = F1 * dn[1] + s10 + s11;
                const float num2 = F2 * d[2] + s20 * vv[0] + s21 * vv[1] + s22 * vv[2], den2 = F2 * dn[2] + s20 + s21 + s22;
                const float num3 = F3 * d[3] + s30 * vv[0] + s31 * vv[1] + s32 * vv[2] + s33 * vv[3], den3 = F3 * dn[3] + s30 + s31 + s32 + s33;
                if (s == 0) {
                    ob[(t0 + 0) * 32 + cl] = num0 / fmaxf(fabsf(den0), em[0]); ob[(t0 + 1) * 32 + cl] = num1 / fmaxf(fabsf(den1), em[1]);
                    ob[(t0 + 2) * 32 + cl] = num2 / fmaxf(fabsf(den2), em[2]); ob[(t0 + 3) * 32 + cl] = num3 / fmaxf(fabsf(den3), em[3]);
                }
                const float c0 = g30 * vv[0], c1 = g31 * vv[1], c2 = g32 * vv[2], c3 = g33 * vv[3];
#pragma unroll
                for (int j = 0; j < 4; ++j) {
                    C[2 * j] = lo2(k4[3][j]) * bc2(c3) + (lo2(k4[2][j]) * bc2(c2) + (lo2(k4[1][j]) * bc2(c1) + (lo2(k4[0][j]) * bc2(c0) + C[2 * j] * bc2(F3))));
                    C[2 * j + 1] = hi2(k4[3][j]) * bc2(c3) + (hi2(k4[2][j]) * bc2(c2) + (hi2(k4[1][j]) * bc2(c1) + (hi2(k4[0][j]) * bc2(c0) + C[2 * j + 1] * bc2(F3)))); }
                n0v = n0v * F3 + (kn[0][0] * g30 + kn[1][0] * g31) + (kn[2][0] * g32 + kn[3][0] * g33);
                n1v = n1v * F3 + (kn[0][1] * g30 + kn[1][1] * g31) + (kn[2][1] * g32 + kn[3][1] * g33);
                __builtin_amdgcn_sched_barrier(0);
                MLOAD_K(tn);
            }
#undef MLOAD_Q
#undef MLOAD_K
        }
        BARRIER_LDS();
    }
    if (!cons) store_out_blk(P, row0, nblk - 1, L, cV + h * 128 + qtr * 32, OB(lds, (nblk - 1) & 1), ptid);
    else {
        const size_t sh = samp ? (size_t)(l * NS + bs) * 4 + h : (size_t)(l * NB + bs) * 4 + h;
        float* Co = p.out + (samp ? o_sC : o_pC) + sh * 16384;
#pragma unroll
        for (int e = 0; e < 16; ++e) { const int d = (e >> 2) * 32 + s * 4 + (e & 3); Co[d * 128 + col] = C[e >> 1][e & 1]; }
        if (qtr == 0 && w == 0) { float* no = p.out + (samp ? o_sn : o_pn) + sh * 128; no[nd] = n0v; no[nd + 1] = n1v;
            if (lane == 0) p.out[(samp ? o_sm : o_pm) + sh] = m; }
    }
    BARRIER_LDS();
}


constexpr int ST_LD = 33;
__device__ __forceinline__ float* STB(float* lds, int b) { return lds + 2 * SBUF + 2048 + b * (128 * ST_LD); }
__device__ __forceinline__ void st_issue(const float* S0, int qtr, int ptid, f32x4& a0, f32x4& a1, f32x4& a2, f32x4& a3) {
    const int d = ptid >> 3, c = (ptid & 7) * 4; const float* b = S0 + d * 128 + qtr * 32 + c;
    a0 = *(const f32x4*)b; a1 = *(const f32x4*)(b + 32 * 128); a2 = *(const f32x4*)(b + 64 * 128); a3 = *(const f32x4*)(b + 96 * 128);
}
__device__ __forceinline__ void st_commit(float* st, int ptid, const f32x4& a0, const f32x4& a1, const f32x4& a2, const f32x4& a3) {
    const int d = ptid >> 3, c = (ptid & 7) * 4; float* b = st + d * ST_LD + c;
#pragma unroll
    for (int i = 0; i < 4; ++i) { b[i] = a0[i]; b[32 * ST_LD + i] = a1[i]; b[64 * ST_LD + i] = a2[i]; b[96 * ST_LD + i] = a3[i]; }
}
__device__ __forceinline__ void st_store(float* So, int qtr, const float* st, int ptid) {
    const int d = ptid >> 3, c = (ptid & 7) * 4; const float* b = st + d * ST_LD + c; float* o = So + d * 128 + qtr * 32 + c;
#pragma unroll
    for (int q = 0; q < 4; ++q) *(f32x4*)(o + q * 32 * 128) = (f32x4){b[q * 32 * ST_LD], b[q * 32 * ST_LD + 1], b[q * 32 * ST_LD + 2], b[q * 32 * ST_LD + 3]};
}
__device__ __forceinline__ void scan_mlstm_stream(const Params& p, int l, int h, int qtr, int bs0, int nseq, float* lds) {
    const int tid = opaque_tid(p.wv); const bool cons = tid < 256; const int ptid = tid - 256;
    const int lane = tid & 63, w = (tid >> 6) & 3, s = lane & 7, cl = w * 8 + (lane >> 3), col = qtr * 32 + cl;
    const int e2 = 2 * (lane >> 3), nd = (e2 >> 2) * 32 + s * 4 + (e2 & 3);
    bf16_t* P = (bf16_t*)(p.ws + OFF_P);
    f32x2 C[8]; float n0v = 0.f, n1v = 0.f, m = 0.f, n0n = 0.f, n1n = 0.f, mnx = 0.f;
#pragma unroll
    for (int e = 0; e < 8; ++e) C[e] = bc2(0.f);
    f32x4 k4[4][4];
    StageRegs sr{k4[0][0], k4[0][1], k4[0][2], k4[0][3], k4[1][0], k4[1][1], k4[1][2], k4[1][3]};
#define LOADSTATE(BS) do { const size_t sh_ = (size_t)(l * NS + (BS)) * 4 + h; n0n = p.st_n[sh_ * 128 + nd]; n1n = p.st_n[sh_ * 128 + nd + 1]; mnx = p.st_m[sh_]; } while (0)
#define STISSUE(BS) st_issue(p.st_C + ((size_t)(l * NS + (BS)) * 4 + h) * 16384, qtr, ptid, k4[2][0], k4[2][1], k4[2][2], k4[2][3])
    if (!cons) { issue_mlstm(p, h, qtr, SROW0 + bs0 * 4, LS, 0, ptid, sr); STISSUE(bs0); } else LOADSTATE(bs0);
#pragma unroll 1
    for (int k = 0; k < nseq; ++k) {
        const int bs = bs0 + 8 * k, row0 = SROW0 + bs * 4;
        if (!cons) { commit_mlstm(p, l, h, LS, 0, lds, ptid, sr, k & 1); st_commit(STB(lds, k & 1), ptid, k4[2][0], k4[2][1], k4[2][2], k4[2][3]);
            if (k + 1 < nseq) { issue_mlstm(p, h, qtr, row0 + 32, LS, 0, ptid, sr); STISSUE(bs + 8); } }
        else {
            n0v = n0n; n1v = n1n; m = mnx;
            if (k + 1 < nseq) LOADSTATE(bs + 8);
        }
        BARRIER_LDS();
        if (!cons) { if (k > 0) { store_out_blk(P, row0 - 32, 0, LS, cV + h * 128 + qtr * 32, OB(lds, (k - 1) & 1), ptid); st_store(p.out + o_sC + ((size_t)(l * NS + bs - 8) * 4 + h) * 16384, qtr, STB(lds, (k - 1) & 1), ptid); } }
        else {
            const float* qb = QB(lds, k & 1); const float* kb = KB(lds, k & 1); const float* vb = VB(lds, k & 1); const float* sc = SCB(lds, k & 1);
            float* ob = OB(lds, k & 1); float* stb = STB(lds, k & 1);
#pragma unroll
            for (int e = 0; e < 16; ++e) { const int d = (e >> 2) * 32 + s * 4 + (e & 3); C[e >> 1][e & 1] = stb[d * ST_LD + cl]; }
            f32x4 q4[4][4]; f32x2 kn[4], qn[4]; float vv[4], ig[4], lf[4]; f32x4 qk[4];
#define MLOAD_Q(T0) do { _Pragma("unroll") for (int i = 0; i < 4; ++i) { const int t = (T0) + i; \
        _Pragma("unroll") for (int j = 0; j < 4; ++j) q4[i][j] = *(const f32x4*)(qb + t * 128 + j * 32 + s * 4); \
        qn[i] = *(const f32x2*)(qb + t * 128 + nd); } } while (0)
#define MLOAD_K(T0) do { _Pragma("unroll") for (int i = 0; i < 4; ++i) { const int t = (T0) + i; \
        const f32x2 gg = *(const f32x2*)(sc + t * 16); ig[i] = gg[0]; lf[i] = gg[1]; \
        qk[i] = *(const f32x4*)(sc + t * 16 + 4); vv[i] = vb[t * 32 + cl]; } \
      _Pragma("unroll") for (int i = 0; i < 4; ++i) { const int t = (T0) + i; \
        _Pragma("unroll") for (int j = 0; j < 4; ++j) k4[i][j] = *(const f32x4*)(kb + t * 128 + j * 32 + s * 4); \
        kn[i] = *(const f32x2*)(kb + t * 128 + nd); } } while (0)
            MLOAD_Q(0); MLOAD_K(0);
            {
                float d[4], dn[4];
                __builtin_amdgcn_sched_barrier(0);
#pragma unroll
                for (int i = 0; i < 4; ++i) {
                    f32x2 a = bc2(0.f), a2 = bc2(0.f);
#pragma unroll
                    for (int j = 0; j < 4; ++j) { a = lo2(q4[i][j]) * C[2 * j] + a; a2 = hi2(q4[i][j]) * C[2 * j + 1] + a2; }
                    a = a + a2;
                    d[i] = a[0] + a[1]; dn[i] = qn[i][0] * n0v + qn[i][1] * n1v;
                }
                __builtin_amdgcn_sched_barrier(0);
#pragma unroll
                for (int i = 0; i < 4; ++i) { d[i] = red8(d[i]); dn[i] = red64(dn[i]); }
                float fp[4], ip[4], em[4];
#pragma unroll
                for (int i = 0; i < 4; ++i) { const float mn = fmaxf(lf[i] + m, ig[i]); fp[i] = __expf(lf[i] + m - mn); ip[i] = __expf(ig[i] - mn); em[i] = __expf(-mn); m = mn; }
                const float F0 = fp[0], F1 = F0 * fp[1], F2 = F1 * fp[2], F3 = F2 * fp[3];
                const float g00 = ip[0], g10 = g00 * fp[1], g11 = ip[1], g20 = g10 * fp[2], g21 = g11 * fp[2], g22 = ip[2];
                const float g30 = g20 * fp[3], g31 = g21 * fp[3], g32 = g22 * fp[3], g33 = ip[3];
                const float s00 = g00 * qk[0][0];
                const float s10 = g10 * qk[1][0], s11 = g11 * qk[1][1];
                const float s20 = g20 * qk[2][0], s21 = g21 * qk[2][1], s22 = g22 * qk[2][2];
                const float s30 = g30 * qk[3][0], s31 = g31 * qk[3][1], s32 = g32 * qk[3][2], s33 = g33 * qk[3][3];
                const float num0 = F0 * d[0] + s00 * vv[0], den0 = F0 * dn[0] + s00;
                const float num1 = F1 * d[1] + s10 * vv[0] + s11 * vv[1], den1 = F1 * dn[1] + s10 + s11;
                const float num2 = F2 * d[2] + s20 * vv[0] + s21 * vv[1] + s22 * vv[2], den2 = F2 * dn[2] + s20 + s21 + s22;
                const float num3 = F3 * d[3] + s30 * vv[0] + s31 * vv[1] + s32 * vv[2] + s33 * vv[3], den3 = F3 * dn[3] + s30 + s31 + s32 + s33;
                if (s == 0) {
                    ob[0 * 32 + cl] = num0 / fmaxf(fabsf(den0), em[0]); ob[1 * 32 + cl] = num1 / fmaxf(fabsf(den1), em[1]);
                    ob[2 * 32 + cl] = num2 / fmaxf(fabsf(den2), em[2]); ob[3 * 32 + cl] = num3 / fmaxf(fabsf(den3), em[3]);
                }
                const float c0 = g30 * vv[0], c1 = g31 * vv[1], c2 = g32 * vv[2], c3 = g33 * vv[3];
#pragma unroll
                for (int j = 0; j < 4; ++j) {
                    C[2 * j] = lo2(k4[3][j]) * bc2(c3) + (lo2(k4[2][j]) * bc2(c2) + (lo2(k4[1][j]) * bc2(c1) + (lo2(k4[0][j]) * bc2(c0) + C[2 * j] * bc2(F3))));
                    C[2 * j + 1] = hi2(k4[3][j]) * bc2(c3) + (hi2(k4[2][j]) * bc2(c2) + (hi2(k4[1][j]) * bc2(c1) + (hi2(k4[0][j]) * bc2(c0) + C[2 * j + 1] * bc2(F3)))); }
                n0v = n0v * F3 + (kn[0][0] * g30 + kn[1][0] * g31) + (kn[2][0] * g32 + kn[3][0] * g33);
                n1v = n1v * F3 + (kn[0][1] * g30 + kn[1][1] * g31) + (kn[2][1] * g32 + kn[3][1] * g33);
            }
#undef MLOAD_Q
#undef MLOAD_K
            const size_t sh = (size_t)(l * NS + bs) * 4 + h;
#pragma unroll
            for (int e = 0; e < 16; ++e) { const int d = (e >> 2) * 32 + s * 4 + (e & 3); stb[d * ST_LD + cl] = C[e >> 1][e & 1]; }
            if (qtr == 0 && w == 0) { float* no = p.out + o_sn + sh * 128; no[nd] = n0v; no[nd + 1] = n1v; if (lane == 0) p.out[o_sm + sh] = m; }
        }
    }
    BARRIER_LDS();
    if (!cons) { store_out_blk(P, SROW0 + (bs0 + 8 * (nseq - 1)) * 4, 0, LS, cV + h * 128 + qtr * 32, OB(lds, (nseq - 1) & 1), ptid); st_store(p.out + o_sC + ((size_t)(l * NS + bs0 + 8 * (nseq - 1)) * 4 + h) * 16384, qtr, STB(lds, (nseq - 1) & 1), ptid); }
    BARRIER_LDS();
#undef LOADSTATE
#undef STISSUE
}


typedef float f32x16 __attribute__((ext_vector_type(16)));
#define MFMA32(a, b, c) __builtin_amdgcn_mfma_f32_32x32x16_bf16((a), (b), (c), 0, 0, 0)
__device__ __forceinline__ int crow(int reg, int hf) { return (reg & 3) + 8 * (reg >> 2) + 4 * hf; }
__device__ __forceinline__ bf16x8 pack_step(const f32x16& x, int s) {
    u32x4 pk;
    asm volatile("s_nop 7\n\ts_nop 3\n\tv_cvt_pk_bf16_f32 %0, %4, %5\n\tv_cvt_pk_bf16_f32 %1, %6, %7\n\tv_cvt_pk_bf16_f32 %2, %8, %9\n\tv_cvt_pk_bf16_f32 %3, %10, %11\n\ts_nop 1"
                 : "=&v"(pk[0]), "=&v"(pk[1]), "=&v"(pk[2]), "=&v"(pk[3])
                 : "v"(x[8 * s]), "v"(x[8 * s + 1]), "v"(x[8 * s + 2]), "v"(x[8 * s + 3]), "v"(x[8 * s + 4]), "v"(x[8 * s + 5]), "v"(x[8 * s + 6]), "v"(x[8 * s + 7]));
    return __builtin_bit_cast(bf16x8, pk);
}
__device__ __forceinline__ bf16x8 frag_n(const bf16_t* base, int ld, int r, int hf, int kb) { return *(const bf16x8*)(base + r * ld + kb * 16 + hf * 8); }
__device__ __forceinline__ bf16x8 frag_p(const bf16_t* base, int ld, int r, int hf, int k0) {
    const u32x2 a = *(const u32x2*)(base + r * ld + k0 + 4 * hf), b = *(const u32x2*)(base + r * ld + k0 + 8 + 4 * hf);
    return __builtin_bit_cast(bf16x8, (u32x4){a.x, a.y, b.x, b.y});
}
__device__ __forceinline__ int kto(int d) { return d * 40 + (d >> 4) * 8; }
__device__ __forceinline__ bf16_t f2bf(float x) { return (bf16_t)(pk2(x, 0.f) & 0xffffu); }

constexpr int CH_LDQ = 136, CH_LDS = 40;
constexpr int CH_QB = 0, CH_KB = 8704, CH_KWT = 17408, CH_VT = 27904, CH_SW = 33024, CH_SC = 35584, CH_QW = 36608, CH_SLOT = 45312, CH_OB = 2 * CH_SLOT;
constexpr int SC_U = 0, SC_B = 32, SC_PM = 64;

__device__ __forceinline__ void store_out_norm(bf16_t* P, int row0, int jb, int L, int pcol, const float* ob, const float* rd, int ptid) {
    const int tt = ptid >> 3, g = ptid & 7, t0 = jb * 32;
    if (t0 + tt < L) { const f32x4 v = *(const f32x4*)(ob + tt * 32 + g * 4) * rd[tt];
        *(u32x2*)(P + (size_t)(row0 + t0 + tt) * NP + pcol + g * 4) = (u32x2){pk2(v[0], v[1]), pk2(v[2], v[3])}; }
}
__device__ __forceinline__ void issue_mlstm_chunk(const Params& p, int h, int qtr, int row0, int L, int nch, int jb, int ptid, StageRegs& r) {
    if (jb >= nch) return;
    const bf16_t* P = (const bf16_t*)(p.ws + OFF_P); const float* REC = (const float*)(p.ws + OFF_REC);
    const int tt = ptid >> 3, g = ptid & 7, t0 = jb * 32;
    const int row = row0 + t0 + tt;
    if (g == 0) r.r0 = *(const f32x4*)(REC + ((size_t)row * 4 + h) * 16 + 4);
    if (t0 + tt >= L) return;
    const bf16_t* prow = P + (size_t)row * NP;
    r.q0 = asf(*(const u32x4*)(prow + cQ + h * 128 + g * 16)); r.q1 = asf(*(const u32x4*)(prow + cQ + h * 128 + g * 16 + 8));
    r.k0 = asf(*(const u32x4*)(prow + cK + h * 128 + g * 16)); r.k1 = asf(*(const u32x4*)(prow + cK + h * 128 + g * 16 + 8));
    { const u32x2 vv_ = *(const u32x2*)(prow + cV + h * 128 + qtr * 32 + g * 4); r.v = asf((u32x4){vv_.x, vv_.y, 0u, 0u}); }
}

__device__ __forceinline__ void scan_mlstm_chunk(const Params& p, int l, int bs, int h, int qtr, int row0, int L, unsigned char* lb) {
    const int tid = opaque_tid(p.wv); const int wave = tid >> 6, lane = tid & 63, r = lane & 31, hf = lane >> 5, ptid = tid - 256;
    bf16_t* P = (bf16_t*)(p.ws + OFF_P);
    const int nch = (L + 31) >> 5;
    f32x16 C[4];
    const int ct = wave == 3 ? 1 : 0;
#pragma unroll
    for (int dt = 0; dt < 4; ++dt)
#pragma unroll
        for (int i = 0; i < 16; ++i) C[dt][i] = 0.f;
    float m0 = 0.f;
    f32x4 s0, s1, s2, s3, s4, s5, s6, s7; StageRegs sr{s0, s1, s2, s3, s4, s5, s6, s7};
    if (wave >= 4) { for (int i = ptid; i < 2 * 32 * CH_LDS; i += 256) { const int sl = i / (32 * CH_LDS), e = i % (32 * CH_LDS);
            ((bf16_t*)(lb + sl * CH_SLOT + CH_VT))[32 * CH_LDS + e] = (e < CH_LDS) ? (bf16_t)0x3f80 : (bf16_t)0; } }
#define CH_P1(JN) do { const int jn_ = (JN); unsigned char* sl_ = lb + (jn_ & 1) * CH_SLOT; const int tt = ptid >> 3, g = ptid & 7; const bool val_ = jn_ * 32 + tt < L; \
        u32x4 q0_ = asu(sr.q0), q1_ = asu(sr.q1), k0_ = asu(sr.k0), k1_ = asu(sr.k1); u32x4 v_ = asu(sr.v); \
        if (!val_) { q0_ = q1_ = k0_ = k1_ = v_ = (u32x4){0u, 0u, 0u, 0u}; } \
        *(u32x4*)(sl_ + CH_QB + (tt * CH_LDQ + g * 16) * 2) = q0_; *(u32x4*)(sl_ + CH_QB + (tt * CH_LDQ + g * 16 + 8) * 2) = q1_; \
        *(u32x4*)(sl_ + CH_KB + (tt * CH_LDQ + g * 16) * 2) = k0_; *(u32x4*)(sl_ + CH_KB + (tt * CH_LDQ + g * 16 + 8) * 2) = k1_; \
        bf16_t* vt_ = (bf16_t*)(sl_ + CH_VT); \
        vt_[(g * 4 + 0) * CH_LDS + tt] = (bf16_t)(v_.x & 0xffffu); vt_[(g * 4 + 1) * CH_LDS + tt] = (bf16_t)(v_.x >> 16); \
        vt_[(g * 4 + 2) * CH_LDS + tt] = (bf16_t)(v_.y & 0xffffu); vt_[(g * 4 + 3) * CH_LDS + tt] = (bf16_t)(v_.y >> 16); \
        if (g == 0) { float* sc_ = (float*)(sl_ + CH_SC); sc_[SC_U + tt] = sr.r0[0]; sc_[SC_B + tt] = sr.r0[1]; sc_[SC_PM + tt] = sr.r0[2]; } \
        issue_mlstm_chunk(p, h, qtr, row0, L, nch, jn_ + 1, ptid, sr); } while (0)
#define CH_P2(JN) do { unsigned char* sl_ = lb + ((JN) & 1) * CH_SLOT; const float* sc_ = (const float*)(sl_ + CH_SC); \
        const float bT_ = sc_[SC_B + 31], mT_ = bT_ + fmaxf(m0, sc_[SC_PM + 31]); \
        if (wave == 1) { f32x16 a_; _Pragma("unroll") for (int i = 0; i < 16; ++i) a_[i] = 0.f; \
            _Pragma("unroll") for (int kb = 0; kb < 8; ++kb) a_ = MFMA32(frag_n((const bf16_t*)(sl_ + CH_QB), CH_LDQ, r, hf, kb), frag_n((const bf16_t*)(sl_ + CH_KB), CH_LDQ, r, hf, kb), a_); \
            bf16_t* sw_ = (bf16_t*)(sl_ + CH_SW); const float us_ = sc_[SC_U + r]; \
            _Pragma("unroll") for (int i4 = 0; i4 < 4; ++i4) { const f32x4 pm4 = *(const f32x4*)(sc_ + SC_PM + 8 * i4 + 4 * hf); \
                _Pragma("unroll") for (int ii = 0; ii < 4; ++ii) { const int t = 8 * i4 + 4 * hf + ii; const float w_ = (r <= t) ? __expf(us_ - fmaxf(m0, pm4[ii])) * 0.08838834764831845f : 0.f; \
                    sw_[t * CH_LDS + r] = f2bf(a_[4 * i4 + ii] * w_); } } } \
        else if (wave >= 4) { const int tt = ptid >> 3, g = ptid & 7; \
            const float wi_ = __expf(m0 - fmaxf(m0, sc_[SC_PM + tt])) * 0.08838834764831845f, ws_ = __expf(sc_[SC_U + tt] + bT_ - mT_); float x_[16]; \
            u32x4* qp_ = (u32x4*)(sl_ + CH_QB + (tt * CH_LDQ + g * 16) * 2); unpack8(qp_[0], x_); unpack8(qp_[1], x_ + 8); \
            _Pragma("unroll") for (int i = 0; i < 16; ++i) x_[i] *= wi_; \
            u32x4* qo_ = (u32x4*)(sl_ + CH_QW + (tt * CH_LDQ + g * 16) * 2); qo_[0] = pack8(x_); qo_[1] = pack8(x_ + 8); \
            const u32x4* kp_ = (const u32x4*)(sl_ + CH_KB + (tt * CH_LDQ + g * 16) * 2); unpack8(kp_[0], x_); unpack8(kp_[1], x_ + 8); \
            bf16_t* kw_ = (bf16_t*)(sl_ + CH_KWT); \
            _Pragma("unroll") for (int i = 0; i < 16; ++i) kw_[kto(g * 16) + i * CH_LDS + tt] = f2bf(x_[i] * ws_); } \
        if (wave == 1 || wave >= 4) m0 = mT_; } while (0)
    if (wave >= 4) { issue_mlstm_chunk(p, h, qtr, row0, L, nch, 0, ptid, sr); CH_P1(0); }
    BARRIER_LDS();
    CH_P2(0);
    BARRIER_LDS();
#pragma unroll 1
    for (int j = 0; j < nch; ++j) {
        if (wave == 0 || wave == 3) {
            const unsigned char* sl = lb + (j & 1) * CH_SLOT; const float* sc = (const float*)(sl + CH_SC);
            const bf16_t* qw = (const bf16_t*)(sl + CH_QW); const bf16_t* sw = (const bf16_t*)(sl + CH_SW); const bf16_t* vt = (const bf16_t*)(sl + CH_VT) + ct * 32 * CH_LDS; const bf16_t* kwt = (const bf16_t*)(sl + CH_KWT);
            const float bT = sc[SC_B + 31], mT = bT + fmaxf(m0, sc[SC_PM + 31]);
            f32x16 H;
#pragma unroll
            for (int i = 0; i < 16; ++i) H[i] = 0.f;
#pragma unroll
            for (int dt = 0; dt < 4; ++dt)
#pragma unroll
                for (int u = 0; u < 2; ++u) H = MFMA32(frag_p(qw, CH_LDQ, r, hf, 32 * dt + 16 * u), pack_step(C[dt], u), H);
            bf16x8 vb[2];
#pragma unroll
            for (int kb = 0; kb < 2; ++kb) { vb[kb] = frag_n(vt, CH_LDS, r, hf, kb); H = MFMA32(frag_n(sw, CH_LDS, r, hf, kb), vb[kb], H); }
            const float wold = __expf(bT - mT + m0);
#pragma unroll
            for (int dt = 0; dt < 4; ++dt) {
#pragma unroll
                for (int i = 0; i < 16; ++i) C[dt][i] *= wold;
#pragma unroll
                for (int kb = 0; kb < 2; ++kb) C[dt] = MFMA32(frag_n(kwt + kto(dt * 32 + r), 0, 0, hf, kb), vb[kb], C[dt]);
            }
            float* ob = (float*)(lb + CH_OB) + (j & 1) * 1024; float* rd = (float*)(lb + CH_OB + 8192) + (j & 1) * 32;
            if (ct == 0) {
#pragma unroll
                for (int i = 0; i < 16; ++i) ob[crow(i, hf) * 32 + r] = H[i];
            } else if (r == 0) {
#pragma unroll
                for (int i = 0; i < 16; ++i) { const int t = crow(i, hf); rd[t] = __builtin_amdgcn_rcpf(fmaxf(fabsf(H[i]), __expf(-(sc[SC_B + t] + fmaxf(m0, sc[SC_PM + t]))))); }
            }
            m0 = mT;
        } else if (wave >= 4) {
            if (j + 1 < nch) CH_P1(j + 1);
            if (j > 0) store_out_norm(P, row0, j - 1, L, cV + h * 128 + qtr * 32, (const float*)(lb + CH_OB) + ((j - 1) & 1) * 1024, (const float*)(lb + CH_OB + 8192) + ((j - 1) & 1) * 32, ptid);
        }
        BARRIER_LDS();
        if (j + 1 < nch) CH_P2(j + 1);
        BARRIER_LDS();
    }
    if (wave >= 4) store_out_norm(P, row0, nch - 1, L, cV + h * 128 + qtr * 32, (const float*)(lb + CH_OB) + ((nch - 1) & 1) * 1024, (const float*)(lb + CH_OB + 8192) + ((nch - 1) & 1) * 32, ptid);
    const size_t sh = (size_t)(l * NB + bs) * 4 + h;
    if (wave == 0) {
        float* Co = p.out + o_pC + sh * 16384;
#pragma unroll
        for (int dt = 0; dt < 4; ++dt)
#pragma unroll
            for (int i = 0; i < 16; ++i) Co[(32 * dt + crow(i, hf)) * 128 + qtr * 32 + r] = C[dt][i];
        if (lane == 0 && qtr == 0) p.out[o_pm + sh] = m0;
    } else if (wave == 3 && r == 0 && qtr == 0) {
#pragma unroll
        for (int dt = 0; dt < 4; ++dt)
#pragma unroll
            for (int i = 0; i < 16; ++i) p.out[o_pn + sh * 128 + 32 * dt + crow(i, hf)] = C[dt][i];
    }
    __syncthreads();
#undef CH_P1
#undef CH_P2
}

__device__ __forceinline__ void gdn_raw8(const bf16_t* P, int r0, int tr, int pcol, const bf16_t* gh, const float* st, int hch, float* x) {
    if (tr >= 0) unpack8(*(const u32x4*)(P + (size_t)(r0 + tr) * NP + pcol), x);
    else if (gh) unpack8(*(const u32x4*)(gh + (3 + tr) * 1536 + hch), x);
    else if (st) { const float* hp = st + (3 + tr) * 1536 + hch; const f32x4 a = *(const f32x4*)hp, b = *(const f32x4*)(hp + 4);
        x[0] = a[0]; x[1] = a[1]; x[2] = a[2]; x[3] = a[3]; x[4] = b[0]; x[5] = b[1]; x[6] = b[2]; x[7] = b[3]; }
    else {
#pragma unroll
        for (int i = 0; i < 8; ++i) x[i] = 0.f; }
}
__device__ __forceinline__ void gdn_conv8(const bf16_t* P, int r0, int tr, int pcol, const bf16_t* gh, const float* st, int hch, const float* cw, float* y) {
#pragma unroll
    for (int i = 0; i < 8; ++i) y[i] = 0.f;
#pragma unroll
    for (int j = 0; j < 4; ++j) { float x[8]; gdn_raw8(P, r0, tr - 3 + j, pcol, gh, st, hch, x);
        const f32x4 w0 = *(const f32x4*)(cw + j * 1536 + hch), w1 = *(const f32x4*)(cw + j * 1536 + hch + 4);
        y[0] += x[0] * w0[0]; y[1] += x[1] * w0[1]; y[2] += x[2] * w0[2]; y[3] += x[3] * w0[3];
        y[4] += x[4] * w1[0]; y[5] += x[5] * w1[1]; y[6] += x[6] * w1[2]; y[7] += x[7] * w1[3]; }
#pragma unroll
    for (int i = 0; i < 8; ++i) y[i] = y[i] * sigmoidf_(y[i]);
}

__device__ __forceinline__ void phase_prep(const Params& p, int l, float* lds) {
    const int tid = opaque_tid(p.wv); const int half = tid >> 8, t = tid & 255, tt = t >> 3, g = t & 7, wq = t >> 6, lane = t & 63, r = lane & 31, hf = lane >> 5;
    bf16_t* P = (bf16_t*)(p.ws + OFF_P); const bf16_t* GH = (const bf16_t*)(p.ws + OFF_GH);
    const float* G = (const float*)(p.ws + OFF_G); float* REC = (float*)(p.ws + OFF_REC); bf16_t* TB = (bf16_t*)(p.ws + OFF_TB);
    const float* cw = p.gconv_w + (size_t)l * 4 * 1536;
    float* ksc = lds + half * 4096;
    unsigned char* pl = (unsigned char*)lds + 32768 + half * 22016;
    bf16_t* kimg = (bf16_t*)pl; bf16_t* qimg = (bf16_t*)(pl + 8704); float* am = (float*)(pl + 17408); float* sgl = (float*)(pl + 21504); float* sbe = sgl + 32; float* sG = sgl + 64;
    constexpr int NITEM = (MROWS / 32) * 4;
    for (int base = blockIdx.x * 2; base < NITEM; base += gridDim.x * 2) {
        const int item = base + half; const bool act = item < NITEM;
        const int rb = item >> 2, h = item & 3, r0 = rb * 32;
        const bool samp = rb >= SROW0 / 32;
        int tr = tt; const bf16_t* gh = nullptr; const float* st = nullptr; int rbase = r0; bool valid = act;
        if (!samp) { const int jb = rb % (LPAD / 32); if (jb * 32 + tt >= LP) valid = false; if (jb > 0) gh = GH + (size_t)(rb - 1) * 3 * 1536; }
        else { const int sq = (rb - SROW0 / 32) * 8 + (tt >> 2); tr = tt & 3; rbase = r0 + (tt & ~3); st = p.st_gconv + (size_t)(l * NS + sq) * 3 * 1536; }
        const int ch = h * 128 + g * 16;
        u32x4 oq0 = (u32x4){0u, 0u, 0u, 0u}, oq1 = oq0, ok0 = oq0, ok1 = oq0, ov0 = oq0, ov1 = oq0;
        float ga = 0.f, gb = 0.f, gg = 0.f;
        if (valid) {
            float y[16];
            gdn_conv8(P, rbase, tr, cBV + ch, gh, st, 1024 + ch, cw, y); gdn_conv8(P, rbase, tr, cBV + ch + 8, gh, st, 1024 + ch + 8, cw, y + 8);
            ov0 = pack8(y); ov1 = pack8(y + 8);
            __builtin_amdgcn_sched_barrier(0);
            gdn_conv8(P, rbase, tr, cBQ + ch, gh, st, ch, cw, y); gdn_conv8(P, rbase, tr, cBQ + ch + 8, gh, st, ch + 8, cw, y + 8);
            float ss = 0.f;
#pragma unroll
            for (int i = 0; i < 16; ++i) ss += y[i] * y[i];
            float rs = rsqrtf(red8(ss) + 1e-6f) * 0.08838834764831845f;
#pragma unroll
            for (int i = 0; i < 16; ++i) y[i] *= rs;
            oq0 = pack8(y); oq1 = pack8(y + 8);
            __builtin_amdgcn_sched_barrier(0);
            gdn_conv8(P, rbase, tr, cBK + ch, gh, st, 512 + ch, cw, y); gdn_conv8(P, rbase, tr, cBK + ch + 8, gh, st, 512 + ch + 8, cw, y + 8);
            ss = 0.f;
#pragma unroll
            for (int i = 0; i < 16; ++i) ss += y[i] * y[i];
            rs = rsqrtf(red8(ss) + 1e-6f);
#pragma unroll
            for (int i = 0; i < 16; ++i) y[i] *= rs;
            ok0 = pack8(y); ok1 = pack8(y + 8);
            unpack8(ok0, y); unpack8(ok1, y + 8);
#pragma unroll
            for (int i = 0; i < 4; ++i) *(f32x4*)(ksc + tt * 128 + g * 16 + 4 * i) = (f32x4){y[4 * i], y[4 * i + 1], y[4 * i + 2], y[4 * i + 3]};
            if (g == 0) { const float* gr = G + (size_t)(r0 + tt) * 16;
                gb = sigmoidf_(gr[8 + h]);
                const float xa = gr[12 + h] + p.dt_bias[l * 4 + h];
                const float sp = fmaxf(xa, 0.f) + log1pf(__expf(-fabsf(xa)));
                gg = -__expf(p.A_log[l * 4 + h]) * sp; ga = __expf(gg); }
        }
        if (!samp) {
            *(u32x4*)(kimg + tt * CH_LDQ + g * 16) = ok0; *(u32x4*)(kimg + tt * CH_LDQ + g * 16 + 8) = ok1;
            *(u32x4*)(qimg + tt * CH_LDQ + g * 16) = oq0; *(u32x4*)(qimg + tt * CH_LDQ + g * 16 + 8) = oq1;
            if (g == 0) { sgl[tt] = gg; sbe[tt] = gb; }
        }
        __syncthreads();
        f32x16 pacc;
#pragma unroll
        for (int i = 0; i < 16; ++i) pacc[i] = 0.f;
        float myG = 0.f, totG = 0.f;
        if (valid) {
            bf16_t* pr = P + (size_t)(r0 + tt) * NP;
            *(u32x4*)(pr + cBQ + ch) = oq0; *(u32x4*)(pr + cBQ + ch + 8) = oq1; *(u32x4*)(pr + cBK + ch) = ok0; *(u32x4*)(pr + cBK + ch + 8) = ok1;
            *(u32x4*)(pr + cBV + ch) = ov0; *(u32x4*)(pr + cBV + ch + 8) = ov1;
        }
        if (samp) {
            if (valid) {
                const float* kmb = ksc + (tt & ~3) * 128 + g * 16;
                f32x4 qk, kk, qs[4], ks[4];
                { float y[16]; unpack8(oq0, y); unpack8(oq1, y + 8);
#pragma unroll
                  for (int i = 0; i < 4; ++i) qs[i] = (f32x4){y[4 * i], y[4 * i + 1], y[4 * i + 2], y[4 * i + 3]};
                  unpack8(ok0, y); unpack8(ok1, y + 8);
#pragma unroll
                  for (int i = 0; i < 4; ++i) ks[i] = (f32x4){y[4 * i], y[4 * i + 1], y[4 * i + 2], y[4 * i + 3]}; }
#pragma unroll
                for (int j = 0; j < 4; ++j) { qk[j] = red8(dot16(qs, kmb + j * 128)); kk[j] = red8(dot16(ks, kmb + j * 128)); }
                if (g == 0) { float* rec = REC + ((size_t)(r0 + tt) * 4 + h) * 16; *(f32x4*)rec = (f32x4){ga, gb, gg, 0.f}; *(f32x4*)(rec + 4) = qk; *(f32x4*)(rec + 8) = kk; }
            }
        } else if (act) {
            if (wq < 2) {
                const bf16_t* ai = wq == 0 ? kimg : qimg;
#pragma unroll
                for (int kb = 0; kb < 8; ++kb) pacc = MFMA32(frag_n(ai, CH_LDQ, r, hf, kb), frag_n(kimg, CH_LDQ, r, hf, kb), pacc);
            } else if (wq == 2) {
                const float gm = sgl[r]; float cum = 0.f;
#pragma unroll
                for (int t2 = 0; t2 < 32; ++t2) { cum += rdl(gm, t2); if (r == t2) myG = cum; }
                totG = cum;
                if (lane < 32) sG[r] = myG;
                if (lane == 0) sG[32] = cum;
            }
        }
        __syncthreads();
        if (!samp && act) {
            bf16_t* tb = TB + (size_t)item * 3072;
            if (wq == 0) {
                const float Gs_ = sG[r]; float* ag = (float*)tb;
#pragma unroll
                for (int i4 = 0; i4 < 4; ++i4) { const f32x4 G4 = *(const f32x4*)(sG + 8 * i4 + 4 * hf), b4 = *(const f32x4*)(sbe + 8 * i4 + 4 * hf);
#pragma unroll
                    for (int ii = 0; ii < 4; ++ii) { const int t2 = 8 * i4 + 4 * hf + ii; ag[t2 * 32 + r] = (r < t2) ? b4[ii] * pacc[4 * i4 + ii] * __expf(G4[ii] - Gs_) : 0.f; } }
            } else if (wq == 1) {
                const float Gs_ = sG[r];
#pragma unroll
                for (int i4 = 0; i4 < 4; ++i4) { const f32x4 G4 = *(const f32x4*)(sG + 8 * i4 + 4 * hf);
#pragma unroll
                    for (int ii = 0; ii < 4; ++ii) { const int t2 = 8 * i4 + 4 * hf + ii; tb[2048 + t2 * 32 + r] = f2bf((r <= t2) ? pacc[4 * i4 + ii] * __expf(G4[ii] - Gs_) : 0.f); } }
            }
            if (valid && g == 0) { const float Gt = sG[tt], GT = sG[32];
                float* rec = REC + ((size_t)(r0 + tt) * 4 + h) * 16; *(f32x4*)rec = (f32x4){ga, gb, gg, Gt}; *(f32x4*)(rec + 12) = (f32x4){GT - Gt, GT, 0.f, 0.f}; }
        }
        __syncthreads();
    }
    asm volatile("s_waitcnt vmcnt(0)" ::: "memory");
    __syncthreads();
    { const int wv_ = tid >> 6; float* am = lds + wv_ * 1024;
      int nmine = 0;
      for (int base = blockIdx.x * 2; base < NITEM; base += gridDim.x * 2) nmine += 2;
      for (int idx = wv_; idx < nmine; idx += 8) {
        const int item = blockIdx.x * 2 + (idx >> 1) * gridDim.x * 2 + (idx & 1);
        const int rb = item >> 2, h = item & 3;
        if (item >= NITEM || rb >= SROW0 / 32) continue;
        bf16_t* tb = TB + (size_t)item * 3072; const float* ag = (const float*)tb;
#pragma unroll
        for (int q = 0; q < 4; ++q) *(f32x4*)(am + q * 256 + lane * 4) = *(const f32x4*)(ag + q * 256 + lane * 4);
        const float* rec = REC + ((size_t)(rb * 32 + r) * 4 + h) * 16;
        const bool rv = (rb % (LPAD / 32)) * 32 + r < LP;
        const float bs_ = rv ? rec[1] : 0.f, bg_ = rv ? bs_ * __expf(rec[3]) : 0.f;
        asm volatile("s_waitcnt vmcnt(0) lgkmcnt(0)" ::: "memory");
        float Tc[32];
#pragma unroll
        for (int t2 = 0; t2 < 32; ++t2) { float v0 = 0.f, v1 = 0.f, v2 = 0.f, v3 = 0.f;
#pragma unroll
            for (int q4 = 0; q4 < (t2 + 3) / 4; ++q4) { const f32x4 a4 = *(const f32x4*)(am + t2 * 32 + q4 * 4);
                if (q4 * 4 + 0 < t2) v0 += a4[0] * Tc[q4 * 4 + 0]; if (q4 * 4 + 1 < t2) v1 += a4[1] * Tc[q4 * 4 + 1];
                if (q4 * 4 + 2 < t2) v2 += a4[2] * Tc[q4 * 4 + 2]; if (q4 * 4 + 3 < t2) v3 += a4[3] * Tc[q4 * 4 + 3]; }
            Tc[t2] = ((r == t2) ? 1.f : 0.f) - ((v0 + v1) + (v2 + v3)); }
        if (hf == 0) {
#pragma unroll
            for (int t2 = 0; t2 < 32; ++t2) { tb[t2 * 32 + r] = f2bf(Tc[t2] * bs_); tb[1024 + t2 * 32 + r] = f2bf(Tc[t2] * bg_); } }
        asm volatile("s_waitcnt lgkmcnt(0)" ::: "memory");
      } }
    { const int wv_ = tid >> 6;
      for (int it = blockIdx.x * 8 + wv_; it < (SROW0 / 32) * 4; it += gridDim.x * 8) {
        const int rbp = it >> 2, hh = it & 3, jb = rbp % (LPAD / 32), row = rbp * 32 + r;
        float igm = -1e30f, lfm = 0.f;
        if (jb * 32 + r < LP) { const float* gr = G + (size_t)row * 16; igm = gr[hh] + p.gate_bias[l * 8 + hh]; const float f = gr[4 + hh] + p.gate_bias[l * 8 + 4 + hh]; lfm = fminf(f, 0.f) - log1pf(__expf(-fabsf(f))); }
        float bsum = 0.f, pm = -3e38f, myb = 0.f, myu = 0.f, mypm = 0.f;
#pragma unroll
        for (int t2 = 0; t2 < 32; ++t2) { bsum += rdl(lfm, t2); const float u_ = rdl(igm, t2) - bsum; pm = fmaxf(pm, u_); if (r == t2) { myb = bsum; myu = u_; mypm = pm; } }
        if (lane < 32) *(f32x4*)(REC + ((size_t)row * 4 + hh) * 16 + 4) = (f32x4){myu, myb, mypm, 0.f};
      } }
}

__device__ __forceinline__ void issue_gdn(const Params& p, int h, int qtr, int row0, int L, int jb, int ptid, StageRegs& r) {
    const bf16_t* P = (const bf16_t*)(p.ws + OFF_P); const float* REC = (const float*)(p.ws + OFF_REC);
    const int tt = ptid >> 3, g = ptid & 7, t0 = jb * 32;
    if (t0 + tt >= L) return;
    const int row = row0 + t0 + tt;
    const bf16_t* prow = P + (size_t)row * NP;
    r.q0 = asf(*(const u32x4*)(prow + cBQ + h * 128 + g * 16)); r.q1 = asf(*(const u32x4*)(prow + cBQ + h * 128 + g * 16 + 8));
    r.k0 = asf(*(const u32x4*)(prow + cBK + h * 128 + g * 16)); r.k1 = asf(*(const u32x4*)(prow + cBK + h * 128 + g * 16 + 8));
    { const u32x2 vv_ = *(const u32x2*)(prow + cBV + h * 128 + qtr * 32 + g * 4); r.v = asf((u32x4){vv_.x, vv_.y, 0u, 0u}); }
    if (g < 3) r.r0 = *(const f32x4*)(REC + ((size_t)row * 4 + h) * 16 + g * 4);
}
__device__ __forceinline__ void commit_gdn(int L, int jb, float* lds, int ptid, const StageRegs& r, int bsel = -1) {
    const int tt = ptid >> 3, g = ptid & 7, t0 = jb * 32, b = bsel >= 0 ? bsel : (jb & 1);
    if (t0 + tt >= L) return;
    float x[16];
    unpack8(asu(r.q0), x); unpack8(asu(r.q1), x + 8);
    float* qd = QB(lds, b) + tt * 128 + g * 16;
#pragma unroll
    for (int i = 0; i < 4; ++i) *(f32x4*)(qd + 4 * i) = (f32x4){x[4 * i], x[4 * i + 1], x[4 * i + 2], x[4 * i + 3]};
    unpack8(asu(r.k0), x); unpack8(asu(r.k1), x + 8);
    float* kd = KB(lds, b) + tt * 128 + g * 16;
#pragma unroll
    for (int i = 0; i < 4; ++i) *(f32x4*)(kd + 4 * i) = (f32x4){x[4 * i], x[4 * i + 1], x[4 * i + 2], x[4 * i + 3]};
    *(f32x4*)(VB(lds, b) + tt * 32 + g * 4) = (f32x4){bflo(asu(r.v).x), bfhi(asu(r.v).x), bflo(asu(r.v).y), bfhi(asu(r.v).y)};
    if (g < 3) *(f32x4*)(SCB(lds, b) + tt * 16 + g * 4) = r.r0;
}

constexpr int GD_Q = 0, GD_K = 8704, GD_KT = 17408, GD_KDT = 27904, GD_VT = 38400, GD_QKD = 40960, GD_TV = 43520, GD_TK = 46080, GD_W = 48640, GD_SC = 57344, GD_SLOT = 58368, GD_OB = 2 * GD_SLOT;
constexpr int GS_B = 32, GS_EG = 96, GS_ETG = 128, GS_EGT = 160;

__device__ __forceinline__ void issue_gdn_chunk(const Params& p, int h, int qtr, int row0, int L, int nch, int jb, int ptid, StageRegs& r) {
    if (jb >= nch) return;
    const bf16_t* P = (const bf16_t*)(p.ws + OFF_P); const float* REC = (const float*)(p.ws + OFF_REC);
    const bf16_t* tb = (const bf16_t*)(p.ws + OFF_TB) + ((size_t)((row0 >> 5) + jb) * 4 + h) * 3072;
    r.x0 = asf(*(const u32x4*)(tb + ptid * 8));
    if (ptid < 128) r.x1 = asf(*(const u32x4*)(tb + 2048 + ptid * 8));
    const int tt = ptid >> 3, g = ptid & 7, t0 = jb * 32;
    if (t0 + tt >= L) return;
    const int row = row0 + t0 + tt;
    const bf16_t* prow = P + (size_t)row * NP;
    r.q0 = asf(*(const u32x4*)(prow + cBQ + h * 128 + g * 16)); r.q1 = asf(*(const u32x4*)(prow + cBQ + h * 128 + g * 16 + 8));
    r.k0 = asf(*(const u32x4*)(prow + cBK + h * 128 + g * 16)); r.k1 = asf(*(const u32x4*)(prow + cBK + h * 128 + g * 16 + 8));
    { const u32x2 vv_ = *(const u32x2*)(prow + cBV + h * 128 + qtr * 32 + g * 4); r.v = asf((u32x4){vv_.x, vv_.y, 0u, 0u}); }
    if (g == 0 || g == 3) r.r0 = *(const f32x4*)(REC + ((size_t)row * 4 + h) * 16 + g * 4);
}

__device__ __forceinline__ void scan_gdn_chunk(const Params& p, int l, int bs, int h, int qtr, int row0, int L, unsigned char* lb) {
    const int tid = opaque_tid(p.wv); const int wave = tid >> 6, lane = tid & 63, r = lane & 31, hf = lane >> 5, ptid = tid - 256;
    bf16_t* P = (bf16_t*)(p.ws + OFF_P);
    const int nch = (L + 31) >> 5;
    f32x16 S[4];
#pragma unroll
    for (int dt = 0; dt < 4; ++dt)
#pragma unroll
        for (int i = 0; i < 16; ++i) S[dt][i] = 0.f;
    f32x4 s0, s1, s2, s3, s4, s5, s6, s7; StageRegs sr{s0, s1, s2, s3, s4, s5, s6, s7};
#define GD_P1(JN) do { const int jn_ = (JN); unsigned char* sl_ = lb + (jn_ & 1) * GD_SLOT; const int tt = ptid >> 3, g = ptid & 7; const bool val_ = jn_ * 32 + tt < L; \
        u32x4 q0_ = asu(sr.q0), q1_ = asu(sr.q1), k0_ = asu(sr.k0), k1_ = asu(sr.k1); u32x4 v_ = asu(sr.v); \
        if (!val_) { q0_ = q1_ = k0_ = k1_ = v_ = (u32x4){0u, 0u, 0u, 0u}; } \
        *(u32x4*)(sl_ + GD_Q + (tt * CH_LDQ + g * 16) * 2) = q0_; *(u32x4*)(sl_ + GD_Q + (tt * CH_LDQ + g * 16 + 8) * 2) = q1_; \
        *(u32x4*)(sl_ + GD_K + (tt * CH_LDQ + g * 16) * 2) = k0_; *(u32x4*)(sl_ + GD_K + (tt * CH_LDQ + g * 16 + 8) * 2) = k1_; \
        bf16_t* kt_ = (bf16_t*)(sl_ + GD_KT) + kto(g * 16) + tt; \
        _Pragma("unroll") for (int i = 0; i < 4; ++i) { kt_[(2 * i) * CH_LDS] = (bf16_t)(k0_[i] & 0xffffu); kt_[(2 * i + 1) * CH_LDS] = (bf16_t)(k0_[i] >> 16); \
            kt_[(8 + 2 * i) * CH_LDS] = (bf16_t)(k1_[i] & 0xffffu); kt_[(8 + 2 * i + 1) * CH_LDS] = (bf16_t)(k1_[i] >> 16); } \
        bf16_t* vt_ = (bf16_t*)(sl_ + GD_VT); \
        vt_[(g * 4 + 0) * CH_LDS + tt] = (bf16_t)(v_.x & 0xffffu); vt_[(g * 4 + 1) * CH_LDS + tt] = (bf16_t)(v_.x >> 16); \
        vt_[(g * 4 + 2) * CH_LDS + tt] = (bf16_t)(v_.y & 0xffffu); vt_[(g * 4 + 3) * CH_LDS + tt] = (bf16_t)(v_.y >> 16); \
        { const int row_ = ptid >> 2, c4_ = ptid & 3; *(u32x4*)(sl_ + (row_ < 32 ? GD_TV : GD_TK) + ((row_ & 31) * CH_LDS + c4_ * 8) * 2) = asu(sr.x0); \
          if (ptid < 128) *(u32x4*)(sl_ + GD_QKD + (row_ * CH_LDS + c4_ * 8) * 2) = asu(sr.x1); } \
        float* sc_ = (float*)(sl_ + GD_SC); \
        if (g == 0) { sc_[GS_B + tt] = val_ ? sr.r0[1] : 0.f; sc_[GS_EG + tt] = val_ ? __expf(sr.r0[3]) : 0.f; } \
        if (g == 3) { sc_[GS_ETG + tt] = val_ ? __expf(sr.r0[0]) : 0.f; if (tt == 0) sc_[GS_EGT] = __expf(sr.r0[1]); } \
        issue_gdn_chunk(p, h, qtr, row0, L, nch, jn_ + 1, ptid, sr); } while (0)
#define GD_P2(JN) do { if (wave >= 4) { unsigned char* sl_ = lb + ((JN) & 1) * GD_SLOT; const float* sc_ = (const float*)(sl_ + GD_SC); \
        { const int tt = ptid >> 3, g = ptid & 7; const float eg_ = sc_[GS_EG + tt], et_ = sc_[GS_ETG + tt]; float x_[16]; \
            u32x4* qp_ = (u32x4*)(sl_ + GD_Q + (tt * CH_LDQ + g * 16) * 2); unpack8(qp_[0], x_); unpack8(qp_[1], x_ + 8); \
            _Pragma("unroll") for (int i = 0; i < 16; ++i) x_[i] *= eg_; \
            qp_[0] = pack8(x_); qp_[1] = pack8(x_ + 8); \
            const u32x4* kp_ = (const u32x4*)(sl_ + GD_K + (tt * CH_LDQ + g * 16) * 2); unpack8(kp_[0], x_); unpack8(kp_[1], x_ + 8); \
            bf16_t* kd_ = (bf16_t*)(sl_ + GD_KDT); \
            _Pragma("unroll") for (int i = 0; i < 16; ++i) kd_[kto(g * 16) + i * CH_LDS + tt] = f2bf(x_[i] * et_); } \
        { const int dt_ = wave - 4; f32x16 a_; \
            _Pragma("unroll") for (int i = 0; i < 16; ++i) a_[i] = 0.f; \
            _Pragma("unroll") for (int kb = 0; kb < 2; ++kb) a_ = MFMA32(frag_n((const bf16_t*)(sl_ + GD_KT) + kto(dt_ * 32 + r), 0, 0, hf, kb), frag_n((const bf16_t*)(sl_ + GD_TK), CH_LDS, r, hf, kb), a_); \
            _Pragma("unroll") for (int i4 = 0; i4 < 4; ++i4) { unsigned lo_, hi_;     \
                asm volatile("s_nop 7\n\ts_nop 7\n\tv_cvt_pk_bf16_f32 %0, %2, %3\n\tv_cvt_pk_bf16_f32 %1, %4, %5" : "=&v"(lo_), "=&v"(hi_) : "v"(a_[4 * i4]), "v"(a_[4 * i4 + 1]), "v"(a_[4 * i4 + 2]), "v"(a_[4 * i4 + 3])); \
                *(u32x2*)(sl_ + GD_W + (r * CH_LDQ + 32 * dt_ + 8 * i4 + 4 * hf) * 2) = (u32x2){lo_, hi_}; } } } } while (0)
    if (wave >= 4) { issue_gdn_chunk(p, h, qtr, row0, L, nch, 0, ptid, sr); GD_P1(0); }
    BARRIER_LDS();
    GD_P2(0);
    BARRIER_LDS();
#pragma unroll 1
    for (int j = 0; j < nch; ++j) {
        if (wave == 0) {
            const unsigned char* sl = lb + (j & 1) * GD_SLOT; const float* sc = (const float*)(sl + GD_SC);
            const bf16_t* wq = (const bf16_t*)(sl + GD_W); const bf16_t* qg = (const bf16_t*)(sl + GD_Q); const bf16_t* tv = (const bf16_t*)(sl + GD_TV); const bf16_t* vt = (const bf16_t*)(sl + GD_VT);
            const bf16_t* qkd = (const bf16_t*)(sl + GD_QKD); const bf16_t* kdt = (const bf16_t*)(sl + GD_KDT);
            f32x16 U, O;
#pragma unroll
            for (int i = 0; i < 16; ++i) { U[i] = 0.f; O[i] = 0.f; }
#pragma unroll
            for (int dt = 0; dt < 4; ++dt)
#pragma unroll
                for (int u = 0; u < 2; ++u) { const bf16x8 sb = pack_step(S[dt], u);
                    U = MFMA32(frag_p(wq, CH_LDQ, r, hf, 32 * dt + 16 * u), sb, U); O = MFMA32(frag_p(qg, CH_LDQ, r, hf, 32 * dt + 16 * u), sb, O); }
            f32x16 Uv;
#pragma unroll
            for (int i = 0; i < 16; ++i) Uv[i] = 0.f;
#pragma unroll
            for (int kb = 0; kb < 2; ++kb) Uv = MFMA32(frag_n(tv, CH_LDS, r, hf, kb), frag_n(vt, CH_LDS, r, hf, kb), Uv);
#pragma unroll
            for (int i = 0; i < 16; ++i) U[i] = Uv[i] - U[i];
            bf16x8 ub[2]; ub[0] = pack_step(U, 0); ub[1] = pack_step(U, 1);
#pragma unroll
            for (int u = 0; u < 2; ++u) O = MFMA32(frag_p(qkd, CH_LDS, r, hf, 16 * u), ub[u], O);
            const float egt = sc[GS_EGT];
#pragma unroll
            for (int dt = 0; dt < 4; ++dt) {
#pragma unroll
                for (int i = 0; i < 16; ++i) S[dt][i] *= egt;
#pragma unroll
                for (int u = 0; u < 2; ++u) S[dt] = MFMA32(frag_p(kdt + kto(dt * 32 + r), 0, 0, hf, 16 * u), ub[u], S[dt]);
            }
            float* ob = (float*)(lb + GD_OB) + (j & 1) * 1024;
#pragma unroll
            for (int i = 0; i < 16; ++i) ob[crow(i, hf) * 32 + r] = O[i];
        } else if (wave >= 4) {
            if (j + 1 < nch) GD_P1(j + 1);
            if (j > 0) store_out_blk(P, row0, j - 1, L, cBV + h * 128 + qtr * 32, (const float*)(lb + GD_OB) + ((j - 1) & 1) * 1024, ptid);
        }
        BARRIER_LDS();
        if (j + 1 < nch) GD_P2(j + 1);
        BARRIER_LDS();
    }
    if (wave >= 4) store_out_blk(P, row0, nch - 1, L, cBV + h * 128 + qtr * 32, (const float*)(lb + GD_OB) + ((nch - 1) & 1) * 1024, ptid);
    if (wave == 0) {
        float* So = p.out + o_pS + ((size_t)(l * NB + bs) * 4 + h) * 16384;
#pragma unroll
        for (int dt = 0; dt < 4; ++dt)
#pragma unroll
            for (int i = 0; i < 16; ++i) So[(32 * dt + crow(i, hf)) * 128 + qtr * 32 + r] = S[dt][i];
    }
    __syncthreads();
#undef GD_P1
#undef GD_P2
}

__device__ __forceinline__ void scan_gdn(const Params& p, int l, bool samp, int bs, int h, int qtr, int row0, int L, float* lds) {
    const int tid = opaque_tid(p.wv); const bool cons = tid < 256; const int ptid = tid - 256;
    const int lane = tid & 63, w = (tid >> 6) & 3, s = lane & 7, cl = w * 8 + (lane >> 3), col = qtr * 32 + cl;
    bf16_t* P = (bf16_t*)(p.ws + OFF_P);
    f32x2 S[8];
#pragma unroll
    for (int e = 0; e < 8; ++e) S[e] = bc2(0.f);
    if (cons && samp) {
        const float* S0 = p.st_S + ((size_t)(l * NS + bs) * 4 + h) * 16384;
#pragma unroll
        for (int e = 0; e < 16; ++e) { const int d = (e >> 2) * 32 + s * 4 + (e & 3); S[e >> 1][e & 1] = S0[d * 128 + col]; }
    }
    const int nblk = (L + 31) >> 5;
    f32x4 k4[4][4];
    StageRegs sr{k4[0][0], k4[0][1], k4[0][2], k4[0][3], k4[1][0], k4[1][1], k4[1][2], k4[1][3]};
    if (!cons) { issue_gdn(p, h, qtr, row0, L, 0, ptid, sr); commit_gdn(L, 0, lds, ptid, sr); if (1 < nblk) issue_gdn(p, h, qtr, row0, L, 1, ptid, sr); }
    BARRIER_LDS();
    for (int jb = 0; jb < nblk; ++jb) {
        if (!cons) {
            if (jb + 1 < nblk) commit_gdn(L, jb + 1, lds, ptid, sr);
            if (jb + 2 < nblk) issue_gdn(p, h, qtr, row0, L, jb + 2, ptid, sr);
            if (jb > 0) store_out_blk(P, row0, jb - 1, L, cBV + h * 128 + qtr * 32, OB(lds, (jb - 1) & 1), ptid);
        } else {
            const float* qb = QB(lds, jb & 1); const float* kb = KB(lds, jb & 1); const float* vb = VB(lds, jb & 1); const float* sc = SCB(lds, jb & 1);
            float* ob = OB(lds, jb & 1);
            const int nt = min(32, L - jb * 32);
            f32x4 q4[4][4]; float vv[4], a[4], be[4]; f32x4 qk[4], kk[4];
#define GLOAD_Q(T0) do { _Pragma("unroll") for (int i = 0; i < 4; ++i) { const int t = (T0) + i; \
        _Pragma("unroll") for (int j = 0; j < 4; ++j) q4[i][j] = *(const f32x4*)(qb + t * 128 + j * 32 + s * 4); } } while (0)
#define GLOAD_K(T0) do { _Pragma("unroll") for (int i = 0; i < 4; ++i) { const int t = (T0) + i; \
        _Pragma("unroll") for (int j = 0; j < 4; ++j) k4[i][j] = *(const f32x4*)(kb + t * 128 + j * 32 + s * 4); } \
      _Pragma("unroll") for (int i = 0; i < 4; ++i) { const int t = (T0) + i; \
        const f32x2 gg = *(const f32x2*)(sc + t * 16); a[i] = gg[0]; be[i] = gg[1]; \
        qk[i] = *(const f32x4*)(sc + t * 16 + 4); kk[i] = *(const f32x4*)(sc + t * 16 + 8); vv[i] = vb[t * 32 + cl]; } } while (0)
            GLOAD_Q(0); GLOAD_K(0);
#pragma unroll 1
            for (int t0 = 0; t0 < nt; t0 += 4) {
                float dk[4], dq[4];
                const int tn = min(t0 + 4, 28);
                __builtin_amdgcn_sched_barrier(0);
#pragma unroll
                for (int i = 0; i < 4; ++i) {
                    f32x2 x = bc2(0.f), x2 = bc2(0.f), y = bc2(0.f), y2 = bc2(0.f);
#pragma unroll
                    for (int j = 0; j < 4; ++j) {
                        x = lo2(k4[i][j]) * S[2 * j] + x; x2 = hi2(k4[i][j]) * S[2 * j + 1] + x2;
                        y = lo2(q4[i][j]) * S[2 * j] + y; y2 = hi2(q4[i][j]) * S[2 * j + 1] + y2; }
                    x = x + x2; y = y + y2;
                    dk[i] = x[0] + x[1]; dq[i] = y[0] + y[1];
                }
                __builtin_amdgcn_sched_barrier(0);
                GLOAD_Q(tn);
                __builtin_amdgcn_sched_barrier(0);
#pragma unroll
                for (int i = 0; i < 4; ++i) { dk[i] = red8(dk[i]); dq[i] = red8(dq[i]); }
                const float A0 = a[0], A1 = A0 * a[1], A2 = A1 * a[2], A3 = A2 * a[3];
                const float r10 = a[1], r21 = a[2], r32 = a[3], r20 = r10 * a[2], r31 = r21 * a[3], r30 = r20 * a[3];
                const float u0 = be[0] * (vv[0] - A0 * dk[0]);
                const float u1 = be[1] * (vv[1] - A1 * dk[1] - r10 * kk[1][0] * u0);
                const float u2 = be[2] * (vv[2] - A2 * dk[2] - r20 * kk[2][0] * u0 - r21 * kk[2][1] * u1);
                const float u3 = be[3] * (vv[3] - A3 * dk[3] - r30 * kk[3][0] * u0 - r31 * kk[3][1] * u1 - r32 * kk[3][2] * u2);
                if (s == 0) {
                    ob[(t0 + 0) * 32 + cl] = A0 * dq[0] + qk[0][0] * u0;
                    ob[(t0 + 1) * 32 + cl] = A1 * dq[1] + r10 * qk[1][0] * u0 + qk[1][1] * u1;
                    ob[(t0 + 2) * 32 + cl] = A2 * dq[2] + r20 * qk[2][0] * u0 + r21 * qk[2][1] * u1 + qk[2][2] * u2;
                    ob[(t0 + 3) * 32 + cl] = A3 * dq[3] + r30 * qk[3][0] * u0 + r31 * qk[3][1] * u1 + r32 * qk[3][2] * u2 + qk[3][3] * u3;
                }
                const float c0 = r30 * u0, c1 = r31 * u1, c2 = r32 * u2, c3 = u3;
#pragma unroll
                for (int j = 0; j < 4; ++j) {
                    S[2 * j] = lo2(k4[3][j]) * bc2(c3) + (lo2(k4[2][j]) * bc2(c2) + (lo2(k4[1][j]) * bc2(c1) + (lo2(k4[0][j]) * bc2(c0) + S[2 * j] * bc2(A3))));
                    S[2 * j + 1] = hi2(k4[3][j]) * bc2(c3) + (hi2(k4[2][j]) * bc2(c2) + (hi2(k4[1][j]) * bc2(c1) + (hi2(k4[0][j]) * bc2(c0) + S[2 * j + 1] * bc2(A3)))); }
                __builtin_amdgcn_sched_barrier(0);
                GLOAD_K(tn);
            }
#undef GLOAD_Q
#undef GLOAD_K
        }
        BARRIER_LDS();
    }
    if (!cons) store_out_blk(P, row0, nblk - 1, L, cBV + h * 128 + qtr * 32, OB(lds, (nblk - 1) & 1), ptid);
    else {
        const size_t sh = samp ? (size_t)(l * NS + bs) * 4 + h : (size_t)(l * NB + bs) * 4 + h;
        float* So = p.out + (samp ? o_sS : o_pS) + sh * 16384;
#pragma unroll
        for (int e = 0; e < 16; ++e) { const int d = (e >> 2) * 32 + s * 4 + (e & 3); So[d * 128 + col] = S[e >> 1][e & 1]; }
    }
    BARRIER_LDS();
}

__device__ __forceinline__ void scan_gdn_stream(const Params& p, int l, int h, int qtr, int bs0, int nseq, float* lds) {
    const int tid = opaque_tid(p.wv); const bool cons = tid < 256; const int ptid = tid - 256;
    const int lane = tid & 63, w = (tid >> 6) & 3, s = lane & 7, cl = w * 8 + (lane >> 3), col = qtr * 32 + cl;
    bf16_t* P = (bf16_t*)(p.ws + OFF_P);
    f32x2 S[8];
#pragma unroll
    for (int e = 0; e < 8; ++e) S[e] = bc2(0.f);
    f32x4 k4[4][4];
    StageRegs sr{k4[0][0], k4[0][1], k4[0][2], k4[0][3], k4[1][0], k4[1][1], k4[1][2], k4[1][3]};
#define LOADSTATE(BS) do { } while (0)
#define STISSUE(BS) st_issue(p.st_S + ((size_t)(l * NS + (BS)) * 4 + h) * 16384, qtr, ptid, k4[2][0], k4[2][1], k4[2][2], k4[2][3])
    if (!cons) { issue_gdn(p, h, qtr, SROW0 + bs0 * 4, LS, 0, ptid, sr); STISSUE(bs0); }
#pragma unroll 1
    for (int k = 0; k < nseq; ++k) {
        const int bs = bs0 + 8 * k, row0 = SROW0 + bs * 4;
        if (!cons) { commit_gdn(LS, 0, lds, ptid, sr, k & 1); st_commit(STB(lds, k & 1), ptid, k4[2][0], k4[2][1], k4[2][2], k4[2][3]);
            if (k + 1 < nseq) { issue_gdn(p, h, qtr, row0 + 32, LS, 0, ptid, sr); STISSUE(bs + 8); } }
        BARRIER_LDS();
        if (!cons) { if (k > 0) { store_out_blk(P, row0 - 32, 0, LS, cBV + h * 128 + qtr * 32, OB(lds, (k - 1) & 1), ptid); st_store(p.out + o_sS + ((size_t)(l * NS + bs - 8) * 4 + h) * 16384, qtr, STB(lds, (k - 1) & 1), ptid); } }
        else {
            const float* qb = QB(lds, k & 1); const float* kb = KB(lds, k & 1); const float* vb = VB(lds, k & 1); const float* sc = SCB(lds, k & 1);
            float* ob = OB(lds, k & 1); float* stb = STB(lds, k & 1);
#pragma unroll
            for (int e = 0; e < 16; ++e) { const int d = (e >> 2) * 32 + s * 4 + (e & 3); S[e >> 1][e & 1] = stb[d * ST_LD + cl]; }
            f32x4 q4[4][4]; float vv[4], a[4], be[4]; f32x4 qk[4], kk[4];
#define GLOAD_Q(T0) do { _Pragma("unroll") for (int i = 0; i < 4; ++i) { const int t = (T0) + i; \
        _Pragma("unroll") for (int j = 0; j < 4; ++j) q4[i][j] = *(const f32x4*)(qb + t * 128 + j * 32 + s * 4); } } while (0)
#define GLOAD_K(T0) do { _Pragma("unroll") for (int i = 0; i < 4; ++i) { const int t = (T0) + i; \
        _Pragma("unroll") for (int j = 0; j < 4; ++j) k4[i][j] = *(const f32x4*)(kb + t * 128 + j * 32 + s * 4); } \
      _Pragma("unroll") for (int i = 0; i < 4; ++i) { const int t = (T0) + i; \
        const f32x2 gg = *(const f32x2*)(sc + t * 16); a[i] = gg[0]; be[i] = gg[1]; \
        qk[i] = *(const f32x4*)(sc + t * 16 + 4); kk[i] = *(const f32x4*)(sc + t * 16 + 8); vv[i] = vb[t * 32 + cl]; } } while (0)
            GLOAD_Q(0); GLOAD_K(0);
            {
                float dk[4], dq[4];
                __builtin_amdgcn_sched_barrier(0);
#pragma unroll
                for (int i = 0; i < 4; ++i) {
                    f32x2 x = bc2(0.f), x2 = bc2(0.f), y = bc2(0.f), y2 = bc2(0.f);
#pragma unroll
                    for (int j = 0; j < 4; ++j) {
                        x = lo2(k4[i][j]) * S[2 * j] + x; x2 = hi2(k4[i][j]) * S[2 * j + 1] + x2;
                        y = lo2(q4[i][j]) * S[2 * j] + y; y2 = hi2(q4[i][j]) * S[2 * j + 1] + y2; }
                    x = x + x2; y = y + y2;
                    dk[i] = x[0] + x[1]; dq[i] = y[0] + y[1];
                }
                __builtin_amdgcn_sched_barrier(0);
#pragma unroll
                for (int i = 0; i < 4; ++i) { dk[i] = red8(dk[i]); dq[i] = red8(dq[i]); }
                const float A0 = a[0], A1 = A0 * a[1], A2 = A1 * a[2], A3 = A2 * a[3];
                const float r10 = a[1], r21 = a[2], r32 = a[3], r20 = r10 * a[2], r31 = r21 * a[3], r30 = r20 * a[3];
                const float u0 = be[0] * (vv[0] - A0 * dk[0]);
                const float u1 = be[1] * (vv[1] - A1 * dk[1] - r10 * kk[1][0] * u0);
                const float u2 = be[2] * (vv[2] - A2 * dk[2] - r20 * kk[2][0] * u0 - r21 * kk[2][1] * u1);
                const float u3 = be[3] * (vv[3] - A3 * dk[3] - r30 * kk[3][0] * u0 - r31 * kk[3][1] * u1 - r32 * kk[3][2] * u2);
                if (s == 0) {
                    ob[0 * 32 + cl] = A0 * dq[0] + qk[0][0] * u0;
                    ob[1 * 32 + cl] = A1 * dq[1] + r10 * qk[1][0] * u0 + qk[1][1] * u1;
                    ob[2 * 32 + cl] = A2 * dq[2] + r20 * qk[2][0] * u0 + r21 * qk[2][1] * u1 + qk[2][2] * u2;
                    ob[3 * 32 + cl] = A3 * dq[3] + r30 * qk[3][0] * u0 + r31 * qk[3][1] * u1 + r32 * qk[3][2] * u2 + qk[3][3] * u3;
                }
                const float c0 = r30 * u0, c1 = r31 * u1, c2 = r32 * u2, c3 = u3;
#pragma unroll
                for (int j = 0; j < 4; ++j) {
                    S[2 * j] = lo2(k4[3][j]) * bc2(c3) + (lo2(k4[2][j]) * bc2(c2) + (lo2(k4[1][j]) * bc2(c1) + (lo2(k4[0][j]) * bc2(c0) + S[2 * j] * bc2(A3))));
                    S[2 * j + 1] = hi2(k4[3][j]) * bc2(c3) + (hi2(k4[2][j]) * bc2(c2) + (hi2(k4[1][j]) * bc2(c1) + (hi2(k4[0][j]) * bc2(c0) + S[2 * j + 1] * bc2(A3)))); }
            }
#undef GLOAD_Q
#undef GLOAD_K
#pragma unroll
            for (int e = 0; e < 16; ++e) { const int d = (e >> 2) * 32 + s * 4 + (e & 3); stb[d * ST_LD + cl] = S[e >> 1][e & 1]; }
        }
    }
    BARRIER_LDS();
    if (!cons) { store_out_blk(P, SROW0 + (bs0 + 8 * (nseq - 1)) * 4, 0, LS, cBV + h * 128 + qtr * 32, OB(lds, (nseq - 1) & 1), ptid); st_store(p.out + o_sS + ((size_t)(l * NS + bs0 + 8 * (nseq - 1)) * 4 + h) * 16384, qtr, STB(lds, (nseq - 1) & 1), ptid); }
    BARRIER_LDS();
#undef LOADSTATE
#undef STISSUE
}


__device__ __forceinline__ void phase_scan(const Params& p, int l, float* lds) {
    for (int item = blockIdx.x; item < 256; item += gridDim.x) {
        const int qtr = item & 3, h = (item >> 2) & 3, bs = (item >> 4) & 7, branch = item >> 7;
        if (branch == 0) scan_mlstm_chunk(p, l, bs, h, qtr, bs * LPAD, LP, (unsigned char*)lds); else scan_gdn_chunk(p, l, bs, h, qtr, bs * LPAD, LP, (unsigned char*)lds);
    }
    for (int c = blockIdx.x; c < 256; c += gridDim.x) {
        const int qtr = c & 3, h = (c >> 2) & 3, branch = (c >> 4) & 1, bs0 = c >> 5;
        if (branch == 0) scan_mlstm_stream(p, l, h, qtr, bs0, NS / 8, lds); else scan_gdn_stream(p, l, h, qtr, bs0, NS / 8, lds);
    }
}

__device__ __forceinline__ void phase_norm(const Params& p, int l) {
    const int tid = opaque_tid(p.wv); const int wave = tid >> 6, lane = tid & 63;
    bf16_t* P = (bf16_t*)(p.ws + OFF_P);
    const int part = lane >> 5, hh = (lane >> 3) & 3, g = lane & 7, ch0 = hh * 128 + g * 16;
    const int craw = (part ? cBV : cV) + ch0, cgate = (part ? cZ : cO) + ch0;
    const float* wn = part ? p.b_norm_w + l * 128 + g * 16 : p.a_norm_w + l * 512 + ch0;
    for (int row = blockIdx.x * 8 + wave; row < MROWS; row += gridDim.x * 8) {
        if (row < SROW0 && (row % LPAD) >= LP) continue;
        bf16_t* pr = P + (size_t)row * NP;
        float x[16], z[16];
        unpack8(*(const u32x4*)(pr + craw), x); unpack8(*(const u32x4*)(pr + craw + 8), x + 8);
        unpack8(*(const u32x4*)(pr + cgate), z); unpack8(*(const u32x4*)(pr + cgate + 8), z + 8);
        float sum = 0.f;
#pragma unroll
        for (int i = 0; i < 16; ++i) sum += x[i];
        float mean = red8(sum) * (1.f / 128.f);
        if (part) mean = 0.f;
        float s2 = 0.f;
#pragma unroll
        for (int i = 0; i < 16; ++i) { x[i] -= mean; s2 += x[i] * x[i]; }
        const float rstd = rsqrtf(red8(s2) * (1.f / 128.f) + 1e-6f);
        float y[16];
#pragma unroll
        for (int i = 0; i < 16; ++i) { const float sg = sigmoidf_(z[i]); y[i] = x[i] * rstd * wn[i] * (part ? z[i] * sg : sg); }
        u32x4 o0, o1;
        o0.x = pk2(y[0], y[1]); o0.y = pk2(y[2], y[3]); o0.z = pk2(y[4], y[5]); o0.w = pk2(y[6], y[7]);
        o1.x = pk2(y[8], y[9]); o1.y = pk2(y[10], y[11]); o1.z = pk2(y[12], y[13]); o1.w = pk2(y[14], y[15]);
        *(u32x4*)(pr + cgate) = o0; *(u32x4*)(pr + cgate + 8) = o1;
    }
}

__device__ __forceinline__ void phase_convact(const Params& p, int l) {
    bf16_t* U = (bf16_t*)(p.ws + OFF_P); const bf16_t* HB = (const bf16_t*)(p.ws + OFF_HB);
    const float* cw = p.fconv_w + (size_t)l * 3 * NU;
    constexpr int NCG = DFF / 8, NRG = MROWS / 32;
    const int tid = opaque_tid(p.wv);
    for (int it = blockIdx.x * NTHREADS + tid; it < NRG * NCG; it += gridDim.x * NTHREADS) {
        const int rg = it / NCG, cg_ = it - rg * NCG, c0 = cg_ * 8;
        float wa[3][8], wb[3][8];
#pragma unroll
        for (int j = 0; j < 3; ++j) {
            const f32x4 a0 = *(const f32x4*)(cw + j * NU + c0), a1 = *(const f32x4*)(cw + j * NU + c0 + 4);
            const f32x4 b0 = *(const f32x4*)(cw + j * NU + DFF + c0), b1 = *(const f32x4*)(cw + j * NU + DFF + c0 + 4);
#pragma unroll
            for (int i = 0; i < 4; ++i) { wa[j][i] = a0[i]; wa[j][4 + i] = a1[i]; wb[j][i] = b0[i]; wb[j][4 + i] = b1[i]; }
        }
        float a2[8], a1[8], b2[8], b1[8];
        const bool samp = rg >= SROW0 / 32;
#pragma unroll
        for (int i = 0; i < 8; ++i) { a2[i] = a1[i] = b2[i] = b1[i] = 0.f; }
        if (!samp && (rg % (LPAD / 32)) != 0) {
            const bf16_t* h0 = HB + (size_t)(rg - 1) * 2 * NU;
            unpack8(*(const u32x4*)(h0 + c0), a2); unpack8(*(const u32x4*)(h0 + NU + c0), a1);
            unpack8(*(const u32x4*)(h0 + DFF + c0), b2); unpack8(*(const u32x4*)(h0 + NU + DFF + c0), b1);
        }
#pragma unroll 4
        for (int i = 0; i < 32; ++i) {
            const int row = rg * 32 + i;
            if (samp && (i & 3) == 0) {
                const float* st = p.st_fconv + ((size_t)(l * NS + ((row - SROW0) >> 2)) * 2) * NU;
                const f32x4 x0 = *(const f32x4*)(st + c0), x1 = *(const f32x4*)(st + c0 + 4), y0 = *(const f32x4*)(st + NU + c0), y1 = *(const f32x4*)(st + NU + c0 + 4);
                const f32x4 u0 = *(const f32x4*)(st + DFF + c0), u1 = *(const f32x4*)(st + DFF + c0 + 4), v0 = *(const f32x4*)(st + NU + DFF + c0), v1 = *(const f32x4*)(st + NU + DFF + c0 + 4);
#pragma unroll
                for (int e = 0; e < 4; ++e) { a2[e] = x0[e]; a2[4 + e] = x1[e]; a1[e] = y0[e]; a1[4 + e] = y1[e]; b2[e] = u0[e]; b2[4 + e] = u1[e]; b1[e] = v0[e]; b1[4 + e] = v1[e]; }
            }
            bf16_t* ur = U + (size_t)row * NU;
            float a[8], b[8], hh[8];
            unpack8(*(const u32x4*)(ur + c0), a); unpack8(*(const u32x4*)(ur + DFF + c0), b);
#pragma unroll
            for (int e = 0; e < 8; ++e) {
                const float ca = wa[0][e] * a2[e] + wa[1][e] * a1[e] + wa[2][e] * a[e];
                const float cb = wb[0][e] * b2[e] + wb[1][e] * b1[e] + wb[2][e] * b[e];
                hh[e] = ca * sigmoidf_(ca) * cb;
                a2[e] = a1[e]; a1[e] = a[e]; b2[e] = b1[e]; b1[e] = b[e];
            }
            u32x4 o; o.x = pk2(hh[0], hh[1]); o.y = pk2(hh[2], hh[3]); o.z = pk2(hh[4], hh[5]); o.w = pk2(hh[6], hh[7]);
            *(u32x4*)(ur + c0) = o;
        }
    }
}

#ifndef PROBE
#define PROBE 0
#endif
constexpr int NPHASE = 2 + DEPTH * 11;
__global__ void __launch_bounds__(NTHREADS) fwd_kernel(Params pin) {
    extern __shared__ __attribute__((aligned(16))) unsigned char smem_raw[];
    Params p = pin; p.wv = __builtin_amdgcn_readfirstlane((int)(threadIdx.x >> 6));
    unsigned* bar = (unsigned*)(p.ws + OFF_BAR); const unsigned xcc = xb_xcc_id();
    volatile LAS unsigned* xst = (volatile LAS unsigned*)(LAS unsigned char*)(smem_raw + LDS_GEMM);
    if (threadIdx.x == 0) { xst[0] = 0u; xst[1] = 0u; (void)xb_add(&bar[XB_XCNT(xcc)], 1u); }
    __syncthreads();
    float* lds = (float*)smem_raw;
    bf16_t* X = (bf16_t*)(p.ws + OFF_X); bf16_t* P = (bf16_t*)(p.ws + OFF_P); bf16_t* HB = (bf16_t*)(p.ws + OFF_HB);
    for (int ph = p.ph_lo; ph < p.ph_hi; ++ph) {
#if PROBE == 3
      for (int rep = 0; rep < 2; ++rep) { const int sx = ph < 2 ? -1 : (ph - 2) % 11; if (rep == 1 && !(ph < 2 || sx == 6 || sx == 10)) break;
#endif
        if (ph == 0) phase_weights(p, lds);
        else if (ph == 1) phase_ln(p, 0, nullptr, 0, p.ln_emb_g, p.ln_emb_b, 0, false);
        else {
            const int l = (ph - 2) / 11, s = (ph - 2) % 11;
            if (s == 0) { GemmArgs g{X, X, 1 << 30, D, w_inT(p, l), MROWS, NP, 1024}; gemm_phase(g, EpiP{P, (bf16_t*)(p.ws + OFF_GH), p.out, l}, p.wv); }
            else if (s == 1) phase_prep(p, l, lds);
            else if (s == 2) phase_scan(p, l, lds);
            else if (s == 3) phase_norm(p, l);
            else if (s == 4) { GemmArgs g{P + cO, P + cZ, 4, NP, w_abT(p, l), MROWS, 2048, 512}; gemm_phase(g, EpiMerge{P}, p.wv); }
            else if (s == 5) { GemmArgs g{P + cMG, P + cMG, 1 << 30, NP, w_outT(p, l), MROWS, 1024, 2048, 1}; gemm_phase(g, EpiRes{X, P, NP, 0, (bf16_t*)(p.ws + OFF_GH)}, p.wv); }
            else if (s == 6) phase_ln(p, 1, P, NP, p.ln1_g + l * D, p.ln1_b + l * D, -1, false);
            else if (s == 7) { GemmArgs g{X, X, 1 << 30, D, w_upT(p, l), MROWS, NU, 1024}; gemm_phase(g, EpiUp{P, HB, p.out, l}, p.wv); }
            else if (s == 8) phase_convact(p, l);
            else if (s == 9) { GemmArgs g{P, P, 1 << 30, NU, w_dnT(p, l), MROWS, 1024, DFF, 1}; gemm_phase(g, EpiRes{X, P, NU, DFF, (bf16_t*)(p.ws + OFF_GH)}, p.wv); }
            else phase_ln(p, 1, P + DFF, NU, p.ln2_g + l * D, p.ln2_b + l * D, l + 1 < DEPTH ? l + 1 : -1, l + 1 == DEPTH);
        }
#if PROBE == 3
      }
#endif
        if (ph + 1 < p.ph_hi) { if (ph == 0) cg::this_grid().sync(); else xcd_barrier(bar, xcc, xst, p.wv); }
    }
#if PROBE == 4
    for (int i = 0; i < 20; ++i) xcd_barrier(bar, xcc, xst, p.wv);
#endif
}

extern "C" void kernel_launch(void* const* d_in, const int* in_sizes, int n_in, void* d_out, int out_size, void* d_ws, size_t ws_size, hipStream_t stream) {
    static int grid = 0;
    if (grid == 0) {
        if (n_in != 28 || (size_t)out_size != o_end || ws_size < WS_END) { fprintf(stderr, "kernel_launch: unexpected sizes n_in %d out %d ws %zu (need %zu)\n", n_in, out_size, ws_size, (size_t)WS_END); grid = -1; return; }
        int dev = 0, cus = 0, per_cu = 0;
        hipGetDevice(&dev); hipDeviceGetAttribute(&cus, hipDeviceAttributeMultiprocessorCount, dev);
        if (hipFuncSetAttribute((const void*)fwd_kernel, hipFuncAttributeMaxDynamicSharedMemorySize, LDS_BYTES) != hipSuccess) { fprintf(stderr, "hipFuncSetAttribute failed\n"); grid = -1; return; }
        if (hipOccupancyMaxActiveBlocksPerMultiprocessor(&per_cu, (const void*)fwd_kernel, NTHREADS, LDS_BYTES) != hipSuccess || per_cu < 1) { fprintf(stderr, "occupancy query failed (%d)\n", per_cu); (void)hipGetLastError(); per_cu = 1; }
        grid = cus * per_cu;
        if (grid > 256) grid = 256;
    }
    if (grid < 0) return;
    if (hipMemsetAsync((unsigned char*)d_ws + OFF_BAR, 0, 16384, stream) != hipSuccess) { fprintf(stderr, "memset of barrier words failed\n"); return; }
    Params p{};
    const float** pp = (const float**)&p;
    for (int i = 0; i < 28; ++i) pp[i] = (const float*)d_in[i];
    p.out = (float*)d_out; p.ws = (unsigned char*)d_ws;
#if MULTI
    for (int ph = 0; ph < NPHASE; ++ph) { p.ph_lo = ph; p.ph_hi = ph + 1; hipLaunchKernelGGL(fwd_kernel, dim3(grid), dim3(NTHREADS), LDS_BYTES, stream, p); }
#else
    p.ph_lo = 0; p.ph_hi = NPHASE;
    void* args[] = {&p};
    hipError_t e = hipLaunchCooperativeKernel((const void*)fwd_kernel, dim3(grid), dim3(NTHREADS), args, LDS_BYTES, stream);
    if (e != hipSuccess) fprintf(stderr, "cooperative launch failed: %s (grid %d)\n", hipGetErrorString(e), grid);
#endif
}
```

```cpp
#include <hip/hip_runtime.h>
#include <hip/hip_cooperative_groups.h>
#include <cstdio>
namespace cg = cooperative_groups;

#ifndef MULTI
#define MULTI 0
#endif

typedef unsigned short bf16_t;
typedef short bf16x8 __attribute__((ext_vector_type(8)));
typedef float f32x4 __attribute__((ext_vector_type(4)));
typedef float f32x2 __attribute__((ext_vector_type(2)));
typedef unsigned u32x2 __attribute__((ext_vector_type(2)));
typedef unsigned u32x4 __attribute__((ext_vector_type(4)));

constexpr int D = 1024, NB = 8, LP = 2064, LPAD = 2080, NS = 128, LS = 4, DEPTH = 2, NMETA = 16, SEQ = 2048;
constexpr int MROWS = NB * LPAD + NS * LS;
constexpr int SROW0 = NB * LPAD;
constexpr int NIN = 6160, NP = 6144, DFF = 2816, NU = 5632;
constexpr int cQ = 0, cK = 512, cV = 1024, cO = 1536, cBQ = 2048, cBK = 2560, cBV = 3072, cZ = 3584, cMG = 4096;
constexpr float ALPHA = 1.4142135623730951f;
constexpr int SPLIT_ROW0 = 64 * 256;
constexpr int NTHREADS = 512;
constexpr int LDS_GEMM = 131072;
constexpr int LDS_BYTES = LDS_GEMM + 256;

constexpr size_t W_IN = (size_t)NP * 1024, W_AB = 2048 * 512, W_OUT = 1024 * 2048, W_UP = (size_t)NU * 1024, W_DN = (size_t)1024 * DFF;
constexpr size_t W_LAYER = W_IN + W_AB + W_OUT + W_UP + W_DN;
constexpr size_t OFF_W = 0;
constexpr size_t OFF_WG = OFF_W + DEPTH * W_LAYER * 2;
constexpr size_t OFF_X = OFF_WG + DEPTH * 16 * 1024 * 4;
constexpr size_t OFF_G = OFF_X + (size_t)MROWS * D * 2;
constexpr size_t OFF_HB = OFF_G + (size_t)MROWS * 16 * 4;
constexpr size_t OFF_P = OFF_HB + (size_t)(MROWS / 32) * 2 * NU * 2;
constexpr size_t OFF_GH = OFF_P + (size_t)MROWS * NP * 2;
constexpr size_t OFF_REC = OFF_GH + (size_t)(MROWS / 32) * 3 * 1536 * 2;
constexpr size_t OFF_BAR = OFF_REC + (size_t)MROWS * 4 * 16 * 4;
constexpr size_t OFF_TB = OFF_BAR + 16384;
constexpr size_t WS_END = OFF_TB + (size_t)(MROWS / 32) * 4 * 3 * 1024 * 2;

constexpr size_t o_yp = 0;
constexpr size_t o_ys = o_yp + (size_t)NB * SEQ * D;
constexpr size_t o_pC = o_ys + (size_t)NS * LS * D;
constexpr size_t o_pn = o_pC + (size_t)DEPTH * NB * 4 * 128 * 128;
constexpr size_t o_pm = o_pn + (size_t)DEPTH * NB * 4 * 128;
constexpr size_t o_pS = o_pm + (size_t)DEPTH * NB * 4;
constexpr size_t o_pgc = o_pS + (size_t)DEPTH * NB * 4 * 128 * 128;
constexpr size_t o_pfc = o_pgc + (size_t)DEPTH * NB * 3 * 1536;
constexpr size_t o_sC = o_pfc + (size_t)DEPTH * NB * 2 * NU;
constexpr size_t o_sn = o_sC + (size_t)DEPTH * NS * 4 * 128 * 128;
constexpr size_t o_sm = o_sn + (size_t)DEPTH * NS * 4 * 128;
constexpr size_t o_sS = o_sm + (size_t)DEPTH * NS * 4;
constexpr size_t o_sgc = o_sS + (size_t)DEPTH * NS * 4 * 128 * 128;
constexpr size_t o_sfc = o_sgc + (size_t)DEPTH * NS * 3 * 1536;
constexpr size_t o_end = o_sfc + (size_t)DEPTH * NS * 2 * NU;

struct Params {
    const float* x_prompt; const float* x_sample; const float* st_C; const float* st_n; const float* st_m; const float* st_S;
    const float* st_gconv; const float* st_fconv; const float* meta; const float* ln_emb_g; const float* ln_emb_b; const float* w_in;
    const float* gate_bias; const float* a_norm_w; const float* gconv_w; const float* A_log; const float* dt_bias; const float* b_norm_w;
    const float* w_pa; const float* w_pb; const float* w_out; const float* ln1_g; const float* ln1_b; const float* w_up;
    const float* fconv_w; const float* w_down; const float* ln2_g; const float* ln2_b;
    float* out; unsigned char* ws;
    int ph_lo, ph_hi;
    int wv, pad_;
};

__device__ __forceinline__ int opaque_tid(int wv) { int lane; asm volatile("v_mbcnt_lo_u32_b32 %0, -1, 0\n\tv_mbcnt_hi_u32_b32 %0, -1, %0" : "=v"(lane)); return wv * 64 + lane; }
__device__ __forceinline__ float bflo(unsigned u) { return __uint_as_float(u << 16); }
__device__ __forceinline__ float bfhi(unsigned u) { return __uint_as_float(u & 0xffff0000u); }
__device__ __forceinline__ unsigned pk2(float lo, float hi) { unsigned r; asm("v_cvt_pk_bf16_f32 %0, %1, %2" : "=v"(r) : "v"(lo), "v"(hi)); return r; }
template <int CTRL> __device__ __forceinline__ float dppf(float v) { return __int_as_float(__builtin_amdgcn_update_dpp(0, __float_as_int(v), CTRL, 0xf, 0xf, true)); }
__device__ __forceinline__ float red8(float v) { v += dppf<0xB1>(v); v += dppf<0x4E>(v); v += dppf<0x141>(v); return v; }
__device__ __forceinline__ float red16(float v) { v = red8(v); v += dppf<0x140>(v); return v; }
__device__ __forceinline__ float rdl(float v, int l) { return __int_as_float(__builtin_amdgcn_readlane(__float_as_int(v), l)); }
__device__ __forceinline__ float rdl_pin(float v, int l) { float r_; asm volatile("v_readlane_b32 %0, %1, %2" : "=s"(r_) : "v"(v), "s"(l)); return r_; }
__device__ __forceinline__ float red64(float v) { v = red16(v); return (rdl(v, 0) + rdl(v, 16)) + (rdl(v, 32) + rdl(v, 48)); }
__device__ __forceinline__ float sigmoidf_(float x) { return __builtin_amdgcn_rcpf(1.f + __expf(-x)); }
__device__ __forceinline__ u32x4 pack8(const float* y) { u32x4 o; o.x = pk2(y[0], y[1]); o.y = pk2(y[2], y[3]); o.z = pk2(y[4], y[5]); o.w = pk2(y[6], y[7]); return o; }
__device__ __forceinline__ void unpack8(u32x4 a, float* x) { x[0] = bflo(a.x); x[1] = bfhi(a.x); x[2] = bflo(a.y); x[3] = bfhi(a.y); x[4] = bflo(a.z); x[5] = bfhi(a.z); x[6] = bflo(a.w); x[7] = bfhi(a.w); }


#define XB_TMO      128
#define XB_XCNT(j)  (256  + 64 * (j))
#define XB_XSUB(j)  (1280 + 64 * (j))
#define XB_XGEN(j)  (2304 + 64 * (j))
#define XB_TOP      3328
#define XB_TOPGEN   3392
#define XCD_BAR_WORDS 3456
#define XB_SPIN_CAP (1u << 18)
#define LAS __attribute__((address_space(3)))
__device__ __forceinline__ unsigned xb_ld(unsigned* p)              { return __hip_atomic_load(p, __ATOMIC_RELAXED, __HIP_MEMORY_SCOPE_AGENT); }
__device__ __forceinline__ unsigned xb_add(unsigned* p, unsigned v) { return __hip_atomic_fetch_add(p, v, __ATOMIC_RELAXED, __HIP_MEMORY_SCOPE_AGENT); }
__device__ __forceinline__ unsigned xb_xcc_id() { return (unsigned)__builtin_amdgcn_s_getreg((3 << 11) | 20) & 0xFu; }
#define XB_SPIN(cond, bar) do { unsigned _sp = 0; while (cond) { __builtin_amdgcn_s_sleep(1); \
    if ((++_sp & 255u) == 0u) { if (xb_ld(&(bar)[XB_TMO])) break; if (_sp > XB_SPIN_CAP) { atomicAdd(&(bar)[XB_TMO], 1u); break; } } } } while (0)
__device__ __forceinline__ void xcd_barrier_complete(unsigned* bar, unsigned x, unsigned& nloc, unsigned& nx) {
    const unsigned G = gridDim.x;
    unsigned sum, cnt, mine, sp = 0u;
    for (;;) {
        sum = 0u; cnt = 0u; mine = 0u;
#pragma unroll
        for (unsigned j = 0; j < 16; ++j) { const unsigned c = xb_ld(&bar[XB_XCNT(j)]); sum += c; cnt += (c > 0u) ? 1u : 0u; mine = (j == x) ? c : mine; }
        if (sum == G) break;
        __builtin_amdgcn_s_sleep(1);
        if ((++sp & 255u) == 0u) { if (xb_ld(&bar[XB_TMO])) break; if (sp > XB_SPIN_CAP) { atomicAdd(&bar[XB_TMO], 1u); break; } }
    }
    nloc = mine > 0u ? mine : 1u; nx = cnt > 0u ? cnt : 1u;
}
__device__ __forceinline__ void xcd_barrier(unsigned* bar, unsigned x, volatile LAS unsigned* st, int wv) {
    asm volatile("s_waitcnt vmcnt(0)" ::: "memory");
    __syncthreads();
    if (opaque_tid(wv) == 0) {
        __builtin_amdgcn_s_waitcnt(0);
        unsigned nloc = st[0], nx = st[1];
        if (nloc == 0u) { xcd_barrier_complete(bar, x, nloc, nx); st[0] = nloc; st[1] = nx; }
        const unsigned old = xb_add(&bar[XB_XSUB(x)], 1u);
        const unsigned gen = old / nloc;
        if (old + 1u == (gen + 1u) * nloc) {
            __builtin_amdgcn_fence(__ATOMIC_RELEASE, "agent");
            asm volatile("s_waitcnt vmcnt(0)" ::: "memory");
            const unsigned og = xb_add(&bar[XB_TOP], 1u);
            const unsigned tg = og / nx;
            if (og + 1u == (tg + 1u) * nx) xb_add(&bar[XB_TOPGEN], 1u);
            else XB_SPIN(xb_ld(&bar[XB_TOPGEN]) == tg, bar);
            __builtin_amdgcn_fence(__ATOMIC_ACQUIRE, "agent");
            xb_add(&bar[XB_XGEN(x)], 1u);
            asm volatile("s_waitcnt vmcnt(0)" ::: "memory");
        } else {
            XB_SPIN(xb_ld(&bar[XB_XGEN(x)]) == gen, bar);
            __builtin_amdgcn_fence(__ATOMIC_ACQUIRE, "agent");
            asm volatile("s_waitcnt vmcnt(0)" ::: "memory");
        }
    }
    __syncthreads();
}

struct TJob { const float* src; int ldw; int K; int N; bf16_t* dst; int ldt; };
__device__ __forceinline__ void transpose_item(const TJob& jb, int item, float* scr, int lane) {
    const int nblk = jb.N / 32, kb = item / nblk, nb = item % nblk, k0 = 64 * kb, n0 = 32 * nb;
#pragma unroll 8
    for (int i = 0; i < 32; ++i) { const int kk = 2 * i + (lane >> 5); scr[kk * 33 + (lane & 31)] = jb.src[(size_t)(k0 + kk) * jb.ldw + n0 + (lane & 31)]; }
    __builtin_amdgcn_s_waitcnt(0xc07f); asm volatile("" ::: "memory");
    const int c = lane & 7;
#pragma unroll
    for (int j = 0; j < 4; ++j) { const int n = (lane >> 3) + 8 * j; const float* s = scr + (8 * c) * 33 + n;
        u32x4 o; o.x = pk2(s[0 * 33], s[1 * 33]); o.y = pk2(s[2 * 33], s[3 * 33]); o.z = pk2(s[4 * 33], s[5 * 33]); o.w = pk2(s[6 * 33], s[7 * 33]);
        *(u32x4*)(jb.dst + (size_t)(n0 + n) * jb.ldt + k0 + 8 * c) = o; }
    __builtin_amdgcn_s_waitcnt(0xc07f); asm volatile("" ::: "memory");
}
__device__ __forceinline__ bf16_t* wl(const Params& p, int l) { return (bf16_t*)(p.ws + OFF_W) + (size_t)l * W_LAYER; }
__device__ __forceinline__ bf16_t* w_inT(const Params& p, int l) { return wl(p, l); }
__device__ __forceinline__ bf16_t* w_abT(const Params& p, int l) { return wl(p, l) + W_IN; }
__device__ __forceinline__ bf16_t* w_outT(const Params& p, int l) { return wl(p, l) + W_IN + W_AB; }
__device__ __forceinline__ bf16_t* w_upT(const Params& p, int l) { return wl(p, l) + W_IN + W_AB + W_OUT; }
__device__ __forceinline__ bf16_t* w_dnT(const Params& p, int l) { return wl(p, l) + W_IN + W_AB + W_OUT + W_UP; }

__device__ __forceinline__ void phase_weights(const Params& p, float* lds) {
    const int tid = opaque_tid(p.wv); const int wave = tid >> 6, lane = tid & 63;
    float* scr = lds + wave * (64 * 33);
    const int gw = blockIdx.x * 8 + wave, NGW = gridDim.x * 8;
    constexpr int I0 = 16 * 64, I1 = 16 * 64, I2 = 16 * 64, I3 = 8 * 32, I4 = 8 * 32, I5 = 16 * 32, I6 = 16 * 32, I7 = 16 * (NU / 32), I8 = (DFF / 64) * 32;
    constexpr int IL = I0 + I1 + I2 + I3 + I4 + I5 + I6 + I7 + I8;
    for (int it = gw; it < DEPTH * IL; it += NGW) {
        const int l = it / IL; int r = it % IL;
        TJob jb;
        const float* win = p.w_in + (size_t)l * 1024 * NIN;
        if (r < I0) { jb = {win, NIN, 1024, 2048, w_inT(p, l), 1024}; }
        else if ((r -= I0) < I1) { jb = {win + 2056, NIN, 1024, 2048, w_inT(p, l) + (size_t)2048 * 1024, 1024}; }
        else if ((r -= I1) < I2) { jb = {win + 4112, NIN, 1024, 2048, w_inT(p, l) + (size_t)4096 * 1024, 1024}; }
        else if ((r -= I2) < I3) { jb = {p.w_pa + (size_t)l * 512 * 1024, 1024, 512, 1024, w_abT(p, l), 512}; }
        else if ((r -= I3) < I4) { jb = {p.w_pb + (size_t)l * 512 * 1024, 1024, 512, 1024, w_abT(p, l) + (size_t)1024 * 512, 512}; }
        else if ((r -= I4) < I5) { jb = {p.w_out + (size_t)l * 1024 * 1024, 1024, 1024, 1024, w_outT(p, l), 2048}; }
        else if ((r -= I5) < I6) { jb = {p.w_out + (size_t)l * 1024 * 1024, 1024, 1024, 1024, w_outT(p, l) + 1024, 2048}; }
        else if ((r -= I6) < I7) { jb = {p.w_up + (size_t)l * 1024 * NU, NU, 1024, NU, w_upT(p, l), 1024}; }
        else { r -= I7; jb = {p.w_down + (size_t)l * DFF * 1024, 1024, DFF, 1024, w_dnT(p, l), DFF}; }
        transpose_item(jb, r, scr, lane);
    }
    float* wg = (float*)(p.ws + OFF_WG);
    for (int i = blockIdx.x * NTHREADS + tid; i < DEPTH * 16 * 1024; i += gridDim.x * NTHREADS) {
        const int l = i >> 14, g = (i >> 10) & 15, k = i & 1023;
        const int col = g < 8 ? 2048 + g : 4104 + (g - 8);
        wg[i] = p.w_in[((size_t)l * 1024 + k) * NIN + col];
    }
}

__device__ __forceinline__ void phase_ln(const Params& p, int mode, const bf16_t* src, int ldsrc, const float* gam, const float* bet,
                                         int gate_layer  , bool final_out) {
    const int tid = opaque_tid(p.wv); const int wave = tid >> 6, lane = tid & 63;
    bf16_t* X = (bf16_t*)(p.ws + OFF_X);
#define EOFF(j) (512 * ((j) >> 1) + lane * 8 + 4 * ((j) & 1))
    float* G = (float*)(p.ws + OFF_G);
    const float* wg = (const float*)(p.ws + OFF_WG) + (size_t)(gate_layer < 0 ? 0 : gate_layer) * 16 * 1024;
    for (int row = blockIdx.x * 8 + wave; row < MROWS; row += gridDim.x * 8) {
        int b = 0, t = 0; bool samp = row >= SROW0;
        if (!samp) { b = row / LPAD; t = row - b * LPAD; } else { b = (row - SROW0) >> 2; t = row & 3; }
        const bool valid = samp || t < LP;
        bf16_t* xo = X + (size_t)row * D;
        if (!valid) { if (mode == 0) {
#pragma unroll
                for (int jj = 0; jj < 2; ++jj) *(u32x4*)(xo + 512 * jj + lane * 8) = (u32x4){0u, 0u, 0u, 0u}; }
            continue; }
        f32x4 v[4];
        if (mode == 0) {
            const float* s = samp ? p.x_sample + ((size_t)b * LS + t) * D : (t < NMETA ? p.meta + (size_t)t * D : p.x_prompt + ((size_t)b * SEQ + (t - NMETA)) * D);
#pragma unroll
            for (int j = 0; j < 4; ++j) v[j] = *(const f32x4*)(s + EOFF(j));
        } else {
            const bf16_t* s = src + (size_t)row * ldsrc;
#pragma unroll
            for (int jj = 0; jj < 2; ++jj) { const u32x4 u = *(const u32x4*)(s + 512 * jj + lane * 8); v[2 * jj] = (f32x4){bflo(u.x), bfhi(u.x), bflo(u.y), bfhi(u.y)}; v[2 * jj + 1] = (f32x4){bflo(u.z), bfhi(u.z), bflo(u.w), bfhi(u.w)}; }
            if (row >= SPLIT_ROW0) { const bf16_t* sp = (const bf16_t*)(p.ws + OFF_GH) + (size_t)(row - SPLIT_ROW0) * D;
#pragma unroll
                for (int q = 0; q < 3; ++q)
#pragma unroll
                    for (int jj = 0; jj < 2; ++jj) { const u32x4 u = *(const u32x4*)(sp + (size_t)q * (MROWS - SPLIT_ROW0) * D + 512 * jj + lane * 8); v[2 * jj] += (f32x4){bflo(u.x), bfhi(u.x), bflo(u.y), bfhi(u.y)}; v[2 * jj + 1] += (f32x4){bflo(u.z), bfhi(u.z), bflo(u.w), bfhi(u.w)}; } }
        }
        float sum = 0.f;
#pragma unroll
        for (int j = 0; j < 4; ++j) sum += (v[j][0] + v[j][1]) + (v[j][2] + v[j][3]);
        const float mean = red64(sum) * (1.f / D);
        float s2 = 0.f;
#pragma unroll
        for (int j = 0; j < 4; ++j) { v[j] = v[j] - mean; s2 += (v[j][0] * v[j][0] + v[j][1] * v[j][1]) + (v[j][2] * v[j][2] + v[j][3] * v[j][3]); }
        const float rstd = rsqrtf(red64(s2) * (1.f / D) + 1e-5f);
#pragma unroll
        for (int j = 0; j < 4; ++j) { const f32x4 g4 = *(const f32x4*)(gam + EOFF(j)), b4 = *(const f32x4*)(bet + EOFF(j)); v[j] = v[j] * rstd * g4 + b4; }
#pragma unroll
        for (int jj = 0; jj < 2; ++jj) *(u32x4*)(xo + 512 * jj + lane * 8) = (u32x4){pk2(v[2 * jj][0], v[2 * jj][1]), pk2(v[2 * jj][2], v[2 * jj][3]), pk2(v[2 * jj + 1][0], v[2 * jj + 1][1]), pk2(v[2 * jj + 1][2], v[2 * jj + 1][3])};
        if (final_out) {
            float* o = nullptr;
            if (samp) o = p.out + o_ys + ((size_t)b * LS + t) * D; else if (t >= NMETA) o = p.out + o_yp + ((size_t)b * SEQ + (t - NMETA)) * D;
            if (o) {
#pragma unroll
                for (int j = 0; j < 4; ++j) *(f32x4*)(o + EOFF(j)) = v[j]; }
        }
        if (gate_layer >= 0) {
            float mine = 0.f;
#pragma unroll 2
            for (int g = 0; g < 16; ++g) {
                float a = 0.f;
#pragma unroll
                for (int j = 0; j < 4; ++j) { const f32x4 w4 = *(const f32x4*)(wg + g * 1024 + EOFF(j)); a += (v[j][0] * w4[0] + v[j][1] * w4[1]) + (v[j][2] * w4[2] + v[j][3] * w4[3]); }
                a = red64(a);
                if (lane == g) mine = a;
            }
            if (lane < 16) G[(size_t)row * 16 + lane] = mine;
        }
    }
#undef EOFF
}

constexpr int BM = 256, BK = 64, HALF = 128, HT = HALF * BK, NXCD = 8, WGM = 8;
__device__ __forceinline__ int lds_byte(int r, int c) { int st = (r >> 4) * 2 + (c >> 5), rr = r & 15, cc = c & 31, ob = rr * 64 + cc * 2; return st * 1024 + (ob ^ (((ob >> 9) & 1) << 5)); }
__device__ __forceinline__ void stage_rc(int b, int& R, int& C) { int st = b / 1024, sb = b % 1024, swz = sb ^ (((sb >> 9) & 1) << 5); R = (st >> 1) * 16 + swz / 64; C = (st & 1) * 32 + (swz % 64) / 2; }

struct GemmArgs { const bf16_t* A; const bf16_t* A2; int a2_from_pn; int lda; const bf16_t* Bt; int M, N, K; int splitk; };

template <class Epi>
__device__ __forceinline__ void gemm_phase(const GemmArgs g, const Epi& epi, int wv) {
    extern __shared__ __attribute__((aligned(16))) unsigned char smem_raw[];
    bf16_t* shm = (bf16_t*)smem_raw;
#define SA(b, h) (shm + ((b) * 2 + (h)) * HT)
#define SB(b, h) (shm + (4 + (b) * 2 + (h)) * HT)
#define STAGE_A(P_, br, kt) do { const char* _gb = (const char*)(A + (size_t)(br) * lda + (size_t)((kt) + kofs) * BK); \
    unsigned _o0 = offA0, _o1 = offA1; asm volatile("" : "+v"(_o0), "+v"(_o1)); \
    __builtin_amdgcn_global_load_lds((const unsigned*)(_gb + _o0), (unsigned*)((char*)(P_) + tid * 16), 16, 0, 0); \
    __builtin_amdgcn_global_load_lds((const unsigned*)(_gb + _o1), (unsigned*)((char*)(P_) + tid * 16 + 8192), 16, 0, 0); } while (0)
#define STAGE_B(P_, bc, kt) do { const char* _gb = (const char*)(Bt + (size_t)(bc) * K + (size_t)((kt) + kofs) * BK); \
    unsigned _o0 = offB0, _o1 = offB1; asm volatile("" : "+v"(_o0), "+v"(_o1)); \
    __builtin_amdgcn_global_load_lds((const unsigned*)(_gb + _o0), (unsigned*)((char*)(P_) + tid * 16), 16, 0, 0); \
    __builtin_amdgcn_global_load_lds((const unsigned*)(_gb + _o1), (unsigned*)((char*)(P_) + tid * 16 + 8192), 16, 0, 0); } while (0)
#define LDA(dst, b, h) for (int m = 0; m < 4; ++m) for (int k = 0; k < 2; ++k) \
    dst[m][k] = *reinterpret_cast<const bf16x8*>((char*)SA(b, h) + lds_byte(wr * 64 + m * 16 + fr, k * 32 + fq * 8))
#define LDB(dst, b, h) for (int n = 0; n < 2; ++n) for (int k = 0; k < 2; ++k) \
    dst[n][k] = *reinterpret_cast<const bf16x8*>((char*)SB(b, h) + lds_byte(wc * 32 + n * 16 + fr, k * 32 + fq * 8))
#define MMA(ai, bj, At_, Bt_) do { __builtin_amdgcn_s_setprio(1); \
    for (int m = 0; m < 4; ++m) for (int n = 0; n < 2; ++n) for (int k = 0; k < 2; ++k) \
      acc[ai][bj][m][n] = __builtin_amdgcn_mfma_f32_16x16x32_bf16(Bt_[n][k], At_[m][k], acc[ai][bj][m][n], 0, 0, 0); \
    __builtin_amdgcn_s_setprio(0); } while (0)
#define WAIT_V(n) asm volatile("s_waitcnt vmcnt(" #n ")" ::: "memory")
#define WAIT_L(n) asm volatile("s_waitcnt lgkmcnt(" #n ")" ::: "memory")
#define BAR __builtin_amdgcn_s_barrier()
#define SCHED __builtin_amdgcn_sched_barrier(0)
    const int lda = g.lda, K = g.K; const bf16_t* Bt = g.Bt;
    const int nMall = g.M / BM, nN = g.N / BM, nM = g.splitk ? 64 : nMall, nwg = nM * nN, nunits = nwg + (nMall - nM) * nN * 4;
    const int tid = opaque_tid(wv);
    const int wid = tid >> 6, lane = tid & 63, wr = wid >> 2, wc = wid & 3, fr = lane & 15, fq = lane >> 4;
    const int ntK = K / BK;
    unsigned offA0, offA1, offB0, offB1;
    { int r0, c0, r1, c1; stage_rc(tid * 16, r0, c0); stage_rc(tid * 16 + 8192, r1, c1);
      offA0 = (unsigned)(r0 * lda + c0) * 2u; offA1 = (unsigned)(r1 * lda + c1) * 2u;
      const int p0 = (r0 & ~31) + 8 * ((r0 & 15) >> 2) + 4 * ((r0 >> 4) & 1) + (r0 & 3), p1 = (r1 & ~31) + 8 * ((r1 & 15) >> 2) + 4 * ((r1 >> 4) & 1) + (r1 & 3);
      offB0 = (unsigned)(p0 * K + c0) * 2u; offB1 = (unsigned)(p1 * K + c1) * 2u; }
    for (int Lt = blockIdx.x; Lt < nunits; Lt += gridDim.x) {
        int pm, pn, kofs = 0, nt = ntK, split = 0;
        if (Lt < nwg) {
            int wgid = Lt;
            { int q = nwg / NXCD, r = nwg % NXCD, xcd = wgid % NXCD, off = wgid / NXCD; wgid = (xcd < r ? xcd * (q + 1) : r * (q + 1) + (xcd - r) * q) + off; }
            const int nig = WGM * nN, gid = wgid / nig, fm = gid * WGM, gsz = min(nM - fm, WGM);
            pm = fm + ((wgid % nig) % gsz); pn = (wgid % nig) / gsz;
        } else {
            const int u = Lt - nwg, tl = u >> 2; split = u & 3; pm = nM + tl / nN; pn = tl % nN;
            const int q4 = ntK >> 2;
            if (q4 & 1) { nt = split < 2 ? q4 + 1 : q4 - 1; kofs = split < 2 ? split * (q4 + 1) : 2 * (q4 + 1) + (split - 2) * (q4 - 1); } else { nt = q4; kofs = split * q4; }
        }
        const int brow = pm * BM, bcol = pn * BM;
        const bf16_t* A = (pn >= g.a2_from_pn) ? g.A2 : g.A;
        f32x4 acc[2][2][4][2] = {};
        bf16x8 At[4][2], B0[2][2], B1[2][2];
        STAGE_B(SB(0, 0), bcol, 0); STAGE_A(SA(0, 0), brow, 0);
        STAGE_B(SB(0, 1), bcol + HALF, 0); STAGE_A(SA(0, 1), brow + HALF, 0);
        if (wr == 1) BAR;
        WAIT_V(4); BAR;
        STAGE_B(SB(1, 0), bcol, 1); STAGE_A(SA(1, 0), brow, 1); STAGE_B(SB(1, 1), bcol + HALF, 1);
        WAIT_V(6); BAR;
        for (int t = 0; t < nt - 2; t += 2) {
            LDB(B0, 0, 0); SCHED; LDA(At, 0, 0); STAGE_A(SA(1, 1), brow + HALF, t + 1);
            WAIT_L(8); BAR; WAIT_L(0); MMA(0, 0, At, B0); BAR; SCHED;
            LDB(B1, 0, 1); STAGE_B(SB(0, 0), bcol, t + 2);
            BAR; WAIT_L(0); MMA(0, 1, At, B1); BAR;
            LDA(At, 0, 1); STAGE_A(SA(0, 0), brow, t + 2);
            BAR; WAIT_L(0); MMA(1, 0, At, B0); BAR; SCHED;
            STAGE_B(SB(0, 1), bcol + HALF, t + 2);
            WAIT_V(6); BAR; MMA(1, 1, At, B1); BAR;
            LDB(B0, 1, 0); SCHED; LDA(At, 1, 0); STAGE_A(SA(0, 1), brow + HALF, t + 2);
            WAIT_L(8); BAR; WAIT_L(0); MMA(0, 0, At, B0); BAR; SCHED;
            LDB(B1, 1, 1); STAGE_B(SB(1, 0), bcol, t + 3);
            BAR; WAIT_L(0); MMA(0, 1, At, B1); BAR;
            LDA(At, 1, 1); STAGE_A(SA(1, 0), brow, t + 3);
            BAR; WAIT_L(0); MMA(1, 0, At, B0); BAR; SCHED;
            STAGE_B(SB(1, 1), bcol + HALF, t + 3);
            WAIT_V(6); BAR; MMA(1, 1, At, B1); BAR;
        }
        { LDB(B0, 0, 0); LDA(At, 0, 0); STAGE_A(SA(1, 1), brow + HALF, nt - 1);
          BAR; WAIT_L(0); MMA(0, 0, At, B0); BAR;
          LDB(B1, 0, 1); BAR; WAIT_L(0); MMA(0, 1, At, B1); BAR;
          LDA(At, 0, 1); WAIT_V(4); BAR; WAIT_L(0); MMA(1, 0, At, B0); MMA(1, 1, At, B1); BAR; }
        { LDB(B0, 1, 0); LDA(At, 1, 0); WAIT_V(2); BAR; WAIT_L(0); MMA(0, 0, At, B0); BAR;
          LDB(B1, 1, 1); WAIT_V(0); BAR; WAIT_L(0); MMA(0, 1, At, B1); BAR;
          LDA(At, 1, 1); BAR; WAIT_L(0); MMA(1, 0, At, B0); MMA(1, 1, At, B1); BAR; }
        if (wr == 0) BAR;
        int erow = brow + wr * 64 + fr, ecol = bcol + wc * 32 + fq * 8;
        asm volatile("" : "+v"(erow), "+v"(ecol));
#pragma unroll
        for (int ai = 0; ai < 2; ++ai)
#pragma unroll
            for (int m = 0; m < 4; ++m) {
                const int row = erow + ai * HALF + m * 16;
#pragma unroll
                for (int bj = 0; bj < 2; ++bj) epi(row, ecol + bj * HALF, acc[ai][bj][m][0], acc[ai][bj][m][1], split);
                if (m & 1) SCHED;
            }
    }
#undef SA
#undef SB
}

struct EpiP {
    bf16_t* P; bf16_t* GH; float* out; int l;
    __device__ __forceinline__ void operator()(int row, int col, f32x4 v, f32x4 w, int split) const {
        const u32x4 o = (u32x4){pk2(v[0], v[1]), pk2(v[2], v[3]), pk2(w[0], w[1]), pk2(w[2], w[3])};
        *(u32x4*)(P + (size_t)row * NP + col) = o;
        if (col >= cBQ && col < cZ) {
            const int c = col - cBQ;
            if ((row & 31) >= 29) *(u32x4*)(GH + ((size_t)(row >> 5) * 3 + ((row & 31) - 29)) * 1536 + c) = o;
            if (row < SROW0) { const int b = row / LPAD, t = row - b * LPAD; if (t >= LP - 3 && t < LP) { float* d = out + o_pgc + ((size_t)(l * NB + b) * 3 + (t - (LP - 3))) * 1536 + c; *(f32x4*)d = v; *(f32x4*)(d + 4) = w; } }
            else { const int s = (row - SROW0) >> 2, t = row & 3; if (t >= 1) { float* d = out + o_sgc + ((size_t)(l * NS + s) * 3 + (t - 1)) * 1536 + c; *(f32x4*)d = v; *(f32x4*)(d + 4) = w; } }
        }
    }
};
struct EpiMerge {
    bf16_t* P;
    __device__ __forceinline__ void operator()(int row, int col, f32x4 v, f32x4 w, int split) const {
        u32x4* ptr = (u32x4*)(P + (size_t)row * NP + cMG + col); const u32x4 gm = *ptr;
        v[0] *= sigmoidf_(bflo(gm.x)); v[1] *= sigmoidf_(bfhi(gm.x)); v[2] *= sigmoidf_(bflo(gm.y)); v[3] *= sigmoidf_(bfhi(gm.y));
        w[0] *= sigmoidf_(bflo(gm.z)); w[1] *= sigmoidf_(bfhi(gm.z)); w[2] *= sigmoidf_(bflo(gm.w)); w[3] *= sigmoidf_(bfhi(gm.w));
        *ptr = (u32x4){pk2(v[0], v[1]), pk2(v[2], v[3]), pk2(w[0], w[1]), pk2(w[2], w[3])};
    }
};
struct EpiRes {
    const bf16_t* X; bf16_t* O; int ldo; int ocol0; bf16_t* SCR;
    __device__ __forceinline__ void operator()(int row, int col, f32x4 v, f32x4 w, int split) const {
        if (split == 0) {
            const u32x4 x = *(const u32x4*)(X + (size_t)row * D + col);
            v[0] += ALPHA * bflo(x.x); v[1] += ALPHA * bfhi(x.x); v[2] += ALPHA * bflo(x.y); v[3] += ALPHA * bfhi(x.y);
            w[0] += ALPHA * bflo(x.z); w[1] += ALPHA * bfhi(x.z); w[2] += ALPHA * bflo(x.w); w[3] += ALPHA * bfhi(x.w);
            *(u32x4*)(O + (size_t)row * ldo + ocol0 + col) = (u32x4){pk2(v[0], v[1]), pk2(v[2], v[3]), pk2(w[0], w[1]), pk2(w[2], w[3])};
        } else *(u32x4*)(SCR + ((size_t)(split - 1) * (MROWS - SPLIT_ROW0) + (row - SPLIT_ROW0)) * D + col) = (u32x4){pk2(v[0], v[1]), pk2(v[2], v[3]), pk2(w[0], w[1]), pk2(w[2], w[3])};
    }
};
struct EpiUp {
    bf16_t* U; bf16_t* HB; float* out; int l;
    __device__ __forceinline__ void operator()(int row, int col, f32x4 v, f32x4 w, int split) const {
        const u32x4 o = (u32x4){pk2(v[0], v[1]), pk2(v[2], v[3]), pk2(w[0], w[1]), pk2(w[2], w[3])};
        *(u32x4*)(U + (size_t)row * NU + col) = o;
        if ((row & 31) >= 30) *(u32x4*)(HB + ((size_t)(row >> 5) * 2 + (row & 1)) * NU + col) = o;
        if (row < SROW0) { const int b = row / LPAD, t = row - b * LPAD; if (t >= LP - 2 && t < LP) { float* d = out + o_pfc + ((size_t)(l * NB + b) * 2 + (t - (LP - 2))) * NU + col; *(f32x4*)d = v; *(f32x4*)(d + 4) = w; } }
        else { const int s = (row - SROW0) >> 2, t = row & 3; if (t >= 2) { float* d = out + o_sfc + ((size_t)(l * NS + s) * 2 + (t - 2)) * NU + col; *(f32x4*)d = v; *(f32x4*)(d + 4) = w; } }
    }
};

constexpr int SBUF = 32 * 128 * 2 + 32 * 32 + 32 * 16;
__device__ __forceinline__ float* QB(float* lds, int b) { return lds + b * SBUF; }
__device__ __forceinline__ float* KB(float* lds, int b) { return lds + b * SBUF + 4096; }
__device__ __forceinline__ float* VB(float* lds, int b) { return lds + b * SBUF + 8192; }
__device__ __forceinline__ float* SCB(float* lds, int b) { return lds + b * SBUF + 9216; }
__device__ __forceinline__ float* OB(float* lds, int b) { return lds + 2 * SBUF + b * 1024; }

__device__ __forceinline__ void store_out_blk(bf16_t* P, int row0, int jb, int L, int pcol, const float* ob, int ptid) {
    const int tt = ptid >> 3, g = ptid & 7, t0 = jb * 32;
    if (t0 + tt < L) { const f32x4 v = *(const f32x4*)(ob + tt * 32 + g * 4);
        *(u32x2*)(P + (size_t)(row0 + t0 + tt) * NP + pcol + g * 4) = (u32x2){pk2(v[0], v[1]), pk2(v[2], v[3])}; }
}
__device__ __forceinline__ f32x2 lo2(f32x4 v) { return __builtin_shufflevector(v, v, 0, 1); }
__device__ __forceinline__ f32x2 hi2(f32x4 v) { return __builtin_shufflevector(v, v, 2, 3); }
__device__ __forceinline__ f32x2 bc2(float x) { return (f32x2){x, x}; }
__device__ __forceinline__ float dot16(const f32x4* a, const float* kp) {
    float s = 0.f;
#pragma unroll
    for (int i = 0; i < 4; ++i) { const f32x4 b = *(const f32x4*)(kp + 4 * i); s += (a[i][0] * b[0] + a[i][1] * b[1]) + (a[i][2] * b[2] + a[i][3] * b[3]); }
    return s;
}

struct StageRegs { f32x4 &q0, &q1, &k0, &k1, &v, &r0, &x0, &x1; };
__device__ __forceinline__ f32x4 asf(u32x4 u) { return __builtin_bit_cast(f32x4, u); }
__device__ __forceinline__ u32x4 asu(f32x4 f) { return __builtin_bit_cast(u32x4, f); }
#define BARRIER_LDS() asm volatile("s_waitcnt lgkmcnt(0)\n\ts_barrier" ::: "memory")
__device__ __forceinline__ void issue_mlstm(const Params& p, int h, int qtr, int row0, int L, int jb, int ptid, StageRegs& r) {
    const bf16_t* P = (const bf16_t*)(p.ws + OFF_P); const float* G = (const float*)(p.ws + OFF_G);
    const int tt = ptid >> 3, g = ptid & 7, t0 = jb * 32;
    if (t0 + tt >= L) return;
    const int row = row0 + t0 + tt;
    const bf16_t* prow = P + (size_t)row * NP;
    r.q0 = asf(*(const u32x4*)(prow + cQ + h * 128 + g * 16)); r.q1 = asf(*(const u32x4*)(prow + cQ + h * 128 + g * 16 + 8));
    r.k0 = asf(*(const u32x4*)(prow + cK + h * 128 + g * 16)); r.k1 = asf(*(const u32x4*)(prow + cK + h * 128 + g * 16 + 8));
    { const u32x2 vv_ = *(const u32x2*)(prow + cV + h * 128 + qtr * 32 + g * 4); r.v = asf((u32x4){vv_.x, vv_.y, 0u, 0u}); }
    if (g == 0) { const float* gr = G + (size_t)row * 16; r.r0 = (f32x4){gr[h], gr[4 + h], 0.f, 0.f}; }
}
__device__ __forceinline__ void commit_mlstm(const Params& p, int l, int h, int L, int jb, float* lds, int ptid, const StageRegs& r, int bsel = -1) {
    const int tt = ptid >> 3, g = ptid & 7, t0 = jb * 32, b = bsel >= 0 ? bsel : (jb & 1);
    if (t0 + tt >= L) return;
    float x[16]; f32x4 qs[4];
    unpack8(asu(r.q0), x); unpack8(asu(r.q1), x + 8);
    float* qd = QB(lds, b) + tt * 128 + g * 16;
#pragma unroll
    for (int i = 0; i < 4; ++i) { qs[i] = (f32x4){x[4 * i], x[4 * i + 1], x[4 * i + 2], x[4 * i + 3]} * 0.08838834764831845f; *(f32x4*)(qd + 4 * i) = qs[i]; }
    unpack8(asu(r.k0), x); unpack8(asu(r.k1), x + 8);
    float* kd = KB(lds, b) + tt * 128 + g * 16;
#pragma unroll
    for (int i = 0; i < 4; ++i) *(f32x4*)(kd + 4 * i) = (f32x4){x[4 * i], x[4 * i + 1], x[4 * i + 2], x[4 * i + 3]};
    *(f32x4*)(VB(lds, b) + tt * 32 + g * 4) = (f32x4){bflo(asu(r.v).x), bfhi(asu(r.v).x), bflo(asu(r.v).y), bfhi(asu(r.v).y)};
    const float* kmb = KB(lds, b) + (tt & ~3) * 128 + g * 16;
    f32x4 qk;
#pragma unroll
    for (int j = 0; j < 4; ++j) qk[j] = red8(dot16(qs, kmb + j * 128));
    if (g == 0) {
        const float ig = r.r0[0] + p.gate_bias[l * 8 + h], f = r.r0[1] + p.gate_bias[l * 8 + 4 + h];
        const float lf = fminf(f, 0.f) - log1pf(__expf(-fabsf(f)));
        float* sc = SCB(lds, b) + tt * 16; *(f32x2*)sc = (f32x2){ig, lf}; *(f32x4*)(sc + 4) = qk; }
}

__device__ __forceinline__ void scan_mlstm(const Params& p, int l, bool samp, int bs, int h, int qtr, int row0, int L, float* lds) {
    const int tid = opaque_tid(p.wv); const bool cons = tid < 256; const int ptid = tid - 256;
    const int lane = tid & 63, w = (tid >> 6) & 3, s = lane & 7, cl = w * 8 + (lane >> 3), col = qtr * 32 + cl;
    const int e2 = 2 * (lane >> 3), nd = (e2 >> 2) * 32 + s * 4 + (e2 & 3);
    bf16_t* P = (bf16_t*)(p.ws + OFF_P);
    f32x2 C[8]; float n0v = 0.f, n1v = 0.f, m = 0.f;
#pragma unroll
    for (int e = 0; e < 8; ++e) C[e] = bc2(0.f);
    if (cons && samp) {
        const size_t sh = (size_t)(l * NS + bs) * 4 + h;
        const float* C0 = p.st_C + sh * 16384;
#pragma unroll
        for (int e = 0; e < 16; ++e) { const int d = (e >> 2) * 32 + s * 4 + (e & 3); C[e >> 1][e & 1] = C0[d * 128 + col]; }
        n0v = p.st_n[sh * 128 + nd]; n1v = p.st_n[sh * 128 + nd + 1]; m = p.st_m[sh];
    }
    const int nblk = (L + 31) >> 5;
    f32x4 k4[4][4];
    StageRegs sr{k4[0][0], k4[0][1], k4[0][2], k4[0][3], k4[1][0], k4[1][1], k4[1][2], k4[1][3]};
    if (!cons) { issue_mlstm(p, h, qtr, row0, L, 0, ptid, sr); commit_mlstm(p, l, h, L, 0, lds, ptid, sr); if (1 < nblk) issue_mlstm(p, h, qtr, row0, L, 1, ptid, sr); }
    BARRIER_LDS();
    for (int jb = 0; jb < nblk; ++jb) {
        if (!cons) {
            if (jb + 1 < nblk) commit_mlstm(p, l, h, L, jb + 1, lds, ptid, sr);
            if (jb + 2 < nblk) issue_mlstm(p, h, qtr, row0, L, jb + 2, ptid, sr);
            if (jb > 0) store_out_blk(P, row0, jb - 1, L, cV + h * 128 + qtr * 32, OB(lds, (jb - 1) & 1), ptid);
        } else {
            const float* qb = QB(lds, jb & 1); const float* kb = KB(lds, jb & 1); const float* vb = VB(lds, jb & 1); const float* sc = SCB(lds, jb & 1);
            float* ob = OB(lds, jb & 1);
            const int nt = min(32, L - jb * 32);
            f32x4 q4[4][4]; f32x2 kn[4], qn[4]; float vv[4], ig[4], lf[4]; f32x4 qk[4];
#define MLOAD_Q(T0) do { _Pragma("unroll") for (int i = 0; i < 4; ++i) { const int t = (T0) + i; \
        _Pragma("unroll") for (int j = 0; j < 4; ++j) q4[i][j] = *(const f32x4*)(qb + t * 128 + j * 32 + s * 4); \
        qn[i] = *(const f32x2*)(qb + t * 128 + nd); } } while (0)
#define MLOAD_K(T0) do { _Pragma("unroll") for (int i = 0; i < 4; ++i) { const int t = (T0) + i; \
        const f32x2 gg = *(const f32x2*)(sc + t * 16); ig[i] = gg[0]; lf[i] = gg[1]; \
        qk[i] = *(const f32x4*)(sc + t * 16 + 4); vv[i] = vb[t * 32 + cl]; } \
      _Pragma("unroll") for (int i = 0; i < 4; ++i) { const int t = (T0) + i; \
        _Pragma("unroll") for (int j = 0; j < 4; ++j) k4[i][j] = *(const f32x4*)(kb + t * 128 + j * 32 + s * 4); \
        kn[i] = *(const f32x2*)(kb + t * 128 + nd); } } while (0)
            MLOAD_Q(0); MLOAD_K(0);
#pragma unroll 1
            for (int t0 = 0; t0 < nt; t0 += 4) {
                float d[4], dn[4];
                const int tn = min(t0 + 4, 28);
                __builtin_amdgcn_sched_barrier(0);
#pragma unroll
                for (int i = 0; i < 4; ++i) {
                    f32x2 a = bc2(0.f), a2 = bc2(0.f);
#pragma unroll
                    for (int j = 0; j < 4; ++j) { a = lo2(q4[i][j]) * C[2 * j] + a; a2 = hi2(q4[i][j]) * C[2 * j + 1] + a2; }
                    a = a + a2;
                    d[i] = a[0] + a[1]; dn[i] = qn[i][0] * n0v + qn[i][1] * n1v;
                }
                __builtin_amdgcn_sched_barrier(0);
                MLOAD_Q(tn);
                __builtin_amdgcn_sched_barrier(0);
#pragma unroll
                for (int i = 0; i < 4; ++i) { d[i] = red8(d[i]); dn[i] = red64(dn[i]); }
                float fp[4], ip[4], em[4];
#pragma unroll
                for (int i = 0; i < 4; ++i) { const float mn = fmaxf(lf[i] + m, ig[i]); fp[i] = __expf(lf[i] + m - mn); ip[i] = __expf(ig[i] - mn); em[i] = __expf(-mn); m = mn; }
                const float F0 = fp[0], F1 = F0 * fp[1], F2 = F1 * fp[2], F3 = F2 * fp[3];
                const float g00 = ip[0], g10 = g00 * fp[1], g11 = ip[1], g20 = g10 * fp[2], g21 = g11 * fp[2], g22 = ip[2];
                const float g30 = g20 * fp[3], g31 = g21 * fp[3], g32 = g22 * fp[3], g33 = ip[3];
                const float s00 = g00 * qk[0][0];
                const float s10 = g10 * qk[1][0], s11 = g11 * qk[1][1];
                const float s20 = g20 * qk[2][0], s21 = g21 * qk[2][1], s22 = g22 * qk[2][2];
                const float s30 = g30 * qk[3][0], s31 = g31 * qk[3][1], s32 = g32 * qk[3][2], s33 = g33 * qk[3][3];
                const float num0 = F0 * d[0] + s00 * vv[0], den0 = F0 * dn[0] + s00;
                const float num1 = F1 * d[1] + s10 * vv[0] + s11 * vv[1], den1 = F1 * dn[1] + s10 + s11;
                const float num2 = F2 * d[2] + s20 * vv[0] + s21 * vv[1] + s22 * vv[2], den2 = F2 * dn[2] + s20 + s21 + s22;
                const float num3 = F3 * d[3] + s30 * vv[0] + s31 * vv[1] + s32 * vv[2] + s33 * vv[3], den3 = F3 * dn[3] + s30 + s31 + s32 + s33;
                if (s == 0) {
                    ob[(t0 + 0) * 32 + cl] = num0 / fmaxf(fabsf(den0), em[0]); ob[(t0 + 1) * 32 + cl] = num1 / fmaxf(fabsf(den1), em[1]);
                    ob[(t0 + 2) * 32 + cl] = num2 / fmaxf(fabsf(den2), em[2]); ob[(t0 + 3) * 32 + cl] = num3 / fmaxf(fabsf(den3), em[3]);
                }
                const float c0 = g30 * vv[0], c1 = g31 * vv[1], c2 = g32 * vv[2], c3 = g33 * vv[3];
#pragma unroll
                for (int j = 0; j < 4; ++j) {
                    C[2 * j] = lo2(k4[3][j]) * bc2(c3) + (lo2(k4[2][j]) * bc2(c2) + (lo2(k4[1][j]) * bc2(c1) + (lo2(k4[0][j]) * bc2(c0) + C[2 * j] * bc2(F3))));
                    C[2 * j + 1] = hi2(k4[3][j]) * bc2(c3) + (hi2(k4[2][j]) * bc2(c2) + (hi2(k4[1][j]) * bc2(c1) + (hi2(k4[0][j]) * bc2(c0) + C[2 * j + 1] * bc2(F3)))); }
                n0v = n0v * F3 + (kn[0][0] * g30 + kn[1][0] * g31) + (kn[2][0] * g32 + kn[3][0] * g33);
                n1v = n1v * F3 + (kn[0][1] * g30 + kn[1][1] * g31) + (kn[2][1] * g32 + kn[3][1] * g33);
                __builtin_amdgcn_sched_barrier(0);
                MLOAD_K(tn);
            }
#undef MLOAD_Q
#undef MLOAD_K
        }
        BARRIER_LDS();
    }
    if (!cons) store_out_blk(P, row0, nblk - 1, L, cV + h * 128 + qtr * 32, OB(lds, (nblk - 1) & 1), ptid);
    else {
        const size_t sh = samp ? (size_t)(l * NS + bs) * 4 + h : (size_t)(l * NB + bs) * 4 + h;
        float* Co = p.out + (samp ? o_sC : o_pC) + sh * 16384;
#pragma unroll
        for (int e = 0; e < 16; ++e) { const int d = (e >> 2) * 32 + s * 4 + (e & 3); Co[d * 128 + col] = C[e >> 1][e & 1]; }
        if (qtr == 0 && w == 0) { float* no = p.out + (samp ? o_sn : o_pn) + sh * 128; no[nd] = n0v; no[nd + 1] = n1v;
            if (lane == 0) p.out[(samp ? o_sm : o_pm) + sh] = m; }
    }
    BARRIER_LDS();
}


constexpr int ST_LD = 33;
__device__ __forceinline__ float* STB(float* lds, int b) { return lds + 2 * SBUF + 2048 + b * (128 * ST_LD); }
__device__ __forceinline__ void st_issue(const float* S0, int qtr, int ptid, f32x4& a0, f32x4& a1, f32x4& a2, f32x4& a3) {
    const int d = ptid >> 3, c = (ptid & 7) * 4; const float* b = S0 + d * 128 + qtr * 32 + c;
    a0 = *(const f32x4*)b; a1 = *(const f32x4*)(b + 32 * 128); a2 = *(const f32x4*)(b + 64 * 128); a3 = *(const f32x4*)(b + 96 * 128);
}
__device__ __forceinline__ void st_commit(float* st, int ptid, const f32x4& a0, const f32x4& a1, const f32x4& a2, const f32x4& a3) {
    const int d = ptid >> 3, c = (ptid & 7) * 4; float* b = st + d * ST_LD + c;
#pragma unroll
    for (int i = 0; i < 4; ++i) { b[i] = a0[i]; b[32 * ST_LD + i] = a1[i]; b[64 * ST_LD + i] = a2[i]; b[96 * ST_LD + i] = a3[i]; }
}
__device__ __forceinline__ void st_store(float* So, int qtr, const float* st, int ptid) {
    const int d = ptid >> 3, c = (ptid & 7) * 4; const float* b = st + d * ST_LD + c; float* o = So + d * 128 + qtr * 32 + c;
#pragma unroll
    for (int q = 0; q < 4; ++q) *(f32x4*)(o + q * 32 * 128) = (f32x4){b[q * 32 * ST_LD], b[q * 32 * ST_LD + 1], b[q * 32 * ST_LD + 2], b[q * 32 * ST_LD + 3]};
}
__device__ __forceinline__ void scan_mlstm_stream(const Params& p, int l, int h, int qtr, int bs0, int nseq, float* lds) {
    const int tid = opaque_tid(p.wv); const bool cons = tid < 256; const int ptid = tid - 256;
    const int lane = tid & 63, w = (tid >> 6) & 3, s = lane & 7, cl = w * 8 + (lane >> 3), col = qtr * 32 + cl;
    const int e2 = 2 * (lane >> 3), nd = (e2 >> 2) * 32 + s * 4 + (e2 & 3);
    bf16_t* P = (bf16_t*)(p.ws + OFF_P);
    f32x2 C[8]; float n0v = 0.f, n1v = 0.f, m = 0.f, n0n = 0.f, n1n = 0.f, mnx = 0.f;
#pragma unroll
    for (int e = 0; e < 8; ++e) C[e] = bc2(0.f);
    f32x4 k4[4][4];
    StageRegs sr{k4[0][0], k4[0][1], k4[0][2], k4[0][3], k4[1][0], k4[1][1], k4[1][2], k4[1][3]};
#define LOADSTATE(BS) do { const size_t sh_ = (size_t)(l * NS + (BS)) * 4 + h; n0n = p.st_n[sh_ * 128 + nd]; n1n = p.st_n[sh_ * 128 + nd + 1]; mnx = p.st_m[sh_]; } while (0)
#define STISSUE(BS) st_issue(p.st_C + ((size_t)(l * NS + (BS)) * 4 + h) * 16384, qtr, ptid, k4[2][0], k4[2][1], k4[2][2], k4[2][3])
    if (!cons) { issue_mlstm(p, h, qtr, SROW0 + bs0 * 4, LS, 0, ptid, sr); STISSUE(bs0); } else LOADSTATE(bs0);
#pragma unroll 1
    for (int k = 0; k < nseq; ++k) {
        const int bs = bs0 + 8 * k, row0 = SROW0 + bs * 4;
        if (!cons) { commit_mlstm(p, l, h, LS, 0, lds, ptid, sr, k & 1); st_commit(STB(lds, k & 1), ptid, k4[2][0], k4[2][1], k4[2][2], k4[2][3]);
            if (k + 1 < nseq) { issue_mlstm(p, h, qtr, row0 + 32, LS, 0, ptid, sr); STISSUE(bs + 8); } }
        else {
            n0v = n0n; n1v = n1n; m = mnx;
            if (k + 1 < nseq) LOADSTATE(bs + 8);
        }
        BARRIER_LDS();
        if (!cons) { if (k > 0) { store_out_blk(P, row0 - 32, 0, LS, cV + h * 128 + qtr * 32, OB(lds, (k - 1) & 1), ptid); st_store(p.out + o_sC + ((size_t)(l * NS + bs - 8) * 4 + h) * 16384, qtr, STB(lds, (k - 1) & 1), ptid); } }
        else {
            const float* qb = QB(lds, k & 1); const float* kb = KB(lds, k & 1); const float* vb = VB(lds, k & 1); const float* sc = SCB(lds, k & 1);
            float* ob = OB(lds, k & 1); float* stb = STB(lds, k & 1);
#pragma unroll
            for (int e = 0; e < 16; ++e) { const int d = (e >> 2) * 32 + s * 4 + (e & 3); C[e >> 1][e & 1] = stb[d * ST_LD + cl]; }
            f32x4 q4[4][4]; f32x2 kn[4], qn[4]; float vv[4], ig[4], lf[4]; f32x4 qk[4];
#define MLOAD_Q(T0) do { _Pragma("unroll") for (int i = 0; i < 4; ++i) { const int t = (T0) + i; \
        _Pragma("unroll") for (int j = 0; j < 4; ++j) q4[i][j] = *(const f32x4*)(qb + t * 128 + j * 32 + s * 4); \
        qn[i] = *(const f32x2*)(qb + t * 128 + nd); } } while (0)
#define MLOAD_K(T0) do { _Pragma("unroll") for (int i = 0; i < 4; ++i) { const int t = (T0) + i; \
        const f32x2 gg = *(const f32x2*)(sc + t * 16); ig[i] = gg[0]; lf[i] = gg[1]; \
        qk[i] = *(const f32x4*)(sc + t * 16 + 4); vv[i] = vb[t * 32 + cl]; } \
      _Pragma("unroll") for (int i = 0; i < 4; ++i) { const int t = (T0) + i; \
        _Pragma("unroll") for (int j = 0; j < 4; ++j) k4[i][j] = *(const f32x4*)(kb + t * 128 + j * 32 + s * 4); \
        kn[i] = *(const f32x2*)(kb + t * 128 + nd); } } while (0)
            MLOAD_Q(0); MLOAD_K(0);
            {
                float d[4], dn[4];
                __builtin_amdgcn_sched_barrier(0);
#pragma unroll
                for (int i = 0; i < 4; ++i) {
                    f32x2 a = bc2(0.f), a2 = bc2(0.f);
#pragma unroll
                    for (int j = 0; j < 4; ++j) { a = lo2(q4[i][j]) * C[2 * j] + a; a2 = hi2(q4[i][j]) * C[2 * j + 1] + a2; }
                    a = a + a2;
                    d[i] = a[0] + a[1]; dn[i] = qn[i][0] * n0v + qn[i][1] * n1v;
                }
                __builtin_amdgcn_sched_barrier(0);
#pragma unroll
                for (int i = 0; i < 4; ++i) { d[i] = red8(d[i]); dn[i] = red64(dn[i]); }
                float fp[4], ip[4], em[4];
#pragma unroll
                for (int i = 0; i < 4; ++i) { const float mn = fmaxf(lf[i] + m, ig[i]); fp[i] = __expf(lf[i] + m - mn); ip[i] = __expf(ig[i] - mn); em[i] = __expf(-mn); m = mn; }
                const float F0 = fp[0], F1 = F0 * fp[1], F2 = F1 * fp[2], F3 = F2 * fp[3];
                const float g00 = ip[0], g10 = g00 * fp[1], g11 = ip[1], g20 = g10 * fp[2], g21 = g11 * fp[2], g22 = ip[2];
                const float g30 = g20 * fp[3], g31 = g21 * fp[3], g32 = g22 * fp[3], g33 = ip[3];
                const float s00 = g00 * qk[0][0];
                const float s10 = g10 * qk[1][0], s11 = g11 * qk[1][1];
                const float s20 = g20 * qk[2][0], s21 = g21 * qk[2][1], s22 = g22 * qk[2][2];
                const float s30 = g30 * qk[3][0], s31 = g31 * qk[3][1], s32 = g32 * qk[3][2], s33 = g33 * qk[3][3];
                const float num0 = F0 * d[0] + s00 * vv[0], den0 = F0 * dn[0] + s00;
                const float num1 = F1 * d[1] + s10 * vv[0] + s11 * vv[1], den1 = F1 * dn[1] + s10 + s11;
                const float num2 = F2 * d[2] + s20 * vv[0] + s21 * vv[1] + s22 * vv[2], den2 = F2 * dn[2] + s20 + s21 + s22;
                const float num3 = F3 * d[3] + s30 * vv[0] + s31 * vv[1] + s32 * vv[2] + s33 * vv[3], den3 = F3 * dn[3] + s30 + s31 + s32 + s33;
                if (s == 0) {
                    ob[0 * 32 + cl] = num0 / fmaxf(fabsf(den0), em[0]); ob[1 * 32 + cl] = num1 / fmaxf(fabsf(den1), em[1]);
                    ob[2 * 32 + cl] = num2 / fmaxf(fabsf(den2), em[2]); ob[3 * 32 + cl] = num3 / fmaxf(fabsf(den3), em[3]);
                }
                const float c0 = g30 * vv[0], c1 = g31 * vv[1], c2 = g32 * vv[2], c3 = g33 * vv[3];
#pragma unroll
                for (int j = 0; j < 4; ++j) {
                    C[2 * j] = lo2(k4[3][j]) * bc2(c3) + (lo2(k4[2][j]) * bc2(c2) + (lo2(k4[1][j]) * bc2(c1) + (lo2(k4[0][j]) * bc2(c0) + C[2 * j] * bc2(F3))));
                    C[2 * j + 1] = hi2(k4[3][j]) * bc2(c3) + (hi2(k4[2][j]) * bc2(c2) + (hi2(k4[1][j]) * bc2(c1) + (hi2(k4[0][j]) * bc2(c0) + C[2 * j + 1] * bc2(F3)))); }
                n0v = n0v * F3 + (kn[0][0] * g30 + kn[1][0] * g31) + (kn[2][0] * g32 + kn[3][0] * g33);
                n1v = n1v * F3 + (kn[0][1] * g30 + kn[1][1] * g31) + (kn[2][1] * g32 + kn[3][1] * g33);
            }
#undef MLOAD_Q
#undef MLOAD_K
            const size_t sh = (size_t)(l * NS + bs) * 4 + h;
#pragma unroll
            for (int e = 0; e < 16; ++e) { const int d = (e >> 2) * 32 + s * 4 + (e & 3); stb[d * ST_LD + cl] = C[e >> 1][e & 1]; }
            if (qtr == 0 && w == 0) { float* no = p.out + o_sn + sh * 128; no[nd] = n0v; no[nd + 1] = n1v; if (lane == 0) p.out[o_sm + sh] = m; }
        }
    }
    BARRIER_LDS();
    if (!cons) { store_out_blk(P, SROW0 + (bs0 + 8 * (nseq - 1)) * 4, 0, LS, cV + h * 128 + qtr * 32, OB(lds, (nseq - 1) & 1), ptid); st_store(p.out + o_sC + ((size_t)(l * NS + bs0 + 8 * (nseq - 1)) * 4 + h) * 16384, qtr, STB(lds, (nseq - 1) & 1), ptid); }
    BARRIER_LDS();
#undef LOADSTATE
#undef STISSUE
}


typedef float f32x16 __attribute__((ext_vector_type(16)));
#define MFMA32(a, b, c) __builtin_amdgcn_mfma_f32_32x32x16_bf16((a), (b), (c), 0, 0, 0)
__device__ __forceinline__ int crow(int reg, int hf) { return (reg & 3) + 8 * (reg >> 2) + 4 * hf; }
__device__ __forceinline__ bf16x8 pack_step(const f32x16& x, int s) {
    u32x4 pk;
    asm volatile("s_nop 7\n\ts_nop 3\n\tv_cvt_pk_bf16_f32 %0, %4, %5\n\tv_cvt_pk_bf16_f32 %1, %6, %7\n\tv_cvt_pk_bf16_f32 %2, %8, %9\n\tv_cvt_pk_bf16_f32 %3, %10, %11\n\ts_nop 1"
                 : "=&v"(pk[0]), "=&v"(pk[1]), "=&v"(pk[2]), "=&v"(pk[3])
                 : "v"(x[8 * s]), "v"(x[8 * s + 1]), "v"(x[8 * s + 2]), "v"(x[8 * s + 3]), "v"(x[8 * s + 4]), "v"(x[8 * s + 5]), "v"(x[8 * s + 6]), "v"(x[8 * s + 7]));
    return __builtin_bit_cast(bf16x8, pk);
}
__device__ __forceinline__ bf16x8 frag_n(const bf16_t* base, int ld, int r, int hf, int kb) { return *(const bf16x8*)(base + r * ld + kb * 16 + hf * 8); }
__device__ __forceinline__ bf16x8 frag_p(const bf16_t* base, int ld, int r, int hf, int k0) {
    const u32x2 a = *(const u32x2*)(base + r * ld + k0 + 4 * hf), b = *(const u32x2*)(base + r * ld + k0 + 8 + 4 * hf);
    return __builtin_bit_cast(bf16x8, (u32x4){a.x, a.y, b.x, b.y});
}
__device__ __forceinline__ int kto(int d) { return d * 40 + (d >> 4) * 8; }
__device__ __forceinline__ bf16_t f2bf(float x) { return (bf16_t)(pk2(x, 0.f) & 0xffffu); }

constexpr int CH_LDQ = 136, CH_LDS = 40;
constexpr int CH_QB = 0, CH_KB = 8704, CH_KWT = 17408, CH_VT = 27904, CH_SW = 33024, CH_SC = 35584, CH_QW = 36608, CH_SLOT = 45312, CH_OB = 2 * CH_SLOT;
constexpr int SC_U = 0, SC_B = 32, SC_PM = 64;

__device__ __forceinline__ void store_out_norm(bf16_t* P, int row0, int jb, int L, int pcol, const float* ob, const float* rd, int ptid) {
    const int tt = ptid >> 3, g = ptid & 7, t0 = jb * 32;
    if (t0 + tt < L) { const f32x4 v = *(const f32x4*)(ob + tt * 32 + g * 4) * rd[tt];
        *(u32x2*)(P + (size_t)(row0 + t0 + tt) * NP + pcol + g * 4) = (u32x2){pk2(v[0], v[1]), pk2(v[2], v[3])}; }
}
__device__ __forceinline__ void issue_mlstm_chunk(const Params& p, int h, int qtr, int row0, int L, int nch, int jb, int ptid, StageRegs& r) {
    if (jb >= nch) return;
    const bf16_t* P = (const bf16_t*)(p.ws + OFF_P); const float* REC = (const float*)(p.ws + OFF_REC);
    const int tt = ptid >> 3, g = ptid & 7, t0 = jb * 32;
    const int row = row0 + t0 + tt;
    if (g == 0) r.r0 = *(const f32x4*)(REC + ((size_t)row * 4 + h) * 16 + 4);
    if (t0 + tt >= L) return;
    const bf16_t* prow = P + (size_t)row * NP;
    r.q0 = asf(*(const u32x4*)(prow + cQ + h * 128 + g * 16)); r.q1 = asf(*(const u32x4*)(prow + cQ + h * 128 + g * 16 + 8));
    r.k0 = asf(*(const u32x4*)(prow + cK + h * 128 + g * 16)); r.k1 = asf(*(const u32x4*)(prow + cK + h * 128 + g * 16 + 8));
    { const u32x2 vv_ = *(const u32x2*)(prow + cV + h * 128 + qtr * 32 + g * 4); r.v = asf((u32x4){vv_.x, vv_.y, 0u, 0u}); }
}

__device__ __forceinline__ void scan_mlstm_chunk(const Params& p, int l, int bs, int h, int qtr, int row0, int L, unsigned char* lb) {
    const int tid = opaque_tid(p.wv); const int wave = tid >> 6, lane = tid & 63, r = lane & 31, hf = lane >> 5, ptid = tid - 256;
    bf16_t* P = (bf16_t*)(p.ws + OFF_P);
    const int nch = (L + 31) >> 5;
    f32x16 C[4];
    const int ct = wave == 3 ? 1 : 0;
#pragma unroll
    for (int dt = 0; dt < 4; ++dt)
#pragma unroll
        for (int i = 0; i < 16; ++i) C[dt][i] = 0.f;
    float m0 = 0.f;
    f32x4 s0, s1, s2, s3, s4, s5, s6, s7; StageRegs sr{s0, s1, s2, s3, s4, s5, s6, s7};
    if (wave >= 4) { for (int i = ptid; i < 2 * 32 * CH_LDS; i += 256) { const int sl = i / (32 * CH_LDS), e = i % (32 * CH_LDS);
            ((bf16_t*)(lb + sl * CH_SLOT + CH_VT))[32 * CH_LDS + e] = (e < CH_LDS) ? (bf16_t)0x3f80 : (bf16_t)0; } }
#define CH_P1(JN) do { const int jn_ = (JN); unsigned char* sl_ = lb + (jn_ & 1) * CH_SLOT; const int tt = ptid >> 3, g = ptid & 7; const bool val_ = jn_ * 32 + tt < L; \
        u32x4 q0_ = asu(sr.q0), q1_ = asu(sr.q1), k0_ = asu(sr.k0), k1_ = asu(sr.k1); u32x4 v_ = asu(sr.v); \
        if (!val_) { q0_ = q1_ = k0_ = k1_ = v_ = (u32x4){0u, 0u, 0u, 0u}; } \
        *(u32x4*)(sl_ + CH_QB + (tt * CH_LDQ + g * 16) * 2) = q0_; *(u32x4*)(sl_ + CH_QB + (tt * CH_LDQ + g * 16 + 8) * 2) = q1_; \
        *(u32x4*)(sl_ + CH_KB + (tt * CH_LDQ + g * 16) * 2) = k0_; *(u32x4*)(sl_ + CH_KB + (tt * CH_LDQ + g * 16 + 8) * 2) = k1_; \
        bf16_t* vt_ = (bf16_t*)(sl_ + CH_VT); \
        vt_[(g * 4 + 0) * CH_LDS + tt] = (bf16_t)(v_.x & 0xffffu); vt_[(g * 4 + 1) * CH_LDS + tt] = (bf16_t)(v_.x >> 16); \
        vt_[(g * 4 + 2) * CH_LDS + tt] = (bf16_t)(v_.y & 0xffffu); vt_[(g * 4 + 3) * CH_LDS + tt] = (bf16_t)(v_.y >> 16); \
        if (g == 0) { float* sc_ = (float*)(sl_ + CH_SC); sc_[SC_U + tt] = sr.r0[0]; sc_[SC_B + tt] = sr.r0[1]; sc_[SC_PM + tt] = sr.r0[2]; } \
        issue_mlstm_chunk(p, h, qtr, row0, L, nch, jn_ + 1, ptid, sr); } while (0)
#define CH_P2(JN) do { unsigned char* sl_ = lb + ((JN) & 1) * CH_SLOT; const float* sc_ = (const float*)(sl_ + CH_SC); \
        const float bT_ = sc_[SC_B + 31], mT_ = bT_ + fmaxf(m0, sc_[SC_PM + 31]); \
        if (wave == 1) { f32x16 a_; _Pragma("unroll") for (int i = 0; i < 16; ++i) a_[i] = 0.f; \
            _Pragma("unroll") for (int kb = 0; kb < 8; ++kb) a_ = MFMA32(frag_n((const bf16_t*)(sl_ + CH_QB), CH_LDQ, r, hf, kb), frag_n((const bf16_t*)(sl_ + CH_KB), CH_LDQ, r, hf, kb), a_); \
            bf16_t* sw_ = (bf16_t*)(sl_ + CH_SW); const float us_ = sc_[SC_U + r]; \
            _Pragma("unroll") for (int i4 = 0; i4 < 4; ++i4) { const f32x4 pm4 = *(const f32x4*)(sc_ + SC_PM + 8 * i4 + 4 * hf); \
                _Pragma("unroll") for (int ii = 0; ii < 4; ++ii) { const int t = 8 * i4 + 4 * hf + ii; const float w_ = (r <= t) ? __expf(us_ - fmaxf(m0, pm4[ii])) * 0.08838834764831845f : 0.f; \
                    sw_[t * CH_LDS + r] = f2bf(a_[4 * i4 + ii] * w_); } } } \
        else if (wave >= 4) { const int tt = ptid >> 3, g = ptid & 7; \
            const float wi_ = __expf(m0 - fmaxf(m0, sc_[SC_PM + tt])) * 0.08838834764831845f, ws_ = __expf(sc_[SC_U + tt] + bT_ - mT_); float x_[16]; \
            u32x4* qp_ = (u32x4*)(sl_ + CH_QB + (tt * CH_LDQ + g * 16) * 2); unpack8(qp_[0], x_); unpack8(qp_[1], x_ + 8); \
            _Pragma("unroll") for (int i = 0; i < 16; ++i) x_[i] *= wi_; \
            u32x4* qo_ = (u32x4*)(sl_ + CH_QW + (tt * CH_LDQ + g * 16) * 2); qo_[0] = pack8(x_); qo_[1] = pack8(x_ + 8); \
            const u32x4* kp_ = (const u32x4*)(sl_ + CH_KB + (tt * CH_LDQ + g * 16) * 2); unpack8(kp_[0], x_); unpack8(kp_[1], x_ + 8); \
            bf16_t* kw_ = (bf16_t*)(sl_ + CH_KWT); \
            _Pragma("unroll") for (int i = 0; i < 16; ++i) kw_[kto(g * 16) + i * CH_LDS + tt] = f2bf(x_[i] * ws_); } \
        if (wave == 1 || wave >= 4) m0 = mT_; } while (0)
    if (wave >= 4) { issue_mlstm_chunk(p, h, qtr, row0, L, nch, 0, ptid, sr); CH_P1(0); }
    BARRIER_LDS();
    CH_P2(0);
    BARRIER_LDS();
#pragma unroll 1
    for (int j = 0; j < nch; ++j) {
        if (wave == 0 || wave == 3) {
            const unsigned char* sl = lb + (j & 1) * CH_SLOT; const float* sc = (const float*)(sl + CH_SC);
            const bf16_t* qw = (const bf16_t*)(sl + CH_QW); const bf16_t* sw = (const bf16_t*)(sl + CH_SW); const bf16_t* vt = (const bf16_t*)(sl + CH_VT) + ct * 32 * CH_LDS; const bf16_t* kwt = (const bf16_t*)(sl + CH_KWT);
            const float bT = sc[SC_B + 31], mT = bT + fmaxf(m0, sc[SC_PM + 31]);
            f32x16 H;
#pragma unroll
            for (int i = 0; i < 16; ++i) H[i] = 0.f;
#pragma unroll
            for (int dt = 0; dt < 4; ++dt)
#pragma unroll
                for (int u = 0; u < 2; ++u) H = MFMA32(frag_p(qw, CH_LDQ, r, hf, 32 * dt + 16 * u), pack_step(C[dt], u), H);
            bf16x8 vb[2];
#pragma unroll
            for (int kb = 0; kb < 2; ++kb) { vb[kb] = frag_n(vt, CH_LDS, r, hf, kb); H = MFMA32(frag_n(sw, CH_LDS, r, hf, kb), vb[kb], H); }
            const float wold = __expf(bT - mT + m0);
#pragma unroll
            for (int dt = 0; dt < 4; ++dt) {
#pragma unroll
                for (int i = 0; i < 16; ++i) C[dt][i] *= wold;
#pragma unroll
                for (int kb = 0; kb < 2; ++kb) C[dt] = MFMA32(frag_n(kwt + kto(dt * 32 + r), 0, 0, hf, kb), vb[kb], C[dt]);
            }
            float* ob = (float*)(lb + CH_OB) + (j & 1) * 1024; float* rd = (float*)(lb + CH_OB + 8192) + (j & 1) * 32;
            if (ct == 0) {
#pragma unroll
                for (int i = 0; i < 16; ++i) ob[crow(i, hf) * 32 + r] = H[i];
            } else if (r == 0) {
#pragma unroll
                for (int i = 0; i < 16; ++i) { const int t = crow(i, hf); rd[t] = __builtin_amdgcn_rcpf(fmaxf(fabsf(H[i]), __expf(-(sc[SC_B + t] + fmaxf(m0, sc[SC_PM + t]))))); }
            }
            m0 = mT;
        } else if (wave >= 4) {
            if (j + 1 < nch) CH_P1(j + 1);
            if (j > 0) store_out_norm(P, row0, j - 1, L, cV + h * 128 + qtr * 32, (const float*)(lb + CH_OB) + ((j - 1) & 1) * 1024, (const float*)(lb + CH_OB + 8192) + ((j - 1) & 1) * 32, ptid);
        }
        BARRIER_LDS();
        if (j + 1 < nch) CH_P2(j + 1);
        BARRIER_LDS();
    }
    if (wave >= 4) store_out_norm(P, row0, nch - 1, L, cV + h * 128 + qtr * 32, (const float*)(lb + CH_OB) + ((nch - 1) & 1) * 1024, (const float*)(lb + CH_OB + 8192) + ((nch - 1) & 1) * 32, ptid);
    const size_t sh = (size_t)(l * NB + bs) * 4 + h;
    if (wave == 0) {
        float* Co = p.out + o_pC + sh * 16384;
#pragma unroll
        for (int dt = 0; dt < 4; ++dt)
#pragma unroll
            for (int i = 0; i < 16; ++i) Co[(32 * dt + crow(i, hf)) * 128 + qtr * 32 + r] = C[dt][i];
        if (lane == 0 && qtr == 0) p.out[o_pm + sh] = m0;
    } else if (wave == 3 && r == 0 && qtr == 0) {
#pragma unroll
        for (int dt = 0; dt < 4; ++dt)
#pragma unroll
            for (int i = 0; i < 16; ++i) p.out[o_pn + sh * 128 + 32 * dt + crow(i, hf)] = C[dt][i];
    }
    __syncthreads();
#undef CH_P1
#undef CH_P2
}

__device__ __forceinline__ void gdn_raw8(const bf16_t* P, int r0, int tr, int pcol, const bf16_t* gh, const float* st, int hch, float* x) {
    if (tr >= 0) unpack8(*(const u32x4*)(P + (size_t)(r0 + tr) * NP + pcol), x);
    else if (gh) unpack8(*(const u32x4*)(gh + (3 + tr) * 1536 + hch), x);
    else if (st) { const float* hp = st + (3 + tr) * 1536 + hch; const f32x4 a = *(const f32x4*)hp, b = *(const f32x4*)(hp + 4);
        x[0] = a[0]; x[1] = a[1]; x[2] = a[2]; x[3] = a[3]; x[4] = b[0]; x[5] = b[1]; x[6] = b[2]; x[7] = b[3]; }
    else {
#pragma unroll
        for (int i = 0; i < 8; ++i) x[i] = 0.f; }
}
__device__ __forceinline__ void gdn_conv8(const bf16_t* P, int r0, int tr, int pcol, const bf16_t* gh, const float* st, int hch, const float* cw, float* y) {
#pragma unroll
    for (int i = 0; i < 8; ++i) y[i] = 0.f;
#pragma unroll
    for (int j = 0; j < 4; ++j) { float x[8]; gdn_raw8(P, r0, tr - 3 + j, pcol, gh, st, hch, x);
        const f32x4 w0 = *(const f32x4*)(cw + j * 1536 + hch), w1 = *(const f32x4*)(cw + j * 1536 + hch + 4);
        y[0] += x[0] * w0[0]; y[1] += x[1] * w0[1]; y[2] += x[2] * w0[2]; y[3] += x[3] * w0[3];
        y[4] += x[4] * w1[0]; y[5] += x[5] * w1[1]; y[6] += x[6] * w1[2]; y[7] += x[7] * w1[3]; }
#pragma unroll
    for (int i = 0; i < 8; ++i) y[i] = y[i] * sigmoidf_(y[i]);
}

__device__ __forceinline__ void phase_prep(const Params& p, int l, float* lds) {
    const int tid = opaque_tid(p.wv); const int half = tid >> 8, t = tid & 255, tt = t >> 3, g = t & 7, wq = t >> 6, lane = t & 63, r = lane & 31, hf = lane >> 5;
    bf16_t* P = (bf16_t*)(p.ws + OFF_P); const bf16_t* GH = (const bf16_t*)(p.ws + OFF_GH);
    const float* G = (const float*)(p.ws + OFF_G); float* REC = (float*)(p.ws + OFF_REC); bf16_t* TB = (bf16_t*)(p.ws + OFF_TB);
    const float* cw = p.gconv_w + (size_t)l * 4 * 1536;
    float* ksc = lds + half * 4096;
    unsigned char* pl = (unsigned char*)lds + 32768 + half * 22016;
    bf16_t* kimg = (bf16_t*)pl; bf16_t* qimg = (bf16_t*)(pl + 8704); float* am = (float*)(pl + 17408); float* sgl = (float*)(pl + 21504); float* sbe = sgl + 32; float* sG = sgl + 64;
    constexpr int NITEM = (MROWS / 32) * 4;
    for (int base = blockIdx.x * 2; base < NITEM; base += gridDim.x * 2) {
        const int item = base + half; const bool act = item < NITEM;
        const int rb = item >> 2, h = item & 3, r0 = rb * 32;
        const bool samp = rb >= SROW0 / 32;
        int tr = tt; const bf16_t* gh = nullptr; const float* st = nullptr; int rbase = r0; bool valid = act;
        if (!samp) { const int jb = rb % (LPAD / 32); if (jb * 32 + tt >= LP) valid = false; if (jb > 0) gh = GH + (size_t)(rb - 1) * 3 * 1536; }
        else { const int sq = (rb - SROW0 / 32) * 8 + (tt >> 2); tr = tt & 3; rbase = r0 + (tt & ~3); st = p.st_gconv + (size_t)(l * NS + sq) * 3 * 1536; }
        const int ch = h * 128 + g * 16;
        u32x4 oq0 = (u32x4){0u, 0u, 0u, 0u}, oq1 = oq0, ok0 = oq0, ok1 = oq0, ov0 = oq0, ov1 = oq0;
        float ga = 0.f, gb = 0.f, gg = 0.f;
        if (valid) {
            float y[16];
            gdn_conv8(P, rbase, tr, cBV + ch, gh, st, 1024 + ch, cw, y); gdn_conv8(P, rbase, tr, cBV + ch + 8, gh, st, 1024 + ch + 8, cw, y + 8);
            ov0 = pack8(y); ov1 = pack8(y + 8);
            __builtin_amdgcn_sched_barrier(0);
            gdn_conv8(P, rbase, tr, cBQ + ch, gh, st, ch, cw, y); gdn_conv8(P, rbase, tr, cBQ + ch + 8, gh, st, ch + 8, cw, y + 8);
            float ss = 0.f;
#pragma unroll
            for (int i = 0; i < 16; ++i) ss += y[i] * y[i];
            float rs = rsqrtf(red8(ss) + 1e-6f) * 0.08838834764831845f;
#pragma unroll
            for (int i = 0; i < 16; ++i) y[i] *= rs;
            oq0 = pack8(y); oq1 = pack8(y + 8);
            __builtin_amdgcn_sched_barrier(0);
            gdn_conv8(P, rbase, tr, cBK + ch, gh, st, 512 + ch, cw, y); gdn_conv8(P, rbase, tr, cBK + ch + 8, gh, st, 512 + ch + 8, cw, y + 8);
            ss = 0.f;
#pragma unroll
            for (int i = 0; i < 16; ++i) ss += y[i] * y[i];
            rs = rsqrtf(red8(ss) + 1e-6f);
#pragma unroll
            for (int i = 0; i < 16; ++i) y[i] *= rs;
            ok0 = pack8(y); ok1 = pack8(y + 8);
            unpack8(ok0, y); unpack8(ok1, y + 8);
#pragma unroll
            for (int i = 0; i < 4; ++i) *(f32x4*)(ksc + tt * 128 + g * 16 + 4 * i) = (f32x4){y[4 * i], y[4 * i + 1], y[4 * i + 2], y[4 * i + 3]};
            if (g == 0) { const float* gr = G + (size_t)(r0 + tt) * 16;
                gb = sigmoidf_(gr[8 + h]);
                const float xa = gr[12 + h] + p.dt_bias[l * 4 + h];
                const float sp = fmaxf(xa, 0.f) + log1pf(__expf(-fabsf(xa)));
                gg = -__expf(p.A_log[l * 4 + h]) * sp; ga = __expf(gg); }
        }
        if (!samp) {
            *(u32x4*)(kimg + tt * CH_LDQ + g * 16) = ok0; *(u32x4*)(kimg + tt * CH_LDQ + g * 16 + 8) = ok1;
            *(u32x4*)(qimg + tt * CH_LDQ + g * 16) = oq0; *(u32x4*)(qimg + tt * CH_LDQ + g * 16 + 8) = oq1;
            if (g == 0) { sgl[tt] = gg; sbe[tt] = gb; }
        }
        __syncthreads();
        f32x16 pacc;
#pragma unroll
        for (int i = 0; i < 16; ++i) pacc[i] = 0.f;
        float myG = 0.f, totG = 0.f;
        if (valid) {
            bf16_t* pr = P + (size_t)(r0 + tt) * NP;
            *(u32x4*)(pr + cBQ + ch) = oq0; *(u32x4*)(pr + cBQ + ch + 8) = oq1; *(u32x4*)(pr + cBK + ch) = ok0; *(u32x4*)(pr + cBK + ch + 8) = ok1;
            *(u32x4*)(pr + cBV + ch) = ov0; *(u32x4*)(pr + cBV + ch + 8) = ov1;
        }
        if (samp) {
            if (valid) {
                const float* kmb = ksc + (tt & ~3) * 128 + g * 16;
                f32x4 qk, kk, qs[4], ks[4];
                { float y[16]; unpack8(oq0, y); unpack8(oq1, y + 8);
#pragma unroll
                  for (int i = 0; i < 4; ++i) qs[i] = (f32x4){y[4 * i], y[4 * i + 1], y[4 * i + 2], y[4 * i + 3]};
                  unpack8(ok0, y); unpack8(ok1, y + 8);
#pragma unroll
                  for (int i = 0; i < 4; ++i) ks[i] = (f32x4){y[4 * i], y[4 * i + 1], y[4 * i + 2], y[4 * i + 3]}; }
#pragma unroll
                for (int j = 0; j < 4; ++j) { qk[j] = red8(dot16(qs, kmb + j * 128)); kk[j] = red8(dot16(ks, kmb + j * 128)); }
                if (g == 0) { float* rec = REC + ((size_t)(r0 + tt) * 4 + h) * 16; *(f32x4*)rec = (f32x4){ga, gb, gg, 0.f}; *(f32x4*)(rec + 4) = qk; *(f32x4*)(rec + 8) = kk; }
            }
        } else if (act) {
            if (wq < 2) {
                const bf16_t* ai = wq == 0 ? kimg : qimg;
#pragma unroll
                for (int kb = 0; kb < 8; ++kb) pacc = MFMA32(frag_n(ai, CH_LDQ, r, hf, kb), frag_n(kimg, CH_LDQ, r, hf, kb), pacc);
            } else if (wq == 2) {
                const float gm = sgl[r]; float cum = 0.f;
#pragma unroll
                for (int t2 = 0; t2 < 32; ++t2) { cum += rdl(gm, t2); if (r == t2) myG = cum; }
                totG = cum;
                if (lane < 32) sG[r] = myG;
                if (lane == 0) sG[32] = cum;
            }
        }
        __syncthreads();
        if (!samp && act) {
            bf16_t* tb = TB + (size_t)item * 3072;
            if (wq == 0) {
                const float Gs_ = sG[r]; float* ag = (float*)tb;
#pragma unroll
                for (int i4 = 0; i4 < 4; ++i4) { const f32x4 G4 = *(const f32x4*)(sG + 8 * i4 + 4 * hf), b4 = *(const f32x4*)(sbe + 8 * i4 + 4 * hf);
#pragma unroll
                    for (int ii = 0; ii < 4; ++ii) { const int t2 = 8 * i4 + 4 * hf + ii; ag[t2 * 32 + r] = (r < t2) ? b4[ii] * pacc[4 * i4 + ii] * __expf(G4[ii] - Gs_) : 0.f; } }
            } else if (wq == 1) {
                const float Gs_ = sG[r];
#pragma unroll
                for (int i4 = 0; i4 < 4; ++i4) { const f32x4 G4 = *(const f32x4*)(sG + 8 * i4 + 4 * hf);
#pragma unroll
                    for (int ii = 0; ii < 4; ++ii) { const int t2 = 8 * i4 + 4 * hf + ii; tb[2048 + t2 * 32 + r] = f2bf((r <= t2) ? pacc[4 * i4 + ii] * __expf(G4[ii] - Gs_) : 0.f); } }
            }
            if (valid && g == 0) { const float Gt = sG[tt], GT = sG[32];
                float* rec = REC + ((size_t)(r0 + tt) * 4 + h) * 16; *(f32x4*)rec = (f32x4){ga, gb, gg, Gt}; *(f32x4*)(rec + 12) = (f32x4){GT - Gt, GT, 0.f, 0.f}; }
        }
        __syncthreads();
    }
    asm volatile("s_waitcnt vmcnt(0)" ::: "memory");
    __syncthreads();
    { const int wv_ = tid >> 6; float* am = lds + wv_ * 1024;
      int nmine = 0;
      for (int base = blockIdx.x * 2; base < NITEM; base += gridDim.x * 2) nmine += 2;
      for (int idx = wv_; idx < nmine; idx += 8) {
        const int item = blockIdx.x * 2 + (idx >> 1) * gridDim.x * 2 + (idx & 1);
        const int rb = item >> 2, h = item & 3;
        if (item >= NITEM || rb >= SROW0 / 32) continue;
        bf16_t* tb = TB + (size_t)item * 3072; const float* ag = (const float*)tb;
#pragma unroll
        for (int q = 0; q < 4; ++q) *(f32x4*)(am + q * 256 + lane * 4) = *(const f32x4*)(ag + q * 256 + lane * 4);
        const float* rec = REC + ((size_t)(rb * 32 + r) * 4 + h) * 16;
        const bool rv = (rb % (LPAD / 32)) * 32 + r < LP;
        const float bs_ = rv ? rec[1] : 0.f, bg_ = rv ? bs_ * __expf(rec[3]) : 0.f;
        asm volatile("s_waitcnt vmcnt(0) lgkmcnt(0)" ::: "memory");
        float Tc[32];
#pragma unroll
        for (int t2 = 0; t2 < 32; ++t2) { float v0 = 0.f, v1 = 0.f, v2 = 0.f, v3 = 0.f;
#pragma unroll
            for (int q4 = 0; q4 < (t2 + 3) / 4; ++q4) { const f32x4 a4 = *(const f32x4*)(am + t2 * 32 + q4 * 4);
                if (q4 * 4 + 0 < t2) v0 += a4[0] * Tc[q4 * 4 + 0]; if (q4 * 4 + 1 < t2) v1 += a4[1] * Tc[q4 * 4 + 1];
                if (q4 * 4 + 2 < t2) v2 += a4[2] * Tc[q4 * 4 + 2]; if (q4 * 4 + 3 < t2) v3 += a4[3] * Tc[q4 * 4 + 3]; }
            Tc[t2] = ((r == t2) ? 1.f : 0.f) - ((v0 + v1) + (v2 + v3)); }
        if (hf == 0) {
#pragma unroll
            for (int t2 = 0; t2 < 32; ++t2) { tb[t2 * 32 + r] = f2bf(Tc[t2] * bs_); tb[1024 + t2 * 32 + r] = f2bf(Tc[t2] * bg_); } }
        asm volatile("s_waitcnt lgkmcnt(0)" ::: "memory");
      } }
    { const int wv_ = tid >> 6;
      for (int it = blockIdx.x * 8 + wv_; it < (SROW0 / 32) * 4; it += gridDim.x * 8) {
        const int rbp = it >> 2, hh = it & 3, jb = rbp % (LPAD / 32), row = rbp * 32 + r;
        float igm = -1e30f, lfm = 0.f;
        if (jb * 32 + r < LP) { const float* gr = G + (size_t)row * 16; igm = gr[hh] + p.gate_bias[l * 8 + hh]; const float f = gr[4 + hh] + p.gate_bias[l * 8 + 4 + hh]; lfm = fminf(f, 0.f) - log1pf(__expf(-fabsf(f))); }
        float bsum = 0.f, pm = -3e38f, myb = 0.f, myu = 0.f, mypm = 0.f;
#pragma unroll
        for (int t2 = 0; t2 < 32; ++t2) { bsum += rdl(lfm, t2); const float u_ = rdl(igm, t2) - bsum; pm = fmaxf(pm, u_); if (r == t2) { myb = bsum; myu = u_; mypm = pm; } }
        if (lane < 32) *(f32x4*)(REC + ((size_t)row * 4 + hh) * 16 + 4) = (f32x4){myu, myb, mypm, 0.f};
      } }
}

__device__ __forceinline__ void issue_gdn(const Params& p, int h, int qtr, int row0, int L, int jb, int ptid, StageRegs& r) {
    const bf16_t* P = (const bf16_t*)(p.ws + OFF_P); const float* REC = (const float*)(p.ws + OFF_REC);
    const int tt = ptid >> 3, g = ptid & 7, t0 = jb * 32;
    if (t0 + tt >= L) return;
    const int row = row0 + t0 + tt;
    const bf16_t* prow = P + (size_t)row * NP;
    r.q0 = asf(*(const u32x4*)(prow + cBQ + h * 128 + g * 16)); r.q1 = asf(*(const u32x4*)(prow + cBQ + h * 128 + g * 16 + 8));
    r.k0 = asf(*(const u32x4*)(prow + cBK + h * 128 + g * 16)); r.k1 = asf(*(const u32x4*)(prow + cBK + h * 128 + g * 16 + 8));
    { const u32x2 vv_ = *(const u32x2*)(prow + cBV + h * 128 + qtr * 32 + g * 4); r.v = asf((u32x4){vv_.x, vv_.y, 0u, 0u}); }
    if (g < 3) r.r0 = *(const f32x4*)(REC + ((size_t)row * 4 + h) * 16 + g * 4);
}
__device__ __forceinline__ void commit_gdn(int L, int jb, float* lds, int ptid, const StageRegs& r, int bsel = -1) {
    const int tt = ptid >> 3, g = ptid & 7, t0 = jb * 32, b = bsel >= 0 ? bsel : (jb & 1);
    if (t0 + tt >= L) return;
    float x[16];
    unpack8(asu(r.q0), x); unpack8(asu(r.q1), x + 8);
    float* qd = QB(lds, b) + tt * 128 + g * 16;
#pragma unroll
    for (int i = 0; i < 4; ++i) *(f32x4*)(qd + 4 * i) = (f32x4){x[4 * i], x[4 * i + 1], x[4 * i + 2], x[4 * i + 3]};
    unpack8(asu(r.k0), x); unpack8(asu(r.k1), x + 8);
    float* kd = KB(lds, b) + tt * 128 + g * 16;
#pragma unroll
    for (int i = 0; i < 4; ++i) *(f32x4*)(kd + 4 * i) = (f32x4){x[4 * i], x[4 * i + 1], x[4 * i + 2], x[4 * i + 3]};
    *(f32x4*)(VB(lds, b) + tt * 32 + g * 4) = (f32x4){bflo(asu(r.v).x), bfhi(asu(r.v).x), bflo(asu(r.v).y), bfhi(asu(r.v).y)};
    if (g < 3) *(f32x4*)(SCB(lds, b) + tt * 16 + g * 4) = r.r0;
}

constexpr int GD_Q = 0, GD_K = 8704, GD_KT = 17408, GD_KDT = 27904, GD_VT = 38400, GD_QKD = 40960, GD_TV = 43520, GD_TK = 46080, GD_W = 48640, GD_SC = 57344, GD_SLOT = 58368, GD_OB = 2 * GD_SLOT;
constexpr int GS_B = 32, GS_EG = 96, GS_ETG = 128, GS_EGT = 160;

__device__ __forceinline__ void issue_gdn_chunk(const Params& p, int h, int qtr, int row0, int L, int nch, int jb, int ptid, StageRegs& r) {
    if (jb >= nch) return;
    const bf16_t* P = (const bf16_t*)(p.ws + OFF_P); const float* REC = (const float*)(p.ws + OFF_REC);
    const bf16_t* tb = (const bf16_t*)(p.ws + OFF_TB) + ((size_t)((row0 >> 5) + jb) * 4 + h) * 3072;
    r.x0 = asf(*(const u32x4*)(tb + ptid * 8));
    if (ptid < 128) r.x1 = asf(*(const u32x4*)(tb + 2048 + ptid * 8));
    const int tt = ptid >> 3, g = ptid & 7, t0 = jb * 32;
    if (t0 + tt >= L) return;
    const int row = row0 + t0 + tt;
    const bf16_t* prow = P + (size_t)row * NP;
    r.q0 = asf(*(const u32x4*)(prow + cBQ + h * 128 + g * 16)); r.q1 = asf(*(const u32x4*)(prow + cBQ + h * 128 + g * 16 + 8));
    r.k0 = asf(*(const u32x4*)(prow + cBK + h * 128 + g * 16)); r.k1 = asf(*(const u32x4*)(prow + cBK + h * 128 + g * 16 + 8));
    { const u32x2 vv_ = *(const u32x2*)(prow + cBV + h * 128 + qtr * 32 + g * 4); r.v = asf((u32x4){vv_.x, vv_.y, 0u, 0u}); }
    if (g == 0 || g == 3) r.r0 = *(const f32x4*)(REC + ((size_t)row * 4 + h) * 16 + g * 4);
}

__device__ __forceinline__ void scan_gdn_chunk(const Params& p, int l, int bs, int h, int qtr, int row0, int L, unsigned char* lb) {
    const int tid = opaque_tid(p.wv); const int wave = tid >> 6, lane = tid & 63, r = lane & 31, hf = lane >> 5, ptid = tid - 256;
    bf16_t* P = (bf16_t*)(p.ws + OFF_P);
    const int nch = (L + 31) >> 5;
    f32x16 S[4];
#pragma unroll
    for (int dt = 0; dt < 4; ++dt)
#pragma unroll
        for (int i = 0; i < 16; ++i) S[dt][i] = 0.f;
    f32x4 s0, s1, s2, s3, s4, s5, s6, s7; StageRegs sr{s0, s1, s2, s3, s4, s5, s6, s7};
#define GD_P1(JN) do { const int jn_ = (JN); unsigned char* sl_ = lb + (jn_ & 1) * GD_SLOT; const int tt = ptid >> 3, g = ptid & 7; const bool val_ = jn_ * 32 + tt < L; \
        u32x4 q0_ = asu(sr.q0), q1_ = asu(sr.q1), k0_ = asu(sr.k0), k1_ = asu(sr.k1); u32x4 v_ = asu(sr.v); \
        if (!val_) { q0_ = q1_ = k0_ = k1_ = v_ = (u32x4){0u, 0u, 0u, 0u}; } \
        *(u32x4*)(sl_ + GD_Q + (tt * CH_LDQ + g * 16) * 2) = q0_; *(u32x4*)(sl_ + GD_Q + (tt * CH_LDQ + g * 16 + 8) * 2) = q1_; \
        *(u32x4*)(sl_ + GD_K + (tt * CH_LDQ + g * 16) * 2) = k0_; *(u32x4*)(sl_ + GD_K + (tt * CH_LDQ + g * 16 + 8) * 2) = k1_; \
        bf16_t* kt_ = (bf16_t*)(sl_ + GD_KT) + kto(g * 16) + tt; \
        _Pragma("unroll") for (int i = 0; i < 4; ++i) { kt_[(2 * i) * CH_LDS] = (bf16_t)(k0_[i] & 0xffffu); kt_[(2 * i + 1) * CH_LDS] = (bf16_t)(k0_[i] >> 16); \
            kt_[(8 + 2 * i) * CH_LDS] = (bf16_t)(k1_[i] & 0xffffu); kt_[(8 + 2 * i + 1) * CH_LDS] = (bf16_t)(k1_[i] >> 16); } \
        bf16_t* vt_ = (bf16_t*)(sl_ + GD_VT); \
        vt_[(g * 4 + 0) * CH_LDS + tt] = (bf16_t)(v_.x & 0xffffu); vt_[(g * 4 + 1) * CH_LDS + tt] = (bf16_t)(v_.x >> 16); \
        vt_[(g * 4 + 2) * CH_LDS + tt] = (bf16_t)(v_.y & 0xffffu); vt_[(g * 4 + 3) * CH_LDS + tt] = (bf16_t)(v_.y >> 16); \
        { const int row_ = ptid >> 2, c4_ = ptid & 3; *(u32x4*)(sl_ + (row_ < 32 ? GD_TV : GD_TK) + ((row_ & 31) * CH_LDS + c4_ * 8) * 2) = asu(sr.x0); \
          if (ptid < 128) *(u32x4*)(sl_ + GD_QKD + (row_ * CH_LDS + c4_ * 8) * 2) = asu(sr.x1); } \
        float* sc_ = (float*)(sl_ + GD_SC); \
        if (g == 0) { sc_[GS_B + tt] = val_ ? sr.r0[1] : 0.f; sc_[GS_EG + tt] = val_ ? __expf(sr.r0[3]) : 0.f; } \
        if (g == 3) { sc_[GS_ETG + tt] = val_ ? __expf(sr.r0[0]) : 0.f; if (tt == 0) sc_[GS_EGT] = __expf(sr.r0[1]); } \
        issue_gdn_chunk(p, h, qtr, row0, L, nch, jn_ + 1, ptid, sr); } while (0)
#define GD_P2(JN) do { if (wave >= 4) { unsigned char* sl_ = lb + ((JN) & 1) * GD_SLOT; const float* sc_ = (const float*)(sl_ + GD_SC); \
        { const int tt = ptid >> 3, g = ptid & 7; const float eg_ = sc_[GS_EG + tt], et_ = sc_[GS_ETG + tt]; float x_[16]; \
            u32x4* qp_ = (u32x4*)(sl_ + GD_Q + (tt * CH_LDQ + g * 16) * 2); unpack8(qp_[0], x_); unpack8(qp_[1], x_ + 8); \
            _Pragma("unroll") for (int i = 0; i < 16; ++i) x_[i] *= eg_; \
            qp_[0] = pack8(x_); qp_[1] = pack8(x_ + 8); \
            const u32x4* kp_ = (const u32x4*)(sl_ + GD_K + (tt * CH_LDQ + g * 16) * 2); unpack8(kp_[0], x_); unpack8(kp_[1], x_ + 8); \
            bf16_t* kd_ = (bf16_t*)(sl_ + GD_KDT); \
            _Pragma("unroll") for (int i = 0; i < 16; ++i) kd_[kto(g * 16) + i * CH_LDS + tt] = f2bf(x_[i] * et_); } \
        { const int dt_ = wave - 4; f32x16 a_; \
            _Pragma("unroll") for (int i = 0; i < 16; ++i) a_[i] = 0.f; \
            _Pragma("unroll") for (int kb = 0; kb < 2; ++kb) a_ = MFMA32(frag_n((const bf16_t*)(sl_ + GD_KT) + kto(dt_ * 32 + r), 0, 0, hf, kb), frag_n((const bf16_t*)(sl_ + GD_TK), CH_LDS, r, hf, kb), a_); \
            _Pragma("unroll") for (int i4 = 0; i4 < 4; ++i4) { unsigned lo_, hi_;     \
                asm volatile("s_nop 7\n\ts_nop 7\n\tv_cvt_pk_bf16_f32 %0, %2, %3\n\tv_cvt_pk_bf16_f32 %1, %4, %5" : "=&v"(lo_), "=&v"(hi_) : "v"(a_[4 * i4]), "v"(a_[4 * i4 + 1]), "v"(a_[4 * i4 + 2]), "v"(a_[4 * i4 + 3])); \
                *(u32x2*)(sl_ + GD_W + (r * CH_LDQ + 32 * dt_ + 8 * i4 + 4 * hf) * 2) = (u32x2){lo_, hi_}; } } } } while (0)
    if (wave >= 4) { issue_gdn_chunk(p, h, qtr, row0, L, nch, 0, ptid, sr); GD_P1(0); }
    BARRIER_LDS();
    GD_P2(0);
    BARRIER_LDS();
#pragma unroll 1
    for (int j = 0; j < nch; ++j) {
        if (wave == 0) {
            const unsigned char* sl = lb + (j & 1) * GD_SLOT; const float* sc = (const float*)(sl + GD_SC);
            const bf16_t* wq = (const bf16_t*)(sl + GD_W); const bf16_t* qg = (const bf16_t*)(sl + GD_Q); const bf16_t* tv = (const bf16_t*)(sl + GD_TV); const bf16_t* vt = (const bf16_t*)(sl + GD_VT);
            const bf16_t* qkd = (const bf16_t*)(sl + GD_QKD); const bf16_t* kdt = (const bf16_t*)(sl + GD_KDT);
            f32x16 U, O;
#pragma unroll
            for (int i = 0; i < 16; ++i) { U[i] = 0.f; O[i] = 0.f; }
#pragma unroll
            for (int dt = 0; dt < 4; ++dt)
#pragma unroll
                for (int u = 0; u < 2; ++u) { const bf16x8 sb = pack_step(S[dt], u);
                    U = MFMA32(frag_p(wq, CH_LDQ, r, hf, 32 * dt + 16 * u), sb, U); O = MFMA32(frag_p(qg, CH_LDQ, r, hf, 32 * dt + 16 * u), sb, O); }
            f32x16 Uv;
#pragma unroll
            for (int i = 0; i < 16; ++i) Uv[i] = 0.f;
#pragma unroll
            for (int kb = 0; kb < 2; ++kb) Uv = MFMA32(frag_n(tv, CH_LDS, r, hf, kb), frag_n(vt, CH_LDS, r, hf, kb), Uv);
#pragma unroll
            for (int i = 0; i < 16; ++i) U[i] = Uv[i] - U[i];
            bf16x8 ub[2]; ub[0] = pack_step(U, 0); ub[1] = pack_step(U, 1);
#pragma unroll
            for (int u = 0; u < 2; ++u) O = MFMA32(frag_p(qkd, CH_LDS, r, hf, 16 * u), ub[u], O);
            const float egt = sc[GS_EGT];
#pragma unroll
            for (int dt = 0; dt < 4; ++dt) {
#pragma unroll
                for (int i = 0; i < 16; ++i) S[dt][i] *= egt;
#pragma unroll
                for (int u = 0; u < 2; ++u) S[dt] = MFMA32(frag_p(kdt + kto(dt * 32 + r), 0, 0, hf, 16 * u), ub[u], S[dt]);
            }
            float* ob = (float*)(lb + GD_OB) + (j & 1) * 1024;
#pragma unroll
            for (int i = 0; i < 16; ++i) ob[crow(i, hf) * 32 + r] = O[i];
        } else if (wave >= 4) {
            if (j + 1 < nch) GD_P1(j + 1);
            if (j > 0) store_out_blk(P, row0, j - 1, L, cBV + h * 128 + qtr * 32, (const float*)(lb + GD_OB) + ((j - 1) & 1) * 1024, ptid);
        }
        BARRIER_LDS();
        if (j + 1 < nch) GD_P2(j + 1);
        BARRIER_LDS();
    }
    if (wave >= 4) store_out_blk(P, row0, nch - 1, L, cBV + h * 128 + qtr * 32, (const float*)(lb + GD_OB) + ((nch - 1) & 1) * 1024, ptid);
    if (wave == 0) {
        float* So = p.out + o_pS + ((size_t)(l * NB + bs) * 4 + h) * 16384;
#pragma unroll
        for (int dt = 0; dt < 4; ++dt)
#pragma unroll
            for (int i = 0; i < 16; ++i) So[(32 * dt + crow(i, hf)) * 128 + qtr * 32 + r] = S[dt][i];
    }
    __syncthreads();
#undef GD_P1
#undef GD_P2
}

__device__ __forceinline__ void scan_gdn(const Params& p, int l, bool samp, int bs, int h, int qtr, int row0, int L, float* lds) {
    const int tid = opaque_tid(p.wv); const bool cons = tid < 256; const int ptid = tid - 256;
    const int lane = tid & 63, w = (tid >> 6) & 3, s = lane & 7, cl = w * 8 + (lane >> 3), col = qtr * 32 + cl;
    bf16_t* P = (bf16_t*)(p.ws + OFF_P);
    f32x2 S[8];
#pragma unroll
    for (int e = 0; e < 8; ++e) S[e] = bc2(0.f);
    if (cons && samp) {
        const float* S0 = p.st_S + ((size_t)(l * NS + bs) * 4 + h) * 16384;
#pragma unroll
        for (int e = 0; e < 16; ++e) { const int d = (e >> 2) * 32 + s * 4 + (e & 3); S[e >> 1][e & 1] = S0[d * 128 + col]; }
    }
    const int nblk = (L + 31) >> 5;
    f32x4 k4[4][4];
    StageRegs sr{k4[0][0], k4[0][1], k4[0][2], k4[0][3], k4[1][0], k4[1][1], k4[1][2], k4[1][3]};
    if (!cons) { issue_gdn(p, h, qtr, row0, L, 0, ptid, sr); commit_gdn(L, 0, lds, ptid, sr); if (1 < nblk) issue_gdn(p, h, qtr, row0, L, 1, ptid, sr); }
    BARRIER_LDS();
    for (int jb = 0; jb < nblk; ++jb) {
        if (!cons) {
            if (jb + 1 < nblk) commit_gdn(L, jb + 1, lds, ptid, sr);
            if (jb + 2 < nblk) issue_gdn(p, h, qtr, row0, L, jb + 2, ptid, sr);
            if (jb > 0) store_out_blk(P, row0, jb - 1, L, cBV + h * 128 + qtr * 32, OB(lds, (jb - 1) & 1), ptid);
        } else {
            const float* qb = QB(lds, jb & 1); const float* kb = KB(lds, jb & 1); const float* vb = VB(lds, jb & 1); const float* sc = SCB(lds, jb & 1);
            float* ob = OB(lds, jb & 1);
            const int nt = min(32, L - jb * 32);
            f32x4 q4[4][4]; float vv[4], a[4], be[4]; f32x4 qk[4], kk[4];
#define GLOAD_Q(T0) do { _Pragma("unroll") for (int i = 0; i < 4; ++i) { const int t = (T0) + i; \
        _Pragma("unroll") for (int j = 0; j < 4; ++j) q4[i][j] = *(const f32x4*)(qb + t * 128 + j * 32 + s * 4); } } while (0)
#define GLOAD_K(T0) do { _Pragma("unroll") for (int i = 0; i < 4; ++i) { const int t = (T0) + i; \
        _Pragma("unroll") for (int j = 0; j < 4; ++j) k4[i][j] = *(const f32x4*)(kb + t * 128 + j * 32 + s * 4); } \
      _Pragma("unroll") for (int i = 0; i < 4; ++i) { const int t = (T0) + i; \
        const f32x2 gg = *(const f32x2*)(sc + t * 16); a[i] = gg[0]; be[i] = gg[1]; \
        qk[i] = *(const f32x4*)(sc + t * 16 + 4); kk[i] = *(const f32x4*)(sc + t * 16 + 8); vv[i] = vb[t * 32 + cl]; } } while (0)
            GLOAD_Q(0); GLOAD_K(0);
#pragma unroll 1
            for (int t0 = 0; t0 < nt; t0 += 4) {
                float dk[4], dq[4];
                const int tn = min(t0 + 4, 28);
                __builtin_amdgcn_sched_barrier(0);
#pragma unroll
                for (int i = 0; i < 4; ++i) {
                    f32x2 x = bc2(0.f), x2 = bc2(0.f), y = bc2(0.f), y2 = bc2(0.f);
#pragma unroll
                    for (int j = 0; j < 4; ++j) {
                        x = lo2(k4[i][j]) * S[2 * j] + x; x2 = hi2(k4[i][j]) * S[2 * j + 1] + x2;
                        y = lo2(q4[i][j]) * S[2 * j] + y; y2 = hi2(q4[i][j]) * S[2 * j + 1] + y2; }
                    x = x + x2; y = y + y2;
                    dk[i] = x[0] + x[1]; dq[i] = y[0] + y[1];
                }
                __builtin_amdgcn_sched_barrier(0);
                GLOAD_Q(tn);
                __builtin_amdgcn_sched_barrier(0);
#pragma unroll
                for (int i = 0; i < 4; ++i) { dk[i] = red8(dk[i]); dq[i] = red8(dq[i]); }
                const float A0 = a[0], A1 = A0 * a[1], A2 = A1 * a[2], A3 = A2 * a[3];
                const float r10 = a[1], r21 = a[2], r32 = a[3], r20 = r10 * a[2], r31 = r21 * a[3], r30 = r20 * a[3];
                const float u0 = be[0] * (vv[0] - A0 * dk[0]);
                const float u1 = be[1] * (vv[1] - A1 * dk[1] - r10 * kk[1][0] * u0);
                const float u2 = be[2] * (vv[2] - A2 * dk[2] - r20 * kk[2][0] * u0 - r21 * kk[2][1] * u1);
                const float u3 = be[3] * (vv[3] - A3 * dk[3] - r30 * kk[3][0] * u0 - r31 * kk[3][1] * u1 - r32 * kk[3][2] * u2);
                if (s == 0) {
                    ob[(t0 + 0) * 32 + cl] = A0 * dq[0] + qk[0][0] * u0;
                    ob[(t0 + 1) * 32 + cl] = A1 * dq[1] + r10 * qk[1][0] * u0 + qk[1][1] * u1;
                    ob[(t0 + 2) * 32 + cl] = A2 * dq[2] + r20 * qk[2][0] * u0 + r21 * qk[2][1] * u1 + qk[2][2] * u2;
                    ob[(t0 + 3) * 32 + cl] = A3 * dq[3] + r30 * qk[3][0] * u0 + r31 * qk[3][1] * u1 + r32 * qk[3][2] * u2 + qk[3][3] * u3;
                }
                const float c0 = r30 * u0, c1 = r31 * u1, c2 = r32 * u2, c3 = u3;
#pragma unroll
                for (int j = 0; j < 4; ++j) {
                    S[2 * j] = lo2(k4[3][j]) * bc2(c3) + (lo2(k4[2][j]) * bc2(c2) + (lo2(k4[1][j]) * bc2(c1) + (lo2(k4[0][j]) * bc2(c0) + S[2 * j] * bc2(A3))));
                    S[2 * j + 1] = hi2(k4[3][j]) * bc2(c3) + (hi2(k4[2][j]) * bc2(c2) + (hi2(k4[1][j]) * bc2(c1) + (hi2(k4[0][j]) * bc2(c0) + S[2 * j + 1] * bc2(A3)))); }
                __builtin_amdgcn_sched_barrier(0);
                GLOAD_K(tn);
            }
#undef GLOAD_Q
#undef GLOAD_K
        }
        BARRIER_LDS();
    }
    if (!cons) store_out_blk(P, row0, nblk - 1, L, cBV + h * 128 + qtr * 32, OB(lds, (nblk - 1) & 1), ptid);
    else {
        const size_t sh = samp ? (size_t)(l * NS + bs) * 4 + h : (size_t)(l * NB + bs) * 4 + h;
        float* So = p.out + (samp ? o_sS : o_pS) + sh * 16384;
#pragma unroll
        for (int e = 0; e < 16; ++e) { const int d = (e >> 2) * 32 + s * 4 + (e & 3); So[d * 128 + col] = S[e >> 1][e & 1]; }
    }
    BARRIER_LDS();
}

__device__ __forceinline__ void scan_gdn_stream(const Params& p, int l, int h, int qtr, int bs0, int nseq, float* lds) {
    const int tid = opaque_tid(p.wv); const bool cons = tid < 256; const int ptid = tid - 256;
    const int lane = tid & 63, w = (tid >> 6) & 3, s = lane & 7, cl = w * 8 + (lane >> 3), col = qtr * 32 + cl;
    bf16_t* P = (bf16_t*)(p.ws + OFF_P);
    f32x2 S[8];
#pragma unroll
    for (int e = 0; e < 8; ++e) S[e] = bc2(0.f);
    f32x4 k4[4][4];
    StageRegs sr{k4[0][0], k4[0][1], k4[0][2], k4[0][3], k4[1][0], k4[1][1], k4[1][2], k4[1][3]};
#define LOADSTATE(BS) do { } while (0)
#define STISSUE(BS) st_issue(p.st_S + ((size_t)(l * NS + (BS)) * 4 + h) * 16384, qtr, ptid, k4[2][0], k4[2][1], k4[2][2], k4[2][3])
    if (!cons) { issue_gdn(p, h, qtr, SROW0 + bs0 * 4, LS, 0, ptid, sr); STISSUE(bs0); }
#pragma unroll 1
    for (int k = 0; k < nseq; ++k) {
        const int bs = bs0 + 8 * k, row0 = SROW0 + bs * 4;
        if (!cons) { commit_gdn(LS, 0, lds, ptid, sr, k & 1); st_commit(STB(lds, k & 1), ptid, k4[2][0], k4[2][1], k4[2][2], k4[2][3]);
            if (k + 1 < nseq) { issue_gdn(p, h, qtr, row0 + 32, LS, 0, ptid, sr); STISSUE(bs + 8); } }
        BARRIER_LDS();
        if (!cons) { if (k > 0) { store_out_blk(P, row0 - 32, 0, LS, cBV + h * 128 + qtr * 32, OB(lds, (k - 1) & 1), ptid); st_store(p.out + o_sS + ((size_t)(l * NS + bs - 8) * 4 + h) * 16384, qtr, STB(lds, (k - 1) & 1), ptid); } }
        else {
            const float* qb = QB(lds, k & 1); const float* kb = KB(lds, k & 1); const float* vb = VB(lds, k & 1); const float* sc = SCB(lds, k & 1);
            float* ob = OB(lds, k & 1); float* stb = STB(lds, k & 1);
#pragma unroll
            for (int e = 0; e < 16; ++e) { const int d = (e >> 2) * 32 + s * 4 + (e & 3); S[e >> 1][e & 1] = stb[d * ST_LD + cl]; }
            f32x4 q4[4][4]; float vv[4], a[4], be[4]; f32x4 qk[4], kk[4];
#define GLOAD_Q(T0) do { _Pragma("unroll") for (int i = 0; i < 4; ++i) { const int t = (T0) + i; \
        _Pragma("unroll") for (int j = 0; j < 4; ++j) q4[i][j] = *(const f32x4*)(qb + t * 128 + j * 32 + s * 4); } } while (0)
#define GLOAD_K(T0) do { _Pragma("unroll") for (int i = 0; i < 4; ++i) { const int t = (T0) + i; \
        _Pragma("unroll") for (int j = 0; j < 4; ++j) k4[i][j] = *(const f32x4*)(kb + t * 128 + j * 32 + s * 4); } \
      _Pragma("unroll") for (int i = 0; i < 4; ++i) { const int t = (T0) + i; \
        const f32x2 gg = *(const f32x2*)(sc + t * 16); a[i] = gg[0]; be[i] = gg[1]; \
        qk[i] = *(const f32x4*)(sc + t * 16 + 4); kk[i] = *(const f32x4*)(sc + t * 16 + 8); vv[i] = vb[t * 32 + cl]; } } while (0)
            GLOAD_Q(0); GLOAD_K(0);
            {
                float dk[4], dq[4];
                __builtin_amdgcn_sched_barrier(0);
#pragma unroll
                for (int i = 0; i < 4; ++i) {
                    f32x2 x = bc2(0.f), x2 = bc2(0.f), y = bc2(0.f), y2 = bc2(0.f);
#pragma unroll
                    for (int j = 0; j < 4; ++j) {
                        x = lo2(k4[i][j]) * S[2 * j] + x; x2 = hi2(k4[i][j]) * S[2 * j + 1] + x2;
                        y = lo2(q4[i][j]) * S[2 * j] + y; y2 = hi2(q4[i][j]) * S[2 * j + 1] + y2; }
                    x = x + x2; y = y + y2;
                    dk[i] = x[0] + x[1]; dq[i] = y[0] + y[1];
                }
                __builtin_amdgcn_sched_barrier(0);
#pragma unroll
                for (int i = 0; i < 4; ++i) { dk[i] = red8(dk[i]); dq[i] = red8(dq[i]); }
                const float A0 = a[0], A1 = A0 * a[1], A2 = A1 * a[2], A3 = A2 * a[3];
                const float r10 = a[1], r21 = a[2], r32 = a[3], r20 = r10 * a[2], r31 = r21 * a[3], r30 = r20 * a[3];
                const float u0 = be[0] * (vv[0] - A0 * dk[0]);
                const float u1 = be[1] * (vv[1] - A1 * dk[1] - r10 * kk[1][0] * u0);
                const float u2 = be[2] * (vv[2] - A2 * dk[2] - r20 * kk[2][0] * u0 - r21 * kk[2][1] * u1);
                const float u3 = be[3] * (vv[3] - A3 * dk[3] - r30 * kk[3][0] * u0 - r31 * kk[3][1] * u1 - r32 * kk[3][2] * u2);
                if (s == 0) {
                    ob[0 * 32 + cl] = A0 * dq[0] + qk[0][0] * u0;
                    ob[1 * 32 + cl] = A1 * dq[1] + r10 * qk[1][0] * u0 + qk[1][1] * u1;
                    ob[2 * 32 + cl] = A2 * dq[2] + r20 * qk[2][0] * u0 + r21 * qk[2][1] * u1 + qk[2][2] * u2;
                    ob[3 * 32 + cl] = A3 * dq[3] + r30 * qk[3][0] * u0 + r31 * qk[3][1] * u1 + r32 * qk[3][2] * u2 + qk[3][3] * u3;
                }
                const float c0 = r30 * u0, c1 = r31 * u1, c2 = r32 * u2, c3 = u3;
#pragma unroll
                for (int j = 0; j < 4; ++j) {
                    S[2 * j] = lo2(k4[3][j]) * bc2(c3) + (lo2(k4[2][j]) * bc2(c2) + (lo2(k4[1][j]) * bc2(c1) + (lo2(k4[0][j]) * bc2(c0) + S[2 * j] * bc2(A3))));
                    S[2 * j + 1] = hi2(k4[3][j]) * bc2(c3) + (hi2(k4[2][j]) * bc2(c2) + (hi2(k4[1][j]) * bc2(c1) + (hi2(k4[0][j]) * bc2(c0) + S[2 * j + 1] * bc2(A3)))); }
            }
#undef GLOAD_Q
#undef GLOAD_K
#pragma unroll
            for (int e = 0; e < 16; ++e) { const int d = (e >> 2) * 32 + s * 4 + (e & 3); stb[d * ST_LD + cl] = S[e >> 1][e & 1]; }
        }
    }
    BARRIER_LDS();
    if (!cons) { store_out_blk(P, SROW0 + (bs0 + 8 * (nseq - 1)) * 4, 0, LS, cBV + h * 128 + qtr * 32, OB(lds, (nseq - 1) & 1), ptid); st_store(p.out + o_sS + ((size_t)(l * NS + bs0 + 8 * (nseq - 1)) * 4 + h) * 16384, qtr, STB(lds, (nseq - 1) & 1), ptid); }
    BARRIER_LDS();
#undef LOADSTATE
#undef STISSUE
}


__device__ __forceinline__ void phase_scan(const Params& p, int l, float* lds) {
    for (int item = blockIdx.x; item < 256; item += gridDim.x) {
        const int qtr = item & 3, h = (item >> 2) & 3, bs = (item >> 4) & 7, branch = item >> 7;
        if (branch == 0) scan_mlstm_chunk(p, l, bs, h, qtr, bs * LPAD, LP, (unsigned char*)lds); else scan_gdn_chunk(p, l, bs, h, qtr, bs * LPAD, LP, (unsigned char*)lds);
    }
    for (int c = blockIdx.x; c < 256; c += gridDim.x) {
        const int qtr = c & 3, h = (c >> 2) & 3, branch = (c >> 4) & 1, bs0 = c >> 5;
        if (branch == 0) scan_mlstm_stream(p, l, h, qtr, bs0, NS / 8, lds); else scan_gdn_stream(p, l, h, qtr, bs0, NS / 8, lds);
    }
}

__device__ __forceinline__ void phase_norm(const Params& p, int l) {
    const int tid = opaque_tid(p.wv); const int wave = tid >> 6, lane = tid & 63;
    bf16_t* P = (bf16_t*)(p.ws + OFF_P);
    const int part = lane >> 5, hh = (lane >> 3) & 3, g = lane & 7, ch0 = hh * 128 + g * 16;
    const int craw = (part ? cBV : cV) + ch0, cgate = (part ? cZ : cO) + ch0;
    const float* wn = part ? p.b_norm_w + l * 128 + g * 16 : p.a_norm_w + l * 512 + ch0;
    for (int row = blockIdx.x * 8 + wave; row < MROWS; row += gridDim.x * 8) {
        if (row < SROW0 && (row % LPAD) >= LP) continue;
        bf16_t* pr = P + (size_t)row * NP;
        float x[16], z[16];
        unpack8(*(const u32x4*)(pr + craw), x); unpack8(*(const u32x4*)(pr + craw + 8), x + 8);
        unpack8(*(const u32x4*)(pr + cgate), z); unpack8(*(const u32x4*)(pr + cgate + 8), z + 8);
        float sum = 0.f;
#pragma unroll
        for (int i = 0; i < 16; ++i) sum += x[i];
        float mean = red8(sum) * (1.f / 128.f);
        if (part) mean = 0.f;
        float s2 = 0.f;
#pragma unroll
        for (int i = 0; i < 16; ++i) { x[i] -= mean; s2 += x[i] * x[i]; }
        const float rstd = rsqrtf(red8(s2) * (1.f / 128.f) + 1e-6f);
        float y[16];
#pragma unroll
        for (int i = 0; i < 16; ++i) { const float sg = sigmoidf_(z[i]); y[i] = x[i] * rstd * wn[i] * (part ? z[i] * sg : sg); }
        u32x4 o0, o1;
        o0.x = pk2(y[0], y[1]); o0.y = pk2(y[2], y[3]); o0.z = pk2(y[4], y[5]); o0.w = pk2(y[6], y[7]);
        o1.x = pk2(y[8], y[9]); o1.y = pk2(y[10], y[11]); o1.z = pk2(y[12], y[13]); o1.w = pk2(y[14], y[15]);
        *(u32x4*)(pr + cgate) = o0; *(u32x4*)(pr + cgate + 8) = o1;
    }
}

__device__ __forceinline__ void phase_convact(const Params& p, int l) {
    bf16_t* U = (bf16_t*)(p.ws + OFF_P); const bf16_t* HB = (const bf16_t*)(p.ws + OFF_HB);
    const float* cw = p.fconv_w + (size_t)l * 3 * NU;
    constexpr int NCG = DFF / 8, NRG = MROWS / 32;
    const int tid = opaque_tid(p.wv);
    for (int it = blockIdx.x * NTHREADS + tid; it < NRG * NCG; it += gridDim.x * NTHREADS) {
        const int rg = it / NCG, cg_ = it - rg * NCG, c0 = cg_ * 8;
        float wa[3][8], wb[3][8];
#pragma unroll
        for (int j = 0; j < 3; ++j) {
            const f32x4 a0 = *(const f32x4*)(cw + j * NU + c0), a1 = *(const f32x4*)(cw + j * NU + c0 + 4);
            const f32x4 b0 = *(const f32x4*)(cw + j * NU + DFF + c0), b1 = *(const f32x4*)(cw + j * NU + DFF + c0 + 4);
#pragma unroll
            for (int i = 0; i < 4; ++i) { wa[j][i] = a0[i]; wa[j][4 + i] = a1[i]; wb[j][i] = b0[i]; wb[j][4 + i] = b1[i]; }
        }
        float a2[8], a1[8], b2[8], b1[8];
        const bool samp = rg >= SROW0 / 32;
#pragma unroll
        for (int i = 0; i < 8; ++i) { a2[i] = a1[i] = b2[i] = b1[i] = 0.f; }
        if (!samp && (rg % (LPAD / 32)) != 0) {
            const bf16_t* h0 = HB + (size_t)(rg - 1) * 2 * NU;
            unpack8(*(const u32x4*)(h0 + c0), a2); unpack8(*(const u32x4*)(h0 + NU + c0), a1);
            unpack8(*(const u32x4*)(h0 + DFF + c0), b2); unpack8(*(const u32x4*)(h0 + NU + DFF + c0), b1);
        }
#pragma unroll 4
        for (int i = 0; i < 32; ++i) {
            const int row = rg * 32 + i;
            if (samp && (i & 3) == 0) {
                const float* st = p.st_fconv + ((size_t)(l * NS + ((row - SROW0) >> 2)) * 2) * NU;
                const f32x4 x0 = *(const f32x4*)(st + c0), x1 = *(const f32x4*)(st + c0 + 4), y0 = *(const f32x4*)(st + NU + c0), y1 = *(const f32x4*)(st + NU + c0 + 4);
                const f32x4 u0 = *(const f32x4*)(st + DFF + c0), u1 = *(const f32x4*)(st + DFF + c0 + 4), v0 = *(const f32x4*)(st + NU + DFF + c0), v1 = *(const f32x4*)(st + NU + DFF + c0 + 4);
#pragma unroll
                for (int e = 0; e < 4; ++e) { a2[e] = x0[e]; a2[4 + e] = x1[e]; a1[e] = y0[e]; a1[4 + e] = y1[e]; b2[e] = u0[e]; b2[4 + e] = u1[e]; b1[e] = v0[e]; b1[4 + e] = v1[e]; }
            }
            bf16_t* ur = U + (size_t)row * NU;
            float a[8], b[8], hh[8];
            unpack8(*(const u32x4*)(ur + c0), a); unpack8(*(const u32x4*)(ur + DFF + c0), b);
#pragma unroll
            for (int e = 0; e < 8; ++e) {
                const float ca = wa[0][e] * a2[e] + wa[1][e] * a1[e] + wa[2][e] * a[e];
                const float cb = wb[0][e] * b2[e] + wb[1][e] * b1[e] + wb[2][e] * b[e];
                hh[e] = ca * sigmoidf_(ca) * cb;
                a2[e] = a1[e]; a1[e] = a[e]; b2[e] = b1[e]; b1[e] = b[e];
            }
            u32x4 o; o.x = pk2(hh[0], hh[1]); o.y = pk2(hh[2], hh[3]); o.z = pk2(hh[4], hh[5]); o.w = pk2(hh[6], hh[7]);
            *(u32x4*)(ur + c0) = o;
        }
    }
}

#ifndef PROBE
#define PROBE 0
#endif
constexpr int NPHASE = 2 + DEPTH * 11;
__global__ void __launch_bounds__(NTHREADS) fwd_kernel(Params pin) {
    extern __shared__ __attribute__((aligned(16))) unsigned char smem_raw[];
    Params p = pin; p.wv = __builtin_amdgcn_readfirstlane((int)(threadIdx.x >> 6));
    unsigned* bar = (unsigned*)(p.ws + OFF_BAR); const unsigned xcc = xb_xcc_id();
    volatile LAS unsigned* xst = (volatile LAS unsigned*)(LAS unsigned char*)(smem_raw + LDS_GEMM);
    if (threadIdx.x == 0) { xst[0] = 0u; xst[1] = 0u; (void)xb_add(&bar[XB_XCNT(xcc)], 1u); }
    __syncthreads();
    float* lds = (float*)smem_raw;
    bf16_t* X = (bf16_t*)(p.ws + OFF_X); bf16_t* P = (bf16_t*)(p.ws + OFF_P); bf16_t* HB = (bf16_t*)(p.ws + OFF_HB);
    for (int ph = p.ph_lo; ph < p.ph_hi; ++ph) {
#if PROBE == 3
      for (int rep = 0; rep < 2; ++rep) { const int sx = ph < 2 ? -1 : (ph - 2) % 11; if (rep == 1 && !(ph < 2 || sx == 6 || sx == 10)) break;
#endif
        if (ph == 0) phase_weights(p, lds);
        else if (ph == 1) phase_ln(p, 0, nullptr, 0, p.ln_emb_g, p.ln_emb_b, 0, false);
        else {
            const int l = (ph - 2) / 11, s = (ph - 2) % 11;
            if (s == 0) { GemmArgs g{X, X, 1 << 30, D, w_inT(p, l), MROWS, NP, 1024}; gemm_phase(g, EpiP{P, (bf16_t*)(p.ws + OFF_GH), p.out, l}, p.wv); }
            else if (s == 1) phase_prep(p, l, lds);
            else if (s == 2) phase_scan(p, l, lds);
            else if (s == 3) phase_norm(p, l);
            else if (s == 4) { GemmArgs g{P + cO, P + cZ, 4, NP, w_abT(p, l), MROWS, 2048, 512}; gemm_phase(g, EpiMerge{P}, p.wv); }
            else if (s == 5) { GemmArgs g{P + cMG, P + cMG, 1 << 30, NP, w_outT(p, l), MROWS, 1024, 2048, 1}; gemm_phase(g, EpiRes{X, P, NP, 0, (bf16_t*)(p.ws + OFF_GH)}, p.wv); }
            else if (s == 6) phase_ln(p, 1, P, NP, p.ln1_g + l * D, p.ln1_b + l * D, -1, false);
            else if (s == 7) { GemmArgs g{X, X, 1 << 30, D, w_upT(p, l), MROWS, NU, 1024}; gemm_phase(g, EpiUp{P, HB, p.out, l}, p.wv); }
            else if (s == 8) phase_convact(p, l);
            else if (s == 9) { GemmArgs g{P, P, 1 << 30, NU, w_dnT(p, l), MROWS, 1024, DFF, 1}; gemm_phase(g, EpiRes{X, P, NU, DFF, (bf16_t*)(p.ws + OFF_GH)}, p.wv); }
            else phase_ln(p, 1, P + DFF, NU, p.ln2_g + l * D, p.ln2_b + l * D, l + 1 < DEPTH ? l + 1 : -1, l + 1 == DEPTH);
        }
#if PROBE == 3
      }
#endif
        if (ph + 1 < p.ph_hi) { if (p.ph_lo < 0) cg::this_grid().sync(); else xcd_barrier(bar, xcc, xst, p.wv); }
    }
#if PROBE == 4
    for (int i = 0; i < 20; ++i) xcd_barrier(bar, xcc, xst, p.wv);
#endif
}

extern "C" void kernel_launch(void* const* d_in, const int* in_sizes, int n_in, void* d_out, int out_size, void* d_ws, size_t ws_size, hipStream_t stream) {
    static int grid = 0;
    if (grid == 0) {
        if (n_in != 28 || (size_t)out_size != o_end || ws_size < WS_END) { fprintf(stderr, "kernel_launch: unexpected sizes n_in %d out %d ws %zu (need %zu)\n", n_in, out_size, ws_size, (size_t)WS_END); grid = -1; return; }
        int dev = 0, cus = 0, per_cu = 0;
        hipGetDevice(&dev); hipDeviceGetAttribute(&cus, hipDeviceAttributeMultiprocessorCount, dev);
        if (hipFuncSetAttribute((const void*)fwd_kernel, hipFuncAttributeMaxDynamicSharedMemorySize, LDS_BYTES) != hipSuccess) { fprintf(stderr, "hipFuncSetAttribute failed\n"); grid = -1; return; }
        if (hipOccupancyMaxActiveBlocksPerMultiprocessor(&per_cu, (const void*)fwd_kernel, NTHREADS, LDS_BYTES) != hipSuccess || per_cu < 1) { fprintf(stderr, "occupancy query failed (%d)\n", per_cu); (void)hipGetLastError(); per_cu = 1; }
        grid = cus * per_cu;
        if (grid > 256) grid = 256;
    }
    if (grid < 0) return;
    if (hipMemsetAsync((unsigned char*)d_ws + OFF_BAR, 0, 16384, stream) != hipSuccess) { fprintf(stderr, "memset of barrier words failed\n"); return; }
    Params p{};
    const float** pp = (const float**)&p;
    for (int i = 0; i < 28; ++i) pp[i] = (const float*)d_in[i];
    p.out = (float*)d_out; p.ws = (unsigned char*)d_ws;
#if MULTI
    for (int ph = 0; ph < NPHASE; ++ph) { p.ph_lo = ph; p.ph_hi = ph + 1; hipLaunchKernelGGL(fwd_kernel, dim3(grid), dim3(NTHREADS), LDS_BYTES, stream, p); }
#else
    p.ph_lo = 0; p.ph_hi = NPHASE;
    void* args[] = {&p};
    hipError_t e = hipLaunchCooperativeKernel((const void*)fwd_kernel, dim3(grid), dim3(NTHREADS), args, LDS_BYTES, stream);
    if (e != hipSuccess) fprintf(stderr, "cooperative launch failed: %s (grid %d)\n", hipGetErrorString(e), grid);
#endif
}
```

```cpp
#include <hip/hip_runtime.h>
#include <hip/hip_cooperative_groups.h>
#include <cstdio>
namespace cg = cooperative_groups;

#ifndef MULTI
#define MULTI 0
#endif

typedef unsigned short bf16_t;
typedef short bf16x8 __attribute__((ext_vector_type(8)));
typedef float f32x4 __attribute__((ext_vector_type(4)));
typedef float f32x2 __attribute__((ext_vector_type(2)));
typedef unsigned u32x2 __attribute__((ext_vector_type(2)));
typedef unsigned u32x4 __attribute__((ext_vector_type(4)));

constexpr int D = 1024, NB = 8, LP = 2064, LPAD = 2080, NS = 128, LS = 4, DEPTH = 2, NMETA = 16, SEQ = 2048;
constexpr int MROWS = NB * LPAD + NS * LS;
constexpr int SROW0 = NB * LPAD;
constexpr int NIN = 6160, NP = 6144, DFF = 2816, NU = 5632;
constexpr int cQ = 0, cK = 512, cV = 1024, cO = 1536, cBQ = 2048, cBK = 2560, cBV = 3072, cZ = 3584, cMG = 4096;
constexpr float ALPHA = 1.4142135623730951f;
constexpr int SPLIT_ROW0 = 64 * 256;
constexpr int NTHREADS = 512;
constexpr int LDS_GEMM = 131072;
constexpr int LDS_BYTES = LDS_GEMM + 256;

constexpr size_t W_IN = (size_t)NP * 1024, W_AB = 2048 * 512, W_OUT = 1024 * 2048, W_UP = (size_t)NU * 1024, W_DN = (size_t)1024 * DFF;
constexpr size_t W_LAYER = W_IN + W_AB + W_OUT + W_UP + W_DN;
constexpr size_t OFF_W = 0;
constexpr size_t OFF_WG = OFF_W + DEPTH * W_LAYER * 2;
constexpr size_t OFF_X = OFF_WG + DEPTH * 16 * 1024 * 4;
constexpr size_t OFF_G = OFF_X + (size_t)MROWS * D * 2;
constexpr size_t OFF_HB = OFF_G + (size_t)MROWS * 16 * 4;
constexpr size_t OFF_P = OFF_HB + (size_t)(MROWS / 32) * 2 * NU * 2;
constexpr size_t OFF_GH = OFF_P + (size_t)MROWS * NP * 2;
constexpr size_t OFF_REC = OFF_GH + (size_t)(MROWS / 32) * 3 * 1536 * 2;
constexpr size_t OFF_BAR = OFF_REC + (size_t)MROWS * 4 * 16 * 4;
constexpr size_t OFF_TB = OFF_BAR + 16384;
constexpr size_t WS_END = OFF_TB + (size_t)(MROWS / 32) * 4 * 3 * 1024 * 2;

constexpr size_t o_yp = 0;
constexpr size_t o_ys = o_yp + (size_t)NB * SEQ * D;
constexpr size_t o_pC = o_ys + (size_t)NS * LS * D;
constexpr size_t o_pn = o_pC + (size_t)DEPTH * NB * 4 * 128 * 128;
constexpr size_t o_pm = o_pn + (size_t)DEPTH * NB * 4 * 128;
constexpr size_t o_pS = o_pm + (size_t)DEPTH * NB * 4;
constexpr size_t o_pgc = o_pS + (size_t)DEPTH * NB * 4 * 128 * 128;
constexpr size_t o_pfc = o_pgc + (size_t)DEPTH * NB * 3 * 1536;
constexpr size_t o_sC = o_pfc + (size_t)DEPTH * NB * 2 * NU;
constexpr size_t o_sn = o_sC + (size_t)DEPTH * NS * 4 * 128 * 128;
constexpr size_t o_sm = o_sn + (size_t)DEPTH * NS * 4 * 128;
constexpr size_t o_sS = o_sm + (size_t)DEPTH * NS * 4;
constexpr size_t o_sgc = o_sS + (size_t)DEPTH * NS * 4 * 128 * 128;
constexpr size_t o_sfc = o_sgc + (size_t)DEPTH * NS * 3 * 1536;
constexpr size_t o_end = o_sfc + (size_t)DEPTH * NS * 2 * NU;

struct Params {
    const float* x_prompt; const float* x_sample; const float* st_C; const float* st_n; const float* st_m; const float* st_S;
    const float* st_gconv; const float* st_fconv; const float* meta; const float* ln_emb_g; const float* ln_emb_b; const float* w_in;
    const float* gate_bias; const float* a_norm_w; const float* gconv_w; const float* A_log; const float* dt_bias; const float* b_norm_w;
    const float* w_pa; const float* w_pb; const float* w_out; const float* ln1_g; const float* ln1_b; const float* w_up;
    const float* fconv_w; const float* w_down; const float* ln2_g; const float* ln2_b;
    float* out; unsigned char* ws;
    int ph_lo, ph_hi;
    int wv, pad_;
};

__device__ __forceinline__ int opaque_tid(int wv) { int lane; asm volatile("v_mbcnt_lo_u32_b32 %0, -1, 0\n\tv_mbcnt_hi_u32_b32 %0, -1, %0" : "=v"(lane)); return wv * 64 + lane; }
__device__ __forceinline__ float bflo(unsigned u) { return __uint_as_float(u << 16); }
__device__ __forceinline__ float bfhi(unsigned u) { return __uint_as_float(u & 0xffff0000u); }
__device__ __forceinline__ unsigned pk2(float lo, float hi) { unsigned r; asm("v_cvt_pk_bf16_f32 %0, %1, %2" : "=v"(r) : "v"(lo), "v"(hi)); return r; }
template <int CTRL> __device__ __forceinline__ float dppf(float v) { return __int_as_float(__builtin_amdgcn_update_dpp(0, __float_as_int(v), CTRL, 0xf, 0xf, true)); }
__device__ __forceinline__ float red8(float v) { v += dppf<0xB1>(v); v += dppf<0x4E>(v); v += dppf<0x141>(v); return v; }
__device__ __forceinline__ float red16(float v) { v = red8(v); v += dppf<0x140>(v); return v; }
__device__ __forceinline__ float rdl(float v, int l) { return __int_as_float(__builtin_amdgcn_readlane(__float_as_int(v), l)); }
__device__ __forceinline__ float rdl_pin(float v, int l) { float r_; asm volatile("v_readlane_b32 %0, %1, %2" : "=s"(r_) : "v"(v), "s"(l)); return r_; }
__device__ __forceinline__ float red64(float v) { v = red16(v); return (rdl(v, 0) + rdl(v, 16)) + (rdl(v, 32) + rdl(v, 48)); }
__device__ __forceinline__ float sigmoidf_(float x) { return __builtin_amdgcn_rcpf(1.f + __expf(-x)); }
__device__ __forceinline__ u32x4 pack8(const float* y) { u32x4 o; o.x = pk2(y[0], y[1]); o.y = pk2(y[2], y[3]); o.z = pk2(y[4], y[5]); o.w = pk2(y[6], y[7]); return o; }
__device__ __forceinline__ void unpack8(u32x4 a, float* x) { x[0] = bflo(a.x); x[1] = bfhi(a.x); x[2] = bflo(a.y); x[3] = bfhi(a.y); x[4] = bflo(a.z); x[5] = bfhi(a.z); x[6] = bflo(a.w); x[7] = bfhi(a.w); }


#define XB_TMO      128
#define XB_XCNT(j)  (256  + 64 * (j))
#define XB_XSUB(j)  (1280 + 64 * (j))
#define XB_XGEN(j)  (2304 + 64 * (j))
#define XB_TOP      3328
#define XB_TOPGEN   3392
#define XCD_BAR_WORDS 3456
#define XB_SPIN_CAP (1u << 18)
#define LAS __attribute__((address_space(3)))
__device__ __forceinline__ unsigned xb_ld(unsigned* p)              { return __hip_atomic_load(p, __ATOMIC_RELAXED, __HIP_MEMORY_SCOPE_AGENT); }
__device__ __forceinline__ unsigned xb_add(unsigned* p, unsigned v) { return __hip_atomic_fetch_add(p, v, __ATOMIC_RELAXED, __HIP_MEMORY_SCOPE_AGENT); }
__device__ __forceinline__ unsigned xb_xcc_id() { return (unsigned)__builtin_amdgcn_s_getreg((3 << 11) | 20) & 0xFu; }
#define XB_SPIN(cond, bar) do { unsigned _sp = 0; while (cond) { __builtin_amdgcn_s_sleep(1); \
    if ((++_sp & 255u) == 0u) { if (xb_ld(&(bar)[XB_TMO])) break; if (_sp > XB_SPIN_CAP) { atomicAdd(&(bar)[XB_TMO], 1u); break; } } } } while (0)
__device__ __forceinline__ void xcd_barrier_complete(unsigned* bar, unsigned x, unsigned& nloc, unsigned& nx) {
    const unsigned G = gridDim.x;
    unsigned sum, cnt, mine, sp = 0u;
    for (;;) {
        sum = 0u; cnt = 0u; mine = 0u;
#pragma unroll
        for (unsigned j = 0; j < 16; ++j) { const unsigned c = xb_ld(&bar[XB_XCNT(j)]); sum += c; cnt += (c > 0u) ? 1u : 0u; mine = (j == x) ? c : mine; }
        if (sum == G) break;
        __builtin_amdgcn_s_sleep(1);
        if ((++sp & 255u) == 0u) { if (xb_ld(&bar[XB_TMO])) break; if (sp > XB_SPIN_CAP) { atomicAdd(&bar[XB_TMO], 1u); break; } }
    }
    nloc = mine > 0u ? mine : 1u; nx = cnt > 0u ? cnt : 1u;
}
__device__ __forceinline__ void xcd_barrier(unsigned* bar, unsigned x, volatile LAS unsigned* st, int wv) {
    asm volatile("s_waitcnt vmcnt(0)" ::: "memory");
    __syncthreads();
    if (opaque_tid(wv) == 0) {
        __builtin_amdgcn_s_waitcnt(0);
        unsigned nloc = st[0], nx = st[1];
        if (nloc == 0u) { xcd_barrier_complete(bar, x, nloc, nx); st[0] = nloc; st[1] = nx; }
        const unsigned old = xb_add(&bar[XB_XSUB(x)], 1u);
        const unsigned gen = old / nloc;
        if (old + 1u == (gen + 1u) * nloc) {
            __builtin_amdgcn_fence(__ATOMIC_RELEASE, "agent");
            asm volatile("s_waitcnt vmcnt(0)" ::: "memory");
            const unsigned og = xb_add(&bar[XB_TOP], 1u);
            const unsigned tg = og / nx;
            if (og + 1u == (tg + 1u) * nx) xb_add(&bar[XB_TOPGEN], 1u);
            else XB_SPIN(xb_ld(&bar[XB_TOPGEN]) == tg, bar);
            __builtin_amdgcn_fence(__ATOMIC_ACQUIRE, "agent");
            xb_add(&bar[XB_XGEN(x)], 1u);
            asm volatile("s_waitcnt vmcnt(0)" ::: "memory");
        } else {
            XB_SPIN(xb_ld(&bar[XB_XGEN(x)]) == gen, bar);
            __builtin_amdgcn_fence(__ATOMIC_ACQUIRE, "agent");
            asm volatile("s_waitcnt vmcnt(0)" ::: "memory");
        }
    }
    __syncthreads();
}

struct TJob { const float* src; int ldw; int K; int N; bf16_t* dst; int ldt; };
__device__ __forceinline__ void transpose_item(const TJob& jb, int item, float* scr, int lane) {
    const int nblk = jb.N / 32, kb = item / nblk, nb = item % nblk, k0 = 64 * kb, n0 = 32 * nb;
#pragma unroll 8
    for (int i = 0; i < 32; ++i) { const int kk = 2 * i + (lane >> 5); scr[kk * 33 + (lane & 31)] = jb.src[(size_t)(k0 + kk) * jb.ldw + n0 + (lane & 31)]; }
    __builtin_amdgcn_s_waitcnt(0xc07f); asm volatile("" ::: "memory");
    const int c = lane & 7;
#pragma unroll
    for (int j = 0; j < 4; ++j) { const int n = (lane >> 3) + 8 * j; const float* s = scr + (8 * c) * 33 + n;
        u32x4 o; o.x = pk2(s[0 * 33], s[1 * 33]); o.y = pk2(s[2 * 33], s[3 * 33]); o.z = pk2(s[4 * 33], s[5 * 33]); o.w = pk2(s[6 * 33], s[7 * 33]);
        *(u32x4*)(jb.dst + (size_t)(n0 + n) * jb.ldt + k0 + 8 * c) = o; }
    __builtin_amdgcn_s_waitcnt(0xc07f); asm volatile("" ::: "memory");
}
__device__ __forceinline__ bf16_t* wl(const Params& p, int l) { return (bf16_t*)(p.ws + OFF_W) + (size_t)l * W_LAYER; }
__device__ __forceinline__ bf16_t* w_inT(const Params& p, int l) { return wl(p, l); }
__device__ __forceinline__ bf16_t* w_abT(const Params& p, int l) { return wl(p, l) + W_IN; }
__device__ __forceinline__ bf16_t* w_outT(const Params& p, int l) { return wl(p, l) + W_IN + W_AB; }
__device__ __forceinline__ bf16_t* w_upT(const Params& p, int l) { return wl(p, l) + W_IN + W_AB + W_OUT; }
__device__ __forceinline__ bf16_t* w_dnT(const Params& p, int l) { return wl(p, l) + W_IN + W_AB + W_OUT + W_UP; }

__device__ __forceinline__ void phase_weights(const Params& p, float* lds) {
    const int tid = opaque_tid(p.wv); const int wave = tid >> 6, lane = tid & 63;
    float* scr = lds + wave * (64 * 33);
    const int gw = blockIdx.x * 8 + wave, NGW = gridDim.x * 8;
    constexpr int I0 = 16 * 64, I1 = 16 * 64, I2 = 16 * 64, I3 = 8 * 32, I4 = 8 * 32, I5 = 16 * 32, I6 = 16 * 32, I7 = 16 * (NU / 32), I8 = (DFF / 64) * 32;
    constexpr int IL = I0 + I1 + I2 + I3 + I4 + I5 + I6 + I7 + I8;
    for (int it = gw; it < DEPTH * IL; it += NGW) {
        const int l = it / IL; int r = it % IL;
        TJob jb;
        const float* win = p.w_in + (size_t)l * 1024 * NIN;
        if (r < I0) { jb = {win, NIN, 1024, 2048, w_inT(p, l), 1024}; }
        else if ((r -= I0) < I1) { jb = {win + 2056, NIN, 1024, 2048, w_inT(p, l) + (size_t)2048 * 1024, 1024}; }
        else if ((r -= I1) < I2) { jb = {win + 4112, NIN, 1024, 2048, w_inT(p, l) + (size_t)4096 * 1024, 1024}; }
        else if ((r -= I2) < I3) { jb = {p.w_pa + (size_t)l * 512 * 1024, 1024, 512, 1024, w_abT(p, l), 512}; }
        else if ((r -= I3) < I4) { jb = {p.w_pb + (size_t)l * 512 * 1024, 1024, 512, 1024, w_abT(p, l) + (size_t)1024 * 512, 512}; }
        else if ((r -= I4) < I5) { jb = {p.w_out + (size_t)l * 1024 * 1024, 1024, 1024, 1024, w_outT(p, l), 2048}; }
        else if ((r -= I5) < I6) { jb = {p.w_out + (size_t)l * 1024 * 1024, 1024, 1024, 1024, w_outT(p, l) + 1024, 2048}; }
        else if ((r -= I6) < I7) { jb = {p.w_up + (size_t)l * 1024 * NU, NU, 1024, NU, w_upT(p, l), 1024}; }
        else { r -= I7; jb = {p.w_down + (size_t)l * DFF * 1024, 1024, DFF, 1024, w_dnT(p, l), DFF}; }
        transpose_item(jb, r, scr, lane);
    }
    float* wg = (float*)(p.ws + OFF_WG);
    for (int i = blockIdx.x * NTHREADS + tid; i < DEPTH * 16 * 1024; i += gridDim.x * NTHREADS) {
        const int l = i >> 14, g = (i >> 10) & 15, k = i & 1023;
        const int col = g < 8 ? 2048 + g : 4104 + (g - 8);
        wg[i] = p.w_in[((size_t)l * 1024 + k) * NIN + col];
    }
}

__device__ __forceinline__ void phase_ln(const Params& p, int mode, const bf16_t* src, int ldsrc, const float* gam, const float* bet,
                                         int gate_layer  , bool final_out) {
    const int tid = opaque_tid(p.wv); const int wave = tid >> 6, lane = tid & 63;
    bf16_t* X = (bf16_t*)(p.ws + OFF_X);
#define EOFF(j) (512 * ((j) >> 1) + lane * 8 + 4 * ((j) & 1))
    float* G = (float*)(p.ws + OFF_G);
    const float* wg = (const float*)(p.ws + OFF_WG) + (size_t)(gate_layer < 0 ? 0 : gate_layer) * 16 * 1024;
    const int stride = gridDim.x * 8;
    int row = blockIdx.x * 8 + wave;
    u32x4 c0 = (u32x4){0u, 0u, 0u, 0u}, c1 = c0;
    if (mode == 1) {
        while (row < SROW0 && (row % LPAD) >= LP) row += stride;
        if (row < MROWS) { const bf16_t* s_ = src + (size_t)row * ldsrc; c0 = *(const u32x4*)(s_ + lane * 8); c1 = *(const u32x4*)(s_ + 512 + lane * 8); }
    }
    while (row < MROWS) {
        int nrow = row + stride; u32x4 n0 = c0, n1 = c1;
        if (mode == 1) {
            while (nrow < SROW0 && (nrow % LPAD) >= LP) nrow += stride;
            if (nrow < MROWS) { const bf16_t* s_ = src + (size_t)nrow * ldsrc; n0 = *(const u32x4*)(s_ + lane * 8); n1 = *(const u32x4*)(s_ + 512 + lane * 8); }
        }
        int b = 0, t = 0; bool samp = row >= SROW0;
        if (!samp) { b = row / LPAD; t = row - b * LPAD; } else { b = (row - SROW0) >> 2; t = row & 3; }
        const bool valid = samp || t < LP;
        bf16_t* xo = X + (size_t)row * D;
        if (!valid) { if (mode == 0) {
#pragma unroll
                for (int jj = 0; jj < 2; ++jj) *(u32x4*)(xo + 512 * jj + lane * 8) = (u32x4){0u, 0u, 0u, 0u}; }
            row = nrow; c0 = n0; c1 = n1; continue; }
        f32x4 v[4];
        if (mode == 0) {
            const float* s = samp ? p.x_sample + ((size_t)b * LS + t) * D : (t < NMETA ? p.meta + (size_t)t * D : p.x_prompt + ((size_t)b * SEQ + (t - NMETA)) * D);
#pragma unroll
            for (int j = 0; j < 4; ++j) v[j] = *(const f32x4*)(s + EOFF(j));
        } else {
#pragma unroll
            for (int jj = 0; jj < 2; ++jj) { const u32x4 u = jj ? c1 : c0; v[2 * jj] = (f32x4){bflo(u.x), bfhi(u.x), bflo(u.y), bfhi(u.y)}; v[2 * jj + 1] = (f32x4){bflo(u.z), bfhi(u.z), bflo(u.w), bfhi(u.w)}; }
            if (row >= SPLIT_ROW0) { const bf16_t* sp = (const bf16_t*)(p.ws + OFF_GH) + (size_t)(row - SPLIT_ROW0) * D;
#pragma unroll
                for (int q = 0; q < 3; ++q)
#pragma unroll
                    for (int jj = 0; jj < 2; ++jj) { const u32x4 u = *(const u32x4*)(sp + (size_t)q * (MROWS - SPLIT_ROW0) * D + 512 * jj + lane * 8); v[2 * jj] += (f32x4){bflo(u.x), bfhi(u.x), bflo(u.y), bfhi(u.y)}; v[2 * jj + 1] += (f32x4){bflo(u.z), bfhi(u.z), bflo(u.w), bfhi(u.w)}; } }
        }
        float sum = 0.f;
#pragma unroll
        for (int j = 0; j < 4; ++j) sum += (v[j][0] + v[j][1]) + (v[j][2] + v[j][3]);
        const float mean = red64(sum) * (1.f / D);
        float s2 = 0.f;
#pragma unroll
        for (int j = 0; j < 4; ++j) { v[j] = v[j] - mean; s2 += (v[j][0] * v[j][0] + v[j][1] * v[j][1]) + (v[j][2] * v[j][2] + v[j][3] * v[j][3]); }
        const float rstd = rsqrtf(red64(s2) * (1.f / D) + 1e-5f);
#pragma unroll
        for (int j = 0; j < 4; ++j) { const f32x4 g4 = *(const f32x4*)(gam + EOFF(j)), b4 = *(const f32x4*)(bet + EOFF(j)); v[j] = v[j] * rstd * g4 + b4; }
#pragma unroll
        for (int jj = 0; jj < 2; ++jj) *(u32x4*)(xo + 512 * jj + lane * 8) = (u32x4){pk2(v[2 * jj][0], v[2 * jj][1]), pk2(v[2 * jj][2], v[2 * jj][3]), pk2(v[2 * jj + 1][0], v[2 * jj + 1][1]), pk2(v[2 * jj + 1][2], v[2 * jj + 1][3])};
        if (final_out) {
            float* o = nullptr;
            if (samp) o = p.out + o_ys + ((size_t)b * LS + t) * D; else if (t >= NMETA) o = p.out + o_yp + ((size_t)b * SEQ + (t - NMETA)) * D;
            if (o) {
#pragma unroll
                for (int j = 0; j < 4; ++j) *(f32x4*)(o + EOFF(j)) = v[j]; }
        }
        if (gate_layer >= 0) {
            float mine = 0.f;
#pragma unroll 2
            for (int g = 0; g < 16; ++g) {
                float a = 0.f;
#pragma unroll
                for (int j = 0; j < 4; ++j) { const f32x4 w4 = *(const f32x4*)(wg + g * 1024 + EOFF(j)); a += (v[j][0] * w4[0] + v[j][1] * w4[1]) + (v[j][2] * w4[2] + v[j][3] * w4[3]); }
                a = red64(a);
                if (lane == g) mine = a;
            }
            if (lane < 16) G[(size_t)row * 16 + lane] = mine;
        }
        row = nrow; c0 = n0; c1 = n1;
    }
#undef EOFF
}

constexpr int BM = 256, BK = 64, HALF = 128, HT = HALF * BK, NXCD = 8, WGM = 8;
__device__ __forceinline__ int lds_byte(int r, int c) { int st = (r >> 4) * 2 + (c >> 5), rr = r & 15, cc = c & 31, ob = rr * 64 + cc * 2; return st * 1024 + (ob ^ (((ob >> 9) & 1) << 5)); }
__device__ __forceinline__ void stage_rc(int b, int& R, int& C) { int st = b / 1024, sb = b % 1024, swz = sb ^ (((sb >> 9) & 1) << 5); R = (st >> 1) * 16 + swz / 64; C = (st & 1) * 32 + (swz % 64) / 2; }

struct GemmArgs { const bf16_t* A; const bf16_t* A2; int a2_from_pn; int lda; const bf16_t* Bt; int M, N, K; int splitk; };

template <class Epi>
__device__ __forceinline__ void gemm_phase(const GemmArgs g, const Epi& epi, int wv) {
    extern __shared__ __attribute__((aligned(16))) unsigned char smem_raw[];
    bf16_t* shm = (bf16_t*)smem_raw;
#define SA(b, h) (shm + ((b) * 2 + (h)) * HT)
#define SB(b, h) (shm + (4 + (b) * 2 + (h)) * HT)
#define STAGE_A(P_, br, kt) do { const char* _gb = (const char*)(A + (size_t)(br) * lda + (size_t)((kt) + kofs) * BK); \
    unsigned _o0 = offA0, _o1 = offA1; asm volatile("" : "+v"(_o0), "+v"(_o1)); \
    __builtin_amdgcn_global_load_lds((const unsigned*)(_gb + _o0), (unsigned*)((char*)(P_) + tid * 16), 16, 0, 0); \
    __builtin_amdgcn_global_load_lds((const unsigned*)(_gb + _o1), (unsigned*)((char*)(P_) + tid * 16 + 8192), 16, 0, 0); } while (0)
#define STAGE_B(P_, bc, kt) do { const char* _gb = (const char*)(Bt + (size_t)(bc) * K + (size_t)((kt) + kofs) * BK); \
    unsigned _o0 = offB0, _o1 = offB1; asm volatile("" : "+v"(_o0), "+v"(_o1)); \
    __builtin_amdgcn_global_load_lds((const unsigned*)(_gb + _o0), (unsigned*)((char*)(P_) + tid * 16), 16, 0, 0); \
    __builtin_amdgcn_global_load_lds((const unsigned*)(_gb + _o1), (unsigned*)((char*)(P_) + tid * 16 + 8192), 16, 0, 0); } while (0)
#define LDA(dst, b, h) for (int m = 0; m < 4; ++m) for (int k = 0; k < 2; ++k) \
    dst[m][k] = *reinterpret_cast<const bf16x8*>((char*)SA(b, h) + lds_byte(wr * 64 + m * 16 + fr, k * 32 + fq * 8))
#define LDB(dst, b, h) for (int n = 0; n < 2; ++n) for (int k = 0; k < 2; ++k) \
    dst[n][k] = *reinterpret_cast<const bf16x8*>((char*)SB(b, h) + lds_byte(wc * 32 + n * 16 + fr, k * 32 + fq * 8))
#define MMA(ai, bj, At_, Bt_) do { __builtin_amdgcn_s_setprio(1); \
    for (int m = 0; m < 4; ++m) for (int n = 0; n < 2; ++n) for (int k = 0; k < 2; ++k) \
      acc[ai][bj][m][n] = __builtin_amdgcn_mfma_f32_16x16x32_bf16(Bt_[n][k], At_[m][k], acc[ai][bj][m][n], 0, 0, 0); \
    __builtin_amdgcn_s_setprio(0); } while (0)
#define WAIT_V(n) asm volatile("s_waitcnt vmcnt(" #n ")" ::: "memory")
#define WAIT_L(n) asm volatile("s_waitcnt lgkmcnt(" #n ")" ::: "memory")
#define BAR __builtin_amdgcn_s_barrier()
#define SCHED __builtin_amdgcn_sched_barrier(0)
    const int lda = g.lda, K = g.K; const bf16_t* Bt = g.Bt;
    const int nMall = g.M / BM, nN = g.N / BM, nM = g.splitk ? 64 : nMall, nwg = nM * nN, nunits = nwg + (nMall - nM) * nN * 4;
    const int tid = opaque_tid(wv);
    const int wid = tid >> 6, lane = tid & 63, wr = wid >> 2, wc = wid & 3, fr = lane & 15, fq = lane >> 4;
    const int ntK = K / BK;
    unsigned offA0, offA1, offB0, offB1;
    { int r0, c0, r1, c1; stage_rc(tid * 16, r0, c0); stage_rc(tid * 16 + 8192, r1, c1);
      offA0 = (unsigned)(r0 * lda + c0) * 2u; offA1 = (unsigned)(r1 * lda + c1) * 2u;
      const int p0 = (r0 & ~31) + 8 * ((r0 & 15) >> 2) + 4 * ((r0 >> 4) & 1) + (r0 & 3), p1 = (r1 & ~31) + 8 * ((r1 & 15) >> 2) + 4 * ((r1 >> 4) & 1) + (r1 & 3);
      offB0 = (unsigned)(p0 * K + c0) * 2u; offB1 = (unsigned)(p1 * K + c1) * 2u; }
    for (int Lt = blockIdx.x; Lt < nunits; Lt += gridDim.x) {
        int pm, pn, kofs = 0, nt = ntK, split = 0;
        if (Lt < nwg) {
            int wgid = Lt;
            { int q = nwg / NXCD, r = nwg % NXCD, xcd = wgid % NXCD, off = wgid / NXCD; wgid = (xcd < r ? xcd * (q + 1) : r * (q + 1) + (xcd - r) * q) + off; }
            const int nig = WGM * nN, gid = wgid / nig, fm = gid * WGM, gsz = min(nM - fm, WGM);
            pm = fm + ((wgid % nig) % gsz); pn = (wgid % nig) / gsz;
        } else {
            const int u = Lt - nwg, tl = u >> 2; split = u & 3; pm = nM + tl / nN; pn = tl % nN;
            const int q4 = ntK >> 2;
            if (q4 & 1) { nt = split < 2 ? q4 + 1 : q4 - 1; kofs = split < 2 ? split * (q4 + 1) : 2 * (q4 + 1) + (split - 2) * (q4 - 1); } else { nt = q4; kofs = split * q4; }
        }
        const int brow = pm * BM, bcol = pn * BM;
        const bf16_t* A = (pn >= g.a2_from_pn) ? g.A2 : g.A;
        f32x4 acc[2][2][4][2] = {};
        bf16x8 At[4][2], B0[2][2], B1[2][2];
        STAGE_B(SB(0, 0), bcol, 0); STAGE_A(SA(0, 0), brow, 0);
        STAGE_B(SB(0, 1), bcol + HALF, 0); STAGE_A(SA(0, 1), brow + HALF, 0);
        if (wr == 1) BAR;
        WAIT_V(4); BAR;
        STAGE_B(SB(1, 0), bcol, 1); STAGE_A(SA(1, 0), brow, 1); STAGE_B(SB(1, 1), bcol + HALF, 1);
        WAIT_V(6); BAR;
        for (int t = 0; t < nt - 2; t += 2) {
            LDB(B0, 0, 0); SCHED; LDA(At, 0, 0); STAGE_A(SA(1, 1), brow + HALF, t + 1);
            WAIT_L(8); BAR; WAIT_L(0); MMA(0, 0, At, B0); BAR; SCHED;
            LDB(B1, 0, 1); STAGE_B(SB(0, 0), bcol, t + 2);
            BAR; WAIT_L(0); MMA(0, 1, At, B1); BAR;
            LDA(At, 0, 1); STAGE_A(SA(0, 0), brow, t + 2);
            BAR; WAIT_L(0); MMA(1, 0, At, B0); BAR; SCHED;
            STAGE_B(SB(0, 1), bcol + HALF, t + 2);
            WAIT_V(6); BAR; MMA(1, 1, At, B1); BAR;
            LDB(B0, 1, 0); SCHED; LDA(At, 1, 0); STAGE_A(SA(0, 1), brow + HALF, t + 2);
            WAIT_L(8); BAR; WAIT_L(0); MMA(0, 0, At, B0); BAR; SCHED;
            LDB(B1, 1, 1); STAGE_B(SB(1, 0), bcol, t + 3);
            BAR; WAIT_L(0); MMA(0, 1, At, B1); BAR;
            LDA(At, 1, 1); STAGE_A(SA(1, 0), brow, t + 3);
            BAR; WAIT_L(0); MMA(1, 0, At, B0); BAR; SCHED;
            STAGE_B(SB(1, 1), bcol + HALF, t + 3);
            WAIT_V(6); BAR; MMA(1, 1, At, B1); BAR;
        }
        { LDB(B0, 0, 0); LDA(At, 0, 0); STAGE_A(SA(1, 1), brow + HALF, nt - 1);
          BAR; WAIT_L(0); MMA(0, 0, At, B0); BAR;
          LDB(B1, 0, 1); BAR; WAIT_L(0); MMA(0, 1, At, B1); BAR;
          LDA(At, 0, 1); WAIT_V(4); BAR; WAIT_L(0); MMA(1, 0, At, B0); MMA(1, 1, At, B1); BAR; }
        { LDB(B0, 1, 0); LDA(At, 1, 0); WAIT_V(2); BAR; WAIT_L(0); MMA(0, 0, At, B0); BAR;
          LDB(B1, 1, 1); WAIT_V(0); BAR; WAIT_L(0); MMA(0, 1, At, B1); BAR;
          LDA(At, 1, 1); BAR; WAIT_L(0); MMA(1, 0, At, B0); MMA(1, 1, At, B1); BAR; }
        if (wr == 0) BAR;
        int erow = brow + wr * 64 + fr, ecol = bcol + wc * 32 + fq * 8;
        asm volatile("" : "+v"(erow), "+v"(ecol));
#pragma unroll
        for (int ai = 0; ai < 2; ++ai)
#pragma unroll
            for (int m = 0; m < 4; ++m) {
                const int row = erow + ai * HALF + m * 16;
#pragma unroll
                for (int bj = 0; bj < 2; ++bj) epi(row, ecol + bj * HALF, acc[ai][bj][m][0], acc[ai][bj][m][1], split);
                if (m & 1) SCHED;
            }
    }
#undef SA
#undef SB
}

struct EpiP {
    bf16_t* P; bf16_t* GH; float* out; int l;
    __device__ __forceinline__ void operator()(int row, int col, f32x4 v, f32x4 w, int split) const {
        const u32x4 o = (u32x4){pk2(v[0], v[1]), pk2(v[2], v[3]), pk2(w[0], w[1]), pk2(w[2], w[3])};
        *(u32x4*)(P + (size_t)row * NP + col) = o;
        if (col >= cBQ && col < cZ) {
            const int c = col - cBQ;
            if ((row & 31) >= 29) *(u32x4*)(GH + ((size_t)(row >> 5) * 3 + ((row & 31) - 29)) * 1536 + c) = o;
            if (row < SROW0) { const int b = row / LPAD, t = row - b * LPAD; if (t >= LP - 3 && t < LP) { float* d = out + o_pgc + ((size_t)(l * NB + b) * 3 + (t - (LP - 3))) * 1536 + c; *(f32x4*)d = v; *(f32x4*)(d + 4) = w; } }
            else { const int s = (row - SROW0) >> 2, t = row & 3; if (t >= 1) { float* d = out + o_sgc + ((size_t)(l * NS + s) * 3 + (t - 1)) * 1536 + c; *(f32x4*)d = v; *(f32x4*)(d + 4) = w; } }
        }
    }
};
struct EpiMerge {
    bf16_t* P;
    __device__ __forceinline__ void operator()(int row, int col, f32x4 v, f32x4 w, int split) const {
        u32x4* ptr = (u32x4*)(P + (size_t)row * NP + cMG + col); const u32x4 gm = *ptr;
        v[0] *= sigmoidf_(bflo(gm.x)); v[1] *= sigmoidf_(bfhi(gm.x)); v[2] *= sigmoidf_(bflo(gm.y)); v[3] *= sigmoidf_(bfhi(gm.y));
        w[0] *= sigmoidf_(bflo(gm.z)); w[1] *= sigmoidf_(bfhi(gm.z)); w[2] *= sigmoidf_(bflo(gm.w)); w[3] *= sigmoidf_(bfhi(gm.w));
        *ptr = (u32x4){pk2(v[0], v[1]), pk2(v[2], v[3]), pk2(w[0], w[1]), pk2(w[2], w[3])};
    }
};
struct EpiRes {
    const bf16_t* X; bf16_t* O; int ldo; int ocol0; bf16_t* SCR;
    __device__ __forceinline__ void operator()(int row, int col, f32x4 v, f32x4 w, int split) const {
        if (split == 0) {
            const u32x4 x = *(const u32x4*)(X + (size_t)row * D + col);
            v[0] += ALPHA * bflo(x.x); v[1] += ALPHA * bfhi(x.x); v[2] += ALPHA * bflo(x.y); v[3] += ALPHA * bfhi(x.y);
            w[0] += ALPHA * bflo(x.z); w[1] += ALPHA * bfhi(x.z); w[2] += ALPHA * bflo(x.w); w[3] += ALPHA * bfhi(x.w);
            *(u32x4*)(O + (size_t)row * ldo + ocol0 + col) = (u32x4){pk2(v[0], v[1]), pk2(v[2], v[3]), pk2(w[0], w[1]), pk2(w[2], w[3])};
        } else *(u32x4*)(SCR + ((size_t)(split - 1) * (MROWS - SPLIT_ROW0) + (row - SPLIT_ROW0)) * D + col) = (u32x4){pk2(v[0], v[1]), pk2(v[2], v[3]), pk2(w[0], w[1]), pk2(w[2], w[3])};
    }
};
struct EpiUp {
    bf16_t* U; bf16_t* HB; float* out; int l;
    __device__ __forceinline__ void operator()(int row, int col, f32x4 v, f32x4 w, int split) const {
        const u32x4 o = (u32x4){pk2(v[0], v[1]), pk2(v[2], v[3]), pk2(w[0], w[1]), pk2(w[2], w[3])};
        *(u32x4*)(U + (size_t)row * NU + col) = o;
        if ((row & 31) >= 30) *(u32x4*)(HB + ((size_t)(row >> 5) * 2 + (row & 1)) * NU + col) = o;
        if (row < SROW0) { const int b = row / LPAD, t = row - b * LPAD; if (t >= LP - 2 && t < LP) { float* d = out + o_pfc + ((size_t)(l * NB + b) * 2 + (t - (LP - 2))) * NU + col; *(f32x4*)d = v; *(f32x4*)(d + 4) = w; } }
        else { const int s = (row - SROW0) >> 2, t = row & 3; if (t >= 2) { float* d = out + o_sfc + ((size_t)(l * NS + s) * 2 + (t - 2)) * NU + col; *(f32x4*)d = v; *(f32x4*)(d + 4) = w; } }
    }
};

constexpr int SBUF = 32 * 128 * 2 + 32 * 32 + 32 * 16;
__device__ __forceinline__ float* QB(float* lds, int b) { return lds + b * SBUF; }
__device__ __forceinline__ float* KB(float* lds, int b) { return lds + b * SBUF + 4096; }
__device__ __forceinline__ float* VB(float* lds, int b) { return lds + b * SBUF + 8192; }
__device__ __forceinline__ float* SCB(float* lds, int b) { return lds + b * SBUF + 9216; }
__device__ __forceinline__ float* OB(float* lds, int b) { return lds + 2 * SBUF + b * 1024; }

__device__ __forceinline__ void store_out_blk(bf16_t* P, int row0, int jb, int L, int pcol, const float* ob, int ptid) {
    const int tt = ptid >> 3, g = ptid & 7, t0 = jb * 32;
    if (t0 + tt < L) { const f32x4 v = *(const f32x4*)(ob + tt * 32 + g * 4);
        *(u32x2*)(P + (size_t)(row0 + t0 + tt) * NP + pcol + g * 4) = (u32x2){pk2(v[0], v[1]), pk2(v[2], v[3])}; }
}
__device__ __forceinline__ f32x2 lo2(f32x4 v) { return __builtin_shufflevector(v, v, 0, 1); }
__device__ __forceinline__ f32x2 hi2(f32x4 v) { return __builtin_shufflevector(v, v, 2, 3); }
__device__ __forceinline__ f32x2 bc2(float x) { return (f32x2){x, x}; }
__device__ __forceinline__ float dot16(const f32x4* a, const float* kp) {
    float s = 0.f;
#pragma unroll
    for (int i = 0; i < 4; ++i) { const f32x4 b = *(const f32x4*)(kp + 4 * i); s += (a[i][0] * b[0] + a[i][1] * b[1]) + (a[i][2] * b[2] + a[i][3] * b[3]); }
    return s;
}

struct StageRegs { f32x4 &q0, &q1, &k0, &k1, &v, &r0, &x0, &x1; };
__device__ __forceinline__ f32x4 asf(u32x4 u) { return __builtin_bit_cast(f32x4, u); }
__device__ __forceinline__ u32x4 asu(f32x4 f) { return __builtin_bit_cast(u32x4, f); }
#define BARRIER_LDS() asm volatile("s_waitcnt lgkmcnt(0)\n\ts_barrier" ::: "memory")
__device__ __forceinline__ void issue_mlstm(const Params& p, int h, int qtr, int row0, int L, int jb, int ptid, StageRegs& r) {
    const bf16_t* P = (const bf16_t*)(p.ws + OFF_P); const float* G = (const float*)(p.ws + OFF_G);
    const int tt = ptid >> 3, g = ptid & 7, t0 = jb * 32;
    if (t0 + tt >= L) return;
    const int row = row0 + t0 + tt;
    const bf16_t* prow = P + (size_t)row * NP;
    r.q0 = asf(*(const u32x4*)(prow + cQ + h * 128 + g * 16)); r.q1 = asf(*(const u32x4*)(prow + cQ + h * 128 + g * 16 + 8));
    r.k0 = asf(*(const u32x4*)(prow + cK + h * 128 + g * 16)); r.k1 = asf(*(const u32x4*)(prow + cK + h * 128 + g * 16 + 8));
    { const u32x2 vv_ = *(const u32x2*)(prow + cV + h * 128 + qtr * 32 + g * 4); r.v = asf((u32x4){vv_.x, vv_.y, 0u, 0u}); }
    if (g == 0) { const float* gr = G + (size_t)row * 16; r.r0 = (f32x4){gr[h], gr[4 + h], 0.f, 0.f}; }
}
__device__ __forceinline__ void commit_mlstm(const Params& p, int l, int h, int L, int jb, float* lds, int ptid, const StageRegs& r, int bsel = -1) {
    const int tt = ptid >> 3, g = ptid & 7, t0 = jb * 32, b = bsel >= 0 ? bsel : (jb & 1);
    if (t0 + tt >= L) return;
    float x[16]; f32x4 qs[4];
    unpack8(asu(r.q0), x); unpack8(asu(r.q1), x + 8);
    float* qd = QB(lds, b) + tt * 128 + g * 16;
#pragma unroll
    for (int i = 0; i < 4; ++i) { qs[i] = (f32x4){x[4 * i], x[4 * i + 1], x[4 * i + 2], x[4 * i + 3]} * 0.08838834764831845f; *(f32x4*)(qd + 4 * i) = qs[i]; }
    unpack8(asu(r.k0), x); unpack8(asu(r.k1), x + 8);
    float* kd = KB(lds, b) + tt * 128 + g * 16;
#pragma unroll
    for (int i = 0; i < 4; ++i) *(f32x4*)(kd + 4 * i) = (f32x4){x[4 * i], x[4 * i + 1], x[4 * i + 2], x[4 * i + 3]};
    *(f32x4*)(VB(lds, b) + tt * 32 + g * 4) = (f32x4){bflo(asu(r.v).x), bfhi(asu(r.v).x), bflo(asu(r.v).y), bfhi(asu(r.v).y)};
    const float* kmb = KB(lds, b) + (tt & ~3) * 128 + g * 16;
    f32x4 qk;
#pragma unroll
    for (int j = 0; j < 4; ++j) qk[j] = red8(dot16(qs, kmb + j * 128));
    if (g == 0) {
        const float ig = r.r0[0] + p.gate_bias[l * 8 + h], f = r.r0[1] + p.gate_bias[l * 8 + 4 + h];
        const float lf = fminf(f, 0.f) - log1pf(__expf(-fabsf(f)));
        float* sc = SCB(lds, b) + tt * 16; *(f32x2*)sc = (f32x2){ig, lf}; *(f32x4*)(sc + 4) = qk; }
}

__device__ __forceinline__ void scan_mlstm(const Params& p, int l, bool samp, int bs, int h, int qtr, int row0, int L, float* lds) {
    const int tid = opaque_tid(p.wv); const bool cons = tid < 256; const int ptid = tid - 256;
    const int lane = tid & 63, w = (tid >> 6) & 3, s = lane & 7, cl = w * 8 + (lane >> 3), col = qtr * 32 + cl;
    const int e2 = 2 * (lane >> 3), nd = (e2 >> 2) * 32 + s * 4 + (e2 & 3);
    bf16_t* P = (bf16_t*)(p.ws + OFF_P);
    f32x2 C[8]; float n0v = 0.f, n1v = 0.f, m = 0.f;
#pragma unroll
    for (int e = 0; e < 8; ++e) C[e] = bc2(0.f);
    if (cons && samp) {
        const size_t sh = (size_t)(l * NS + bs) * 4 + h;
        const float* C0 = p.st_C + sh * 16384;
#pragma unroll
        for (int e = 0; e < 16; ++e) { const int d = (e >> 2) * 32 + s * 4 + (e & 3); C[e >> 1][e & 1] = C0[d * 128 + col]; }
        n0v = p.st_n[sh * 128 + nd]; n1v = p.st_n[sh * 128 + nd + 1]; m = p.st_m[sh];
    }
    const int nblk = (L + 31) >> 5;
    f32x4 k4[4][4];
    StageRegs sr{k4[0][0], k4[0][1], k4[0][2], k4[0][3], k4[1][0], k4[1][1], k4[1][2], k4[1][3]};
    if (!cons) { issue_mlstm(p, h, qtr, row0, L, 0, ptid, sr); commit_mlstm(p, l, h, L, 0, lds, ptid, sr); if (1 < nblk) issue_mlstm(p, h, qtr, row0, L, 1, ptid, sr); }
    BARRIER_LDS();
    for (int jb = 0; jb < nblk; ++jb) {
        if (!cons) {
            if (jb + 1 < nblk) commit_mlstm(p, l, h, L, jb + 1, lds, ptid, sr);
            if (jb + 2 < nblk) issue_mlstm(p, h, qtr, row0, L, jb + 2, ptid, sr);
            if (jb > 0) store_out_blk(P, row0, jb - 1, L, cV + h * 128 + qtr * 32, OB(lds, (jb - 1) & 1), ptid);
        } else {
            const float* qb = QB(lds, jb & 1); const float* kb = KB(lds, jb & 1); const float* vb = VB(lds, jb & 1); const float* sc = SCB(lds, jb & 1);
            float* ob = OB(lds, jb & 1);
            const int nt = min(32, L - jb * 32);
            f32x4 q4[4][4]; f32x2 kn[4], qn[4]; float vv[4], ig[4], lf[4]; f32x4 qk[4];
#define MLOAD_Q(T0) do { _Pragma("unroll") for (int i = 0; i < 4; ++i) { const int t = (T0) + i; \
        _Pragma("unroll") for (int j = 0; j < 4; ++j) q4[i][j] = *(const f32x4*)(qb + t * 128 + j * 32 + s * 4); \
        qn[i] = *(const f32x2*)(qb + t * 128 + nd); } } while (0)
#define MLOAD_K(T0) do { _Pragma("unroll") for (int i = 0; i < 4; ++i) { const int t = (T0) + i; \
        const f32x2 gg = *(const f32x2*)(sc + t * 16); ig[i] = gg[0]; lf[i] = gg[1]; \
        qk[i] = *(const f32x4*)(sc + t * 16 + 4); vv[i] = vb[t * 32 + cl]; } \
      _Pragma("unroll") for (int i = 0; i < 4; ++i) { const int t = (T0) + i; \
        _Pragma("unroll") for (int j = 0; j < 4; ++j) k4[i][j] = *(const f32x4*)(kb + t * 128 + j * 32 + s * 4); \
        kn[i] = *(const f32x2*)(kb + t * 128 + nd); } } while (0)
            MLOAD_Q(0); MLOAD_K(0);
#pragma unroll 1
            for (int t0 = 0; t0 < nt; t0 += 4) {
                float d[4], dn[4];
                const int tn = min(t0 + 4, 28);
                __builtin_amdgcn_sched_barrier(0);
#pragma unroll
                for (int i = 0; i < 4; ++i) {
                    f32x2 a = bc2(0.f), a2 = bc2(0.f);
#pragma unroll
                    for (int j = 0; j < 4; ++j) { a = lo2(q4[i][j]) * C[2 * j] + a; a2 = hi2(q4[i][j]) * C[2 * j + 1] + a2; }
                    a = a + a2;
                    d[i] = a[0] + a[1]; dn[i] = qn[i][0] * n0v + qn[i][1] * n1v;
                }
                __builtin_amdgcn_sched_barrier(0);
                MLOAD_Q(tn);
                __builtin_amdgcn_sched_barrier(0);
#pragma unroll
                for (int i = 0; i < 4; ++i) { d[i] = red8(d[i]); dn[i] = red64(dn[i]); }
                float fp[4], ip[4], em[4];
#pragma unroll
                for (int i = 0; i < 4; ++i) { const float mn = fmaxf(lf[i] + m, ig[i]); fp[i] = __expf(lf[i] + m - mn); ip[i] = __expf(ig[i] - mn); em[i] = __expf(-mn); m = mn; }
                const float F0 = fp[0], F1 = F0 * fp[1], F2 = F1 * fp[2], F3 = F2 * fp[3];
                const float g00 = ip[0], g10 = g00 * fp[1], g11 = ip[1], g20 = g10 * fp[2], g21 = g11 * fp[2], g22 = ip[2];
                const float g30 = g20 * fp[3], g31 = g21 * fp[3], g32 = g22 * fp[3], g33 = ip[3];
                const float s00 = g00 * qk[0][0];
                const float s10 = g10 * qk[1][0], s11 = g11 * qk[1][1];
                const float s20 = g20 * qk[2][0], s21 = g21 * qk[2][1], s22 = g22 * qk[2][2];
                const float s30 = g30 * qk[3][0], s31 = g31 * qk[3][1], s32 = g32 * qk[3][2], s33 = g33 * qk[3][3];
                const float num0 = F0 * d[0] + s00 * vv[0], den0 = F0 * dn[0] + s00;
                const float num1 = F1 * d[1] + s10 * vv[0] + s11 * vv[1], den1 = F1 * dn[1] + s10 + s11;
                const float num2 = F2 * d[2] + s20 * vv[0] + s21 * vv[1] + s22 * vv[2], den2 = F2 * dn[2] + s20 + s21 + s22;
                const float num3 = F3 * d[3] + s30 * vv[0] + s31 * vv[1] + s32 * vv[2] + s33 * vv[3], den3 = F3 * dn[3] + s30 + s31 + s32 + s33;
                if (s == 0) {
                    ob[(t0 + 0) * 32 + cl] = num0 / fmaxf(fabsf(den0), em[0]); ob[(t0 + 1) * 32 + cl] = num1 / fmaxf(fabsf(den1), em[1]);
                    ob[(t0 + 2) * 32 + cl] = num2 / fmaxf(fabsf(den2), em[2]); ob[(t0 + 3) * 32 + cl] = num3 / fmaxf(fabsf(den3), em[3]);
                }
                const float c0 = g30 * vv[0], c1 = g31 * vv[1], c2 = g32 * vv[2], c3 = g33 * vv[3];
#pragma unroll
                for (int j = 0; j < 4; ++j) {
                    C[2 * j] = lo2(k4[3][j]) * bc2(c3) + (lo2(k4[2][j]) * bc2(c2) + (lo2(k4[1][j]) * bc2(c1) + (lo2(k4[0][j]) * bc2(c0) + C[2 * j] * bc2(F3))));
                    C[2 * j + 1] = hi2(k4[3][j]) * bc2(c3) + (hi2(k4[2][j]) * bc2(c2) + (hi2(k4[1][j]) * bc2(c1) + (hi2(k4[0][j]) * bc2(c0) + C[2 * j + 1] * bc2(F3)))); }
                n0v = n0v * F3 + (kn[0][0] * g30 + kn[1][0] * g31) + (kn[2][0] * g32 + kn[3][0] * g33);
                n1v = n1v * F3 + (kn[0][1] * g30 + kn[1][1] * g31) + (kn[2][1] * g32 + kn[3][1] * g33);
                __builtin_amdgcn_sched_barrier(0);
                MLOAD_K(tn);
            }
#undef MLOAD_Q
#undef MLOAD_K
        }
        BARRIER_LDS();
    }
    if (!cons) store_out_blk(P, row0, nblk - 1, L, cV + h * 128 + qtr * 32, OB(lds, (nblk - 1) & 1), ptid);
    else {
        const size_t sh = samp ? (size_t)(l * NS + bs) * 4 + h : (size_t)(l * NB + bs) * 4 + h;
        float* Co = p.out + (samp ? o_sC : o_pC) + sh * 16384;
#pragma unroll
        for (int e = 0; e < 16; ++e) { const int d = (e >> 2) * 32 + s * 4 + (e & 3); Co[d * 128 + col] = C[e >> 1][e & 1]; }
        if (qtr == 0 && w == 0) { float* no = p.out + (samp ? o_sn : o_pn) + sh * 128; no[nd] = n0v; no[nd + 1] = n1v;
            if (lane == 0) p.out[(samp ? o_sm : o_pm) + sh] = m; }
    }
    BARRIER_LDS();
}


constexpr int ST_LD = 33;
__device__ __forceinline__ float* STB(float* lds, int b) { return lds + 2 * SBUF + 2048 + b * (128 * ST_LD); }
__device__ __forceinline__ void st_issue(const float* S0, int qtr, int ptid, f32x4& a0, f32x4& a1, f32x4& a2, f32x4& a3) {
    const int d = ptid >> 3, c = (ptid & 7) * 4; const float* b = S0 + d * 128 + qtr * 32 + c;
    a0 = *(const f32x4*)b; a1 = *(const f32x4*)(b + 32 * 128); a2 = *(const f32x4*)(b + 64 * 128); a3 = *(const f32x4*)(b + 96 * 128);
}
__device__ __forceinline__ void st_commit(float* st, int ptid, const f32x4& a0, const f32x4& a1, const f32x4& a2, const f32x4& a3) {
    const int d = ptid >> 3, c = (ptid & 7) * 4; float* b = st + d * ST_LD + c;
#pragma unroll
    for (int i = 0; i < 4; ++i) { b[i] = a0[i]; b[32 * ST_LD + i] = a1[i]; b[64 * ST_LD + i] = a2[i]; b[96 * ST_LD + i] = a3[i]; }
}
__device__ __forceinline__ void st_store(float* So, int qtr, const float* st, int ptid) {
    const int d = ptid >> 3, c = (ptid & 7) * 4; const float* b = st + d * ST_LD + c; float* o = So + d * 128 + qtr * 32 + c;
#pragma unroll
    for (int q = 0; q < 4; ++q) *(f32x4*)(o + q * 32 * 128) = (f32x4){b[q * 32 * ST_LD], b[q * 32 * ST_LD + 1], b[q * 32 * ST_LD + 2], b[q * 32 * ST_LD + 3]};
}
__device__ __forceinline__ void scan_mlstm_stream(const Params& p, int l, int h, int qtr, int bs0, int nseq, float* lds) {
    const int tid = opaque_tid(p.wv); const bool cons = tid < 256; const int ptid = tid - 256;
    const int lane = tid & 63, w = (tid >> 6) & 3, s = lane & 7, cl = w * 8 + (lane >> 3), col = qtr * 32 + cl;
    const int e2 = 2 * (lane >> 3), nd = (e2 >> 2) * 32 + s * 4 + (e2 & 3);
    bf16_t* P = (bf16_t*)(p.ws + OFF_P);
    f32x2 C[8]; float n0v = 0.f, n1v = 0.f, m = 0.f, n0n = 0.f, n1n = 0.f, mnx = 0.f;
#pragma unroll
    for (int e = 0; e < 8; ++e) C[e] = bc2(0.f);
    f32x4 k4[4][4];
    StageRegs sr{k4[0][0], k4[0][1], k4[0][2], k4[0][3], k4[1][0], k4[1][1], k4[1][2], k4[1][3]};
#define LOADSTATE(BS) do { const size_t sh_ = (size_t)(l * NS + (BS)) * 4 + h; n0n = p.st_n[sh_ * 128 + nd]; n1n = p.st_n[sh_ * 128 + nd + 1]; mnx = p.st_m[sh_]; } while (0)
#define STISSUE(BS) st_issue(p.st_C + ((size_t)(l * NS + (BS)) * 4 + h) * 16384, qtr, ptid, k4[2][0], k4[2][1], k4[2][2], k4[2][3])
    if (!cons) { issue_mlstm(p, h, qtr, SROW0 + bs0 * 4, LS, 0, ptid, sr); STISSUE(bs0); } else LOADSTATE(bs0);
#pragma unroll 1
    for (int k = 0; k < nseq; ++k) {
        const int bs = bs0 + 8 * k, row0 = SROW0 + bs * 4;
        if (!cons) { commit_mlstm(p, l, h, LS, 0, lds, ptid, sr, k & 1); st_commit(STB(lds, k & 1), ptid, k4[2][0], k4[2][1], k4[2][2], k4[2][3]);
            if (k + 1 < nseq) { issue_mlstm(p, h, qtr, row0 + 32, LS, 0, ptid, sr); STISSUE(bs + 8); } }
        else {
            n0v = n0n; n1v = n1n; m = mnx;
            if (k + 1 < nseq) LOADSTATE(bs + 8);
        }
        BARRIER_LDS();
        if (!cons) { if (k > 0) { store_out_blk(P, row0 - 32, 0, LS, cV + h * 128 + qtr * 32, OB(lds, (k - 1) & 1), ptid); st_store(p.out + o_sC + ((size_t)(l * NS + bs - 8) * 4 + h) * 16384, qtr, STB(lds, (k - 1) & 1), ptid); } }
        else {
            const float* qb = QB(lds, k & 1); const float* kb = KB(lds, k & 1); const float* vb = VB(lds, k & 1); const float* sc = SCB(lds, k & 1);
            float* ob = OB(lds, k & 1); float* stb = STB(lds, k & 1);
#pragma unroll
            for (int e = 0; e < 16; ++e) { const int d = (e >> 2) * 32 + s * 4 + (e & 3); C[e >> 1][e & 1] = stb[d * ST_LD + cl]; }
            f32x4 q4[4][4]; f32x2 kn[4], qn[4]; float vv[4], ig[4], lf[4]; f32x4 qk[4];
#define MLOAD_Q(T0) do { _Pragma("unroll") for (int i = 0; i < 4; ++i) { const int t = (T0) + i; \
        _Pragma("unroll") for (int j = 0; j < 4; ++j) q4[i][j] = *(const f32x4*)(qb + t * 128 + j * 32 + s * 4); \
        qn[i] = *(const f32x2*)(qb + t * 128 + nd); } } while (0)
#define MLOAD_K(T0) do { _Pragma("unroll") for (int i = 0; i < 4; ++i) { const int t = (T0) + i; \
        const f32x2 gg = *(const f32x2*)(sc + t * 16); ig[i] = gg[0]; lf[i] = gg[1]; \
        qk[i] = *(const f32x4*)(sc + t * 16 + 4); vv[i] = vb[t * 32 + cl]; } \
      _Pragma("unroll") for (int i = 0; i < 4; ++i) { const int t = (T0) + i; \
        _Pragma("unroll") for (int j = 0; j < 4; ++j) k4[i][j] = *(const f32x4*)(kb + t * 128 + j * 32 + s * 4); \
        kn[i] = *(const f32x2*)(kb + t * 128 + nd); } } while (0)
            MLOAD_Q(0); MLOAD_K(0);
            {
                float d[4], dn[4];
                __builtin_amdgcn_sched_barrier(0);
#pragma unroll
                for (int i = 0; i < 4; ++i) {
                    f32x2 a = bc2(0.f), a2 = bc2(0.f);
#pragma unroll
                    for (int j = 0; j < 4; ++j) { a = lo2(q4[i][j]) * C[2 * j] + a; a2 = hi2(q4[i][j]) * C[2 * j + 1] + a2; }
                    a = a + a2;
                    d[i] = a[0] + a[1]; dn[i] = qn[i][0] * n0v + qn[i][1] * n1v;
                }
                __builtin_amdgcn_sched_barrier(0);
#pragma unroll
                for (int i = 0; i < 4; ++i) { d[i] = red8(d[i]); dn[i] = red64(dn[i]); }
                float fp[4], ip[4], em[4];
#pragma unroll
                for (int i = 0; i < 4; ++i) { const float mn = fmaxf(lf[i] + m, ig[i]); fp[i] = __expf(lf[i] + m - mn); ip[i] = __expf(ig[i] - mn); em[i] = __expf(-mn); m = mn; }
                const float F0 = fp[0], F1 = F0 * fp[1], F2 = F1 * fp[2], F3 = F2 * fp[3];
                const float g00 = ip[0], g10 = g00 * fp[1], g11 = ip[1], g20 = g10 * fp[2], g21 = g11 * fp[2], g22 = ip[2];
                const float g30 = g20 * fp[3], g31 = g21 * fp[3], g32 = g22 * fp[3], g33 = ip[3];
                const float s00 = g00 * qk[0][0];
                const float s10 = g10 * qk[1][0], s11 = g11 * qk[1][1];
                const float s20 = g20 * qk[2][0], s21 = g21 * qk[2][1], s22 = g22 * qk[2][2];
                const float s30 = g30 * qk[3][0], s31 = g31 * qk[3][1], s32 = g32 * qk[3][2], s33 = g33 * qk[3][3];
                const float num0 = F0 * d[0] + s00 * vv[0], den0 = F0 * dn[0] + s00;
                const float num1 = F1 * d[1] + s10 * vv[0] + s11 * vv[1], den1 = F1 * dn[1] + s10 + s11;
                const float num2 = F2 * d[2] + s20 * vv[0] + s21 * vv[1] + s22 * vv[2], den2 = F2 * dn[2] + s20 + s21 + s22;
                const float num3 = F3 * d[3] + s30 * vv[0] + s31 * vv[1] + s32 * vv[2] + s33 * vv[3], den3 = F3 * dn[3] + s30 + s31 + s32 + s33;
                if (s == 0) {
                    ob[0 * 32 + cl] = num0 / fmaxf(fabsf(den0), em[0]); ob[1 * 32 + cl] = num1 / fmaxf(fabsf(den1), em[1]);
                    ob[2 * 32 + cl] = num2 / fmaxf(fabsf(den2), em[2]); ob[3 * 32 + cl] = num3 / fmaxf(fabsf(den3), em[3]);
                }
                const float c0 = g30 * vv[0], c1 = g31 * vv[1], c2 = g32 * vv[2], c3 = g33 * vv[3];
#pragma unroll
                for (int j = 0; j < 4; ++j) {
                    C[2 * j] = lo2(k4[3][j]) * bc2(c3) + (lo2(k4[2][j]) * bc2(c2) + (lo2(k4[1][j]) * bc2(c1) + (lo2(k4[0][j]) * bc2(c0) + C[2 * j] * bc2(F3))));
                    C[2 * j + 1] = hi2(k4[3][j]) * bc2(c3) + (hi2(k4[2][j]) * bc2(c2) + (hi2(k4[1][j]) * bc2(c1) + (hi2(k4[0][j]) * bc2(c0) + C[2 * j + 1] * bc2(F3)))); }
                n0v = n0v * F3 + (kn[0][0] * g30 + kn[1][0] * g31) + (kn[2][0] * g32 + kn[3][0] * g33);
                n1v = n1v * F3 + (kn[0][1] * g30 + kn[1][1] * g31) + (kn[2][1] * g32 + kn[3][1] * g33);
            }
#undef MLOAD_Q
#undef MLOAD_K
            const size_t sh = (size_t)(l * NS + bs) * 4 + h;
#pragma unroll
            for (int e = 0; e < 16; ++e) { const int d = (e >> 2) * 32 + s * 4 + (e & 3); stb[d * ST_LD + cl] = C[e >> 1][e & 1]; }
            if (qtr == 0 && w == 0) { float* no = p.out + o_sn + sh * 128; no[nd] = n0v; no[nd + 1] = n1v; if (lane == 0) p.out[o_sm + sh] = m; }
        }
    }
    BARRIER_LDS();
    if (!cons) { store_out_blk(P, SROW0 + (bs0 + 8 * (nseq - 1)) * 4, 0, LS, cV + h * 128 + qtr * 32, OB(lds, (nseq - 1) & 1), ptid); st_store(p.out + o_sC + ((size_t)(l * NS + bs0 + 8 * (nseq - 1)) * 4 + h) * 16384, qtr, STB(lds, (nseq - 1) & 1), ptid); }
    BARRIER_LDS();
#undef LOADSTATE
#undef STISSUE
}


typedef float f32x16 __attribute__((ext_vector_type(16)));
#define MFMA32(a, b, c) __builtin_amdgcn_mfma_f32_32x32x16_bf16((a), (b), (c), 0, 0, 0)
__device__ __forceinline__ int crow(int reg, int hf) { return (reg & 3) + 8 * (reg >> 2) + 4 * hf; }
__device__ __forceinline__ bf16x8 pack_step(const f32x16& x, int s) {
    u32x4 pk;
    asm volatile("s_nop 7\n\ts_nop 3\n\tv_cvt_pk_bf16_f32 %0, %4, %5\n\tv_cvt_pk_bf16_f32 %1, %6, %7\n\tv_cvt_pk_bf16_f32 %2, %8, %9\n\tv_cvt_pk_bf16_f32 %3, %10, %11\n\ts_nop 1"
                 : "=&v"(pk[0]), "=&v"(pk[1]), "=&v"(pk[2]), "=&v"(pk[3])
                 : "v"(x[8 * s]), "v"(x[8 * s + 1]), "v"(x[8 * s + 2]), "v"(x[8 * s + 3]), "v"(x[8 * s + 4]), "v"(x[8 * s + 5]), "v"(x[8 * s + 6]), "v"(x[8 * s + 7]));
    return __builtin_bit_cast(bf16x8, pk);
}
__device__ __forceinline__ bf16x8 frag_n(const bf16_t* base, int ld, int r, int hf, int kb) { return *(const bf16x8*)(base + r * ld + kb * 16 + hf * 8); }
__device__ __forceinline__ bf16x8 frag_p(const bf16_t* base, int ld, int r, int hf, int k0) {
    const u32x2 a = *(const u32x2*)(base + r * ld + k0 + 4 * hf), b = *(const u32x2*)(base + r * ld + k0 + 8 + 4 * hf);
    return __builtin_bit_cast(bf16x8, (u32x4){a.x, a.y, b.x, b.y});
}
__device__ __forceinline__ int kto(int d) { return d * 40 + (d >> 4) * 8; }
__device__ __forceinline__ bf16_t f2bf(float x) { return (bf16_t)(pk2(x, 0.f) & 0xffffu); }

constexpr int CH_LDQ = 136, CH_LDS = 40;
constexpr int CH_QB = 0, CH_KB = 8704, CH_KWT = 17408, CH_VT = 27904, CH_SW = 33024, CH_SC = 35584, CH_QW = 36608, CH_SLOT = 45312, CH_OB = 2 * CH_SLOT;
constexpr int SC_U = 0, SC_B = 32, SC_PM = 64;

__device__ __forceinline__ void store_out_norm(bf16_t* P, int row0, int jb, int L, int pcol, const float* ob, const float* rd, int ptid) {
    const int tt = ptid >> 3, g = ptid & 7, t0 = jb * 32;
    if (t0 + tt < L) { const f32x4 v = *(const f32x4*)(ob + tt * 32 + g * 4) * rd[tt];
        *(u32x2*)(P + (size_t)(row0 + t0 + tt) * NP + pcol + g * 4) = (u32x2){pk2(v[0], v[1]), pk2(v[2], v[3])}; }
}
__device__ __forceinline__ void issue_mlstm_chunk(const Params& p, int h, int qtr, int row0, int L, int nch, int jb, int ptid, StageRegs& r) {
    if (jb >= nch) return;
    const bf16_t* P = (const bf16_t*)(p.ws + OFF_P); const float* REC = (const float*)(p.ws + OFF_REC);
    const int tt = ptid >> 3, g = ptid & 7, t0 = jb * 32;
    const int row = row0 + t0 + tt;
    if (g == 0) r.r0 = *(const f32x4*)(REC + ((size_t)row * 4 + h) * 16 + 4);
    if (t0 + tt >= L) return;
    const bf16_t* prow = P + (size_t)row * NP;
    r.q0 = asf(*(const u32x4*)(prow + cQ + h * 128 + g * 16)); r.q1 = asf(*(const u32x4*)(prow + cQ + h * 128 + g * 16 + 8));
    r.k0 = asf(*(const u32x4*)(prow + cK + h * 128 + g * 16)); r.k1 = asf(*(const u32x4*)(prow + cK + h * 128 + g * 16 + 8));
    { const u32x2 vv_ = *(const u32x2*)(prow + cV + h * 128 + qtr * 32 + g * 4); r.v = asf((u32x4){vv_.x, vv_.y, 0u, 0u}); }
}

__device__ __forceinline__ void scan_mlstm_chunk(const Params& p, int l, int bs, int h, int qtr, int row0, int L, unsigned char* lb) {
    const int tid = opaque_tid(p.wv); const int wave = tid >> 6, lane = tid & 63, r = lane & 31, hf = lane >> 5, ptid = tid - 256;
    bf16_t* P = (bf16_t*)(p.ws + OFF_P);
    const int nch = (L + 31) >> 5;
    f32x16 C[4];
    const int ct = wave == 3 ? 1 : 0;
#pragma unroll
    for (int dt = 0; dt < 4; ++dt)
#pragma unroll
        for (int i = 0; i < 16; ++i) C[dt][i] = 0.f;
    float m0 = 0.f;
    f32x4 s0, s1, s2, s3, s4, s5, s6, s7; StageRegs sr{s0, s1, s2, s3, s4, s5, s6, s7};
    if (wave >= 4) { for (int i = ptid; i < 2 * 32 * CH_LDS; i += 256) { const int sl = i / (32 * CH_LDS), e = i % (32 * CH_LDS);
            ((bf16_t*)(lb + sl * CH_SLOT + CH_VT))[32 * CH_LDS + e] = (e < CH_LDS) ? (bf16_t)0x3f80 : (bf16_t)0; } }
#define CH_P1(JN) do { const int jn_ = (JN); unsigned char* sl_ = lb + (jn_ & 1) * CH_SLOT; const int tt = ptid >> 3, g = ptid & 7; const bool val_ = jn_ * 32 + tt < L; \
        u32x4 q0_ = asu(sr.q0), q1_ = asu(sr.q1), k0_ = asu(sr.k0), k1_ = asu(sr.k1); u32x4 v_ = asu(sr.v); \
        if (!val_) { q0_ = q1_ = k0_ = k1_ = v_ = (u32x4){0u, 0u, 0u, 0u}; } \
        *(u32x4*)(sl_ + CH_QB + (tt * CH_LDQ + g * 16) * 2) = q0_; *(u32x4*)(sl_ + CH_QB + (tt * CH_LDQ + g * 16 + 8) * 2) = q1_; \
        *(u32x4*)(sl_ + CH_KB + (tt * CH_LDQ + g * 16) * 2) = k0_; *(u32x4*)(sl_ + CH_KB + (tt * CH_LDQ + g * 16 + 8) * 2) = k1_; \
        bf16_t* vt_ = (bf16_t*)(sl_ + CH_VT); \
        vt_[(g * 4 + 0) * CH_LDS + tt] = (bf16_t)(v_.x & 0xffffu); vt_[(g * 4 + 1) * CH_LDS + tt] = (bf16_t)(v_.x >> 16); \
        vt_[(g * 4 + 2) * CH_LDS + tt] = (bf16_t)(v_.y & 0xffffu); vt_[(g * 4 + 3) * CH_LDS + tt] = (bf16_t)(v_.y >> 16); \
        if (g == 0) { float* sc_ = (float*)(sl_ + CH_SC); sc_[SC_U + tt] = sr.r0[0]; sc_[SC_B + tt] = sr.r0[1]; sc_[SC_PM + tt] = sr.r0[2]; } \
        issue_mlstm_chunk(p, h, qtr, row0, L, nch, jn_ + 1, ptid, sr); } while (0)
#define CH_P2(JN) do { unsigned char* sl_ = lb + ((JN) & 1) * CH_SLOT; const float* sc_ = (const float*)(sl_ + CH_SC); \
        const float bT_ = sc_[SC_B + 31], mT_ = bT_ + fmaxf(m0, sc_[SC_PM + 31]); \
        if (wave == 1) { f32x16 a_; _Pragma("unroll") for (int i = 0; i < 16; ++i) a_[i] = 0.f; \
            _Pragma("unroll") for (int kb = 0; kb < 8; ++kb) a_ = MFMA32(frag_n((const bf16_t*)(sl_ + CH_QB), CH_LDQ, r, hf, kb), frag_n((const bf16_t*)(sl_ + CH_KB), CH_LDQ, r, hf, kb), a_); \
            bf16_t* sw_ = (bf16_t*)(sl_ + CH_SW); const float us_ = sc_[SC_U + r]; \
            _Pragma("unroll") for (int i4 = 0; i4 < 4; ++i4) { const f32x4 pm4 = *(const f32x4*)(sc_ + SC_PM + 8 * i4 + 4 * hf); \
                _Pragma("unroll") for (int ii = 0; ii < 4; ++ii) { const int t = 8 * i4 + 4 * hf + ii; const float w_ = (r <= t) ? __expf(us_ - fmaxf(m0, pm4[ii])) * 0.08838834764831845f : 0.f; \
                    sw_[t * CH_LDS + r] = f2bf(a_[4 * i4 + ii] * w_); } } } \
        else if (wave >= 4) { const int tt = ptid >> 3, g = ptid & 7; \
            const float wi_ = __expf(m0 - fmaxf(m0, sc_[SC_PM + tt])) * 0.08838834764831845f, ws_ = __expf(sc_[SC_U + tt] + bT_ - mT_); float x_[16]; \
            u32x4* qp_ = (u32x4*)(sl_ + CH_QB + (tt * CH_LDQ + g * 16) * 2); unpack8(qp_[0], x_); unpack8(qp_[1], x_ + 8); \
            _Pragma("unroll") for (int i = 0; i < 16; ++i) x_[i] *= wi_; \
            u32x4* qo_ = (u32x4*)(sl_ + CH_QW + (tt * CH_LDQ + g * 16) * 2); qo_[0] = pack8(x_); qo_[1] = pack8(x_ + 8); \
            const u32x4* kp_ = (const u32x4*)(sl_ + CH_KB + (tt * CH_LDQ + g * 16) * 2); unpack8(kp_[0], x_); unpack8(kp_[1], x_ + 8); \
            bf16_t* kw_ = (bf16_t*)(sl_ + CH_KWT); \
            _Pragma("unroll") for (int i = 0; i < 16; ++i) kw_[kto(g * 16) + i * CH_LDS + tt] = f2bf(x_[i] * ws_); } \
        if (wave == 1 || wave >= 4) m0 = mT_; } while (0)
    if (wave >= 4) { issue_mlstm_chunk(p, h, qtr, row0, L, nch, 0, ptid, sr); CH_P1(0); }
    BARRIER_LDS();
    CH_P2(0);
    BARRIER_LDS();
#pragma unroll 1
    for (int j = 0; j < nch; ++j) {
        if (wave == 0 || wave == 3) {
            const unsigned char* sl = lb + (j & 1) * CH_SLOT; const float* sc = (const float*)(sl + CH_SC);
            const bf16_t* qw = (const bf16_t*)(sl + CH_QW); const bf16_t* sw = (const bf16_t*)(sl + CH_SW); const bf16_t* vt = (const bf16_t*)(sl + CH_VT) + ct * 32 * CH_LDS; const bf16_t* kwt = (const bf16_t*)(sl + CH_KWT);
            const float bT = sc[SC_B + 31], mT = bT + fmaxf(m0, sc[SC_PM + 31]);
            f32x16 H;
#pragma unroll
            for (int i = 0; i < 16; ++i) H[i] = 0.f;
#pragma unroll
            for (int dt = 0; dt < 4; ++dt)
#pragma unroll
                for (int u = 0; u < 2; ++u) H = MFMA32(frag_p(qw, CH_LDQ, r, hf, 32 * dt + 16 * u), pack_step(C[dt], u), H);
            bf16x8 vb[2];
#pragma unroll
            for (int kb = 0; kb < 2; ++kb) { vb[kb] = frag_n(vt, CH_LDS, r, hf, kb); H = MFMA32(frag_n(sw, CH_LDS, r, hf, kb), vb[kb], H); }
            const float wold = __expf(bT - mT + m0);
#pragma unroll
            for (int dt = 0; dt < 4; ++dt) {
#pragma unroll
                for (int i = 0; i < 16; ++i) C[dt][i] *= wold;
#pragma unroll
                for (int kb = 0; kb < 2; ++kb) C[dt] = MFMA32(frag_n(kwt + kto(dt * 32 + r), 0, 0, hf, kb), vb[kb], C[dt]);
            }
            float* ob = (float*)(lb + CH_OB) + (j & 1) * 1024; float* rd = (float*)(lb + CH_OB + 8192) + (j & 1) * 32;
            if (ct == 0) {
#pragma unroll
                for (int i = 0; i < 16; ++i) ob[crow(i, hf) * 32 + r] = H[i];
            } else if (r == 0) {
#pragma unroll
                for (int i = 0; i < 16; ++i) { const int t = crow(i, hf); rd[t] = __builtin_amdgcn_rcpf(fmaxf(fabsf(H[i]), __expf(-(sc[SC_B + t] + fmaxf(m0, sc[SC_PM + t]))))); }
            }
            m0 = mT;
        } else if (wave >= 4) {
            if (j + 1 < nch) CH_P1(j + 1);
            if (j > 0) store_out_norm(P, row0, j - 1, L, cV + h * 128 + qtr * 32, (const float*)(lb + CH_OB) + ((j - 1) & 1) * 1024, (const float*)(lb + CH_OB + 8192) + ((j - 1) & 1) * 32, ptid);
        }
        BARRIER_LDS();
        if (j + 1 < nch) CH_P2(j + 1);
        BARRIER_LDS();
    }
    if (wave >= 4) store_out_norm(P, row0, nch - 1, L, cV + h * 128 + qtr * 32, (const float*)(lb + CH_OB) + ((nch - 1) & 1) * 1024, (const float*)(lb + CH_OB + 8192) + ((nch - 1) & 1) * 32, ptid);
    const size_t sh = (size_t)(l * NB + bs) * 4 + h;
    if (wave == 0) {
        float* Co = p.out + o_pC + sh * 16384;
#pragma unroll
        for (int dt = 0; dt < 4; ++dt)
#pragma unroll
            for (int i = 0; i < 16; ++i) Co[(32 * dt + crow(i, hf)) * 128 + qtr * 32 + r] = C[dt][i];
        if (lane == 0 && qtr == 0) p.out[o_pm + sh] = m0;
    } else if (wave == 3 && r == 0 && qtr == 0) {
#pragma unroll
        for (int dt = 0; dt < 4; ++dt)
#pragma unroll
            for (int i = 0; i < 16; ++i) p.out[o_pn + sh * 128 + 32 * dt + crow(i, hf)] = C[dt][i];
    }
    __syncthreads();
#undef CH_P1
#undef CH_P2
}

__device__ __forceinline__ void gdn_raw8(const bf16_t* P, int r0, int tr, int pcol, const bf16_t* gh, const float* st, int hch, float* x) {
    if (tr >= 0) unpack8(*(const u32x4*)(P + (size_t)(r0 + tr) * NP + pcol), x);
    else if (gh) unpack8(*(const u32x4*)(gh + (3 + tr) * 1536 + hch), x);
    else if (st) { const float* hp = st + (3 + tr) * 1536 + hch; const f32x4 a = *(const f32x4*)hp, b = *(const f32x4*)(hp + 4);
        x[0] = a[0]; x[1] = a[1]; x[2] = a[2]; x[3] = a[3]; x[4] = b[0]; x[5] = b[1]; x[6] = b[2]; x[7] = b[3]; }
    else {
#pragma unroll
        for (int i = 0; i < 8; ++i) x[i] = 0.f; }
}
__device__ __forceinline__ void gdn_conv8(const bf16_t* P, int r0, int tr, int pcol, const bf16_t* gh, const float* st, int hch, const float* cw, float* y) {
#pragma unroll
    for (int i = 0; i < 8; ++i) y[i] = 0.f;
#pragma unroll
    for (int j = 0; j < 4; ++j) { float x[8]; gdn_raw8(P, r0, tr - 3 + j, pcol, gh, st, hch, x);
        const f32x4 w0 = *(const f32x4*)(cw + j * 1536 + hch), w1 = *(const f32x4*)(cw + j * 1536 + hch + 4);
        y[0] += x[0] * w0[0]; y[1] += x[1] * w0[1]; y[2] += x[2] * w0[2]; y[3] += x[3] * w0[3];
        y[4] += x[4] * w1[0]; y[5] += x[5] * w1[1]; y[6] += x[6] * w1[2]; y[7] += x[7] * w1[3]; }
#pragma unroll
    for (int i = 0; i < 8; ++i) y[i] = y[i] * sigmoidf_(y[i]);
}

__device__ __forceinline__ void phase_prep(const Params& p, int l, float* lds) {
    const int tid = opaque_tid(p.wv); const int half = tid >> 8, t = tid & 255, tt = t >> 3, g = t & 7, wq = t >> 6, lane = t & 63, r = lane & 31, hf = lane >> 5;
    bf16_t* P = (bf16_t*)(p.ws + OFF_P); const bf16_t* GH = (const bf16_t*)(p.ws + OFF_GH);
    const float* G = (const float*)(p.ws + OFF_G); float* REC = (float*)(p.ws + OFF_REC); bf16_t* TB = (bf16_t*)(p.ws + OFF_TB);
    const float* cw = p.gconv_w + (size_t)l * 4 * 1536;
    float* ksc = lds + half * 4096;
    unsigned char* pl = (unsigned char*)lds + 32768 + half * 22016;
    bf16_t* kimg = (bf16_t*)pl; bf16_t* qimg = (bf16_t*)(pl + 8704); float* am = (float*)(pl + 17408); float* sgl = (float*)(pl + 21504); float* sbe = sgl + 32; float* sG = sgl + 64;
    constexpr int NITEM = (MROWS / 32) * 4;
    for (int base = blockIdx.x * 2; base < NITEM; base += gridDim.x * 2) {
        const int item = base + half; const bool act = item < NITEM;
        const int rb = item >> 2, h = item & 3, r0 = rb * 32;
        const bool samp = rb >= SROW0 / 32;
        int tr = tt; const bf16_t* gh = nullptr; const float* st = nullptr; int rbase = r0; bool valid = act;
        if (!samp) { const int jb = rb % (LPAD / 32); if (jb * 32 + tt >= LP) valid = false; if (jb > 0) gh = GH + (size_t)(rb - 1) * 3 * 1536; }
        else { const int sq = (rb - SROW0 / 32) * 8 + (tt >> 2); tr = tt & 3; rbase = r0 + (tt & ~3); st = p.st_gconv + (size_t)(l * NS + sq) * 3 * 1536; }
        const int ch = h * 128 + g * 16;
        u32x4 oq0 = (u32x4){0u, 0u, 0u, 0u}, oq1 = oq0, ok0 = oq0, ok1 = oq0, ov0 = oq0, ov1 = oq0;
        float ga = 0.f, gb = 0.f, gg = 0.f;
        if (valid) {
            float y[16];
            gdn_conv8(P, rbase, tr, cBV + ch, gh, st, 1024 + ch, cw, y); gdn_conv8(P, rbase, tr, cBV + ch + 8, gh, st, 1024 + ch + 8, cw, y + 8);
            ov0 = pack8(y); ov1 = pack8(y + 8);
            __builtin_amdgcn_sched_barrier(0);
            gdn_conv8(P, rbase, tr, cBQ + ch, gh, st, ch, cw, y); gdn_conv8(P, rbase, tr, cBQ + ch + 8, gh, st, ch + 8, cw, y + 8);
            float ss = 0.f;
#pragma unroll
            for (int i = 0; i < 16; ++i) ss += y[i] * y[i];
            float rs = rsqrtf(red8(ss) + 1e-6f) * 0.08838834764831845f;
#pragma unroll
            for (int i = 0; i < 16; ++i) y[i] *= rs;
            oq0 = pack8(y); oq1 = pack8(y + 8);
            __builtin_amdgcn_sched_barrier(0);
            gdn_conv8(P, rbase, tr, cBK + ch, gh, st, 512 + ch, cw, y); gdn_conv8(P, rbase, tr, cBK + ch + 8, gh, st, 512 + ch + 8, cw, y + 8);
            ss = 0.f;
#pragma unroll
            for (int i = 0; i < 16; ++i) ss += y[i] * y[i];
            rs = rsqrtf(red8(ss) + 1e-6f);
#pragma unroll
            for (int i = 0; i < 16; ++i) y[i] *= rs;
            ok0 = pack8(y); ok1 = pack8(y + 8);
            unpack8(ok0, y); unpack8(ok1, y + 8);
#pragma unroll
            for (int i = 0; i < 4; ++i) *(f32x4*)(ksc + tt * 128 + g * 16 + 4 * i) = (f32x4){y[4 * i], y[4 * i + 1], y[4 * i + 2], y[4 * i + 3]};
            if (g == 0) { const float* gr = G + (size_t)(r0 + tt) * 16;
                gb = sigmoidf_(gr[8 + h]);
                const float xa = gr[12 + h] + p.dt_bias[l * 4 + h];
                const float sp = fmaxf(xa, 0.f) + log1pf(__expf(-fabsf(xa)));
                gg = -__expf(p.A_log[l * 4 + h]) * sp; ga = __expf(gg); }
        }
        if (!samp) {
            *(u32x4*)(kimg + tt * CH_LDQ + g * 16) = ok0; *(u32x4*)(kimg + tt * CH_LDQ + g * 16 + 8) = ok1;
            *(u32x4*)(qimg + tt * CH_LDQ + g * 16) = oq0; *(u32x4*)(qimg + tt * CH_LDQ + g * 16 + 8) = oq1;
            if (g == 0) { sgl[tt] = gg; sbe[tt] = gb; }
        }
        __syncthreads();
        f32x16 pacc;
#pragma unroll
        for (int i = 0; i < 16; ++i) pacc[i] = 0.f;
        float myG = 0.f, totG = 0.f;
        if (valid) {
            bf16_t* pr = P + (size_t)(r0 + tt) * NP;
            *(u32x4*)(pr + cBQ + ch) = oq0; *(u32x4*)(pr + cBQ + ch + 8) = oq1; *(u32x4*)(pr + cBK + ch) = ok0; *(u32x4*)(pr + cBK + ch + 8) = ok1;
            *(u32x4*)(pr + cBV + ch) = ov0; *(u32x4*)(pr + cBV + ch + 8) = ov1;
        }
        if (samp) {
            if (valid) {
                const float* kmb = ksc + (tt & ~3) * 128 + g * 16;
                f32x4 qk, kk, qs[4], ks[4];
                { float y[16]; unpack8(oq0, y); unpack8(oq1, y + 8);
#pragma unroll
                  for (int i = 0; i < 4; ++i) qs[i] = (f32x4){y[4 * i], y[4 * i + 1], y[4 * i + 2], y[4 * i + 3]};
                  unpack8(ok0, y); unpack8(ok1, y + 8);
#pragma unroll
                  for (int i = 0; i < 4; ++i) ks[i] = (f32x4){y[4 * i], y[4 * i + 1], y[4 * i + 2], y[4 * i + 3]}; }
#pragma unroll
                for (int j = 0; j < 4; ++j) { qk[j] = red8(dot16(qs, kmb + j * 128)); kk[j] = red8(dot16(ks, kmb + j * 128)); }
                if (g == 0) { float* rec = REC + ((size_t)(r0 + tt) * 4 + h) * 16; *(f32x4*)rec = (f32x4){ga, gb, gg, 0.f}; *(f32x4*)(rec + 4) = qk; *(f32x4*)(rec + 8) = kk; }
            }
        } else if (act) {
            if (wq < 2) {
                const bf16_t* ai = wq == 0 ? kimg : qimg;
#pragma unroll
                for (int kb = 0; kb < 8; ++kb) pacc = MFMA32(frag_n(ai, CH_LDQ, r, hf, kb), frag_n(kimg, CH_LDQ, r, hf, kb), pacc);
            } else if (wq == 2) {
                const float gm = sgl[r]; float cum = 0.f;
#pragma unroll
                for (int t2 = 0; t2 < 32; ++t2) { cum += rdl(gm, t2); if (r == t2) myG = cum; }
                totG = cum;
                if (lane < 32) sG[r] = myG;
                if (lane == 0) sG[32] = cum;
            }
        }
        __syncthreads();
        if (!samp && act) {
            bf16_t* tb = TB + (size_t)item * 3072;
            if (wq == 0) {
                const float Gs_ = sG[r]; float* ag = (float*)tb;
#pragma unroll
                for (int i4 = 0; i4 < 4; ++i4) { const f32x4 G4 = *(const f32x4*)(sG + 8 * i4 + 4 * hf), b4 = *(const f32x4*)(sbe + 8 * i4 + 4 * hf);
#pragma unroll
                    for (int ii = 0; ii < 4; ++ii) { const int t2 = 8 * i4 + 4 * hf + ii; ag[t2 * 32 + r] = (r < t2) ? b4[ii] * pacc[4 * i4 + ii] * __expf(G4[ii] - Gs_) : 0.f; } }
            } else if (wq == 1) {
                const float Gs_ = sG[r];
#pragma unroll
                for (int i4 = 0; i4 < 4; ++i4) { const f32x4 G4 = *(const f32x4*)(sG + 8 * i4 + 4 * hf);
#pragma unroll
                    for (int ii = 0; ii < 4; ++ii) { const int t2 = 8 * i4 + 4 * hf + ii; tb[2048 + t2 * 32 + r] = f2bf((r <= t2) ? pacc[4 * i4 + ii] * __expf(G4[ii] - Gs_) : 0.f); } }
            }
            if (valid && g == 0) { const float Gt = sG[tt], GT = sG[32];
                float* rec = REC + ((size_t)(r0 + tt) * 4 + h) * 16; *(f32x4*)rec = (f32x4){ga, gb, gg, Gt}; *(f32x4*)(rec + 12) = (f32x4){GT - Gt, GT, 0.f, 0.f}; }
        }
        __syncthreads();
    }
    asm volatile("s_waitcnt vmcnt(0)" ::: "memory");
    __syncthreads();
    { const int wv_ = tid >> 6; float* am = lds + wv_ * 1024;
      int nmine = 0;
      for (int base = blockIdx.x * 2; base < NITEM; base += gridDim.x * 2) nmine += 2;
      for (int idx = wv_; idx < nmine; idx += 8) {
        const int item = blockIdx.x * 2 + (idx >> 1) * gridDim.x * 2 + (idx & 1);
        const int rb = item >> 2, h = item & 3;
        if (item >= NITEM || rb >= SROW0 / 32) continue;
        bf16_t* tb = TB + (size_t)item * 3072; const float* ag = (const float*)tb;
#pragma unroll
        for (int q = 0; q < 4; ++q) *(f32x4*)(am + q * 256 + lane * 4) = *(const f32x4*)(ag + q * 256 + lane * 4);
        const float* rec = REC + ((size_t)(rb * 32 + r) * 4 + h) * 16;
        const bool rv = (rb % (LPAD / 32)) * 32 + r < LP;
        const float bs_ = rv ? rec[1] : 0.f, bg_ = rv ? bs_ * __expf(rec[3]) : 0.f;
        asm volatile("s_waitcnt vmcnt(0) lgkmcnt(0)" ::: "memory");
        float Tc[32];
#pragma unroll
        for (int t2 = 0; t2 < 32; ++t2) { float v0 = 0.f, v1 = 0.f, v2 = 0.f, v3 = 0.f;
#pragma unroll
            for (int q4 = 0; q4 < (t2 + 3) / 4; ++q4) { const f32x4 a4 = *(const f32x4*)(am + t2 * 32 + q4 * 4);
                if (q4 * 4 + 0 < t2) v0 += a4[0] * Tc[q4 * 4 + 0]; if (q4 * 4 + 1 < t2) v1 += a4[1] * Tc[q4 * 4 + 1];
                if (q4 * 4 + 2 < t2) v2 += a4[2] * Tc[q4 * 4 + 2]; if (q4 * 4 + 3 < t2) v3 += a4[3] * Tc[q4 * 4 + 3]; }
            Tc[t2] = ((r == t2) ? 1.f : 0.f) - ((v0 + v1) + (v2 + v3)); }
        if (hf == 0) {
#pragma unroll
            for (int t2 = 0; t2 < 32; ++t2) { tb[t2 * 32 + r] = f2bf(Tc[t2] * bs_); tb[1024 + t2 * 32 + r] = f2bf(Tc[t2] * bg_); } }
        asm volatile("s_waitcnt lgkmcnt(0)" ::: "memory");
      } }
    { const int wv_ = tid >> 6;
      for (int it = blockIdx.x * 8 + wv_; it < (SROW0 / 32) * 4; it += gridDim.x * 8) {
        const int rbp = it >> 2, hh = it & 3, jb = rbp % (LPAD / 32), row = rbp * 32 + r;
        float igm = -1e30f, lfm = 0.f;
        if (jb * 32 + r < LP) { const float* gr = G + (size_t)row * 16; igm = gr[hh] + p.gate_bias[l * 8 + hh]; const float f = gr[4 + hh] + p.gate_bias[l * 8 + 4 + hh]; lfm = fminf(f, 0.f) - log1pf(__expf(-fabsf(f))); }
        float bsum = 0.f, pm = -3e38f, myb = 0.f, myu = 0.f, mypm = 0.f;
#pragma unroll
        for (int t2 = 0; t2 < 32; ++t2) { bsum += rdl(lfm, t2); const float u_ = rdl(igm, t2) - bsum; pm = fmaxf(pm, u_); if (r == t2) { myb = bsum; myu = u_; mypm = pm; } }
        if (lane < 32) *(f32x4*)(REC + ((size_t)row * 4 + hh) * 16 + 4) = (f32x4){myu, myb, mypm, 0.f};
      } }
}

__device__ __forceinline__ void issue_gdn(const Params& p, int h, int qtr, int row0, int L, int jb, int ptid, StageRegs& r) {
    const bf16_t* P = (const bf16_t*)(p.ws + OFF_P); const float* REC = (const float*)(p.ws + OFF_REC);
    const int tt = ptid >> 3, g = ptid & 7, t0 = jb * 32;
    if (t0 + tt >= L) return;
    const int row = row0 + t0 + tt;
    const bf16_t* prow = P + (size_t)row * NP;
    r.q0 = asf(*(const u32x4*)(prow + cBQ + h * 128 + g * 16)); r.q1 = asf(*(const u32x4*)(prow + cBQ + h * 128 + g * 16 + 8));
    r.k0 = asf(*(const u32x4*)(prow + cBK + h * 128 + g * 16)); r.k1 = asf(*(const u32x4*)(prow + cBK + h * 128 + g * 16 + 8));
    { const u32x2 vv_ = *(const u32x2*)(prow + cBV + h * 128 + qtr * 32 + g * 4); r.v = asf((u32x4){vv_.x, vv_.y, 0u, 0u}); }
    if (g < 3) r.r0 = *(const f32x4*)(REC + ((size_t)row * 4 + h) * 16 + g * 4);
}
__device__ __forceinline__ void commit_gdn(int L, int jb, float* lds, int ptid, const StageRegs& r, int bsel = -1) {
    const int tt = ptid >> 3, g = ptid & 7, t0 = jb * 32, b = bsel >= 0 ? bsel : (jb & 1);
    if (t0 + tt >= L) return;
    float x[16];
    unpack8(asu(r.q0), x); unpack8(asu(r.q1), x + 8);
    float* qd = QB(lds, b) + tt * 128 + g * 16;
#pragma unroll
    for (int i = 0; i < 4; ++i) *(f32x4*)(qd + 4 * i) = (f32x4){x[4 * i], x[4 * i + 1], x[4 * i + 2], x[4 * i + 3]};
    unpack8(asu(r.k0), x); unpack8(asu(r.k1), x + 8);
    float* kd = KB(lds, b) + tt * 128 + g * 16;
#pragma unroll
    for (int i = 0; i < 4; ++i) *(f32x4*)(kd + 4 * i) = (f32x4){x[4 * i], x[4 * i + 1], x[4 * i + 2], x[4 * i + 3]};
    *(f32x4*)(VB(lds, b) + tt * 32 + g * 4) = (f32x4){bflo(asu(r.v).x), bfhi(asu(r.v).x), bflo(asu(r.v).y), bfhi(asu(r.v).y)};
    if (g < 3) *(f32x4*)(SCB(lds, b) + tt * 16 + g * 4) = r.r0;
}

constexpr int GD_Q = 0, GD_K = 8704, GD_KT = 17408, GD_KDT = 27904, GD_VT = 38400, GD_QKD = 40960, GD_TV = 43520, GD_TK = 46080, GD_W = 48640, GD_SC = 57344, GD_SLOT = 58368, GD_OB = 2 * GD_SLOT;
constexpr int GS_B = 32, GS_EG = 96, GS_ETG = 128, GS_EGT = 160;

__device__ __forceinline__ void issue_gdn_chunk(const Params& p, int h, int qtr, int row0, int L, int nch, int jb, int ptid, StageRegs& r) {
    if (jb >= nch) return;
    const bf16_t* P = (const bf16_t*)(p.ws + OFF_P); const float* REC = (const float*)(p.ws + OFF_REC);
    const bf16_t* tb = (const bf16_t*)(p.ws + OFF_TB) + ((size_t)((row0 >> 5) + jb) * 4 + h) * 3072;
    r.x0 = asf(*(const u32x4*)(tb + ptid * 8));
    if (ptid < 128) r.x1 = asf(*(const u32x4*)(tb + 2048 + ptid * 8));
    const int tt = ptid >> 3, g = ptid & 7, t0 = jb * 32;
    if (t0 + tt >= L) return;
    const int row = row0 + t0 + tt;
    const bf16_t* prow = P + (size_t)row * NP;
    r.q0 = asf(*(const u32x4*)(prow + cBQ + h * 128 + g * 16)); r.q1 = asf(*(const u32x4*)(prow + cBQ + h * 128 + g * 16 + 8));
    r.k0 = asf(*(const u32x4*)(prow + cBK + h * 128 + g * 16)); r.k1 = asf(*(const u32x4*)(prow + cBK + h * 128 + g * 16 + 8));
    { const u32x2 vv_ = *(const u32x2*)(prow + cBV + h * 128 + qtr * 32 + g * 4); r.v = asf((u32x4){vv_.x, vv_.y, 0u, 0u}); }
    if (g == 0 || g == 3) r.r0 = *(const f32x4*)(REC + ((size_t)row * 4 + h) * 16 + g * 4);
}

__device__ __forceinline__ void scan_gdn_chunk(const Params& p, int l, int bs, int h, int qtr, int row0, int L, unsigned char* lb) {
    const int tid = opaque_tid(p.wv); const int wave = tid >> 6, lane = tid & 63, r = lane & 31, hf = lane >> 5, ptid = tid - 256;
    bf16_t* P = (bf16_t*)(p.ws + OFF_P);
    const int nch = (L + 31) >> 5;
    f32x16 S[4];
#pragma unroll
    for (int dt = 0; dt < 4; ++dt)
#pragma unroll
        for (int i = 0; i < 16; ++i) S[dt][i] = 0.f;
    f32x4 s0, s1, s2, s3, s4, s5, s6, s7; StageRegs sr{s0, s1, s2, s3, s4, s5, s6, s7};
#define GD_P1(JN) do { const int jn_ = (JN); unsigned char* sl_ = lb + (jn_ & 1) * GD_SLOT; const int tt = ptid >> 3, g = ptid & 7; const bool val_ = jn_ * 32 + tt < L; \
        u32x4 q0_ = asu(sr.q0), q1_ = asu(sr.q1), k0_ = asu(sr.k0), k1_ = asu(sr.k1); u32x4 v_ = asu(sr.v); \
        if (!val_) { q0_ = q1_ = k0_ = k1_ = v_ = (u32x4){0u, 0u, 0u, 0u}; } \
        *(u32x4*)(sl_ + GD_Q + (tt * CH_LDQ + g * 16) * 2) = q0_; *(u32x4*)(sl_ + GD_Q + (tt * CH_LDQ + g * 16 + 8) * 2) = q1_; \
        *(u32x4*)(sl_ + GD_K + (tt * CH_LDQ + g * 16) * 2) = k0_; *(u32x4*)(sl_ + GD_K + (tt * CH_LDQ + g * 16 + 8) * 2) = k1_; \
        bf16_t* kt_ = (bf16_t*)(sl_ + GD_KT) + kto(g * 16) + tt; \
        _Pragma("unroll") for (int i = 0; i < 4; ++i) { kt_[(2 * i) * CH_LDS] = (bf16_t)(k0_[i] & 0xffffu); kt_[(2 * i + 1) * CH_LDS] = (bf16_t)(k0_[i] >> 16); \
            kt_[(8 + 2 * i) * CH_LDS] = (bf16_t)(k1_[i] & 0xffffu); kt_[(8 + 2 * i + 1) * CH_LDS] = (bf16_t)(k1_[i] >> 16); } \
        bf16_t* vt_ = (bf16_t*)(sl_ + GD_VT); \
        vt_[(g * 4 + 0) * CH_LDS + tt] = (bf16_t)(v_.x & 0xffffu); vt_[(g * 4 + 1) * CH_LDS + tt] = (bf16_t)(v_.x >> 16); \
        vt_[(g * 4 + 2) * CH_LDS + tt] = (bf16_t)(v_.y & 0xffffu); vt_[(g * 4 + 3) * CH_LDS + tt] = (bf16_t)(v_.y >> 16); \
        { const int row_ = ptid >> 2, c4_ = ptid & 3; *(u32x4*)(sl_ + (row_ < 32 ? GD_TV : GD_TK) + ((row_ & 31) * CH_LDS + c4_ * 8) * 2) = asu(sr.x0); \
          if (ptid < 128) *(u32x4*)(sl_ + GD_QKD + (row_ * CH_LDS + c4_ * 8) * 2) = asu(sr.x1); } \
        float* sc_ = (float*)(sl_ + GD_SC); \
        if (g == 0) { sc_[GS_B + tt] = val_ ? sr.r0[1] : 0.f; sc_[GS_EG + tt] = val_ ? __expf(sr.r0[3]) : 0.f; } \
        if (g == 3) { sc_[GS_ETG + tt] = val_ ? __expf(sr.r0[0]) : 0.f; if (tt == 0) sc_[GS_EGT] = __expf(sr.r0[1]); } \
        issue_gdn_chunk(p, h, qtr, row0, L, nch, jn_ + 1, ptid, sr); } while (0)
#define GD_P2(JN) do { if (wave >= 4) { unsigned char* sl_ = lb + ((JN) & 1) * GD_SLOT; const float* sc_ = (const float*)(sl_ + GD_SC); \
        { const int tt = ptid >> 3, g = ptid & 7; const float eg_ = sc_[GS_EG + tt], et_ = sc_[GS_ETG + tt]; float x_[16]; \
            u32x4* qp_ = (u32x4*)(sl_ + GD_Q + (tt * CH_LDQ + g * 16) * 2); unpack8(qp_[0], x_); unpack8(qp_[1], x_ + 8); \
            _Pragma("unroll") for (int i = 0; i < 16; ++i) x_[i] *= eg_; \
            qp_[0] = pack8(x_); qp_[1] = pack8(x_ + 8); \
            const u32x4* kp_ = (const u32x4*)(sl_ + GD_K + (tt * CH_LDQ + g * 16) * 2); unpack8(kp_[0], x_); unpack8(kp_[1], x_ + 8); \
            bf16_t* kd_ = (bf16_t*)(sl_ + GD_KDT); \
            _Pragma("unroll") for (int i = 0; i < 16; ++i) kd_[kto(g * 16) + i * CH_LDS + tt] = f2bf(x_[i] * et_); } \
        { const int dt_ = wave - 4; f32x16 a_; \
            _Pragma("unroll") for (int i = 0; i < 16; ++i) a_[i] = 0.f; \
            _Pragma("unroll") for (int kb = 0; kb < 2; ++kb) a_ = MFMA32(frag_n((const bf16_t*)(sl_ + GD_KT) + kto(dt_ * 32 + r), 0, 0, hf, kb), frag_n((const bf16_t*)(sl_ + GD_TK), CH_LDS, r, hf, kb), a_); \
            _Pragma("unroll") for (int i4 = 0; i4 < 4; ++i4) { unsigned lo_, hi_;     \
                asm volatile("s_nop 7\n\ts_nop 7\n\tv_cvt_pk_bf16_f32 %0, %2, %3\n\tv_cvt_pk_bf16_f32 %1, %4, %5" : "=&v"(lo_), "=&v"(hi_) : "v"(a_[4 * i4]), "v"(a_[4 * i4 + 1]), "v"(a_[4 * i4 + 2]), "v"(a_[4 * i4 + 3])); \
                *(u32x2*)(sl_ + GD_W + (r * CH_LDQ + 32 * dt_ + 8 * i4 + 4 * hf) * 2) = (u32x2){lo_, hi_}; } } } } while (0)
    if (wave >= 4) { issue_gdn_chunk(p, h, qtr, row0, L, nch, 0, ptid, sr); GD_P1(0); }
    BARRIER_LDS();
    GD_P2(0);
    BARRIER_LDS();
#pragma unroll 1
    for (int j = 0; j < nch; ++j) {
        if (wave == 0) {
            const unsigned char* sl = lb + (j & 1) * GD_SLOT; const float* sc = (const float*)(sl + GD_SC);
            const bf16_t* wq = (const bf16_t*)(sl + GD_W); const bf16_t* qg = (const bf16_t*)(sl + GD_Q); const bf16_t* tv = (const bf16_t*)(sl + GD_TV); const bf16_t* vt = (const bf16_t*)(sl + GD_VT);
            const bf16_t* qkd = (const bf16_t*)(sl + GD_QKD); const bf16_t* kdt = (const bf16_t*)(sl + GD_KDT);
            f32x16 U, O;
#pragma unroll
            for (int i = 0; i < 16; ++i) { U[i] = 0.f; O[i] = 0.f; }
#pragma unroll
            for (int dt = 0; dt < 4; ++dt)
#pragma unroll
                for (int u = 0; u < 2; ++u) { const bf16x8 sb = pack_step(S[dt], u);
                    U = MFMA32(frag_p(wq, CH_LDQ, r, hf, 32 * dt + 16 * u), sb, U); O = MFMA32(frag_p(qg, CH_LDQ, r, hf, 32 * dt + 16 * u), sb, O); }
            f32x16 Uv;
#pragma unroll
            for (int i = 0; i < 16; ++i) Uv[i] = 0.f;
#pragma unroll
            for (int kb = 0; kb < 2; ++kb) Uv = MFMA32(frag_n(tv, CH_LDS, r, hf, kb), frag_n(vt, CH_LDS, r, hf, kb), Uv);
#pragma unroll
            for (int i = 0; i < 16; ++i) U[i] = Uv[i] - U[i];
            bf16x8 ub[2]; ub[0] = pack_step(U, 0); ub[1] = pack_step(U, 1);
#pragma unroll
            for (int u = 0; u < 2; ++u) O = MFMA32(frag_p(qkd, CH_LDS, r, hf, 16 * u), ub[u], O);
            const float egt = sc[GS_EGT];
#pragma unroll
            for (int dt = 0; dt < 4; ++dt) {
#pragma unroll
                for (int i = 0; i < 16; ++i) S[dt][i] *= egt;
#pragma unroll
                for (int u = 0; u < 2; ++u) S[dt] = MFMA32(frag_p(kdt + kto(dt * 32 + r), 0, 0, hf, 16 * u), ub[u], S[dt]);
            }
            float* ob = (float*)(lb + GD_OB) + (j & 1) * 1024;
#pragma unroll
            for (int i = 0; i < 16; ++i) ob[crow(i, hf) * 32 + r] = O[i];
        } else if (wave >= 4) {
            if (j + 1 < nch) GD_P1(j + 1);
            if (j > 0) store_out_blk(P, row0, j - 1, L, cBV + h * 128 + qtr * 32, (const float*)(lb + GD_OB) + ((j - 1) & 1) * 1024, ptid);
        }
        BARRIER_LDS();
        if (j + 1 < nch) GD_P2(j + 1);
        BARRIER_LDS();
    }
    if (wave >= 4) store_out_blk(P, row0, nch - 1, L, cBV + h * 128 + qtr * 32, (const float*)(lb + GD_OB) + ((nch - 1) & 1) * 1024, ptid);
    if (wave == 0) {
        float* So = p.out + o_pS + ((size_t)(l * NB + bs) * 4 + h) * 16384;
#pragma unroll
        for (int dt = 0; dt < 4; ++dt)
#pragma unroll
            for (int i = 0; i < 16; ++i) So[(32 * dt + crow(i, hf)) * 128 + qtr * 32 + r] = S[dt][i];
    }
    __syncthreads();
#undef GD_P1
#undef GD_P2
}

__device__ __forceinline__ void scan_gdn(const Params& p, int l, bool samp, int bs, int h, int qtr, int row0, int L, float* lds) {
    const int tid = opaque_tid(p.wv); const bool cons = tid < 256; const int ptid = tid - 256;
    const int lane = tid & 63, w = (tid >> 6) & 3, s = lane & 7, cl = w * 8 + (lane >> 3), col = qtr * 32 + cl;
    bf16_t* P = (bf16_t*)(p.ws + OFF_P);
    f32x2 S[8];
#pragma unroll
    for (int e = 0; e < 8; ++e) S[e] = bc2(0.f);
    if (cons && samp) {
        const float* S0 = p.st_S + ((size_t)(l * NS + bs) * 4 + h) * 16384;
#pragma unroll
        for (int e = 0; e < 16; ++e) { const int d = (e >> 2) * 32 + s * 4 + (e & 3); S[e >> 1][e & 1] = S0[d * 128 + col]; }
    }
    const int nblk = (L + 31) >> 5;
    f32x4 k4[4][4];
    StageRegs sr{k4[0][0], k4[0][1], k4[0][2], k4[0][3], k4[1][0], k4[1][1], k4[1][2], k4[1][3]};
    if (!cons) { issue_gdn(p, h, qtr, row0, L, 0, ptid, sr); commit_gdn(L, 0, lds, ptid, sr); if (1 < nblk) issue_gdn(p, h, qtr, row0, L, 1, ptid, sr); }
    BARRIER_LDS();
    for (int jb = 0; jb < nblk; ++jb) {
        if (!cons) {
            if (jb + 1 < nblk) commit_gdn(L, jb + 1, lds, ptid, sr);
            if (jb + 2 < nblk) issue_gdn(p, h, qtr, row0, L, jb + 2, ptid, sr);
            if (jb > 0) store_out_blk(P, row0, jb - 1, L, cBV + h * 128 + qtr * 32, OB(lds, (jb - 1) & 1), ptid);
        } else {
            const float* qb = QB(lds, jb & 1); const float* kb = KB(lds, jb & 1); const float* vb = VB(lds, jb & 1); const float* sc = SCB(lds, jb & 1);
            float* ob = OB(lds, jb & 1);
            const int nt = min(32, L - jb * 32);
            f32x4 q4[4][4]; float vv[4], a[4], be[4]; f32x4 qk[4], kk[4];
#define GLOAD_Q(T0) do { _Pragma("unroll") for (int i = 0; i < 4; ++i) { const int t = (T0) + i; \
        _Pragma("unroll") for (int j = 0; j < 4; ++j) q4[i][j] = *(const f32x4*)(qb + t * 128 + j * 32 + s * 4); } } while (0)
#define GLOAD_K(T0) do { _Pragma("unroll") for (int i = 0; i < 4; ++i) { const int t = (T0) + i; \
        _Pragma("unroll") for (int j = 0; j < 4; ++j) k4[i][j] = *(const f32x4*)(kb + t * 128 + j * 32 + s * 4); } \
      _Pragma("unroll") for (int i = 0; i < 4; ++i) { const int t = (T0) + i; \
        const f32x2 gg = *(const f32x2*)(sc + t * 16); a[i] = gg[0]; be[i] = gg[1]; \
        qk[i] = *(const f32x4*)(sc + t * 16 + 4); kk[i] = *(const f32x4*)(sc + t * 16 + 8); vv[i] = vb[t * 32 + cl]; } } while (0)
            GLOAD_Q(0); GLOAD_K(0);
#pragma unroll 1
            for (int t0 = 0; t0 < nt; t0 += 4) {
                float dk[4], dq[4];
                const int tn = min(t0 + 4, 28);
                __builtin_amdgcn_sched_barrier(0);
#pragma unroll
                for (int i = 0; i < 4; ++i) {
                    f32x2 x = bc2(0.f), x2 = bc2(0.f), y = bc2(0.f), y2 = bc2(0.f);
#pragma unroll
                    for (int j = 0; j < 4; ++j) {
                        x = lo2(k4[i][j]) * S[2 * j] + x; x2 = hi2(k4[i][j]) * S[2 * j + 1] + x2;
                        y = lo2(q4[i][j]) * S[2 * j] + y; y2 = hi2(q4[i][j]) * S[2 * j + 1] + y2; }
                    x = x + x2; y = y + y2;
                    dk[i] = x[0] + x[1]; dq[i] = y[0] + y[1];
                }
                __builtin_amdgcn_sched_barrier(0);
                GLOAD_Q(tn);
                __builtin_amdgcn_sched_barrier(0);
#pragma unroll
                for (int i = 0; i < 4; ++i) { dk[i] = red8(dk[i]); dq[i] = red8(dq[i]); }
                const float A0 = a[0], A1 = A0 * a[1], A2 = A1 * a[2], A3 = A2 * a[3];
                const float r10 = a[1], r21 = a[2], r32 = a[3], r20 = r10 * a[2], r31 = r21 * a[3], r30 = r20 * a[3];
                const float u0 = be[0] * (vv[0] - A0 * dk[0]);
                const float u1 = be[1] * (vv[1] - A1 * dk[1] - r10 * kk[1][0] * u0);
                const float u2 = be[2] * (vv[2] - A2 * dk[2] - r20 * kk[2][0] * u0 - r21 * kk[2][1] * u1);
                const float u3 = be[3] * (vv[3] - A3 * dk[3] - r30 * kk[3][0] * u0 - r31 * kk[3][1] * u1 - r32 * kk[3][2] * u2);
                if (s == 0) {
                    ob[(t0 + 0) * 32 + cl] = A0 * dq[0] + qk[0][0] * u0;
                    ob[(t0 + 1) * 32 + cl] = A1 * dq[1] + r10 * qk[1][0] * u0 + qk[1][1] * u1;
                    ob[(t0 + 2) * 32 + cl] = A2 * dq[2] + r20 * qk[2][0] * u0 + r21 * qk[2][1] * u1 + qk[2][2] * u2;
                    ob[(t0 + 3) * 32 + cl] = A3 * dq[3] + r30 * qk[3][0] * u0 + r31 * qk[3][1] * u1 + r32 * qk[3][2] * u2 + qk[3][3] * u3;
                }
                const float c0 = r30 * u0, c1 = r31 * u1, c2 = r32 * u2, c3 = u3;
#pragma unroll
                for (int j = 0; j < 4; ++j) {
                    S[2 * j] = lo2(k4[3][j]) * bc2(c3) + (lo2(k4[2][j]) * bc2(c2) + (lo2(k4[1][j]) * bc2(c1) + (lo2(k4[0][j]) * bc2(c0) + S[2 * j] * bc2(A3))));
                    S[2 * j + 1] = hi2(k4[3][j]) * bc2(c3) + (hi2(k4[2][j]) * bc2(c2) + (hi2(k4[1][j]) * bc2(c1) + (hi2(k4[0][j]) * bc2(c0) + S[2 * j + 1] * bc2(A3)))); }
                __builtin_amdgcn_sched_barrier(0);
                GLOAD_K(tn);
            }
#undef GLOAD_Q
#undef GLOAD_K
        }
        BARRIER_LDS();
    }
    if (!cons) store_out_blk(P, row0, nblk - 1, L, cBV + h * 128 + qtr * 32, OB(lds, (nblk - 1) & 1), ptid);
    else {
        const size_t sh = samp ? (size_t)(l * NS + bs) * 4 + h : (size_t)(l * NB + bs) * 4 + h;
        float* So = p.out + (samp ? o_sS : o_pS) + sh * 16384;
#pragma unroll
        for (int e = 0; e < 16; ++e) { const int d = (e >> 2) * 32 + s * 4 + (e & 3); So[d * 128 + col] = S[e >> 1][e & 1]; }
    }
    BARRIER_LDS();
}

__device__ __forceinline__ void scan_gdn_stream(const Params& p, int l, int h, int qtr, int bs0, int nseq, float* lds) {
    const int tid = opaque_tid(p.wv); const bool cons = tid < 256; const int ptid = tid - 256;
    const int lane = tid & 63, w = (tid >> 6) & 3, s = lane & 7, cl = w * 8 + (lane >> 3), col = qtr * 32 + cl;
    bf16_t* P = (bf16_t*)(p.ws + OFF_P);
    f32x2 S[8];
#pragma unroll
    for (int e = 0; e < 8; ++e) S[e] = bc2(0.f);
    f32x4 k4[4][4];
    StageRegs sr{k4[0][0], k4[0][1], k4[0][2], k4[0][3], k4[1][0], k4[1][1], k4[1][2], k4[1][3]};
#define LOADSTATE(BS) do { } while (0)
#define STISSUE(BS) st_issue(p.st_S + ((size_t)(l * NS + (BS)) * 4 + h) * 16384, qtr, ptid, k4[2][0], k4[2][1], k4[2][2], k4[2][3])
    if (!cons) { issue_gdn(p, h, qtr, SROW0 + bs0 * 4, LS, 0, ptid, sr); STISSUE(bs0); }
#pragma unroll 1
    for (int k = 0; k < nseq; ++k) {
        const int bs = bs0 + 8 * k, row0 = SROW0 + bs * 4;
        if (!cons) { commit_gdn(LS, 0, lds, ptid, sr, k & 1); st_commit(STB(lds, k & 1), ptid, k4[2][0], k4[2][1], k4[2][2], k4[2][3]);
            if (k + 1 < nseq) { issue_gdn(p, h, qtr, row0 + 32, LS, 0, ptid, sr); STISSUE(bs + 8); } }
        BARRIER_LDS();
        if (!cons) { if (k > 0) { store_out_blk(P, row0 - 32, 0, LS, cBV + h * 128 + qtr * 32, OB(lds, (k - 1) & 1), ptid); st_store(p.out + o_sS + ((size_t)(l * NS + bs - 8) * 4 + h) * 16384, qtr, STB(lds, (k - 1) & 1), ptid); } }
        else {
            const float* qb = QB(lds, k & 1); const float* kb = KB(lds, k & 1); const float* vb = VB(lds, k & 1); const float* sc = SCB(lds, k & 1);
            float* ob = OB(lds, k & 1); float* stb = STB(lds, k & 1);
#pragma unroll
            for (int e = 0; e < 16; ++e) { const int d = (e >> 2) * 32 + s * 4 + (e & 3); S[e >> 1][e & 1] = stb[d * ST_LD + cl]; }
            f32x4 q4[4][4]; float vv[4], a[4], be[4]; f32x4 qk[4], kk[4];
#define GLOAD_Q(T0) do { _Pragma("unroll") for (int i = 0; i < 4; ++i) { const int t = (T0) + i; \
        _Pragma("unroll") for (int j = 0; j < 4; ++j) q4[i][j] = *(const f32x4*)(qb + t * 128 + j * 32 + s * 4); } } while (0)
#define GLOAD_K(T0) do { _Pragma("unroll") for (int i = 0; i < 4; ++i) { const int t = (T0) + i; \
        _Pragma("unroll") for (int j = 0; j < 4; ++j) k4[i][j] = *(const f32x4*)(kb + t * 128 + j * 32 + s * 4); } \
      _Pragma("unroll") for (int i = 0; i < 4; ++i) { const int t = (T0) + i; \
        const f32x2 gg = *(const f32x2*)(sc + t * 16); a[i] = gg[0]; be[i] = gg[1]; \
        qk[i] = *(const f32x4*)(sc + t * 16 + 4); kk[i] = *(const f32x4*)(sc + t * 16 + 8); vv[i] = vb[t * 32 + cl]; } } while (0)
            GLOAD_Q(0); GLOAD_K(0);
            {
                float dk[4], dq[4];
                __builtin_amdgcn_sched_barrier(0);
#pragma unroll
                for (int i = 0; i < 4; ++i) {
                    f32x2 x = bc2(0.f), x2 = bc2(0.f), y = bc2(0.f), y2 = bc2(0.f);
#pragma unroll
                    for (int j = 0; j < 4; ++j) {
                        x = lo2(k4[i][j]) * S[2 * j] + x; x2 = hi2(k4[i][j]) * S[2 * j + 1] + x2;
                        y = lo2(q4[i][j]) * S[2 * j] + y; y2 = hi2(q4[i][j]) * S[2 * j + 1] + y2; }
                    x = x + x2; y = y + y2;
                    dk[i] = x[0] + x[1]; dq[i] = y[0] + y[1];
                }
                __builtin_amdgcn_sched_barrier(0);
#pragma unroll
                for (int i = 0; i < 4; ++i) { dk[i] = red8(dk[i]); dq[i] = red8(dq[i]); }
                const float A0 = a[0], A1 = A0 * a[1], A2 = A1 * a[2], A3 = A2 * a[3];
                const float r10 = a[1], r21 = a[2], r32 = a[3], r20 = r10 * a[2], r31 = r21 * a[3], r30 = r20 * a[3];
                const float u0 = be[0] * (vv[0] - A0 * dk[0]);
                const float u1 = be[1] * (vv[1] - A1 * dk[1] - r10 * kk[1][0] * u0);
                const float u2 = be[2] * (vv[2] - A2 * dk[2] - r20 * kk[2][0] * u0 - r21 * kk[2][1] * u1);
                const float u3 = be[3] * (vv[3] - A3 * dk[3] - r30 * kk[3][0] * u0 - r31 * kk[3][1] * u1 - r32 * kk[3][2] * u2);
                if (s == 0) {
                    ob[0 * 32 + cl] = A0 * dq[0] + qk[0][0] * u0;
                    ob[1 * 32 + cl] = A1 * dq[1] + r10 * qk[1][0] * u0 + qk[1][1] * u1;
                    ob[2 * 32 + cl] = A2 * dq[2] + r20 * qk[2][0] * u0 + r21 * qk[2][1] * u1 + qk[2][2] * u2;
                    ob[3 * 32 + cl] = A3 * dq[3] + r30 * qk[3][0] * u0 + r31 * qk[3][1] * u1 + r32 * qk[3][2] * u2 + qk[3][3] * u3;
                }
                const float c0 = r30 * u0, c1 = r31 * u1, c2 = r32 * u2, c3 = u3;
#pragma unroll
                for (int j = 0; j < 4; ++j) {
                    S[2 * j] = lo2(k4[3][j]) * bc2(c3) + (lo2(k4[2][j]) * bc2(c2) + (lo2(k4[1][j]) * bc2(c1) + (lo2(k4[0][j]) * bc2(c0) + S[2 * j] * bc2(A3))));
                    S[2 * j + 1] = hi2(k4[3][j]) * bc2(c3) + (hi2(k4[2][j]) * bc2(c2) + (hi2(k4[1][j]) * bc2(c1) + (hi2(k4[0][j]) * bc2(c0) + S[2 * j + 1] * bc2(A3)))); }
            }
#undef GLOAD_Q
#undef GLOAD_K
#pragma unroll
            for (int e = 0; e < 16; ++e) { const int d = (e >> 2) * 32 + s * 4 + (e & 3); stb[d * ST_LD + cl] = S[e >> 1][e & 1]; }
        }
    }
    BARRIER_LDS();
    if (!cons) { store_out_blk(P, SROW0 + (bs0 + 8 * (nseq - 1)) * 4, 0, LS, cBV + h * 128 + qtr * 32, OB(lds, (nseq - 1) & 1), ptid); st_store(p.out + o_sS + ((size_t)(l * NS + bs0 + 8 * (nseq - 1)) * 4 + h) * 16384, qtr, STB(lds, (nseq - 1) & 1), ptid); }
    BARRIER_LDS();
#undef LOADSTATE
#undef STISSUE
}


__device__ __forceinline__ void phase_scan(const Params& p, int l, float* lds) {
    for (int item = blockIdx.x; item < 256; item += gridDim.x) {
        const int qtr = item & 3, h = (item >> 2) & 3, bs = (item >> 4) & 7, branch = item >> 7;
        if (branch == 0) scan_mlstm_chunk(p, l, bs, h, qtr, bs * LPAD, LP, (unsigned char*)lds); else scan_gdn_chunk(p, l, bs, h, qtr, bs * LPAD, LP, (unsigned char*)lds);
    }
    for (int c = blockIdx.x; c < 256; c += gridDim.x) {
        const int qtr = c & 3, h = (c >> 2) & 3, branch = (c >> 4) & 1, bs0 = c >> 5;
        if (branch == 0) scan_mlstm_stream(p, l, h, qtr, bs0, NS / 8, lds); else scan_gdn_stream(p, l, h, qtr, bs0, NS / 8, lds);
    }
}

__device__ __forceinline__ void phase_norm(const Params& p, int l) {
    const int tid = opaque_tid(p.wv); const int wave = tid >> 6, lane = tid & 63;
    bf16_t* P = (bf16_t*)(p.ws + OFF_P);
    const int part = lane >> 5, hh = (lane >> 3) & 3, g = lane & 7, ch0 = hh * 128 + g * 16;
    const int craw = (part ? cBV : cV) + ch0, cgate = (part ? cZ : cO) + ch0;
    const float* wnp = part ? p.b_norm_w + l * 128 + g * 16 : p.a_norm_w + l * 512 + ch0;
    float wn[16];
#pragma unroll
    for (int i = 0; i < 4; ++i) { const f32x4 w4 = *(const f32x4*)(wnp + 4 * i); wn[4 * i] = w4[0]; wn[4 * i + 1] = w4[1]; wn[4 * i + 2] = w4[2]; wn[4 * i + 3] = w4[3]; }
    const int stride = gridDim.x * 8;
    int row = blockIdx.x * 8 + wave;
    while (row < SROW0 && (row % LPAD) >= LP) row += stride;
    u32x4 cx0 = (u32x4){0u, 0u, 0u, 0u}, cx1 = cx0, cz0 = cx0, cz1 = cx0;
    if (row < MROWS) { const bf16_t* pr = P + (size_t)row * NP; cx0 = *(const u32x4*)(pr + craw); cx1 = *(const u32x4*)(pr + craw + 8); cz0 = *(const u32x4*)(pr + cgate); cz1 = *(const u32x4*)(pr + cgate + 8); }
    while (row < MROWS) {
        int nrow = row + stride;
        while (nrow < SROW0 && (nrow % LPAD) >= LP) nrow += stride;
        u32x4 nx0 = cx0, nx1 = cx1, nz0 = cz0, nz1 = cz1;
        if (nrow < MROWS) { const bf16_t* pn = P + (size_t)nrow * NP; nx0 = *(const u32x4*)(pn + craw); nx1 = *(const u32x4*)(pn + craw + 8); nz0 = *(const u32x4*)(pn + cgate); nz1 = *(const u32x4*)(pn + cgate + 8); }
        bf16_t* pr = P + (size_t)row * NP;
        float x[16], z[16];
        unpack8(cx0, x); unpack8(cx1, x + 8); unpack8(cz0, z); unpack8(cz1, z + 8);
        float sum = 0.f;
#pragma unroll
        for (int i = 0; i < 16; ++i) sum += x[i];
        float mean = red8(sum) * (1.f / 128.f);
        if (part) mean = 0.f;
        float s2 = 0.f;
#pragma unroll
        for (int i = 0; i < 16; ++i) { x[i] -= mean; s2 += x[i] * x[i]; }
        const float rstd = rsqrtf(red8(s2) * (1.f / 128.f) + 1e-6f);
        float y[16];
#pragma unroll
        for (int i = 0; i < 16; ++i) { const float sg = sigmoidf_(z[i]); y[i] = x[i] * rstd * wn[i] * (part ? z[i] * sg : sg); }
        *(u32x4*)(pr + cgate) = pack8(y); *(u32x4*)(pr + cgate + 8) = pack8(y + 8);
        cx0 = nx0; cx1 = nx1; cz0 = nz0; cz1 = nz1; row = nrow;
    }
}

__device__ __forceinline__ void phase_convact(const Params& p, int l) {
    bf16_t* U = (bf16_t*)(p.ws + OFF_P); const bf16_t* HB = (const bf16_t*)(p.ws + OFF_HB);
    const float* cw = p.fconv_w + (size_t)l * 3 * NU;
    constexpr int NCG = DFF / 8, NRG = MROWS / 32;
    const int tid = opaque_tid(p.wv);
    for (int it = blockIdx.x * NTHREADS + tid; it < NRG * NCG; it += gridDim.x * NTHREADS) {
        const int rg = it / NCG, cg_ = it - rg * NCG, c0 = cg_ * 8;
        float wa[3][8], wb[3][8];
#pragma unroll
        for (int j = 0; j < 3; ++j) {
            const f32x4 a0 = *(const f32x4*)(cw + j * NU + c0), a1 = *(const f32x4*)(cw + j * NU + c0 + 4);
            const f32x4 b0 = *(const f32x4*)(cw + j * NU + DFF + c0), b1 = *(const f32x4*)(cw + j * NU + DFF + c0 + 4);
#pragma unroll
            for (int i = 0; i < 4; ++i) { wa[j][i] = a0[i]; wa[j][4 + i] = a1[i]; wb[j][i] = b0[i]; wb[j][4 + i] = b1[i]; }
        }
        float a2[8], a1[8], b2[8], b1[8];
        const bool samp = rg >= SROW0 / 32;
#pragma unroll
        for (int i = 0; i < 8; ++i) { a2[i] = a1[i] = b2[i] = b1[i] = 0.f; }
        if (!samp && (rg % (LPAD / 32)) != 0) {
            const bf16_t* h0 = HB + (size_t)(rg - 1) * 2 * NU;
            unpack8(*(const u32x4*)(h0 + c0), a2); unpack8(*(const u32x4*)(h0 + NU + c0), a1);
            unpack8(*(const u32x4*)(h0 + DFF + c0), b2); unpack8(*(const u32x4*)(h0 + NU + DFF + c0), b1);
        }
#pragma unroll 4
        for (int i = 0; i < 32; ++i) {
            const int row = rg * 32 + i;
            if (samp && (i & 3) == 0) {
                const float* st = p.st_fconv + ((size_t)(l * NS + ((row - SROW0) >> 2)) * 2) * NU;
                const f32x4 x0 = *(const f32x4*)(st + c0), x1 = *(const f32x4*)(st + c0 + 4), y0 = *(const f32x4*)(st + NU + c0), y1 = *(const f32x4*)(st + NU + c0 + 4);
                const f32x4 u0 = *(const f32x4*)(st + DFF + c0), u1 = *(const f32x4*)(st + DFF + c0 + 4), v0 = *(const f32x4*)(st + NU + DFF + c0), v1 = *(const f32x4*)(st + NU + DFF + c0 + 4);
#pragma unroll
                for (int e = 0; e < 4; ++e) { a2[e] = x0[e]; a2[4 + e] = x1[e]; a1[e] = y0[e]; a1[4 + e] = y1[e]; b2[e] = u0[e]; b2[4 + e] = u1[e]; b1[e] = v0[e]; b1[4 + e] = v1[e]; }
            }
            bf16_t* ur = U + (size_t)row * NU;
            float a[8], b[8], hh[8];
            unpack8(*(const u32x4*)(ur + c0), a); unpack8(*(const u32x4*)(ur + DFF + c0), b);
#pragma unroll
            for (int e = 0; e < 8; ++e) {
                const float ca = wa[0][e] * a2[e] + wa[1][e] * a1[e] + wa[2][e] * a[e];
                const float cb = wb[0][e] * b2[e] + wb[1][e] * b1[e] + wb[2][e] * b[e];
                hh[e] = ca * sigmoidf_(ca) * cb;
                a2[e] = a1[e]; a1[e] = a[e]; b2[e] = b1[e]; b1[e] = b[e];
            }
            u32x4 o; o.x = pk2(hh[0], hh[1]); o.y = pk2(hh[2], hh[3]); o.z = pk2(hh[4], hh[5]); o.w = pk2(hh[6], hh[7]);
            *(u32x4*)(ur + c0) = o;
        }
    }
}

#ifndef PROBE
#define PROBE 0
#endif
constexpr int NPHASE = 2 + DEPTH * 11;
__global__ void __launch_bounds__(NTHREADS) fwd_kernel(Params pin) {
    extern __shared__ __attribute__((aligned(16))) unsigned char smem_raw[];
    Params p = pin; p.wv = __builtin_amdgcn_readfirstlane((int)(threadIdx.x >> 6));
    unsigned* bar = (unsigned*)(p.ws + OFF_BAR); const unsigned xcc = xb_xcc_id();
    volatile LAS unsigned* xst = (volatile LAS unsigned*)(LAS unsigned char*)(smem_raw + LDS_GEMM);
    if (threadIdx.x == 0) { xst[0] = 0u; xst[1] = 0u; (void)xb_add(&bar[XB_XCNT(xcc)], 1u); }
    __syncthreads();
    float* lds = (float*)smem_raw;
    bf16_t* X = (bf16_t*)(p.ws + OFF_X); bf16_t* P = (bf16_t*)(p.ws + OFF_P); bf16_t* HB = (bf16_t*)(p.ws + OFF_HB);
    for (int ph = p.ph_lo; ph < p.ph_hi; ++ph) {
#if PROBE == 3
      for (int rep = 0; rep < 2; ++rep) { const int sx = ph < 2 ? -1 : (ph - 2) % 11; if (rep == 1 && !(ph < 2 || sx == 6 || sx == 10)) break;
#endif
        if (ph == 0) phase_weights(p, lds);
        else if (ph == 1) phase_ln(p, 0, nullptr, 0, p.ln_emb_g, p.ln_emb_b, 0, false);
        else {
            const int l = (ph - 2) / 11, s = (ph - 2) % 11;
            if (s == 0) { GemmArgs g{X, X, 1 << 30, D, w_inT(p, l), MROWS, NP, 1024}; gemm_phase(g, EpiP{P, (bf16_t*)(p.ws + OFF_GH), p.out, l}, p.wv); }
            else if (s == 1) phase_prep(p, l, lds);
            else if (s == 2) phase_scan(p, l, lds);
            else if (s == 3) phase_norm(p, l);
            else if (s == 4) { GemmArgs g{P + cO, P + cZ, 4, NP, w_abT(p, l), MROWS, 2048, 512}; gemm_phase(g, EpiMerge{P}, p.wv); }
            else if (s == 5) { GemmArgs g{P + cMG, P + cMG, 1 << 30, NP, w_outT(p, l), MROWS, 1024, 2048, 1}; gemm_phase(g, EpiRes{X, P, NP, 0, (bf16_t*)(p.ws + OFF_GH)}, p.wv); }
            else if (s == 6) phase_ln(p, 1, P, NP, p.ln1_g + l * D, p.ln1_b + l * D, -1, false);
            else if (s == 7) { GemmArgs g{X, X, 1 << 30, D, w_upT(p, l), MROWS, NU, 1024}; gemm_phase(g, EpiUp{P, HB, p.out, l}, p.wv); }
            else if (s == 8) phase_convact(p, l);
            else if (s == 9) { GemmArgs g{P, P, 1 << 30, NU, w_dnT(p, l), MROWS, 1024, DFF, 1}; gemm_phase(g, EpiRes{X, P, NU, DFF, (bf16_t*)(p.ws + OFF_GH)}, p.wv); }
            else phase_ln(p, 1, P + DFF, NU, p.ln2_g + l * D, p.ln2_b + l * D, l + 1 < DEPTH ? l + 1 : -1, l + 1 == DEPTH);
        }
#if PROBE == 3
      }
#endif
        if (ph + 1 < p.ph_hi) { if (p.ph_lo < 0) cg::this_grid().sync(); else xcd_barrier(bar, xcc, xst, p.wv); }
    }
#if PROBE == 4
    for (int i = 0; i < 20; ++i) xcd_barrier(bar, xcc, xst, p.wv);
#endif
}

extern "C" void kernel_launch(void* const* d_in, const int* in_sizes, int n_in, void* d_out, int out_size, void* d_ws, size_t ws_size, hipStream_t stream) {
    static int grid = 0;
    if (grid == 0) {
        if (n_in != 28 || (size_t)out_size != o_end || ws_size < WS_END) { fprintf(stderr, "kernel_launch: unexpected sizes n_in %d out %d ws %zu (need %zu)\n", n_in, out_size, ws_size, (size_t)WS_END); grid = -1; return; }
        int dev = 0, cus = 0, per_cu = 0;
        hipGetDevice(&dev); hipDeviceGetAttribute(&cus, hipDeviceAttributeMultiprocessorCount, dev);
        if (hipFuncSetAttribute((const void*)fwd_kernel, hipFuncAttributeMaxDynamicSharedMemorySize, LDS_BYTES) != hipSuccess) { fprintf(stderr, "hipFuncSetAttribute failed\n"); grid = -1; return; }
        if (hipOccupancyMaxActiveBlocksPerMultiprocessor(&per_cu, (const void*)fwd_kernel, NTHREADS, LDS_BYTES) != hipSuccess || per_cu < 1) { fprintf(stderr, "occupancy query failed (%d)\n", per_cu); (void)hipGetLastError(); per_cu = 1; }
        grid = cus * per_cu;
        if (grid > 256) grid = 256;
    }
    if (grid < 0) return;
    if (hipMemsetAsync((unsigned char*)d_ws + OFF_BAR, 0, 16384, stream) != hipSuccess) { fprintf(stderr, "memset of barrier words failed\n"); return; }
    Params p{};
    const float** pp = (const float**)&p;
    for (int i = 0; i < 28; ++i) pp[i] = (const float*)d_in[i];
    p.out = (float*)d_out; p.ws = (unsigned char*)d_ws;
#if MULTI
    for (int ph = 0; ph < NPHASE; ++ph) { p.ph_lo = ph; p.ph_hi = ph + 1; hipLaunchKernelGGL(fwd_kernel, dim3(grid), dim3(NTHREADS), LDS_BYTES, stream, p); }
#else
    p.ph_lo = 0; p.ph_hi = NPHASE;
    void* args[] = {&p};
    hipError_t e = hipLaunchCooperativeKernel((const void*)fwd_kernel, dim3(grid), dim3(NTHREADS), args, LDS_BYTES, stream);
    if (e != hipSuccess) fprintf(stderr, "cooperative launch failed: %s (grid %d)\n", hipGetErrorString(e), grid);
#endif
}
```

```cpp
#include <hip/hip_runtime.h>
#include <hip/hip_cooperative_groups.h>
#include <cstdio>
namespace cg = cooperative_groups;

#ifndef MULTI
#define MULTI 0
#endif

typedef unsigned short bf16_t;
typedef short bf16x8 __attribute__((ext_vector_type(8)));
typedef float f32x4 __attribute__((ext_vector_type(4)));
typedef float f32x2 __attribute__((ext_vector_type(2)));
typedef unsigned u32x2 __attribute__((ext_vector_type(2)));
typedef unsigned u32x4 __attribute__((ext_vector_type(4)));

constexpr int D = 1024, NB = 8, LP = 2064, LPAD = 2080, NS = 128, LS = 4, DEPTH = 2, NMETA = 16, SEQ = 2048;
constexpr int MROWS = NB * LPAD + NS * LS;
constexpr int SROW0 = NB * LPAD;
constexpr int NIN = 6160, NP = 6144, DFF = 2816, NU = 5632;
constexpr int cQ = 0, cK = 512, cV = 1024, cO = 1536, cBQ = 2048, cBK = 2560, cBV = 3072, cZ = 3584, cMG = 4096;
constexpr float ALPHA = 1.4142135623730951f;
constexpr int SPLIT_ROW0 = 64 * 256;
constexpr int NTHREADS = 512;
constexpr int LDS_GEMM = 131072;
constexpr int LDS_BYTES = LDS_GEMM + 256;

constexpr size_t W_IN = (size_t)NP * 1024, W_AB = 2048 * 512, W_OUT = 1024 * 2048, W_UP = (size_t)NU * 1024, W_DN = (size_t)1024 * DFF;
constexpr size_t W_LAYER = W_IN + W_AB + W_OUT + W_UP + W_DN;
constexpr size_t OFF_W = 0;
constexpr size_t OFF_WG = OFF_W + DEPTH * W_LAYER * 2;
constexpr size_t OFF_X = OFF_WG + DEPTH * 16 * 1024 * 4;
constexpr size_t OFF_G = OFF_X + (size_t)MROWS * D * 2;
constexpr size_t OFF_HB = OFF_G + (size_t)MROWS * 16 * 4;
constexpr size_t OFF_P = OFF_HB + (size_t)(MROWS / 32) * 2 * NU * 2;
constexpr size_t OFF_GH = OFF_P + (size_t)MROWS * NP * 2;
constexpr size_t OFF_REC = OFF_GH + (size_t)(MROWS / 32) * 3 * 1536 * 2;
constexpr size_t OFF_BAR = OFF_REC + (size_t)MROWS * 4 * 16 * 4;
constexpr size_t OFF_TB = OFF_BAR + 16384;
constexpr size_t WS_END = OFF_TB + (size_t)(MROWS / 32) * 4 * 3 * 1024 * 2;

constexpr size_t o_yp = 0;
constexpr size_t o_ys = o_yp + (size_t)NB * SEQ * D;
constexpr size_t o_pC = o_ys + (size_t)NS * LS * D;
constexpr size_t o_pn = o_pC + (size_t)DEPTH * NB * 4 * 128 * 128;
constexpr size_t o_pm = o_pn + (size_t)DEPTH * NB * 4 * 128;
constexpr size_t o_pS = o_pm + (size_t)DEPTH * NB * 4;
constexpr size_t o_pgc = o_pS + (size_t)DEPTH * NB * 4 * 128 * 128;
constexpr size_t o_pfc = o_pgc + (size_t)DEPTH * NB * 3 * 1536;
constexpr size_t o_sC = o_pfc + (size_t)DEPTH * NB * 2 * NU;
constexpr size_t o_sn = o_sC + (size_t)DEPTH * NS * 4 * 128 * 128;
constexpr size_t o_sm = o_sn + (size_t)DEPTH * NS * 4 * 128;
constexpr size_t o_sS = o_sm + (size_t)DEPTH * NS * 4;
constexpr size_t o_sgc = o_sS + (size_t)DEPTH * NS * 4 * 128 * 128;
constexpr size_t o_sfc = o_sgc + (size_t)DEPTH * NS * 3 * 1536;
constexpr size_t o_end = o_sfc + (size_t)DEPTH * NS * 2 * NU;

struct Params {
    const float* x_prompt; const float* x_sample; const float* st_C; const float* st_n; const float* st_m; const float* st_S;
    const float* st_gconv; const float* st_fconv; const float* meta; const float* ln_emb_g; const float* ln_emb_b; const float* w_in;
    const float* gate_bias; const float* a_norm_w; const float* gconv_w; const float* A_log; const float* dt_bias; const float* b_norm_w;
    const float* w_pa; const float* w_pb; const float* w_out; const float* ln1_g; const float* ln1_b; const float* w_up;
    const float* fconv_w; const float* w_down; const float* ln2_g; const float* ln2_b;
    float* out; unsigned char* ws;
    int ph_lo, ph_hi;
    int wv, pad_;
};

__device__ __forceinline__ int opaque_tid(int wv) { int lane; asm volatile("v_mbcnt_lo_u32_b32 %0, -1, 0\n\tv_mbcnt_hi_u32_b32 %0, -1, %0" : "=v"(lane)); return wv * 64 + lane; }
__device__ __forceinline__ float bflo(unsigned u) { return __uint_as_float(u << 16); }
__device__ __forceinline__ float bfhi(unsigned u) { return __uint_as_float(u & 0xffff0000u); }
__device__ __forceinline__ unsigned pk2(float lo, float hi) { unsigned r; asm("v_cvt_pk_bf16_f32 %0, %1, %2" : "=v"(r) : "v"(lo), "v"(hi)); return r; }
template <int CTRL> __device__ __forceinline__ float dppf(float v) { return __int_as_float(__builtin_amdgcn_update_dpp(0, __float_as_int(v), CTRL, 0xf, 0xf, true)); }
__device__ __forceinline__ float red8(float v) { v += dppf<0xB1>(v); v += dppf<0x4E>(v); v += dppf<0x141>(v); return v; }
__device__ __forceinline__ float red16(float v) { v = red8(v); v += dppf<0x140>(v); return v; }
__device__ __forceinline__ float rdl(float v, int l) { return __int_as_float(__builtin_amdgcn_readlane(__float_as_int(v), l)); }
__device__ __forceinline__ float rdl_pin(float v, int l) { float r_; asm volatile("v_readlane_b32 %0, %1, %2" : "=s"(r_) : "v"(v), "s"(l)); return r_; }
__device__ __forceinline__ float red64(float v) { v = red16(v); return (rdl(v, 0) + rdl(v, 16)) + (rdl(v, 32) + rdl(v, 48)); }
__device__ __forceinline__ float sigmoidf_(float x) { return __builtin_amdgcn_rcpf(1.f + __expf(-x)); }
__device__ __forceinline__ u32x4 pack8(const float* y) { u32x4 o; o.x = pk2(y[0], y[1]); o.y = pk2(y[2], y[3]); o.z = pk2(y[4], y[5]); o.w = pk2(y[6], y[7]); return o; }
__device__ __forceinline__ void unpack8(u32x4 a, float* x) { x[0] = bflo(a.x); x[1] = bfhi(a.x); x[2] = bflo(a.y); x[3] = bfhi(a.y); x[4] = bflo(a.z); x[5] = bfhi(a.z); x[6] = bflo(a.w); x[7] = bfhi(a.w); }


#define XB_TMO      128
#define XB_XCNT(j)  (256  + 64 * (j))
#define XB_XSUB(j)  (1280 + 64 * (j))
#define XB_XGEN(j)  (2304 + 64 * (j))
#define XB_TOP      3328
#define XB_TOPGEN   3392
#define XCD_BAR_WORDS 3456
#define XB_SPIN_CAP (1u << 18)
#define LAS __attribute__((address_space(3)))
__device__ __forceinline__ unsigned xb_ld(unsigned* p)              { return __hip_atomic_load(p, __ATOMIC_RELAXED, __HIP_MEMORY_SCOPE_AGENT); }
__device__ __forceinline__ unsigned xb_add(unsigned* p, unsigned v) { return __hip_atomic_fetch_add(p, v, __ATOMIC_RELAXED, __HIP_MEMORY_SCOPE_AGENT); }
__device__ __forceinline__ unsigned xb_xcc_id() { return (unsigned)__builtin_amdgcn_s_getreg((3 << 11) | 20) & 0xFu; }
#define XB_SPIN(cond, bar) do { unsigned _sp = 0; while (cond) { __builtin_amdgcn_s_sleep(1); \
    if ((++_sp & 255u) == 0u) { if (xb_ld(&(bar)[XB_TMO])) break; if (_sp > XB_SPIN_CAP) { atomicAdd(&(bar)[XB_TMO], 1u); break; } } } } while (0)
__device__ __forceinline__ void xcd_barrier_complete(unsigned* bar, unsigned x, unsigned& nloc, unsigned& nx) {
    const unsigned G = gridDim.x;
    unsigned sum, cnt, mine, sp = 0u;
    for (;;) {
        sum = 0u; cnt = 0u; mine = 0u;
#pragma unroll
        for (unsigned j = 0; j < 16; ++j) { const unsigned c = xb_ld(&bar[XB_XCNT(j)]); sum += c; cnt += (c > 0u) ? 1u : 0u; mine = (j == x) ? c : mine; }
        if (sum == G) break;
        __builtin_amdgcn_s_sleep(1);
        if ((++sp & 255u) == 0u) { if (xb_ld(&bar[XB_TMO])) break; if (sp > XB_SPIN_CAP) { atomicAdd(&bar[XB_TMO], 1u); break; } }
    }
    nloc = mine > 0u ? mine : 1u; nx = cnt > 0u ? cnt : 1u;
}
__device__ __forceinline__ void xcd_barrier(unsigned* bar, unsigned x, volatile LAS unsigned* st, int wv) {
    asm volatile("s_waitcnt vmcnt(0)" ::: "memory");
    __syncthreads();
    if (opaque_tid(wv) == 0) {
        __builtin_amdgcn_s_waitcnt(0);
        unsigned nloc = st[0], nx = st[1];
        if (nloc == 0u) { xcd_barrier_complete(bar, x, nloc, nx); st[0] = nloc; st[1] = nx; }
        const unsigned old = xb_add(&bar[XB_XSUB(x)], 1u);
        const unsigned gen = old / nloc;
        if (old + 1u == (gen + 1u) * nloc) {
            __builtin_amdgcn_fence(__ATOMIC_RELEASE, "agent");
            asm volatile("s_waitcnt vmcnt(0)" ::: "memory");
            const unsigned og = xb_add(&bar[XB_TOP], 1u);
            const unsigned tg = og / nx;
            if (og + 1u == (tg + 1u) * nx) xb_add(&bar[XB_TOPGEN], 1u);
            else XB_SPIN(xb_ld(&bar[XB_TOPGEN]) == tg, bar);
            __builtin_amdgcn_fence(__ATOMIC_ACQUIRE, "agent");
            xb_add(&bar[XB_XGEN(x)], 1u);
            asm volatile("s_waitcnt vmcnt(0)" ::: "memory");
        } else {
            XB_SPIN(xb_ld(&bar[XB_XGEN(x)]) == gen, bar);
            __builtin_amdgcn_fence(__ATOMIC_ACQUIRE, "agent");
            asm volatile("s_waitcnt vmcnt(0)" ::: "memory");
        }
    }
    __syncthreads();
}

struct TJob { const float* src; int ldw; int K; int N; bf16_t* dst; int ldt; };
__device__ __forceinline__ void transpose_item(const TJob& jb, int item, float* scr, int lane) {
    const int nblk = jb.N / 32, kb = item / nblk, nb = item % nblk, k0 = 64 * kb, n0 = 32 * nb;
#pragma unroll 8
    for (int i = 0; i < 32; ++i) { const int kk = 2 * i + (lane >> 5); scr[kk * 33 + (lane & 31)] = jb.src[(size_t)(k0 + kk) * jb.ldw + n0 + (lane & 31)]; }
    __builtin_amdgcn_s_waitcnt(0xc07f); asm volatile("" ::: "memory");
    const int c = lane & 7;
#pragma unroll
    for (int j = 0; j < 4; ++j) { const int n = (lane >> 3) + 8 * j; const float* s = scr + (8 * c) * 33 + n;
        u32x4 o; o.x = pk2(s[0 * 33], s[1 * 33]); o.y = pk2(s[2 * 33], s[3 * 33]); o.z = pk2(s[4 * 33], s[5 * 33]); o.w = pk2(s[6 * 33], s[7 * 33]);
        *(u32x4*)(jb.dst + (size_t)(n0 + n) * jb.ldt + k0 + 8 * c) = o; }
    __builtin_amdgcn_s_waitcnt(0xc07f); asm volatile("" ::: "memory");
}
__device__ __forceinline__ bf16_t* wl(const Params& p, int l) { return (bf16_t*)(p.ws + OFF_W) + (size_t)l * W_LAYER; }
__device__ __forceinline__ bf16_t* w_inT(const Params& p, int l) { return wl(p, l); }
__device__ __forceinline__ bf16_t* w_abT(const Params& p, int l) { return wl(p, l) + W_IN; }
__device__ __forceinline__ bf16_t* w_outT(const Params& p, int l) { return wl(p, l) + W_IN + W_AB; }
__device__ __forceinline__ bf16_t* w_upT(const Params& p, int l) { return wl(p, l) + W_IN + W_AB + W_OUT; }
__device__ __forceinline__ bf16_t* w_dnT(const Params& p, int l) { return wl(p, l) + W_IN + W_AB + W_OUT + W_UP; }

__device__ __forceinline__ void phase_weights(const Params& p, float* lds) {
    const int tid = opaque_tid(p.wv); const int wave = tid >> 6, lane = tid & 63;
    float* scr = lds + wave * (64 * 33);
    const int gw = blockIdx.x * 8 + wave, NGW = gridDim.x * 8;
    constexpr int I0 = 16 * 64, I1 = 16 * 64, I2 = 16 * 64, I3 = 8 * 32, I4 = 8 * 32, I5 = 16 * 32, I6 = 16 * 32, I7 = 16 * (NU / 32), I8 = (DFF / 64) * 32;
    constexpr int IL = I0 + I1 + I2 + I3 + I4 + I5 + I6 + I7 + I8;
    for (int it = gw; it < DEPTH * IL; it += NGW) {
        const int l = it / IL; int r = it % IL;
        TJob jb;
        const float* win = p.w_in + (size_t)l * 1024 * NIN;
        if (r < I0) { jb = {win, NIN, 1024, 2048, w_inT(p, l), 1024}; }
        else if ((r -= I0) < I1) { jb = {win + 2056, NIN, 1024, 2048, w_inT(p, l) + (size_t)2048 * 1024, 1024}; }
        else if ((r -= I1) < I2) { jb = {win + 4112, NIN, 1024, 2048, w_inT(p, l) + (size_t)4096 * 1024, 1024}; }
        else if ((r -= I2) < I3) { jb = {p.w_pa + (size_t)l * 512 * 1024, 1024, 512, 1024, w_abT(p, l), 512}; }
        else if ((r -= I3) < I4) { jb = {p.w_pb + (size_t)l * 512 * 1024, 1024, 512, 1024, w_abT(p, l) + (size_t)1024 * 512, 512}; }
        else if ((r -= I4) < I5) { jb = {p.w_out + (size_t)l * 1024 * 1024, 1024, 1024, 1024, w_outT(p, l), 2048}; }
        else if ((r -= I5) < I6) { jb = {p.w_out + (size_t)l * 1024 * 1024, 1024, 1024, 1024, w_outT(p, l) + 1024, 2048}; }
        else if ((r -= I6) < I7) { jb = {p.w_up + (size_t)l * 1024 * NU, NU, 1024, NU, w_upT(p, l), 1024}; }
        else { r -= I7; jb = {p.w_down + (size_t)l * DFF * 1024, 1024, DFF, 1024, w_dnT(p, l), DFF}; }
        transpose_item(jb, r, scr, lane);
    }
    float* wg = (float*)(p.ws + OFF_WG);
    for (int i = blockIdx.x * NTHREADS + tid; i < DEPTH * 16 * 1024; i += gridDim.x * NTHREADS) {
        const int l = i >> 14, g = (i >> 10) & 15, k = i & 1023;
        const int col = g < 8 ? 2048 + g : 4104 + (g - 8);
        wg[i] = p.w_in[((size_t)l * 1024 + k) * NIN + col];
    }
}

__device__ __forceinline__ void phase_ln(const Params& p, int mode, const bf16_t* src, int ldsrc, const float* gam, const float* bet,
                                         int gate_layer  , bool final_out) {
    const int tid = opaque_tid(p.wv); const int wave = tid >> 6, lane = tid & 63;
    bf16_t* X = (bf16_t*)(p.ws + OFF_X);
#define EOFF(j) (512 * ((j) >> 1) + lane * 8 + 4 * ((j) & 1))
    float* G = (float*)(p.ws + OFF_G);
    const float* wg = (const float*)(p.ws + OFF_WG) + (size_t)(gate_layer < 0 ? 0 : gate_layer) * 16 * 1024;
    const int stride = gridDim.x * 8;
    int row = blockIdx.x * 8 + wave;
    u32x4 c0 = (u32x4){0u, 0u, 0u, 0u}, c1 = c0;
    if (mode == 1) {
        while (row < SROW0 && (row % LPAD) >= LP) row += stride;
        if (row < MROWS) { const bf16_t* s_ = src + (size_t)row * ldsrc; c0 = *(const u32x4*)(s_ + lane * 8); c1 = *(const u32x4*)(s_ + 512 + lane * 8); }
    }
    while (row < MROWS) {
        int nrow = row + stride; u32x4 n0 = c0, n1 = c1;
        if (mode == 1) {
            while (nrow < SROW0 && (nrow % LPAD) >= LP) nrow += stride;
            if (nrow < MROWS) { const bf16_t* s_ = src + (size_t)nrow * ldsrc; n0 = *(const u32x4*)(s_ + lane * 8); n1 = *(const u32x4*)(s_ + 512 + lane * 8); }
        }
        int b = 0, t = 0; bool samp = row >= SROW0;
        if (!samp) { b = row / LPAD; t = row - b * LPAD; } else { b = (row - SROW0) >> 2; t = row & 3; }
        const bool valid = samp || t < LP;
        bf16_t* xo = X + (size_t)row * D;
        if (!valid) { if (mode == 0) {
#pragma unroll
                for (int jj = 0; jj < 2; ++jj) *(u32x4*)(xo + 512 * jj + lane * 8) = (u32x4){0u, 0u, 0u, 0u}; }
            row = nrow; c0 = n0; c1 = n1; continue; }
        f32x4 v[4];
        if (mode == 0) {
            const float* s = samp ? p.x_sample + ((size_t)b * LS + t) * D : (t < NMETA ? p.meta + (size_t)t * D : p.x_prompt + ((size_t)b * SEQ + (t - NMETA)) * D);
#pragma unroll
            for (int j = 0; j < 4; ++j) v[j] = *(const f32x4*)(s + EOFF(j));
        } else {
#pragma unroll
            for (int jj = 0; jj < 2; ++jj) { const u32x4 u = jj ? c1 : c0; v[2 * jj] = (f32x4){bflo(u.x), bfhi(u.x), bflo(u.y), bfhi(u.y)}; v[2 * jj + 1] = (f32x4){bflo(u.z), bfhi(u.z), bflo(u.w), bfhi(u.w)}; }
            if (row >= SPLIT_ROW0) { const bf16_t* sp = (const bf16_t*)(p.ws + OFF_GH) + (size_t)(row - SPLIT_ROW0) * D;
#pragma unroll
                for (int q = 0; q < 3; ++q)
#pragma unroll
                    for (int jj = 0; jj < 2; ++jj) { const u32x4 u = *(const u32x4*)(sp + (size_t)q * (MROWS - SPLIT_ROW0) * D + 512 * jj + lane * 8); v[2 * jj] += (f32x4){bflo(u.x), bfhi(u.x), bflo(u.y), bfhi(u.y)}; v[2 * jj + 1] += (f32x4){bflo(u.z), bfhi(u.z), bflo(u.w), bfhi(u.w)}; } }
        }
        float sum = 0.f;
#pragma unroll
        for (int j = 0; j < 4; ++j) sum += (v[j][0] + v[j][1]) + (v[j][2] + v[j][3]);
        const float mean = red64(sum) * (1.f / D);
        float s2 = 0.f;
#pragma unroll
        for (int j = 0; j < 4; ++j) { v[j] = v[j] - mean; s2 += (v[j][0] * v[j][0] + v[j][1] * v[j][1]) + (v[j][2] * v[j][2] + v[j][3] * v[j][3]); }
        const float rstd = rsqrtf(red64(s2) * (1.f / D) + 1e-5f);
#pragma unroll
        for (int j = 0; j < 4; ++j) { const f32x4 g4 = *(const f32x4*)(gam + EOFF(j)), b4 = *(const f32x4*)(bet + EOFF(j)); v[j] = v[j] * rstd * g4 + b4; }
#pragma unroll
        for (int jj = 0; jj < 2; ++jj) *(u32x4*)(xo + 512 * jj + lane * 8) = (u32x4){pk2(v[2 * jj][0], v[2 * jj][1]), pk2(v[2 * jj][2], v[2 * jj][3]), pk2(v[2 * jj + 1][0], v[2 * jj + 1][1]), pk2(v[2 * jj + 1][2], v[2 * jj + 1][3])};
        if (final_out) {
            float* o = nullptr;
            if (samp) o = p.out + o_ys + ((size_t)b * LS + t) * D; else if (t >= NMETA) o = p.out + o_yp + ((size_t)b * SEQ + (t - NMETA)) * D;
            if (o) {
#pragma unroll
                for (int j = 0; j < 4; ++j) *(f32x4*)(o + EOFF(j)) = v[j]; }
        }
        if (gate_layer >= 0) {
            float mine = 0.f;
#pragma unroll 2
            for (int g = 0; g < 16; ++g) {
                float a = 0.f;
#pragma unroll
                for (int j = 0; j < 4; ++j) { const f32x4 w4 = *(const f32x4*)(wg + g * 1024 + EOFF(j)); a += (v[j][0] * w4[0] + v[j][1] * w4[1]) + (v[j][2] * w4[2] + v[j][3] * w4[3]); }
                a = red64(a);
                if (lane == g) mine = a;
            }
            if (lane < 16) G[(size_t)row * 16 + lane] = mine;
        }
        row = nrow; c0 = n0; c1 = n1;
    }
#undef EOFF
}

constexpr int BM = 256, BK = 64, HALF = 128, HT = HALF * BK, NXCD = 8, WGM = 8;
__device__ __forceinline__ int lds_byte(int r, int c) { int st = (r >> 4) * 2 + (c >> 5), rr = r & 15, cc = c & 31, ob = rr * 64 + cc * 2; return st * 1024 + (ob ^ (((ob >> 9) & 1) << 5)); }
__device__ __forceinline__ void stage_rc(int b, int& R, int& C) { int st = b / 1024, sb = b % 1024, swz = sb ^ (((sb >> 9) & 1) << 5); R = (st >> 1) * 16 + swz / 64; C = (st & 1) * 32 + (swz % 64) / 2; }

struct GemmArgs { const bf16_t* A; const bf16_t* A2; int a2_from_pn; int lda; const bf16_t* Bt; int M, N, K; int splitk; };

template <class Epi>
__device__ __forceinline__ void gemm_phase(const GemmArgs g, const Epi& epi, int wv) {
    extern __shared__ __attribute__((aligned(16))) unsigned char smem_raw[];
    bf16_t* shm = (bf16_t*)smem_raw;
#define SA(b, h) (shm + ((b) * 2 + (h)) * HT)
#define SB(b, h) (shm + (4 + (b) * 2 + (h)) * HT)
#define STAGE_A(P_, br, kt) do { const char* _gb = (const char*)(A + (size_t)(br) * lda + (size_t)((kt) + kofs) * BK); \
    unsigned _o0 = offA0, _o1 = offA1; asm volatile("" : "+v"(_o0), "+v"(_o1)); \
    __builtin_amdgcn_global_load_lds((const unsigned*)(_gb + _o0), (unsigned*)((char*)(P_) + tid * 16), 16, 0, 0); \
    __builtin_amdgcn_global_load_lds((const unsigned*)(_gb + _o1), (unsigned*)((char*)(P_) + tid * 16 + 8192), 16, 0, 0); } while (0)
#define STAGE_B(P_, bc, kt) do { const char* _gb = (const char*)(Bt + (size_t)(bc) * K + (size_t)((kt) + kofs) * BK); \
    unsigned _o0 = offB0, _o1 = offB1; asm volatile("" : "+v"(_o0), "+v"(_o1)); \
    __builtin_amdgcn_global_load_lds((const unsigned*)(_gb + _o0), (unsigned*)((char*)(P_) + tid * 16), 16, 0, 0); \
    __builtin_amdgcn_global_load_lds((const unsigned*)(_gb + _o1), (unsigned*)((char*)(P_) + tid * 16 + 8192), 16, 0, 0); } while (0)
#define LDA(dst, b, h) for (int m = 0; m < 4; ++m) for (int k = 0; k < 2; ++k) \
    dst[m][k] = *reinterpret_cast<const bf16x8*>((char*)SA(b, h) + lds_byte(wr * 64 + m * 16 + fr, k * 32 + fq * 8))
#define LDB(dst, b, h) for (int n = 0; n < 2; ++n) for (int k = 0; k < 2; ++k) \
    dst[n][k] = *reinterpret_cast<const bf16x8*>((char*)SB(b, h) + lds_byte(wc * 32 + n * 16 + fr, k * 32 + fq * 8))
#define MMA(ai, bj, At_, Bt_) do { __builtin_amdgcn_s_setprio(1); \
    for (int m = 0; m < 4; ++m) for (int n = 0; n < 2; ++n) for (int k = 0; k < 2; ++k) \
      acc[ai][bj][m][n] = __builtin_amdgcn_mfma_f32_16x16x32_bf16(Bt_[n][k], At_[m][k], acc[ai][bj][m][n], 0, 0, 0); \
    __builtin_amdgcn_s_setprio(0); } while (0)
#define WAIT_V(n) asm volatile("s_waitcnt vmcnt(" #n ")" ::: "memory")
#define WAIT_L(n) asm volatile("s_waitcnt lgkmcnt(" #n ")" ::: "memory")
#define BAR __builtin_amdgcn_s_barrier()
#define SCHED __builtin_amdgcn_sched_barrier(0)
    const int lda = g.lda, K = g.K; const bf16_t* Bt = g.Bt;
    const int nMall = g.M / BM, nN = g.N / BM, nM = g.splitk ? 64 : nMall, nwg = nM * nN, nunits = nwg + (nMall - nM) * nN * 4;
    const int tid = opaque_tid(wv);
    const int wid = tid >> 6, lane = tid & 63, wr = wid >> 2, wc = wid & 3, fr = lane & 15, fq = lane >> 4;
    const int ntK = K / BK;
    unsigned offA0, offA1, offB0, offB1;
    { int r0, c0, r1, c1; stage_rc(tid * 16, r0, c0); stage_rc(tid * 16 + 8192, r1, c1);
      offA0 = (unsigned)(r0 * lda + c0) * 2u; offA1 = (unsigned)(r1 * lda + c1) * 2u;
      const int p0 = (r0 & ~31) + 8 * ((r0 & 15) >> 2) + 4 * ((r0 >> 4) & 1) + (r0 & 3), p1 = (r1 & ~31) + 8 * ((r1 & 15) >> 2) + 4 * ((r1 >> 4) & 1) + (r1 & 3);
      offB0 = (unsigned)(p0 * K + c0) * 2u; offB1 = (unsigned)(p1 * K + c1) * 2u; }
    for (int Lt = blockIdx.x; Lt < nunits; Lt += gridDim.x) {
        int pm, pn, kofs = 0, nt = ntK, split = 0;
        if (Lt < nwg) {
            int wgid = Lt;
            { int q = nwg / NXCD, r = nwg % NXCD, xcd = wgid % NXCD, off = wgid / NXCD; wgid = (xcd < r ? xcd * (q + 1) : r * (q + 1) + (xcd - r) * q) + off; }
            const int nig = WGM * nN, gid = wgid / nig, fm = gid * WGM, gsz = min(nM - fm, WGM);
            pm = fm + ((wgid % nig) % gsz); pn = (wgid % nig) / gsz;
        } else {
            const int u = Lt - nwg, tl = u >> 2; split = u & 3; pm = nM + tl / nN; pn = tl % nN;
            const int q4 = ntK >> 2;
            if (q4 & 1) { nt = split < 2 ? q4 + 1 : q4 - 1; kofs = split < 2 ? split * (q4 + 1) : 2 * (q4 + 1) + (split - 2) * (q4 - 1); } else { nt = q4; kofs = split * q4; }
        }
        const int brow = pm * BM, bcol = pn * BM;
        const bf16_t* A = (pn >= g.a2_from_pn) ? g.A2 : g.A;
        f32x4 acc[2][2][4][2] = {};
        bf16x8 At[4][2], B0[2][2], B1[2][2];
        STAGE_B(SB(0, 0), bcol, 0); STAGE_A(SA(0, 0), brow, 0);
        STAGE_B(SB(0, 1), bcol + HALF, 0); STAGE_A(SA(0, 1), brow + HALF, 0);
        if (wr == 1) BAR;
        WAIT_V(4); BAR;
        STAGE_B(SB(1, 0), bcol, 1); STAGE_A(SA(1, 0), brow, 1); STAGE_B(SB(1, 1), bcol + HALF, 1);
        WAIT_V(6); BAR;
        for (int t = 0; t < nt - 2; t += 2) {
            LDB(B0, 0, 0); SCHED; LDA(At, 0, 0); STAGE_A(SA(1, 1), brow + HALF, t + 1);
            WAIT_L(8); BAR; WAIT_L(0); MMA(0, 0, At, B0); BAR; SCHED;
            LDB(B1, 0, 1); STAGE_B(SB(0, 0), bcol, t + 2);
            BAR; WAIT_L(0); MMA(0, 1, At, B1); BAR;
            LDA(At, 0, 1); STAGE_A(SA(0, 0), brow, t + 2);
            BAR; WAIT_L(0); MMA(1, 0, At, B0); BAR; SCHED;
            STAGE_B(SB(0, 1), bcol + HALF, t + 2);
            WAIT_V(6); BAR; MMA(1, 1, At, B1); BAR;
            LDB(B0, 1, 0); SCHED; LDA(At, 1, 0); STAGE_A(SA(0, 1), brow + HALF, t + 2);
            WAIT_L(8); BAR; WAIT_L(0); MMA(0, 0, At, B0); BAR; SCHED;
            LDB(B1, 1, 1); STAGE_B(SB(1, 0), bcol, t + 3);
            BAR; WAIT_L(0); MMA(0, 1, At, B1); BAR;
            LDA(At, 1, 1); STAGE_A(SA(1, 0), brow, t + 3);
            BAR; WAIT_L(0); MMA(1, 0, At, B0); BAR; SCHED;
            STAGE_B(SB(1, 1), bcol + HALF, t + 3);
            WAIT_V(6); BAR; MMA(1, 1, At, B1); BAR;
        }
        { LDB(B0, 0, 0); LDA(At, 0, 0); STAGE_A(SA(1, 1), brow + HALF, nt - 1);
          BAR; WAIT_L(0); MMA(0, 0, At, B0); BAR;
          LDB(B1, 0, 1); BAR; WAIT_L(0); MMA(0, 1, At, B1); BAR;
          LDA(At, 0, 1); WAIT_V(4); BAR; WAIT_L(0); MMA(1, 0, At, B0); MMA(1, 1, At, B1); BAR; }
        { LDB(B0, 1, 0); LDA(At, 1, 0); WAIT_V(2); BAR; WAIT_L(0); MMA(0, 0, At, B0); BAR;
          LDB(B1, 1, 1); WAIT_V(0); BAR; WAIT_L(0); MMA(0, 1, At, B1); BAR;
          LDA(At, 1, 1); BAR; WAIT_L(0); MMA(1, 0, At, B0); MMA(1, 1, At, B1); BAR; }
        if (wr == 0) BAR;
        int erow = brow + wr * 64 + fr, ecol = bcol + wc * 32 + fq * 8;
        asm volatile("" : "+v"(erow), "+v"(ecol));
#pragma unroll
        for (int ai = 0; ai < 2; ++ai)
#pragma unroll
            for (int m = 0; m < 4; ++m) {
                const int row = erow + ai * HALF + m * 16;
#pragma unroll
                for (int bj = 0; bj < 2; ++bj) epi(row, ecol + bj * HALF, acc[ai][bj][m][0], acc[ai][bj][m][1], split);
                if (m & 1) SCHED;
            }
    }
#undef SA
#undef SB
}

struct EpiP {
    bf16_t* P; bf16_t* GH; float* out; int l;
    __device__ __forceinline__ void operator()(int row, int col, f32x4 v, f32x4 w, int split) const {
        const u32x4 o = (u32x4){pk2(v[0], v[1]), pk2(v[2], v[3]), pk2(w[0], w[1]), pk2(w[2], w[3])};
        *(u32x4*)(P + (size_t)row * NP + col) = o;
        if (col >= cBQ && col < cZ) {
            const int c = col - cBQ;
            if ((row & 31) >= 29) *(u32x4*)(GH + ((size_t)(row >> 5) * 3 + ((row & 31) - 29)) * 1536 + c) = o;
            if (row < SROW0) { const int b = row / LPAD, t = row - b * LPAD; if (t >= LP - 3 && t < LP) { float* d = out + o_pgc + ((size_t)(l * NB + b) * 3 + (t - (LP - 3))) * 1536 + c; *(f32x4*)d = v; *(f32x4*)(d + 4) = w; } }
            else { const int s = (row - SROW0) >> 2, t = row & 3; if (t >= 1) { float* d = out + o_sgc + ((size_t)(l * NS + s) * 3 + (t - 1)) * 1536 + c; *(f32x4*)d = v; *(f32x4*)(d + 4) = w; } }
        }
    }
};
struct EpiMerge {
    bf16_t* P;
    __device__ __forceinline__ void operator()(int row, int col, f32x4 v, f32x4 w, int split) const {
        u32x4* ptr = (u32x4*)(P + (size_t)row * NP + cMG + col); const u32x4 gm = *ptr;
        v[0] *= sigmoidf_(bflo(gm.x)); v[1] *= sigmoidf_(bfhi(gm.x)); v[2] *= sigmoidf_(bflo(gm.y)); v[3] *= sigmoidf_(bfhi(gm.y));
        w[0] *= sigmoidf_(bflo(gm.z)); w[1] *= sigmoidf_(bfhi(gm.z)); w[2] *= sigmoidf_(bflo(gm.w)); w[3] *= sigmoidf_(bfhi(gm.w));
        *ptr = (u32x4){pk2(v[0], v[1]), pk2(v[2], v[3]), pk2(w[0], w[1]), pk2(w[2], w[3])};
    }
};
struct EpiRes {
    const bf16_t* X; bf16_t* O; int ldo; int ocol0; bf16_t* SCR;
    __device__ __forceinline__ void operator()(int row, int col, f32x4 v, f32x4 w, int split) const {
        if (split == 0) {
            const u32x4 x = *(const u32x4*)(X + (size_t)row * D + col);
            v[0] += ALPHA * bflo(x.x); v[1] += ALPHA * bfhi(x.x); v[2] += ALPHA * bflo(x.y); v[3] += ALPHA * bfhi(x.y);
            w[0] += ALPHA * bflo(x.z); w[1] += ALPHA * bfhi(x.z); w[2] += ALPHA * bflo(x.w); w[3] += ALPHA * bfhi(x.w);
            *(u32x4*)(O + (size_t)row * ldo + ocol0 + col) = (u32x4){pk2(v[0], v[1]), pk2(v[2], v[3]), pk2(w[0], w[1]), pk2(w[2], w[3])};
        } else *(u32x4*)(SCR + ((size_t)(split - 1) * (MROWS - SPLIT_ROW0) + (row - SPLIT_ROW0)) * D + col) = (u32x4){pk2(v[0], v[1]), pk2(v[2], v[3]), pk2(w[0], w[1]), pk2(w[2], w[3])};
    }
};
struct EpiUp {
    bf16_t* U; bf16_t* HB; float* out; int l;
    __device__ __forceinline__ void operator()(int row, int col, f32x4 v, f32x4 w, int split) const {
        const u32x4 o = (u32x4){pk2(v[0], v[1]), pk2(v[2], v[3]), pk2(w[0], w[1]), pk2(w[2], w[3])};
        *(u32x4*)(U + (size_t)row * NU + col) = o;
        if ((row & 31) >= 30) *(u32x4*)(HB + ((size_t)(row >> 5) * 2 + (row & 1)) * NU + col) = o;
        if (row < SROW0) { const int b = row / LPAD, t = row - b * LPAD; if (t >= LP - 2 && t < LP) { float* d = out + o_pfc + ((size_t)(l * NB + b) * 2 + (t - (LP - 2))) * NU + col; *(f32x4*)d = v; *(f32x4*)(d + 4) = w; } }
        else { const int s = (row - SROW0) >> 2, t = row & 3; if (t >= 2) { float* d = out + o_sfc + ((size_t)(l * NS + s) * 2 + (t - 2)) * NU + col; *(f32x4*)d = v; *(f32x4*)(d + 4) = w; } }
    }
};

constexpr int SBUF = 32 * 128 * 2 + 32 * 32 + 32 * 16;
__device__ __forceinline__ float* QB(float* lds, int b) { return lds + b * SBUF; }
__device__ __forceinline__ float* KB(float* lds, int b) { return lds + b * SBUF + 4096; }
__device__ __forceinline__ float* VB(float* lds, int b) { return lds + b * SBUF + 8192; }
__device__ __forceinline__ float* SCB(float* lds, int b) { return lds + b * SBUF + 9216; }
__device__ __forceinline__ float* OB(float* lds, int b) { return lds + 2 * SBUF + b * 1024; }

__device__ __forceinline__ void store_out_blk(bf16_t* P, int row0, int jb, int L, int pcol, const float* ob, int ptid) {
    const int tt = ptid >> 3, g = ptid & 7, t0 = jb * 32;
    if (t0 + tt < L) { const f32x4 v = *(const f32x4*)(ob + tt * 32 + g * 4);
        *(u32x2*)(P + (size_t)(row0 + t0 + tt) * NP + pcol + g * 4) = (u32x2){pk2(v[0], v[1]), pk2(v[2], v[3])}; }
}
__device__ __forceinline__ f32x2 lo2(f32x4 v) { return __builtin_shufflevector(v, v, 0, 1); }
__device__ __forceinline__ f32x2 hi2(f32x4 v) { return __builtin_shufflevector(v, v, 2, 3); }
__device__ __forceinline__ f32x2 bc2(float x) { return (f32x2){x, x}; }
__device__ __forceinline__ float dot16(const f32x4* a, const float* kp) {
    float s = 0.f;
#pragma unroll
    for (int i = 0; i < 4; ++i) { const f32x4 b = *(const f32x4*)(kp + 4 * i); s += (a[i][0] * b[0] + a[i][1] * b[1]) + (a[i][2] * b[2] + a[i][3] * b[3]); }
    return s;
}

struct StageRegs { f32x4 &q0, &q1, &k0, &k1, &v, &r0, &x0, &x1; };
__device__ __forceinline__ f32x4 asf(u32x4 u) { return __builtin_bit_cast(f32x4, u); }
__device__ __forceinline__ u32x4 asu(f32x4 f) { return __builtin_bit_cast(u32x4, f); }
#define BARRIER_LDS() asm volatile("s_waitcnt lgkmcnt(0)\n\ts_barrier" ::: "memory")
__device__ __forceinline__ void issue_mlstm(const Params& p, int h, int qtr, int row0, int L, int jb, int ptid, StageRegs& r) {
    const bf16_t* P = (const bf16_t*)(p.ws + OFF_P); const float* G = (const float*)(p.ws + OFF_G);
    const int tt = ptid >> 3, g = ptid & 7, t0 = jb * 32;
    if (t0 + tt >= L) return;
    const int row = row0 + t0 + tt;
    const bf16_t* prow = P + (size_t)row * NP;
    r.q0 = asf(*(const u32x4*)(prow + cQ + h * 128 + g * 16)); r.q1 = asf(*(const u32x4*)(prow + cQ + h * 128 + g * 16 + 8));
    r.k0 = asf(*(const u32x4*)(prow + cK + h * 128 + g * 16)); r.k1 = asf(*(const u32x4*)(prow + cK + h * 128 + g * 16 + 8));
    { const u32x2 vv_ = *(const u32x2*)(prow + cV + h * 128 + qtr * 32 + g * 4); r.v = asf((u32x4){vv_.x, vv_.y, 0u, 0u}); }
    if (g == 0) { const float* gr = G + (size_t)row * 16; r.r0 = (f32x4){gr[h], gr[4 + h], 0.f, 0.f}; }
}
__device__ __forceinline__ void commit_mlstm(const Params& p, int l, int h, int L, int jb, float* lds, int ptid, const StageRegs& r, int bsel = -1) {
    const int tt = ptid >> 3, g = ptid & 7, t0 = jb * 32, b = bsel >= 0 ? bsel : (jb & 1);
    if (t0 + tt >= L) return;
    float x[16]; f32x4 qs[4];
    unpack8(asu(r.q0), x); unpack8(asu(r.q1), x + 8);
    float* qd = QB(lds, b) + tt * 128 + g * 16;
#pragma unroll
    for (int i = 0; i < 4; ++i) { qs[i] = (f32x4){x[4 * i], x[4 * i + 1], x[4 * i + 2], x[4 * i + 3]} * 0.08838834764831845f; *(f32x4*)(qd + 4 * i) = qs[i]; }
    unpack8(asu(r.k0), x); unpack8(asu(r.k1), x + 8);
    float* kd = KB(lds, b) + tt * 128 + g * 16;
#pragma unroll
    for (int i = 0; i < 4; ++i) *(f32x4*)(kd + 4 * i) = (f32x4){x[4 * i], x[4 * i + 1], x[4 * i + 2], x[4 * i + 3]};
    *(f32x4*)(VB(lds, b) + tt * 32 + g * 4) = (f32x4){bflo(asu(r.v).x), bfhi(asu(r.v).x), bflo(asu(r.v).y), bfhi(asu(r.v).y)};
    const float* kmb = KB(lds, b) + (tt & ~3) * 128 + g * 16;
    f32x4 qk;
#pragma unroll
    for (int j = 0; j < 4; ++j) qk[j] = red8(dot16(qs, kmb + j * 128));
    if (g == 0) {
        const float ig = r.r0[0] + p.gate_bias[l * 8 + h], f = r.r0[1] + p.gate_bias[l * 8 + 4 + h];
        const float lf = fminf(f, 0.f) - log1pf(__expf(-fabsf(f)));
        float* sc = SCB(lds, b) + tt * 16; *(f32x2*)sc = (f32x2){ig, lf}; *(f32x4*)(sc + 4) = qk; }
}

__device__ __forceinline__ void scan_mlstm(const Params& p, int l, bool samp, int bs, int h, int qtr, int row0, int L, float* lds) {
    const int tid = opaque_tid(p.wv); const bool cons = tid < 256; const int ptid = tid - 256;
    const int lane = tid & 63, w = (tid >> 6) & 3, s = lane & 7, cl = w * 8 + (lane >> 3), col = qtr * 32 + cl;
    const int e2 = 2 * (lane >> 3), nd = (e2 >> 2) * 32 + s * 4 + (e2 & 3);
    bf16_t* P = (bf16_t*)(p.ws + OFF_P);
    f32x2 C[8]; float n0v = 0.f, n1v = 0.f, m = 0.f;
#pragma unroll
    for (int e = 0; e < 8; ++e) C[e] = bc2(0.f);
    if (cons && samp) {
        const size_t sh = (size_t)(l * NS + bs) * 4 + h;
        const float* C0 = p.st_C + sh * 16384;
#pragma unroll
        for (int e = 0; e < 16; ++e) { const int d = (e >> 2) * 32 + s * 4 + (e & 3); C[e >> 1][e & 1] = C0[d * 128 + col]; }
        n0v = p.st_n[sh * 128 + nd]; n1v = p.st_n[sh * 128 + nd + 1]; m = p.st_m[sh];
    }
    const int nblk = (L + 31) >> 5;
    f32x4 k4[4][4];
    StageRegs sr{k4[0][0], k4[0][1], k4[0][2], k4[0][3], k4[1][0], k4[1][1], k4[1][2], k4[1][3]};
    if (!cons) { issue_mlstm(p, h, qtr, row0, L, 0, ptid, sr); commit_mlstm(p, l, h, L, 0, lds, ptid, sr); if (1 < nblk) issue_mlstm(p, h, qtr, row0, L, 1, ptid, sr); }
    BARRIER_LDS();
    for (int jb = 0; jb < nblk; ++jb) {
        if (!cons) {
            if (jb + 1 < nblk) commit_mlstm(p, l, h, L, jb + 1, lds, ptid, sr);
            if (jb + 2 < nblk) issue_mlstm(p, h, qtr, row0, L, jb + 2, ptid, sr);
            if (jb > 0) store_out_blk(P, row0, jb - 1, L, cV + h * 128 + qtr * 32, OB(lds, (jb - 1) & 1), ptid);
        } else {
            const float* qb = QB(lds, jb & 1); const float* kb = KB(lds, jb & 1); const float* vb = VB(lds, jb & 1); const float* sc = SCB(lds, jb & 1);
            float* ob = OB(lds, jb & 1);
            const int nt = min(32, L - jb * 32);
            f32x4 q4[4][4]; f32x2 kn[4], qn[4]; float vv[4], ig[4], lf[4]; f32x4 qk[4];
#define MLOAD_Q(T0) do { _Pragma("unroll") for (int i = 0; i < 4; ++i) { const int t = (T0) + i; \
        _Pragma("unroll") for (int j = 0; j < 4; ++j) q4[i][j] = *(const f32x4*)(qb + t * 128 + j * 32 + s * 4); \
        qn[i] = *(const f32x2*)(qb + t * 128 + nd); } } while (0)
#define MLOAD_K(T0) do { _Pragma("unroll") for (int i = 0; i < 4; ++i) { const int t = (T0) + i; \
        const f32x2 gg = *(const f32x2*)(sc + t * 16); ig[i] = gg[0]; lf[i] = gg[1]; \
        qk[i] = *(const f32x4*)(sc + t * 16 + 4); vv[i] = vb[t * 32 + cl]; } \
      _Pragma("unroll") for (int i = 0; i < 4; ++i) { const int t = (T0) + i; \
        _Pragma("unroll") for (int j = 0; j < 4; ++j) k4[i][j] = *(const f32x4*)(kb + t * 128 + j * 32 + s * 4); \
        kn[i] = *(const f32x2*)(kb + t * 128 + nd); } } while (0)
            MLOAD_Q(0); MLOAD_K(0);
#pragma unroll 1
            for (int t0 = 0; t0 < nt; t0 += 4) {
                float d[4], dn[4];
                const int tn = min(t0 + 4, 28);
                __builtin_amdgcn_sched_barrier(0);
#pragma unroll
                for (int i = 0; i < 4; ++i) {
                    f32x2 a = bc2(0.f), a2 = bc2(0.f);
#pragma unroll
                    for (int j = 0; j < 4; ++j) { a = lo2(q4[i][j]) * C[2 * j] + a; a2 = hi2(q4[i][j]) * C[2 * j + 1] + a2; }
                    a = a + a2;
                    d[i] = a[0] + a[1]; dn[i] = qn[i][0] * n0v + qn[i][1] * n1v;
                }
                __builtin_amdgcn_sched_barrier(0);
                MLOAD_Q(tn);
                __builtin_amdgcn_sched_barrier(0);
#pragma unroll
                for (int i = 0; i < 4; ++i) { d[i] = red8(d[i]); dn[i] = red64(dn[i]); }
                float fp[4], ip[4], em[4];
#pragma unroll
                for (int i = 0; i < 4; ++i) { const float mn = fmaxf(lf[i] + m, ig[i]); fp[i] = __expf(lf[i] + m - mn); ip[i] = __expf(ig[i] - mn); em[i] = __expf(-mn); m = mn; }
                const float F0 = fp[0], F1 = F0 * fp[1], F2 = F1 * fp[2], F3 = F2 * fp[3];
                const float g00 = ip[0], g10 = g00 * fp[1], g11 = ip[1], g20 = g10 * fp[2], g21 = g11 * fp[2], g22 = ip[2];
                const float g30 = g20 * fp[3], g31 = g21 * fp[3], g32 = g22 * fp[3], g33 = ip[3];
                const float s00 = g00 * qk[0][0];
                const float s10 = g10 * qk[1][0], s11 = g11 * qk[1][1];
                const float s20 = g20 * qk[2][0], s21 = g21 * qk[2][1], s22 = g22 * qk[2][2];
                const float s30 = g30 * qk[3][0], s31 = g31 * qk[3][1], s32 = g32 * qk[3][2], s33 = g33 * qk[3][3];
                const float num0 = F0 * d[0] + s00 * vv[0], den0 = F0 * dn[0] + s00;
                const float num1 = F1 * d[1] + s10 * vv[0] + s11 * vv[1], den1 = F1 * dn[1] + s10 + s11;
                const float num2 = F2 * d[2] + s20 * vv[0] + s21 * vv[1] + s22 * vv[2], den2 = F2 * dn[2] + s20 + s21 + s22;
                const float num3 = F3 * d[3] + s30 * vv[0] + s31 * vv[1] + s32 * vv[2] + s33 * vv[3], den3 = F3 * dn[3] + s30 + s31 + s32 + s33;
                if (s == 0) {
                    ob[(t0 + 0) * 32 + cl] = num0 / fmaxf(fabsf(den0), em[0]); ob[(t0 + 1) * 32 + cl] = num1 / fmaxf(fabsf(den1), em[1]);
                    ob[(t0 + 2) * 32 + cl] = num2 / fmaxf(fabsf(den2), em[2]); ob[(t0 + 3) * 32 + cl] = num3 / fmaxf(fabsf(den3), em[3]);
                }
                const float c0 = g30 * vv[0], c1 = g31 * vv[1], c2 = g32 * vv[2], c3 = g33 * vv[3];
#pragma unroll
                for (int j = 0; j < 4; ++j) {
                    C[2 * j] = lo2(k4[3][j]) * bc2(c3) + (lo2(k4[2][j]) * bc2(c2) + (lo2(k4[1][j]) * bc2(c1) + (lo2(k4[0][j]) * bc2(c0) + C[2 * j] * bc2(F3))));
                    C[2 * j + 1] = hi2(k4[3][j]) * bc2(c3) + (hi2(k4[2][j]) * bc2(c2) + (hi2(k4[1][j]) * bc2(c1) + (hi2(k4[0][j]) * bc2(c0) + C[2 * j + 1] * bc2(F3)))); }
                n0v = n0v * F3 + (kn[0][0] * g30 + kn[1][0] * g31) + (kn[2][0] * g32 + kn[3][0] * g33);
                n1v = n1v * F3 + (kn[0][1] * g30 + kn[1][1] * g31) + (kn[2][1] * g32 + kn[3][1] * g33);
                __builtin_amdgcn_sched_barrier(0);
                MLOAD_K(tn);
            }
#undef MLOAD_Q
#undef MLOAD_K
        }
        BARRIER_LDS();
    }
    if (!cons) store_out_blk(P, row0, nblk - 1, L, cV + h * 128 + qtr * 32, OB(lds, (nblk - 1) & 1), ptid);
    else {
        const size_t sh = samp ? (size_t)(l * NS + bs) * 4 + h : (size_t)(l * NB + bs) * 4 + h;
        float* Co = p.out + (samp ? o_sC : o_pC) + sh * 16384;
#pragma unroll
        for (int e = 0; e < 16; ++e) { const int d = (e >> 2) * 32 + s * 4 + (e & 3); Co[d * 128 + col] = C[e >> 1][e & 1]; }
        if (qtr == 0 && w == 0) { float* no = p.out + (samp ? o_sn : o_pn) + sh * 128; no[nd] = n0v; no[nd + 1] = n1v;
            if (lane == 0) p.out[(samp ? o_sm : o_pm) + sh] = m; }
    }
    BARRIER_LDS();
}


constexpr int ST_LD = 33;
__device__ __forceinline__ float* STB(float* lds, int b) { return lds + 2 * SBUF + 2048 + b * (128 * ST_LD); }
__device__ __forceinline__ void st_issue(const float* S0, int qtr, int ptid, f32x4& a0, f32x4& a1, f32x4& a2, f32x4& a3) {
    const int d = ptid >> 3, c = (ptid & 7) * 4; const float* b = S0 + d * 128 + qtr * 32 + c;
    a0 = *(const f32x4*)b; a1 = *(const f32x4*)(b + 32 * 128); a2 = *(const f32x4*)(b + 64 * 128); a3 = *(const f32x4*)(b + 96 * 128);
}
__device__ __forceinline__ void st_commit(float* st, int ptid, const f32x4& a0, const f32x4& a1, const f32x4& a2, const f32x4& a3) {
    const int d = ptid >> 3, c = (ptid & 7) * 4; float* b = st + d * ST_LD + c;
#pragma unroll
    for (int i = 0; i < 4; ++i) { b[i] = a0[i]; b[32 * ST_LD + i] = a1[i]; b[64 * ST_LD + i] = a2[i]; b[96 * ST_LD + i] = a3[i]; }
}
__device__ __forceinline__ void st_store(float* So, int qtr, const float* st, int ptid) {
    const int d = ptid >> 3, c = (ptid & 7) * 4; const float* b = st + d * ST_LD + c; float* o = So + d * 128 + qtr * 32 + c;
#pragma unroll
    for (int q = 0; q < 4; ++q) *(f32x4*)(o + q * 32 * 128) = (f32x4){b[q * 32 * ST_LD], b[q * 32 * ST_LD + 1], b[q * 32 * ST_LD + 2], b[q * 32 * ST_LD + 3]};
}
__device__ __forceinline__ void scan_mlstm_stream(const Params& p, int l, int h, int qtr, int bs0, int nseq, float* lds) {
    const int tid = opaque_tid(p.wv); const bool cons = tid < 256; const int ptid = tid - 256;
    const int lane = tid & 63, w = (tid >> 6) & 3, s = lane & 7, cl = w * 8 + (lane >> 3), col = qtr * 32 + cl;
    const int e2 = 2 * (lane >> 3), nd = (e2 >> 2) * 32 + s * 4 + (e2 & 3);
    bf16_t* P = (bf16_t*)(p.ws + OFF_P);
    f32x2 C[8]; float n0v = 0.f, n1v = 0.f, m = 0.f, n0n = 0.f, n1n = 0.f, mnx = 0.f;
#pragma unroll
    for (int e = 0; e < 8; ++e) C[e] = bc2(0.f);
    f32x4 k4[4][4];
    StageRegs sr{k4[0][0], k4[0][1], k4[0][2], k4[0][3], k4[1][0], k4[1][1], k4[1][2], k4[1][3]};
#define LOADSTATE(BS) do { const size_t sh_ = (size_t)(l * NS + (BS)) * 4 + h; n0n = p.st_n[sh_ * 128 + nd]; n1n = p.st_n[sh_ * 128 + nd + 1]; mnx = p.st_m[sh_]; } while (0)
#define STISSUE(BS) st_issue(p.st_C + ((size_t)(l * NS + (BS)) * 4 + h) * 16384, qtr, ptid, k4[2][0], k4[2][1], k4[2][2], k4[2][3])
    if (!cons) { issue_mlstm(p, h, qtr, SROW0 + bs0 * 4, LS, 0, ptid, sr); STISSUE(bs0); } else LOADSTATE(bs0);
#pragma unroll 1
    for (int k = 0; k < nseq; ++k) {
        const int bs = bs0 + 8 * k, row0 = SROW0 + bs * 4;
        if (!cons) { commit_mlstm(p, l, h, LS, 0, lds, ptid, sr, k & 1); st_commit(STB(lds, k & 1), ptid, k4[2][0], k4[2][1], k4[2][2], k4[2][3]);
            if (k + 1 < nseq) { issue_mlstm(p, h, qtr, row0 + 32, LS, 0, ptid, sr); STISSUE(bs + 8); } }
        else {
            n0v = n0n; n1v = n1n; m = mnx;
            if (k + 1 < nseq) LOADSTATE(bs + 8);
        }
        BARRIER_LDS();
        if (!cons) { if (k > 0) { store_out_blk(P, row0 - 32, 0, LS, cV + h * 128 + qtr * 32, OB(lds, (k - 1) & 1), ptid); st_store(p.out + o_sC + ((size_t)(l * NS + bs - 8) * 4 + h) * 16384, qtr, STB(lds, (k - 1) & 1), ptid); } }
        else {
            const float* qb = QB(lds, k & 1); const float* kb = KB(lds, k & 1); const float* vb = VB(lds, k & 1); const float* sc = SCB(lds, k & 1);
            float* ob = OB(lds, k & 1); float* stb = STB(lds, k & 1);
#pragma unroll
            for (int e = 0; e < 16; ++e) { const int d = (e >> 2) * 32 + s * 4 + (e & 3); C[e >> 1][e & 1] = stb[d * ST_LD + cl]; }
            f32x4 q4[4][4]; f32x2 kn[4], qn[4]; float vv[4], ig[4], lf[4]; f32x4 qk[4];
#define MLOAD_Q(T0) do { _Pragma("unroll") for (int i = 0; i < 4; ++i) { const int t = (T0) + i; \
        _Pragma("unroll") for (int j = 0; j < 4; ++j) q4[i][j] = *(const f32x4*)(qb + t * 128 + j * 32 + s * 4); \
        qn[i] = *(const f32x2*)(qb + t * 128 + nd); } } while (0)
#define MLOAD_K(T0) do { _Pragma("unroll") for (int i = 0; i < 4; ++i) { const int t = (T0) + i; \
        const f32x2 gg = *(const f32x2*)(sc + t * 16); ig[i] = gg[0]; lf[i] = gg[1]; \
        qk[i] = *(const f32x4*)(sc + t * 16 + 4); vv[i] = vb[t * 32 + cl]; } \
      _Pragma("unroll") for (int i = 0; i < 4; ++i) { const int t = (T0) + i; \
        _Pragma("unroll") for (int j = 0; j < 4; ++j) k4[i][j] = *(const f32x4*)(kb + t * 128 + j * 32 + s * 4); \
        kn[i] = *(const f32x2*)(kb + t * 128 + nd); } } while (0)
            MLOAD_Q(0); MLOAD_K(0);
            {
                float d[4], dn[4];
                __builtin_amdgcn_sched_barrier(0);
#pragma unroll
                for (int i = 0; i < 4; ++i) {
                    f32x2 a = bc2(0.f), a2 = bc2(0.f);
#pragma unroll
                    for (int j = 0; j < 4; ++j) { a = lo2(q4[i][j]) * C[2 * j] + a; a2 = hi2(q4[i][j]) * C[2 * j + 1] + a2; }
                    a = a + a2;
                    d[i] = a[0] + a[1]; dn[i] = qn[i][0] * n0v + qn[i][1] * n1v;
                }
                __builtin_amdgcn_sched_barrier(0);
#pragma unroll
                for (int i = 0; i < 4; ++i) { d[i] = red8(d[i]); dn[i] = red64(dn[i]); }
                float fp[4], ip[4], em[4];
#pragma unroll
                for (int i = 0; i < 4; ++i) { const float mn = fmaxf(lf[i] + m, ig[i]); fp[i] = __expf(lf[i] + m - mn); ip[i] = __expf(ig[i] - mn); em[i] = __expf(-mn); m = mn; }
                const float F0 = fp[0], F1 = F0 * fp[1], F2 = F1 * fp[2], F3 = F2 * fp[3];
                const float g00 = ip[0], g10 = g00 * fp[1], g11 = ip[1], g20 = g10 * fp[2], g21 = g11 * fp[2], g22 = ip[2];
                const float g30 = g20 * fp[3], g31 = g21 * fp[3], g32 = g22 * fp[3], g33 = ip[3];
                const float s00 = g00 * qk[0][0];
                const float s10 = g10 * qk[1][0], s11 = g11 * qk[1][1];
                const float s20 = g20 * qk[2][0], s21 = g21 * qk[2][1], s22 = g22 * qk[2][2];
                const float s30 = g30 * qk[3][0], s31 = g31 * qk[3][1], s32 = g32 * qk[3][2], s33 = g33 * qk[3][3];
                const float num0 = F0 * d[0] + s00 * vv[0], den0 = F0 * dn[0] + s00;
                const float num1 = F1 * d[1] + s10 * vv[0] + s11 * vv[1], den1 = F1 * dn[1] + s10 + s11;
                const float num2 = F2 * d[2] + s20 * vv[0] + s21 * vv[1] + s22 * vv[2], den2 = F2 * dn[2] + s20 + s21 + s22;
                const float num3 = F3 * d[3] + s30 * vv[0] + s31 * vv[1] + s32 * vv[2] + s33 * vv[3], den3 = F3 * dn[3] + s30 + s31 + s32 + s33;
                if (s == 0) {
                    ob[0 * 32 + cl] = num0 / fmaxf(fabsf(den0), em[0]); ob[1 * 32 + cl] = num1 / fmaxf(fabsf(den1), em[1]);
                    ob[2 * 32 + cl] = num2 / fmaxf(fabsf(den2), em[2]); ob[3 * 32 + cl] = num3 / fmaxf(fabsf(den3), em[3]);
                }
                const float c0 = g30 * vv[0], c1 = g31 * vv[1], c2 = g32 * vv[2], c3 = g33 * vv[3];
#pragma unroll
                for (int j = 0; j < 4; ++j) {
                    C[2 * j] = lo2(k4[3][j]) * bc2(c3) + (lo2(k4[2][j]) * bc2(c2) + (lo2(k4[1][j]) * bc2(c1) + (lo2(k4[0][j]) * bc2(c0) + C[2 * j] * bc2(F3))));
                    C[2 * j + 1] = hi2(k4[3][j]) * bc2(c3) + (hi2(k4[2][j]) * bc2(c2) + (hi2(k4[1][j]) * bc2(c1) + (hi2(k4[0][j]) * bc2(c0) + C[2 * j + 1] * bc2(F3)))); }
                n0v = n0v * F3 + (kn[0][0] * g30 + kn[1][0] * g31) + (kn[2][0] * g32 + kn[3][0] * g33);
                n1v = n1v * F3 + (kn[0][1] * g30 + kn[1][1] * g31) + (kn[2][1] * g32 + kn[3][1] * g33);
            }
#undef MLOAD_Q
#undef MLOAD_K
            const size_t sh = (size_t)(l * NS + bs) * 4 + h;
#pragma unroll
            for (int e = 0; e < 16; ++e) { const int d = (e >> 2) * 32 + s * 4 + (e & 3); stb[d * ST_LD + cl] = C[e >> 1][e & 1]; }
            if (qtr == 0 && w == 0) { float* no = p.out + o_sn + sh * 128; no[nd] = n0v; no[nd + 1] = n1v; if (lane == 0) p.out[o_sm + sh] = m; }
        }
    }
    BARRIER_LDS();
    if (!cons) { store_out_blk(P, SROW0 + (bs0 + 8 * (nseq - 1)) * 4, 0, LS, cV + h * 128 + qtr * 32, OB(lds, (nseq - 1) & 1), ptid); st_store(p.out + o_sC + ((size_t)(l * NS + bs0 + 8 * (nseq - 1)) * 4 + h) * 16384, qtr, STB(lds, (nseq - 1) & 1), ptid); }
    BARRIER_LDS();
#undef LOADSTATE
#undef STISSUE
}


typedef float f32x16 __attribute__((ext_vector_type(16)));
#define MFMA32(a, b, c) __builtin_amdgcn_mfma_f32_32x32x16_bf16((a), (b), (c), 0, 0, 0)
__device__ __forceinline__ int crow(int reg, int hf) { return (reg & 3) + 8 * (reg >> 2) + 4 * hf; }
__device__ __forceinline__ bf16x8 pack_step(const f32x16& x, int s) {
    u32x4 pk;
    asm volatile("s_nop 7\n\ts_nop 3\n\tv_cvt_pk_bf16_f32 %0, %4, %5\n\tv_cvt_pk_bf16_f32 %1, %6, %7\n\tv_cvt_pk_bf16_f32 %2, %8, %9\n\tv_cvt_pk_bf16_f32 %3, %10, %11\n\ts_nop 1"
                 : "=&v"(pk[0]), "=&v"(pk[1]), "=&v"(pk[2]), "=&v"(pk[3])
                 : "v"(x[8 * s]), "v"(x[8 * s + 1]), "v"(x[8 * s + 2]), "v"(x[8 * s + 3]), "v"(x[8 * s + 4]), "v"(x[8 * s + 5]), "v"(x[8 * s + 6]), "v"(x[8 * s + 7]));
    return __builtin_bit_cast(bf16x8, pk);
}
__device__ __forceinline__ bf16x8 frag_n(const bf16_t* base, int ld, int r, int hf, int kb) { return *(const bf16x8*)(base + r * ld + kb * 16 + hf * 8); }
__device__ __forceinline__ bf16x8 frag_p(const bf16_t* base, int ld, int r, int hf, int k0) {
    const u32x2 a = *(const u32x2*)(base + r * ld + k0 + 4 * hf), b = *(const u32x2*)(base + r * ld + k0 + 8 + 4 * hf);
    return __builtin_bit_cast(bf16x8, (u32x4){a.x, a.y, b.x, b.y});
}
__device__ __forceinline__ int kto(int d) { return d * 40 + (d >> 4) * 8; }
__device__ __forceinline__ bf16_t f2bf(float x) { return (bf16_t)(pk2(x, 0.f) & 0xffffu); }

constexpr int CH_LDQ = 136, CH_LDS = 40;
constexpr int CH_QB = 0, CH_KB = 8704, CH_KWT = 17408, CH_VT = 27904, CH_SW = 33024, CH_SC = 35584, CH_QW = 36608, CH_SLOT = 45312, CH_OB = 2 * CH_SLOT;
constexpr int SC_U = 0, SC_B = 32, SC_PM = 64;

__device__ __forceinline__ void store_out_norm(bf16_t* P, int row0, int jb, int L, int pcol, const float* ob, const float* rd, int ptid) {
    const int tt = ptid >> 3, g = ptid & 7, t0 = jb * 32;
    if (t0 + tt < L) { const f32x4 v = *(const f32x4*)(ob + tt * 32 + g * 4) * rd[tt];
        *(u32x2*)(P + (size_t)(row0 + t0 + tt) * NP + pcol + g * 4) = (u32x2){pk2(v[0], v[1]), pk2(v[2], v[3])}; }
}
__device__ __forceinline__ void issue_mlstm_chunk(const Params& p, int h, int qtr, int row0, int L, int nch, int jb, int ptid, StageRegs& r) {
    if (jb >= nch) return;
    const bf16_t* P = (const bf16_t*)(p.ws + OFF_P); const float* REC = (const float*)(p.ws + OFF_REC);
    const int tt = ptid >> 3, g = ptid & 7, t0 = jb * 32;
    const int row = row0 + t0 + tt;
    if (g == 0) r.r0 = *(const f32x4*)(REC + ((size_t)row * 4 + h) * 16 + 4);
    if (t0 + tt >= L) return;
    const bf16_t* prow = P + (size_t)row * NP;
    r.q0 = asf(*(const u32x4*)(prow + cQ + h * 128 + g * 16)); r.q1 = asf(*(const u32x4*)(prow + cQ + h * 128 + g * 16 + 8));
    r.k0 = asf(*(const u32x4*)(prow + cK + h * 128 + g * 16)); r.k1 = asf(*(const u32x4*)(prow + cK + h * 128 + g * 16 + 8));
    { const u32x2 vv_ = *(const u32x2*)(prow + cV + h * 128 + qtr * 32 + g * 4); r.v = asf((u32x4){vv_.x, vv_.y, 0u, 0u}); }
}

__device__ __forceinline__ void scan_mlstm_chunk(const Params& p, int l, int bs, int h, int qtr, int row0, int L, unsigned char* lb) {
    const int tid = opaque_tid(p.wv); const int wave = tid >> 6, lane = tid & 63, r = lane & 31, hf = lane >> 5, ptid = tid - 256;
    bf16_t* P = (bf16_t*)(p.ws + OFF_P);
    const int nch = (L + 31) >> 5;
    f32x16 C[4];
    const int ct = wave == 3 ? 1 : 0;
#pragma unroll
    for (int dt = 0; dt < 4; ++dt)
#pragma unroll
        for (int i = 0; i < 16; ++i) C[dt][i] = 0.f;
    float m0 = 0.f;
    f32x4 s0, s1, s2, s3, s4, s5, s6, s7; StageRegs sr{s0, s1, s2, s3, s4, s5, s6, s7};
    if (wave >= 4) { for (int i = ptid; i < 2 * 32 * CH_LDS; i += 256) { const int sl = i / (32 * CH_LDS), e = i % (32 * CH_LDS);
            ((bf16_t*)(lb + sl * CH_SLOT + CH_VT))[32 * CH_LDS + e] = (e < CH_LDS) ? (bf16_t)0x3f80 : (bf16_t)0; } }
#define CH_P1(JN) do { const int jn_ = (JN); unsigned char* sl_ = lb + (jn_ & 1) * CH_SLOT; const int tt = ptid >> 3, g = ptid & 7; const bool val_ = jn_ * 32 + tt < L; \
        u32x4 q0_ = asu(sr.q0), q1_ = asu(sr.q1), k0_ = asu(sr.k0), k1_ = asu(sr.k1); u32x4 v_ = asu(sr.v); \
        if (!val_) { q0_ = q1_ = k0_ = k1_ = v_ = (u32x4){0u, 0u, 0u, 0u}; } \
        *(u32x4*)(sl_ + CH_QB + (tt * CH_LDQ + g * 16) * 2) = q0_; *(u32x4*)(sl_ + CH_QB + (tt * CH_LDQ + g * 16 + 8) * 2) = q1_; \
        *(u32x4*)(sl_ + CH_KB + (tt * CH_LDQ + g * 16) * 2) = k0_; *(u32x4*)(sl_ + CH_KB + (tt * CH_LDQ + g * 16 + 8) * 2) = k1_; \
        bf16_t* vt_ = (bf16_t*)(sl_ + CH_VT); \
        vt_[(g * 4 + 0) * CH_LDS + tt] = (bf16_t)(v_.x & 0xffffu); vt_[(g * 4 + 1) * CH_LDS + tt] = (bf16_t)(v_.x >> 16); \
        vt_[(g * 4 + 2) * CH_LDS + tt] = (bf16_t)(v_.y & 0xffffu); vt_[(g * 4 + 3) * CH_LDS + tt] = (bf16_t)(v_.y >> 16); \
        if (g == 0) { float* sc_ = (float*)(sl_ + CH_SC); sc_[SC_U + tt] = sr.r0[0]; sc_[SC_B + tt] = sr.r0[1]; sc_[SC_PM + tt] = sr.r0[2]; } \
        issue_mlstm_chunk(p, h, qtr, row0, L, nch, jn_ + 1, ptid, sr); } while (0)
#define CH_P2(JN) do { unsigned char* sl_ = lb + ((JN) & 1) * CH_SLOT; const float* sc_ = (const float*)(sl_ + CH_SC); \
        const float bT_ = sc_[SC_B + 31], mT_ = bT_ + fmaxf(m0, sc_[SC_PM + 31]); \
        if (wave == 1) { f32x16 a_; _Pragma("unroll") for (int i = 0; i < 16; ++i) a_[i] = 0.f; \
            _Pragma("unroll") for (int kb = 0; kb < 8; ++kb) a_ = MFMA32(frag_n((const bf16_t*)(sl_ + CH_QB), CH_LDQ, r, hf, kb), frag_n((const bf16_t*)(sl_ + CH_KB), CH_LDQ, r, hf, kb), a_); \
            bf16_t* sw_ = (bf16_t*)(sl_ + CH_SW); const float us_ = sc_[SC_U + r]; \
            _Pragma("unroll") for (int i4 = 0; i4 < 4; ++i4) { const f32x4 pm4 = *(const f32x4*)(sc_ + SC_PM + 8 * i4 + 4 * hf); \
                _Pragma("unroll") for (int ii = 0; ii < 4; ++ii) { const int t = 8 * i4 + 4 * hf + ii; const float w_ = (r <= t) ? __expf(us_ - fmaxf(m0, pm4[ii])) * 0.08838834764831845f : 0.f; \
                    sw_[t * CH_LDS + r] = f2bf(a_[4 * i4 + ii] * w_); } } } \
        else if (wave >= 4) { const int tt = ptid >> 3, g = ptid & 7; \
            const float wi_ = __expf(m0 - fmaxf(m0, sc_[SC_PM + tt])) * 0.08838834764831845f, ws_ = __expf(sc_[SC_U + tt] + bT_ - mT_); float x_[16]; \
            u32x4* qp_ = (u32x4*)(sl_ + CH_QB + (tt * CH_LDQ + g * 16) * 2); unpack8(qp_[0], x_); unpack8(qp_[1], x_ + 8); \
            _Pragma("unroll") for (int i = 0; i < 16; ++i) x_[i] *= wi_; \
            u32x4* qo_ = (u32x4*)(sl_ + CH_QW + (tt * CH_LDQ + g * 16) * 2); qo_[0] = pack8(x_); qo_[1] = pack8(x_ + 8); \
            const u32x4* kp_ = (const u32x4*)(sl_ + CH_KB + (tt * CH_LDQ + g * 16) * 2); unpack8(kp_[0], x_); unpack8(kp_[1], x_ + 8); \
            bf16_t* kw_ = (bf16_t*)(sl_ + CH_KWT); \
            _Pragma("unroll") for (int i = 0; i < 16; ++i) kw_[kto(g * 16) + i * CH_LDS + tt] = f2bf(x_[i] * ws_); } \
        if (wave == 1 || wave >= 4) m0 = mT_; } while (0)
    if (wave >= 4) { issue_mlstm_chunk(p, h, qtr, row0, L, nch, 0, ptid, sr); CH_P1(0); }
    BARRIER_LDS();
    CH_P2(0);
    BARRIER_LDS();
#pragma unroll 1
    for (int j = 0; j < nch; ++j) {
        if (wave == 0 || wave == 3) {
            const unsigned char* sl = lb + (j & 1) * CH_SLOT; const float* sc = (const float*)(sl + CH_SC);
            const bf16_t* qw = (const bf16_t*)(sl + CH_QW); const bf16_t* sw = (const bf16_t*)(sl + CH_SW); const bf16_t* vt = (const bf16_t*)(sl + CH_VT) + ct * 32 * CH_LDS; const bf16_t* kwt = (const bf16_t*)(sl + CH_KWT);
            const float bT = sc[SC_B + 31], mT = bT + fmaxf(m0, sc[SC_PM + 31]);
            f32x16 H;
#pragma unroll
            for (int i = 0; i < 16; ++i) H[i] = 0.f;
#pragma unroll
            for (int dt = 0; dt < 4; ++dt)
#pragma unroll
                for (int u = 0; u < 2; ++u) H = MFMA32(frag_p(qw, CH_LDQ, r, hf, 32 * dt + 16 * u), pack_step(C[dt], u), H);
            bf16x8 vb[2];
#pragma unroll
            for (int kb = 0; kb < 2; ++kb) { vb[kb] = frag_n(vt, CH_LDS, r, hf, kb); H = MFMA32(frag_n(sw, CH_LDS, r, hf, kb), vb[kb], H); }
            const float wold = __expf(bT - mT + m0);
#pragma unroll
            for (int dt = 0; dt < 4; ++dt) {
#pragma unroll
                for (int i = 0; i < 16; ++i) C[dt][i] *= wold;
#pragma unroll
                for (int kb = 0; kb < 2; ++kb) C[dt] = MFMA32(frag_n(kwt + kto(dt * 32 + r), 0, 0, hf, kb), vb[kb], C[dt]);
            }
            float* ob = (float*)(lb + CH_OB) + (j & 1) * 1024; float* rd = (float*)(lb + CH_OB + 8192) + (j & 1) * 32;
            if (ct == 0) {
#pragma unroll
                for (int i = 0; i < 16; ++i) ob[crow(i, hf) * 32 + r] = H[i];
            } else if (r == 0) {
#pragma unroll
                for (int i = 0; i < 16; ++i) { const int t = crow(i, hf); rd[t] = __builtin_amdgcn_rcpf(fmaxf(fabsf(H[i]), __expf(-(sc[SC_B + t] + fmaxf(m0, sc[SC_PM + t]))))); }
            }
            m0 = mT;
        } else if (wave >= 4) {
            if (j + 1 < nch) CH_P1(j + 1);
            if (j > 0) store_out_norm(P, row0, j - 1, L, cV + h * 128 + qtr * 32, (const float*)(lb + CH_OB) + ((j - 1) & 1) * 1024, (const float*)(lb + CH_OB + 8192) + ((j - 1) & 1) * 32, ptid);
        }
        BARRIER_LDS();
        if (j + 1 < nch) CH_P2(j + 1);
        BARRIER_LDS();
    }
    if (wave >= 4) store_out_norm(P, row0, nch - 1, L, cV + h * 128 + qtr * 32, (const float*)(lb + CH_OB) + ((nch - 1) & 1) * 1024, (const float*)(lb + CH_OB + 8192) + ((nch - 1) & 1) * 32, ptid);
    const size_t sh = (size_t)(l * NB + bs) * 4 + h;
    if (wave == 0) {
        float* Co = p.out + o_pC + sh * 16384;
#pragma unroll
        for (int dt = 0; dt < 4; ++dt)
#pragma unroll
            for (int i = 0; i < 16; ++i) Co[(32 * dt + crow(i, hf)) * 128 + qtr * 32 + r] = C[dt][i];
        if (lane == 0 && qtr == 0) p.out[o_pm + sh] = m0;
    } else if (wave == 3 && r == 0 && qtr == 0) {
#pragma unroll
        for (int dt = 0; dt < 4; ++dt)
#pragma unroll
            for (int i = 0; i < 16; ++i) p.out[o_pn + sh * 128 + 32 * dt + crow(i, hf)] = C[dt][i];
    }
    __syncthreads();
#undef CH_P1
#undef CH_P2
}

__device__ __forceinline__ void gdn_raw8(const bf16_t* P, int r0, int tr, int pcol, const bf16_t* gh, const float* st, int hch, float* x) {
    if (tr >= 0) unpack8(*(const u32x4*)(P + (size_t)(r0 + tr) * NP + pcol), x);
    else if (gh) unpack8(*(const u32x4*)(gh + (3 + tr) * 1536 + hch), x);
    else if (st) { const float* hp = st + (3 + tr) * 1536 + hch; const f32x4 a = *(const f32x4*)hp, b = *(const f32x4*)(hp + 4);
        x[0] = a[0]; x[1] = a[1]; x[2] = a[2]; x[3] = a[3]; x[4] = b[0]; x[5] = b[1]; x[6] = b[2]; x[7] = b[3]; }
    else {
#pragma unroll
        for (int i = 0; i < 8; ++i) x[i] = 0.f; }
}
__device__ __forceinline__ void gdn_conv8(const bf16_t* P, int r0, int tr, int pcol, const bf16_t* gh, const float* st, int hch, const float* cw, float* y) {
#pragma unroll
    for (int i = 0; i < 8; ++i) y[i] = 0.f;
#pragma unroll
    for (int j = 0; j < 4; ++j) { float x[8]; gdn_raw8(P, r0, tr - 3 + j, pcol, gh, st, hch, x);
        const f32x4 w0 = *(const f32x4*)(cw + j * 1536 + hch), w1 = *(const f32x4*)(cw + j * 1536 + hch + 4);
        y[0] += x[0] * w0[0]; y[1] += x[1] * w0[1]; y[2] += x[2] * w0[2]; y[3] += x[3] * w0[3];
        y[4] += x[4] * w1[0]; y[5] += x[5] * w1[1]; y[6] += x[6] * w1[2]; y[7] += x[7] * w1[3]; }
#pragma unroll
    for (int i = 0; i < 8; ++i) y[i] = y[i] * sigmoidf_(y[i]);
}

__device__ __forceinline__ void phase_prep(const Params& p, int l, float* lds) {
    const int tid = opaque_tid(p.wv); const int half = tid >> 8, t = tid & 255, tt = t >> 3, g = t & 7, wq = t >> 6, lane = t & 63, r = lane & 31, hf = lane >> 5;
    bf16_t* P = (bf16_t*)(p.ws + OFF_P); const bf16_t* GH = (const bf16_t*)(p.ws + OFF_GH);
    const float* G = (const float*)(p.ws + OFF_G); float* REC = (float*)(p.ws + OFF_REC); bf16_t* TB = (bf16_t*)(p.ws + OFF_TB);
    const float* cw = p.gconv_w + (size_t)l * 4 * 1536;
    float* ksc = lds + half * 4096;
    unsigned char* pl = (unsigned char*)lds + 32768 + half * 22016;
    bf16_t* kimg = (bf16_t*)pl; bf16_t* qimg = (bf16_t*)(pl + 8704); float* am = (float*)(pl + 17408); float* sgl = (float*)(pl + 21504); float* sbe = sgl + 32; float* sG = sgl + 64;
    constexpr int NITEM = (MROWS / 32) * 4;
    for (int base = blockIdx.x * 2; base < NITEM; base += gridDim.x * 2) {
        const int item = base + half; const bool act = item < NITEM;
        const int rb = item >> 2, h = item & 3, r0 = rb * 32;
        const bool samp = rb >= SROW0 / 32;
        int tr = tt; const bf16_t* gh = nullptr; const float* st = nullptr; int rbase = r0; bool valid = act;
        if (!samp) { const int jb = rb % (LPAD / 32); if (jb * 32 + tt >= LP) valid = false; if (jb > 0) gh = GH + (size_t)(rb - 1) * 3 * 1536; }
        else { const int sq = (rb - SROW0 / 32) * 8 + (tt >> 2); tr = tt & 3; rbase = r0 + (tt & ~3); st = p.st_gconv + (size_t)(l * NS + sq) * 3 * 1536; }
        const int ch = h * 128 + g * 16;
        u32x4 oq0 = (u32x4){0u, 0u, 0u, 0u}, oq1 = oq0, ok0 = oq0, ok1 = oq0, ov0 = oq0, ov1 = oq0;
        float ga = 0.f, gb = 0.f, gg = 0.f;
        if (valid) {
            float y[16];
            gdn_conv8(P, rbase, tr, cBV + ch, gh, st, 1024 + ch, cw, y); gdn_conv8(P, rbase, tr, cBV + ch + 8, gh, st, 1024 + ch + 8, cw, y + 8);
            ov0 = pack8(y); ov1 = pack8(y + 8);
            __builtin_amdgcn_sched_barrier(0);
            gdn_conv8(P, rbase, tr, cBQ + ch, gh, st, ch, cw, y); gdn_conv8(P, rbase, tr, cBQ + ch + 8, gh, st, ch + 8, cw, y + 8);
            float ss = 0.f;
#pragma unroll
            for (int i = 0; i < 16; ++i) ss += y[i] * y[i];
            float rs = rsqrtf(red8(ss) + 1e-6f) * 0.08838834764831845f;
#pragma unroll
            for (int i = 0; i < 16; ++i) y[i] *= rs;
            oq0 = pack8(y); oq1 = pack8(y + 8);
            __builtin_amdgcn_sched_barrier(0);
            gdn_conv8(P, rbase, tr, cBK + ch, gh, st, 512 + ch, cw, y); gdn_conv8(P, rbase, tr, cBK + ch + 8, gh, st, 512 + ch + 8, cw, y + 8);
            ss = 0.f;
#pragma unroll
            for (int i = 0; i < 16; ++i) ss += y[i] * y[i];
            rs = rsqrtf(red8(ss) + 1e-6f);
#pragma unroll
            for (int i = 0; i < 16; ++i) y[i] *= rs;
            ok0 = pack8(y); ok1 = pack8(y + 8);
            unpack8(ok0, y); unpack8(ok1, y + 8);
#pragma unroll
            for (int i = 0; i < 4; ++i) *(f32x4*)(ksc + tt * 128 + g * 16 + 4 * i) = (f32x4){y[4 * i], y[4 * i + 1], y[4 * i + 2], y[4 * i + 3]};
            if (g == 0) { const float* gr = G + (size_t)(r0 + tt) * 16;
                gb = sigmoidf_(gr[8 + h]);
                const float xa = gr[12 + h] + p.dt_bias[l * 4 + h];
                const float sp = fmaxf(xa, 0.f) + log1pf(__expf(-fabsf(xa)));
                gg = -__expf(p.A_log[l * 4 + h]) * sp; ga = __expf(gg); }
        }
        if (!samp) {
            *(u32x4*)(kimg + tt * CH_LDQ + g * 16) = ok0; *(u32x4*)(kimg + tt * CH_LDQ + g * 16 + 8) = ok1;
            *(u32x4*)(qimg + tt * CH_LDQ + g * 16) = oq0; *(u32x4*)(qimg + tt * CH_LDQ + g * 16 + 8) = oq1;
            if (g == 0) { sgl[tt] = gg; sbe[tt] = gb; }
        }
        __syncthreads();
        f32x16 pacc;
#pragma unroll
        for (int i = 0; i < 16; ++i) pacc[i] = 0.f;
        float myG = 0.f, totG = 0.f;
        if (valid) {
            bf16_t* pr = P + (size_t)(r0 + tt) * NP;
            *(u32x4*)(pr + cBQ + ch) = oq0; *(u32x4*)(pr + cBQ + ch + 8) = oq1; *(u32x4*)(pr + cBK + ch) = ok0; *(u32x4*)(pr + cBK + ch + 8) = ok1;
            *(u32x4*)(pr + cBV + ch) = ov0; *(u32x4*)(pr + cBV + ch + 8) = ov1;
        }
        if (samp) {
            if (valid) {
                const float* kmb = ksc + (tt & ~3) * 128 + g * 16;
                f32x4 qk, kk, qs[4], ks[4];
                { float y[16]; unpack8(oq0, y); unpack8(oq1, y + 8);
#pragma unroll
                  for (int i = 0; i < 4; ++i) qs[i] = (f32x4){y[4 * i], y[4 * i + 1], y[4 * i + 2], y[4 * i + 3]};
                  unpack8(ok0, y); unpack8(ok1, y + 8);
#pragma unroll
                  for (int i = 0; i < 4; ++i) ks[i] = (f32x4){y[4 * i], y[4 * i + 1], y[4 * i + 2], y[4 * i + 3]}; }
#pragma unroll
                for (int j = 0; j < 4; ++j) { qk[j] = red8(dot16(qs, kmb + j * 128)); kk[j] = red8(dot16(ks, kmb + j * 128)); }
                if (g == 0) { float* rec = REC + ((size_t)(r0 + tt) * 4 + h) * 16; *(f32x4*)rec = (f32x4){ga, gb, gg, 0.f}; *(f32x4*)(rec + 4) = qk; *(f32x4*)(rec + 8) = kk; }
            }
        } else if (act) {
            if (wq < 2) {
                const bf16_t* ai = wq == 0 ? kimg : qimg;
#pragma unroll
                for (int kb = 0; kb < 8; ++kb) pacc = MFMA32(frag_n(ai, CH_LDQ, r, hf, kb), frag_n(kimg, CH_LDQ, r, hf, kb), pacc);
            } else if (wq == 2) {
                const float gm = sgl[r]; float cum = 0.f;
#pragma unroll
                for (int t2 = 0; t2 < 32; ++t2) { cum += rdl(gm, t2); if (r == t2) myG = cum; }
                totG = cum;
                if (lane < 32) sG[r] = myG;
                if (lane == 0) sG[32] = cum;
            }
        }
        __syncthreads();
        if (!samp && act) {
            bf16_t* tb = TB + (size_t)item * 3072;
            if (wq == 0) {
                const float Gs_ = sG[r]; float* ag = (float*)tb;
#pragma unroll
                for (int i4 = 0; i4 < 4; ++i4) { const f32x4 G4 = *(const f32x4*)(sG + 8 * i4 + 4 * hf), b4 = *(const f32x4*)(sbe + 8 * i4 + 4 * hf);
#pragma unroll
                    for (int ii = 0; ii < 4; ++ii) { const int t2 = 8 * i4 + 4 * hf + ii; ag[t2 * 32 + r] = (r < t2) ? b4[ii] * pacc[4 * i4 + ii] * __expf(G4[ii] - Gs_) : 0.f; } }
            } else if (wq == 1) {
                const float Gs_ = sG[r];
#pragma unroll
                for (int i4 = 0; i4 < 4; ++i4) { const f32x4 G4 = *(const f32x4*)(sG + 8 * i4 + 4 * hf);
#pragma unroll
                    for (int ii = 0; ii < 4; ++ii) { const int t2 = 8 * i4 + 4 * hf + ii; tb[2048 + t2 * 32 + r] = f2bf((r <= t2) ? pacc[4 * i4 + ii] * __expf(G4[ii] - Gs_) : 0.f); } }
            }
            if (valid && g == 0) { const float Gt = sG[tt], GT = sG[32];
                float* rec = REC + ((size_t)(r0 + tt) * 4 + h) * 16; *(f32x4*)rec = (f32x4){ga, gb, gg, Gt}; *(f32x4*)(rec + 12) = (f32x4){GT - Gt, GT, 0.f, 0.f}; }
        }
        __syncthreads();
    }
    asm volatile("s_waitcnt vmcnt(0)" ::: "memory");
    __syncthreads();
    { const int wv_ = tid >> 6; float* am = lds + wv_ * 1024;
      int nmine = 0;
      for (int base = blockIdx.x * 2; base < NITEM; base += gridDim.x * 2) nmine += 2;
      for (int idx = wv_; idx < nmine; idx += 8) {
        const int item = blockIdx.x * 2 + (idx >> 1) * gridDim.x * 2 + (idx & 1);
        const int rb = item >> 2, h = item & 3;
        if (item >= NITEM || rb >= SROW0 / 32) continue;
        bf16_t* tb = TB + (size_t)item * 3072; const float* ag = (const float*)tb;
#pragma unroll
        for (int q = 0; q < 4; ++q) *(f32x4*)(am + q * 256 + lane * 4) = *(const f32x4*)(ag + q * 256 + lane * 4);
        const float* rec = REC + ((size_t)(rb * 32 + r) * 4 + h) * 16;
        const bool rv = (rb % (LPAD / 32)) * 32 + r < LP;
        const float bs_ = rv ? rec[1] : 0.f, bg_ = rv ? bs_ * __expf(rec[3]) : 0.f;
        asm volatile("s_waitcnt vmcnt(0) lgkmcnt(0)" ::: "memory");
        float Tc[32];
#pragma unroll
        for (int t2 = 0; t2 < 32; ++t2) { float v0 = 0.f, v1 = 0.f, v2 = 0.f, v3 = 0.f;
#pragma unroll
            for (int q4 = 0; q4 < (t2 + 3) / 4; ++q4) { const f32x4 a4 = *(const f32x4*)(am + t2 * 32 + q4 * 4);
                if (q4 * 4 + 0 < t2) v0 += a4[0] * Tc[q4 * 4 + 0]; if (q4 * 4 + 1 < t2) v1 += a4[1] * Tc[q4 * 4 + 1];
                if (q4 * 4 + 2 < t2) v2 += a4[2] * Tc[q4 * 4 + 2]; if (q4 * 4 + 3 < t2) v3 += a4[3] * Tc[q4 * 4 + 3]; }
            Tc[t2] = ((r == t2) ? 1.f : 0.f) - ((v0 + v1) + (v2 + v3)); }
        if (hf == 0) {
#pragma unroll
            for (int t2 = 0; t2 < 32; ++t2) { tb[t2 * 32 + r] = f2bf(Tc[t2] * bs_); tb[1024 + t2 * 32 + r] = f2bf(Tc[t2] * bg_); } }
        asm volatile("s_waitcnt lgkmcnt(0)" ::: "memory");
      } }
    { const int wv_ = tid >> 6;
      for (int it = blockIdx.x * 8 + wv_; it < (SROW0 / 32) * 4; it += gridDim.x * 8) {
        const int rbp = it >> 2, hh = it & 3, jb = rbp % (LPAD / 32), row = rbp * 32 + r;
        float igm = -1e30f, lfm = 0.f;
        if (jb * 32 + r < LP) { const float* gr = G + (size_t)row * 16; igm = gr[hh] + p.gate_bias[l * 8 + hh]; const float f = gr[4 + hh] + p.gate_bias[l * 8 + 4 + hh]; lfm = fminf(f, 0.f) - log1pf(__expf(-fabsf(f))); }
        float bsum = 0.f, pm = -3e38f, myb = 0.f, myu = 0.f, mypm = 0.f;
#pragma unroll
        for (int t2 = 0; t2 < 32; ++t2) { bsum += rdl(lfm, t2); const float u_ = rdl(igm, t2) - bsum; pm = fmaxf(pm, u_); if (r == t2) { myb = bsum; myu = u_; mypm = pm; } }
        if (lane < 32) *(f32x4*)(REC + ((size_t)row * 4 + hh) * 16 + 4) = (f32x4){myu, myb, mypm, 0.f};
      } }
}

__device__ __forceinline__ void issue_gdn(const Params& p, int h, int qtr, int row0, int L, int jb, int ptid, StageRegs& r) {
    const bf16_t* P = (const bf16_t*)(p.ws + OFF_P); const float* REC = (const float*)(p.ws + OFF_REC);
    const int tt = ptid >> 3, g = ptid & 7, t0 = jb * 32;
    if (t0 + tt >= L) return;
    const int row = row0 + t0 + tt;
    const bf16_t* prow = P + (size_t)row * NP;
    r.q0 = asf(*(const u32x4*)(prow + cBQ + h * 128 + g * 16)); r.q1 = asf(*(const u32x4*)(prow + cBQ + h * 128 + g * 16 + 8));
    r.k0 = asf(*(const u32x4*)(prow + cBK + h * 128 + g * 16)); r.k1 = asf(*(const u32x4*)(prow + cBK + h * 128 + g * 16 + 8));
    { const u32x2 vv_ = *(const u32x2*)(prow + cBV + h * 128 + qtr * 32 + g * 4); r.v = asf((u32x4){vv_.x, vv_.y, 0u, 0u}); }
    if (g < 3) r.r0 = *(const f32x4*)(REC + ((size_t)row * 4 + h) * 16 + g * 4);
}
__device__ __forceinline__ void commit_gdn(int L, int jb, float* lds, int ptid, const StageRegs& r, int bsel = -1) {
    const int tt = ptid >> 3, g = ptid & 7, t0 = jb * 32, b = bsel >= 0 ? bsel : (jb & 1);
    if (t0 + tt >= L) return;
    float x[16];
    unpack8(asu(r.q0), x); unpack8(asu(r.q1), x + 8);
    float* qd = QB(lds, b) + tt * 128 + g * 16;
#pragma unroll
    for (int i = 0; i < 4; ++i) *(f32x4*)(qd + 4 * i) = (f32x4){x[4 * i], x[4 * i + 1], x[4 * i + 2], x[4 * i + 3]};
    unpack8(asu(r.k0), x); unpack8(asu(r.k1), x + 8);
    float* kd = KB(lds, b) + tt * 128 + g * 16;
#pragma unroll
    for (int i = 0; i < 4; ++i) *(f32x4*)(kd + 4 * i) = (f32x4){x[4 * i], x[4 * i + 1], x[4 * i + 2], x[4 * i + 3]};
    *(f32x4*)(VB(lds, b) + tt * 32 + g * 4) = (f32x4){bflo(asu(r.v).x), bfhi(asu(r.v).x), bflo(asu(r.v).y), bfhi(asu(r.v).y)};
    if (g < 3) *(f32x4*)(SCB(lds, b) + tt * 16 + g * 4) = r.r0;
}

constexpr int GD_Q = 0, GD_K = 8704, GD_KT = 17408, GD_KDT = 27904, GD_VT = 38400, GD_QKD = 40960, GD_TV = 43520, GD_TK = 46080, GD_W = 48640, GD_SC = 57344, GD_SLOT = 58368, GD_OB = 2 * GD_SLOT;
constexpr int GS_B = 32, GS_EG = 96, GS_ETG = 128, GS_EGT = 160;

__device__ __forceinline__ void issue_gdn_chunk(const Params& p, int h, int qtr, int row0, int L, int nch, int jb, int ptid, StageRegs& r) {
    if (jb >= nch) return;
    const bf16_t* P = (const bf16_t*)(p.ws + OFF_P); const float* REC = (const float*)(p.ws + OFF_REC);
    const bf16_t* tb = (const bf16_t*)(p.ws + OFF_TB) + ((size_t)((row0 >> 5) + jb) * 4 + h) * 3072;
    r.x0 = asf(*(const u32x4*)(tb + ptid * 8));
    if (ptid < 128) r.x1 = asf(*(const u32x4*)(tb + 2048 + ptid * 8));
    const int tt = ptid >> 3, g = ptid & 7, t0 = jb * 32;
    if (t0 + tt >= L) return;
    const int row = row0 + t0 + tt;
    const bf16_t* prow = P + (size_t)row * NP;
    r.q0 = asf(*(const u32x4*)(prow + cBQ + h * 128 + g * 16)); r.q1 = asf(*(const u32x4*)(prow + cBQ + h * 128 + g * 16 + 8));
    r.k0 = asf(*(const u32x4*)(prow + cBK + h * 128 + g * 16)); r.k1 = asf(*(const u32x4*)(prow + cBK + h * 128 + g * 16 + 8));
    { const u32x2 vv_ = *(const u32x2*)(prow + cBV + h * 128 + qtr * 32 + g * 4); r.v = asf((u32x4){vv_.x, vv_.y, 0u, 0u}); }
    if (g == 0 || g == 3) r.r0 = *(const f32x4*)(REC + ((size_t)row * 4 + h) * 16 + g * 4);
}

__device__ __forceinline__ void scan_gdn_chunk(const Params& p, int l, int bs, int h, int qtr, int row0, int L, unsigned char* lb) {
    const int tid = opaque_tid(p.wv); const int wave = tid >> 6, lane = tid & 63, r = lane & 31, hf = lane >> 5, ptid = tid - 256;
    bf16_t* P = (bf16_t*)(p.ws + OFF_P);
    const int nch = (L + 31) >> 5;
    f32x16 S[4];
#pragma unroll
    for (int dt = 0; dt < 4; ++dt)
#pragma unroll
        for (int i = 0; i < 16; ++i) S[dt][i] = 0.f;
    f32x4 s0, s1, s2, s3, s4, s5, s6, s7; StageRegs sr{s0, s1, s2, s3, s4, s5, s6, s7};
#define GD_P1(JN) do { const int jn_ = (JN); unsigned char* sl_ = lb + (jn_ & 1) * GD_SLOT; const int tt = ptid >> 3, g = ptid & 7; const bool val_ = jn_ * 32 + tt < L; \
        u32x4 q0_ = asu(sr.q0), q1_ = asu(sr.q1), k0_ = asu(sr.k0), k1_ = asu(sr.k1); u32x4 v_ = asu(sr.v); \
        if (!val_) { q0_ = q1_ = k0_ = k1_ = v_ = (u32x4){0u, 0u, 0u, 0u}; } \
        *(u32x4*)(sl_ + GD_Q + (tt * CH_LDQ + g * 16) * 2) = q0_; *(u32x4*)(sl_ + GD_Q + (tt * CH_LDQ + g * 16 + 8) * 2) = q1_; \
        *(u32x4*)(sl_ + GD_K + (tt * CH_LDQ + g * 16) * 2) = k0_; *(u32x4*)(sl_ + GD_K + (tt * CH_LDQ + g * 16 + 8) * 2) = k1_; \
        bf16_t* kt_ = (bf16_t*)(sl_ + GD_KT) + kto(g * 16) + tt; \
        _Pragma("unroll") for (int i = 0; i < 4; ++i) { kt_[(2 * i) * CH_LDS] = (bf16_t)(k0_[i] & 0xffffu); kt_[(2 * i + 1) * CH_LDS] = (bf16_t)(k0_[i] >> 16); \
            kt_[(8 + 2 * i) * CH_LDS] = (bf16_t)(k1_[i] & 0xffffu); kt_[(8 + 2 * i + 1) * CH_LDS] = (bf16_t)(k1_[i] >> 16); } \
        bf16_t* vt_ = (bf16_t*)(sl_ + GD_VT); \
        vt_[(g * 4 + 0) * CH_LDS + tt] = (bf16_t)(v_.x & 0xffffu); vt_[(g * 4 + 1) * CH_LDS + tt] = (bf16_t)(v_.x >> 16); \
        vt_[(g * 4 + 2) * CH_LDS + tt] = (bf16_t)(v_.y & 0xffffu); vt_[(g * 4 + 3) * CH_LDS + tt] = (bf16_t)(v_.y >> 16); \
        { const int row_ = ptid >> 2, c4_ = ptid & 3; *(u32x4*)(sl_ + (row_ < 32 ? GD_TV : GD_TK) + ((row_ & 31) * CH_LDS + c4_ * 8) * 2) = asu(sr.x0); \
          if (ptid < 128) *(u32x4*)(sl_ + GD_QKD + (row_ * CH_LDS + c4_ * 8) * 2) = asu(sr.x1); } \
        float* sc_ = (float*)(sl_ + GD_SC); \
        if (g == 0) { sc_[GS_B + tt] = val_ ? sr.r0[1] : 0.f; sc_[GS_EG + tt] = val_ ? __expf(sr.r0[3]) : 0.f; } \
        if (g == 3) { sc_[GS_ETG + tt] = val_ ? __expf(sr.r0[0]) : 0.f; if (tt == 0) sc_[GS_EGT] = __expf(sr.r0[1]); } \
        issue_gdn_chunk(p, h, qtr, row0, L, nch, jn_ + 1, ptid, sr); } while (0)
#define GD_P2(JN) do { if (wave >= 4) { unsigned char* sl_ = lb + ((JN) & 1) * GD_SLOT; const float* sc_ = (const float*)(sl_ + GD_SC); \
        { const int tt = ptid >> 3, g = ptid & 7; const float eg_ = sc_[GS_EG + tt], et_ = sc_[GS_ETG + tt]; float x_[16]; \
            u32x4* qp_ = (u32x4*)(sl_ + GD_Q + (tt * CH_LDQ + g * 16) * 2); unpack8(qp_[0], x_); unpack8(qp_[1], x_ + 8); \
            _Pragma("unroll") for (int i = 0; i < 16; ++i) x_[i] *= eg_; \
            qp_[0] = pack8(x_); qp_[1] = pack8(x_ + 8); \
            const u32x4* kp_ = (const u32x4*)(sl_ + GD_K + (tt * CH_LDQ + g * 16) * 2); unpack8(kp_[0], x_); unpack8(kp_[1], x_ + 8); \
            bf16_t* kd_ = (bf16_t*)(sl_ + GD_KDT); \
            _Pragma("unroll") for (int i = 0; i < 16; ++i) kd_[kto(g * 16) + i * CH_LDS + tt] = f2bf(x_[i] * et_); } \
        { const int dt_ = wave - 4; f32x16 a_; \
            _Pragma("unroll") for (int i = 0; i < 16; ++i) a_[i] = 0.f; \
            _Pragma("unroll") for (int kb = 0; kb < 2; ++kb) a_ = MFMA32(frag_n((const bf16_t*)(sl_ + GD_KT) + kto(dt_ * 32 + r), 0, 0, hf, kb), frag_n((const bf16_t*)(sl_ + GD_TK), CH_LDS, r, hf, kb), a_); \
            _Pragma("unroll") for (int i4 = 0; i4 < 4; ++i4) { unsigned lo_, hi_;     \
                asm volatile("s_nop 7\n\ts_nop 7\n\tv_cvt_pk_bf16_f32 %0, %2, %3\n\tv_cvt_pk_bf16_f32 %1, %4, %5" : "=&v"(lo_), "=&v"(hi_) : "v"(a_[4 * i4]), "v"(a_[4 * i4 + 1]), "v"(a_[4 * i4 + 2]), "v"(a_[4 * i4 + 3])); \
                *(u32x2*)(sl_ + GD_W + (r * CH_LDQ + 32 * dt_ + 8 * i4 + 4 * hf) * 2) = (u32x2){lo_, hi_}; } } } } while (0)
    if (wave >= 4) { issue_gdn_chunk(p, h, qtr, row0, L, nch, 0, ptid, sr); GD_P1(0); }
    BARRIER_LDS();
    GD_P2(0);
    BARRIER_LDS();
#pragma unroll 1
    for (int j = 0; j < nch; ++j) {
        if (wave == 0) {
            const unsigned char* sl = lb + (j & 1) * GD_SLOT; const float* sc = (const float*)(sl + GD_SC);
            const bf16_t* wq = (const bf16_t*)(sl + GD_W); const bf16_t* qg = (const bf16_t*)(sl + GD_Q); const bf16_t* tv = (const bf16_t*)(sl + GD_TV); const bf16_t* vt = (const bf16_t*)(sl + GD_VT);
            const bf16_t* qkd = (const bf16_t*)(sl + GD_QKD); const bf16_t* kdt = (const bf16_t*)(sl + GD_KDT);
            f32x16 U, O;
#pragma unroll
            for (int i = 0; i < 16; ++i) { U[i] = 0.f; O[i] = 0.f; }
#pragma unroll
            for (int dt = 0; dt < 4; ++dt)
#pragma unroll
                for (int u = 0; u < 2; ++u) { const bf16x8 sb = pack_step(S[dt], u);
                    U = MFMA32(frag_p(wq, CH_LDQ, r, hf, 32 * dt + 16 * u), sb, U); O = MFMA32(frag_p(qg, CH_LDQ, r, hf, 32 * dt + 16 * u), sb, O); }
            f32x16 Uv;
#pragma unroll
            for (int i = 0; i < 16; ++i) Uv[i] = 0.f;
#pragma unroll
            for (int kb = 0; kb < 2; ++kb) Uv = MFMA32(frag_n(tv, CH_LDS, r, hf, kb), frag_n(vt, CH_LDS, r, hf, kb), Uv);
#pragma unroll
            for (int i = 0; i < 16; ++i) U[i] = Uv[i] - U[i];
            bf16x8 ub[2]; ub[0] = pack_step(U, 0); ub[1] = pack_step(U, 1);
#pragma unroll
            for (int u = 0; u < 2; ++u) O = MFMA32(frag_p(qkd, CH_LDS, r, hf, 16 * u), ub[u], O);
            const float egt = sc[GS_EGT];
#pragma unroll
            for (int dt = 0; dt < 4; ++dt) {
#pragma unroll
                for (int i = 0; i < 16; ++i) S[dt][i] *= egt;
#pragma unroll
                for (int u = 0; u < 2; ++u) S[dt] = MFMA32(frag_p(kdt + kto(dt * 32 + r), 0, 0, hf, 16 * u), ub[u], S[dt]);
            }
            float* ob = (float*)(lb + GD_OB) + (j & 1) * 1024;
#pragma unroll
            for (int i = 0; i < 16; ++i) ob[crow(i, hf) * 32 + r] = O[i];
        } else if (wave >= 4) {
            if (j + 1 < nch) GD_P1(j + 1);
            if (j > 0) store_out_blk(P, row0, j - 1, L, cBV + h * 128 + qtr * 32, (const float*)(lb + GD_OB) + ((j - 1) & 1) * 1024, ptid);
        }
        BARRIER_LDS();
        if (j + 1 < nch) GD_P2(j + 1);
        BARRIER_LDS();
    }
    if (wave >= 4) store_out_blk(P, row0, nch - 1, L, cBV + h * 128 + qtr * 32, (const float*)(lb + GD_OB) + ((nch - 1) & 1) * 1024, ptid);
    if (wave == 0) {
        float* So = p.out + o_pS + ((size_t)(l * NB + bs) * 4 + h) * 16384;
#pragma unroll
        for (int dt = 0; dt < 4; ++dt)
#pragma unroll
            for (int i = 0; i < 16; ++i) So[(32 * dt + crow(i, hf)) * 128 + qtr * 32 + r] = S[dt][i];
    }
    __syncthreads();
#undef GD_P1
#undef GD_P2
}

__device__ __forceinline__ void scan_gdn(const Params& p, int l, bool samp, int bs, int h, int qtr, int row0, int L, float* lds) {
    const int tid = opaque_tid(p.wv); const bool cons = tid < 256; const int ptid = tid - 256;
    const int lane = tid & 63, w = (tid >> 6) & 3, s = lane & 7, cl = w * 8 + (lane >> 3), col = qtr * 32 + cl;
    bf16_t* P = (bf16_t*)(p.ws + OFF_P);
    f32x2 S[8];
#pragma unroll
    for (int e = 0; e < 8; ++e) S[e] = bc2(0.f);
    if (cons && samp) {
        const float* S0 = p.st_S + ((size_t)(l * NS + bs) * 4 + h) * 16384;
#pragma unroll
        for (int e = 0; e < 16; ++e) { const int d = (e >> 2) * 32 + s * 4 + (e & 3); S[e >> 1][e & 1] = S0[d * 128 + col]; }
    }
    const int nblk = (L + 31) >> 5;
    f32x4 k4[4][4];
    StageRegs sr{k4[0][0], k4[0][1], k4[0][2], k4[0][3], k4[1][0], k4[1][1], k4[1][2], k4[1][3]};
    if (!cons) { issue_gdn(p, h, qtr, row0, L, 0, ptid, sr); commit_gdn(L, 0, lds, ptid, sr); if (1 < nblk) issue_gdn(p, h, qtr, row0, L, 1, ptid, sr); }
    BARRIER_LDS();
    for (int jb = 0; jb < nblk; ++jb) {
        if (!cons) {
            if (jb + 1 < nblk) commit_gdn(L, jb + 1, lds, ptid, sr);
            if (jb + 2 < nblk) issue_gdn(p, h, qtr, row0, L, jb + 2, ptid, sr);
            if (jb > 0) store_out_blk(P, row0, jb - 1, L, cBV + h * 128 + qtr * 32, OB(lds, (jb - 1) & 1), ptid);
        } else {
            const float* qb = QB(lds, jb & 1); const float* kb = KB(lds, jb & 1); const float* vb = VB(lds, jb & 1); const float* sc = SCB(lds, jb & 1);
            float* ob = OB(lds, jb & 1);
            const int nt = min(32, L - jb * 32);
            f32x4 q4[4][4]; float vv[4], a[4], be[4]; f32x4 qk[4], kk[4];
#define GLOAD_Q(T0) do { _Pragma("unroll") for (int i = 0; i < 4; ++i) { const int t = (T0) + i; \
        _Pragma("unroll") for (int j = 0; j < 4; ++j) q4[i][j] = *(const f32x4*)(qb + t * 128 + j * 32 + s * 4); } } while (0)
#define GLOAD_K(T0) do { _Pragma("unroll") for (int i = 0; i < 4; ++i) { const int t = (T0) + i; \
        _Pragma("unroll") for (int j = 0; j < 4; ++j) k4[i][j] = *(const f32x4*)(kb + t * 128 + j * 32 + s * 4); } \
      _Pragma("unroll") for (int i = 0; i < 4; ++i) { const int t = (T0) + i; \
        const f32x2 gg = *(const f32x2*)(sc + t * 16); a[i] = gg[0]; be[i] = gg[1]; \
        qk[i] = *(const f32x4*)(sc + t * 16 + 4); kk[i] = *(const f32x4*)(sc + t * 16 + 8); vv[i] = vb[t * 32 + cl]; } } while (0)
            GLOAD_Q(0); GLOAD_K(0);
#pragma unroll 1
            for (int t0 = 0; t0 < nt; t0 += 4) {
                float dk[4], dq[4];
                const int tn = min(t0 + 4, 28);
                __builtin_amdgcn_sched_barrier(0);
#pragma unroll
                for (int i = 0; i < 4; ++i) {
                    f32x2 x = bc2(0.f), x2 = bc2(0.f), y = bc2(0.f), y2 = bc2(0.f);
#pragma unroll
                    for (int j = 0; j < 4; ++j) {
                        x = lo2(k4[i][j]) * S[2 * j] + x; x2 = hi2(k4[i][j]) * S[2 * j + 1] + x2;
                        y = lo2(q4[i][j]) * S[2 * j] + y; y2 = hi2(q4[i][j]) * S[2 * j + 1] + y2; }
                    x = x + x2; y = y + y2;
                    dk[i] = x[0] + x[1]; dq[i] = y[0] + y[1];
                }
                __builtin_amdgcn_sched_barrier(0);
                GLOAD_Q(tn);
                __builtin_amdgcn_sched_barrier(0);
#pragma unroll
                for (int i = 0; i < 4; ++i) { dk[i] = red8(dk[i]); dq[i] = red8(dq[i]); }
                const float A0 = a[0], A1 = A0 * a[1], A2 = A1 * a[2], A3 = A2 * a[3];
                const float r10 = a[1], r21 = a[2], r32 = a[3], r20 = r10 * a[2], r31 = r21 * a[3], r30 = r20 * a[3];
                const float u0 = be[0] * (vv[0] - A0 * dk[0]);
                const float u1 = be[1] * (vv[1] - A1 * dk[1] - r10 * kk[1][0] * u0);
                const float u2 = be[2] * (vv[2] - A2 * dk[2] - r20 * kk[2][0] * u0 - r21 * kk[2][1] * u1);
                const float u3 = be[3] * (vv[3] - A3 * dk[3] - r30 * kk[3][0] * u0 - r31 * kk[3][1] * u1 - r32 * kk[3][2] * u2);
                if (s == 0) {
                    ob[(t0 + 0) * 32 + cl] = A0 * dq[0] + qk[0][0] * u0;
                    ob[(t0 + 1) * 32 + cl] = A1 * dq[1] + r10 * qk[1][0] * u0 + qk[1][1] * u1;
                    ob[(t0 + 2) * 32 + cl] = A2 * dq[2] + r20 * qk[2][0] * u0 + r21 * qk[2][1] * u1 + qk[2][2] * u2;
                    ob[(t0 + 3) * 32 + cl] = A3 * dq[3] + r30 * qk[3][0] * u0 + r31 * qk[3][1] * u1 + r32 * qk[3][2] * u2 + qk[3][3] * u3;
                }
                const float c0 = r30 * u0, c1 = r31 * u1, c2 = r32 * u2, c3 = u3;
#pragma unroll
                for (int j = 0; j < 4; ++j) {
                    S[2 * j] = lo2(k4[3][j]) * bc2(c3) + (lo2(k4[2][j]) * bc2(c2) + (lo2(k4[1][j]) * bc2(c1) + (lo2(k4[0][j]) * bc2(c0) + S[2 * j] * bc2(A3))));
                    S[2 * j + 1] = hi2(k4[3][j]) * bc2(c3) + (hi2(k4[2][j]) * bc2(c2) + (hi2(k4[1][j]) * bc2(c1) + (hi2(k4[0][j]) * bc2(c0) + S[2 * j + 1] * bc2(A3)))); }
                __builtin_amdgcn_sched_barrier(0);
                GLOAD_K(tn);
            }
#undef GLOAD_Q
#undef GLOAD_K
        }
        BARRIER_LDS();
    }
    if (!cons) store_out_blk(P, row0, nblk - 1, L, cBV + h * 128 + qtr * 32, OB(lds, (nblk - 1) & 1), ptid);
    else {
        const size_t sh = samp ? (size_t)(l * NS + bs) * 4 + h : (size_t)(l * NB + bs) * 4 + h;
        float* So = p.out + (samp ? o_sS : o_pS) + sh * 16384;
#pragma unroll
        for (int e = 0; e < 16; ++e) { const int d = (e >> 2) * 32 + s * 4 + (e & 3); So[d * 128 + col] = S[e >> 1][e & 1]; }
    }
    BARRIER_LDS();
}

__device__ __forceinline__ void scan_gdn_stream(const Params& p, int l, int h, int qtr, int bs0, int nseq, float* lds) {
    const int tid = opaque_tid(p.wv); const bool cons = tid < 256; const int ptid = tid - 256;
    const int lane = tid & 63, w = (tid >> 6) & 3, s = lane & 7, cl = w * 8 + (lane >> 3), col = qtr * 32 + cl;
    bf16_t* P = (bf16_t*)(p.ws + OFF_P);
    f32x2 S[8];
#pragma unroll
    for (int e = 0; e < 8; ++e) S[e] = bc2(0.f);
    f32x4 k4[4][4];
    StageRegs sr{k4[0][0], k4[0][1], k4[0][2], k4[0][3], k4[1][0], k4[1][1], k4[1][2], k4[1][3]};
#define LOADSTATE(BS) do { } while (0)
#define STISSUE(BS) st_issue(p.st_S + ((size_t)(l * NS + (BS)) * 4 + h) * 16384, qtr, ptid, k4[2][0], k4[2][1], k4[2][2], k4[2][3])
    if (!cons) { issue_gdn(p, h, qtr, SROW0 + bs0 * 4, LS, 0, ptid, sr); STISSUE(bs0); }
#pragma unroll 1
    for (int k = 0; k < nseq; ++k) {
        const int bs = bs0 + 8 * k, row0 = SROW0 + bs * 4;
        if (!cons) { commit_gdn(LS, 0, lds, ptid, sr, k & 1); st_commit(STB(lds, k & 1), ptid, k4[2][0], k4[2][1], k4[2][2], k4[2][3]);
            if (k + 1 < nseq) { issue_gdn(p, h, qtr, row0 + 32, LS, 0, ptid, sr); STISSUE(bs + 8); } }
        BARRIER_LDS();
        if (!cons) { if (k > 0) { store_out_blk(P, row0 - 32, 0, LS, cBV + h * 128 + qtr * 32, OB(lds, (k - 1) & 1), ptid); st_store(p.out + o_sS + ((size_t)(l * NS + bs - 8) * 4 + h) * 16384, qtr, STB(lds, (k - 1) & 1), ptid); } }
        else {
            const float* qb = QB(lds, k & 1); const float* kb = KB(lds, k & 1); const float* vb = VB(lds, k & 1); const float* sc = SCB(lds, k & 1);
            float* ob = OB(lds, k & 1); float* stb = STB(lds, k & 1);
#pragma unroll
            for (int e = 0; e < 16; ++e) { const int d = (e >> 2) * 32 + s * 4 + (e & 3); S[e >> 1][e & 1] = stb[d * ST_LD + cl]; }
            f32x4 q4[4][4]; float vv[4], a[4], be[4]; f32x4 qk[4], kk[4];
#define GLOAD_Q(T0) do { _Pragma("unroll") for (int i = 0; i < 4; ++i) { const int t = (T0) + i; \
        _Pragma("unroll") for (int j = 0; j < 4; ++j) q4[i][j] = *(const f32x4*)(qb + t * 128 + j * 32 + s * 4); } } while (0)
#define GLOAD_K(T0) do { _Pragma("unroll") for (int i = 0; i < 4; ++i) { const int t = (T0) + i; \
        _Pragma("unroll") for (int j = 0; j < 4; ++j) k4[i][j] = *(const f32x4*)(kb + t * 128 + j * 32 + s * 4); } \
      _Pragma("unroll") for (int i = 0; i < 4; ++i) { const int t = (T0) + i; \
        const f32x2 gg = *(const f32x2*)(sc + t * 16); a[i] = gg[0]; be[i] = gg[1]; \
        qk[i] = *(const f32x4*)(sc + t * 16 + 4); kk[i] = *(const f32x4*)(sc + t * 16 + 8); vv[i] = vb[t * 32 + cl]; } } while (0)
            GLOAD_Q(0); GLOAD_K(0);
            {
                float dk[4], dq[4];
                __builtin_amdgcn_sched_barrier(0);
#pragma unroll
                for (int i = 0; i < 4; ++i) {
                    f32x2 x = bc2(0.f), x2 = bc2(0.f), y = bc2(0.f), y2 = bc2(0.f);
#pragma unroll
                    for (int j = 0; j < 4; ++j) {
                        x = lo2(k4[i][j]) * S[2 * j] + x; x2 = hi2(k4[i][j]) * S[2 * j + 1] + x2;
                        y = lo2(q4[i][j]) * S[2 * j] + y; y2 = hi2(q4[i][j]) * S[2 * j + 1] + y2; }
                    x = x + x2; y = y + y2;
                    dk[i] = x[0] + x[1]; dq[i] = y[0] + y[1];
                }
                __builtin_amdgcn_sched_barrier(0);
#pragma unroll
                for (int i = 0; i < 4; ++i) { dk[i] = red8(dk[i]); dq[i] = red8(dq[i]); }
                const float A0 = a[0], A1 = A0 * a[1], A2 = A1 * a[2], A3 = A2 * a[3];
                const float r10 = a[1], r21 = a[2], r32 = a[3], r20 = r10 * a[2], r31 = r21 * a[3], r30 = r20 * a[3];
                const float u0 = be[0] * (vv[0] - A0 * dk[0]);
                const float u1 = be[1] * (vv[1] - A1 * dk[1] - r10 * kk[1][0] * u0);
                const float u2 = be[2] * (vv[2] - A2 * dk[2] - r20 * kk[2][0] * u0 - r21 * kk[2][1] * u1);
                const float u3 = be[3] * (vv[3] - A3 * dk[3] - r30 * kk[3][0] * u0 - r31 * kk[3][1] * u1 - r32 * kk[3][2] * u2);
                if (s == 0) {
                    ob[0 * 32 + cl] = A0 * dq[0] + qk[0][0] * u0;
                    ob[1 * 32 + cl] = A1 * dq[1] + r10 * qk[1][0] * u0 + qk[1][1] * u1;
                    ob[2 * 32 + cl] = A2 * dq[2] + r20 * qk[2][0] * u0 + r21 * qk[2][1] * u1 + qk[2][2] * u2;
                    ob[3 * 32 + cl] = A3 * dq[3] + r30 * qk[3][0] * u0 + r31 * qk[3][1] * u1 + r32 * qk[3][2] * u2 + qk[3][3] * u3;
                }
                const float c0 = r30 * u0, c1 = r31 * u1, c2 = r32 * u2, c3 = u3;
#pragma unroll
                for (int j = 0; j < 4; ++j) {
                    S[2 * j] = lo2(k4[3][j]) * bc2(c3) + (lo2(k4[2][j]) * bc2(c2) + (lo2(k4[1][j]) * bc2(c1) + (lo2(k4[0][j]) * bc2(c0) + S[2 * j] * bc2(A3))));
                    S[2 * j + 1] = hi2(k4[3][j]) * bc2(c3) + (hi2(k4[2][j]) * bc2(c2) + (hi2(k4[1][j]) * bc2(c1) + (hi2(k4[0][j]) * bc2(c0) + S[2 * j + 1] * bc2(A3)))); }
            }
#undef GLOAD_Q
#undef GLOAD_K
#pragma unroll
            for (int e = 0; e < 16; ++e) { const int d = (e >> 2) * 32 + s * 4 + (e & 3); stb[d * ST_LD + cl] = S[e >> 1][e & 1]; }
        }
    }
    BARRIER_LDS();
    if (!cons) { store_out_blk(P, SROW0 + (bs0 + 8 * (nseq - 1)) * 4, 0, LS, cBV + h * 128 + qtr * 32, OB(lds, (nseq - 1) & 1), ptid); st_store(p.out + o_sS + ((size_t)(l * NS + bs0 + 8 * (nseq - 1)) * 4 + h) * 16384, qtr, STB(lds, (nseq - 1) & 1), ptid); }
    BARRIER_LDS();
#undef LOADSTATE
#undef STISSUE
}


__device__ __forceinline__ void phase_scan(const Params& p, int l, float* lds) {
    for (int item = blockIdx.x; item < 256; item += gridDim.x) {
        const int xcd_ = item & 7, y_ = item >> 3, qtr = y_ & 3, chain = (y_ >> 2) * 8 + xcd_;
        const int h = chain & 3, bs = (chain >> 2) & 7, branch = chain >> 5;
        if (branch == 0) scan_mlstm_chunk(p, l, bs, h, qtr, bs * LPAD, LP, (unsigned char*)lds); else scan_gdn_chunk(p, l, bs, h, qtr, bs * LPAD, LP, (unsigned char*)lds);
    }
    for (int c = blockIdx.x; c < 256; c += gridDim.x) {
        const int qtr = c & 3, h = (c >> 2) & 3, branch = (c >> 4) & 1, bs0 = c >> 5;
        if (branch == 0) scan_mlstm_stream(p, l, h, qtr, bs0, NS / 8, lds); else scan_gdn_stream(p, l, h, qtr, bs0, NS / 8, lds);
    }
}

__device__ __forceinline__ void phase_norm(const Params& p, int l) {
    const int tid = opaque_tid(p.wv); const int wave = tid >> 6, lane = tid & 63;
    bf16_t* P = (bf16_t*)(p.ws + OFF_P);
    const int part = lane >> 5, hh = (lane >> 3) & 3, g = lane & 7, ch0 = hh * 128 + g * 16;
    const int craw = (part ? cBV : cV) + ch0, cgate = (part ? cZ : cO) + ch0;
    const float* wnp = part ? p.b_norm_w + l * 128 + g * 16 : p.a_norm_w + l * 512 + ch0;
    float wn[16];
#pragma unroll
    for (int i = 0; i < 4; ++i) { const f32x4 w4 = *(const f32x4*)(wnp + 4 * i); wn[4 * i] = w4[0]; wn[4 * i + 1] = w4[1]; wn[4 * i + 2] = w4[2]; wn[4 * i + 3] = w4[3]; }
    const int stride = gridDim.x * 8;
    int row = blockIdx.x * 8 + wave;
    while (row < SROW0 && (row % LPAD) >= LP) row += stride;
    u32x4 cx0 = (u32x4){0u, 0u, 0u, 0u}, cx1 = cx0, cz0 = cx0, cz1 = cx0;
    if (row < MROWS) { const bf16_t* pr = P + (size_t)row * NP; cx0 = *(const u32x4*)(pr + craw); cx1 = *(const u32x4*)(pr + craw + 8); cz0 = *(const u32x4*)(pr + cgate); cz1 = *(const u32x4*)(pr + cgate + 8); }
    while (row < MROWS) {
        int nrow = row + stride;
        while (nrow < SROW0 && (nrow % LPAD) >= LP) nrow += stride;
        u32x4 nx0 = cx0, nx1 = cx1, nz0 = cz0, nz1 = cz1;
        if (nrow < MROWS) { const bf16_t* pn = P + (size_t)nrow * NP; nx0 = *(const u32x4*)(pn + craw); nx1 = *(const u32x4*)(pn + craw + 8); nz0 = *(const u32x4*)(pn + cgate); nz1 = *(const u32x4*)(pn + cgate + 8); }
        bf16_t* pr = P + (size_t)row * NP;
        float x[16], z[16];
        unpack8(cx0, x); unpack8(cx1, x + 8); unpack8(cz0, z); unpack8(cz1, z + 8);
        float sum = 0.f;
#pragma unroll
        for (int i = 0; i < 16; ++i) sum += x[i];
        float mean = red8(sum) * (1.f / 128.f);
        if (part) mean = 0.f;
        float s2 = 0.f;
#pragma unroll
        for (int i = 0; i < 16; ++i) { x[i] -= mean; s2 += x[i] * x[i]; }
        const float rstd = rsqrtf(red8(s2) * (1.f / 128.f) + 1e-6f);
        float y[16];
#pragma unroll
        for (int i = 0; i < 16; ++i) { const float sg = sigmoidf_(z[i]); y[i] = x[i] * rstd * wn[i] * (part ? z[i] * sg : sg); }
        *(u32x4*)(pr + cgate) = pack8(y); *(u32x4*)(pr + cgate + 8) = pack8(y + 8);
        cx0 = nx0; cx1 = nx1; cz0 = nz0; cz1 = nz1; row = nrow;
    }
}

__device__ __forceinline__ void phase_convact(const Params& p, int l) {
    bf16_t* U = (bf16_t*)(p.ws + OFF_P); const bf16_t* HB = (const bf16_t*)(p.ws + OFF_HB);
    const float* cw = p.fconv_w + (size_t)l * 3 * NU;
    constexpr int NCG = DFF / 8, NRG = MROWS / 32;
    const int tid = opaque_tid(p.wv);
    for (int it = blockIdx.x * NTHREADS + tid; it < NRG * NCG; it += gridDim.x * NTHREADS) {
        const int rg = it / NCG, cg_ = it - rg * NCG, c0 = cg_ * 8;
        float wa[3][8], wb[3][8];
#pragma unroll
        for (int j = 0; j < 3; ++j) {
            const f32x4 a0 = *(const f32x4*)(cw + j * NU + c0), a1 = *(const f32x4*)(cw + j * NU + c0 + 4);
            const f32x4 b0 = *(const f32x4*)(cw + j * NU + DFF + c0), b1 = *(const f32x4*)(cw + j * NU + DFF + c0 + 4);
#pragma unroll
            for (int i = 0; i < 4; ++i) { wa[j][i] = a0[i]; wa[j][4 + i] = a1[i]; wb[j][i] = b0[i]; wb[j][4 + i] = b1[i]; }
        }
        float a2[8], a1[8], b2[8], b1[8];
        const bool samp = rg >= SROW0 / 32;
#pragma unroll
        for (int i = 0; i < 8; ++i) { a2[i] = a1[i] = b2[i] = b1[i] = 0.f; }
        if (!samp && (rg % (LPAD / 32)) != 0) {
            const bf16_t* h0 = HB + (size_t)(rg - 1) * 2 * NU;
            unpack8(*(const u32x4*)(h0 + c0), a2); unpack8(*(const u32x4*)(h0 + NU + c0), a1);
            unpack8(*(const u32x4*)(h0 + DFF + c0), b2); unpack8(*(const u32x4*)(h0 + NU + DFF + c0), b1);
        }
#pragma unroll 4
        for (int i = 0; i < 32; ++i) {
            const int row = rg * 32 + i;
            if (samp && (i & 3) == 0) {
                const float* st = p.st_fconv + ((size_t)(l * NS + ((row - SROW0) >> 2)) * 2) * NU;
                const f32x4 x0 = *(const f32x4*)(st + c0), x1 = *(const f32x4*)(st + c0 + 4), y0 = *(const f32x4*)(st + NU + c0), y1 = *(const f32x4*)(st + NU + c0 + 4);
                const f32x4 u0 = *(const f32x4*)(st + DFF + c0), u1 = *(const f32x4*)(st + DFF + c0 + 4), v0 = *(const f32x4*)(st + NU + DFF + c0), v1 = *(const f32x4*)(st + NU + DFF + c0 + 4);
#pragma unroll
                for (int e = 0; e < 4; ++e) { a2[e] = x0[e]; a2[4 + e] = x1[e]; a1[e] = y0[e]; a1[4 + e] = y1[e]; b2[e] = u0[e]; b2[4 + e] = u1[e]; b1[e] = v0[e]; b1[4 + e] = v1[e]; }
            }
            bf16_t* ur = U + (size_t)row * NU;
            float a[8], b[8], hh[8];
            unpack8(*(const u32x4*)(ur + c0), a); unpack8(*(const u32x4*)(ur + DFF + c0), b);
#pragma unroll
            for (int e = 0; e < 8; ++e) {
                const float ca = wa[0][e] * a2[e] + wa[1][e] * a1[e] + wa[2][e] * a[e];
                const float cb = wb[0][e] * b2[e] + wb[1][e] * b1[e] + wb[2][e] * b[e];
                hh[e] = ca * sigmoidf_(ca) * cb;
                a2[e] = a1[e]; a1[e] = a[e]; b2[e] = b1[e]; b1[e] = b[e];
            }
            u32x4 o; o.x = pk2(hh[0], hh[1]); o.y = pk2(hh[2], hh[3]); o.z = pk2(hh[4], hh[5]); o.w = pk2(hh[6], hh[7]);
            *(u32x4*)(ur + c0) = o;
        }
    }
}

#ifndef PROBE
#define PROBE 0
#endif
constexpr int NPHASE = 2 + DEPTH * 11;
__global__ void __launch_bounds__(NTHREADS) fwd_kernel(Params pin) {
    extern __shared__ __attribute__((aligned(16))) unsigned char smem_raw[];
    Params p = pin; p.wv = __builtin_amdgcn_readfirstlane((int)(threadIdx.x >> 6));
    unsigned* bar = (unsigned*)(p.ws + OFF_BAR); const unsigned xcc = xb_xcc_id();
    volatile LAS unsigned* xst = (volatile LAS unsigned*)(LAS unsigned char*)(smem_raw + LDS_GEMM);
    if (threadIdx.x == 0) { xst[0] = 0u; xst[1] = 0u; (void)xb_add(&bar[XB_XCNT(xcc)], 1u); }
    __syncthreads();
    float* lds = (float*)smem_raw;
    bf16_t* X = (bf16_t*)(p.ws + OFF_X); bf16_t* P = (bf16_t*)(p.ws + OFF_P); bf16_t* HB = (bf16_t*)(p.ws + OFF_HB);
    for (int ph = p.ph_lo; ph < p.ph_hi; ++ph) {
#if PROBE == 3
      for (int rep = 0; rep < 2; ++rep) { const int sx = ph < 2 ? -1 : (ph - 2) % 11; if (rep == 1 && !(ph < 2 || sx == 6 || sx == 10)) break;
#endif
        if (ph == 0) phase_weights(p, lds);
        else if (ph == 1) phase_ln(p, 0, nullptr, 0, p.ln_emb_g, p.ln_emb_b, 0, false);
        else {
            const int l = (ph - 2) / 11, s = (ph - 2) % 11;
            if (s == 0) { GemmArgs g{X, X, 1 << 30, D, w_inT(p, l), MROWS, NP, 1024}; gemm_phase(g, EpiP{P, (bf16_t*)(p.ws + OFF_GH), p.out, l}, p.wv); }
            else if (s == 1) phase_prep(p, l, lds);
            else if (s == 2) phase_scan(p, l, lds);
            else if (s == 3) phase_norm(p, l);
            else if (s == 4) { GemmArgs g{P + cO, P + cZ, 4, NP, w_abT(p, l), MROWS, 2048, 512}; gemm_phase(g, EpiMerge{P}, p.wv); }
            else if (s == 5) { GemmArgs g{P + cMG, P + cMG, 1 << 30, NP, w_outT(p, l), MROWS, 1024, 2048, 1}; gemm_phase(g, EpiRes{X, P, NP, 0, (bf16_t*)(p.ws + OFF_GH)}, p.wv); }
            else if (s == 6) phase_ln(p, 1, P, NP, p.ln1_g + l * D, p.ln1_b + l * D, -1, false);
            else if (s == 7) { GemmArgs g{X, X, 1 << 30, D, w_upT(p, l), MROWS, NU, 1024}; gemm_phase(g, EpiUp{P, HB, p.out, l}, p.wv); }
            else if (s == 8) phase_convact(p, l);
            else if (s == 9) { GemmArgs g{P, P, 1 << 30, NU, w_dnT(p, l), MROWS, 1024, DFF, 1}; gemm_phase(g, EpiRes{X, P, NU, DFF, (bf16_t*)(p.ws + OFF_GH)}, p.wv); }
            else phase_ln(p, 1, P + DFF, NU, p.ln2_g + l * D, p.ln2_b + l * D, l + 1 < DEPTH ? l + 1 : -1, l + 1 == DEPTH);
        }
#if PROBE == 3
      }
#endif
        if (ph + 1 < p.ph_hi) { if (p.ph_lo < 0) cg::this_grid().sync(); else xcd_barrier(bar, xcc, xst, p.wv); }
    }
#if PROBE == 4
    for (int i = 0; i < 20; ++i) xcd_barrier(bar, xcc, xst, p.wv);
#endif
}

extern "C" void kernel_launch(void* const* d_in, const int* in_sizes, int n_in, void* d_out, int out_size, void* d_ws, size_t ws_size, hipStream_t stream) {
    static int grid = 0;
    if (grid == 0) {
        if (n_in != 28 || (size_t)out_size != o_end || ws_size < WS_END) { fprintf(stderr, "kernel_launch: unexpected sizes n_in %d out %d ws %zu (need %zu)\n", n_in, out_size, ws_size, (size_t)WS_END); grid = -1; return; }
        int dev = 0, cus = 0, per_cu = 0;
        hipGetDevice(&dev); hipDeviceGetAttribute(&cus, hipDeviceAttributeMultiprocessorCount, dev);
        if (hipFuncSetAttribute((const void*)fwd_kernel, hipFuncAttributeMaxDynamicSharedMemorySize, LDS_BYTES) != hipSuccess) { fprintf(stderr, "hipFuncSetAttribute failed\n"); grid = -1; return; }
        if (hipOccupancyMaxActiveBlocksPerMultiprocessor(&per_cu, (const void*)fwd_kernel, NTHREADS, LDS_BYTES) != hipSuccess || per_cu < 1) { fprintf(stderr, "occupancy query failed (%d)\n", per_cu); (void)hipGetLastError(); per_cu = 1; }
        grid = cus * per_cu;
        if (grid > 256) grid = 256;
    }
    if (grid < 0) return;
    if (hipMemsetAsync((unsigned char*)d_ws + OFF_BAR, 0, 16384, stream) != hipSuccess) { fprintf(stderr, "memset of barrier words failed\n"); return; }
    Params p{};
    const float** pp = (const float**)&p;
    for (int i = 0; i < 28; ++i) pp[i] = (const float*)d_in[i];
    p.out = (float*)d_out; p.ws = (unsigned char*)d_ws;
#if MULTI
    for (int ph = 0; ph < NPHASE; ++ph) { p.ph_lo = ph; p.ph_hi = ph + 1; hipLaunchKernelGGL(fwd_kernel, dim3(grid), dim3(NTHREADS), LDS_BYTES, stream, p); }
#else
    p.ph_lo = 0; p.ph_hi = NPHASE;
    void* args[] = {&p};
    hipError_t e = hipLaunchCooperativeKernel((const void*)fwd_kernel, dim3(grid), dim3(NTHREADS), args, LDS_BYTES, stream);
    if (e != hipSuccess) fprintf(stderr, "cooperative launch failed: %s (grid %d)\n", hipGetErrorString(e), grid);
#endif
}
```

```cpp
#include <hip/hip_runtime.h>
#include <hip/hip_cooperative_groups.h>
#include <cstdio>
namespace cg = cooperative_groups;

#ifndef MULTI
#define MULTI 0
#endif

typedef unsigned short bf16_t;
typedef short bf16x8 __attribute__((ext_vector_type(8)));
typedef float f32x4 __attribute__((ext_vector_type(4)));
typedef float f32x2 __attribute__((ext_vector_type(2)));
typedef unsigned u32x2 __attribute__((ext_vector_type(2)));
typedef unsigned u32x4 __attribute__((ext_vector_type(4)));

constexpr int D = 1024, NB = 8, LP = 2064, LPAD = 2080, NS = 128, LS = 4, DEPTH = 2, NMETA = 16, SEQ = 2048;
constexpr int MROWS = NB * LPAD + NS * LS;
constexpr int SROW0 = NB * LPAD;
constexpr int NIN = 6160, NP = 6144, DFF = 2816, NU = 5632;
constexpr int cQ = 0, cK = 512, cV = 1024, cO = 1536, cBQ = 2048, cBK = 2560, cBV = 3072, cZ = 3584, cMG = 4096;
constexpr float ALPHA = 1.4142135623730951f;
constexpr int SPLIT_ROW0 = 64 * 256;
constexpr int NTHREADS = 512;
constexpr int LDS_GEMM = 131072;
constexpr int LDS_BYTES = LDS_GEMM + 256;

constexpr size_t W_IN = (size_t)NP * 1024, W_AB = 2048 * 512, W_OUT = 1024 * 2048, W_UP = (size_t)NU * 1024, W_DN = (size_t)1024 * DFF;
constexpr size_t W_LAYER = W_IN + W_AB + W_OUT + W_UP + W_DN;
constexpr size_t OFF_W = 0;
constexpr size_t OFF_WG = OFF_W + DEPTH * W_LAYER * 2;
constexpr size_t OFF_X = OFF_WG + DEPTH * 16 * 1024 * 4;
constexpr size_t OFF_G = OFF_X + (size_t)MROWS * D * 2;
constexpr size_t OFF_HB = OFF_G + (size_t)MROWS * 16 * 4;
constexpr size_t OFF_P = OFF_HB + (size_t)(MROWS / 32) * 2 * NU * 2;
constexpr size_t OFF_GH = OFF_P + (size_t)MROWS * NP * 2;
constexpr size_t OFF_REC = OFF_GH + (size_t)(MROWS / 32) * 3 * 1536 * 2;
constexpr size_t OFF_BAR = OFF_REC + (size_t)MROWS * 4 * 16 * 4;
constexpr size_t OFF_TB = OFF_BAR + 16384;
constexpr size_t WS_END = OFF_TB + (size_t)(MROWS / 32) * 4 * 3 * 1024 * 2;

constexpr size_t o_yp = 0;
constexpr size_t o_ys = o_yp + (size_t)NB * SEQ * D;
constexpr size_t o_pC = o_ys + (size_t)NS * LS * D;
constexpr size_t o_pn = o_pC + (size_t)DEPTH * NB * 4 * 128 * 128;
constexpr size_t o_pm = o_pn + (size_t)DEPTH * NB * 4 * 128;
constexpr size_t o_pS = o_pm + (size_t)DEPTH * NB * 4;
constexpr size_t o_pgc = o_pS + (size_t)DEPTH * NB * 4 * 128 * 128;
constexpr size_t o_pfc = o_pgc + (size_t)DEPTH * NB * 3 * 1536;
constexpr size_t o_sC = o_pfc + (size_t)DEPTH * NB * 2 * NU;
constexpr size_t o_sn = o_sC + (size_t)DEPTH * NS * 4 * 128 * 128;
constexpr size_t o_sm = o_sn + (size_t)DEPTH * NS * 4 * 128;
constexpr size_t o_sS = o_sm + (size_t)DEPTH * NS * 4;
constexpr size_t o_sgc = o_sS + (size_t)DEPTH * NS * 4 * 128 * 128;
constexpr size_t o_sfc = o_sgc + (size_t)DEPTH * NS * 3 * 1536;
constexpr size_t o_end = o_sfc + (size_t)DEPTH * NS * 2 * NU;

struct Params {
    const float* x_prompt; const float* x_sample; const float* st_C; const float* st_n; const float* st_m; const float* st_S;
    const float* st_gconv; const float* st_fconv; const float* meta; const float* ln_emb_g; const float* ln_emb_b; const float* w_in;
    const float* gate_bias; const float* a_norm_w; const float* gconv_w; const float* A_log; const float* dt_bias; const float* b_norm_w;
    const float* w_pa; const float* w_pb; const float* w_out; const float* ln1_g; const float* ln1_b; const float* w_up;
    const float* fconv_w; const float* w_down; const float* ln2_g; const float* ln2_b;
    float* out; unsigned char* ws;
    int ph_lo, ph_hi;
    int wv, pad_;
};

__device__ __forceinline__ int opaque_tid(int wv) { int lane; asm volatile("v_mbcnt_lo_u32_b32 %0, -1, 0\n\tv_mbcnt_hi_u32_b32 %0, -1, %0" : "=v"(lane)); return wv * 64 + lane; }
__device__ __forceinline__ float bflo(unsigned u) { return __uint_as_float(u << 16); }
__device__ __forceinline__ float bfhi(unsigned u) { return __uint_as_float(u & 0xffff0000u); }
__device__ __forceinline__ unsigned pk2(float lo, float hi) { unsigned r; asm("v_cvt_pk_bf16_f32 %0, %1, %2" : "=v"(r) : "v"(lo), "v"(hi)); return r; }
template <int CTRL> __device__ __forceinline__ float dppf(float v) { return __int_as_float(__builtin_amdgcn_update_dpp(0, __float_as_int(v), CTRL, 0xf, 0xf, true)); }
__device__ __forceinline__ float red8(float v) { v += dppf<0xB1>(v); v += dppf<0x4E>(v); v += dppf<0x141>(v); return v; }
__device__ __forceinline__ float red16(float v) { v = red8(v); v += dppf<0x140>(v); return v; }
__device__ __forceinline__ float rdl(float v, int l) { return __int_as_float(__builtin_amdgcn_readlane(__float_as_int(v), l)); }
__device__ __forceinline__ float rdl_pin(float v, int l) { float r_; asm volatile("v_readlane_b32 %0, %1, %2" : "=s"(r_) : "v"(v), "s"(l)); return r_; }
__device__ __forceinline__ float red64(float v) { v = red16(v); return (rdl(v, 0) + rdl(v, 16)) + (rdl(v, 32) + rdl(v, 48)); }
__device__ __forceinline__ float sigmoidf_(float x) { return __builtin_amdgcn_rcpf(1.f + __expf(-x)); }
__device__ __forceinline__ u32x4 pack8(const float* y) { u32x4 o; o.x = pk2(y[0], y[1]); o.y = pk2(y[2], y[3]); o.z = pk2(y[4], y[5]); o.w = pk2(y[6], y[7]); return o; }
__device__ __forceinline__ void unpack8(u32x4 a, float* x) { x[0] = bflo(a.x); x[1] = bfhi(a.x); x[2] = bflo(a.y); x[3] = bfhi(a.y); x[4] = bflo(a.z); x[5] = bfhi(a.z); x[6] = bflo(a.w); x[7] = bfhi(a.w); }


#define XB_TMO      128
#define XB_XCNT(j)  (256  + 64 * (j))
#define XB_XSUB(j)  (1280 + 64 * (j))
#define XB_XGEN(j)  (2304 + 64 * (j))
#define XB_TOP      3328
#define XB_TOPGEN   3392
#define XCD_BAR_WORDS 3456
#define XB_SPIN_CAP (1u << 18)
#define LAS __attribute__((address_space(3)))
__device__ __forceinline__ unsigned xb_ld(unsigned* p)              { return __hip_atomic_load(p, __ATOMIC_RELAXED, __HIP_MEMORY_SCOPE_AGENT); }
__device__ __forceinline__ unsigned xb_add(unsigned* p, unsigned v) { return __hip_atomic_fetch_add(p, v, __ATOMIC_RELAXED, __HIP_MEMORY_SCOPE_AGENT); }
__device__ __forceinline__ unsigned xb_xcc_id() { return (unsigned)__builtin_amdgcn_s_getreg((3 << 11) | 20) & 0xFu; }
#define XB_SPIN(cond, bar) do { unsigned _sp = 0; while (cond) { __builtin_amdgcn_s_sleep(1); \
    if ((++_sp & 255u) == 0u) { if (xb_ld(&(bar)[XB_TMO])) break; if (_sp > XB_SPIN_CAP) { atomicAdd(&(bar)[XB_TMO], 1u); break; } } } } while (0)
__device__ __forceinline__ void xcd_barrier_complete(unsigned* bar, unsigned x, unsigned& nloc, unsigned& nx) {
    const unsigned G = gridDim.x;
    unsigned sum, cnt, mine, sp = 0u;
    for (;;) {
        sum = 0u; cnt = 0u; mine = 0u;
#pragma unroll
        for (unsigned j = 0; j < 16; ++j) { const unsigned c = xb_ld(&bar[XB_XCNT(j)]); sum += c; cnt += (c > 0u) ? 1u : 0u; mine = (j == x) ? c : mine; }
        if (sum == G) break;
        __builtin_amdgcn_s_sleep(1);
        if ((++sp & 255u) == 0u) { if (xb_ld(&bar[XB_TMO])) break; if (sp > XB_SPIN_CAP) { atomicAdd(&bar[XB_TMO], 1u); break; } }
    }
    nloc = mine > 0u ? mine : 1u; nx = cnt > 0u ? cnt : 1u;
}
__device__ __forceinline__ void xcd_barrier(unsigned* bar, unsigned x, volatile LAS unsigned* st, int wv) {
    asm volatile("s_waitcnt vmcnt(0)" ::: "memory");
    __syncthreads();
    if (opaque_tid(wv) == 0) {
        __builtin_amdgcn_s_waitcnt(0);
        unsigned nloc = st[0], nx = st[1];
        if (nloc == 0u) { xcd_barrier_complete(bar, x, nloc, nx); st[0] = nloc; st[1] = nx; }
        const unsigned old = xb_add(&bar[XB_XSUB(x)], 1u);
        const unsigned gen = old / nloc;
        if (old + 1u == (gen + 1u) * nloc) {
            __builtin_amdgcn_fence(__ATOMIC_RELEASE, "agent");
            asm volatile("s_waitcnt vmcnt(0)" ::: "memory");
            const unsigned og = xb_add(&bar[XB_TOP], 1u);
            const unsigned tg = og / nx;
            if (og + 1u == (tg + 1u) * nx) xb_add(&bar[XB_TOPGEN], 1u);
            else XB_SPIN(xb_ld(&bar[XB_TOPGEN]) == tg, bar);
            __builtin_amdgcn_fence(__ATOMIC_ACQUIRE, "agent");
            xb_add(&bar[XB_XGEN(x)], 1u);
            asm volatile("s_waitcnt vmcnt(0)" ::: "memory");
        } else {
            XB_SPIN(xb_ld(&bar[XB_XGEN(x)]) == gen, bar);
            __builtin_amdgcn_fence(__ATOMIC_ACQUIRE, "agent");
            asm volatile("s_waitcnt vmcnt(0)" ::: "memory");
        }
    }
    __syncthreads();
}

struct TJob { const float* src; int ldw; int K; int N; bf16_t* dst; int ldt; };
__device__ __forceinline__ void transpose_item(const TJob& jb, int item, float* scr, int lane) {
    const int nblk = jb.N / 32, kb = item / nblk, nb = item % nblk, k0 = 64 * kb, n0 = 32 * nb;
#pragma unroll 8
    for (int i = 0; i < 32; ++i) { const int kk = 2 * i + (lane >> 5); scr[kk * 33 + (lane & 31)] = jb.src[(size_t)(k0 + kk) * jb.ldw + n0 + (lane & 31)]; }
    __builtin_amdgcn_s_waitcnt(0xc07f); asm volatile("" ::: "memory");
    const int c = lane & 7;
#pragma unroll
    for (int j = 0; j < 4; ++j) { const int n = (lane >> 3) + 8 * j; const float* s = scr + (8 * c) * 33 + n;
        u32x4 o; o.x = pk2(s[0 * 33], s[1 * 33]); o.y = pk2(s[2 * 33], s[3 * 33]); o.z = pk2(s[4 * 33], s[5 * 33]); o.w = pk2(s[6 * 33], s[7 * 33]);
        *(u32x4*)(jb.dst + (size_t)(n0 + n) * jb.ldt + k0 + 8 * c) = o; }
    __builtin_amdgcn_s_waitcnt(0xc07f); asm volatile("" ::: "memory");
}
__device__ __forceinline__ bf16_t* wl(const Params& p, int l) { return (bf16_t*)(p.ws + OFF_W) + (size_t)l * W_LAYER; }
__device__ __forceinline__ bf16_t* w_inT(const Params& p, int l) { return wl(p, l); }
__device__ __forceinline__ bf16_t* w_abT(const Params& p, int l) { return wl(p, l) + W_IN; }
__device__ __forceinline__ bf16_t* w_outT(const Params& p, int l) { return wl(p, l) + W_IN + W_AB; }
__device__ __forceinline__ bf16_t* w_upT(const Params& p, int l) { return wl(p, l) + W_IN + W_AB + W_OUT; }
__device__ __forceinline__ bf16_t* w_dnT(const Params& p, int l) { return wl(p, l) + W_IN + W_AB + W_OUT + W_UP; }

__device__ __forceinline__ void phase_weights(const Params& p, float* lds) {
    const int tid = opaque_tid(p.wv); const int wave = tid >> 6, lane = tid & 63;
    float* scr = lds + wave * (64 * 33);
    const int gw = blockIdx.x * 8 + wave, NGW = gridDim.x * 8;
    constexpr int I0 = 16 * 64, I1 = 16 * 64, I2 = 16 * 64, I3 = 8 * 32, I4 = 8 * 32, I5 = 16 * 32, I6 = 16 * 32, I7 = 16 * (NU / 32), I8 = (DFF / 64) * 32;
    constexpr int IL = I0 + I1 + I2 + I3 + I4 + I5 + I6 + I7 + I8;
    for (int it = gw; it < DEPTH * IL; it += NGW) {
        const int l = it / IL; int r = it % IL;
        TJob jb;
        const float* win = p.w_in + (size_t)l * 1024 * NIN;
        if (r < I0) { jb = {win, NIN, 1024, 2048, w_inT(p, l), 1024}; }
        else if ((r -= I0) < I1) { jb = {win + 2056, NIN, 1024, 2048, w_inT(p, l) + (size_t)2048 * 1024, 1024}; }
        else if ((r -= I1) < I2) { jb = {win + 4112, NIN, 1024, 2048, w_inT(p, l) + (size_t)4096 * 1024, 1024}; }
        else if ((r -= I2) < I3) { jb = {p.w_pa + (size_t)l * 512 * 1024, 1024, 512, 1024, w_abT(p, l), 512}; }
        else if ((r -= I3) < I4) { jb = {p.w_pb + (size_t)l * 512 * 1024, 1024, 512, 1024, w_abT(p, l) + (size_t)1024 * 512, 512}; }
        else if ((r -= I4) < I5) { jb = {p.w_out + (size_t)l * 1024 * 1024, 1024, 1024, 1024, w_outT(p, l), 2048}; }
        else if ((r -= I5) < I6) { jb = {p.w_out + (size_t)l * 1024 * 1024, 1024, 1024, 1024, w_outT(p, l) + 1024, 2048}; }
        else if ((r -= I6) < I7) { jb = {p.w_up + (size_t)l * 1024 * NU, NU, 1024, NU, w_upT(p, l), 1024}; }
        else { r -= I7; jb = {p.w_down + (size_t)l * DFF * 1024, 1024, DFF, 1024, w_dnT(p, l), DFF}; }
        transpose_item(jb, r, scr, lane);
    }
    float* wg = (float*)(p.ws + OFF_WG);
    for (int i = blockIdx.x * NTHREADS + tid; i < DEPTH * 16 * 1024; i += gridDim.x * NTHREADS) {
        const int l = i >> 14, g = (i >> 10) & 15, k = i & 1023;
        const int col = g < 8 ? 2048 + g : 4104 + (g - 8);
        wg[i] = p.w_in[((size_t)l * 1024 + k) * NIN + col];
    }
}

__device__ __forceinline__ void phase_ln(const Params& p, int mode, const bf16_t* src, int ldsrc, const float* gam, const float* bet,
                                         int gate_layer  , bool final_out) {
    const int tid = opaque_tid(p.wv); const int wave = tid >> 6, lane = tid & 63;
    bf16_t* X = (bf16_t*)(p.ws + OFF_X);
#define EOFF(j) (512 * ((j) >> 1) + lane * 8 + 4 * ((j) & 1))
    float* G = (float*)(p.ws + OFF_G);
    const float* wg = (const float*)(p.ws + OFF_WG) + (size_t)(gate_layer < 0 ? 0 : gate_layer) * 16 * 1024;
    const int stride = gridDim.x * 8;
    int row = blockIdx.x * 8 + wave;
    u32x4 c0 = (u32x4){0u, 0u, 0u, 0u}, c1 = c0;
    if (mode == 1) {
        while (row < SROW0 && (row % LPAD) >= LP) row += stride;
        if (row < MROWS) { const bf16_t* s_ = src + (size_t)row * ldsrc; c0 = *(const u32x4*)(s_ + lane * 8); c1 = *(const u32x4*)(s_ + 512 + lane * 8); }
    }
    while (row < MROWS) {
        int nrow = row + stride; u32x4 n0 = c0, n1 = c1;
        if (mode == 1) {
            while (nrow < SROW0 && (nrow % LPAD) >= LP) nrow += stride;
            if (nrow < MROWS) { const bf16_t* s_ = src + (size_t)nrow * ldsrc; n0 = *(const u32x4*)(s_ + lane * 8); n1 = *(const u32x4*)(s_ + 512 + lane * 8); }
        }
        int b = 0, t = 0; bool samp = row >= SROW0;
        if (!samp) { b = row / LPAD; t = row - b * LPAD; } else { b = (row - SROW0) >> 2; t = row & 3; }
        const bool valid = samp || t < LP;
        bf16_t* xo = X + (size_t)row * D;
        if (!valid) { if (mode == 0) {
#pragma unroll
                for (int jj = 0; jj < 2; ++jj) *(u32x4*)(xo + 512 * jj + lane * 8) = (u32x4){0u, 0u, 0u, 0u}; }
            row = nrow; c0 = n0; c1 = n1; continue; }
        f32x4 v[4];
        if (mode == 0) {
            const float* s = samp ? p.x_sample + ((size_t)b * LS + t) * D : (t < NMETA ? p.meta + (size_t)t * D : p.x_prompt + ((size_t)b * SEQ + (t - NMETA)) * D);
#pragma unroll
            for (int j = 0; j < 4; ++j) v[j] = *(const f32x4*)(s + EOFF(j));
        } else {
#pragma unroll
            for (int jj = 0; jj < 2; ++jj) { const u32x4 u = jj ? c1 : c0; v[2 * jj] = (f32x4){bflo(u.x), bfhi(u.x), bflo(u.y), bfhi(u.y)}; v[2 * jj + 1] = (f32x4){bflo(u.z), bfhi(u.z), bflo(u.w), bfhi(u.w)}; }
            if (row >= SPLIT_ROW0) { const bf16_t* sp = (const bf16_t*)(p.ws + OFF_GH) + (size_t)(row - SPLIT_ROW0) * D;
#pragma unroll
                for (int q = 0; q < 3; ++q)
#pragma unroll
                    for (int jj = 0; jj < 2; ++jj) { const u32x4 u = *(const u32x4*)(sp + (size_t)q * (MROWS - SPLIT_ROW0) * D + 512 * jj + lane * 8); v[2 * jj] += (f32x4){bflo(u.x), bfhi(u.x), bflo(u.y), bfhi(u.y)}; v[2 * jj + 1] += (f32x4){bflo(u.z), bfhi(u.z), bflo(u.w), bfhi(u.w)}; } }
        }
        float sum = 0.f;
#pragma unroll
        for (int j = 0; j < 4; ++j) sum += (v[j][0] + v[j][1]) + (v[j][2] + v[j][3]);
        const float mean = red64(sum) * (1.f / D);
        float s2 = 0.f;
#pragma unroll
        for (int j = 0; j < 4; ++j) { v[j] = v[j] - mean; s2 += (v[j][0] * v[j][0] + v[j][1] * v[j][1]) + (v[j][2] * v[j][2] + v[j][3] * v[j][3]); }
        const float rstd = rsqrtf(red64(s2) * (1.f / D) + 1e-5f);
#pragma unroll
        for (int j = 0; j < 4; ++j) { const f32x4 g4 = *(const f32x4*)(gam + EOFF(j)), b4 = *(const f32x4*)(bet + EOFF(j)); v[j] = v[j] * rstd * g4 + b4; }
#pragma unroll
        for (int jj = 0; jj < 2; ++jj) *(u32x4*)(xo + 512 * jj + lane * 8) = (u32x4){pk2(v[2 * jj][0], v[2 * jj][1]), pk2(v[2 * jj][2], v[2 * jj][3]), pk2(v[2 * jj + 1][0], v[2 * jj + 1][1]), pk2(v[2 * jj + 1][2], v[2 * jj + 1][3])};
        if (final_out) {
            float* o = nullptr;
            if (samp) o = p.out + o_ys + ((size_t)b * LS + t) * D; else if (t >= NMETA) o = p.out + o_yp + ((size_t)b * SEQ + (t - NMETA)) * D;
            if (o) {
#pragma unroll
                for (int j = 0; j < 4; ++j) *(f32x4*)(o + EOFF(j)) = v[j]; }
        }
        if (gate_layer >= 0) {
            float mine = 0.f;
#pragma unroll 2
            for (int g = 0; g < 16; ++g) {
                float a = 0.f;
#pragma unroll
                for (int j = 0; j < 4; ++j) { const f32x4 w4 = *(const f32x4*)(wg + g * 1024 + EOFF(j)); a += (v[j][0] * w4[0] + v[j][1] * w4[1]) + (v[j][2] * w4[2] + v[j][3] * w4[3]); }
                a = red64(a);
                if (lane == g) mine = a;
            }
            if (lane < 16) G[(size_t)row * 16 + lane] = mine;
        }
        row = nrow; c0 = n0; c1 = n1;
    }
#undef EOFF
}

constexpr int BM = 256, BK = 64, HALF = 128, HT = HALF * BK, NXCD = 8, WGM = 4;
__device__ __forceinline__ int lds_byte(int r, int c) { int st = (r >> 4) * 2 + (c >> 5), rr = r & 15, cc = c & 31, ob = rr * 64 + cc * 2; return st * 1024 + (ob ^ (((ob >> 9) & 1) << 5)); }
__device__ __forceinline__ void stage_rc(int b, int& R, int& C) { int st = b / 1024, sb = b % 1024, swz = sb ^ (((sb >> 9) & 1) << 5); R = (st >> 1) * 16 + swz / 64; C = (st & 1) * 32 + (swz % 64) / 2; }

struct GemmArgs { const bf16_t* A; const bf16_t* A2; int a2_from_pn; int lda; const bf16_t* Bt; int M, N, K; int splitk; };

template <class Epi>
__device__ __forceinline__ void gemm_phase(const GemmArgs g, const Epi& epi, int wv) {
    extern __shared__ __attribute__((aligned(16))) unsigned char smem_raw[];
    bf16_t* shm = (bf16_t*)smem_raw;
#define SA(b, h) (shm + ((b) * 2 + (h)) * HT)
#define SB(b, h) (shm + (4 + (b) * 2 + (h)) * HT)
#define STAGE_A(P_, br, kt) do { const char* _gb = (const char*)(A + (size_t)(br) * lda + (size_t)((kt) + kofs) * BK); \
    unsigned _o0 = offA0, _o1 = offA1; asm volatile("" : "+v"(_o0), "+v"(_o1)); \
    __builtin_amdgcn_global_load_lds((const unsigned*)(_gb + _o0), (unsigned*)((char*)(P_) + tid * 16), 16, 0, 0); \
    __builtin_amdgcn_global_load_lds((const unsigned*)(_gb + _o1), (unsigned*)((char*)(P_) + tid * 16 + 8192), 16, 0, 0); } while (0)
#define STAGE_B(P_, bc, kt) do { const char* _gb = (const char*)(Bt + (size_t)(bc) * K + (size_t)((kt) + kofs) * BK); \
    unsigned _o0 = offB0, _o1 = offB1; asm volatile("" : "+v"(_o0), "+v"(_o1)); \
    __builtin_amdgcn_global_load_lds((const unsigned*)(_gb + _o0), (unsigned*)((char*)(P_) + tid * 16), 16, 0, 0); \
    __builtin_amdgcn_global_load_lds((const unsigned*)(_gb + _o1), (unsigned*)((char*)(P_) + tid * 16 + 8192), 16, 0, 0); } while (0)
#define LDA(dst, b, h) for (int m = 0; m < 4; ++m) for (int k = 0; k < 2; ++k) \
    dst[m][k] = *reinterpret_cast<const bf16x8*>((char*)SA(b, h) + lds_byte(wr * 64 + m * 16 + fr, k * 32 + fq * 8))
#define LDB(dst, b, h) for (int n = 0; n < 2; ++n) for (int k = 0; k < 2; ++k) \
    dst[n][k] = *reinterpret_cast<const bf16x8*>((char*)SB(b, h) + lds_byte(wc * 32 + n * 16 + fr, k * 32 + fq * 8))
#define MMA(ai, bj, At_, Bt_) do { __builtin_amdgcn_s_setprio(1); \
    for (int m = 0; m < 4; ++m) for (int n = 0; n < 2; ++n) for (int k = 0; k < 2; ++k) \
      acc[ai][bj][m][n] = __builtin_amdgcn_mfma_f32_16x16x32_bf16(Bt_[n][k], At_[m][k], acc[ai][bj][m][n], 0, 0, 0); \
    __builtin_amdgcn_s_setprio(0); } while (0)
#define WAIT_V(n) asm volatile("s_waitcnt vmcnt(" #n ")" ::: "memory")
#define WAIT_L(n) asm volatile("s_waitcnt lgkmcnt(" #n ")" ::: "memory")
#define BAR __builtin_amdgcn_s_barrier()
#define SCHED __builtin_amdgcn_sched_barrier(0)
    const int lda = g.lda, K = g.K; const bf16_t* Bt = g.Bt;
    const int nMall = g.M / BM, nN = g.N / BM, nM = g.splitk ? 64 : nMall, nwg = nM * nN, nunits = nwg + (nMall - nM) * nN * 4;
    const int tid = opaque_tid(wv);
    const int wid = tid >> 6, lane = tid & 63, wr = wid >> 2, wc = wid & 3, fr = lane & 15, fq = lane >> 4;
    const int ntK = K / BK;
    unsigned offA0, offA1, offB0, offB1;
    { int r0, c0, r1, c1; stage_rc(tid * 16, r0, c0); stage_rc(tid * 16 + 8192, r1, c1);
      offA0 = (unsigned)(r0 * lda + c0) * 2u; offA1 = (unsigned)(r1 * lda + c1) * 2u;
      const int p0 = (r0 & ~31) + 8 * ((r0 & 15) >> 2) + 4 * ((r0 >> 4) & 1) + (r0 & 3), p1 = (r1 & ~31) + 8 * ((r1 & 15) >> 2) + 4 * ((r1 >> 4) & 1) + (r1 & 3);
      offB0 = (unsigned)(p0 * K + c0) * 2u; offB1 = (unsigned)(p1 * K + c1) * 2u; }
    for (int Lt = blockIdx.x; Lt < nunits; Lt += gridDim.x) {
        int pm, pn, kofs = 0, nt = ntK, split = 0;
        if (Lt < nwg) {
            int wgid = Lt;
            { int q = nwg / NXCD, r = nwg % NXCD, xcd = wgid % NXCD, off = wgid / NXCD; wgid = (xcd < r ? xcd * (q + 1) : r * (q + 1) + (xcd - r) * q) + off; }
            const int nig = WGM * nN, gid = wgid / nig, fm = gid * WGM, gsz = min(nM - fm, WGM);
            pm = fm + ((wgid % nig) % gsz); pn = (wgid % nig) / gsz;
        } else {
            const int u = Lt - nwg, tl = u >> 2; split = u & 3; pm = nM + tl / nN; pn = tl % nN;
            const int q4 = ntK >> 2;
            if (q4 & 1) { nt = split < 2 ? q4 + 1 : q4 - 1; kofs = split < 2 ? split * (q4 + 1) : 2 * (q4 + 1) + (split - 2) * (q4 - 1); } else { nt = q4; kofs = split * q4; }
        }
        const int brow = pm * BM, bcol = pn * BM;
        const bf16_t* A = (pn >= g.a2_from_pn) ? g.A2 : g.A;
        f32x4 acc[2][2][4][2] = {};
        bf16x8 At[4][2], B0[2][2], B1[2][2];
        STAGE_B(SB(0, 0), bcol, 0); STAGE_A(SA(0, 0), brow, 0);
        STAGE_B(SB(0, 1), bcol + HALF, 0); STAGE_A(SA(0, 1), brow + HALF, 0);
        if (wr == 1) BAR;
        WAIT_V(4); BAR;
        STAGE_B(SB(1, 0), bcol, 1); STAGE_A(SA(1, 0), brow, 1); STAGE_B(SB(1, 1), bcol + HALF, 1);
        WAIT_V(6); BAR;
        for (int t = 0; t < nt - 2; t += 2) {
            LDB(B0, 0, 0); SCHED; LDA(At, 0, 0); STAGE_A(SA(1, 1), brow + HALF, t + 1);
            WAIT_L(8); BAR; WAIT_L(0); MMA(0, 0, At, B0); BAR; SCHED;
            LDB(B1, 0, 1); STAGE_B(SB(0, 0), bcol, t + 2);
            BAR; WAIT_L(0); MMA(0, 1, At, B1); BAR;
            LDA(At, 0, 1); STAGE_A(SA(0, 0), brow, t + 2);
            BAR; WAIT_L(0); MMA(1, 0, At, B0); BAR; SCHED;
            STAGE_B(SB(0, 1), bcol + HALF, t + 2);
            WAIT_V(6); BAR; MMA(1, 1, At, B1); BAR;
            LDB(B0, 1, 0); SCHED; LDA(At, 1, 0); STAGE_A(SA(0, 1), brow + HALF, t + 2);
            WAIT_L(8); BAR; WAIT_L(0); MMA(0, 0, At, B0); BAR; SCHED;
            LDB(B1, 1, 1); STAGE_B(SB(1, 0), bcol, t + 3);
            BAR; WAIT_L(0); MMA(0, 1, At, B1); BAR;
            LDA(At, 1, 1); STAGE_A(SA(1, 0), brow, t + 3);
            BAR; WAIT_L(0); MMA(1, 0, At, B0); BAR; SCHED;
            STAGE_B(SB(1, 1), bcol + HALF, t + 3);
            WAIT_V(6); BAR; MMA(1, 1, At, B1); BAR;
        }
        { LDB(B0, 0, 0); LDA(At, 0, 0); STAGE_A(SA(1, 1), brow + HALF, nt - 1);
          BAR; WAIT_L(0); MMA(0, 0, At, B0); BAR;
          LDB(B1, 0, 1); BAR; WAIT_L(0); MMA(0, 1, At, B1); BAR;
          LDA(At, 0, 1); WAIT_V(4); BAR; WAIT_L(0); MMA(1, 0, At, B0); MMA(1, 1, At, B1); BAR; }
        { LDB(B0, 1, 0); LDA(At, 1, 0); WAIT_V(2); BAR; WAIT_L(0); MMA(0, 0, At, B0); BAR;
          LDB(B1, 1, 1); WAIT_V(0); BAR; WAIT_L(0); MMA(0, 1, At, B1); BAR;
          LDA(At, 1, 1); BAR; WAIT_L(0); MMA(1, 0, At, B0); MMA(1, 1, At, B1); BAR; }
        if (wr == 0) BAR;
        int erow = brow + wr * 64 + fr, ecol = bcol + wc * 32 + fq * 8;
        asm volatile("" : "+v"(erow), "+v"(ecol));
#pragma unroll
        for (int ai = 0; ai < 2; ++ai)
#pragma unroll
            for (int m = 0; m < 4; ++m) {
                const int row = erow + ai * HALF + m * 16;
#pragma unroll
                for (int bj = 0; bj < 2; ++bj) epi(row, ecol + bj * HALF, acc[ai][bj][m][0], acc[ai][bj][m][1], split);
                if (m & 1) SCHED;
            }
    }
#undef SA
#undef SB
}

struct EpiP {
    bf16_t* P; bf16_t* GH; float* out; int l;
    __device__ __forceinline__ void operator()(int row, int col, f32x4 v, f32x4 w, int split) const {
        const u32x4 o = (u32x4){pk2(v[0], v[1]), pk2(v[2], v[3]), pk2(w[0], w[1]), pk2(w[2], w[3])};
        *(u32x4*)(P + (size_t)row * NP + col) = o;
        if (col >= cBQ && col < cZ) {
            const int c = col - cBQ;
            if ((row & 31) >= 29) *(u32x4*)(GH + ((size_t)(row >> 5) * 3 + ((row & 31) - 29)) * 1536 + c) = o;
            if (row < SROW0) { const int b = row / LPAD, t = row - b * LPAD; if (t >= LP - 3 && t < LP) { float* d = out + o_pgc + ((size_t)(l * NB + b) * 3 + (t - (LP - 3))) * 1536 + c; *(f32x4*)d = v; *(f32x4*)(d + 4) = w; } }
            else { const int s = (row - SROW0) >> 2, t = row & 3; if (t >= 1) { float* d = out + o_sgc + ((size_t)(l * NS + s) * 3 + (t - 1)) * 1536 + c; *(f32x4*)d = v; *(f32x4*)(d + 4) = w; } }
        }
    }
};
struct EpiMerge {
    bf16_t* P;
    __device__ __forceinline__ void operator()(int row, int col, f32x4 v, f32x4 w, int split) const {
        u32x4* ptr = (u32x4*)(P + (size_t)row * NP + cMG + col); const u32x4 gm = *ptr;
        v[0] *= sigmoidf_(bflo(gm.x)); v[1] *= sigmoidf_(bfhi(gm.x)); v[2] *= sigmoidf_(bflo(gm.y)); v[3] *= sigmoidf_(bfhi(gm.y));
        w[0] *= sigmoidf_(bflo(gm.z)); w[1] *= sigmoidf_(bfhi(gm.z)); w[2] *= sigmoidf_(bflo(gm.w)); w[3] *= sigmoidf_(bfhi(gm.w));
        *ptr = (u32x4){pk2(v[0], v[1]), pk2(v[2], v[3]), pk2(w[0], w[1]), pk2(w[2], w[3])};
    }
};
struct EpiRes {
    const bf16_t* X; bf16_t* O; int ldo; int ocol0; bf16_t* SCR;
    __device__ __forceinline__ void operator()(int row, int col, f32x4 v, f32x4 w, int split) const {
        if (split == 0) {
            const u32x4 x = *(const u32x4*)(X + (size_t)row * D + col);
            v[0] += ALPHA * bflo(x.x); v[1] += ALPHA * bfhi(x.x); v[2] += ALPHA * bflo(x.y); v[3] += ALPHA * bfhi(x.y);
            w[0] += ALPHA * bflo(x.z); w[1] += ALPHA * bfhi(x.z); w[2] += ALPHA * bflo(x.w); w[3] += ALPHA * bfhi(x.w);
            *(u32x4*)(O + (size_t)row * ldo + ocol0 + col) = (u32x4){pk2(v[0], v[1]), pk2(v[2], v[3]), pk2(w[0], w[1]), pk2(w[2], w[3])};
        } else *(u32x4*)(SCR + ((size_t)(split - 1) * (MROWS - SPLIT_ROW0) + (row - SPLIT_ROW0)) * D + col) = (u32x4){pk2(v[0], v[1]), pk2(v[2], v[3]), pk2(w[0], w[1]), pk2(w[2], w[3])};
    }
};
struct EpiUp {
    bf16_t* U; bf16_t* HB; float* out; int l;
    __device__ __forceinline__ void operator()(int row, int col, f32x4 v, f32x4 w, int split) const {
        const u32x4 o = (u32x4){pk2(v[0], v[1]), pk2(v[2], v[3]), pk2(w[0], w[1]), pk2(w[2], w[3])};
        *(u32x4*)(U + (size_t)row * NU + col) = o;
        if ((row & 31) >= 30) *(u32x4*)(HB + ((size_t)(row >> 5) * 2 + (row & 1)) * NU + col) = o;
        if (row < SROW0) { const int b = row / LPAD, t = row - b * LPAD; if (t >= LP - 2 && t < LP) { float* d = out + o_pfc + ((size_t)(l * NB + b) * 2 + (t - (LP - 2))) * NU + col; *(f32x4*)d = v; *(f32x4*)(d + 4) = w; } }
        else { const int s = (row - SROW0) >> 2, t = row & 3; if (t >= 2) { float* d = out + o_sfc + ((size_t)(l * NS + s) * 2 + (t - 2)) * NU + col; *(f32x4*)d = v; *(f32x4*)(d + 4) = w; } }
    }
};

constexpr int SBUF = 32 * 128 * 2 + 32 * 32 + 32 * 16;
__device__ __forceinline__ float* QB(float* lds, int b) { return lds + b * SBUF; }
__device__ __forceinline__ float* KB(float* lds, int b) { return lds + b * SBUF + 4096; }
__device__ __forceinline__ float* VB(float* lds, int b) { return lds + b * SBUF + 8192; }
__device__ __forceinline__ float* SCB(float* lds, int b) { return lds + b * SBUF + 9216; }
__device__ __forceinline__ float* OB(float* lds, int b) { return lds + 2 * SBUF + b * 1024; }

__device__ __forceinline__ void store_out_blk(bf16_t* P, int row0, int jb, int L, int pcol, const float* ob, int ptid) {
    const int tt = ptid >> 3, g = ptid & 7, t0 = jb * 32;
    if (t0 + tt < L) { const f32x4 v = *(const f32x4*)(ob + tt * 32 + g * 4);
        *(u32x2*)(P + (size_t)(row0 + t0 + tt) * NP + pcol + g * 4) = (u32x2){pk2(v[0], v[1]), pk2(v[2], v[3])}; }
}
__device__ __forceinline__ f32x2 lo2(f32x4 v) { return __builtin_shufflevector(v, v, 0, 1); }
__device__ __forceinline__ f32x2 hi2(f32x4 v) { return __builtin_shufflevector(v, v, 2, 3); }
__device__ __forceinline__ f32x2 bc2(float x) { return (f32x2){x, x}; }
__device__ __forceinline__ float dot16(const f32x4* a, const float* kp) {
    float s = 0.f;
#pragma unroll
    for (int i = 0; i < 4; ++i) { const f32x4 b = *(const f32x4*)(kp + 4 * i); s += (a[i][0] * b[0] + a[i][1] * b[1]) + (a[i][2] * b[2] + a[i][3] * b[3]); }
    return s;
}

struct StageRegs { f32x4 &q0, &q1, &k0, &k1, &v, &r0, &x0, &x1; };
__device__ __forceinline__ f32x4 asf(u32x4 u) { return __builtin_bit_cast(f32x4, u); }
__device__ __forceinline__ u32x4 asu(f32x4 f) { return __builtin_bit_cast(u32x4, f); }
#define BARRIER_LDS() asm volatile("s_waitcnt lgkmcnt(0)\n\ts_barrier" ::: "memory")
__device__ __forceinline__ void issue_mlstm(const Params& p, int h, int qtr, int row0, int L, int jb, int ptid, StageRegs& r) {
    const bf16_t* P = (const bf16_t*)(p.ws + OFF_P); const float* G = (const float*)(p.ws + OFF_G);
    const int tt = ptid >> 3, g = ptid & 7, t0 = jb * 32;
    if (t0 + tt >= L) return;
    const int row = row0 + t0 + tt;
    const bf16_t* prow = P + (size_t)row * NP;
    r.q0 = asf(*(const u32x4*)(prow + cQ + h * 128 + g * 16)); r.q1 = asf(*(const u32x4*)(prow + cQ + h * 128 + g * 16 + 8));
    r.k0 = asf(*(const u32x4*)(prow + cK + h * 128 + g * 16)); r.k1 = asf(*(const u32x4*)(prow + cK + h * 128 + g * 16 + 8));
    { const u32x2 vv_ = *(const u32x2*)(prow + cV + h * 128 + qtr * 32 + g * 4); r.v = asf((u32x4){vv_.x, vv_.y, 0u, 0u}); }
    if (g == 0) { const float* gr = G + (size_t)row * 16; r.r0 = (f32x4){gr[h], gr[4 + h], 0.f, 0.f}; }
}
__device__ __forceinline__ void commit_mlstm(const Params& p, int l, int h, int L, int jb, float* lds, int ptid, const StageRegs& r, int bsel = -1) {
    const int tt = ptid >> 3, g = ptid & 7, t0 = jb * 32, b = bsel >= 0 ? bsel : (jb & 1);
    if (t0 + tt >= L) return;
    float x[16]; f32x4 qs[4];
    unpack8(asu(r.q0), x); unpack8(asu(r.q1), x + 8);
    float* qd = QB(lds, b) + tt * 128 + g * 16;
#pragma unroll
    for (int i = 0; i < 4; ++i) { qs[i] = (f32x4){x[4 * i], x[4 * i + 1], x[4 * i + 2], x[4 * i + 3]} * 0.08838834764831845f; *(f32x4*)(qd + 4 * i) = qs[i]; }
    unpack8(asu(r.k0), x); unpack8(asu(r.k1), x + 8);
    float* kd = KB(lds, b) + tt * 128 + g * 16;
#pragma unroll
    for (int i = 0; i < 4; ++i) *(f32x4*)(kd + 4 * i) = (f32x4){x[4 * i], x[4 * i + 1], x[4 * i + 2], x[4 * i + 3]};
    *(f32x4*)(VB(lds, b) + tt * 32 + g * 4) = (f32x4){bflo(asu(r.v).x), bfhi(asu(r.v).x), bflo(asu(r.v).y), bfhi(asu(r.v).y)};
    const float* kmb = KB(lds, b) + (tt & ~3) * 128 + g * 16;
    f32x4 qk;
#pragma unroll
    for (int j = 0; j < 4; ++j) qk[j] = red8(dot16(qs, kmb + j * 128));
    if (g == 0) {
        const float ig = r.r0[0] + p.gate_bias[l * 8 + h], f = r.r0[1] + p.gate_bias[l * 8 + 4 + h];
        const float lf = fminf(f, 0.f) - log1pf(__expf(-fabsf(f)));
        float* sc = SCB(lds, b) + tt * 16; *(f32x2*)sc = (f32x2){ig, lf}; *(f32x4*)(sc + 4) = qk; }
}

__device__ __forceinline__ void scan_mlstm(const Params& p, int l, bool samp, int bs, int h, int qtr, int row0, int L, float* lds) {
    const int tid = opaque_tid(p.wv); const bool cons = tid < 256; const int ptid = tid - 256;
    const int lane = tid & 63, w = (tid >> 6) & 3, s = lane & 7, cl = w * 8 + (lane >> 3), col = qtr * 32 + cl;
    const int e2 = 2 * (lane >> 3), nd = (e2 >> 2) * 32 + s * 4 + (e2 & 3);
    bf16_t* P = (bf16_t*)(p.ws + OFF_P);
    f32x2 C[8]; float n0v = 0.f, n1v = 0.f, m = 0.f;
#pragma unroll
    for (int e = 0; e < 8; ++e) C[e] = bc2(0.f);
    if (cons && samp) {
        const size_t sh = (size_t)(l * NS + bs) * 4 + h;
        const float* C0 = p.st_C + sh * 16384;
#pragma unroll
        for (int e = 0; e < 16; ++e) { const int d = (e >> 2) * 32 + s * 4 + (e & 3); C[e >> 1][e & 1] = C0[d * 128 + col]; }
        n0v = p.st_n[sh * 128 + nd]; n1v = p.st_n[sh * 128 + nd + 1]; m = p.st_m[sh];
    }
    const int nblk = (L + 31) >> 5;
    f32x4 k4[4][4];
    StageRegs sr{k4[0][0], k4[0][1], k4[0][2], k4[0][3], k4[1][0], k4[1][1], k4[1][2], k4[1][3]};
    if (!cons) { issue_mlstm(p, h, qtr, row0, L, 0, ptid, sr); commit_mlstm(p, l, h, L, 0, lds, ptid, sr); if (1 < nblk) issue_mlstm(p, h, qtr, row0, L, 1, ptid, sr); }
    BARRIER_LDS();
    for (int jb = 0; jb < nblk; ++jb) {
        if (!cons) {
            if (jb + 1 < nblk) commit_mlstm(p, l, h, L, jb + 1, lds, ptid, sr);
            if (jb + 2 < nblk) issue_mlstm(p, h, qtr, row0, L, jb + 2, ptid, sr);
            if (jb > 0) store_out_blk(P, row0, jb - 1, L, cV + h * 128 + qtr * 32, OB(lds, (jb - 1) & 1), ptid);
        } else {
            const float* qb = QB(lds, jb & 1); const float* kb = KB(lds, jb & 1); const float* vb = VB(lds, jb & 1); const float* sc = SCB(lds, jb & 1);
            float* ob = OB(lds, jb & 1);
            const int nt = min(32, L - jb * 32);
            f32x4 q4[4][4]; f32x2 kn[4], qn[4]; float vv[4], ig[4], lf[4]; f32x4 qk[4];
#define MLOAD_Q(T0) do { _Pragma("unroll") for (int i = 0; i < 4; ++i) { const int t = (T0) + i; \
        _Pragma("unroll") for (int j = 0; j < 4; ++j) q4[i][j] = *(const f32x4*)(qb + t * 128 + j * 32 + s * 4); \
        qn[i] = *(const f32x2*)(qb + t * 128 + nd); } } while (0)
#define MLOAD_K(T0) do { _Pragma("unroll") for (int i = 0; i < 4; ++i) { const int t = (T0) + i; \
        const f32x2 gg = *(const f32x2*)(sc + t * 16); ig[i] = gg[0]; lf[i] = gg[1]; \
        qk[i] = *(const f32x4*)(sc + t * 16 + 4); vv[i] = vb[t * 32 + cl]; } \
      _Pragma("unroll") for (int i = 0; i < 4; ++i) { const int t = (T0) + i; \
        _Pragma("unroll") for (int j = 0; j < 4; ++j) k4[i][j] = *(const f32x4*)(kb + t * 128 + j * 32 + s * 4); \
        kn[i] = *(const f32x2*)(kb + t * 128 + nd); } } while (0)
            MLOAD_Q(0); MLOAD_K(0);
#pragma unroll 1
            for (int t0 = 0; t0 < nt; t0 += 4) {
                float d[4], dn[4];
                const int tn = min(t0 + 4, 28);
                __builtin_amdgcn_sched_barrier(0);
#pragma unroll
                for (int i = 0; i < 4; ++i) {
                    f32x2 a = bc2(0.f), a2 = bc2(0.f);
#pragma unroll
                    for (int j = 0; j < 4; ++j) { a = lo2(q4[i][j]) * C[2 * j] + a; a2 = hi2(q4[i][j]) * C[2 * j + 1] + a2; }
                    a = a + a2;
                    d[i] = a[0] + a[1]; dn[i] = qn[i][0] * n0v + qn[i][1] * n1v;
                }
                __builtin_amdgcn_sched_barrier(0);
                MLOAD_Q(tn);
                __builtin_amdgcn_sched_barrier(0);
#pragma unroll
                for (int i = 0; i < 4; ++i) { d[i] = red8(d[i]); dn[i] = red64(dn[i]); }
                float fp[4], ip[4], em[4];
#pragma unroll
                for (int i = 0; i < 4; ++i) { const float mn = fmaxf(lf[i] + m, ig[i]); fp[i] = __expf(lf[i] + m - mn); ip[i] = __expf(ig[i] - mn); em[i] = __expf(-mn); m = mn; }
                const float F0 = fp[0], F1 = F0 * fp[1], F2 = F1 * fp[2], F3 = F2 * fp[3];
                const float g00 = ip[0], g10 = g00 * fp[1], g11 = ip[1], g20 = g10 * fp[2], g21 = g11 * fp[2], g22 = ip[2];
                const float g30 = g20 * fp[3], g31 = g21 * fp[3], g32 = g22 * fp[3], g33 = ip[3];
                const float s00 = g00 * qk[0][0];
                const float s10 = g10 * qk[1][0], s11 = g11 * qk[1][1];
                const float s20 = g20 * qk[2][0], s21 = g21 * qk[2][1], s22 = g22 * qk[2][2];
                const float s30 = g30 * qk[3][0], s31 = g31 * qk[3][1], s32 = g32 * qk[3][2], s33 = g33 * qk[3][3];
                const float num0 = F0 * d[0] + s00 * vv[0], den0 = F0 * dn[0] + s00;
                const float num1 = F1 * d[1] + s10 * vv[0] + s11 * vv[1], den1 = F1 * dn[1] + s10 + s11;
                const float num2 = F2 * d[2] + s20 * vv[0] + s21 * vv[1] + s22 * vv[2], den2 = F2 * dn[2] + s20 + s21 + s22;
                const float num3 = F3 * d[3] + s30 * vv[0] + s31 * vv[1] + s32 * vv[2] + s33 * vv[3], den3 = F3 * dn[3] + s30 + s31 + s32 + s33;
                if (s == 0) {
                    ob[(t0 + 0) * 32 + cl] = num0 / fmaxf(fabsf(den0), em[0]); ob[(t0 + 1) * 32 + cl] = num1 / fmaxf(fabsf(den1), em[1]);
                    ob[(t0 + 2) * 32 + cl] = num2 / fmaxf(fabsf(den2), em[2]); ob[(t0 + 3) * 32 + cl] = num3 / fmaxf(fabsf(den3), em[3]);
                }
                const float c0 = g30 * vv[0], c1 = g31 * vv[1], c2 = g32 * vv[2], c3 = g33 * vv[3];
#pragma unroll
                for (int j = 0; j < 4; ++j) {
                    C[2 * j] = lo2(k4[3][j]) * bc2(c3) + (lo2(k4[2][j]) * bc2(c2) + (lo2(k4[1][j]) * bc2(c1) + (lo2(k4[0][j]) * bc2(c0) + C[2 * j] * bc2(F3))));
                    C[2 * j + 1] = hi2(k4[3][j]) * bc2(c3) + (hi2(k4[2][j]) * bc2(c2) + (hi2(k4[1][j]) * bc2(c1) + (hi2(k4[0][j]) * bc2(c0) + C[2 * j + 1] * bc2(F3)))); }
                n0v = n0v * F3 + (kn[0][0] * g30 + kn[1][0] * g31) + (kn[2][0] * g32 + kn[3][0] * g33);
                n1v = n1v * F3 + (kn[0][1] * g30 + kn[1][1] * g31) + (kn[2][1] * g32 + kn[3][1] * g33);
                __builtin_amdgcn_sched_barrier(0);
                MLOAD_K(tn);
            }
#undef MLOAD_Q
#undef MLOAD_K
        }
        BARRIER_LDS();
    }
    if (!cons) store_out_blk(P, row0, nblk - 1, L, cV + h * 128 + qtr * 32, OB(lds, (nblk - 1) & 1), ptid);
    else {
        const size_t sh = samp ? (size_t)(l * NS + bs) * 4 + h : (size_t)(l * NB + bs) * 4 + h;
        float* Co = p.out + (samp ? o_sC : o_pC) + sh * 16384;
#pragma unroll
        for (int e = 0; e < 16; ++e) { const int d = (e >> 2) * 32 + s * 4 + (e & 3); Co[d * 128 + col] = C[e >> 1][e & 1]; }
        if (qtr == 0 && w == 0) { float* no = p.out + (samp ? o_sn : o_pn) + sh * 128; no[nd] = n0v; no[nd + 1] = n1v;
            if (lane == 0) p.out[(samp ? o_sm : o_pm) + sh] = m; }
    }
    BARRIER_LDS();
}


constexpr int ST_LD = 33;
__device__ __forceinline__ float* STB(float* lds, int b) { return lds + 2 * SBUF + 2048 + b * (128 * ST_LD); }
__device__ __forceinline__ void st_issue(const float* S0, int qtr, int ptid, f32x4& a0, f32x4& a1, f32x4& a2, f32x4& a3) {
    const int d = ptid >> 3, c = (ptid & 7) * 4; const float* b = S0 + d * 128 + qtr * 32 + c;
    a0 = *(const f32x4*)b; a1 = *(const f32x4*)(b + 32 * 128); a2 = *(const f32x4*)(b + 64 * 128); a3 = *(const f32x4*)(b + 96 * 128);
}
__device__ __forceinline__ void st_commit(float* st, int ptid, const f32x4& a0, const f32x4& a1, const f32x4& a2, const f32x4& a3) {
    const int d = ptid >> 3, c = (ptid & 7) * 4; float* b = st + d * ST_LD + c;
#pragma unroll
    for (int i = 0; i < 4; ++i) { b[i] = a0[i]; b[32 * ST_LD + i] = a1[i]; b[64 * ST_LD + i] = a2[i]; b[96 * ST_LD + i] = a3[i]; }
}
__device__ __forceinline__ void st_store(float* So, int qtr, const float* st, int ptid) {
    const int d = ptid >> 3, c = (ptid & 7) * 4; const float* b = st + d * ST_LD + c; float* o = So + d * 128 + qtr * 32 + c;
#pragma unroll
    for (int q = 0; q < 4; ++q) *(f32x4*)(o + q * 32 * 128) = (f32x4){b[q * 32 * ST_LD], b[q * 32 * ST_LD + 1], b[q * 32 * ST_LD + 2], b[q * 32 * ST_LD + 3]};
}
__device__ __forceinline__ void scan_mlstm_stream(const Params& p, int l, int h, int qtr, int bs0, int nseq, float* lds) {
    const int tid = opaque_tid(p.wv); const bool cons = tid < 256; const int ptid = tid - 256;
    const int lane = tid & 63, w = (tid >> 6) & 3, s = lane & 7, cl = w * 8 + (lane >> 3), col = qtr * 32 + cl;
    const int e2 = 2 * (lane >> 3), nd = (e2 >> 2) * 32 + s * 4 + (e2 & 3);
    bf16_t* P = (bf16_t*)(p.ws + OFF_P);
    f32x2 C[8]; float n0v = 0.f, n1v = 0.f, m = 0.f, n0n = 0.f, n1n = 0.f, mnx = 0.f;
#pragma unroll
    for (int e = 0; e < 8; ++e) C[e] = bc2(0.f);
    f32x4 k4[4][4];
    StageRegs sr{k4[0][0], k4[0][1], k4[0][2], k4[0][3], k4[1][0], k4[1][1], k4[1][2], k4[1][3]};
#define LOADSTATE(BS) do { const size_t sh_ = (size_t)(l * NS + (BS)) * 4 + h; n0n = p.st_n[sh_ * 128 + nd]; n1n = p.st_n[sh_ * 128 + nd + 1]; mnx = p.st_m[sh_]; } while (0)
#define STISSUE(BS) st_issue(p.st_C + ((size_t)(l * NS + (BS)) * 4 + h) * 16384, qtr, ptid, k4[2][0], k4[2][1], k4[2][2], k4[2][3])
    if (!cons) { issue_mlstm(p, h, qtr, SROW0 + bs0 * 4, LS, 0, ptid, sr); STISSUE(bs0); } else LOADSTATE(bs0);
#pragma unroll 1
    for (int k = 0; k < nseq; ++k) {
        const int bs = bs0 + 8 * k, row0 = SROW0 + bs * 4;
        if (!cons) { commit_mlstm(p, l, h, LS, 0, lds, ptid, sr, k & 1); st_commit(STB(lds, k & 1), ptid, k4[2][0], k4[2][1], k4[2][2], k4[2][3]);
            if (k + 1 < nseq) { issue_mlstm(p, h, qtr, row0 + 32, LS, 0, ptid, sr); STISSUE(bs + 8); } }
        else {
            n0v = n0n; n1v = n1n; m = mnx;
            if (k + 1 < nseq) LOADSTATE(bs + 8);
        }
        BARRIER_LDS();
        if (!cons) { if (k > 0) { store_out_blk(P, row0 - 32, 0, LS, cV + h * 128 + qtr * 32, OB(lds, (k - 1) & 1), ptid); st_store(p.out + o_sC + ((size_t)(l * NS + bs - 8) * 4 + h) * 16384, qtr, STB(lds, (k - 1) & 1), ptid); } }
        else {
            const float* qb = QB(lds, k & 1); const float* kb = KB(lds, k & 1); const float* vb = VB(lds, k & 1); const float* sc = SCB(lds, k & 1);
            float* ob = OB(lds, k & 1); float* stb = STB(lds, k & 1);
#pragma unroll
            for (int e = 0; e < 16; ++e) { const int d = (e >> 2) * 32 + s * 4 + (e & 3); C[e >> 1][e & 1] = stb[d * ST_LD + cl]; }
            f32x4 q4[4][4]; f32x2 kn[4], qn[4]; float vv[4], ig[4], lf[4]; f32x4 qk[4];
#define MLOAD_Q(T0) do { _Pragma("unroll") for (int i = 0; i < 4; ++i) { const int t = (T0) + i; \
        _Pragma("unroll") for (int j = 0; j < 4; ++j) q4[i][j] = *(const f32x4*)(qb + t * 128 + j * 32 + s * 4); \
        qn[i] = *(const f32x2*)(qb + t * 128 + nd); } } while (0)
#define MLOAD_K(T0) do { _Pragma("unroll") for (int i = 0; i < 4; ++i) { const int t = (T0) + i; \
        const f32x2 gg = *(const f32x2*)(sc + t * 16); ig[i] = gg[0]; lf[i] = gg[1]; \
        qk[i] = *(const f32x4*)(sc + t * 16 + 4); vv[i] = vb[t * 32 + cl]; } \
      _Pragma("unroll") for (int i = 0; i < 4; ++i) { const int t = (T0) + i; \
        _Pragma("unroll") for (int j = 0; j < 4; ++j) k4[i][j] = *(const f32x4*)(kb + t * 128 + j * 32 + s * 4); \
        kn[i] = *(const f32x2*)(kb + t * 128 + nd); } } while (0)
            MLOAD_Q(0); MLOAD_K(0);
            {
                float d[4], dn[4];
                __builtin_amdgcn_sched_barrier(0);
#pragma unroll
                for (int i = 0; i < 4; ++i) {
                    f32x2 a = bc2(0.f), a2 = bc2(0.f);
#pragma unroll
                    for (int j = 0; j < 4; ++j) { a = lo2(q4[i][j]) * C[2 * j] + a; a2 = hi2(q4[i][j]) * C[2 * j + 1] + a2; }
                    a = a + a2;
                    d[i] = a[0] + a[1]; dn[i] = qn[i][0] * n0v + qn[i][1] * n1v;
                }
                __builtin_amdgcn_sched_barrier(0);
#pragma unroll
                for (int i = 0; i < 4; ++i) { d[i] = red8(d[i]); dn[i] = red64(dn[i]); }
                float fp[4], ip[4], em[4];
#pragma unroll
                for (int i = 0; i < 4; ++i) { const float mn = fmaxf(lf[i] + m, ig[i]); fp[i] = __expf(lf[i] + m - mn); ip[i] = __expf(ig[i] - mn); em[i] = __expf(-mn); m = mn; }
                const float F0 = fp[0], F1 = F0 * fp[1], F2 = F1 * fp[2], F3 = F2 * fp[3];
                const float g00 = ip[0], g10 = g00 * fp[1], g11 = ip[1], g20 = g10 * fp[2], g21 = g11 * fp[2], g22 = ip[2];
                const float g30 = g20 * fp[3], g31 = g21 * fp[3], g32 = g22 * fp[3], g33 = ip[3];
                const float s00 = g00 * qk[0][0];
                const float s10 = g10 * qk[1][0], s11 = g11 * qk[1][1];
                const float s20 = g20 * qk[2][0], s21 = g21 * qk[2][1], s22 = g22 * qk[2][2];
                const float s30 = g30 * qk[3][0], s31 = g31 * qk[3][1], s32 = g32 * qk[3][2], s33 = g33 * qk[3][3];
                const float num0 = F0 * d[0] + s00 * vv[0], den0 = F0 * dn[0] + s00;
                const float num1 = F1 * d[1] + s10 * vv[0] + s11 * vv[1], den1 = F1 * dn[1] + s10 + s11;
                const float num2 = F2 * d[2] + s20 * vv[0] + s21 * vv[1] + s22 * vv[2], den2 = F2 * dn[2] + s20 + s21 + s22;
                const float num3 = F3 * d[3] + s30 * vv[0] + s31 * vv[1] + s32 * vv[2] + s33 * vv[3], den3 = F3 * dn[3] + s30 + s31 + s32 + s33;
                if (s == 0) {
                    ob[0 * 32 + cl] = num0 / fmaxf(fabsf(den0), em[0]); ob[1 * 32 + cl] = num1 / fmaxf(fabsf(den1), em[1]);
                    ob[2 * 32 + cl] = num2 / fmaxf(fabsf(den2), em[2]); ob[3 * 32 + cl] = num3 / fmaxf(fabsf(den3), em[3]);
                }
                const float c0 = g30 * vv[0], c1 = g31 * vv[1], c2 = g32 * vv[2], c3 = g33 * vv[3];
#pragma unroll
                for (int j = 0; j < 4; ++j) {
                    C[2 * j] = lo2(k4[3][j]) * bc2(c3) + (lo2(k4[2][j]) * bc2(c2) + (lo2(k4[1][j]) * bc2(c1) + (lo2(k4[0][j]) * bc2(c0) + C[2 * j] * bc2(F3))));
                    C[2 * j + 1] = hi2(k4[3][j]) * bc2(c3) + (hi2(k4[2][j]) * bc2(c2) + (hi2(k4[1][j]) * bc2(c1) + (hi2(k4[0][j]) * bc2(c0) + C[2 * j + 1] * bc2(F3)))); }
                n0v = n0v * F3 + (kn[0][0] * g30 + kn[1][0] * g31) + (kn[2][0] * g32 + kn[3][0] * g33);
                n1v = n1v * F3 + (kn[0][1] * g30 + kn[1][1] * g31) + (kn[2][1] * g32 + kn[3][1] * g33);
            }
#undef MLOAD_Q
#undef MLOAD_K
            const size_t sh = (size_t)(l * NS + bs) * 4 + h;
#pragma unroll
            for (int e = 0; e < 16; ++e) { const int d = (e >> 2) * 32 + s * 4 + (e & 3); stb[d * ST_LD + cl] = C[e >> 1][e & 1]; }
            if (qtr == 0 && w == 0) { float* no = p.out + o_sn + sh * 128; no[nd] = n0v; no[nd + 1] = n1v; if (lane == 0) p.out[o_sm + sh] = m; }
        }
    }
    BARRIER_LDS();
    if (!cons) { store_out_blk(P, SROW0 + (bs0 + 8 * (nseq - 1)) * 4, 0, LS, cV + h * 128 + qtr * 32, OB(lds, (nseq - 1) & 1), ptid); st_store(p.out + o_sC + ((size_t)(l * NS + bs0 + 8 * (nseq - 1)) * 4 + h) * 16384, qtr, STB(lds, (nseq - 1) & 1), ptid); }
    BARRIER_LDS();
#undef LOADSTATE
#undef STISSUE
}


typedef float f32x16 __attribute__((ext_vector_type(16)));
#define MFMA32(a, b, c) __builtin_amdgcn_mfma_f32_32x32x16_bf16((a), (b), (c), 0, 0, 0)
__device__ __forceinline__ int crow(int reg, int hf) { return (reg & 3) + 8 * (reg >> 2) + 4 * hf; }
__device__ __forceinline__ bf16x8 pack_step(const f32x16& x, int s) {
    u32x4 pk;
    asm volatile("s_nop 7\n\ts_nop 3\n\tv_cvt_pk_bf16_f32 %0, %4, %5\n\tv_cvt_pk_bf16_f32 %1, %6, %7\n\tv_cvt_pk_bf16_f32 %2, %8, %9\n\tv_cvt_pk_bf16_f32 %3, %10, %11\n\ts_nop 1"
                 : "=&v"(pk[0]), "=&v"(pk[1]), "=&v"(pk[2]), "=&v"(pk[3])
                 : "v"(x[8 * s]), "v"(x[8 * s + 1]), "v"(x[8 * s + 2]), "v"(x[8 * s + 3]), "v"(x[8 * s + 4]), "v"(x[8 * s + 5]), "v"(x[8 * s + 6]), "v"(x[8 * s + 7]));
    return __builtin_bit_cast(bf16x8, pk);
}
__device__ __forceinline__ bf16x8 frag_n(const bf16_t* base, int ld, int r, int hf, int kb) { return *(const bf16x8*)(base + r * ld + kb * 16 + hf * 8); }
__device__ __forceinline__ bf16x8 frag_p(const bf16_t* base, int ld, int r, int hf, int k0) {
    const u32x2 a = *(const u32x2*)(base + r * ld + k0 + 4 * hf), b = *(const u32x2*)(base + r * ld + k0 + 8 + 4 * hf);
    return __builtin_bit_cast(bf16x8, (u32x4){a.x, a.y, b.x, b.y});
}
__device__ __forceinline__ int kto(int d) { return d * 40 + (d >> 4) * 8; }
__device__ __forceinline__ bf16_t f2bf(float x) { return (bf16_t)(pk2(x, 0.f) & 0xffffu); }

constexpr int CH_LDQ = 136, CH_LDS = 40;
constexpr int CH_QB = 0, CH_KB = 8704, CH_KWT = 17408, CH_VT = 27904, CH_SW = 33024, CH_SC = 35584, CH_QW = 36608, CH_SLOT = 45312, CH_OB = 2 * CH_SLOT;
constexpr int SC_U = 0, SC_B = 32, SC_PM = 64;

__device__ __forceinline__ void store_out_norm(bf16_t* P, int row0, int jb, int L, int pcol, const float* ob, const float* rd, int ptid) {
    const int tt = ptid >> 3, g = ptid & 7, t0 = jb * 32;
    if (t0 + tt < L) { const f32x4 v = *(const f32x4*)(ob + tt * 32 + g * 4) * rd[tt];
        *(u32x2*)(P + (size_t)(row0 + t0 + tt) * NP + pcol + g * 4) = (u32x2){pk2(v[0], v[1]), pk2(v[2], v[3])}; }
}
__device__ __forceinline__ void issue_mlstm_chunk(const Params& p, int h, int qtr, int row0, int L, int nch, int jb, int ptid, StageRegs& r) {
    if (jb >= nch) return;
    const bf16_t* P = (const bf16_t*)(p.ws + OFF_P); const float* REC = (const float*)(p.ws + OFF_REC);
    const int tt = ptid >> 3, g = ptid & 7, t0 = jb * 32;
    const int row = row0 + t0 + tt;
    if (g == 0) r.r0 = *(const f32x4*)(REC + ((size_t)row * 4 + h) * 16 + 4);
    if (t0 + tt >= L) return;
    const bf16_t* prow = P + (size_t)row * NP;
    r.q0 = asf(*(const u32x4*)(prow + cQ + h * 128 + g * 16)); r.q1 = asf(*(const u32x4*)(prow + cQ + h * 128 + g * 16 + 8));
    r.k0 = asf(*(const u32x4*)(prow + cK + h * 128 + g * 16)); r.k1 = asf(*(const u32x4*)(prow + cK + h * 128 + g * 16 + 8));
    { const u32x2 vv_ = *(const u32x2*)(prow + cV + h * 128 + qtr * 32 + g * 4); r.v = asf((u32x4){vv_.x, vv_.y, 0u, 0u}); }
}

__device__ __forceinline__ void scan_mlstm_chunk(const Params& p, int l, int bs, int h, int qtr, int row0, int L, unsigned char* lb) {
    const int tid = opaque_tid(p.wv); const int wave = tid >> 6, lane = tid & 63, r = lane & 31, hf = lane >> 5, ptid = tid - 256;
    bf16_t* P = (bf16_t*)(p.ws + OFF_P);
    const int nch = (L + 31) >> 5;
    f32x16 C[4];
    const int ct = wave == 3 ? 1 : 0;
#pragma unroll
    for (int dt = 0; dt < 4; ++dt)
#pragma unroll
        for (int i = 0; i < 16; ++i) C[dt][i] = 0.f;
    float m0 = 0.f;
    f32x4 s0, s1, s2, s3, s4, s5, s6, s7; StageRegs sr{s0, s1, s2, s3, s4, s5, s6, s7};
    if (wave >= 4) { for (int i = ptid; i < 2 * 32 * CH_LDS; i += 256) { const int sl = i / (32 * CH_LDS), e = i % (32 * CH_LDS);
            ((bf16_t*)(lb + sl * CH_SLOT + CH_VT))[32 * CH_LDS + e] = (e < CH_LDS) ? (bf16_t)0x3f80 : (bf16_t)0; } }
#define CH_P1(JN) do { const int jn_ = (JN); unsigned char* sl_ = lb + (jn_ & 1) * CH_SLOT; const int tt = ptid >> 3, g = ptid & 7; const bool val_ = jn_ * 32 + tt < L; \
        u32x4 q0_ = asu(sr.q0), q1_ = asu(sr.q1), k0_ = asu(sr.k0), k1_ = asu(sr.k1); u32x4 v_ = asu(sr.v); \
        if (!val_) { q0_ = q1_ = k0_ = k1_ = v_ = (u32x4){0u, 0u, 0u, 0u}; } \
        *(u32x4*)(sl_ + CH_QB + (tt * CH_LDQ + g * 16) * 2) = q0_; *(u32x4*)(sl_ + CH_QB + (tt * CH_LDQ + g * 16 + 8) * 2) = q1_; \
        *(u32x4*)(sl_ + CH_KB + (tt * CH_LDQ + g * 16) * 2) = k0_; *(u32x4*)(sl_ + CH_KB + (tt * CH_LDQ + g * 16 + 8) * 2) = k1_; \
        bf16_t* vt_ = (bf16_t*)(sl_ + CH_VT); \
        vt_[(g * 4 + 0) * CH_LDS + tt] = (bf16_t)(v_.x & 0xffffu); vt_[(g * 4 + 1) * CH_LDS + tt] = (bf16_t)(v_.x >> 16); \
        vt_[(g * 4 + 2) * CH_LDS + tt] = (bf16_t)(v_.y & 0xffffu); vt_[(g * 4 + 3) * CH_LDS + tt] = (bf16_t)(v_.y >> 16); \
        if (g == 0) { float* sc_ = (float*)(sl_ + CH_SC); sc_[SC_U + tt] = sr.r0[0]; sc_[SC_B + tt] = sr.r0[1]; sc_[SC_PM + tt] = sr.r0[2]; } \
        issue_mlstm_chunk(p, h, qtr, row0, L, nch, jn_ + 1, ptid, sr); } while (0)
#define CH_P2(JN) do { unsigned char* sl_ = lb + ((JN) & 1) * CH_SLOT; const float* sc_ = (const float*)(sl_ + CH_SC); \
        const float bT_ = sc_[SC_B + 31], mT_ = bT_ + fmaxf(m0, sc_[SC_PM + 31]); \
        if (wave == 1) { f32x16 a_; _Pragma("unroll") for (int i = 0; i < 16; ++i) a_[i] = 0.f; \
            _Pragma("unroll") for (int kb = 0; kb < 8; ++kb) a_ = MFMA32(frag_n((const bf16_t*)(sl_ + CH_QB), CH_LDQ, r, hf, kb), frag_n((const bf16_t*)(sl_ + CH_KB), CH_LDQ, r, hf, kb), a_); \
            bf16_t* sw_ = (bf16_t*)(sl_ + CH_SW); const float us_ = sc_[SC_U + r]; \
            _Pragma("unroll") for (int i4 = 0; i4 < 4; ++i4) { const f32x4 pm4 = *(const f32x4*)(sc_ + SC_PM + 8 * i4 + 4 * hf); \
                _Pragma("unroll") for (int ii = 0; ii < 4; ++ii) { const int t = 8 * i4 + 4 * hf + ii; const float w_ = (r <= t) ? __expf(us_ - fmaxf(m0, pm4[ii])) * 0.08838834764831845f : 0.f; \
                    sw_[t * CH_LDS + r] = f2bf(a_[4 * i4 + ii] * w_); } } } \
        else if (wave >= 4) { const int tt = ptid >> 3, g = ptid & 7; \
            const float wi_ = __expf(m0 - fmaxf(m0, sc_[SC_PM + tt])) * 0.08838834764831845f, ws_ = __expf(sc_[SC_U + tt] + bT_ - mT_); float x_[16]; \
            u32x4* qp_ = (u32x4*)(sl_ + CH_QB + (tt * CH_LDQ + g * 16) * 2); unpack8(qp_[0], x_); unpack8(qp_[1], x_ + 8); \
            _Pragma("unroll") for (int i = 0; i < 16; ++i) x_[i] *= wi_; \
            u32x4* qo_ = (u32x4*)(sl_ + CH_QW + (tt * CH_LDQ + g * 16) * 2); qo_[0] = pack8(x_); qo_[1] = pack8(x_ + 8); \
            const u32x4* kp_ = (const u32x4*)(sl_ + CH_KB + (tt * CH_LDQ + g * 16) * 2); unpack8(kp_[0], x_); unpack8(kp_[1], x_ + 8); \
            bf16_t* kw_ = (bf16_t*)(sl_ + CH_KWT); \
            _Pragma("unroll") for (int i = 0; i < 16; ++i) kw_[kto(g * 16) + i * CH_LDS + tt] = f2bf(x_[i] * ws_); } \
        if (wave == 1 || wave >= 4) m0 = mT_; } while (0)
    if (wave >= 4) { issue_mlstm_chunk(p, h, qtr, row0, L, nch, 0, ptid, sr); CH_P1(0); }
    BARRIER_LDS();
    CH_P2(0);
    BARRIER_LDS();
#pragma unroll 1
    for (int j = 0; j < nch; ++j) {
        if (wave == 0 || wave == 3) {
            const unsigned char* sl = lb + (j & 1) * CH_SLOT; const float* sc = (const float*)(sl + CH_SC);
            const bf16_t* qw = (const bf16_t*)(sl + CH_QW); const bf16_t* sw = (const bf16_t*)(sl + CH_SW); const bf16_t* vt = (const bf16_t*)(sl + CH_VT) + ct * 32 * CH_LDS; const bf16_t* kwt = (const bf16_t*)(sl + CH_KWT);
            const float bT = sc[SC_B + 31], mT = bT + fmaxf(m0, sc[SC_PM + 31]);
            f32x16 H;
#pragma unroll
            for (int i = 0; i < 16; ++i) H[i] = 0.f;
#pragma unroll
            for (int dt = 0; dt < 4; ++dt)
#pragma unroll
                for (int u = 0; u < 2; ++u) H = MFMA32(frag_p(qw, CH_LDQ, r, hf, 32 * dt + 16 * u), pack_step(C[dt], u), H);
            bf16x8 vb[2];
#pragma unroll
            for (int kb = 0; kb < 2; ++kb) { vb[kb] = frag_n(vt, CH_LDS, r, hf, kb); H = MFMA32(frag_n(sw, CH_LDS, r, hf, kb), vb[kb], H); }
            const float wold = __expf(bT - mT + m0);
#pragma unroll
            for (int dt = 0; dt < 4; ++dt) {
#pragma unroll
                for (int i = 0; i < 16; ++i) C[dt][i] *= wold;
#pragma unroll
                for (int kb = 0; kb < 2; ++kb) C[dt] = MFMA32(frag_n(kwt + kto(dt * 32 + r), 0, 0, hf, kb), vb[kb], C[dt]);
            }
            float* ob = (float*)(lb + CH_OB) + (j & 1) * 1024; float* rd = (float*)(lb + CH_OB + 8192) + (j & 1) * 32;
            if (ct == 0) {
#pragma unroll
                for (int i = 0; i < 16; ++i) ob[crow(i, hf) * 32 + r] = H[i];
            } else if (r == 0) {
#pragma unroll
                for (int i = 0; i < 16; ++i) { const int t = crow(i, hf); rd[t] = __builtin_amdgcn_rcpf(fmaxf(fabsf(H[i]), __expf(-(sc[SC_B + t] + fmaxf(m0, sc[SC_PM + t]))))); }
            }
            m0 = mT;
        } else if (wave >= 4) {
            if (j + 1 < nch) CH_P1(j + 1);
            if (j > 0) store_out_norm(P, row0, j - 1, L, cV + h * 128 + qtr * 32, (const float*)(lb + CH_OB) + ((j - 1) & 1) * 1024, (const float*)(lb + CH_OB + 8192) + ((j - 1) & 1) * 32, ptid);
        }
        BARRIER_LDS();
        if (j + 1 < nch) CH_P2(j + 1);
        BARRIER_LDS();
    }
    if (wave >= 4) store_out_norm(P, row0, nch - 1, L, cV + h * 128 + qtr * 32, (const float*)(lb + CH_OB) + ((nch - 1) & 1) * 1024, (const float*)(lb + CH_OB + 8192) + ((nch - 1) & 1) * 32, ptid);
    const size_t sh = (size_t)(l * NB + bs) * 4 + h;
    if (wave == 0) {
        float* Co = p.out + o_pC + sh * 16384;
#pragma unroll
        for (int dt = 0; dt < 4; ++dt)
#pragma unroll
            for (int i = 0; i < 16; ++i) Co[(32 * dt + crow(i, hf)) * 128 + qtr * 32 + r] = C[dt][i];
        if (lane == 0 && qtr == 0) p.out[o_pm + sh] = m0;
    } else if (wave == 3 && r == 0 && qtr == 0) {
#pragma unroll
        for (int dt = 0; dt < 4; ++dt)
#pragma unroll
            for (int i = 0; i < 16; ++i) p.out[o_pn + sh * 128 + 32 * dt + crow(i, hf)] = C[dt][i];
    }
    __syncthreads();
#undef CH_P1
#undef CH_P2
}

__device__ __forceinline__ void gdn_raw8(const bf16_t* P, int r0, int tr, int pcol, const bf16_t* gh, const float* st, int hch, float* x) {
    if (tr >= 0) unpack8(*(const u32x4*)(P + (size_t)(r0 + tr) * NP + pcol), x);
    else if (gh) unpack8(*(const u32x4*)(gh + (3 + tr) * 1536 + hch), x);
    else if (st) { const float* hp = st + (3 + tr) * 1536 + hch; const f32x4 a = *(const f32x4*)hp, b = *(const f32x4*)(hp + 4);
        x[0] = a[0]; x[1] = a[1]; x[2] = a[2]; x[3] = a[3]; x[4] = b[0]; x[5] = b[1]; x[6] = b[2]; x[7] = b[3]; }
    else {
#pragma unroll
        for (int i = 0; i < 8; ++i) x[i] = 0.f; }
}
__device__ __forceinline__ void gdn_conv8(const bf16_t* P, int r0, int tr, int pcol, const bf16_t* gh, const float* st, int hch, const float* cw, float* y) {
#pragma unroll
    for (int i = 0; i < 8; ++i) y[i] = 0.f;
#pragma unroll
    for (int j = 0; j < 4; ++j) { float x[8]; gdn_raw8(P, r0, tr - 3 + j, pcol, gh, st, hch, x);
        const f32x4 w0 = *(const f32x4*)(cw + j * 1536 + hch), w1 = *(const f32x4*)(cw + j * 1536 + hch + 4);
        y[0] += x[0] * w0[0]; y[1] += x[1] * w0[1]; y[2] += x[2] * w0[2]; y[3] += x[3] * w0[3];
        y[4] += x[4] * w1[0]; y[5] += x[5] * w1[1]; y[6] += x[6] * w1[2]; y[7] += x[7] * w1[3]; }
#pragma unroll
    for (int i = 0; i < 8; ++i) y[i] = y[i] * sigmoidf_(y[i]);
}

__device__ __forceinline__ void phase_prep(const Params& p, int l, float* lds) {
    const int tid = opaque_tid(p.wv); const int half = tid >> 8, t = tid & 255, tt = t >> 3, g = t & 7, wq = t >> 6, lane = t & 63, r = lane & 31, hf = lane >> 5;
    bf16_t* P = (bf16_t*)(p.ws + OFF_P); const bf16_t* GH = (const bf16_t*)(p.ws + OFF_GH);
    const float* G = (const float*)(p.ws + OFF_G); float* REC = (float*)(p.ws + OFF_REC); bf16_t* TB = (bf16_t*)(p.ws + OFF_TB);
    const float* cw = p.gconv_w + (size_t)l * 4 * 1536;
    float* ksc = lds + half * 4096;
    unsigned char* pl = (unsigned char*)lds + 32768 + half * 22016;
    bf16_t* kimg = (bf16_t*)pl; bf16_t* qimg = (bf16_t*)(pl + 8704); float* am = (float*)(pl + 17408); float* sgl = (float*)(pl + 21504); float* sbe = sgl + 32; float* sG = sgl + 64;
    constexpr int NITEM = (MROWS / 32) * 4;
    for (int base = blockIdx.x * 2; base < NITEM; base += gridDim.x * 2) {
        const int item = base + half; const bool act = item < NITEM;
        const int rb = item >> 2, h = item & 3, r0 = rb * 32;
        const bool samp = rb >= SROW0 / 32;
        int tr = tt; const bf16_t* gh = nullptr; const float* st = nullptr; int rbase = r0; bool valid = act;
        if (!samp) { const int jb = rb % (LPAD / 32); if (jb * 32 + tt >= LP) valid = false; if (jb > 0) gh = GH + (size_t)(rb - 1) * 3 * 1536; }
        else { const int sq = (rb - SROW0 / 32) * 8 + (tt >> 2); tr = tt & 3; rbase = r0 + (tt & ~3); st = p.st_gconv + (size_t)(l * NS + sq) * 3 * 1536; }
        const int ch = h * 128 + g * 16;
        u32x4 oq0 = (u32x4){0u, 0u, 0u, 0u}, oq1 = oq0, ok0 = oq0, ok1 = oq0, ov0 = oq0, ov1 = oq0;
        float ga = 0.f, gb = 0.f, gg = 0.f;
        if (valid) {
            float y[16];
            gdn_conv8(P, rbase, tr, cBV + ch, gh, st, 1024 + ch, cw, y); gdn_conv8(P, rbase, tr, cBV + ch + 8, gh, st, 1024 + ch + 8, cw, y + 8);
            ov0 = pack8(y); ov1 = pack8(y + 8);
            __builtin_amdgcn_sched_barrier(0);
            gdn_conv8(P, rbase, tr, cBQ + ch, gh, st, ch, cw, y); gdn_conv8(P, rbase, tr, cBQ + ch + 8, gh, st, ch + 8, cw, y + 8);
            float ss = 0.f;
#pragma unroll
            for (int i = 0; i < 16; ++i) ss += y[i] * y[i];
            float rs = rsqrtf(red8(ss) + 1e-6f) * 0.08838834764831845f;
#pragma unroll
            for (int i = 0; i < 16; ++i) y[i] *= rs;
            oq0 = pack8(y); oq1 = pack8(y + 8);
            __builtin_amdgcn_sched_barrier(0);
            gdn_conv8(P, rbase, tr, cBK + ch, gh, st, 512 + ch, cw, y); gdn_conv8(P, rbase, tr, cBK + ch + 8, gh, st, 512 + ch + 8, cw, y + 8);
            ss = 0.f;
#pragma unroll
            for (int i = 0; i < 16; ++i) ss += y[i] * y[i];
            rs = rsqrtf(red8(ss) + 1e-6f);
#pragma unroll
            for (int i = 0; i < 16; ++i) y[i] *= rs;
            ok0 = pack8(y); ok1 = pack8(y + 8);
            unpack8(ok0, y); unpack8(ok1, y + 8);
#pragma unroll
            for (int i = 0; i < 4; ++i) *(f32x4*)(ksc + tt * 128 + g * 16 + 4 * i) = (f32x4){y[4 * i], y[4 * i + 1], y[4 * i + 2], y[4 * i + 3]};
            if (g == 0) { const float* gr = G + (size_t)(r0 + tt) * 16;
                gb = sigmoidf_(gr[8 + h]);
                const float xa = gr[12 + h] + p.dt_bias[l * 4 + h];
                const float sp = fmaxf(xa, 0.f) + log1pf(__expf(-fabsf(xa)));
                gg = -__expf(p.A_log[l * 4 + h]) * sp; ga = __expf(gg); }
        }
        if (!samp) {
            *(u32x4*)(kimg + tt * CH_LDQ + g * 16) = ok0; *(u32x4*)(kimg + tt * CH_LDQ + g * 16 + 8) = ok1;
            *(u32x4*)(qimg + tt * CH_LDQ + g * 16) = oq0; *(u32x4*)(qimg + tt * CH_LDQ + g * 16 + 8) = oq1;
            if (g == 0) { sgl[tt] = gg; sbe[tt] = gb; }
        }
        __syncthreads();
        f32x16 pacc;
#pragma unroll
        for (int i = 0; i < 16; ++i) pacc[i] = 0.f;
        float myG = 0.f, totG = 0.f;
        if (valid) {
            bf16_t* pr = P + (size_t)(r0 + tt) * NP;
            *(u32x4*)(pr + cBQ + ch) = oq0; *(u32x4*)(pr + cBQ + ch + 8) = oq1; *(u32x4*)(pr + cBK + ch) = ok0; *(u32x4*)(pr + cBK + ch + 8) = ok1;
            *(u32x4*)(pr + cBV + ch) = ov0; *(u32x4*)(pr + cBV + ch + 8) = ov1;
        }
        if (samp) {
            if (valid) {
                const float* kmb = ksc + (tt & ~3) * 128 + g * 16;
                f32x4 qk, kk, qs[4], ks[4];
                { float y[16]; unpack8(oq0, y); unpack8(oq1, y + 8);
#pragma unroll
                  for (int i = 0; i < 4; ++i) qs[i] = (f32x4){y[4 * i], y[4 * i + 1], y[4 * i + 2], y[4 * i + 3]};
                  unpack8(ok0, y); unpack8(ok1, y + 8);
#pragma unroll
                  for (int i = 0; i < 4; ++i) ks[i] = (f32x4){y[4 * i], y[4 * i + 1], y[4 * i + 2], y[4 * i + 3]}; }
#pragma unroll
                for (int j = 0; j < 4; ++j) { qk[j] = red8(dot16(qs, kmb + j * 128)); kk[j] = red8(dot16(ks, kmb + j * 128)); }
                if (g == 0) { float* rec = REC + ((size_t)(r0 + tt) * 4 + h) * 16; *(f32x4*)rec = (f32x4){ga, gb, gg, 0.f}; *(f32x4*)(rec + 4) = qk; *(f32x4*)(rec + 8) = kk; }
            }
        } else if (act) {
            if (wq < 2) {
                const bf16_t* ai = wq == 0 ? kimg : qimg;
#pragma unroll
                for (int kb = 0; kb < 8; ++kb) pacc = MFMA32(frag_n(ai, CH_LDQ, r, hf, kb), frag_n(kimg, CH_LDQ, r, hf, kb), pacc);
            } else if (wq == 2) {
                const float gm = sgl[r]; float cum = 0.f;
#pragma unroll
                for (int t2 = 0; t2 < 32; ++t2) { cum += rdl(gm, t2); if (r == t2) myG = cum; }
                totG = cum;
                if (lane < 32) sG[r] = myG;
                if (lane == 0) sG[32] = cum;
            }
        }
        __syncthreads();
        if (!samp && act) {
            bf16_t* tb = TB + (size_t)item * 3072;
            if (wq == 0) {
                const float Gs_ = sG[r]; float* ag = (float*)tb;
#pragma unroll
                for (int i4 = 0; i4 < 4; ++i4) { const f32x4 G4 = *(const f32x4*)(sG + 8 * i4 + 4 * hf), b4 = *(const f32x4*)(sbe + 8 * i4 + 4 * hf);
#pragma unroll
                    for (int ii = 0; ii < 4; ++ii) { const int t2 = 8 * i4 + 4 * hf + ii; ag[t2 * 32 + r] = (r < t2) ? b4[ii] * pacc[4 * i4 + ii] * __expf(G4[ii] - Gs_) : 0.f; } }
            } else if (wq == 1) {
                const float Gs_ = sG[r];
#pragma unroll
                for (int i4 = 0; i4 < 4; ++i4) { const f32x4 G4 = *(const f32x4*)(sG + 8 * i4 + 4 * hf);
#pragma unroll
                    for (int ii = 0; ii < 4; ++ii) { const int t2 = 8 * i4 + 4 * hf + ii; tb[2048 + t2 * 32 + r] = f2bf((r <= t2) ? pacc[4 * i4 + ii] * __expf(G4[ii] - Gs_) : 0.f); } }
            }
            if (valid && g == 0) { const float Gt = sG[tt], GT = sG[32];
                float* rec = REC + ((size_t)(r0 + tt) * 4 + h) * 16; *(f32x4*)rec = (f32x4){ga, gb, gg, Gt}; *(f32x4*)(rec + 12) = (f32x4){GT - Gt, GT, 0.f, 0.f}; }
        }
        __syncthreads();
    }
    asm volatile("s_waitcnt vmcnt(0)" ::: "memory");
    __syncthreads();
    { const int wv_ = tid >> 6; float* am = lds + wv_ * 1024;
      int nmine = 0;
      for (int base = blockIdx.x * 2; base < NITEM; base += gridDim.x * 2) nmine += 2;
      for (int idx = wv_; idx < nmine; idx += 8) {
        const int item = blockIdx.x * 2 + (idx >> 1) * gridDim.x * 2 + (idx & 1);
        const int rb = item >> 2, h = item & 3;
        if (item >= NITEM || rb >= SROW0 / 32) continue;
        bf16_t* tb = TB + (size_t)item * 3072; const float* ag = (const float*)tb;
#pragma unroll
        for (int q = 0; q < 4; ++q) *(f32x4*)(am + q * 256 + lane * 4) = *(const f32x4*)(ag + q * 256 + lane * 4);
        const float* rec = REC + ((size_t)(rb * 32 + r) * 4 + h) * 16;
        const bool rv = (rb % (LPAD / 32)) * 32 + r < LP;
        const float bs_ = rv ? rec[1] : 0.f, bg_ = rv ? bs_ * __expf(rec[3]) : 0.f;
        asm volatile("s_waitcnt vmcnt(0) lgkmcnt(0)" ::: "memory");
        float Tc[32];
#pragma unroll
        for (int t2 = 0; t2 < 32; ++t2) { float v0 = 0.f, v1 = 0.f, v2 = 0.f, v3 = 0.f;
#pragma unroll
            for (int q4 = 0; q4 < (t2 + 3) / 4; ++q4) { const f32x4 a4 = *(const f32x4*)(am + t2 * 32 + q4 * 4);
                if (q4 * 4 + 0 < t2) v0 += a4[0] * Tc[q4 * 4 + 0]; if (q4 * 4 + 1 < t2) v1 += a4[1] * Tc[q4 * 4 + 1];
                if (q4 * 4 + 2 < t2) v2 += a4[2] * Tc[q4 * 4 + 2]; if (q4 * 4 + 3 < t2) v3 += a4[3] * Tc[q4 * 4 + 3]; }
            Tc[t2] = ((r == t2) ? 1.f : 0.f) - ((v0 + v1) + (v2 + v3)); }
        if (hf == 0) {
#pragma unroll
            for (int t2 = 0; t2 < 32; ++t2) { tb[t2 * 32 + r] = f2bf(Tc[t2] * bs_); tb[1024 + t2 * 32 + r] = f2bf(Tc[t2] * bg_); } }
        asm volatile("s_waitcnt lgkmcnt(0)" ::: "memory");
      } }
    { const int wv_ = tid >> 6;
      for (int it = blockIdx.x * 8 + wv_; it < (SROW0 / 32) * 4; it += gridDim.x * 8) {
        const int rbp = it >> 2, hh = it & 3, jb = rbp % (LPAD / 32), row = rbp * 32 + r;
        float igm = -1e30f, lfm = 0.f;
        if (jb * 32 + r < LP) { const float* gr = G + (size_t)row * 16; igm = gr[hh] + p.gate_bias[l * 8 + hh]; const float f = gr[4 + hh] + p.gate_bias[l * 8 + 4 + hh]; lfm = fminf(f, 0.f) - log1pf(__expf(-fabsf(f))); }
        float bsum = 0.f, pm = -3e38f, myb = 0.f, myu = 0.f, mypm = 0.f;
#pragma unroll
        for (int t2 = 0; t2 < 32; ++t2) { bsum += rdl(lfm, t2); const float u_ = rdl(igm, t2) - bsum; pm = fmaxf(pm, u_); if (r == t2) { myb = bsum; myu = u_; mypm = pm; } }
        if (lane < 32) *(f32x4*)(REC + ((size_t)row * 4 + hh) * 16 + 4) = (f32x4){myu, myb, mypm, 0.f};
      } }
}

__device__ __forceinline__ void issue_gdn(const Params& p, int h, int qtr, int row0, int L, int jb, int ptid, StageRegs& r) {
    const bf16_t* P = (const bf16_t*)(p.ws + OFF_P); const float* REC = (const float*)(p.ws + OFF_REC);
    const int tt = ptid >> 3, g = ptid & 7, t0 = jb * 32;
    if (t0 + tt >= L) return;
    const int row = row0 + t0 + tt;
    const bf16_t* prow = P + (size_t)row * NP;
    r.q0 = asf(*(const u32x4*)(prow + cBQ + h * 128 + g * 16)); r.q1 = asf(*(const u32x4*)(prow + cBQ + h * 128 + g * 16 + 8));
    r.k0 = asf(*(const u32x4*)(prow + cBK + h * 128 + g * 16)); r.k1 = asf(*(const u32x4*)(prow + cBK + h * 128 + g * 16 + 8));
    { const u32x2 vv_ = *(const u32x2*)(prow + cBV + h * 128 + qtr * 32 + g * 4); r.v = asf((u32x4){vv_.x, vv_.y, 0u, 0u}); }
    if (g < 3) r.r0 = *(const f32x4*)(REC + ((size_t)row * 4 + h) * 16 + g * 4);
}
__device__ __forceinline__ void commit_gdn(int L, int jb, float* lds, int ptid, const StageRegs& r, int bsel = -1) {
    const int tt = ptid >> 3, g = ptid & 7, t0 = jb * 32, b = bsel >= 0 ? bsel : (jb & 1);
    if (t0 + tt >= L) return;
    float x[16];
    unpack8(asu(r.q0), x); unpack8(asu(r.q1), x + 8);
    float* qd = QB(lds, b) + tt * 128 + g * 16;
#pragma unroll
    for (int i = 0; i < 4; ++i) *(f32x4*)(qd + 4 * i) = (f32x4){x[4 * i], x[4 * i + 1], x[4 * i + 2], x[4 * i + 3]};
    unpack8(asu(r.k0), x); unpack8(asu(r.k1), x + 8);
    float* kd = KB(lds, b) + tt * 128 + g * 16;
#pragma unroll
    for (int i = 0; i < 4; ++i) *(f32x4*)(kd + 4 * i) = (f32x4){x[4 * i], x[4 * i + 1], x[4 * i + 2], x[4 * i + 3]};
    *(f32x4*)(VB(lds, b) + tt * 32 + g * 4) = (f32x4){bflo(asu(r.v).x), bfhi(asu(r.v).x), bflo(asu(r.v).y), bfhi(asu(r.v).y)};
    if (g < 3) *(f32x4*)(SCB(lds, b) + tt * 16 + g * 4) = r.r0;
}

constexpr int GD_Q = 0, GD_K = 8704, GD_KT = 17408, GD_KDT = 27904, GD_VT = 38400, GD_QKD = 40960, GD_TV = 43520, GD_TK = 46080, GD_W = 48640, GD_SC = 57344, GD_SLOT = 58368, GD_OB = 2 * GD_SLOT;
constexpr int GS_B = 32, GS_EG = 96, GS_ETG = 128, GS_EGT = 160;

__device__ __forceinline__ void issue_gdn_chunk(const Params& p, int h, int qtr, int row0, int L, int nch, int jb, int ptid, StageRegs& r) {
    if (jb >= nch) return;
    const bf16_t* P = (const bf16_t*)(p.ws + OFF_P); const float* REC = (const float*)(p.ws + OFF_REC);
    const bf16_t* tb = (const bf16_t*)(p.ws + OFF_TB) + ((size_t)((row0 >> 5) + jb) * 4 + h) * 3072;
    r.x0 = asf(*(const u32x4*)(tb + ptid * 8));
    if (ptid < 128) r.x1 = asf(*(const u32x4*)(tb + 2048 + ptid * 8));
    const int tt = ptid >> 3, g = ptid & 7, t0 = jb * 32;
    if (t0 + tt >= L) return;
    const int row = row0 + t0 + tt;
    const bf16_t* prow = P + (size_t)row * NP;
    r.q0 = asf(*(const u32x4*)(prow + cBQ + h * 128 + g * 16)); r.q1 = asf(*(const u32x4*)(prow + cBQ + h * 128 + g * 16 + 8));
    r.k0 = asf(*(const u32x4*)(prow + cBK + h * 128 + g * 16)); r.k1 = asf(*(const u32x4*)(prow + cBK + h * 128 + g * 16 + 8));
    { const u32x2 vv_ = *(const u32x2*)(prow + cBV + h * 128 + qtr * 32 + g * 4); r.v = asf((u32x4){vv_.x, vv_.y, 0u, 0u}); }
    if (g == 0 || g == 3) r.r0 = *(const f32x4*)(REC + ((size_t)row * 4 + h) * 16 + g * 4);
}

__device__ __forceinline__ void scan_gdn_chunk(const Params& p, int l, int bs, int h, int qtr, int row0, int L, unsigned char* lb) {
    const int tid = opaque_tid(p.wv); const int wave = tid >> 6, lane = tid & 63, r = lane & 31, hf = lane >> 5, ptid = tid - 256;
    bf16_t* P = (bf16_t*)(p.ws + OFF_P);
    const int nch = (L + 31) >> 5;
    f32x16 S[4];
#pragma unroll
    for (int dt = 0; dt < 4; ++dt)
#pragma unroll
        for (int i = 0; i < 16; ++i) S[dt][i] = 0.f;
    f32x4 s0, s1, s2, s3, s4, s5, s6, s7; StageRegs sr{s0, s1, s2, s3, s4, s5, s6, s7};
#define GD_P1(JN) do { const int jn_ = (JN); unsigned char* sl_ = lb + (jn_ & 1) * GD_SLOT; const int tt = ptid >> 3, g = ptid & 7; const bool val_ = jn_ * 32 + tt < L; \
        u32x4 q0_ = asu(sr.q0), q1_ = asu(sr.q1), k0_ = asu(sr.k0), k1_ = asu(sr.k1); u32x4 v_ = asu(sr.v); \
        if (!val_) { q0_ = q1_ = k0_ = k1_ = v_ = (u32x4){0u, 0u, 0u, 0u}; } \
        *(u32x4*)(sl_ + GD_Q + (tt * CH_LDQ + g * 16) * 2) = q0_; *(u32x4*)(sl_ + GD_Q + (tt * CH_LDQ + g * 16 + 8) * 2) = q1_; \
        *(u32x4*)(sl_ + GD_K + (tt * CH_LDQ + g * 16) * 2) = k0_; *(u32x4*)(sl_ + GD_K + (tt * CH_LDQ + g * 16 + 8) * 2) = k1_; \
        bf16_t* kt_ = (bf16_t*)(sl_ + GD_KT) + kto(g * 16) + tt; \
        _Pragma("unroll") for (int i = 0; i < 4; ++i) { kt_[(2 * i) * CH_LDS] = (bf16_t)(k0_[i] & 0xffffu); kt_[(2 * i + 1) * CH_LDS] = (bf16_t)(k0_[i] >> 16); \
            kt_[(8 + 2 * i) * CH_LDS] = (bf16_t)(k1_[i] & 0xffffu); kt_[(8 + 2 * i + 1) * CH_LDS] = (bf16_t)(k1_[i] >> 16); } \
        bf16_t* vt_ = (bf16_t*)(sl_ + GD_VT); \
        vt_[(g * 4 + 0) * CH_LDS + tt] = (bf16_t)(v_.x & 0xffffu); vt_[(g * 4 + 1) * CH_LDS + tt] = (bf16_t)(v_.x >> 16); \
        vt_[(g * 4 + 2) * CH_LDS + tt] = (bf16_t)(v_.y & 0xffffu); vt_[(g * 4 + 3) * CH_LDS + tt] = (bf16_t)(v_.y >> 16); \
        { const int row_ = ptid >> 2, c4_ = ptid & 3; *(u32x4*)(sl_ + (row_ < 32 ? GD_TV : GD_TK) + ((row_ & 31) * CH_LDS + c4_ * 8) * 2) = asu(sr.x0); \
          if (ptid < 128) *(u32x4*)(sl_ + GD_QKD + (row_ * CH_LDS + c4_ * 8) * 2) = asu(sr.x1); } \
        float* sc_ = (float*)(sl_ + GD_SC); \
        if (g == 0) { sc_[GS_B + tt] = val_ ? sr.r0[1] : 0.f; sc_[GS_EG + tt] = val_ ? __expf(sr.r0[3]) : 0.f; } \
        if (g == 3) { sc_[GS_ETG + tt] = val_ ? __expf(sr.r0[0]) : 0.f; if (tt == 0) sc_[GS_EGT] = __expf(sr.r0[1]); } \
        issue_gdn_chunk(p, h, qtr, row0, L, nch, jn_ + 1, ptid, sr); } while (0)
#define GD_P2(JN) do { if (wave >= 4) { unsigned char* sl_ = lb + ((JN) & 1) * GD_SLOT; const float* sc_ = (const float*)(sl_ + GD_SC); \
        { const int tt = ptid >> 3, g = ptid & 7; const float eg_ = sc_[GS_EG + tt], et_ = sc_[GS_ETG + tt]; float x_[16]; \
            u32x4* qp_ = (u32x4*)(sl_ + GD_Q + (tt * CH_LDQ + g * 16) * 2); unpack8(qp_[0], x_); unpack8(qp_[1], x_ + 8); \
            _Pragma("unroll") for (int i = 0; i < 16; ++i) x_[i] *= eg_; \
            qp_[0] = pack8(x_); qp_[1] = pack8(x_ + 8); \
            const u32x4* kp_ = (const u32x4*)(sl_ + GD_K + (tt * CH_LDQ + g * 16) * 2); unpack8(kp_[0], x_); unpack8(kp_[1], x_ + 8); \
            bf16_t* kd_ = (bf16_t*)(sl_ + GD_KDT); \
            _Pragma("unroll") for (int i = 0; i < 16; ++i) kd_[kto(g * 16) + i * CH_LDS + tt] = f2bf(x_[i] * et_); } \
        { const int dt_ = wave - 4; f32x16 a_; \
            _Pragma("unroll") for (int i = 0; i < 16; ++i) a_[i] = 0.f; \
            _Pragma("unroll") for (int kb = 0; kb < 2; ++kb) a_ = MFMA32(frag_n((const bf16_t*)(sl_ + GD_KT) + kto(dt_ * 32 + r), 0, 0, hf, kb), frag_n((const bf16_t*)(sl_ + GD_TK), CH_LDS, r, hf, kb), a_); \
            _Pragma("unroll") for (int i4 = 0; i4 < 4; ++i4) { unsigned lo_, hi_;     \
                asm volatile("s_nop 7\n\ts_nop 7\n\tv_cvt_pk_bf16_f32 %0, %2, %3\n\tv_cvt_pk_bf16_f32 %1, %4, %5" : "=&v"(lo_), "=&v"(hi_) : "v"(a_[4 * i4]), "v"(a_[4 * i4 + 1]), "v"(a_[4 * i4 + 2]), "v"(a_[4 * i4 + 3])); \
                *(u32x2*)(sl_ + GD_W + (r * CH_LDQ + 32 * dt_ + 8 * i4 + 4 * hf) * 2) = (u32x2){lo_, hi_}; } } } } while (0)
    if (wave >= 4) { issue_gdn_chunk(p, h, qtr, row0, L, nch, 0, ptid, sr); GD_P1(0); }
    BARRIER_LDS();
    GD_P2(0);
    BARRIER_LDS();
#pragma unroll 1
    for (int j = 0; j < nch; ++j) {
        if (wave == 0) {
            const unsigned char* sl = lb + (j & 1) * GD_SLOT; const float* sc = (const float*)(sl + GD_SC);
            const bf16_t* wq = (const bf16_t*)(sl + GD_W); const bf16_t* qg = (const bf16_t*)(sl + GD_Q); const bf16_t* tv = (const bf16_t*)(sl + GD_TV); const bf16_t* vt = (const bf16_t*)(sl + GD_VT);
            const bf16_t* qkd = (const bf16_t*)(sl + GD_QKD); const bf16_t* kdt = (const bf16_t*)(sl + GD_KDT);
            f32x16 U, O;
#pragma unroll
            for (int i = 0; i < 16; ++i) { U[i] = 0.f; O[i] = 0.f; }
#pragma unroll
            for (int dt = 0; dt < 4; ++dt)
#pragma unroll
                for (int u = 0; u < 2; ++u) { const bf16x8 sb = pack_step(S[dt], u);
                    U = MFMA32(frag_p(wq, CH_LDQ, r, hf, 32 * dt + 16 * u), sb, U); O = MFMA32(frag_p(qg, CH_LDQ, r, hf, 32 * dt + 16 * u), sb, O); }
            f32x16 Uv;
#pragma unroll
            for (int i = 0; i < 16; ++i) Uv[i] = 0.f;
#pragma unroll
            for (int kb = 0; kb < 2; ++kb) Uv = MFMA32(frag_n(tv, CH_LDS, r, hf, kb), frag_n(vt, CH_LDS, r, hf, kb), Uv);
#pragma unroll
            for (int i = 0; i < 16; ++i) U[i] = Uv[i] - U[i];
            bf16x8 ub[2]; ub[0] = pack_step(U, 0); ub[1] = pack_step(U, 1);
#pragma unroll
            for (int u = 0; u < 2; ++u) O = MFMA32(frag_p(qkd, CH_LDS, r, hf, 16 * u), ub[u], O);
            const float egt = sc[GS_EGT];
#pragma unroll
            for (int dt = 0; dt < 4; ++dt) {
#pragma unroll
                for (int i = 0; i < 16; ++i) S[dt][i] *= egt;
#pragma unroll
                for (int u = 0; u < 2; ++u) S[dt] = MFMA32(frag_p(kdt + kto(dt * 32 + r), 0, 0, hf, 16 * u), ub[u], S[dt]);
            }
            float* ob = (float*)(lb + GD_OB) + (j & 1) * 1024;
#pragma unroll
            for (int i = 0; i < 16; ++i) ob[crow(i, hf) * 32 + r] = O[i];
        } else if (wave >= 4) {
            if (j + 1 < nch) GD_P1(j + 1);
            if (j > 0) store_out_blk(P, row0, j - 1, L, cBV + h * 128 + qtr * 32, (const float*)(lb + GD_OB) + ((j - 1) & 1) * 1024, ptid);
        }
        BARRIER_LDS();
        if (j + 1 < nch) GD_P2(j + 1);
        BARRIER_LDS();
    }
    if (wave >= 4) store_out_blk(P, row0, nch - 1, L, cBV + h * 128 + qtr * 32, (const float*)(lb + GD_OB) + ((nch - 1) & 1) * 1024, ptid);
    if (wave == 0) {
        float* So = p.out + o_pS + ((size_t)(l * NB + bs) * 4 + h) * 16384;
#pragma unroll
        for (int dt = 0; dt < 4; ++dt)
#pragma unroll
            for (int i = 0; i < 16; ++i) So[(32 * dt + crow(i, hf)) * 128 + qtr * 32 + r] = S[dt][i];
    }
    __syncthreads();
#undef GD_P1
#undef GD_P2
}

__device__ __forceinline__ void scan_gdn(const Params& p, int l, bool samp, int bs, int h, int qtr, int row0, int L, float* lds) {
    const int tid = opaque_tid(p.wv); const bool cons = tid < 256; const int ptid = tid - 256;
    const int lane = tid & 63, w = (tid >> 6) & 3, s = lane & 7, cl = w * 8 + (lane >> 3), col = qtr * 32 + cl;
    bf16_t* P = (bf16_t*)(p.ws + OFF_P);
    f32x2 S[8];
#pragma unroll
    for (int e = 0; e < 8; ++e) S[e] = bc2(0.f);
    if (cons && samp) {
        const float* S0 = p.st_S + ((size_t)(l * NS + bs) * 4 + h) * 16384;
#pragma unroll
        for (int e = 0; e < 16; ++e) { const int d = (e >> 2) * 32 + s * 4 + (e & 3); S[e >> 1][e & 1] = S0[d * 128 + col]; }
    }
    const int nblk = (L + 31) >> 5;
    f32x4 k4[4][4];
    StageRegs sr{k4[0][0], k4[0][1], k4[0][2], k4[0][3], k4[1][0], k4[1][1], k4[1][2], k4[1][3]};
    if (!cons) { issue_gdn(p, h, qtr, row0, L, 0, ptid, sr); commit_gdn(L, 0, lds, ptid, sr); if (1 < nblk) issue_gdn(p, h, qtr, row0, L, 1, ptid, sr); }
    BARRIER_LDS();
    for (int jb = 0; jb < nblk; ++jb) {
        if (!cons) {
            if (jb + 1 < nblk) commit_gdn(L, jb + 1, lds, ptid, sr);
            if (jb + 2 < nblk) issue_gdn(p, h, qtr, row0, L, jb + 2, ptid, sr);
            if (jb > 0) store_out_blk(P, row0, jb - 1, L, cBV + h * 128 + qtr * 32, OB(lds, (jb - 1) & 1), ptid);
        } else {
            const float* qb = QB(lds, jb & 1); const float* kb = KB(lds, jb & 1); const float* vb = VB(lds, jb & 1); const float* sc = SCB(lds, jb & 1);
            float* ob = OB(lds, jb & 1);
            const int nt = min(32, L - jb * 32);
            f32x4 q4[4][4]; float vv[4], a[4], be[4]; f32x4 qk[4], kk[4];
#define GLOAD_Q(T0) do { _Pragma("unroll") for (int i = 0; i < 4; ++i) { const int t = (T0) + i; \
        _Pragma("unroll") for (int j = 0; j < 4; ++j) q4[i][j] = *(const f32x4*)(qb + t * 128 + j * 32 + s * 4); } } while (0)
#define GLOAD_K(T0) do { _Pragma("unroll") for (int i = 0; i < 4; ++i) { const int t = (T0) + i; \
        _Pragma("unroll") for (int j = 0; j < 4; ++j) k4[i][j] = *(const f32x4*)(kb + t * 128 + j * 32 + s * 4); } \
      _Pragma("unroll") for (int i = 0; i < 4; ++i) { const int t = (T0) + i; \
        const f32x2 gg = *(const f32x2*)(sc + t * 16); a[i] = gg[0]; be[i] = gg[1]; \
        qk[i] = *(const f32x4*)(sc + t * 16 + 4); kk[i] = *(const f32x4*)(sc + t * 16 + 8); vv[i] = vb[t * 32 + cl]; } } while (0)
            GLOAD_Q(0); GLOAD_K(0);
#pragma unroll 1
            for (int t0 = 0; t0 < nt; t0 += 4) {
                float dk[4], dq[4];
                const int tn = min(t0 + 4, 28);
                __builtin_amdgcn_sched_barrier(0);
#pragma unroll
                for (int i = 0; i < 4; ++i) {
                    f32x2 x = bc2(0.f), x2 = bc2(0.f), y = bc2(0.f), y2 = bc2(0.f);
#pragma unroll
                    for (int j = 0; j < 4; ++j) {
                        x = lo2(k4[i][j]) * S[2 * j] + x; x2 = hi2(k4[i][j]) * S[2 * j + 1] + x2;
                        y = lo2(q4[i][j]) * S[2 * j] + y; y2 = hi2(q4[i][j]) * S[2 * j + 1] + y2; }
                    x = x + x2; y = y + y2;
                    dk[i] = x[0] + x[1]; dq[i] = y[0] + y[1];
                }
                __builtin_amdgcn_sched_barrier(0);
                GLOAD_Q(tn);
                __builtin_amdgcn_sched_barrier(0);
#pragma unroll
                for (int i = 0; i < 4; ++i) { dk[i] = red8(dk[i]); dq[i] = red8(dq[i]); }
                const float A0 = a[0], A1 = A0 * a[1], A2 = A1 * a[2], A3 = A2 * a[3];
                const float r10 = a[1], r21 = a[2], r32 = a[3], r20 = r10 * a[2], r31 = r21 * a[3], r30 = r20 * a[3];
                const float u0 = be[0] * (vv[0] - A0 * dk[0]);
                const float u1 = be[1] * (vv[1] - A1 * dk[1] - r10 * kk[1][0] * u0);
                const float u2 = be[2] * (vv[2] - A2 * dk[2] - r20 * kk[2][0] * u0 - r21 * kk[2][1] * u1);
                const float u3 = be[3] * (vv[3] - A3 * dk[3] - r30 * kk[3][0] * u0 - r31 * kk[3][1] * u1 - r32 * kk[3][2] * u2);
                if (s == 0) {
                    ob[(t0 + 0) * 32 + cl] = A0 * dq[0] + qk[0][0] * u0;
                    ob[(t0 + 1) * 32 + cl] = A1 * dq[1] + r10 * qk[1][0] * u0 + qk[1][1] * u1;
                    ob[(t0 + 2) * 32 + cl] = A2 * dq[2] + r20 * qk[2][0] * u0 + r21 * qk[2][1] * u1 + qk[2][2] * u2;
                    ob[(t0 + 3) * 32 + cl] = A3 * dq[3] + r30 * qk[3][0] * u0 + r31 * qk[3][1] * u1 + r32 * qk[3][2] * u2 + qk[3][3] * u3;
                }
                const float c0 = r30 * u0, c1 = r31 * u1, c2 = r32 * u2, c3 = u3;
#pragma unroll
                for (int j = 0; j < 4; ++j) {
                    S[2 * j] = lo2(k4[3][j]) * bc2(c3) + (lo2(k4[2][j]) * bc2(c2) + (lo2(k4[1][j]) * bc2(c1) + (lo2(k4[0][j]) * bc2(c0) + S[2 * j] * bc2(A3))));
                    S[2 * j + 1] = hi2(k4[3][j]) * bc2(c3) + (hi2(k4[2][j]) * bc2(c2) + (hi2(k4[1][j]) * bc2(c1) + (hi2(k4[0][j]) * bc2(c0) + S[2 * j + 1] * bc2(A3)))); }
                __builtin_amdgcn_sched_barrier(0);
                GLOAD_K(tn);
            }
#undef GLOAD_Q
#undef GLOAD_K
        }
        BARRIER_LDS();
    }
    if (!cons) store_out_blk(P, row0, nblk - 1, L, cBV + h * 128 + qtr * 32, OB(lds, (nblk - 1) & 1), ptid);
    else {
        const size_t sh = samp ? (size_t)(l * NS + bs) * 4 + h : (size_t)(l * NB + bs) * 4 + h;
        float* So = p.out + (samp ? o_sS : o_pS) + sh * 16384;
#pragma unroll
        for (int e = 0; e < 16; ++e) { const int d = (e >> 2) * 32 + s * 4 + (e & 3); So[d * 128 + col] = S[e >> 1][e & 1]; }
    }
    BARRIER_LDS();
}

__device__ __forceinline__ void scan_gdn_stream(const Params& p, int l, int h, int qtr, int bs0, int nseq, float* lds) {
    const int tid = opaque_tid(p.wv); const bool cons = tid < 256; const int ptid = tid - 256;
    const int lane = tid & 63, w = (tid >> 6) & 3, s = lane & 7, cl = w * 8 + (lane >> 3), col = qtr * 32 + cl;
    bf16_t* P = (bf16_t*)(p.ws + OFF_P);
    f32x2 S[8];
#pragma unroll
    for (int e = 0; e < 8; ++e) S[e] = bc2(0.f);
    f32x4 k4[4][4];
    StageRegs sr{k4[0][0], k4[0][1], k4[0][2], k4[0][3], k4[1][0], k4[1][1], k4[1][2], k4[1][3]};
#define LOADSTATE(BS) do { } while (0)
#define STISSUE(BS) st_issue(p.st_S + ((size_t)(l * NS + (BS)) * 4 + h) * 16384, qtr, ptid, k4[2][0], k4[2][1], k4[2][2], k4[2][3])
    if (!cons) { issue_gdn(p, h, qtr, SROW0 + bs0 * 4, LS, 0, ptid, sr); STISSUE(bs0); }
#pragma unroll 1
    for (int k = 0; k < nseq; ++k) {
        const int bs = bs0 + 8 * k, row0 = SROW0 + bs * 4;
        if (!cons) { commit_gdn(LS, 0, lds, ptid, sr, k & 1); st_commit(STB(lds, k & 1), ptid, k4[2][0], k4[2][1], k4[2][2], k4[2][3]);
            if (k + 1 < nseq) { issue_gdn(p, h, qtr, row0 + 32, LS, 0, ptid, sr); STISSUE(bs + 8); } }
        BARRIER_LDS();
        if (!cons) { if (k > 0) { store_out_blk(P, row0 - 32, 0, LS, cBV + h * 128 + qtr * 32, OB(lds, (k - 1) & 1), ptid); st_store(p.out + o_sS + ((size_t)(l * NS + bs - 8) * 4 + h) * 16384, qtr, STB(lds, (k - 1) & 1), ptid); } }
        else {
            const float* qb = QB(lds, k & 1); const float* kb = KB(lds, k & 1); const float* vb = VB(lds, k & 1); const float* sc = SCB(lds, k & 1);
            float* ob = OB(lds, k & 1); float* stb = STB(lds, k & 1);
#pragma unroll
            for (int e = 0; e < 16; ++e) { const int d = (e >> 2) * 32 + s * 4 + (e & 3); S[e >> 1][e & 1] = stb[d * ST_LD + cl]; }
            f32x4 q4[4][4]; float vv[4], a[4], be[4]; f32x4 qk[4], kk[4];
#define GLOAD_Q(T0) do { _Pragma("unroll") for (int i = 0; i < 4; ++i) { const int t = (T0) + i; \
        _Pragma("unroll") for (int j = 0; j < 4; ++j) q4[i][j] = *(const f32x4*)(qb + t * 128 + j * 32 + s * 4); } } while (0)
#define GLOAD_K(T0) do { _Pragma("unroll") for (int i = 0; i < 4; ++i) { const int t = (T0) + i; \
        _Pragma("unroll") for (int j = 0; j < 4; ++j) k4[i][j] = *(const f32x4*)(kb + t * 128 + j * 32 + s * 4); } \
      _Pragma("unroll") for (int i = 0; i < 4; ++i) { const int t = (T0) + i; \
        const f32x2 gg = *(const f32x2*)(sc + t * 16); a[i] = gg[0]; be[i] = gg[1]; \
        qk[i] = *(const f32x4*)(sc + t * 16 + 4); kk[i] = *(const f32x4*)(sc + t * 16 + 8); vv[i] = vb[t * 32 + cl]; } } while (0)
            GLOAD_Q(0); GLOAD_K(0);
            {
                float dk[4], dq[4];
                __builtin_amdgcn_sched_barrier(0);
#pragma unroll
                for (int i = 0; i < 4; ++i) {
                    f32x2 x = bc2(0.f), x2 = bc2(0.f), y = bc2(0.f), y2 = bc2(0.f);
#pragma unroll
                    for (int j = 0; j < 4; ++j) {
                        x = lo2(k4[i][j]) * S[2 * j] + x; x2 = hi2(k4[i][j]) * S[2 * j + 1] + x2;
                        y = lo2(q4[i][j]) * S[2 * j] + y; y2 = hi2(q4[i][j]) * S[2 * j + 1] + y2; }
                    x = x + x2; y = y + y2;
                    dk[i] = x[0] + x[1]; dq[i] = y[0] + y[1];
                }
                __builtin_amdgcn_sched_barrier(0);
#pragma unroll
                for (int i = 0; i < 4; ++i) { dk[i] = red8(dk[i]); dq[i] = red8(dq[i]); }
                const float A0 = a[0], A1 = A0 * a[1], A2 = A1 * a[2], A3 = A2 * a[3];
                const float r10 = a[1], r21 = a[2], r32 = a[3], r20 = r10 * a[2], r31 = r21 * a[3], r30 = r20 * a[3];
                const float u0 = be[0] * (vv[0] - A0 * dk[0]);
                const float u1 = be[1] * (vv[1] - A1 * dk[1] - r10 * kk[1][0] * u0);
                const float u2 = be[2] * (vv[2] - A2 * dk[2] - r20 * kk[2][0] * u0 - r21 * kk[2][1] * u1);
                const float u3 = be[3] * (vv[3] - A3 * dk[3] - r30 * kk[3][0] * u0 - r31 * kk[3][1] * u1 - r32 * kk[3][2] * u2);
                if (s == 0) {
                    ob[0 * 32 + cl] = A0 * dq[0] + qk[0][0] * u0;
                    ob[1 * 32 + cl] = A1 * dq[1] + r10 * qk[1][0] * u0 + qk[1][1] * u1;
                    ob[2 * 32 + cl] = A2 * dq[2] + r20 * qk[2][0] * u0 + r21 * qk[2][1] * u1 + qk[2][2] * u2;
                    ob[3 * 32 + cl] = A3 * dq[3] + r30 * qk[3][0] * u0 + r31 * qk[3][1] * u1 + r32 * qk[3][2] * u2 + qk[3][3] * u3;
                }
                const float c0 = r30 * u0, c1 = r31 * u1, c2 = r32 * u2, c3 = u3;
#pragma unroll
                for (int j = 0; j < 4; ++j) {
                    S[2 * j] = lo2(k4[3][j]) * bc2(c3) + (lo2(k4[2][j]) * bc2(c2) + (lo2(k4[1][j]) * bc2(c1) + (lo2(k4[0][j]) * bc2(c0) + S[2 * j] * bc2(A3))));
                    S[2 * j + 1] = hi2(k4[3][j]) * bc2(c3) + (hi2(k4[2][j]) * bc2(c2) + (hi2(k4[1][j]) * bc2(c1) + (hi2(k4[0][j]) * bc2(c0) + S[2 * j + 1] * bc2(A3)))); }
            }
#undef GLOAD_Q
#undef GLOAD_K
#pragma unroll
            for (int e = 0; e < 16; ++e) { const int d = (e >> 2) * 32 + s * 4 + (e & 3); stb[d * ST_LD + cl] = S[e >> 1][e & 1]; }
        }
    }
    BARRIER_LDS();
    if (!cons) { store_out_blk(P, SROW0 + (bs0 + 8 * (nseq - 1)) * 4, 0, LS, cBV + h * 128 + qtr * 32, OB(lds, (nseq - 1) & 1), ptid); st_store(p.out + o_sS + ((size_t)(l * NS + bs0 + 8 * (nseq - 1)) * 4 + h) * 16384, qtr, STB(lds, (nseq - 1) & 1), ptid); }
    BARRIER_LDS();
#undef LOADSTATE
#undef STISSUE
}


__device__ __forceinline__ void phase_scan(const Params& p, int l, float* lds) {
    for (int item = blockIdx.x; item < 256; item += gridDim.x) {
        const int xcd_ = item & 7, y_ = item >> 3, qtr = y_ & 3, chain = (y_ >> 2) * 8 + xcd_;
        const int h = chain & 3, bs = (chain >> 2) & 7, branch = chain >> 5;
        if (branch == 0) scan_mlstm_chunk(p, l, bs, h, qtr, bs * LPAD, LP, (unsigned char*)lds); else scan_gdn_chunk(p, l, bs, h, qtr, bs * LPAD, LP, (unsigned char*)lds);
    }
    for (int c = blockIdx.x; c < 256; c += gridDim.x) {
        const int qtr = c & 3, h = (c >> 2) & 3, branch = (c >> 4) & 1, bs0 = c >> 5;
        if (branch == 0) scan_mlstm_stream(p, l, h, qtr, bs0, NS / 8, lds); else scan_gdn_stream(p, l, h, qtr, bs0, NS / 8, lds);
    }
}

__device__ __forceinline__ void phase_norm(const Params& p, int l) {
    const int tid = opaque_tid(p.wv); const int wave = tid >> 6, lane = tid & 63;
    bf16_t* P = (bf16_t*)(p.ws + OFF_P);
    const int part = lane >> 5, hh = (lane >> 3) & 3, g = lane & 7, ch0 = hh * 128 + g * 16;
    const int craw = (part ? cBV : cV) + ch0, cgate = (part ? cZ : cO) + ch0;
    const float* wnp = part ? p.b_norm_w + l * 128 + g * 16 : p.a_norm_w + l * 512 + ch0;
    float wn[16];
#pragma unroll
    for (int i = 0; i < 4; ++i) { const f32x4 w4 = *(const f32x4*)(wnp + 4 * i); wn[4 * i] = w4[0]; wn[4 * i + 1] = w4[1]; wn[4 * i + 2] = w4[2]; wn[4 * i + 3] = w4[3]; }
    const int stride = gridDim.x * 8;
    int row = blockIdx.x * 8 + wave;
    while (row < SROW0 && (row % LPAD) >= LP) row += stride;
    u32x4 cx0 = (u32x4){0u, 0u, 0u, 0u}, cx1 = cx0, cz0 = cx0, cz1 = cx0;
    if (row < MROWS) { const bf16_t* pr = P + (size_t)row * NP; cx0 = *(const u32x4*)(pr + craw); cx1 = *(const u32x4*)(pr + craw + 8); cz0 = *(const u32x4*)(pr + cgate); cz1 = *(const u32x4*)(pr + cgate + 8); }
    while (row < MROWS) {
        int nrow = row + stride;
        while (nrow < SROW0 && (nrow % LPAD) >= LP) nrow += stride;
        u32x4 nx0 = cx0, nx1 = cx1, nz0 = cz0, nz1 = cz1;
        if (nrow < MROWS) { const bf16_t* pn = P + (size_t)nrow * NP; nx0 = *(const u32x4*)(pn + craw); nx1 = *(const u32x4*)(pn + craw + 8); nz0 = *(const u32x4*)(pn + cgate); nz1 = *(const u32x4*)(pn + cgate + 8); }
        bf16_t* pr = P + (size_t)row * NP;
        float x[16], z[16];
        unpack8(cx0, x); unpack8(cx1, x + 8); unpack8(cz0, z); unpack8(cz1, z + 8);
        float sum = 0.f;
#pragma unroll
        for (int i = 0; i < 16; ++i) sum += x[i];
        float mean = red8(sum) * (1.f / 128.f);
        if (part) mean = 0.f;
        float s2 = 0.f;
#pragma unroll
        for (int i = 0; i < 16; ++i) { x[i] -= mean; s2 += x[i] * x[i]; }
        const float rstd = rsqrtf(red8(s2) * (1.f / 128.f) + 1e-6f);
        float y[16];
#pragma unroll
        for (int i = 0; i < 16; ++i) { const float sg = sigmoidf_(z[i]); y[i] = x[i] * rstd * wn[i] * (part ? z[i] * sg : sg); }
        *(u32x4*)(pr + cgate) = pack8(y); *(u32x4*)(pr + cgate + 8) = pack8(y + 8);
        cx0 = nx0; cx1 = nx1; cz0 = nz0; cz1 = nz1; row = nrow;
    }
}

__device__ __forceinline__ void phase_convact(const Params& p, int l) {
    bf16_t* U = (bf16_t*)(p.ws + OFF_P); const bf16_t* HB = (const bf16_t*)(p.ws + OFF_HB);
    const float* cw = p.fconv_w + (size_t)l * 3 * NU;
    constexpr int NCG = DFF / 8, NRG = MROWS / 32;
    const int tid = opaque_tid(p.wv);
    for (int it = blockIdx.x * NTHREADS + tid; it < NRG * NCG; it += gridDim.x * NTHREADS) {
        const int rg = it / NCG, cg_ = it - rg * NCG, c0 = cg_ * 8;
        float wa[3][8], wb[3][8];
#pragma unroll
        for (int j = 0; j < 3; ++j) {
            const f32x4 a0 = *(const f32x4*)(cw + j * NU + c0), a1 = *(const f32x4*)(cw + j * NU + c0 + 4);
            const f32x4 b0 = *(const f32x4*)(cw + j * NU + DFF + c0), b1 = *(const f32x4*)(cw + j * NU + DFF + c0 + 4);
#pragma unroll
            for (int i = 0; i < 4; ++i) { wa[j][i] = a0[i]; wa[j][4 + i] = a1[i]; wb[j][i] = b0[i]; wb[j][4 + i] = b1[i]; }
        }
        float a2[8], a1[8], b2[8], b1[8];
        const bool samp = rg >= SROW0 / 32;
#pragma unroll
        for (int i = 0; i < 8; ++i) { a2[i] = a1[i] = b2[i] = b1[i] = 0.f; }
        if (!samp && (rg % (LPAD / 32)) != 0) {
            const bf16_t* h0 = HB + (size_t)(rg - 1) * 2 * NU;
            unpack8(*(const u32x4*)(h0 + c0), a2); unpack8(*(const u32x4*)(h0 + NU + c0), a1);
            unpack8(*(const u32x4*)(h0 + DFF + c0), b2); unpack8(*(const u32x4*)(h0 + NU + DFF + c0), b1);
        }
#pragma unroll 4
        for (int i = 0; i < 32; ++i) {
            const int row = rg * 32 + i;
            if (samp && (i & 3) == 0) {
                const float* st = p.st_fconv + ((size_t)(l * NS + ((row - SROW0) >> 2)) * 2) * NU;
                const f32x4 x0 = *(const f32x4*)(st + c0), x1 = *(const f32x4*)(st + c0 + 4), y0 = *(const f32x4*)(st + NU + c0), y1 = *(const f32x4*)(st + NU + c0 + 4);
                const f32x4 u0 = *(const f32x4*)(st + DFF + c0), u1 = *(const f32x4*)(st + DFF + c0 + 4), v0 = *(const f32x4*)(st + NU + DFF + c0), v1 = *(const f32x4*)(st + NU + DFF + c0 + 4);
#pragma unroll
                for (int e = 0; e < 4; ++e) { a2[e] = x0[e]; a2[4 + e] = x1[e]; a1[e] = y0[e]; a1[4 + e] = y1[e]; b2[e] = u0[e]; b2[4 + e] = u1[e]; b1[e] = v0[e]; b1[4 + e] = v1[e]; }
            }
            bf16_t* ur = U + (size_t)row * NU;
            float a[8], b[8], hh[8];
            unpack8(*(const u32x4*)(ur + c0), a); unpack8(*(const u32x4*)(ur + DFF + c0), b);
#pragma unroll
            for (int e = 0; e < 8; ++e) {
                const float ca = wa[0][e] * a2[e] + wa[1][e] * a1[e] + wa[2][e] * a[e];
                const float cb = wb[0][e] * b2[e] + wb[1][e] * b1[e] + wb[2][e] * b[e];
                hh[e] = ca * sigmoidf_(ca) * cb;
                a2[e] = a1[e]; a1[e] = a[e]; b2[e] = b1[e]; b1[e] = b[e];
            }
            u32x4 o; o.x = pk2(hh[0], hh[1]); o.y = pk2(hh[2], hh[3]); o.z = pk2(hh[4], hh[5]); o.w = pk2(hh[6], hh[7]);
            *(u32x4*)(ur + c0) = o;
        }
    }
}

#ifndef PROBE
#define PROBE 0
#endif
constexpr int NPHASE = 2 + DEPTH * 11;
__global__ void __launch_bounds__(NTHREADS) fwd_kernel(Params pin) {
    extern __shared__ __attribute__((aligned(16))) unsigned char smem_raw[];
    Params p = pin; p.wv = __builtin_amdgcn_readfirstlane((int)(threadIdx.x >> 6));
    unsigned* bar = (unsigned*)(p.ws + OFF_BAR); const unsigned xcc = xb_xcc_id();
    volatile LAS unsigned* xst = (volatile LAS unsigned*)(LAS unsigned char*)(smem_raw + LDS_GEMM);
    if (threadIdx.x == 0) { xst[0] = 0u; xst[1] = 0u; (void)xb_add(&bar[XB_XCNT(xcc)], 1u); }
    __syncthreads();
    float* lds = (float*)smem_raw;
    bf16_t* X = (bf16_t*)(p.ws + OFF_X); bf16_t* P = (bf16_t*)(p.ws + OFF_P); bf16_t* HB = (bf16_t*)(p.ws + OFF_HB);
    for (int ph = p.ph_lo; ph < p.ph_hi; ++ph) {
#if PROBE == 3
      for (int rep = 0; rep < 2; ++rep) { const int sx = ph < 2 ? -1 : (ph - 2) % 11; if (rep == 1 && !(ph < 2 || sx == 6 || sx == 10)) break;
#endif
        if (ph == 0) phase_weights(p, lds);
        else if (ph == 1) phase_ln(p, 0, nullptr, 0, p.ln_emb_g, p.ln_emb_b, 0, false);
        else {
            const int l = (ph - 2) / 11, s = (ph - 2) % 11;
            if (s == 0) { GemmArgs g{X, X, 1 << 30, D, w_inT(p, l), MROWS, NP, 1024}; gemm_phase(g, EpiP{P, (bf16_t*)(p.ws + OFF_GH), p.out, l}, p.wv); }
            else if (s == 1) phase_prep(p, l, lds);
            else if (s == 2) phase_scan(p, l, lds);
            else if (s == 3) phase_norm(p, l);
            else if (s == 4) { GemmArgs g{P + cO, P + cZ, 4, NP, w_abT(p, l), MROWS, 2048, 512}; gemm_phase(g, EpiMerge{P}, p.wv); }
            else if (s == 5) { GemmArgs g{P + cMG, P + cMG, 1 << 30, NP, w_outT(p, l), MROWS, 1024, 2048, 1}; gemm_phase(g, EpiRes{X, P, NP, 0, (bf16_t*)(p.ws + OFF_GH)}, p.wv); }
            else if (s == 6) phase_ln(p, 1, P, NP, p.ln1_g + l * D, p.ln1_b + l * D, -1, false);
            else if (s == 7) { GemmArgs g{X, X, 1 << 30, D, w_upT(p, l), MROWS, NU, 1024}; gemm_phase(g, EpiUp{P, HB, p.out, l}, p.wv); }
            else if (s == 8) phase_convact(p, l);
            else if (s == 9) { GemmArgs g{P, P, 1 << 30, NU, w_dnT(p, l), MROWS, 1024, DFF, 1}; gemm_phase(g, EpiRes{X, P, NU, DFF, (bf16_t*)(p.ws + OFF_GH)}, p.wv); }
            else phase_ln(p, 1, P + DFF, NU, p.ln2_g + l * D, p.ln2_b + l * D, l + 1 < DEPTH ? l + 1 : -1, l + 1 == DEPTH);
        }
#if PROBE == 3
      }
#endif
        if (ph + 1 < p.ph_hi) { if (p.ph_lo < 0) cg::this_grid().sync(); else xcd_barrier(bar, xcc, xst, p.wv); }
    }
#if PROBE == 4
    for (int i = 0; i < 20; ++i) xcd_barrier(bar, xcc, xst, p.wv);
#endif
}

extern "C" void kernel_launch(void* const* d_in, const int* in_sizes, int n_in, void* d_out, int out_size, void* d_ws, size_t ws_size, hipStream_t stream) {
    static int grid = 0;
    if (grid == 0) {
        if (n_in != 28 || (size_t)out_size != o_end || ws_size < WS_END) { fprintf(stderr, "kernel_launch: unexpected sizes n_in %d out %d ws %zu (need %zu)\n", n_in, out_size, ws_size, (size_t)WS_END); grid = -1; return; }
        int dev = 0, cus = 0, per_cu = 0;
        hipGetDevice(&dev); hipDeviceGetAttribute(&cus, hipDeviceAttributeMultiprocessorCount, dev);
        if (hipFuncSetAttribute((const void*)fwd_kernel, hipFuncAttributeMaxDynamicSharedMemorySize, LDS_BYTES) != hipSuccess) { fprintf(stderr, "hipFuncSetAttribute failed\n"); grid = -1; return; }
        if (hipOccupancyMaxActiveBlocksPerMultiprocessor(&per_cu, (const void*)fwd_kernel, NTHREADS, LDS_BYTES) != hipSuccess || per_cu < 1) { fprintf(stderr, "occupancy query failed (%d)\n", per_cu); (void)hipGetLastError(); per_cu = 1; }
        grid = cus * per_cu;
        if (grid > 256) grid = 256;
    }
    if (grid < 0) return;
    if (hipMemsetAsync((unsigned char*)d_ws + OFF_BAR, 0, 16384, stream) != hipSuccess) { fprintf(stderr, "memset of barrier words failed\n"); return; }
    Params p{};
    const float** pp = (const float**)&p;
    for (int i = 0; i < 28; ++i) pp[i] = (const float*)d_in[i];
    p.out = (float*)d_out; p.ws = (unsigned char*)d_ws;
#if MULTI
    for (int ph = 0; ph < NPHASE; ++ph) { p.ph_lo = ph; p.ph_hi = ph + 1; hipLaunchKernelGGL(fwd_kernel, dim3(grid), dim3(NTHREADS), LDS_BYTES, stream, p); }
#else
    p.ph_lo = 0; p.ph_hi = NPHASE;
    void* args[] = {&p};
    hipError_t e = hipLaunchCooperativeKernel((const void*)fwd_kernel, dim3(grid), dim3(NTHREADS), args, LDS_BYTES, stream);
    if (e != hipSuccess) fprintf(stderr, "cooperative launch failed: %s (grid %d)\n", hipGetErrorString(e), grid);
#endif
}
```
